# Optimizing an MI355X kernel written in HIP

```python
import math
import jax, jax.numpy as jnp
from jax import lax
import numpy as np

D_MODEL = 1024
BATCH = 4
SEQ = 4096
DEPTH = 2

F32 = jnp.float32
EPS = 1e-6
NEG_INF = -1e30
Q_BLOCK = 128
N_MEM = 256
POS_OFFSET_MAX = 1024
S5_WIDTH = 256
S5_GROUP = 16
S5_GROUPS = S5_WIDTH // S5_GROUP
S5_STATE = 64
S5_DT_MIN = 1e-3
S5_DT_MAX = 1e-1
MLA_HEADS = 4
MLA_Q_RANK = 192
MLA_KV_RANK = 128
MLA_NOPE = 64
MLA_ROPE = 32
MLA_V = 64
MLA_WIDTH = MLA_HEADS * MLA_V
ROPE_THETA = 10000.0
LRU_WIDTH = 256
LRU_BLOCKS = 4
LRU_BLOCK = LRU_WIDTH // LRU_BLOCKS
LRU_CONV = 4
LRU_C = 8.0
DIFF_HEADS = 4
DIFF_HEAD_DIM = 32
DIFF_V = 2 * DIFF_HEAD_DIM
DIFF_WIDTH = DIFF_HEADS * DIFF_V
REL_BUCKETS = 32
REL_MAX_DIST = 128
CROSS_HEADS = 4
CROSS_HEAD_DIM = 64
CROSS_WIDTH = CROSS_HEADS * CROSS_HEAD_DIM
DENSE_FF = 2816
N_EXPERTS = 8
TOP_K = 2
EXPERT_FF = 3584
MOE_BLOCK = 256
N_DENSE = (DEPTH + 1) // 2
N_MOE = DEPTH // 2
N_BRANCH = 4
BRANCH_WIDTH = 256
IN_SIZES = (S5_WIDTH, MLA_Q_RANK, MLA_KV_RANK, MLA_ROPE, LRU_WIDTH, LRU_WIDTH,
            DIFF_HEADS * 2 * DIFF_HEAD_DIM, DIFF_HEADS * 2 * DIFF_HEAD_DIM, DIFF_WIDTH,
            N_BRANCH * D_MODEL)
D_IN = sum(IN_SIZES)

kernel_name = 'hybrid_gated_decoder_layers'


def rms_norm(x, g):
    xf = x.astype(F32)
    y = xf * lax.rsqrt(jnp.mean(xf * xf, axis=-1, keepdims=True) + EPS)
    return (y * g.astype(F32)).astype(x.dtype)


def rope(x, pos):
    half = x.shape[-1] // 2
    inv = ROPE_THETA ** (-jnp.arange(half, dtype=F32) / half)
    ang = pos.astype(F32)[:, :, None, None] * inv
    cos, sin = jnp.cos(ang), jnp.sin(ang)
    x1 = x[..., :half].astype(F32)
    x2 = x[..., half:].astype(F32)
    return jnp.concatenate([x1 * cos - x2 * sin, x1 * sin + x2 * cos], axis=-1).astype(x.dtype)


def rel_bucket(dist):
    n = jnp.maximum(dist, 0)
    exact = REL_BUCKETS // 2
    log_ratio = jnp.log(jnp.maximum(n, exact).astype(F32) / exact) / math.log(REL_MAX_DIST / exact)
    large = jnp.minimum(exact + (log_ratio * (REL_BUCKETS - exact)).astype(jnp.int32), REL_BUCKETS - 1)
    return jnp.where(n < exact, n, large)


def to_blocks(a):
    b, s = a.shape[:2]
    a = a.reshape((b, s // Q_BLOCK, Q_BLOCK) + a.shape[2:])
    return jnp.moveaxis(a, 1, 0)


def from_blocks(a):
    a = jnp.moveaxis(a, 0, 1)
    return a.reshape((a.shape[0], a.shape[1] * a.shape[2]) + a.shape[3:])


def _affine_combine(e1, e2):
    a1, b1 = e1
    a2, b2 = e2
    return (a1 * a2, a2 * b1 + b2)


def _complex_affine_combine(e1, e2):
    a1r, a1i, b1r, b1i = e1
    a2r, a2i, b2r, b2i = e2
    return (a2r * a1r - a2i * a1i, a2r * a1i + a2i * a1r,
            a2r * b1r - a2i * b1i + b2r, a2r * b1i + a2i * b1r + b2i)


def s5_branch(u, lam_re, lam_im, log_step, b_re, b_im, c_re, c_im, d_skip, w_glu, b_glu):
    b, s, _ = u.shape
    uf = u.astype(F32)
    ug = uf.reshape(b, s, S5_GROUPS, S5_GROUP)
    dt = jnp.exp(log_step.astype(F32))[:, None]
    lr = lam_re.astype(F32)
    li = lam_im.astype(F32)
    mag = jnp.exp(lr * dt)
    ar = mag * jnp.cos(li * dt)
    ai = mag * jnp.sin(li * dt)
    den = lr * lr + li * li
    zr = ((ar - 1.0) * lr + ai * li) / den
    zi = (ai * lr - (ar - 1.0) * li) / den
    br = b_re.astype(F32)
    bi = b_im.astype(F32)
    bbr = zr[..., None] * br - zi[..., None] * bi
    bbi = zr[..., None] * bi + zi[..., None] * br
    bur = jnp.einsum('bsgc,gpc->bsgp', ug, bbr)
    bui = jnp.einsum('bsgc,gpc->bsgp', ug, bbi)
    shp = bur.shape
    _, _, hr, hi = lax.associative_scan(
        _complex_affine_combine,
        (jnp.broadcast_to(ar, shp), jnp.broadcast_to(ai, shp), bur, bui), axis=1)
    y = (jnp.einsum('bsgp,gcp->bsgc', hr, c_re.astype(F32))
         - jnp.einsum('bsgp,gcp->bsgc', hi, c_im.astype(F32)))
    y = y.reshape(b, s, S5_WIDTH) + d_skip.astype(F32) * uf
    y = jax.nn.gelu(y)
    y = y * jax.nn.sigmoid(jnp.dot(y, w_glu.astype(F32)) + b_glu.astype(F32))
    return y.astype(u.dtype)


def mla_branch(cq, ckv, kpe, pos, g_cq, g_ckv, w_uq, w_ukv, g_qn, g_kn):
    b, s, _ = cq.shape
    q = jnp.dot(rms_norm(cq, g_cq), w_uq).reshape(b, s, MLA_HEADS, MLA_NOPE + MLA_ROPE)
    kv = jnp.dot(rms_norm(ckv, g_ckv), w_ukv).reshape(b, s, MLA_HEADS, MLA_NOPE + MLA_V)
    k_pe = jnp.broadcast_to(kpe[:, :, None, :], (b, s, MLA_HEADS, MLA_ROPE))
    k = jnp.concatenate([kv[..., :MLA_NOPE], k_pe], axis=-1)
    v = kv[..., MLA_NOPE:]
    q = rms_norm(q, g_qn)
    k = rms_norm(k, g_kn)
    q = jnp.concatenate([q[..., :MLA_NOPE], rope(q[..., MLA_NOPE:], pos)], axis=-1) * (MLA_NOPE + MLA_ROPE) ** -0.5
    k = jnp.concatenate([k[..., :MLA_NOPE], rope(k[..., MLA_NOPE:], pos)], axis=-1)

    def one_block(args):
        qb, pb = args
        sc = jnp.einsum('bqhd,bkhd->bhqk', qb, k).astype(F32)
        mask = pb[:, None, :, None] >= pos[:, None, None, :]
        p = jax.nn.softmax(jnp.where(mask, sc, NEG_INF), axis=-1).astype(v.dtype)
        return jnp.einsum('bhqk,bkhd->bqhd', p, v)

    out = from_blocks(lax.map(one_block, (to_blocks(q), to_blocks(pos))))
    return out.reshape(b, s, MLA_WIDTH)


def rglru_branch(xb, gb, conv_w, conv_b, w_r, b_r, w_i, b_i, lam):
    b, s, w = xb.shape
    xp = jnp.pad(xb, ((0, 0), (LRU_CONV - 1, 0), (0, 0)))
    xc = (conv_b + sum(xp[:, k:k + s] * conv_w[k] for k in range(LRU_CONV))).astype(F32)
    xblk = xc.reshape(b, s, LRU_BLOCKS, LRU_BLOCK)
    r = jax.nn.sigmoid(jnp.einsum('bsnc,ncd->bsnd', xblk, w_r.astype(F32)).reshape(b, s, w) + b_r.astype(F32))
    i = jax.nn.sigmoid(jnp.einsum('bsnc,ncd->bsnd', xblk, w_i.astype(F32)).reshape(b, s, w) + b_i.astype(F32))
    log_a = -LRU_C * r * jax.nn.softplus(-lam.astype(F32))
    a = jnp.exp(log_a)
    inp = jnp.sqrt(-jnp.expm1(2.0 * log_a)) * (i * xc)
    _, hseq = lax.associative_scan(_affine_combine, (a, inp), axis=1)
    return (hseq * jax.nn.gelu(gb.astype(F32))).astype(xb.dtype)


def diff_branch(q, k, v, pos, rel_table, g_qn, g_kn, lq1, lk1, lq2, lk2, g_sub, lam_init):
    b, s, _ = q.shape
    q = rms_norm(q.reshape(b, s, DIFF_HEADS, 2, DIFF_HEAD_DIM), g_qn) * DIFF_HEAD_DIM ** -0.5
    k = rms_norm(k.reshape(b, s, DIFF_HEADS, 2, DIFF_HEAD_DIM), g_kn)
    v = v.reshape(b, s, DIFF_HEADS, DIFF_V)
    k1 = k[:, :, :, 0]
    k2 = k[:, :, :, 1]
    lam = (jnp.exp(jnp.sum(lq1.astype(F32) * lk1.astype(F32)))
           - jnp.exp(jnp.sum(lq2.astype(F32) * lk2.astype(F32))) + lam_init)

    def one_block(args):
        qb, pb = args
        dist = pb[:, :, None] - pos[:, None, :]
        bias = jnp.moveaxis(rel_table[rel_bucket(dist)], -1, 1).astype(F32)
        mask = (dist >= 0)[:, None]

        def attn_probs(qq, kk):
            sc = jnp.einsum('bqhd,bkhd->bhqk', qq, kk).astype(F32) + bias
            return jax.nn.softmax(jnp.where(mask, sc, NEG_INF), axis=-1)

        p = attn_probs(qb[:, :, :, 0], k1) - lam * attn_probs(qb[:, :, :, 1], k2)
        return jnp.einsum('bhqk,bkhd->bqhd', p.astype(v.dtype), v)

    out = from_blocks(lax.map(one_block, (to_blocks(q), to_blocks(pos))))
    out = rms_norm(out, g_sub) * (1.0 - lam_init)
    return out.reshape(b, s, DIFF_WIDTH)


def cross_attention(h, m, w_q, w_k, w_v, w_o, g_qn, g_kn):
    b, s, _ = h.shape
    n = m.shape[1]
    q = rms_norm(jnp.dot(h, w_q).reshape(b, s, CROSS_HEADS, CROSS_HEAD_DIM), g_qn) * CROSS_HEAD_DIM ** -0.5
    k = rms_norm(jnp.dot(m, w_k).reshape(b, n, CROSS_HEADS, CROSS_HEAD_DIM), g_kn)
    v = jnp.dot(m, w_v).reshape(b, n, CROSS_HEADS, CROSS_HEAD_DIM)
    p = jax.nn.softmax(jnp.einsum('bqhd,bkhd->bhqk', q, k).astype(F32), axis=-1).astype(v.dtype)
    o = jnp.einsum('bhqk,bkhd->bqhd', p, v).reshape(b, s, CROSS_WIDTH)
    return jnp.dot(o, w_o)


def swiglu(h, w_gate, w_up, w_down):
    return jnp.dot(jax.nn.silu(jnp.dot(h, w_gate)) * jnp.dot(h, w_up), w_down)


def moe_swiglu(h, w_router, w_gate, w_up, w_down):
    b, s, d = h.shape
    n_tok = b * s
    n_assign = n_tok * TOP_K
    n_blk = -(-(n_assign + N_EXPERTS * (MOE_BLOCK - 1)) // MOE_BLOCK)
    n_rows = n_blk * MOE_BLOCK
    ht = h.reshape(n_tok, d)
    logits = jnp.dot(ht, w_router).astype(F32)
    top_v, top_e = lax.top_k(logits, TOP_K)
    top_w = jax.nn.softmax(top_v, axis=-1)
    flat_e = top_e.reshape(-1)
    flat_t = jnp.repeat(jnp.arange(n_tok, dtype=jnp.int32), TOP_K)
    flat_w = top_w.reshape(-1)
    order = jnp.argsort(flat_e)
    se, st, sw = flat_e[order], flat_t[order], flat_w[order]
    counts = jnp.bincount(flat_e, length=N_EXPERTS)
    padded = (counts + MOE_BLOCK - 1) // MOE_BLOCK * MOE_BLOCK
    grp_start = jnp.cumsum(counts) - counts
    pad_end = jnp.cumsum(padded)
    pad_start = pad_end - padded
    dest = pad_start[se] + jnp.arange(n_assign, dtype=jnp.int32) - grp_start[se]
    row_tok = jnp.zeros((n_rows,), jnp.int32).at[dest].set(st)
    row_w = jnp.zeros((n_rows,), F32).at[dest].set(sw)
    blk_e = jnp.minimum(jnp.searchsorted(pad_end, jnp.arange(n_blk) * MOE_BLOCK, side='right'), N_EXPERTS - 1)
    xs = ht[row_tok].reshape(n_blk, MOE_BLOCK, d)

    def one_block(args):
        xb, e = args
        return swiglu(xb, w_gate[e], w_up[e], w_down[e])

    ys = lax.map(one_block, (xs, blk_e)).reshape(n_rows, d)
    out = jnp.zeros((n_tok, d), h.dtype).at[row_tok].add(ys * row_w[:, None].astype(ys.dtype))
    return out.reshape(b, s, d)


def _in_split_points():
    pts, acc = [], 0
    for w in IN_SIZES[:-1]:
        acc += w
        pts.append(acc)
    return pts


def setup_inputs(seed: int = 0) -> dict:
    key = jax.random.key(seed)
    keys = iter(jax.random.split(key, 80))

    def nrm(shape, scale):
        return scale * jax.random.normal(next(keys), shape, F32)

    def gain(shape):
        return 1.0 + 0.01 * jax.random.normal(next(keys), shape, F32)

    L = DEPTH
    x = nrm((BATCH, SEQ, D_MODEL), 1.0)
    mem = nrm((BATCH, N_MEM, D_MODEL), 1.0)
    offsets = jax.random.randint(next(keys), (BATCH, 1), 0, POS_OFFSET_MAX, jnp.int32)
    positions = offsets + jnp.arange(SEQ, dtype=jnp.int32)[None, :]
    rel_table = nrm((REL_BUCKETS, DIFF_HEADS), 0.5)
    g_mix = gain((L, D_MODEL))
    g_cross = gain((L, D_MODEL))
    g_mem = gain((L, D_MODEL))
    g_ffn = gain((L, D_MODEL))
    w_in = nrm((L, D_MODEL, D_IN), D_MODEL ** -0.5)
    b_gate = nrm((L, N_BRANCH, D_MODEL), 0.01)
    s5_lam_re = -0.5 + nrm((L, S5_GROUPS, S5_STATE), 0.01)
    s5_lam_im = math.pi * jnp.arange(S5_STATE, dtype=F32) + nrm((L, S5_GROUPS, S5_STATE), 0.01)
    s5_log_step = jax.random.uniform(next(keys), (L, S5_GROUPS), F32, math.log(S5_DT_MIN), math.log(S5_DT_MAX))
    s5_b_re = nrm((L, S5_GROUPS, S5_STATE, S5_GROUP), S5_GROUP ** -0.5)
    s5_b_im = nrm((L, S5_GROUPS, S5_STATE, S5_GROUP), S5_GROUP ** -0.5)
    s5_c_re = nrm((L, S5_GROUPS, S5_GROUP, S5_STATE), S5_STATE ** -0.5)
    s5_c_im = nrm((L, S5_GROUPS, S5_GROUP, S5_STATE), S5_STATE ** -0.5)
    s5_d = nrm((L, S5_WIDTH), 1.0)
    s5_w_glu = nrm((L, S5_WIDTH, S5_WIDTH), S5_WIDTH ** -0.5)
    s5_b_glu = nrm((L, S5_WIDTH), 0.01)
    mla_g_cq = gain((L, MLA_Q_RANK))
    mla_g_ckv = gain((L, MLA_KV_RANK))
    mla_w_uq = nrm((L, MLA_Q_RANK, MLA_HEADS * (MLA_NOPE + MLA_ROPE)), MLA_Q_RANK ** -0.5)
    mla_w_ukv = nrm((L, MLA_KV_RANK, MLA_HEADS * (MLA_NOPE + MLA_V)), MLA_KV_RANK ** -0.5)
    mla_g_qn = gain((L, MLA_NOPE + MLA_ROPE))
    mla_g_kn = gain((L, MLA_NOPE + MLA_ROPE))
    lru_conv_w = nrm((L, LRU_CONV, LRU_WIDTH), LRU_CONV ** -0.5)
    lru_conv_b = nrm((L, LRU_WIDTH), 0.01)
    lru_w_r = nrm((L, LRU_BLOCKS, LRU_BLOCK, LRU_BLOCK), LRU_BLOCK ** -0.5)
    lru_b_r = nrm((L, LRU_WIDTH), 0.01)
    lru_w_i = nrm((L, LRU_BLOCKS, LRU_BLOCK, LRU_BLOCK), LRU_BLOCK ** -0.5)
    lru_b_i = nrm((L, LRU_WIDTH), 0.01)
    a_c = jax.random.uniform(next(keys), (L, LRU_WIDTH), F32, 0.9, 0.999)
    a_base = a_c ** (1.0 / LRU_C)
    lru_lam = jnp.log(a_base) - jnp.log1p(-a_base)
    diff_g_qn = gain((L, DIFF_HEAD_DIM))
    diff_g_kn = gain((L, DIFF_HEAD_DIM))
    diff_lq1 = nrm((L, DIFF_HEAD_DIM), 0.1)
    diff_lk1 = nrm((L, DIFF_HEAD_DIM), 0.1)
    diff_lq2 = nrm((L, DIFF_HEAD_DIM), 0.1)
    diff_lk2 = nrm((L, DIFF_HEAD_DIM), 0.1)
    diff_g_sub = gain((L, DIFF_V))
    w_branch = nrm((L, N_BRANCH, BRANCH_WIDTH, D_MODEL), BRANCH_WIDTH ** -0.5)
    w_out = nrm((L, D_MODEL, D_MODEL), D_MODEL ** -0.5)
    x_wq = nrm((L, D_MODEL, CROSS_WIDTH), D_MODEL ** -0.5)
    x_wk = nrm((L, D_MODEL, CROSS_WIDTH), D_MODEL ** -0.5)
    x_wv = nrm((L, D_MODEL, CROSS_WIDTH), D_MODEL ** -0.5)
    x_wo = nrm((L, CROSS_WIDTH, D_MODEL), CROSS_WIDTH ** -0.5)
    x_g_qn = gain((L, CROSS_HEAD_DIM))
    x_g_kn = gain((L, CROSS_HEAD_DIM))
    ffn_w_gate = nrm((N_DENSE, D_MODEL, DENSE_FF), D_MODEL ** -0.5)
    ffn_w_up = nrm((N_DENSE, D_MODEL, DENSE_FF), D_MODEL ** -0.5)
    ffn_w_down = nrm((N_DENSE, DENSE_FF, D_MODEL), DENSE_FF ** -0.5)
    moe_w_router = nrm((N_MOE, D_MODEL, N_EXPERTS), D_MODEL ** -0.5)
    moe_w_gate = nrm((N_MOE, N_EXPERTS, D_MODEL, EXPERT_FF), D_MODEL ** -0.5)
    moe_w_up = nrm((N_MOE, N_EXPERTS, D_MODEL, EXPERT_FF), D_MODEL ** -0.5)
    moe_w_down = nrm((N_MOE, N_EXPERTS, EXPERT_FF, D_MODEL), EXPERT_FF ** -0.5)
    return {'x': x, 'mem': mem, 'positions': positions, 'rel_table': rel_table,
            'g_mix': g_mix, 'g_cross': g_cross, 'g_mem': g_mem, 'g_ffn': g_ffn,
            'w_in': w_in, 'b_gate': b_gate,
            's5_lam_re': s5_lam_re, 's5_lam_im': s5_lam_im, 's5_log_step': s5_log_step,
            's5_b_re': s5_b_re, 's5_b_im': s5_b_im, 's5_c_re': s5_c_re, 's5_c_im': s5_c_im,
            's5_d': s5_d, 's5_w_glu': s5_w_glu, 's5_b_glu': s5_b_glu,
            'mla_g_cq': mla_g_cq, 'mla_g_ckv': mla_g_ckv, 'mla_w_uq': mla_w_uq, 'mla_w_ukv': mla_w_ukv,
            'mla_g_qn': mla_g_qn, 'mla_g_kn': mla_g_kn,
            'lru_conv_w': lru_conv_w, 'lru_conv_b': lru_conv_b, 'lru_w_r': lru_w_r, 'lru_b_r': lru_b_r,
            'lru_w_i': lru_w_i, 'lru_b_i': lru_b_i, 'lru_lam': lru_lam,
            'diff_g_qn': diff_g_qn, 'diff_g_kn': diff_g_kn, 'diff_lq1': diff_lq1, 'diff_lk1': diff_lk1,
            'diff_lq2': diff_lq2, 'diff_lk2': diff_lk2, 'diff_g_sub': diff_g_sub,
            'w_branch': w_branch, 'w_out': w_out,
            'x_wq': x_wq, 'x_wk': x_wk, 'x_wv': x_wv, 'x_wo': x_wo, 'x_g_qn': x_g_qn, 'x_g_kn': x_g_kn,
            'ffn_w_gate': ffn_w_gate, 'ffn_w_up': ffn_w_up, 'ffn_w_down': ffn_w_down,
            'moe_w_router': moe_w_router, 'moe_w_gate': moe_w_gate, 'moe_w_up': moe_w_up,
            'moe_w_down': moe_w_down}


def reference(x, mem, positions, rel_table, g_mix, g_cross, g_mem, g_ffn, w_in, b_gate,
              s5_lam_re, s5_lam_im, s5_log_step, s5_b_re, s5_b_im, s5_c_re, s5_c_im,
              s5_d, s5_w_glu, s5_b_glu,
              mla_g_cq, mla_g_ckv, mla_w_uq, mla_w_ukv, mla_g_qn, mla_g_kn,
              lru_conv_w, lru_conv_b, lru_w_r, lru_b_r, lru_w_i, lru_b_i, lru_lam,
              diff_g_qn, diff_g_kn, diff_lq1, diff_lk1, diff_lq2, diff_lk2, diff_g_sub,
              w_branch, w_out,
              x_wq, x_wk, x_wv, x_wo, x_g_qn, x_g_kn,
              ffn_w_gate, ffn_w_up, ffn_w_down,
              moe_w_router, moe_w_gate, moe_w_up, moe_w_down):
    b, s, _ = x.shape
    split_points = _in_split_points()
    for l in range(DEPTH):
        h = rms_norm(x, g_mix[l])
        z = jnp.dot(h, w_in[l])
        (u_s5, c_q, c_kv, k_pe, x_lru, gate_lru, q_d, k_d, v_d, z_gate) = jnp.split(z, split_points, axis=-1)
        lam_init = 0.8 - 0.6 * math.exp(-0.3 * l)
        branches = (
            s5_branch(u_s5, s5_lam_re[l], s5_lam_im[l], s5_log_step[l], s5_b_re[l], s5_b_im[l],
                      s5_c_re[l], s5_c_im[l], s5_d[l], s5_w_glu[l], s5_b_glu[l]),
            mla_branch(c_q, c_kv, k_pe, positions, mla_g_cq[l], mla_g_ckv[l], mla_w_uq[l], mla_w_ukv[l],
                       mla_g_qn[l], mla_g_kn[l]),
            rglru_branch(x_lru, gate_lru, lru_conv_w[l], lru_conv_b[l], lru_w_r[l], lru_b_r[l],
                         lru_w_i[l], lru_b_i[l], lru_lam[l]),
            diff_branch(q_d, k_d, v_d, positions, rel_table, diff_g_qn[l], diff_g_kn[l], diff_lq1[l],
                        diff_lk1[l], diff_lq2[l], diff_lk2[l], diff_g_sub[l], lam_init),
        )
        z_gate = z_gate.reshape(b, s, N_BRANCH, D_MODEL)
        merged = sum(jax.nn.sigmoid(z_gate[:, :, n] + b_gate[l, n]) * jnp.dot(y, w_branch[l, n])
                     for n, y in enumerate(branches))
        x = x + jnp.dot(merged, w_out[l])
        x = x + cross_attention(rms_norm(x, g_cross[l]), rms_norm(mem, g_mem[l]),
                                x_wq[l], x_wk[l], x_wv[l], x_wo[l], x_g_qn[l], x_g_kn[l])
        hf = rms_norm(x, g_ffn[l])
        if l % 2 == 0:
            x = x + swiglu(hf, ffn_w_gate[l // 2], ffn_w_up[l // 2], ffn_w_down[l // 2])
        else:
            x = x + moe_swiglu(hf, moe_w_router[l // 2], moe_w_gate[l // 2], moe_w_up[l // 2], moe_w_down[l // 2])
    return x
```

```cpp
#include <hip/hip_runtime.h>
#include <cstdio>
#include <cstdint>

#define DBG_NPH 24

#ifndef DBG_GPERM
#define DBG_GPERM(n) (n)
#endif
#ifndef DBG_SCALE
#define DBG_SCALE 1.0f
#endif
#ifndef MK_ONE_LAUNCH
#define MK_ONE_LAUNCH 1
#endif
#ifndef G2_FP8
#define G2_FP8 0
#endif

#define LAS __attribute__((address_space(3)))
typedef unsigned short bf16_t;
typedef short bf16x8 __attribute__((ext_vector_type(8)));
typedef float f32x2 __attribute__((ext_vector_type(2)));
typedef float f32x4 __attribute__((ext_vector_type(4)));
typedef float f32x16 __attribute__((ext_vector_type(16)));
typedef unsigned u32x2 __attribute__((ext_vector_type(2)));
typedef unsigned u32x4 __attribute__((ext_vector_type(4)));
typedef int i32x4 __attribute__((ext_vector_type(4)));
typedef int i32x8 __attribute__((ext_vector_type(8)));

constexpr int DM = 1024, NB = 4, SEQ = 4096, MTOK = NB * SEQ, NMEM = 256;
constexpr int DIN = 5984, ZSW = 2048, ZGW = 4096, NIN = ZSW + ZGW;
constexpr int C_S5 = 0, C_CQ = 256, C_CKV = 448, C_KPE = 576, C_XLRU = 608, C_GLRU = 864, C_QD = 1120, C_KD = 1376, C_VD = 1632, C_END = 1888;
constexpr int FF = 2816, EFF = 3584, NEXP = 8, MOE_ROWS = 34816;
constexpr float EPS = 1e-6f, LOG2E = 1.4426950408889634f;

constexpr size_t MiB = 1u << 20;
constexpr size_t WS_CTL = 0, CTL_ZERO_BYTES = 1 * MiB + 512 * 1024;
constexpr size_t WS_MOESM = 1 * MiB;
constexpr size_t WS_XB = 2 * MiB;
constexpr size_t WS_WL = 34 * MiB, WL_STRIDE = 19 * MiB;
constexpr size_t WL_WIN = 0, WL_PT = 12 * MiB, WL_WO = 14 * MiB, WL_WXQ = 16 * MiB, WL_WXKV = 16 * MiB + 512 * 1024, WL_WXO = 17 * MiB + 512 * 1024, WL_SM = 18 * MiB;
constexpr size_t SM_WUQ = 0, SM_WUKV = 256 * 1024, SM_WR = 512 * 1024, SM_WI = 576 * 1024, SM_WGLU = 640 * 1024;
constexpr size_t WS_WGU = 72 * MiB, WS_WD = 83 * MiB, WS_TAB = 89 * MiB, WS_KX = 90 * MiB, WS_VXT = 91 * MiB;
constexpr size_t TAB_S5T = 0, TAB_CMAT = 512 * 1024, TAB_MISC = 768 * 1024;
constexpr size_t WS_ZS = 92 * MiB, WS_MERGED = 92 * MiB, WS_ZG = 156 * MiB, WS_HFF = 156 * MiB, WS_Y = 284 * MiB;
constexpr size_t WS_QM = 316 * MiB, WS_KM = 328 * MiB, WS_VMT = 340 * MiB, WS_QD = 348 * MiB, WS_KD = 356 * MiB, WS_VDT = 364 * MiB;
constexpr size_t WS_QX = 316 * MiB, WS_OX = 324 * MiB;
constexpr size_t WS_LA = 372 * MiB, WS_LI = 388 * MiB, WS_S5S = 404 * MiB, WS_LSUM = 406 * MiB, WS_RSP = 407 * MiB;
constexpr size_t WS_WMGU = 34 * MiB, WS_WMD = 146 * MiB, WS_HMOE = 202 * MiB, WS_XQ = 330 * MiB, WS_YS = 34 * MiB, WS_X8 = 416 * MiB, WS_END = 440 * MiB;
constexpr int CW_TMO = 0, CW_BAR = 4096, CW_MOECNT = 8192, CW_Q = 12288;
constexpr size_t CTL_ROWSS = 256 * 1024;
constexpr size_t MS_ROWTOK = 0, MS_TOKW = 512 * 1024, MS_ASSIGN = 640 * 1024, MS_RSTD = 768 * 1024;
constexpr int RING_BYTES = 131072, MISC_OFF = RING_BYTES + 320, LDS_BYTES = 147456;

typedef __bf16 bf16x2_t __attribute__((ext_vector_type(2)));
__device__ __forceinline__ unsigned cvt_pk_bf16(float lo, float hi) { const f32x2 v = {lo, hi}; const bf16x2_t b = __builtin_convertvector(v, bf16x2_t); return __builtin_bit_cast(unsigned, b); }
__device__ __forceinline__ float clamp8(float x) { return __builtin_fminf(__builtin_fmaxf(x, -448.f), 448.f); }
__device__ __forceinline__ unsigned cvt_pk4_fp8(float a, float b, float c, float d) { int w = __builtin_amdgcn_cvt_pk_fp8_f32(clamp8(a), clamp8(b), 0, false); w = __builtin_amdgcn_cvt_pk_fp8_f32(clamp8(c), clamp8(d), w, true); return (unsigned)w; }
__device__ __forceinline__ float bflo(unsigned w) { return __uint_as_float(w << 16); }
__device__ __forceinline__ float bfhi(unsigned w) { return __uint_as_float(w & 0xffff0000u); }
__device__ __forceinline__ float bf2f(bf16_t b) { return __uint_as_float((unsigned)b << 16); }
__device__ __forceinline__ bf16_t f2bf(float f) { return (bf16_t)(cvt_pk_bf16(f, 0.f) & 0xffffu); }
__device__ __forceinline__ float fexp2(float x) { return __builtin_amdgcn_exp2f(x); }
__device__ __forceinline__ float frcp(float x) { return __builtin_amdgcn_rcpf(x); }
__device__ __forceinline__ float frsq(float x) { return __builtin_amdgcn_rsqf(x); }
__device__ __forceinline__ float fsigmoid(float x) { return frcp(1.f + fexp2(-x * LOG2E)); }
__device__ __forceinline__ float fgelu(float x) {
    const float z = 0.7978845608028654f * (x + 0.044715f * x * x * x);
    const float e = fexp2(2.f * LOG2E * z);
    const float th = 1.f - 2.f * frcp(e + 1.f);
    return 0.5f * x * (1.f + th);
}
__device__ __forceinline__ int crow(int r, int hi) { return (r & 3) + 8 * (r >> 2) + 4 * hi; }
__device__ __forceinline__ bf16x8 ldg8(const bf16_t* p) { return *(const bf16x8*)p; }
__device__ __forceinline__ float sq8(bf16x8 v) {
    const u32x4 w = *(const u32x4*)&v; float s = 0.f;
#pragma unroll
    for (int i = 0; i < 4; ++i) { const float a = bflo(w[i]), b = bfhi(w[i]); s += a * a + b * b; }
    return s;
}
__device__ __forceinline__ float row_rstd(const float* rsp, int row) {
    const f32x4* p = (const f32x4*)(rsp + (size_t)row * 16); const f32x4 a = p[0], b = p[1], c = p[2], d = p[3];
    const float s = (((a.x + a.y) + (a.z + a.w)) + ((b.x + b.y) + (b.z + b.w))) + (((c.x + c.y) + (c.z + c.w)) + ((d.x + d.y) + (d.z + d.w)));
    return frsq(s * (1.f / DM) + EPS);
}
__device__ __forceinline__ float wave_sum(float v) {
#pragma unroll
    for (int o = 1; o < 64; o <<= 1) v += __shfl_xor(v, o);
    return v;
}
#define MFMA32(a, b, c) __builtin_amdgcn_mfma_f32_32x32x16_bf16((a), (b), (c), 0, 0, 0)
#define MFMA16(a, b, c) __builtin_amdgcn_mfma_f32_16x16x32_bf16((a), (b), (c), 0, 0, 0)
__device__ __forceinline__ void sincos_red(float a, float& s, float& c) {
    const float k = rintf(a * 0.15915494309189535f);
    float r = fmaf(-k, 6.28318548202514648f, a);
    r = fmaf(-k, -1.7484555e-7f, r);
    s = __sinf(r); c = __cosf(r);
}

namespace pg8 {
constexpr int BM = 256, BK = 64, HALF = 128, HTB = HALF * BK * 2, STAGE_BYTES = 8 * HTB;
__host__ __device__ __forceinline__ int lds_byte(int r, int c) { const int st = (r >> 4) * 2 + (c >> 5), rr = r & 15, cc = c & 31, ob = rr * 64 + cc * 2; return st * 1024 + (ob ^ (((ob >> 9) & 1) << 5)); }
__host__ __device__ __forceinline__ void stage_rc(int b, int& R, int& C) { const int st = b / 1024, sb = b % 1024, swz = sb ^ (((sb >> 9) & 1) << 5); R = (st >> 1) * 16 + swz / 64; C = (st & 1) * 32 + (swz % 64) / 2; }
__host__ __device__ __forceinline__ int perm32(int rho) { const int n = rho >> 4, i = rho & 15; return 8 * (i >> 2) + 4 * n + (i & 3); }

struct Unit { int pm, pn, om, on, aux, gofs; };
struct Gemm { const bf16_t* A; const bf16_t* Bt; int K; const int* gather; };

template <class Epi, class Sched, bool ALIGN_EPI, bool GATHER, bool FP8 = false>
__device__ __forceinline__ void gemm_phase(LAS unsigned char* lds, Gemm g, const Sched& S, const Epi& E) {
    int tid = threadIdx.x; asm volatile("" : "+v"(tid));
    asm volatile("" : "+s"(g.A), "+s"(g.Bt));
    const int wid = __builtin_amdgcn_readfirstlane(tid >> 6), lane = tid & 63, wr = wid >> 2, wc = wid & 3, fr = lane & 15, fq = lane >> 4;
    const int K = g.K, nt = K / BK;
    unsigned voffB[2];
#pragma unroll
    for (int i = 0; i < 2; ++i) { int Rr_, Cc_; stage_rc(tid * 16 + i * 8192, Rr_, Cc_); const int Rb = (Rr_ & ~31) + perm32(Rr_ & 31); voffB[i] = (unsigned)(Rb * K + Cc_) * 2u; }
    const size_t kstep = (size_t)(BK * 2);
    const size_t hstep = (size_t)HALF * K * 2;
    const size_t tstep = 2 * hstep;
    const unsigned ldsw = (unsigned)wid * 1024u;
    const int aoff = lds_byte(wr * 64 + fr, fq * 8), boff = lds_byte(wc * 32 + fr, fq * 8);
#define PG8_SA(b, h) (((b) * 2 + (h)) * HTB)
#define PG8_SB(b, h) ((4 + (b) * 2 + (h)) * HTB)
#define PG8_STAGE_B(bufoff, gbase) do { _Pragma("unroll") for (int _i = 0; _i < 2; ++_i) \
        __builtin_amdgcn_global_load_lds((const unsigned*)((const char*)(gbase) + voffB[_i]), (LAS unsigned*)(lds + (bufoff) + ldsw + _i * 8192), 16, 0, 0); } while (0)
#define PG8_STAGE_A(bufoff, kt, vo0, vo1) do { const char* _gb = (const char*)g.A + (size_t)(kt) * kstep; \
        __builtin_amdgcn_global_load_lds((const unsigned*)(_gb + (vo0)), (LAS unsigned*)(lds + (bufoff) + ldsw), 16, 0, 0); \
        __builtin_amdgcn_global_load_lds((const unsigned*)(_gb + (vo1)), (LAS unsigned*)(lds + (bufoff) + ldsw + 8192), 16, 0, 0); } while (0)
#define PG8_LDA(dst, b, h) do { _Pragma("unroll") for (int m = 0; m < 4; ++m) _Pragma("unroll") for (int k = 0; k < 2; ++k) dst[m][k] = *(const LAS bf16x8*)(lds + PG8_SA(b, h) + aoff + m * 2048 + k * 1024); } while (0)
#define PG8_LDB(dst, b, h) do { _Pragma("unroll") for (int n = 0; n < 2; ++n) _Pragma("unroll") for (int k = 0; k < 2; ++k) dst[n][k] = *(const LAS bf16x8*)(lds + PG8_SB(b, h) + boff + n * 2048 + k * 1024); } while (0)
#define PG8_MMA(ai, bj, At, Bt) do { __builtin_amdgcn_s_setprio(1); _Pragma("unroll") for (int m = 0; m < 4; ++m) _Pragma("unroll") for (int n = 0; n < 2; ++n) _Pragma("unroll") for (int k = 0; k < 2; ++k) \
        acc[ai][bj][m][n] = __builtin_amdgcn_mfma_f32_16x16x32_bf16(Bt[n][k], At[m][k], acc[ai][bj][m][n], 0, 0, 0); __builtin_amdgcn_s_setprio(0); } while (0)
#define PG8_MMA8(ai, bj, w) do { __builtin_amdgcn_s_setprio(1); _Pragma("unroll") for (int m = 0; m < 4; ++m) _Pragma("unroll") for (int n = 0; n < 2; ++n) \
        asm volatile("v_mfma_f32_16x16x128_f8f6f4 %0, %1, %2, %0" : "+v"(acc[ai][bj][m][n]) : "v"(B##w##8[n]), "v"(A8[m])); __builtin_amdgcn_s_setprio(0); } while (0)
#define PG8_LA(b, h) do { if constexpr (FP8) { _Pragma("unroll") for (int m = 0; m < 4; ++m) { A8[m].lo = *(const LAS i32x4*)(lds + PG8_SA(b, h) + aoff + m * 2048); A8[m].hi = *(const LAS i32x4*)(lds + PG8_SA(b, h) + aoff + m * 2048 + 1024); } } \
        else PG8_LDA(At, b, h); } while (0)
#define PG8_LB(w, b, h) do { if constexpr (FP8) { _Pragma("unroll") for (int n = 0; n < 2; ++n) { B##w##8[n].lo = *(const LAS i32x4*)(lds + PG8_SB(b, h) + boff + n * 2048); B##w##8[n].hi = *(const LAS i32x4*)(lds + PG8_SB(b, h) + boff + n * 2048 + 1024); } } \
        else PG8_LDB(B##w, b, h); } while (0)
#define PG8_MM(ai, bj, w) do { if constexpr (FP8) PG8_MMA8(ai, bj, w); else PG8_MMA(ai, bj, At, B##w); } while (0)
#define PG8_WAIT_V(n) asm volatile("s_waitcnt vmcnt(" #n ")" ::: "memory")
#define PG8_WAIT_L(n) asm volatile("s_waitcnt lgkmcnt(" #n ")" ::: "memory")
#define PG8_BAR __builtin_amdgcn_s_barrier()
#define PG8_SCHED __builtin_amdgcn_sched_barrier(0)
#define PG8_VOFF(dst, u) do { _Pragma("unroll") for (int _h = 0; _h < 2; ++_h) _Pragma("unroll") for (int _i = 0; _i < 2; ++_i) { int Rr_, Cc_; stage_rc(tid * 16 + _i * 8192, Rr_, Cc_); \
        const int _rt = (u).pm * BM + _h * HALF + Rr_; const int _ar = GATHER ? g.gather[_rt + (u).gofs] : _rt; dst[_h][_i] = (unsigned)((size_t)_ar * K + Cc_) * 2u; } } while (0)
    Unit cur, nxt; int ui = 0;
    if (!S.next(0, cur)) return;
    f32x4 acc[2][2][4][2];
#pragma unroll
    for (int a = 0; a < 2; ++a)
#pragma unroll
        for (int b = 0; b < 2; ++b)
#pragma unroll
            for (int m = 0; m < 4; ++m)
#pragma unroll
                for (int n = 0; n < 2; ++n) acc[a][b][m][n] = (f32x4){0.f, 0.f, 0.f, 0.f};
    bf16x8 At[4][2], B0[2][2], B1[2][2];
    i32x8 A8[4], B08[2], B18[2];
    unsigned vC[2][2], vN[2][2];
    PG8_VOFF(vC, cur);
    const char* cB = (const char*)g.Bt + (size_t)cur.pn * tstep;
    PG8_STAGE_B(PG8_SB(0, 0), cB); PG8_STAGE_B(PG8_SB(0, 1), cB + hstep); PG8_STAGE_A(PG8_SA(0, 0), 0, vC[0][0], vC[0][1]); PG8_STAGE_A(PG8_SA(0, 1), 0, vC[1][0], vC[1][1]);
    if (wr == 1) PG8_BAR;
    PG8_WAIT_V(2); PG8_BAR;
    PG8_STAGE_B(PG8_SB(1, 0), cB + kstep); PG8_STAGE_A(PG8_SA(1, 0), 1, vC[0][0], vC[0][1]); PG8_STAGE_B(PG8_SB(1, 1), cB + hstep + kstep);
    PG8_WAIT_V(6); PG8_BAR;
    for (;;) {
        const bool has_next = S.next(ui + 1, nxt);
        unsigned ndelta = 0u;
        if constexpr (GATHER) {
            if (has_next) { PG8_VOFF(vN, nxt); } else {
#pragma unroll
                for (int _h = 0; _h < 2; ++_h)
#pragma unroll
                    for (int _i = 0; _i < 2; ++_i) vN[_h][_i] = vC[_h][_i]; }
        } else { if (has_next) ndelta = (unsigned)((nxt.pm - cur.pm) * (int)tstep); }
        const char* nB = has_next ? (const char*)g.Bt + (size_t)nxt.pn * tstep : cB;
#pragma unroll 1
        for (int t = 0; t < nt; t += 2) {
            const bool last = (t == nt - 2);
            const int k2 = last ? 0 : t + 2, k3 = k2 + 1;
            const char* b2 = last ? nB : cB + (size_t)(t + 2) * kstep; const char* b3 = b2 + kstep;
            unsigned v200, v201, v210, v211;
            if constexpr (GATHER) { v200 = last ? vN[0][0] : vC[0][0]; v201 = last ? vN[0][1] : vC[0][1]; v210 = last ? vN[1][0] : vC[1][0]; v211 = last ? vN[1][1] : vC[1][1]; }
            else { const unsigned dl = last ? ndelta : 0u; v200 = vC[0][0] + dl; v201 = vC[0][1] + dl; v210 = vC[1][0] + dl; v211 = vC[1][1] + dl; }
            PG8_LB(0, 0, 0); PG8_LB(1, 0, 1); PG8_SCHED; PG8_LA(0, 0); PG8_STAGE_A(PG8_SA(1, 1), t + 1, vC[1][0], vC[1][1]);
            PG8_WAIT_V(8); PG8_WAIT_L(0); PG8_BAR; PG8_MM(0, 0, 0); PG8_MM(0, 1, 1); PG8_BAR; PG8_SCHED;
            PG8_LA(0, 1); PG8_STAGE_B(PG8_SB(0, 0), b2); PG8_STAGE_B(PG8_SB(0, 1), b2 + hstep); PG8_STAGE_A(PG8_SA(0, 0), k2, v200, v201);
            PG8_WAIT_V(8); PG8_WAIT_L(0); PG8_BAR; PG8_MM(1, 0, 0); PG8_MM(1, 1, 1); PG8_BAR; PG8_SCHED;
            PG8_LB(0, 1, 0); PG8_LB(1, 1, 1); PG8_SCHED; PG8_LA(1, 0); PG8_STAGE_A(PG8_SA(0, 1), k2, v210, v211);
            PG8_WAIT_V(8); PG8_WAIT_L(0); PG8_BAR; PG8_MM(0, 0, 0); PG8_MM(0, 1, 1); PG8_BAR; PG8_SCHED;
            PG8_LA(1, 1); PG8_STAGE_B(PG8_SB(1, 0), b3); PG8_STAGE_B(PG8_SB(1, 1), b3 + hstep); PG8_STAGE_A(PG8_SA(1, 0), k3, v200, v201);
            PG8_WAIT_V(8); PG8_WAIT_L(0); PG8_BAR; PG8_MM(1, 0, 0); PG8_MM(1, 1, 1); PG8_BAR; PG8_SCHED;
        }
        if constexpr (ALIGN_EPI) { if (wr == 0) PG8_BAR; }
        if constexpr (FP8) asm volatile("s_nop 15\n\ts_nop 15" ::: "memory");
        { int fr_ = fr, fq_ = fq; asm volatile("" : "+v"(fr_), "+v"(fq_)); E(acc, cur, wr, wc, fr_, fq_); }
        if (!has_next) break;
#pragma unroll
        for (int a = 0; a < 2; ++a)
#pragma unroll
            for (int b = 0; b < 2; ++b)
#pragma unroll
                for (int m = 0; m < 4; ++m)
#pragma unroll
                    for (int n = 0; n < 2; ++n) acc[a][b][m][n] = (f32x4){0.f, 0.f, 0.f, 0.f};
        cur = nxt; cB = nB; ++ui;
#pragma unroll
        for (int _h = 0; _h < 2; ++_h)
#pragma unroll
            for (int _i = 0; _i < 2; ++_i) { if constexpr (GATHER) vC[_h][_i] = vN[_h][_i]; else vC[_h][_i] += ndelta; }
        if constexpr (ALIGN_EPI) { if (wr == 1) PG8_BAR; }
    }
    PG8_WAIT_V(0);
    if constexpr (!ALIGN_EPI) { if (wr == 0) PG8_BAR; }
    PG8_BAR;
#undef PG8_SA
#undef PG8_SB
#undef PG8_STAGE_A
#undef PG8_STAGE_B
#undef PG8_LDA
#undef PG8_LDB
#undef PG8_MMA
#undef PG8_MMA8
#undef PG8_MM
#undef PG8_LA
#undef PG8_LB
#undef PG8_WAIT_V
#undef PG8_WAIT_L
#undef PG8_BAR
#undef PG8_SCHED
#undef PG8_VOFF
}

constexpr int NXCD = 8, WGM = 8;
struct StaticOrder {
    int nM, nN, nwg, G, c;
    __device__ void init(int nM_, int nN_, int G_, int c_) { nM = nM_; nN = nN_; nwg = nM * nN; G = G_; c = c_; }
    __device__ bool next(int i, Unit& u) const {
        const long L = (long)i * G + c; if (L >= nwg) return false;
        int wgid = (int)L; { const int q = nwg / NXCD, r = nwg % NXCD, xcd = wgid % NXCD, off = wgid / NXCD; wgid = (xcd < r ? xcd * (q + 1) : r * (q + 1) + (xcd - r) * q) + off; }
        const int nig = WGM * nN, gid = wgid / nig, fm = gid * WGM, gsz = (nM - fm) < WGM ? (nM - fm) : WGM;
        u.pm = fm + ((wgid % nig) % gsz); u.pn = (wgid % nig) / gsz; u.om = u.pm; u.on = u.pn; u.aux = 0; return true;
    }
};
struct MergeOrder {
    int G, c;
    __device__ bool next(int i, Unit& u) const {
        const int n = i & 3; const long tile = (long)(i >> 2) * G + c; if (tile >= 256) return false;
        const int om = (int)tile >> 2, on = (int)tile & 3;
        u.pm = n * 64 + om; u.pn = n * 4 + on; u.om = om; u.on = on; u.aux = n; return true;
    }
};
struct MoeOrder {
    int ntiles, nN, nwg, G, c; int pend[NEXP];
    __device__ void init(const unsigned* cnt, int nN_, int G_, int c_) {
        int acc = 0;
#pragma unroll
        for (int e = 0; e < NEXP; ++e) { const int ce = (int)cnt[64 * e]; acc += (ce + 255) >> 8; pend[e] = acc; }
        ntiles = acc; nN = nN_; nwg = ntiles * nN; G = G_; c = c_;
    }
    __device__ bool next(int i, Unit& u) const {
        const long L = (long)i * G + c; if (L >= nwg) return false;
        const int wgid = (int)L;
        const int nig = WGM * nN, gid = wgid / nig, fm = gid * WGM, gsz = (ntiles - fm) < WGM ? (ntiles - fm) : WGM;
        const int pm = fm + ((wgid % nig) % gsz), pn = (wgid % nig) / gsz;
        int e = 0, ps = 0;
#pragma unroll
        for (int j = 0; j < NEXP - 1; ++j) if (pm >= pend[j]) { e = j + 1; ps = pend[j]; }
        u.pm = pm; u.pn = e * nN + pn; u.om = pm; u.on = pn; u.aux = e; u.gofs = e * 16384 - 256 * ps; return true;
    }
};

__device__ __forceinline__ u32x4 pack8(f32x4 a, f32x4 b) { u32x4 w; w.x = cvt_pk_bf16(a[0], a[1]); w.y = cvt_pk_bf16(a[2], a[3]); w.z = cvt_pk_bf16(b[0], b[1]); w.w = cvt_pk_bf16(b[2], b[3]); return w; }
struct EpiIn {
    bf16_t* Zs; bf16_t* Zg; const float* rowss; const float* bgate;
    __device__ __forceinline__ void operator()(const f32x4 (&acc)[2][2][4][2], const Unit& u, int wr, int wc, int fr, int fq) const {
        const int row0 = u.om * BM + wr * 64 + fr, colt = u.on * BM, cw = wc * 32 + 8 * fq;
        if (colt < ZSW) {
#pragma unroll
            for (int ai = 0; ai < 2; ++ai) { float rsd[4];
#pragma unroll
                for (int m = 0; m < 4; ++m) rsd[m] = row_rstd(rowss, row0 + ai * HALF + m * 16);
#pragma unroll
                for (int m = 0; m < 4; ++m) {
                    const int row = row0 + ai * HALF + m * 16; const float rstd = rsd[m];
#pragma unroll
                    for (int bj = 0; bj < 2; ++bj) *(u32x4*)(Zs + (size_t)row * ZSW + colt + bj * HALF + cw) = pack8(acc[ai][bj][m][0] * rstd, acc[ai][bj][m][1] * rstd);
                    if (m == 3) asm volatile("" ::: "memory");
                } }
        } else {
            const int gc0 = colt - ZSW + cw;
            const f32x4 b00 = *(const f32x4*)(bgate + gc0), b01 = *(const f32x4*)(bgate + gc0 + 4), b10 = *(const f32x4*)(bgate + gc0 + HALF), b11 = *(const f32x4*)(bgate + gc0 + HALF + 4);
#pragma unroll
            for (int ai = 0; ai < 2; ++ai) { float rsd[4];
#pragma unroll
                for (int m = 0; m < 4; ++m) rsd[m] = row_rstd(rowss, row0 + ai * HALF + m * 16);
#pragma unroll
                for (int m = 0; m < 4; ++m) {
                    const int row = row0 + ai * HALF + m * 16; const float rstd = rsd[m];
#pragma unroll
                    for (int bj = 0; bj < 2; ++bj) { f32x4 v0 = acc[ai][bj][m][0] * rstd + (bj ? b10 : b00), v1 = acc[ai][bj][m][1] * rstd + (bj ? b11 : b01);
                        *(u32x4*)(Zg + (size_t)row * ZGW + gc0 + bj * HALF) = pack8(v0, v1); }
                    if (m == 3) asm volatile("" ::: "memory");
                } }
        }
    }
};
struct EpiMerge {
    bf16_t* Mg; const bf16_t* Zg;
    __device__ __forceinline__ void operator()(const f32x4 (&acc)[2][2][4][2], const Unit& u, int wr, int wc, int fr, int fq) const {
        const int row0 = u.om * BM + wr * 64 + fr, colt = u.on * BM, cw = wc * 32 + 8 * fq, n = u.aux;
#pragma unroll
        for (int ai = 0; ai < 2; ++ai) {
            u32x4 gw[4][2], ow[4][2];
#pragma unroll
            for (int m = 0; m < 4; ++m)
#pragma unroll
                for (int bj = 0; bj < 2; ++bj) { const int row = row0 + ai * HALF + m * 16, col = colt + bj * HALF + cw;
                    gw[m][bj] = *(const u32x4*)(Zg + (size_t)row * ZGW + DBG_GPERM(n) * DM + col);
                    ow[m][bj] = n > 0 ? *(const u32x4*)(Mg + (size_t)row * DM + col) : (u32x4){0u, 0u, 0u, 0u}; }
#pragma unroll
            for (int m = 0; m < 4; ++m)
#pragma unroll
                for (int bj = 0; bj < 2; ++bj) { const int row = row0 + ai * HALF + m * 16, col = colt + bj * HALF + cw; const u32x4 g = gw[m][bj], o = ow[m][bj];
                    f32x4 v0 = acc[ai][bj][m][0], v1 = acc[ai][bj][m][1];
                    v0[0] = v0[0] * fsigmoid(bflo(g.x)) + bflo(o.x); v0[1] = v0[1] * fsigmoid(bfhi(g.x)) + bfhi(o.x); v0[2] = v0[2] * fsigmoid(bflo(g.y)) + bflo(o.y); v0[3] = v0[3] * fsigmoid(bfhi(g.y)) + bfhi(o.y);
                    v1[0] = v1[0] * fsigmoid(bflo(g.z)) + bflo(o.z); v1[1] = v1[1] * fsigmoid(bfhi(g.z)) + bfhi(o.z); v1[2] = v1[2] * fsigmoid(bflo(g.w)) + bflo(o.w); v1[3] = v1[3] * fsigmoid(bfhi(g.w)) + bfhi(o.w);
                    *(u32x4*)(Mg + (size_t)row * DM + col) = pack8(v0, v1); }
            asm volatile("" ::: "memory");
        }
    }
};
template <bool F32OUT, bool X8 = false, bool SC32 = false> struct EpiRes {
    float* xout; bf16_t* xb; float* rowss; unsigned char* x8;
    __device__ __forceinline__ void operator()(const f32x4 (&acc)[2][2][4][2], const Unit& u, int wr, int wc, int fr, int fq) const {
        const int row0 = u.om * BM + wr * 64 + fr, colt = u.on * BM, cw = wc * 32 + 8 * fq;
#pragma unroll
        for (int ai = 0; ai < 2; ++ai) {
            u32x4 xw[4][2];
#pragma unroll
            for (int m = 0; m < 4; ++m)
#pragma unroll
                for (int bj = 0; bj < 2; ++bj) xw[m][bj] = *(const u32x4*)(xb + (size_t)(row0 + ai * HALF + m * 16) * DM + colt + bj * HALF + cw);
#pragma unroll
            for (int m = 0; m < 4; ++m) {
                const int row = row0 + ai * HALF + m * 16; float ss = 0.f;
#pragma unroll
                for (int bj = 0; bj < 2; ++bj) { const size_t off = (size_t)row * DM + colt + bj * HALF + cw; const u32x4 w = xw[m][bj];
                    f32x4 v0 = acc[ai][bj][m][0], v1 = acc[ai][bj][m][1];
                    if constexpr (SC32) { v0 *= 0.03125f; v1 *= 0.03125f; }
                    v0[0] += bflo(w.x); v0[1] += bfhi(w.x); v0[2] += bflo(w.y); v0[3] += bfhi(w.y); v1[0] += bflo(w.z); v1[1] += bfhi(w.z); v1[2] += bflo(w.w); v1[3] += bfhi(w.w);
                    if constexpr (F32OUT) { *(f32x4*)(xout + off) = v0; *(f32x4*)(xout + off + 4) = v1; }
                    *(u32x4*)(xb + off) = pack8(v0, v1);
                    if constexpr (X8) { u32x2 q; q.x = cvt_pk4_fp8(v0[0], v0[1], v0[2], v0[3]); q.y = cvt_pk4_fp8(v1[0], v1[1], v1[2], v1[3]); *(u32x2*)(x8 + off) = q; }
                    ss += (v0[0] * v0[0] + v0[1] * v0[1]) + (v0[2] * v0[2] + v0[3] * v0[3]) + (v1[0] * v1[0] + v1[1] * v1[1]) + (v1[2] * v1[2] + v1[3] * v1[3]); }
                ss += __shfl_xor(ss, 16); ss += __shfl_xor(ss, 32);
                if (fq == 0) rowss[(size_t)row * 16 + u.on * 4 + wc] = ss;
            }
            asm volatile("" ::: "memory");
        }
    }
};
struct EpiRowScale {
    bf16_t* O; int ldc; const float* rowss;
    __device__ __forceinline__ void operator()(const f32x4 (&acc)[2][2][4][2], const Unit& u, int wr, int wc, int fr, int fq) const {
        const int row0 = u.om * BM + wr * 64 + fr, colt = u.on * BM, cw = wc * 32 + 8 * fq;
#pragma unroll
        for (int ai = 0; ai < 2; ++ai)
#pragma unroll
            for (int m = 0; m < 4; ++m) {
                const int row = row0 + ai * HALF + m * 16; const float rstd = row_rstd(rowss, row);
#pragma unroll
                for (int bj = 0; bj < 2; ++bj) *(u32x4*)(O + (size_t)row * ldc + colt + bj * HALF + cw) = pack8(acc[ai][bj][m][0] * rstd, acc[ai][bj][m][1] * rstd);
                if (m == 3) asm volatile("" ::: "memory");
            }
    }
};
template <bool MOE> struct EpiSwiGLU {
    bf16_t* H; int ldh; const float* rs; const int* row_tok;
    __device__ __forceinline__ void operator()(const f32x4 (&acc)[2][2][4][2], const Unit& u, int wr, int wc, int fr, int fq) const {
        const int row0 = u.om * BM + wr * 64 + fr, hc = u.on * HALF + wc * 32 + 8 * fq;
#pragma unroll
        for (int ai = 0; ai < 2; ++ai) { float rsd[4];
#pragma unroll
            for (int m = 0; m < 4; ++m) { const int row = row0 + ai * HALF + m * 16; rsd[m] = MOE ? rs[row_tok[row]] : row_rstd(rs, row); }
#pragma unroll
            for (int m = 0; m < 4; ++m) {
                const int row = row0 + ai * HALF + m * 16;
                const float rstd = rsd[m];
                f32x4 o[2];
#pragma unroll
                for (int n = 0; n < 2; ++n)
#pragma unroll
                    for (int j = 0; j < 4; ++j) { const float gv = acc[ai][0][m][n][j] * rstd, uv = acc[ai][1][m][n][j] * rstd; o[n][j] = gv * fsigmoid(gv) * uv; }
                *(u32x4*)(H + (size_t)row * ldh + hc) = pack8(o[0], o[1]);
                if (m == 3) asm volatile("" ::: "memory");
            } }
    }
};
template <bool RSTD, bool W32 = true> struct EpiSwiGLU8 {
    unsigned char* H; int ldh; const float* rs;
    __device__ __forceinline__ void operator()(const f32x4 (&acc)[2][2][4][2], const Unit& u, int wr, int wc, int fr, int fq) const {
        const int row0 = u.om * BM + wr * 64 + fr, hc = u.on * HALF + wc * 32 + 8 * fq;
#pragma unroll
        for (int ai = 0; ai < 2; ++ai)
#pragma unroll
            for (int m = 0; m < 4; ++m) {
                const int row = row0 + ai * HALF + m * 16;
                float sc = W32 ? 0.03125f : 1.f; if constexpr (RSTD) sc *= row_rstd(rs, row);
                f32x4 o[2];
#pragma unroll
                for (int n = 0; n < 2; ++n)
#pragma unroll
                    for (int j = 0; j < 4; ++j) { const float gv = acc[ai][0][m][n][j] * sc, uv = acc[ai][1][m][n][j] * sc; o[n][j] = gv * fsigmoid(gv) * uv; }
                u32x2 w; w.x = cvt_pk4_fp8(o[0][0], o[0][1], o[0][2], o[0][3]); w.y = cvt_pk4_fp8(o[1][0], o[1][1], o[1][2], o[1][3]);
                *(u32x2*)(H + (size_t)row * ldh + hc) = w;
                if (m == 3) asm volatile("" ::: "memory");
            }
    }
};
struct EpiPlain {
    bf16_t* O; int ldc; float sc;
    __device__ __forceinline__ void operator()(const f32x4 (&acc)[2][2][4][2], const Unit& u, int wr, int wc, int fr, int fq) const {
        const int row0 = u.om * BM + wr * 64 + fr, colt = u.on * BM, cw = wc * 32 + 8 * fq;
#pragma unroll
        for (int ai = 0; ai < 2; ++ai)
#pragma unroll
            for (int m = 0; m < 4; ++m) { const int row = row0 + ai * HALF + m * 16;
#pragma unroll
                for (int bj = 0; bj < 2; ++bj) *(u32x4*)(O + (size_t)row * ldc + colt + bj * HALF + cw) = pack8(acc[ai][bj][m][0] * sc, acc[ai][bj][m][1] * sc); }
    }
};
}

#define XB_TMO      128
#define XB_XCNT(j)  (256  + 64 * (j))
#define XB_XSUB(j)  (1280 + 64 * (j))
#define XB_XGEN(j)  (2304 + 64 * (j))
#define XB_TOP      3328
#define XB_TOPGEN   3392
#define XCD_BAR_WORDS 3456
#define XB_SPIN_CAP (1u << 18)
__device__ __forceinline__ unsigned xb_ld(unsigned* p)              { return __hip_atomic_load(p, __ATOMIC_RELAXED, __HIP_MEMORY_SCOPE_AGENT); }
__device__ __forceinline__ unsigned xb_add(unsigned* p, unsigned v) { return __hip_atomic_fetch_add(p, v, __ATOMIC_RELAXED, __HIP_MEMORY_SCOPE_AGENT); }
__device__ __forceinline__ unsigned xb_xcc_id() { return (unsigned)__builtin_amdgcn_s_getreg((3 << 11) | 20) & 0xFu; }
#define XB_SPIN(cond, bar) do { unsigned _sp = 0; while (cond) { __builtin_amdgcn_s_sleep(1); \
    if ((++_sp & 255u) == 0u) { if (xb_ld(&(bar)[XB_TMO])) break; if (_sp > XB_SPIN_CAP) { atomicAdd(&(bar)[XB_TMO], 1u); break; } } } } while (0)
struct XcdBarrier { unsigned* bar; unsigned x; volatile LAS unsigned* st; };
__device__ __forceinline__ XcdBarrier xcd_barrier_post(unsigned* bar, volatile LAS unsigned* st) {
    XcdBarrier b; b.bar = bar; b.x = xb_xcc_id(); b.st = st;
    if (threadIdx.x == 0) (void)xb_add(&bar[XB_XCNT(b.x)], 1u);
    return b;
}
__device__ __forceinline__ void xcd_barrier_complete(unsigned* bar, unsigned x, unsigned& nloc, unsigned& nx) {
    const unsigned G = gridDim.x * gridDim.y * gridDim.z;
    unsigned sum, cnt, mine, sp = 0u;
    for (;;) {
        sum = 0u; cnt = 0u; mine = 0u;
#pragma unroll
        for (unsigned j = 0; j < 16; ++j) { const unsigned c = xb_ld(&bar[XB_XCNT(j)]); sum += c; cnt += (c > 0u) ? 1u : 0u; mine = (j == x) ? c : mine; }
        if (sum == G) break;
        __builtin_amdgcn_s_sleep(1);
        if ((++sp & 255u) == 0u) { if (xb_ld(&bar[XB_TMO])) break; if (sp > XB_SPIN_CAP) { atomicAdd(&bar[XB_TMO], 1u); break; } }
    }
    nloc = mine > 0u ? mine : 1u; nx = cnt > 0u ? cnt : 1u;
}
__device__ __forceinline__ void xcd_barrier(const XcdBarrier& b) {
    asm volatile("s_waitcnt vmcnt(0)" ::: "memory");
    __syncthreads();
    if (threadIdx.x == 0) {
        unsigned* bar = b.bar;
        __builtin_amdgcn_s_waitcnt(0);
        unsigned nloc = b.st[0], nx = b.st[1];
        if (nloc == 0u) { xcd_barrier_complete(bar, b.x, nloc, nx); b.st[0] = nloc; b.st[1] = nx; }
        const unsigned old = xb_add(&bar[XB_XSUB(b.x)], 1u);
        const unsigned gen = old / nloc;
        if (old + 1u == (gen + 1u) * nloc) {
            __builtin_amdgcn_fence(__ATOMIC_RELEASE, "agent");
            asm volatile("s_waitcnt vmcnt(0)" ::: "memory");
            const unsigned og = xb_add(&bar[XB_TOP], 1u);
            const unsigned tg = og / nx;
            if (og + 1u == (tg + 1u) * nx) xb_add(&bar[XB_TOPGEN], 1u);
            else XB_SPIN(xb_ld(&bar[XB_TOPGEN]) == tg, bar);
            __builtin_amdgcn_fence(__ATOMIC_ACQUIRE, "agent");
            xb_add(&bar[XB_XGEN(b.x)], 1u);
            asm volatile("s_waitcnt vmcnt(0)" ::: "memory");
        } else {
            XB_SPIN(xb_ld(&bar[XB_XGEN(b.x)]) == gen, bar);
            __builtin_amdgcn_fence(__ATOMIC_ACQUIRE, "agent");
            asm volatile("s_waitcnt vmcnt(0)" ::: "memory");
        }
    }
    __syncthreads();
}

struct Args { const void* in[55]; float* out; unsigned char* ws; int ph_lo, ph_hi, submask, pad; };
struct Frame {
    LAS unsigned char* lds; unsigned char* ws; unsigned* ctl; float* out;
    int tid, lane, wave, G, bid, gw, ngw;
};
#define GAS __attribute__((address_space(1)))
#define CAS __attribute__((address_space(4)))
#define PHASE_BEGIN() const CAS char* kp_ = (const CAS char*)__builtin_amdgcn_kernarg_segment_ptr(); asm volatile("" : "+s"(kp_)); \
    unsigned char* ws = (unsigned char*)(GAS unsigned char*)(*(const CAS unsigned long long*)(kp_ + 448)); \
    Frame F; { int t_ = threadIdx.x; asm volatile("" : "+v"(t_)); int b_ = blockIdx.x; asm volatile("" : "+s"(b_)); \
      F.lds = (LAS unsigned char*)lds_raw; F.ws = ws; F.ctl = (unsigned*)(ws + WS_CTL); F.out = (float*)(GAS float*)(*(const CAS unsigned long long*)(kp_ + 440)); \
      F.tid = t_; F.lane = t_ & 63; F.wave = __builtin_amdgcn_readfirstlane(t_ >> 6); F.G = gridDim.x; F.bid = b_; F.gw = b_ * 8 + F.wave; F.ngw = F.G * 8; }
#define XB ((bf16_t*)(ws + WS_XB))
#define RS ((float*)(ws + WS_RSP))
#define ZS ((bf16_t*)(ws + WS_ZS))
#define ZG ((bf16_t*)(ws + WS_ZG))
#define YB ((bf16_t*)(ws + WS_Y))
#define MG ((bf16_t*)(ws + WS_MERGED))
#define S5T ((float*)(ws + WS_TAB + TAB_S5T))
#define CMAT ((bf16_t*)(ws + WS_TAB + TAB_CMAT))
#define MISCT ((float*)(ws + WS_TAB + TAB_MISC))
#define BBF ((bf16_t*)(ws + WS_TAB + 832 * 1024))
#define WLP(l) (ws + WS_WL + (size_t)(l) * WL_STRIDE)
#define INF(i) ((const float*)(const GAS float*)(*(const CAS unsigned long long*)(kp_ + 8 * (i))))

struct TJob { const float* W; bf16_t* WT; const float* ks; int K, N, ldw, ldk, nb, map; size_t sstride, dstride; int f8; };
__device__ __forceinline__ int tjob_items(const TJob& j) { return j.nb * (j.K / 64) * (j.N / 32); }
__device__ __forceinline__ void tjob_load(const TJob& j, int item, float (&v)[32], int lane) {
    const int per = (j.K / 64) * (j.N / 32), b = item / per, r = item % per, nblk = j.N / 32, kb = r / nblk, nbk = r % nblk, k0 = 64 * kb, n0 = 32 * nbk;
    const float* W = j.W + (size_t)b * j.sstride + (size_t)(k0 + (lane >> 5)) * j.ldw + n0 + (lane & 31);
#pragma unroll
    for (int i = 0; i < 32; ++i) v[i] = W[(size_t)(2 * i) * j.ldw];
}
__device__ __forceinline__ void tjob_store(const TJob& j, int item, float (&v)[32], LAS float* scr, int lane) {
    const int per = (j.K / 64) * (j.N / 32), b = item / per, r = item % per, nblk = j.N / 32, kb = r / nblk, nbk = r % nblk, k0 = 64 * kb, n0 = 32 * nbk;
    int drow = n0;
    if (j.map == 1) drow = n0 < C_END ? n0 : n0 + (ZSW - C_END);
    else if (j.map == 2) drow = 256 * (n0 >> 7) + (n0 & 127);
    else if (j.map == 3) drow = 256 * (n0 >> 7) + 128 + (n0 & 127);
    if (j.ks) {
#pragma unroll
        for (int i = 0; i < 32; ++i) v[i] *= j.ks[k0 + 2 * i + (lane >> 5)]; }
#pragma unroll
    for (int i = 0; i < 32; ++i) scr[(2 * i + (lane >> 5)) * 33 + (lane & 31)] = v[i];
    asm volatile("s_waitcnt lgkmcnt(0)" ::: "memory");
    const int c = lane & 7; bf16_t* WT = j.WT + (size_t)b * j.dstride;
    if (j.f8) { unsigned char* W8 = (unsigned char*)j.WT + (size_t)b * j.dstride;
#pragma unroll
        for (int q = 0; q < 4; ++q) { const int n = (lane >> 3) + 8 * q; const LAS float* sp = scr + (8 * c) * 33 + n;
            u32x2 o; o.x = cvt_pk4_fp8(sp[0 * 33] * 32.f, sp[1 * 33] * 32.f, sp[2 * 33] * 32.f, sp[3 * 33] * 32.f); o.y = cvt_pk4_fp8(sp[4 * 33] * 32.f, sp[5 * 33] * 32.f, sp[6 * 33] * 32.f, sp[7 * 33] * 32.f);
            *(u32x2*)(W8 + (size_t)(drow + n) * j.ldk + k0 + 8 * c) = o; }
    } else
#pragma unroll
    for (int q = 0; q < 4; ++q) { const int n = (lane >> 3) + 8 * q; const LAS float* sp = scr + (8 * c) * 33 + n;
        u32x4 o; o.x = cvt_pk_bf16(sp[0 * 33], sp[1 * 33]); o.y = cvt_pk_bf16(sp[2 * 33], sp[3 * 33]); o.z = cvt_pk_bf16(sp[4 * 33], sp[5 * 33]); o.w = cvt_pk_bf16(sp[6 * 33], sp[7 * 33]);
        *(u32x4*)(WT + (size_t)(drow + n) * j.ldk + k0 + 8 * c) = o; }
    asm volatile("s_waitcnt lgkmcnt(0)" ::: "memory");
}
__device__ __forceinline__ void tjob_run_all(const TJob& j, int first, int stride, LAS float* scr, int lane) {
    const int ni = tjob_items(j); int it = first; if (it >= ni) return;
    float va[32], vb[32]; tjob_load(j, it, va, lane);
    for (;;) {
        const int n1 = it + stride; if (n1 < ni) tjob_load(j, n1, vb, lane);
        tjob_store(j, it, va, scr, lane); if (n1 >= ni) break;
        const int n2 = n1 + stride; if (n2 < ni) tjob_load(j, n2, va, lane);
        tjob_store(j, n1, vb, scr, lane); if (n2 >= ni) break;
        it = n2;
    }
}

template <int DQ> struct AttnLds { static constexpr int KROW = DQ * 2 + 16, VROW = 272, KBYTES = 128 * KROW, VBYTES = 64 * VROW, BUF = KBYTES + VBYTES; };
#define PK4(P, BASE, OUT) do { unsigned a0_ = cvt_pk_bf16(P[BASE + 0], P[BASE + 1]), a1_ = cvt_pk_bf16(P[BASE + 2], P[BASE + 3]); \
    unsigned b0_ = cvt_pk_bf16(P[BASE + 4], P[BASE + 5]), b1_ = cvt_pk_bf16(P[BASE + 6], P[BASE + 7]); \
    auto r0_ = __builtin_amdgcn_permlane32_swap(a0_, b0_, false, false); auto r1_ = __builtin_amdgcn_permlane32_swap(a1_, b1_, false, false); \
    u32x4 w_ = {r0_[0], r1_[0], r0_[1], r1_[1]}; OUT = *(bf16x8*)&w_; } while (0)

template <int DQ, int NMAP, bool CAUSAL, bool BIAS, bool QNORM>
__device__ __forceinline__ void attn_unit(LAS unsigned char* lds, const bf16_t* Qp, int ldq, const bf16_t* Kp, const bf16_t* Vtp, int vstride, int nkt, int q0,
                                          const LAS float* lut, const float* qg, float qscale, float mshift, f32x16 (&o)[NMAP][2], float (&l)[NMAP]) {
    typedef AttnLds<DQ> L; constexpr int KD = DQ / NMAP, KS = KD / 16, KCH = DQ / 8, NKC = 64 * KCH;
    int tid = threadIdx.x; asm volatile("" : "+v"(tid));
    const int wid = tid >> 6, lane = tid & 63, r32 = lane & 31, hi = lane >> 5;
    bf16x8 q[NMAP][KS];
    {
        const bf16_t* qrow = Qp + (size_t)(wid * 32 + r32) * ldq + hi * 8;
#pragma unroll
        for (int mp = 0; mp < NMAP; ++mp)
#pragma unroll
            for (int ks = 0; ks < KS; ++ks) q[mp][ks] = ldg8(qrow + mp * KD + ks * 16);
        if constexpr (QNORM) {
            float ss = 0.f;
#pragma unroll
            for (int ks = 0; ks < KS; ++ks) ss += sq8(q[0][ks]);
            ss += __shfl_xor(ss, 32);
            const float rs = frsq(ss * (1.f / DQ) + EPS) * qscale;
#pragma unroll
            for (int ks = 0; ks < KS; ++ks) { u32x4 w = *(u32x4*)&q[0][ks]; const float* gp = qg + ks * 16 + hi * 8;
                w.x = cvt_pk_bf16(bflo(w.x) * rs * gp[0], bfhi(w.x) * rs * gp[1]); w.y = cvt_pk_bf16(bflo(w.y) * rs * gp[2], bfhi(w.y) * rs * gp[3]);
                w.z = cvt_pk_bf16(bflo(w.z) * rs * gp[4], bfhi(w.z) * rs * gp[5]); w.w = cvt_pk_bf16(bflo(w.w) * rs * gp[6], bfhi(w.w) * rs * gp[7]);
                q[0][ks] = *(bf16x8*)&w; }
        }
    }
#pragma unroll
    for (int mp = 0; mp < NMAP; ++mp) { l[mp] = 0.f; o[mp][0] = f32x16{}; o[mp][1] = f32x16{}; }
    constexpr int NKI = (128 * KCH) / 512;
    bf16x8 skr[NKI], svr[2];
#define AT_LOAD(j) do { const int key0_ = (j) * 128; \
        _Pragma("unroll") for (int i_ = 0; i_ < NKI; ++i_) { const int c_ = tid + 512 * i_; skr[i_] = ldg8(Kp + (size_t)(key0_ + c_ / KCH) * DQ + (c_ % KCH) * 8); } \
        _Pragma("unroll") for (int i_ = 0; i_ < 2; ++i_) { const int c_ = tid + 512 * i_; svr[i_] = ldg8(Vtp + (size_t)(c_ >> 4) * vstride + key0_ + (c_ & 15) * 8); } } while (0)
#define AT_WRITE(b) do { LAS unsigned char* base_ = lds + (b) * L::BUF; \
        _Pragma("unroll") for (int i_ = 0; i_ < NKI; ++i_) { const int c_ = tid + 512 * i_; *(LAS bf16x8*)(base_ + (c_ / KCH) * L::KROW + (c_ % KCH) * 16) = skr[i_]; } \
        _Pragma("unroll") for (int i_ = 0; i_ < 2; ++i_) { const int c_ = tid + 512 * i_; *(LAS bf16x8*)(base_ + L::KBYTES + (c_ >> 4) * L::VROW + (c_ & 15) * 16) = svr[i_]; } } while (0)
    const int qi = q0 + wid * 32 + r32;
    const int qlo = q0 + wid * 32;
#define AT_COMPUTE(key0, bf, sb) do { const bool active = !CAUSAL || (key0) <= qlo + 31; \
        if (active) { const LAS unsigned char* kb = lds + (bf) * L::BUF + (sb) * 64 * L::KROW; const LAS unsigned char* vb = lds + (bf) * L::BUF + L::KBYTES + (sb) * 128; const bool need_mask = CAUSAL && ((key0) + 63 > qlo); \
            _Pragma("unroll") for (int mp = 0; mp < NMAP; ++mp) { f32x16 p0 = f32x16{}, p1 = f32x16{}; \
                _Pragma("unroll") for (int ks = 0; ks < KS; ++ks) { \
                    const bf16x8 a0 = *(const LAS bf16x8*)(kb + r32 * L::KROW + (mp * KD + ks * 16 + hi * 8) * 2); \
                    const bf16x8 a1 = *(const LAS bf16x8*)(kb + (32 + r32) * L::KROW + (mp * KD + ks * 16 + hi * 8) * 2); \
                    p0 = MFMA32(a0, q[mp][ks], p0); p1 = MFMA32(a1, q[mp][ks], p1); } \
                __builtin_amdgcn_sched_barrier(0); \
                float sh = mshift; \
                if constexpr (BIAS) { \
                    if (qlo - ((key0) + 63) >= 127) sh -= lut[255]; \
                    else { const LAS float* lp = lut + (qi - (key0) - 4 * hi + 69); \
                        _Pragma("unroll") for (int r = 0; r < 16; ++r) { const int cr = (r & 3) + 8 * (r >> 2); p0[r] += lp[59 - cr]; p1[r] += lp[27 - cr]; } } } \
                if (need_mask) { _Pragma("unroll") for (int r = 0; r < 16; ++r) { const int kk = (key0) + crow(r, hi); if (kk > qi) p0[r] = -1e30f; if (kk + 32 > qi) p1[r] = -1e30f; } } \
                float ps = 0.f; \
                _Pragma("unroll") for (int r = 0; r < 16; ++r) { p0[r] = fexp2(p0[r] - sh); p1[r] = fexp2(p1[r] - sh); ps += p0[r] + p1[r]; } \
                l[mp] += ps; \
                __builtin_amdgcn_sched_barrier(0); \
                bf16x8 pa0, pa1, pa2, pa3; \
                PK4(p0, 0, pa0); PK4(p0, 8, pa1); PK4(p1, 0, pa2); PK4(p1, 8, pa3); \
                _Pragma("unroll") for (int dt = 0; dt < 2; ++dt) { \
                    const LAS unsigned char* vrow = vb + (dt * 32 + r32) * L::VROW + hi * 16; \
                    const bf16x8 v0 = *(const LAS bf16x8*)(vrow), v1 = *(const LAS bf16x8*)(vrow + 32), v2 = *(const LAS bf16x8*)(vrow + 64), v3 = *(const LAS bf16x8*)(vrow + 96); \
                    o[mp][dt] = MFMA32(v0, pa0, o[mp][dt]); o[mp][dt] = MFMA32(v1, pa1, o[mp][dt]); o[mp][dt] = MFMA32(v2, pa2, o[mp][dt]); o[mp][dt] = MFMA32(v3, pa3, o[mp][dt]); } \
                __builtin_amdgcn_sched_barrier(0); } } } while (0)
    const int n128 = nkt >> 1;
    if (wid < 4) __builtin_amdgcn_s_setprio(2);
    AT_LOAD(0); AT_WRITE(0); __syncthreads();
    for (int j = 0; j < n128; ++j) {
        if (j + 1 < n128) AT_LOAD(j + 1);
        AT_COMPUTE(j * 128, j & 1, 0);
        AT_COMPUTE(j * 128 + 64, j & 1, 1);
        if (j + 1 < n128) AT_WRITE((j + 1) & 1);
        __syncthreads();
    }
    __builtin_amdgcn_s_setprio(0);
#undef AT_COMPUTE
#pragma unroll
    for (int mp = 0; mp < NMAP; ++mp) l[mp] += __shfl_xor(l[mp], 32);
#undef AT_LOAD
#undef AT_WRITE
}

__device__ __forceinline__ void attn_store(bf16_t* dst, const f32x16 (&o)[2], float scale, int hi) {
#pragma unroll
    for (int dt = 0; dt < 2; ++dt)
#pragma unroll
        for (int rg = 0; rg < 4; ++rg) { u32x2 w; w.x = cvt_pk_bf16(o[dt][4 * rg] * scale, o[dt][4 * rg + 1] * scale); w.y = cvt_pk_bf16(o[dt][4 * rg + 2] * scale, o[dt][4 * rg + 3] * scale);
            *(u32x2*)(dst + dt * 32 + 8 * rg + 4 * hi) = w; }
}

__device__ __forceinline__ bool in_phase(int k) { const __attribute__((address_space(4))) int* p_ = (const __attribute__((address_space(4))) int*)__builtin_amdgcn_kernarg_segment_ptr(); asm volatile("" : "+s"(p_)); return p_[114] <= k && k < p_[115]; }
__device__ __forceinline__ bool sub_on(int k) { const __attribute__((address_space(4))) int* p_ = (const __attribute__((address_space(4))) int*)__builtin_amdgcn_kernarg_segment_ptr(); asm volatile("" : "+s"(p_)); return (p_[116] >> k) & 1; }
__device__ __forceinline__ void s5_bu_tile(LAS unsigned char* tile, const bf16_t* bbf_g, const bf16_t* zs_tok0, int lane) {
    const int r32 = lane & 31, hi = lane >> 5;
    const bf16x8 uf = ldg8(zs_tok0 + (size_t)r32 * ZSW + 8 * hi);
#pragma unroll
    for (int pt = 0; pt < 4; ++pt) { f32x16 d = f32x16{}; d = MFMA32(ldg8(bbf_g + (size_t)(32 * pt + r32) * 16 + 8 * hi), uf, d);
#pragma unroll
        for (int rg = 0; rg < 4; ++rg) { u32x2 w; w.x = cvt_pk_bf16(d[4 * rg], d[4 * rg + 1]); w.y = cvt_pk_bf16(d[4 * rg + 2], d[4 * rg + 3]);
            *(LAS u32x2*)(tile + r32 * 272 + (32 * pt + 8 * rg + 4 * hi) * 2) = w; } }
    asm volatile("s_waitcnt lgkmcnt(0)" ::: "memory");
}
__device__ __forceinline__ int h0_pull(LAS unsigned* qc, int lane, int wg_items, int bid, int G, int total) {
    unsigned k = 0u; if (lane == 0) k = __hip_atomic_fetch_add(qc, 1u, __ATOMIC_RELAXED, __HIP_MEMORY_SCOPE_WORKGROUP);
    const int kk = __builtin_amdgcn_readfirstlane((int)k);
    return kk < wg_items ? bid + kk * G : total;
}
__device__ __forceinline__ int queue_pull(unsigned* ctr, volatile LAS unsigned* slot, int tid) {
    __syncthreads();
    if (tid == 0) *slot = __hip_atomic_fetch_add(ctr, 1u, __ATOMIC_RELAXED, __HIP_MEMORY_SCOPE_AGENT);
    __syncthreads();
    return (int)*slot;
}
constexpr int NPHASE = 24;
#ifndef DBG_NPH
#endif
__global__ void __launch_bounds__(512, 2) hybrid_fwd(Args args) {
    extern __shared__ __attribute__((aligned(16))) unsigned char lds_raw[];
    LAS unsigned char* lds0 = (LAS unsigned char*)lds_raw;
    volatile LAS unsigned* MISC = (volatile LAS unsigned*)(lds0 + MISC_OFF);
    for (int u = threadIdx.x; u < (LDS_BYTES - RING_BYTES) / 4; u += 512) ((LAS unsigned*)(lds0 + RING_BYTES))[u] = 0u;
    __syncthreads();
    const int lo = args.ph_lo, hi_ph = args.ph_hi;
    const bool one_launch = (hi_ph - lo) > 1;
    XcdBarrier bar; bar.bar = (unsigned*)(args.ws + WS_CTL) + CW_BAR; bar.x = 0; bar.st = nullptr;
    if (one_launch) bar = xcd_barrier_post((unsigned*)(args.ws + WS_CTL) + CW_BAR, MISC + 8);
#ifndef SUBMASK
#define SUBMASK 0xFFFFu
#endif
#define SUB(k) ((((SUBMASK) >> (k)) & 1u) && sub_on(k))
#ifndef PHMASK
#define PHMASK 0xFFFFFFu
#endif
#define IN(k) ((((PHMASK) >> (k)) & 1u) && in_phase(k))
#define SEAM(k) do { if (IN(k) && IN((k) + 1)) { XcdBarrier b2_ = bar; asm volatile("" : "+s"(b2_.bar), "+s"(b2_.x)); xcd_barrier(b2_); } } while (0)

    if (IN(0)) { PHASE_BEGIN();
        LAS float* scr = (LAS float*)(F.lds + F.wave * 16384);
        int joff = 0;
        for (int l = 0; l < 2; ++l) {
            unsigned char* wl = ws + WS_WL + l * WL_STRIDE;
#define RUNJOB(...) do { const TJob jb_ = TJob{__VA_ARGS__}; int fst_ = F.gw - joff; if (fst_ < 0) fst_ += F.ngw; tjob_run_all(jb_, fst_, F.ngw, scr, F.lane); joff = (joff + tjob_items(jb_)) % F.ngw; } while (0)
            RUNJOB(INF(8) + (size_t)l * DM * DIN, (bf16_t*)(wl + WL_WIN), INF(4) + l * DM, DM, DIN, DIN, DM, 1, 1, 0, 0);
            RUNJOB(INF(22) + (size_t)l * 192 * 384, (bf16_t*)(wl + WL_SM + SM_WUQ), INF(20) + l * 192, 192, 384, 384, 192, 1, 0, 0, 0);
            RUNJOB(INF(23) + (size_t)l * 128 * 512, (bf16_t*)(wl + WL_SM + SM_WUKV), INF(21) + l * 128, 128, 512, 512, 128, 1, 0, 0, 0);
            RUNJOB(INF(28) + (size_t)l * 4 * 4096, (bf16_t*)(wl + WL_SM + SM_WR), nullptr, 64, 64, 64, 64, 4, 0, 4096, 4096);
            RUNJOB(INF(30) + (size_t)l * 4 * 4096, (bf16_t*)(wl + WL_SM + SM_WI), nullptr, 64, 64, 64, 64, 4, 0, 4096, 4096);
            RUNJOB(INF(18) + (size_t)l * 65536, (bf16_t*)(wl + WL_SM + SM_WGLU), nullptr, 256, 256, 256, 256, 1, 0, 0, 0);
            RUNJOB(INF(40) + (size_t)l * 4 * 256 * DM, (bf16_t*)(wl + WL_PT), nullptr, 256, DM, DM, 256, 4, 0, (size_t)256 * DM, (size_t)DM * 256);
            RUNJOB(INF(41) + (size_t)l * DM * DM, (bf16_t*)(wl + WL_WO), nullptr, DM, DM, DM, DM, 1, 0, 0, 0);
            RUNJOB(INF(42) + (size_t)l * DM * 256, (bf16_t*)(wl + WL_WXQ), INF(5) + l * DM, DM, 256, 256, DM, 1, 0, 0, 0);
            RUNJOB(INF(43) + (size_t)l * DM * 256, (bf16_t*)(wl + WL_WXKV), INF(6) + l * DM, DM, 256, 256, DM, 1, 0, 0, 0);
            RUNJOB(INF(44) + (size_t)l * DM * 256, (bf16_t*)(wl + WL_WXKV) + (size_t)256 * DM, INF(6) + l * DM, DM, 256, 256, DM, 1, 0, 0, 0);
            RUNJOB(INF(45) + (size_t)l * 256 * DM, (bf16_t*)(wl + WL_WXO), nullptr, 256, DM, DM, 256, 1, 0, 0, 0);
            { u32x4* z = (u32x4*)((bf16_t*)(wl + WL_WIN) + (size_t)C_END * DM); const int n16 = (ZSW - C_END) * DM * 2 / 16;
              for (int i = F.bid * 512 + F.tid; i < n16; i += F.G * 512) z[i] = (u32x4){0u, 0u, 0u, 0u}; }
        }
        {
            RUNJOB(INF(48), (bf16_t*)(ws + WS_WGU), INF(7), DM, FF, FF, DM, 1, 2, 0, 0);
            RUNJOB(INF(49), (bf16_t*)(ws + WS_WGU), INF(7), DM, FF, FF, DM, 1, 3, 0, 0);
            RUNJOB(INF(50), (bf16_t*)(ws + WS_WD), nullptr, FF, DM, DM, FF, 1, 0, 0, 0, G2_FP8);
        }
        for (int i = F.bid * 512 + F.tid; i < 2 * 16 * 64; i += F.G * 512) {
            const int l = i >> 10, g = (i >> 6) & 15, p = i & 63;
            const float dt = __expf(INF(12)[l * 16 + g]);
            const float lr = INF(10)[(l * 16 + g) * 64 + p], li = INF(11)[(l * 16 + g) * 64 + p];
            const float mag = __expf(lr * dt); float sn, cs; sincos_red(li * dt, sn, cs);
            const float ar = mag * cs, ai = mag * sn, den = lr * lr + li * li;
            const float zr = ((ar - 1.f) * lr + ai * li) / den, zi = (ai * lr - (ar - 1.f) * li) / den;
            float* tb = S5T + (size_t)(l * 16 + g) * 36 * 64;
            float brv[16], biv[16], crv[16], civ[16];
#pragma unroll
            for (int c = 0; c < 16; ++c) { brv[c] = INF(13)[((l * 16 + g) * 64 + p) * 16 + c]; biv[c] = INF(14)[((l * 16 + g) * 64 + p) * 16 + c];
                crv[c] = INF(15)[((l * 16 + g) * 16 + c) * 64 + p]; civ[c] = INF(16)[((l * 16 + g) * 16 + c) * 64 + p]; }
#pragma unroll
            for (int c = 0; c < 16; ++c) { const float br = brv[c], bi = biv[c];
                tb[c * 64 + p] = zr * br - zi * bi; tb[(16 + c) * 64 + p] = zr * bi + zi * br;
                BBF[((size_t)(l * 16 + g) * 128 + p) * 16 + c] = f2bf(zr * br - zi * bi); BBF[((size_t)(l * 16 + g) * 128 + 64 + p) * 16 + c] = f2bf(zr * bi + zi * br); }
            tb[32 * 64 + p] = ar; tb[33 * 64 + p] = ai;
            float pr = ar, pi = ai;
            for (int s = 0; s < 6; ++s) { const float nr = pr * pr - pi * pi, ni = 2.f * pr * pi; pr = nr; pi = ni; }
            tb[34 * 64 + p] = pr; tb[35 * 64 + p] = pi;
            bf16_t* cm = CMAT + (size_t)(l * 16 + g) * 16 * 128;
#pragma unroll
            for (int c = 0; c < 16; ++c) { cm[c * 128 + p] = f2bf(crv[c]); cm[c * 128 + 64 + p] = f2bf(-civ[c]); }
        }
        for (int i = F.bid * 512 + F.tid; i < 512; i += F.G * 512) { const float lam = INF(32)[i]; MISCT[i] = 8.f * log1pf(__expf(-lam)); }
        if (F.bid == 0 && F.tid < 2) { const int l = F.tid; float s1 = 0.f, s2 = 0.f;
            for (int d = 0; d < 32; ++d) { s1 += INF(35)[l * 32 + d] * INF(36)[l * 32 + d]; s2 += INF(37)[l * 32 + d] * INF(38)[l * 32 + d]; }
            const float lam_init = 0.8f - 0.6f * expf(-0.3f * (float)l);
            MISCT[512 + l] = expf(s1) - expf(s2) + lam_init; MISCT[514 + l] = lam_init;
            float gq = 0.f, gk = 0.f; for (int d = 0; d < 96; ++d) { gq = fmaxf(gq, fabsf(INF(24)[l * 96 + d])); gk = fmaxf(gk, fabsf(INF(25)[l * 96 + d])); }
            MISCT[516 + l * 4 + 0] = 1.02f * gq * gk * 9.797958971f * LOG2E;
            gq = 0.f; gk = 0.f; for (int d = 0; d < 32; ++d) { gq = fmaxf(gq, fabsf(INF(33)[l * 32 + d])); gk = fmaxf(gk, fabsf(INF(34)[l * 32 + d])); }
            float bm = 0.f; for (int i = 0; i < 128; ++i) bm = fmaxf(bm, fabsf(INF(3)[i]));
            MISCT[516 + l * 4 + 1] = 1.02f * gq * gk * 5.656854249f * LOG2E + bm * LOG2E;
            gq = 0.f; gk = 0.f; for (int d = 0; d < 64; ++d) { gq = fmaxf(gq, fabsf(INF(46)[l * 64 + d])); gk = fmaxf(gk, fabsf(INF(47)[l * 64 + d])); }
            MISCT[516 + l * 4 + 2] = 1.02f * gq * gk * 8.f * LOG2E; }
        for (int i = F.bid * 512 + F.tid; i < 4 * 384; i += F.G * 512) { const int h = i / 384, dd = i % 384 - 128, d = dd > 127 ? 127 : dd; int bk;
            if (d < 16) bk = d < 0 ? 0 : d; else { const float lr_ = logf((float)d / 16.f) / logf(8.f); bk = 16 + (int)(lr_ * 16.f); if (bk > 31) bk = 31; }
            MISCT[1024 + i] = dd < 0 ? 0.f : INF(3)[bk * 4 + h] * LOG2E; }
        for (int m = F.gw; m < MTOK; m += F.ngw) {
            const f32x4* xr = (const f32x4*)(INF(0) + (size_t)m * DM) + F.lane; float s = 0.f;
            u32x2* o8 = (u32x2*)(XB + (size_t)m * DM) + F.lane;
#pragma unroll
            for (int j = 0; j < 4; ++j) { const f32x4 v = xr[64 * j]; s += (v.x * v.x + v.y * v.y) + (v.z * v.z + v.w * v.w); u32x2 w; w.x = cvt_pk_bf16(v.x, v.y); w.y = cvt_pk_bf16(v.z, v.w); o8[64 * j] = w; }
            s = wave_sum(s); if (F.lane < 16) RS[(size_t)m * 16 + F.lane] = F.lane == 0 ? s : 0.f;
        }
    }
    SEAM(0);

    for (int l = 0; l < 2; ++l) {
        const int pb = 1 + 10 * l;
        if (IN(pb + 0)) { PHASE_BEGIN();
            pg8::Gemm g{XB, (const bf16_t*)(WLP(l) + WL_WIN), DM, nullptr}; pg8::StaticOrder S; S.init(MTOK / 256, NIN / 256, F.G, F.bid);
            pg8::EpiIn E{ZS, ZG, RS + (size_t)(l == 0 ? 0 : 3) * MTOK * 16, INF(9) + (size_t)l * 4 * DM};
            pg8::gemm_phase<pg8::EpiIn, pg8::StaticOrder, true, false>(F.lds, g, S, E);
        }
        SEAM(pb + 0);
        if (IN(pb + 1)) { PHASE_BEGIN();
            const int lane = F.lane, r = lane & 31, hi = lane >> 5;
            bf16_t* QM = (bf16_t*)(ws + WS_QM); bf16_t* KM = (bf16_t*)(ws + WS_KM); bf16_t* VMT = (bf16_t*)(ws + WS_VMT);
            if (SUB(0) && F.wave < 2) for (int tt = F.bid * 2 + F.wave; tt < 512; tt += F.G * 2) {
                const int row = tt * 32 + r, b = row >> 12, s = row & 4095;
                bf16x8 xq[12]; float ss = 0.f;
#pragma unroll
                for (int ks = 0; ks < 12; ++ks) { xq[ks] = ldg8(ZS + (size_t)row * ZSW + C_CQ + 16 * ks + 8 * hi); ss += sq8(xq[ks]); }
                ss += __shfl_xor(ss, 32); const float rc = frsq(ss * (1.f / 192.f) + EPS);
                const float pos = (float)((const int*)INF(2))[row]; float cs[8], sn[8];
#pragma unroll
                for (int i = 0; i < 8; ++i) { const int fi = crow(i, hi); const float inv = exp2f(-(float)fi * (13.287712379549449f / 16.f)); sincos_red(pos * inv, sn[i], cs[i]); }
                const bf16_t* W = (const bf16_t*)(WLP(l) + WL_SM + SM_WUQ); const float* gq = INF(24) + l * 96;
#pragma unroll 1
                for (int hd = 0; hd < 4; ++hd) {
                    f32x16 acc[3] = {f32x16{}, f32x16{}, f32x16{}};
#pragma unroll
                    for (int ft = 0; ft < 3; ++ft) {
#pragma unroll
                        for (int ks = 0; ks < 12; ++ks) acc[ft] = MFMA32(ldg8(W + (size_t)(hd * 96 + 32 * ft + r) * 192 + 16 * ks + 8 * hi), xq[ks], acc[ft]); }
                    float s2 = 0.f;
#pragma unroll
                    for (int ft = 0; ft < 3; ++ft)
#pragma unroll
                        for (int q = 0; q < 16; ++q) { acc[ft][q] *= rc; s2 += acc[ft][q] * acc[ft][q]; }
                    s2 += __shfl_xor(s2, 32); const float rq = frsq(s2 * (1.f / 96.f) + EPS);
#pragma unroll
                    for (int ft = 0; ft < 3; ++ft)
#pragma unroll
                        for (int q = 0; q < 16; ++q) acc[ft][q] *= rq * gq[32 * ft + crow(q, hi)];
#pragma unroll
                    for (int q = 0; q < 8; ++q) { const float x1 = acc[2][q], x2 = acc[2][q + 8]; acc[2][q] = x1 * cs[q] - x2 * sn[q]; acc[2][q + 8] = x1 * sn[q] + x2 * cs[q]; }
                    const float qs = 0.10206207261596577f * LOG2E;
                    bf16_t* dst = QM + ((size_t)(b * 4 + hd) * SEQ + s) * 96;
#pragma unroll
                    for (int ft = 0; ft < 3; ++ft)
#pragma unroll
                        for (int rg = 0; rg < 4; ++rg) { u32x2 w; w.x = cvt_pk_bf16(acc[ft][4 * rg] * qs, acc[ft][4 * rg + 1] * qs); w.y = cvt_pk_bf16(acc[ft][4 * rg + 2] * qs, acc[ft][4 * rg + 3] * qs);
                            *(u32x2*)(dst + 32 * ft + 8 * rg + 4 * hi) = w; }
                }
            }
            if (SUB(1) && (F.wave == 2 || F.wave == 3)) for (int tt = F.bid * 2 + F.wave - 2; tt < 512; tt += F.G * 2) {
                const int row = tt * 32 + r, b = row >> 12, s = row & 4095;
                bf16x8 xk[8]; float ss = 0.f;
#pragma unroll
                for (int ks = 0; ks < 8; ++ks) { xk[ks] = ldg8(ZS + (size_t)row * ZSW + C_CKV + 16 * ks + 8 * hi); ss += sq8(xk[ks]); }
                ss += __shfl_xor(ss, 32); const float rc = frsq(ss * (1.f / 128.f) + EPS);
                float kp[16]; float sskp = 0.f;
#pragma unroll
                for (int rg = 0; rg < 4; ++rg) { const u32x2 w = *(const u32x2*)(ZS + (size_t)row * ZSW + C_KPE + 8 * rg + 4 * hi);
                    kp[4 * rg] = bflo(w.x); kp[4 * rg + 1] = bfhi(w.x); kp[4 * rg + 2] = bflo(w.y); kp[4 * rg + 3] = bfhi(w.y); }
#pragma unroll
                for (int q = 0; q < 16; ++q) sskp += kp[q] * kp[q];
                const float pos = (float)((const int*)INF(2))[row]; float cs[8], sn[8];
#pragma unroll
                for (int i = 0; i < 8; ++i) { const int fi = crow(i, hi); const float inv = exp2f(-(float)fi * (13.287712379549449f / 16.f)); sincos_red(pos * inv, sn[i], cs[i]); }
                const bf16_t* W = (const bf16_t*)(WLP(l) + WL_SM + SM_WUKV); const float* gk = INF(25) + l * 96;
#pragma unroll 1
                for (int hd = 0; hd < 4; ++hd) {
                    f32x16 acc[4] = {f32x16{}, f32x16{}, f32x16{}, f32x16{}};
#pragma unroll
                    for (int ft = 0; ft < 4; ++ft) {
#pragma unroll
                        for (int ks = 0; ks < 8; ++ks) acc[ft] = MFMA32(ldg8(W + (size_t)(hd * 128 + 32 * ft + r) * 128 + 16 * ks + 8 * hi), xk[ks], acc[ft]); }
                    float s2 = sskp;
#pragma unroll
                    for (int ft = 0; ft < 2; ++ft)
#pragma unroll
                        for (int q = 0; q < 16; ++q) { acc[ft][q] *= rc; s2 += acc[ft][q] * acc[ft][q]; }
                    s2 += __shfl_xor(s2, 32); const float rk = frsq(s2 * (1.f / 96.f) + EPS);
                    float kr[16];
#pragma unroll
                    for (int q = 0; q < 16; ++q) kr[q] = kp[q] * rk * gk[64 + crow(q, hi)];
#pragma unroll
                    for (int q = 0; q < 8; ++q) { const float x1 = kr[q], x2 = kr[q + 8]; kr[q] = x1 * cs[q] - x2 * sn[q]; kr[q + 8] = x1 * sn[q] + x2 * cs[q]; }
                    bf16_t* dst = KM + ((size_t)(b * 4 + hd) * SEQ + s) * 96;
#pragma unroll
                    for (int ft = 0; ft < 2; ++ft)
#pragma unroll
                        for (int rg = 0; rg < 4; ++rg) { const float* gp = gk + 32 * ft + 8 * rg + 4 * hi; u32x2 w;
                            w.x = cvt_pk_bf16(acc[ft][4 * rg] * rk * gp[0], acc[ft][4 * rg + 1] * rk * gp[1]); w.y = cvt_pk_bf16(acc[ft][4 * rg + 2] * rk * gp[2], acc[ft][4 * rg + 3] * rk * gp[3]);
                            *(u32x2*)(dst + 32 * ft + 8 * rg + 4 * hi) = w; }
#pragma unroll
                    for (int rg = 0; rg < 4; ++rg) { u32x2 w; w.x = cvt_pk_bf16(kr[4 * rg], kr[4 * rg + 1]); w.y = cvt_pk_bf16(kr[4 * rg + 2], kr[4 * rg + 3]); *(u32x2*)(dst + 64 + 8 * rg + 4 * hi) = w; }
                    bf16_t* vd = VMT + (size_t)(b * 4 + hd) * 64 * SEQ + s;
#pragma unroll
                    for (int ft = 2; ft < 4; ++ft)
#pragma unroll
                        for (int q = 0; q < 16; ++q) vd[(size_t)(32 * (ft - 2) + crow(q, hi)) * SEQ] = f2bf(acc[ft][q] * rc);
                }
            }
            if (SUB(2)) {
                bf16_t* QD = (bf16_t*)(ws + WS_QD); bf16_t* KD = (bf16_t*)(ws + WS_KD); bf16_t* VDT = (bf16_t*)(ws + WS_VDT);
                const float* gqn = INF(33) + l * 32; const float* gkn = INF(34) + l * 32;
                for (int i = F.bid * 512 + F.tid; i < MTOK * 16; i += F.G * 512) {
                    const int row = i & (MTOK - 1), j = i >> 14, half = j & 1, hd = (j >> 1) & 3, isk = j >> 3;
                    const bf16_t* src = ZS + (size_t)row * ZSW + (isk ? C_KD : C_QD) + hd * 64 + half * 32;
                    bf16x8 v[4]; float ss = 0.f;
#pragma unroll
                    for (int c = 0; c < 4; ++c) { v[c] = ldg8(src + 8 * c); ss += sq8(v[c]); }
                    const float rs = frsq(ss * (1.f / 32.f) + EPS) * (isk ? 1.f : 0.17677669529663687f * LOG2E);
                    const float* gg = isk ? gkn : gqn; const int b = row >> 12, s = row & 4095;
                    bf16_t* dst = (isk ? KD : QD) + ((size_t)(b * 4 + hd) * SEQ + s) * 64 + half * 32;
#pragma unroll
                    for (int c = 0; c < 4; ++c) { u32x4 w = *(u32x4*)&v[c]; const float* gp = gg + 8 * c;
                        w.x = cvt_pk_bf16(bflo(w.x) * rs * gp[0], bfhi(w.x) * rs * gp[1]); w.y = cvt_pk_bf16(bflo(w.y) * rs * gp[2], bfhi(w.y) * rs * gp[3]);
                        w.z = cvt_pk_bf16(bflo(w.z) * rs * gp[4], bfhi(w.z) * rs * gp[5]); w.w = cvt_pk_bf16(bflo(w.w) * rs * gp[6], bfhi(w.w) * rs * gp[7]);
                        *(u32x4*)(dst + 8 * c) = w; }
                }
                for (int i = F.bid * 512 + F.tid; i < MTOK * 32; i += F.G * 512) {
                    const int row = i & (MTOK - 1), j = i >> 14, oc = j & 7, hd = j >> 3, b = row >> 12, s = row & 4095;
                    const bf16x8 v = ldg8(ZS + (size_t)row * ZSW + C_VD + hd * 64 + oc * 8);
                    bf16_t* vd = VDT + ((size_t)(b * 4 + hd) * 64 + oc * 8) * SEQ + s;
#pragma unroll
                    for (int e = 0; e < 8; ++e) vd[(size_t)e * SEQ] = (bf16_t)v[e];
                }
            }
            if (SUB(3)) {
                float* LA = (float*)(ws + WS_LA); float* LI = (float*)(ws + WS_LI); float* LSA = (float*)(ws + WS_LSUM); float* LSH = LSA + NB * 128 * 256;
                const float* cw = INF(26) + l * 4 * 256; const float* cb = INF(27) + l * 256; const float* br = INF(29) + l * 256; const float* bi = INF(31) + l * 256;
                const float* c8 = MISCT + l * 256;
                LAS float* lsa = (LAS float*)(F.lds + F.wave * 16384); LAS float* lsh = lsa + 32 * 64;
                for (int tk = F.gw; tk < NB * 128 * 4; tk += F.ngw) {
                    const int n = tk & 3, tile = (tk >> 2) & 127, b = tk >> 9, s = tile * 32 + r, row = b * SEQ + s, cbase = 64 * n;
                    bf16x8 xcb[4]; float xcf[4][8];
#pragma unroll
                    for (int ks = 0; ks < 4; ++ks) {
                        const int c0 = cbase + 16 * ks + 8 * hi;
#pragma unroll
                        for (int e = 0; e < 8; ++e) xcf[ks][e] = cb[c0 + e];
#pragma unroll
                        for (int k = 0; k < 4; ++k) { const int sr = s - 3 + k;
                            if (sr >= 0) { const bf16x8 xv = ldg8(ZS + (size_t)(b * SEQ + sr) * ZSW + C_XLRU + c0); const u32x4 w = *(const u32x4*)&xv; const float* wk = cw + k * 256 + c0;
                                xcf[ks][0] += wk[0] * bflo(w.x); xcf[ks][1] += wk[1] * bfhi(w.x); xcf[ks][2] += wk[2] * bflo(w.y); xcf[ks][3] += wk[3] * bfhi(w.y);
                                xcf[ks][4] += wk[4] * bflo(w.z); xcf[ks][5] += wk[5] * bfhi(w.z); xcf[ks][6] += wk[6] * bflo(w.w); xcf[ks][7] += wk[7] * bfhi(w.w); } }
                        u32x4 pw; pw.x = cvt_pk_bf16(xcf[ks][0], xcf[ks][1]); pw.y = cvt_pk_bf16(xcf[ks][2], xcf[ks][3]); pw.z = cvt_pk_bf16(xcf[ks][4], xcf[ks][5]); pw.w = cvt_pk_bf16(xcf[ks][6], xcf[ks][7]); xcb[ks] = *(bf16x8*)&pw;
                    }
                    const bf16_t* Wr = (const bf16_t*)(WLP(l) + WL_SM + SM_WR) + n * 4096; const bf16_t* Wi = (const bf16_t*)(WLP(l) + WL_SM + SM_WI) + n * 4096;
                    f32x16 ar_[2] = {f32x16{}, f32x16{}}, ai_[2] = {f32x16{}, f32x16{}};
#pragma unroll
                    for (int ft = 0; ft < 2; ++ft)
#pragma unroll
                        for (int ks = 0; ks < 4; ++ks) { ar_[ft] = MFMA32(ldg8(Wr + (32 * ft + r) * 64 + 16 * ks + 8 * hi), xcb[ks], ar_[ft]); ai_[ft] = MFMA32(ldg8(Wi + (32 * ft + r) * 64 + 16 * ks + 8 * hi), xcb[ks], ai_[ft]); }
                    float xloc[4][4], xrcv[4][4];
#pragma unroll
                    for (int ks = 0; ks < 4; ++ks)
#pragma unroll
                        for (int j = 0; j < 4; ++j) { xloc[ks][j] = hi ? xcf[ks][4 + j] : xcf[ks][j]; const float snd = hi ? xcf[ks][j] : xcf[ks][4 + j]; xrcv[ks][j] = __shfl_xor(snd, 32); }
#pragma unroll
                    for (int ft = 0; ft < 2; ++ft)
#pragma unroll
                        for (int rg = 0; rg < 4; ++rg) {
                            const int c0 = cbase + 32 * ft + 8 * rg + 4 * hi, ks = 2 * ft + (rg >> 1);
                            f32x4 av, iv;
#pragma unroll
                            for (int e = 0; e < 4; ++e) { const float xce = ((rg & 1) == hi) ? xloc[ks][e] : xrcv[ks][e];
                                const float rr = fsigmoid(ar_[ft][4 * rg + e] + br[c0 + e]), ii = fsigmoid(ai_[ft][4 * rg + e] + bi[c0 + e]);
                                const float la = -rr * c8[c0 + e]; const float a = fexp2(la * LOG2E); av[e] = a; iv[e] = sqrtf(fmaxf(1.f - a * a, 0.f)) * ii * xce; }
                            *(f32x4*)(LA + (size_t)row * 256 + c0) = av; *(f32x4*)(LI + (size_t)row * 256 + c0) = iv;
                            { const int sc_ = (32 * ft + 8 * rg + 4 * hi) ^ ((r & 7) << 2); *(LAS f32x4*)(lsa + r * 64 + sc_) = av; *(LAS f32x4*)(lsh + r * 64 + sc_) = iv; }
                        }
                    asm volatile("s_waitcnt lgkmcnt(0)" ::: "memory");
                    {
                        float ta = 1.f, th = 0.f;
#pragma unroll
                        for (int t = 0; t < 32; ++t) { const float a_ = lsa[t * 64 + (lane ^ ((t & 7) << 2))], h_ = lsh[t * 64 + (lane ^ ((t & 7) << 2))]; th = a_ * th + h_; ta = ta * a_; }
                        LSA[(size_t)(b * 128 + tile) * 256 + cbase + lane] = ta; LSH[(size_t)(b * 128 + tile) * 256 + cbase + lane] = th;
                    }
                    asm volatile("s_waitcnt lgkmcnt(0)" ::: "memory");
                }
            }
            if (SUB(4)) {
                float* S5S = (float*)(ws + WS_S5S);
                const int t5cnt = F.wave < 4 ? 1 : (F.wave == 4 ? 0 : 4), t5off = F.wave < 4 ? F.wave : 4 + 4 * (F.wave - 5);
                for (int tbk = F.bid; tbk < NB * 64; tbk += F.G) for (int tj = 0; tj < t5cnt; ++tj) { const int tk = tbk * 16 + t5off + tj;
                    const int g = tk & 15, ch = (tk >> 4) & 63, b = tk >> 10;
                    const float* tb = S5T + (size_t)(l * 16 + g) * 36 * 64 + lane;
                    const float ar = tb[32 * 64], ai = tb[33 * 64];
                    LAS unsigned char* tile = F.lds + F.wave * 16384;
                    float hr = 0.f, hi2 = 0.f;
#pragma unroll 1
                    for (int hf = 0; hf < 2; ++hf) {
                        s5_bu_tile(tile, BBF + (size_t)(l * 16 + g) * 128 * 16, ZS + (size_t)(b * SEQ + ch * 64 + hf * 32) * ZSW + C_S5 + 16 * g, lane);
#pragma unroll 8
                        for (int t2 = 0; t2 < 32; ++t2) { const float bur = bf2f(*(const LAS bf16_t*)(tile + t2 * 272 + lane * 2)), bui = bf2f(*(const LAS bf16_t*)(tile + t2 * 272 + 128 + lane * 2));
                            const float nr = ar * hr - ai * hi2 + bur, ni = ar * hi2 + ai * hr + bui; hr = nr; hi2 = ni; }
                        asm volatile("s_waitcnt lgkmcnt(0)" ::: "memory");
                    }
                    float* dst = S5S + ((size_t)((b * 64 + ch) * 16 + g) * 2) * 64 + lane; dst[0] = hr; dst[64] = hi2;
                }
            }
            if (SUB(5) && l == 0) {
                bf16_t* KX = (bf16_t*)(ws + WS_KX); bf16_t* VXT = (bf16_t*)(ws + WS_VXT);
                if (F.wave == 4) for (int tk = F.bid; tk < 2 * 32 * 4; tk += F.G) {
                    const int hd = tk & 3, mt = (tk >> 2) & 31, ly = tk >> 7, row = mt * 32 + r, b = row >> 8, jm = row & 255;
                    const bf16_t* W = (const bf16_t*)(ws + WS_WL + ly * WL_STRIDE + WL_WXKV);
                    f32x16 acc[4] = {f32x16{}, f32x16{}, f32x16{}, f32x16{}}; float ss = 0.f;
                    const float* mp = INF(1) + (size_t)row * DM + 8 * hi;
#pragma unroll 2
                    for (int ks = 0; ks < 64; ++ks) {
                        const f32x4 m0 = *(const f32x4*)(mp + 16 * ks), m1 = *(const f32x4*)(mp + 16 * ks + 4);
                        ss += (m0.x * m0.x + m0.y * m0.y) + (m0.z * m0.z + m0.w * m0.w) + (m1.x * m1.x + m1.y * m1.y) + (m1.z * m1.z + m1.w * m1.w);
                        const u32x4 pw = pg8::pack8(m0, m1); const bf16x8 xb = *(const bf16x8*)&pw;
#pragma unroll
                        for (int f = 0; f < 4; ++f) { const int wrow = (f < 2 ? 64 * hd + 32 * f : 256 + 64 * hd + 32 * (f - 2)) + r; acc[f] = MFMA32(ldg8(W + (size_t)wrow * DM + 16 * ks + 8 * hi), xb, acc[f]); }
                    }
                    ss += __shfl_xor(ss, 32); const float rm = frsq(ss * (1.f / DM) + EPS);
                    float s2 = 0.f;
#pragma unroll
                    for (int f = 0; f < 2; ++f)
#pragma unroll
                        for (int q = 0; q < 16; ++q) { acc[f][q] *= rm; s2 += acc[f][q] * acc[f][q]; }
                    s2 += __shfl_xor(s2, 32); const float rk = frsq(s2 * (1.f / 64.f) + EPS);
                    const float* gk = INF(47) + ly * 64;
                    bf16_t* kd = KX + ((size_t)(ly * 16 + b * 4 + hd) * 256 + jm) * 64;
#pragma unroll
                    for (int f = 0; f < 2; ++f)
#pragma unroll
                        for (int rg = 0; rg < 4; ++rg) { const float* gp = gk + 32 * f + 8 * rg + 4 * hi; u32x2 w;
                            w.x = cvt_pk_bf16(acc[f][4 * rg] * rk * gp[0], acc[f][4 * rg + 1] * rk * gp[1]); w.y = cvt_pk_bf16(acc[f][4 * rg + 2] * rk * gp[2], acc[f][4 * rg + 3] * rk * gp[3]);
                            *(u32x2*)(kd + 32 * f + 8 * rg + 4 * hi) = w; }
                    bf16_t* vd = VXT + (size_t)(ly * 16 + b * 4 + hd) * 64 * 256 + jm;
#pragma unroll
                    for (int f = 2; f < 4; ++f)
#pragma unroll
                        for (int q = 0; q < 16; ++q) vd[(size_t)(32 * (f - 2) + crow(q, hi)) * 256] = f2bf(acc[f][q] * rm);
                }
            }
        }
        SEAM(pb + 1);
        if (IN(pb + 2)) {
            if (SUB(6)) { PHASE_BEGIN();
            const int lane = F.lane, r32 = lane & 31, hi = lane >> 5, wid = F.wave;
            volatile LAS unsigned* qslot = (volatile LAS unsigned*)(F.lds + MISC_OFF + 64);
            for (int it = queue_pull(F.ctl + CW_Q + 64 * (4 * l + 0), qslot, F.tid); it < 256; it = queue_pull(F.ctl + CW_Q + 64 * (4 * l + 0), qslot, F.tid)) {
                {
                    const int bh = it & 15, qt = 15 - (it >> 4), b = bh >> 2, hd = bh & 3;
                    const bf16_t* QM = (const bf16_t*)(ws + WS_QM) + (size_t)bh * SEQ * 96; const bf16_t* KM = (const bf16_t*)(ws + WS_KM) + (size_t)bh * SEQ * 96;
                    const bf16_t* VMT = (const bf16_t*)(ws + WS_VMT) + (size_t)bh * 64 * SEQ;
                    f32x16 o[1][2]; float lsum[1];
                    attn_unit<96, 1, true, false, false>(F.lds, QM + (size_t)qt * 256 * 96, 96, KM, VMT, SEQ, 4 * (qt + 1), 256 * qt, nullptr, nullptr, 1.f, MISCT[516 + l * 4 + 0], o, lsum);
                    const int row = b * SEQ + qt * 256 + wid * 32 + r32;
                    attn_store(YB + (size_t)1 * MTOK * 256 + (size_t)row * 256 + hd * 64, o[0], frcp(lsum[0]), hi);
                }
            } }
            if (SUB(7)) { PHASE_BEGIN();
            const int lane = F.lane, r32 = lane & 31, hi = lane >> 5, wid = F.wave;
            LAS float* lut = (LAS float*)(F.lds + 106496);
            for (int i = F.tid; i < 4 * 384; i += 512) lut[i] = MISCT[1024 + i];
            __syncthreads();
            volatile LAS unsigned* qslot = (volatile LAS unsigned*)(F.lds + MISC_OFF + 64);
            for (int it = queue_pull(F.ctl + CW_Q + 64 * (4 * l + 1), qslot, F.tid); it < 256; it = queue_pull(F.ctl + CW_Q + 64 * (4 * l + 1), qslot, F.tid)) {
                {
                    const int bh = it & 15, qt = 15 - (it >> 4), b = bh >> 2, hd = bh & 3;
                    const bf16_t* QD = (const bf16_t*)(ws + WS_QD) + (size_t)bh * SEQ * 64; const bf16_t* KD = (const bf16_t*)(ws + WS_KD) + (size_t)bh * SEQ * 64;
                    const bf16_t* VDT = (const bf16_t*)(ws + WS_VDT) + (size_t)bh * 64 * SEQ;
                    f32x16 o[2][2]; float lsum[2];
                    attn_unit<64, 2, true, true, false>(F.lds, QD + (size_t)qt * 256 * 64, 64, KD, VDT, SEQ, 4 * (qt + 1), 256 * qt, lut + hd * 384, nullptr, 1.f, MISCT[516 + l * 4 + 1], o, lsum);
                    const float lam = MISCT[512 + l], lam_init = MISCT[514 + l];
                    const float i1 = frcp(lsum[0]), i2 = lam * frcp(lsum[1]); float ss = 0.f;
#pragma unroll
                    for (int dt = 0; dt < 2; ++dt)
#pragma unroll
                        for (int q = 0; q < 16; ++q) { const float v = o[0][dt][q] * i1 - o[1][dt][q] * i2; o[0][dt][q] = v; ss += v * v; }
                    ss += __shfl_xor(ss, 32); const float rs = frsq(ss * (1.f / 64.f) + EPS) * (1.f - lam_init);
                    const float* gs = INF(39) + l * 64;
#pragma unroll
                    for (int dt = 0; dt < 2; ++dt)
#pragma unroll
                        for (int q = 0; q < 16; ++q) o[0][dt][q] *= gs[32 * dt + crow(q, hi)];
                    const int row = b * SEQ + qt * 256 + wid * 32 + r32;
                    attn_store(YB + (size_t)3 * MTOK * 256 + (size_t)row * 256 + hd * 64, o[0], rs, hi);
                }
            } }
            if (SUB(8)) { PHASE_BEGIN();
            const int lane = F.lane, r32 = lane & 31, hi = lane >> 5, wid = F.wave;
            volatile LAS unsigned* qslot = (volatile LAS unsigned*)(F.lds + MISC_OFF + 64);
            for (int it = queue_pull(F.ctl + CW_Q + 64 * (4 * l + 2), qslot, F.tid); it < 256; it = queue_pull(F.ctl + CW_Q + 64 * (4 * l + 2), qslot, F.tid)) {
                {
                    const int b = it >> 6, ch = it & 63, row0 = b * SEQ + ch * 64;
                    LAS unsigned char* hbuf = F.lds + wid * 8704;
                    LAS unsigned char* ypre = F.lds + 69632;
                    const float* S5S = (const float*)(ws + WS_S5S);
#pragma unroll 1
                    for (int gg = 0; gg < 2; ++gg) {
                        const int g = 2 * wid + gg;
                        const float* tb = S5T + (size_t)(l * 16 + g) * 36 * 64 + lane;
                        const float ar = tb[32 * 64], ai = tb[33 * 64], a64r = tb[34 * 64], a64i = tb[35 * 64];
                        float hr = 0.f, hi2 = 0.f;
                        for (int c0 = 0; c0 < ch; c0 += 8) {
                            float sr[8], si[8];
#pragma unroll
                            for (int u = 0; u < 8; ++u) { const int c = c0 + u; const bool ok = c < ch; const float* sp = S5S + ((size_t)((b * 64 + (ok ? c : 0)) * 16 + g) * 2) * 64 + lane; sr[u] = ok ? sp[0] : 0.f; si[u] = ok ? sp[64] : 0.f; }
#pragma unroll
                            for (int u = 0; u < 8; ++u) { if (c0 + u < ch) { const float nr = a64r * hr - a64i * hi2 + sr[u], ni = a64r * hi2 + a64i * hr + si[u]; hr = nr; hi2 = ni; } }
                        }
                        bf16x8 cf[4];
#pragma unroll
                        for (int ks = 0; ks < 4; ++ks) cf[ks] = ldg8(CMAT + (size_t)(l * 16 + g) * 16 * 128 + (lane & 15) * 128 + 32 * ks + 8 * (lane >> 4));
                        const float* dsk = INF(17) + l * 256 + 16 * g + 4 * (lane >> 4);
#pragma unroll 1
                        for (int hf = 0; hf < 2; ++hf) {
                            s5_bu_tile(hbuf, BBF + (size_t)(l * 16 + g) * 128 * 16, ZS + (size_t)(row0 + hf * 32) * ZSW + C_S5 + 16 * g, lane);
#pragma unroll 8
                            for (int t2 = 0; t2 < 32; ++t2) { const float bur = bf2f(*(const LAS bf16_t*)(hbuf + t2 * 272 + lane * 2)), bui = bf2f(*(const LAS bf16_t*)(hbuf + t2 * 272 + 128 + lane * 2));
                                const float nr = ar * hr - ai * hi2 + bur, ni = ar * hi2 + ai * hr + bui; hr = nr; hi2 = ni;
                                *(LAS bf16_t*)(hbuf + t2 * 272 + lane * 2) = f2bf(hr); *(LAS bf16_t*)(hbuf + t2 * 272 + 128 + lane * 2) = f2bf(hi2);
                            }
                            asm volatile("s_waitcnt lgkmcnt(0)" ::: "memory");
#pragma unroll
                            for (int tq = 0; tq < 2; ++tq) {
                                f32x4 yv = (f32x4){0.f, 0.f, 0.f, 0.f};
#pragma unroll
                                for (int ks = 0; ks < 4; ++ks) { const bf16x8 hb = *(const LAS bf16x8*)(hbuf + (16 * tq + (lane & 15)) * 272 + (32 * ks + 8 * (lane >> 4)) * 2); yv = MFMA16(cf[ks], hb, yv); }
                                const int tl = hf * 32 + 16 * tq + (lane & 15);
                                const u32x2 uw = *(const u32x2*)(ZS + (size_t)(row0 + tl) * ZSW + C_S5 + 16 * g + 4 * (lane >> 4));
                                yv[0] = fgelu(yv[0] + dsk[0] * bflo(uw.x)); yv[1] = fgelu(yv[1] + dsk[1] * bfhi(uw.x)); yv[2] = fgelu(yv[2] + dsk[2] * bflo(uw.y)); yv[3] = fgelu(yv[3] + dsk[3] * bfhi(uw.y));
                                u32x2 pw; pw.x = cvt_pk_bf16(yv[0], yv[1]); pw.y = cvt_pk_bf16(yv[2], yv[3]);
                                *(LAS u32x2*)(ypre + tl * 528 + (16 * g + 4 * (lane >> 4)) * 2) = pw;
                            }
                            asm volatile("s_waitcnt lgkmcnt(0)" ::: "memory");
                        }
                    }
                    __syncthreads();
                    {
                        const bf16_t* WG = (const bf16_t*)(WLP(l) + WL_SM + SM_WGLU);
                        f32x16 acc[2] = {f32x16{}, f32x16{}};
#pragma unroll 4
                        for (int ks = 0; ks < 16; ++ks) { const bf16x8 a = ldg8(WG + (size_t)(32 * wid + r32) * 256 + 16 * ks + 8 * hi);
#pragma unroll
                            for (int tt = 0; tt < 2; ++tt) acc[tt] = MFMA32(a, *(const LAS bf16x8*)(ypre + (32 * tt + r32) * 528 + (16 * ks + 8 * hi) * 2), acc[tt]); }
                        const float* bg = INF(19) + l * 256;
#pragma unroll
                        for (int tt = 0; tt < 2; ++tt)
#pragma unroll
                            for (int rg = 0; rg < 4; ++rg) { const int n0 = 32 * wid + 8 * rg + 4 * hi, t = 32 * tt + r32;
                                const u32x2 yw = *(const LAS u32x2*)(ypre + t * 528 + n0 * 2); u32x2 ow;
                                ow.x = cvt_pk_bf16(bflo(yw.x) * fsigmoid(acc[tt][4 * rg] + bg[n0]), bfhi(yw.x) * fsigmoid(acc[tt][4 * rg + 1] + bg[n0 + 1]));
                                ow.y = cvt_pk_bf16(bflo(yw.y) * fsigmoid(acc[tt][4 * rg + 2] + bg[n0 + 2]), bfhi(yw.y) * fsigmoid(acc[tt][4 * rg + 3] + bg[n0 + 3]));
                                *(u32x2*)(YB + (size_t)(row0 + t) * 256 + n0) = ow; }
                    }
                    __syncthreads();
                }
            }
            }
            if (SUB(9)) { PHASE_BEGIN(); const int lane = F.lane;
                const float* LA = (const float*)(ws + WS_LA); const float* LI = (const float*)(ws + WS_LI); const float* LSA = (const float*)(ws + WS_LSUM); const float* LSH = LSA + NB * 128 * 256;
                volatile LAS unsigned* qslot = (volatile LAS unsigned*)(F.lds + MISC_OFF + 64);
                for (int it = queue_pull(F.ctl + CW_Q + 64 * (4 * l + 3), qslot, F.tid); it < NB * 64 * 4 / 8; it = queue_pull(F.ctl + CW_Q + 64 * (4 * l + 3), qslot, F.tid)) {
                    const int tk = (NB * 64 * 4 / 8 - 1 - it) * 8 + F.wave;
                    const int n = tk & 3, ch = (tk >> 2) & 63, b = tk >> 8, c = 64 * n + lane;
                    float h = 0.f;
                    for (int tp0 = 0; tp0 < 2 * ch; tp0 += 16) {
                        float ca[16], chh[16];
#pragma unroll
                        for (int u = 0; u < 16; ++u) { const int tp = tp0 + u; const bool ok = tp < 2 * ch; const size_t o = (size_t)(b * 128 + (ok ? tp : 0)) * 256 + c; ca[u] = ok ? LSA[o] : 1.f; chh[u] = ok ? LSH[o] : 0.f; }
#pragma unroll
                        for (int u = 0; u < 16; ++u) h = ca[u] * h + chh[u];
                    }
                    const int row0 = b * SEQ + ch * 64;
#pragma unroll 1
                    for (int t0 = 0; t0 < 64; t0 += 16) {
                        float la[16], li[16], gt[16];
#pragma unroll
                        for (int u = 0; u < 16; ++u) { const size_t o = (size_t)(row0 + t0 + u) * 256 + c; la[u] = LA[o]; li[u] = LI[o]; gt[u] = bf2f(ZS[(size_t)(row0 + t0 + u) * ZSW + C_GLRU + c]); }
#pragma unroll
                        for (int u = 0; u < 16; ++u) { h = la[u] * h + li[u]; gt[u] = h * fgelu(gt[u]); }
#pragma unroll
                        for (int u = 0; u < 16; ++u) YB[(size_t)2 * MTOK * 256 + (size_t)(row0 + t0 + u) * 256 + c] = f2bf(gt[u]);
                    }
                }
            }
        }
        SEAM(pb + 2);
        if (IN(pb + 3)) { PHASE_BEGIN();
            pg8::Gemm g{YB, (const bf16_t*)(WLP(l) + WL_PT), 256, nullptr}; pg8::MergeOrder S{F.G, F.bid};
            pg8::EpiMerge E{MG, ZG};
            pg8::gemm_phase<pg8::EpiMerge, pg8::MergeOrder, true, false>(F.lds, g, S, E);
        }
        SEAM(pb + 3);
        if (IN(pb + 4)) { PHASE_BEGIN();
            pg8::Gemm g{MG, (const bf16_t*)(WLP(l) + WL_WO), DM, nullptr}; pg8::StaticOrder S; S.init(MTOK / 256, DM / 256, F.G, F.bid);
            pg8::EpiRes<false> E{nullptr, XB, RS + (size_t)(l == 0 ? 1 : 4) * MTOK * 16, nullptr};
            pg8::gemm_phase<pg8::EpiRes<false>, pg8::StaticOrder, false, false>(F.lds, g, S, E);
        }
        SEAM(pb + 4);
        if (IN(pb + 5)) { PHASE_BEGIN();
            pg8::Gemm g{XB, (const bf16_t*)(WLP(l) + WL_WXQ), DM, nullptr}; pg8::StaticOrder S; S.init(MTOK / 256, 1, F.G, F.bid);
            pg8::EpiRowScale E{(bf16_t*)(ws + WS_QX), 256, RS + (size_t)(l == 0 ? 1 : 4) * MTOK * 16};
            pg8::gemm_phase<pg8::EpiRowScale, pg8::StaticOrder, false, false>(F.lds, g, S, E);
        }
        SEAM(pb + 5);
        if (IN(pb + 6)) { PHASE_BEGIN();
            const int lane = F.lane, r32 = lane & 31, hi = lane >> 5, wid = F.wave;
            for (int it = F.bid; it < 256; it += F.G) {
                const int hd = it & 3, rt = it >> 2, b = rt >> 4;
                const bf16_t* QX = (const bf16_t*)(ws + WS_QX) + (size_t)rt * 256 * 256 + hd * 64;
                const bf16_t* KX = (const bf16_t*)(ws + WS_KX) + (size_t)(l * 16 + b * 4 + hd) * 256 * 64;
                const bf16_t* VXT = (const bf16_t*)(ws + WS_VXT) + (size_t)(l * 16 + b * 4 + hd) * 64 * 256;
                f32x16 o[1][2]; float lsum[1];
                attn_unit<64, 1, false, false, true>(F.lds, QX, 256, KX, VXT, 256, 4, 0, nullptr, INF(46) + l * 64, 0.125f * LOG2E, MISCT[516 + l * 4 + 2], o, lsum);
                const int row = rt * 256 + wid * 32 + r32;
                attn_store((bf16_t*)(ws + WS_OX) + (size_t)row * 256 + hd * 64, o[0], frcp(lsum[0]), hi);
            }
        }
        SEAM(pb + 6);
        if (IN(pb + 7)) { PHASE_BEGIN();
            pg8::Gemm g{(const bf16_t*)(ws + WS_OX), (const bf16_t*)(WLP(l) + WL_WXO), 256, nullptr}; pg8::StaticOrder S; S.init(MTOK / 256, DM / 256, F.G, F.bid);
            if (l == 0) { pg8::EpiRes<false> E{nullptr, XB, RS + (size_t)2 * MTOK * 16, nullptr}; pg8::gemm_phase<pg8::EpiRes<false>, pg8::StaticOrder, false, false>(F.lds, g, S, E); }
            else { pg8::EpiRes<true> E{F.out, XB, RS + (size_t)5 * MTOK * 16, nullptr}; pg8::gemm_phase<pg8::EpiRes<true>, pg8::StaticOrder, false, false>(F.lds, g, S, E); }
        }
        SEAM(pb + 7);
        if (l == 0) {
            if (IN(9)) { PHASE_BEGIN();
                pg8::Gemm g{XB, (const bf16_t*)(ws + WS_WGU), DM, nullptr}; pg8::StaticOrder S; S.init(MTOK / 256, 2 * FF / 256, F.G, F.bid);
#if G2_FP8
                pg8::EpiSwiGLU8<true, false> E{ws + WS_HFF, FF, RS + (size_t)2 * MTOK * 16};
                pg8::gemm_phase<pg8::EpiSwiGLU8<true, false>, pg8::StaticOrder, true, false>(F.lds, g, S, E);
#else
                pg8::EpiSwiGLU<false> E{(bf16_t*)(ws + WS_HFF), FF, RS + (size_t)2 * MTOK * 16, nullptr};
                pg8::gemm_phase<pg8::EpiSwiGLU<false>, pg8::StaticOrder, true, false>(F.lds, g, S, E);
#endif
            }
            SEAM(9);
            if (IN(10)) { PHASE_BEGIN();
#if G2_FP8
                pg8::Gemm g{(const bf16_t*)(ws + WS_HFF), (const bf16_t*)(ws + WS_WD), FF / 2, nullptr}; pg8::StaticOrder S; S.init(MTOK / 256, DM / 256, F.G, F.bid);
                pg8::EpiRes<false, false, true> E{nullptr, XB, RS + (size_t)3 * MTOK * 16, nullptr};
                pg8::gemm_phase<pg8::EpiRes<false, false, true>, pg8::StaticOrder, false, false, true>(F.lds, g, S, E);
#else
                pg8::Gemm g{(const bf16_t*)(ws + WS_HFF), (const bf16_t*)(ws + WS_WD), FF, nullptr}; pg8::StaticOrder S; S.init(MTOK / 256, DM / 256, F.G, F.bid);
                pg8::EpiRes<false> E{nullptr, XB, RS + (size_t)3 * MTOK * 16, nullptr};
                pg8::gemm_phase<pg8::EpiRes<false>, pg8::StaticOrder, false, false>(F.lds, g, S, E);
#endif
            }
            SEAM(10);
        } else {
#define ROWTOK ((int*)(ws + WS_MOESM + MS_ROWTOK))
#define TOKW ((float*)(ws + WS_MOESM + MS_TOKW))
#define ASSIGN ((int*)(ws + WS_MOESM + MS_ASSIGN))
#define RSTD2 ((float*)(ws + WS_MOESM + MS_RSTD))
#define MCNT (F.ctl + CW_MOECNT)
            if (IN(19)) { PHASE_BEGIN();
                LAS float* wrs = (LAS float*)(F.lds);
                { float wv[16], gv[16];
#pragma unroll
                  for (int q = 0; q < 16; ++q) { const int i = F.tid + 512 * q; wv[q] = INF(51)[i]; gv[q] = INF(7)[DM + (i >> 3)]; }
#pragma unroll
                  for (int q = 0; q < 16; ++q) wrs[F.tid + 512 * q] = wv[q] * gv[q]; }
                __syncthreads();
                if (SUB(10) && F.wave < 4) {
                    const int lane = F.lane;
                    for (int blk = F.bid; blk < 256; blk += F.G) {
                        unsigned cntv = 0u, mypack = 0u;
#pragma unroll 1
                        for (int j = 0; j < 16; ++j) {
                            const int tok = blk * 64 + F.wave * 16 + j;
                            const f32x4* xr = (const f32x4*)(F.out + (size_t)tok * DM) + lane;
                            float lg[8] = {0.f, 0.f, 0.f, 0.f, 0.f, 0.f, 0.f, 0.f}; float ss = 0.f; f32x4 xv4[4];
#pragma unroll
                            for (int q = 0; q < 4; ++q) { const f32x4 v = xr[64 * q]; const int k0 = 256 * q + 4 * lane; xv4[q] = v;
                                ss += (v.x * v.x + v.y * v.y) + (v.z * v.z + v.w * v.w);
#pragma unroll
                                for (int e4 = 0; e4 < 4; ++e4) { const float xv = v[e4]; const LAS f32x4* wp = (const LAS f32x4*)(wrs + (k0 + e4) * 8); const f32x4 wa = wp[0], wb = wp[1];
                                    lg[0] += xv * wa.x; lg[1] += xv * wa.y; lg[2] += xv * wa.z; lg[3] += xv * wa.w; lg[4] += xv * wb.x; lg[5] += xv * wb.y; lg[6] += xv * wb.z; lg[7] += xv * wb.w; } }
                            ss = wave_sum(ss);
#pragma unroll
                            for (int e = 0; e < 8; ++e) lg[e] = wave_sum(lg[e]);
                            const float rstd = frsq(ss * (1.f / DM) + EPS);
                            { unsigned* xq = (unsigned*)(ws + WS_XQ + (size_t)tok * DM) + lane;
#pragma unroll
                              for (int q = 0; q < 4; ++q) xq[64 * q] = cvt_pk4_fp8(xv4[q].x * rstd, xv4[q].y * rstd, xv4[q].z * rstd, xv4[q].w * rstd); }
                            int e1 = 0; float v1 = lg[0];
#pragma unroll
                            for (int e = 1; e < 8; ++e) if (lg[e] > v1) { v1 = lg[e]; e1 = e; }
                            int e2 = -1; float v2 = -3.4e38f;
#pragma unroll
                            for (int e = 0; e < 8; ++e) if (e != e1 && lg[e] > v2) { v2 = lg[e]; e2 = e; }
                            if (e2 < 0) e2 = (e1 + 1) & 7;
                            const int se1 = __builtin_amdgcn_readfirstlane(e1), se2 = __builtin_amdgcn_readfirstlane(e2);
                            const unsigned r1 = __builtin_amdgcn_readlane(cntv, se1), r2 = __builtin_amdgcn_readlane(cntv, se2);
                            cntv += (lane == se1 ? 1u : 0u) + (lane == se2 ? 1u : 0u);
                            if (lane == j) mypack = (unsigned)se1 | (r1 << 4) | ((unsigned)se2 << 12) | (r2 << 16);
                            if (lane == 0) { const float w1 = frcp(1.f + __expf((v2 - v1) * rstd)); RSTD2[tok] = rstd; TOKW[tok * 2] = w1; TOKW[tok * 2 + 1] = 1.f - w1; }
                        }
                        unsigned basev = 0u;
                        if (lane < 8) basev = __hip_atomic_fetch_add(MCNT + 64 * lane, cntv, __ATOMIC_RELAXED, __HIP_MEMORY_SCOPE_AGENT);
                        const int pe1 = mypack & 15, pr1 = (mypack >> 4) & 255, pe2 = (mypack >> 12) & 15, pr2 = (mypack >> 16) & 255;
                        const unsigned b1 = __shfl(basev, pe1), b2 = __shfl(basev, pe2);
                        if (lane < 16) { const int tok = blk * 64 + F.wave * 16 + lane; ASSIGN[tok * 2] = pe1 | (int)((b1 + (unsigned)pr1) << 8); ASSIGN[tok * 2 + 1] = pe2 | (int)((b2 + (unsigned)pr2) << 8);
                            ROWTOK[pe1 * 16384 + (int)(b1 + (unsigned)pr1)] = tok; ROWTOK[pe2 * 16384 + (int)(b2 + (unsigned)pr2)] = tok; }
                    }
                }
                if (SUB(11)) {
                    LAS float* scr = (LAS float*)(F.lds + 40960 + F.wave * 8448);
                    const TJob j0{INF(52), (bf16_t*)(ws + WS_WMGU), INF(7) + DM, DM, EFF, EFF, DM, 8, 2, (size_t)DM * EFF, (size_t)2 * EFF * DM, 1};
                    const TJob j1{INF(53), (bf16_t*)(ws + WS_WMGU), INF(7) + DM, DM, EFF, EFF, DM, 8, 3, (size_t)DM * EFF, (size_t)2 * EFF * DM, 1};
                    const TJob j2{INF(54), (bf16_t*)(ws + WS_WMD), nullptr, EFF, DM, DM, EFF, 8, 0, (size_t)EFF * DM, (size_t)DM * EFF, 1};
                    constexpr int NI = 8 * (DM / 64) * (EFF / 32);
                    LAS unsigned* qc = (LAS unsigned*)(F.lds + MISC_OFF + 128);
                    const int wg_items = (3 * NI - F.bid + F.G - 1) / F.G;
#define H0_PULL() h0_pull(qc, F.lane, wg_items, F.bid, F.G, 3 * NI)
#define H0_JOB(idx) const int jn_ = (idx) / NI; TJob js_ = j0; if (jn_ == 1) { js_.W = j1.W; js_.map = 3; } if (jn_ == 2) js_ = j2;
#define H0_LOAD(idx, v) do { H0_JOB(idx) tjob_load(js_, (idx) - jn_ * NI, v, F.lane); } while (0)
#define H0_STORE(idx, v) do { H0_JOB(idx) tjob_store(js_, (idx) - jn_ * NI, v, scr, F.lane); } while (0)
                    float va[32] = {}, vb[32] = {}; int it = H0_PULL();
                    if (it < 3 * NI) { H0_LOAD(it, va);
                        for (;;) {
                            const int n1 = H0_PULL(); if (n1 < 3 * NI) H0_LOAD(n1, vb);
                            H0_STORE(it, va); if (n1 >= 3 * NI) break;
                            const int n2 = H0_PULL(); if (n2 < 3 * NI) H0_LOAD(n2, va);
                            H0_STORE(n1, vb); if (n2 >= 3 * NI) break;
                            it = n2;
                        } }
#undef H0_PULL
#undef H0_JOB
#undef H0_LOAD
#undef H0_STORE
                }
            }
            SEAM(19);
            if (IN(21)) { PHASE_BEGIN();
                pg8::Gemm g{(const bf16_t*)(ws + WS_XQ), (const bf16_t*)(ws + WS_WMGU), DM / 2, ROWTOK}; pg8::MoeOrder S; S.init(MCNT, 2 * EFF / 256, F.G, F.bid);
                pg8::EpiSwiGLU8<false> E{ws + WS_HMOE, EFF, nullptr};
                pg8::gemm_phase<pg8::EpiSwiGLU8<false>, pg8::MoeOrder, true, true, true>(F.lds, g, S, E);
            }
            SEAM(21);
            if (IN(22)) { PHASE_BEGIN();
                pg8::Gemm g{(const bf16_t*)(ws + WS_HMOE), (const bf16_t*)(ws + WS_WMD), EFF / 2, nullptr}; pg8::MoeOrder S; S.init(MCNT, DM / 256, F.G, F.bid);
                pg8::EpiPlain E{(bf16_t*)(ws + WS_YS), DM, 0.03125f};
                pg8::gemm_phase<pg8::EpiPlain, pg8::MoeOrder, true, false, true>(F.lds, g, S, E);
            }
            SEAM(22);
            if (IN(23)) { PHASE_BEGIN();
                const bf16_t* YS = (const bf16_t*)(ws + WS_YS);
                int pst[8]; { int acc = 0;
#pragma unroll
                    for (int e = 0; e < 8; ++e) { pst[e] = acc; acc += ((int)MCNT[64 * e] + 255) & ~255; } }
                for (int m = F.gw; m < MTOK; m += F.ngw) {
                    const int a1 = ASSIGN[2 * m], a2 = ASSIGN[2 * m + 1]; int p1 = 0, p2 = 0;
#pragma unroll
                    for (int q = 0; q < 8; ++q) { p1 = (q == (a1 & 255)) ? pst[q] : p1; p2 = (q == (a2 & 255)) ? pst[q] : p2; }
                    const int d1 = p1 + (a1 >> 8), d2 = p2 + (a2 >> 8); const float w1 = TOKW[2 * m], w2 = TOKW[2 * m + 1];
                    f32x4* xr = (f32x4*)(F.out + (size_t)m * DM) + F.lane;
                    const u32x2* y1 = (const u32x2*)(YS + (size_t)d1 * DM) + F.lane; const u32x2* y2 = (const u32x2*)(YS + (size_t)d2 * DM) + F.lane;
#pragma unroll
                    for (int j = 0; j < 4; ++j) { f32x4 v = xr[64 * j]; const u32x2 a = y1[64 * j], c = y2[64 * j];
                        v.x += w1 * bflo(a.x) + w2 * bflo(c.x); v.y += w1 * bfhi(a.x) + w2 * bfhi(c.x); v.z += w1 * bflo(a.y) + w2 * bflo(c.y); v.w += w1 * bfhi(a.y) + w2 * bfhi(c.y);
                        xr[64 * j] = v; }
                }
            }
        }
    }
#undef IN
#undef SEAM
}

#ifdef DBG_DUMP_OFF
__global__ void dbg_copy_bf16(const bf16_t* src, float* out, int n, int nv) { for (int i = blockIdx.x * 256 + threadIdx.x; i < n; i += gridDim.x * 256) out[i] = i < nv ? bf2f(src[i]) : 0.f; }
#endif

#ifdef DBG_CHECK
struct DbgArgs { const void* in[55]; unsigned char* ws; float* out; float* acc; };
#ifndef DBG_LAYER
#define DBG_LAYER 0
#endif
__device__ __forceinline__ size_t dstride(int i) {
    switch (i) { case 4: case 5: case 6: case 7: case 10: case 11: case 26: return 1024; case 8: return (size_t)DM * DIN; case 9: return 4096; case 12: return 16;
      case 13: case 14: case 15: case 16: case 28: case 30: return 16384; case 17: case 19: case 27: case 29: case 31: case 32: return 256; case 18: case 23: return 65536; case 20: return 192; case 21: return 128;
      case 22: return 73728; case 24: case 25: return 96; case 33: case 34: case 35: case 36: case 37: case 38: return 32; case 39: case 46: case 47: return 64; case 40: return (size_t)4 * 256 * DM; case 41: return (size_t)DM * DM;
      case 42: case 43: case 44: case 45: return (size_t)DM * 256; default: return 0; } }
#define DIN_(i) ((const float*)a.in[i] + (size_t)DBG_LAYER * dstride(i))
#define DXIN_ (DBG_LAYER == 0 ? (const float*)a.in[0] : (const float*)(a.ws + WS_DBG))
constexpr size_t WS_DBG = 440 * MiB;
__device__ float blk_sum(float v, float* sh) { sh[threadIdx.x] = v; __syncthreads(); for (int o = 128; o > 0; o >>= 1) { if ((int)threadIdx.x < o) sh[threadIdx.x] += sh[threadIdx.x + o]; __syncthreads(); } const float r = sh[0]; __syncthreads(); return r; }
__device__ float blk_max(float v, float* sh) { sh[threadIdx.x] = v; __syncthreads(); for (int o = 128; o > 0; o >>= 1) { if ((int)threadIdx.x < o) sh[threadIdx.x] = fmaxf(sh[threadIdx.x], sh[threadIdx.x + o]); __syncthreads(); } const float r = sh[0]; __syncthreads(); return r; }
__device__ void dbg_acc(float* acc, int k, float fast, float ref) { atomicMax((unsigned*)&acc[2 * k], __float_as_uint(fabsf(fast - ref))); atomicAdd(&acc[2 * k + 1], ref * ref); atomicAdd(&acc[64 + k], 1.f); }
__device__ float dsig(float x) { return 1.f / (1.f + expf(-x)); }
__device__ float dgelu(float x) { return 0.5f * x * (1.f + tanhf(0.7978845608028654f * (x + 0.044715f * x * x * x))); }
__device__ int dbucket(int d) { if (d < 16) return d < 0 ? 0 : d; int bk = 16 + (int)(logf((float)d / 16.f) / logf(8.f) * 16.f); return bk > 31 ? 31 : bk; }

__global__ void chk_z(DbgArgs a) {
    __shared__ float sh[256]; const int s = blockIdx.x, tid = threadIdx.x; const int row = (s * 7919 + 13) % MTOK; int col = (s * 104729 + 7 + (s >> 1)) % DIN; if (s & 1) col = col % C_END;
    const float* x = (DBG_LAYER == 0 ? (const float*)a.in[0] : (const float*)a.out) + (size_t)row * DM; const float* g = DIN_(4); const float* W = DIN_(8);
    float ss = 0.f, dot = 0.f; for (int k = tid; k < DM; k += 256) { const float xv = x[k]; ss += xv * xv; dot += xv * g[k] * W[(size_t)k * DIN + col]; }
    ss = blk_sum(ss, sh); dot = blk_sum(dot, sh);
    if (tid == 0) { const float z = dot * rsqrtf(ss / DM + EPS);
        if (col < C_END) dbg_acc(a.acc, 1, bf2f(((const bf16_t*)(a.ws + WS_ZS))[(size_t)row * ZSW + col]), z);
        else { const int gc = col - C_END; dbg_acc(a.acc, 2, bf2f(((const bf16_t*)(a.ws + WS_ZG))[(size_t)row * ZGW + gc]), dsig(z + DIN_(9)[gc])); } }
}
__global__ void chk_mla_prep(DbgArgs a) {
    __shared__ float sh[256]; __shared__ float vn[192]; __shared__ float qs[128];
    const int s = blockIdx.x, tid = threadIdx.x, row = (s * 7919 + 13) % MTOK, hd = s & 3, b = row >> 12, sq = row & 4095;
    const bf16_t* ZSp = (const bf16_t*)(a.ws + WS_ZS) + (size_t)row * ZSW; const float pos = (float)((const int*)a.in[2])[row];
    { const float v = tid < 192 ? bf2f(ZSp[C_CQ + tid]) : 0.f; const float ss = blk_sum(v * v, sh); if (tid < 192) vn[tid] = v * rsqrtf(ss / 192.f + EPS) * DIN_(20)[tid]; __syncthreads(); }
    float qf = 0.f; if (tid < 96) for (int k = 0; k < 192; ++k) qf += vn[k] * DIN_(22)[k * 384 + hd * 96 + tid];
    { const float ss = blk_sum(tid < 96 ? qf * qf : 0.f, sh); if (tid < 96) qs[tid] = qf * rsqrtf(ss / 96.f + EPS) * DIN_(24)[tid]; __syncthreads(); }
    if (tid < 96) { float val = qs[tid]; if (tid >= 64) { const int i = (tid - 64) & 15; float sn, cs; sincos_red(pos * exp2f(-(float)i * (13.287712379549449f / 16.f)), sn, cs); const float x1 = qs[64 + i], x2 = qs[80 + i]; val = tid < 80 ? x1 * cs - x2 * sn : x1 * sn + x2 * cs; }
        val *= 0.10206207261596577f * LOG2E; dbg_acc(a.acc, 3, bf2f(((const bf16_t*)(a.ws + WS_QM))[((size_t)(b * 4 + hd) * SEQ + sq) * 96 + tid]), val); }
    __syncthreads();
    { const float v = tid < 128 ? bf2f(ZSp[C_CKV + tid]) : 0.f; const float ss = blk_sum(v * v, sh); if (tid < 128) vn[tid] = v * rsqrtf(ss / 128.f + EPS) * DIN_(21)[tid]; __syncthreads(); }
    float kv = 0.f; if (tid < 128) for (int k = 0; k < 128; ++k) kv += vn[k] * DIN_(23)[k * 512 + hd * 128 + tid];
    float kfull = 0.f; if (tid < 64) kfull = kv; else if (tid < 96) kfull = bf2f(ZSp[C_KPE + tid - 64]);
    { const float ss = blk_sum(tid < 96 ? kfull * kfull : 0.f, sh); if (tid < 96) qs[tid] = kfull * rsqrtf(ss / 96.f + EPS) * DIN_(25)[tid]; __syncthreads(); }
    if (tid < 96) { float val = qs[tid]; if (tid >= 64) { const int i = (tid - 64) & 15; float sn, cs; sincos_red(pos * exp2f(-(float)i * (13.287712379549449f / 16.f)), sn, cs); const float x1 = qs[64 + i], x2 = qs[80 + i]; val = tid < 80 ? x1 * cs - x2 * sn : x1 * sn + x2 * cs; }
        dbg_acc(a.acc, 4, bf2f(((const bf16_t*)(a.ws + WS_KM))[((size_t)(b * 4 + hd) * SEQ + sq) * 96 + tid]), val); }
    if (tid >= 64 && tid < 128) dbg_acc(a.acc, 5, bf2f(((const bf16_t*)(a.ws + WS_VMT))[((size_t)(b * 4 + hd) * 64 + tid - 64) * SEQ + sq]), kv);
}
__global__ void chk_diff_prep(DbgArgs a) {
    const int i = blockIdx.x * 256 + threadIdx.x; const int row = (i * 37 + 5) % MTOK, hd = i & 3, half = (i >> 2) & 1, isk = (i >> 3) & 1, b = row >> 12, sq = row & 4095;
    const bf16_t* src = (const bf16_t*)(a.ws + WS_ZS) + (size_t)row * ZSW + (isk ? C_KD : C_QD) + hd * 64 + half * 32;
    float ss = 0.f; for (int d = 0; d < 32; ++d) { const float v = bf2f(src[d]); ss += v * v; }
    const float rs = rsqrtf(ss / 32.f + EPS) * (isk ? 1.f : 0.17677669529663687f * LOG2E); const float* gg = DIN_(isk ? 34 : 33);
    const bf16_t* dst = (const bf16_t*)(a.ws + (isk ? WS_KD : WS_QD)) + ((size_t)(b * 4 + hd) * SEQ + sq) * 64 + half * 32;
    for (int d = 0; d < 32; ++d) dbg_acc(a.acc, 6, bf2f(dst[d]), bf2f(src[d]) * rs * gg[d]);
    const bf16_t* vs = (const bf16_t*)(a.ws + WS_ZS) + (size_t)row * ZSW + C_VD + hd * 64;
    for (int d = half * 32; d < half * 32 + 32; ++d) dbg_acc(a.acc, 7, bf2f(((const bf16_t*)(a.ws + WS_VDT))[((size_t)(b * 4 + hd) * 64 + d) * SEQ + sq]), bf2f(vs[d]));
}
__global__ void __launch_bounds__(256) chk_lru_prep(DbgArgs a) {
    __shared__ float xcs[64]; const int s = blockIdx.x, tid = threadIdx.x, row = (s * 7919 + 13) % MTOK, n = s & 3, b = row >> 12, sq = row & 4095;
    if (s == 0 || s == 1) { }
    float xc = 0.f;
    if (tid < 64) { const int c = 64 * n + tid; xc = DIN_(27)[c]; for (int k = 0; k < 4; ++k) { const int sr = sq - 3 + k; if (sr >= 0) xc += DIN_(26)[k * 256 + c] * bf2f(((const bf16_t*)(a.ws + WS_ZS))[(size_t)(b * SEQ + sr) * ZSW + C_XLRU + c]); } xcs[tid] = xc; }
    __syncthreads();
    if (tid < 64) { const int c = 64 * n + tid; float ar = DIN_(29)[c], ai = DIN_(31)[c];
        const float* wr_ = DIN_(28); const float* wi_ = DIN_(30);
#pragma unroll 2
        for (int cc = 0; cc < 64; ++cc) { ar += xcs[cc] * wr_[(n * 64 + cc) * 64 + tid]; ai += xcs[cc] * wi_[(n * 64 + cc) * 64 + tid]; }
        const float r = 1.f / (1.f + __expf(-ar)), ii = 1.f / (1.f + __expf(-ai)), la = -8.f * r * __logf(1.f + __expf(-DIN_(32)[c])), av = __expf(la), iv = sqrtf(fmaxf(1.f - av * av, 0.f)) * ii * xc;
        dbg_acc(a.acc, 8, ((const float*)(a.ws + WS_LA))[(size_t)row * 256 + c], av); dbg_acc(a.acc, 9, ((const float*)(a.ws + WS_LI))[(size_t)row * 256 + c], iv); }
}
__global__ void chk_mla_attn(DbgArgs a) {
    __shared__ float sh[256]; __shared__ float q[96]; __shared__ float p[4096];
    const int s = blockIdx.x, tid = threadIdx.x, bh = s & 15, sq = (s * 523 + 77) % SEQ, b = bh >> 2, hd = bh & 3;
    const bf16_t* QM = (const bf16_t*)(a.ws + WS_QM) + (size_t)bh * SEQ * 96; const bf16_t* KM = (const bf16_t*)(a.ws + WS_KM) + (size_t)bh * SEQ * 96; const bf16_t* VMT = (const bf16_t*)(a.ws + WS_VMT) + (size_t)bh * 64 * SEQ;
    if (tid < 96) q[tid] = bf2f(QM[(size_t)sq * 96 + tid]); __syncthreads();
    float mx = -1e30f; for (int j = tid; j <= sq; j += 256) { float sc = 0.f; for (int d = 0; d < 96; ++d) sc += q[d] * bf2f(KM[(size_t)j * 96 + d]); p[j] = sc; mx = fmaxf(mx, sc); }
    mx = blk_max(mx, sh); float sm = 0.f; for (int j = tid; j <= sq; j += 256) { p[j] = exp2f(p[j] - mx); sm += p[j]; } sm = blk_sum(sm, sh);
    if (tid < 64) { float o = 0.f; for (int j = 0; j <= sq; ++j) o += p[j] * bf2f(VMT[(size_t)tid * SEQ + j]); dbg_acc(a.acc, 10, bf2f(((const bf16_t*)(a.ws + WS_Y))[(size_t)1 * MTOK * 256 + (size_t)(b * SEQ + sq) * 256 + hd * 64 + tid]), o / sm); }
}
__global__ void chk_diff_attn(DbgArgs a) {
    __shared__ float sh[256]; __shared__ float q[64]; __shared__ float p1[4096]; __shared__ float p2[4096];
    const int s = blockIdx.x, tid = threadIdx.x, bh = s & 15, sq = (s * 523 + 77) % SEQ, b = bh >> 2, hd = bh & 3;
    const bf16_t* QD = (const bf16_t*)(a.ws + WS_QD) + (size_t)bh * SEQ * 64; const bf16_t* KD = (const bf16_t*)(a.ws + WS_KD) + (size_t)bh * SEQ * 64; const bf16_t* VDT = (const bf16_t*)(a.ws + WS_VDT) + (size_t)bh * 64 * SEQ;
    if (tid < 64) q[tid] = bf2f(QD[(size_t)sq * 64 + tid]); __syncthreads();
    float m1 = -1e30f, m2 = -1e30f; for (int j = tid; j <= sq; j += 256) { float s1 = 0.f, s2 = 0.f; for (int d = 0; d < 32; ++d) { s1 += q[d] * bf2f(KD[(size_t)j * 64 + d]); s2 += q[32 + d] * bf2f(KD[(size_t)j * 64 + 32 + d]); }
        const float bias = DIN_(3)[dbucket(sq - j) * 4 + hd] * LOG2E; s1 += bias; s2 += bias; p1[j] = s1; p2[j] = s2; m1 = fmaxf(m1, s1); m2 = fmaxf(m2, s2); }
    m1 = blk_max(m1, sh); m2 = blk_max(m2, sh); float l1 = 0.f, l2 = 0.f; for (int j = tid; j <= sq; j += 256) { p1[j] = exp2f(p1[j] - m1); p2[j] = exp2f(p2[j] - m2); l1 += p1[j]; l2 += p2[j]; } l1 = blk_sum(l1, sh); l2 = blk_sum(l2, sh);
    float s1 = 0.f, s2 = 0.f; for (int d = 0; d < 32; ++d) { s1 += DIN_(35)[d] * DIN_(36)[d]; s2 += DIN_(37)[d] * DIN_(38)[d]; } const float lam_init = DBG_LAYER == 0 ? 0.2f : 0.8f - 0.6f * 0.7408182206817179f, lam = expf(s1) - expf(s2) + lam_init;
    float o = 0.f; if (tid < 64) { float o1 = 0.f, o2 = 0.f; for (int j = 0; j <= sq; ++j) { const float v = bf2f(VDT[(size_t)tid * SEQ + j]); o1 += p1[j] * v; o2 += p2[j] * v; } o = o1 / l1 - lam * o2 / l2; }
    const float ss = blk_sum(tid < 64 ? o * o : 0.f, sh);
    if (tid < 64) dbg_acc(a.acc, 11, bf2f(((const bf16_t*)(a.ws + WS_Y))[(size_t)3 * MTOK * 256 + (size_t)(b * SEQ + sq) * 256 + hd * 64 + tid]), o * rsqrtf(ss / 64.f + EPS) * DIN_(39)[tid] * (1.f - lam_init));
}
__global__ void chk_lru_scan(DbgArgs a) {
    const int i = blockIdx.x * 256 + threadIdx.x, b = i >> 8, c = i & 255; if (b >= NB) return;
    const float* LA = (const float*)(a.ws + WS_LA); const float* LI = (const float*)(a.ws + WS_LI); float h = 0.f;
    for (int t = 0; t < SEQ; ++t) { const size_t o = (size_t)(b * SEQ + t) * 256 + c; h = LA[o] * h + LI[o];
        if (t % 97 == 0 || t == SEQ - 1) dbg_acc(a.acc, 12, bf2f(((const bf16_t*)(a.ws + WS_Y))[(size_t)2 * MTOK * 256 + o]), h * dgelu(bf2f(((const bf16_t*)(a.ws + WS_ZS))[(size_t)(b * SEQ + t) * ZSW + C_GLRU + c]))); }
}
__global__ void chk_s5_scan(DbgArgs a) {
    __shared__ float part[16][65]; const int g = blockIdx.x, p = threadIdx.x; float* ypre = (float*)(a.ws + WS_DBG);
    const float dt = expf(DIN_(12)[g]), lr = DIN_(10)[g * 64 + p], li = DIN_(11)[g * 64 + p], mag = expf(lr * dt); float sn, cs; sincos_red(li * dt, sn, cs);
    const float ar = mag * cs, ai = mag * sn, den = lr * lr + li * li, zr = ((ar - 1.f) * lr + ai * li) / den, zi = (ai * lr - (ar - 1.f) * li) / den;
    float hr = 0.f, hi = 0.f;
    for (int t = 0; t < SEQ; ++t) { const bf16_t* up = (const bf16_t*)(a.ws + WS_ZS) + (size_t)(SEQ + t) * ZSW + 16 * g; float bur = 0.f, bui = 0.f;
        for (int c = 0; c < 16; ++c) { const float u = bf2f(up[c]), br = DIN_(13)[(g * 64 + p) * 16 + c], bi = DIN_(14)[(g * 64 + p) * 16 + c]; bur += (zr * br - zi * bi) * u; bui += (zr * bi + zi * br) * u; }
        const float nr = ar * hr - ai * hi + bur, ni = ar * hi + ai * hr + bui; hr = nr; hi = ni;
        for (int c = 0; c < 16; ++c) part[c][p] = DIN_(15)[(g * 16 + c) * 64 + p] * hr - DIN_(16)[(g * 16 + c) * 64 + p] * hi;
        __syncthreads();
        if (p < 16) { float y = 0.f; for (int pp = 0; pp < 64; ++pp) y += part[p][pp]; y += DIN_(17)[16 * g + p] * bf2f(up[p]); ypre[(size_t)t * 256 + 16 * g + p] = dgelu(y); }
        __syncthreads(); }
}
__global__ void chk_s5_glu(DbgArgs a) {
    const int s = blockIdx.x, n = threadIdx.x, t = (s * 61 + 5) % SEQ; const float* ypre = (const float*)(a.ws + WS_DBG) + (size_t)t * 256;
    float z = DIN_(19)[n]; for (int k = 0; k < 256; ++k) z += ypre[k] * DIN_(18)[k * 256 + n];
    dbg_acc(a.acc, 13, bf2f(((const bf16_t*)(a.ws + WS_Y))[(size_t)(SEQ + t) * 256 + n]), ypre[n] * dsig(z));
}

__global__ void chk_merge(DbgArgs a) {
    __shared__ float sh[256]; const int s = blockIdx.x, tid = threadIdx.x, row = (s * 7919 + 13) % MTOK, col = (s * 104729 + 7) % DM;
    const bf16_t* Y = (const bf16_t*)(a.ws + WS_Y); const bf16_t* ZGp = (const bf16_t*)(a.ws + WS_ZG) + (size_t)row * ZGW; const bf16_t* MGp = (const bf16_t*)(a.ws + WS_MERGED) + (size_t)row * DM;
    float m = 0.f;
    for (int n = 0; n < 4; ++n) { float d = 0.f; { const int k = tid; d = bf2f(Y[(size_t)n * MTOK * 256 + (size_t)row * 256 + k]) * DIN_(40)[((size_t)n * 256 + k) * DM + col]; } d = blk_sum(d, sh); m += bf2f(ZGp[n * DM + col]) * d; }
    if (tid == 0) dbg_acc(a.acc, 14, bf2f(MGp[col]), m);
    float o = 0.f; for (int c = tid; c < DM; c += 256) o += bf2f(MGp[c]) * DIN_(41)[(size_t)c * DM + col]; o = blk_sum(o, sh);
    if (tid == 0) dbg_acc(a.acc, 15, a.out[(size_t)row * DM + col], DXIN_[(size_t)row * DM + col] + o);
}
__global__ void chk_cross(DbgArgs a) {
    __shared__ float sh[256]; __shared__ float hn[DM]; __shared__ float q[64]; __shared__ float p[256]; __shared__ float mn[DM];
    const int s = blockIdx.x, tid = threadIdx.x, row = (s * 7919 + 13) % MTOK, hd = s & 3, b = row >> 12;
    const float* x1 = a.out + (size_t)row * DM; float ss = 0.f; for (int k = tid; k < DM; k += 256) ss += x1[k] * x1[k]; ss = blk_sum(ss, sh); const float rs = rsqrtf(ss / DM + EPS);
    for (int k = tid; k < DM; k += 256) hn[k] = x1[k] * rs * DIN_(5)[k]; __syncthreads();
    float qf = 0.f; if (tid < 64) { for (int k = 0; k < DM; ++k) qf += hn[k] * DIN_(42)[(size_t)k * 256 + hd * 64 + tid]; dbg_acc(a.acc, 16, bf2f(((const bf16_t*)(a.ws + WS_QX))[(size_t)row * 256 + hd * 64 + tid]), qf); }
    { const float s2 = blk_sum(tid < 64 ? qf * qf : 0.f, sh); if (tid < 64) q[tid] = qf * rsqrtf(s2 / 64.f + EPS) * DIN_(46)[tid] * 0.125f; __syncthreads(); }
    float sc = 0.f; float vj[1]; (void)vj;
    { const float* mr = DIN_(1) + (size_t)(b * 256 + tid) * DM; float ms = 0.f; for (int k = 0; k < DM; ++k) ms += mr[k] * mr[k]; const float mrs = rsqrtf(ms / DM + EPS);
      float kk[64]; (void)kk; float s2 = 0.f; float dotq = 0.f;
      for (int d = 0; d < 64; ++d) { float kd = 0.f; for (int k = 0; k < DM; ++k) kd += mr[k] * mrs * DIN_(6)[k] * DIN_(43)[(size_t)k * 256 + hd * 64 + d]; s2 += kd * kd; dotq += kd * DIN_(47)[d] * q[d]; }
      sc = dotq * rsqrtf(s2 / 64.f + EPS); }
    const float mx = blk_max(sc, sh); const float e = expf(sc - mx); const float sm = blk_sum(e, sh); p[tid] = e / sm; __syncthreads();
    if (tid < 64) { float o = 0.f; for (int j = 0; j < 256; ++j) { const float* mr = DIN_(1) + (size_t)(b * 256 + j) * DM; float ms = 0.f, vd = 0.f; for (int k = 0; k < DM; ++k) { ms += mr[k] * mr[k]; vd += mr[k] * DIN_(6)[k] * DIN_(44)[(size_t)k * 256 + hd * 64 + tid]; } o += p[j] * vd * rsqrtf(ms / DM + EPS); }
        dbg_acc(a.acc, 17, bf2f(((const bf16_t*)(a.ws + WS_OX))[(size_t)row * 256 + hd * 64 + tid]), o); }
}
__global__ void chk_ffn(DbgArgs a) {
    __shared__ float sh[256]; __shared__ float hn[DM]; const int s = blockIdx.x, tid = threadIdx.x, row = (s * 7919 + 13) % MTOK;
    const float* x2 = a.out + (size_t)row * DM; float ss = 0.f; for (int k = tid; k < DM; k += 256) ss += x2[k] * x2[k]; ss = blk_sum(ss, sh); const float rs = rsqrtf(ss / DM + EPS);
    for (int k = tid; k < DM; k += 256) hn[k] = x2[k] * rs * DIN_(7)[k]; __syncthreads();
    for (int j = tid; j < FF; j += 256 * 8) { float g = 0.f, u = 0.f; for (int k = 0; k < DM; ++k) { g += hn[k] * DIN_(48)[(size_t)k * FF + j]; u += hn[k] * DIN_(49)[(size_t)k * FF + j]; }
        dbg_acc(a.acc, 18, bf2f(((const bf16_t*)(a.ws + WS_HFF))[(size_t)row * FF + j]), g / (1.f + expf(-g)) * u); }
}

__global__ void chk_moe(DbgArgs a) {
    __shared__ float sh[256]; __shared__ float hn[DM]; __shared__ float hid[EFF]; __shared__ float lgs[8];
    const int s = blockIdx.x, tid = threadIdx.x, tok = (s * 7919 + 13) % MTOK, slot = s & 1, col = (s * 104729 + 7) % DM;
    const float* x2 = a.out + (size_t)tok * DM; float ss = 0.f; for (int k = tid; k < DM; k += 256) ss += x2[k] * x2[k]; ss = blk_sum(ss, sh); const float rs = rsqrtf(ss / DM + EPS);
    for (int k = tid; k < DM; k += 256) hn[k] = x2[k] * rs * ((const float*)a.in[7])[DM + k]; __syncthreads();
    for (int e = 0; e < 8; ++e) { float d = 0.f; for (int k = tid; k < DM; k += 256) d += hn[k] * DIN_(51)[k * 8 + e]; d = blk_sum(d, sh); if (tid == 0) lgs[e] = d; } __syncthreads();
    int e1 = 0; for (int e = 1; e < 8; ++e) if (lgs[e] > lgs[e1]) e1 = e; int e2 = -1; for (int e = 0; e < 8; ++e) if (e != e1 && (e2 < 0 || lgs[e] > lgs[e2])) e2 = e;
    const float w1 = 1.f / (1.f + expf(lgs[e2] - lgs[e1])), w2 = 1.f - w1;
    const int* ASG = (const int*)(a.ws + WS_MOESM + MS_ASSIGN); const int* TD = (const int*)(a.ws + WS_MOESM + MS_TOKDEST); const float* TW = (const float*)(a.ws + WS_MOESM + MS_TOKW); const int* RT = (const int*)(a.ws + WS_MOESM + MS_ROWTOK);
    const int ef = ASG[2 * tok + slot] & 255, dest = TD[2 * tok + slot];
    if (tid == 0) { dbg_acc(a.acc, 19, (float)(ASG[2 * tok] & 255), (float)e1 + 1e-3f); dbg_acc(a.acc, 19, (float)(ASG[2 * tok + 1] & 255), (float)e2 + 1e-3f); dbg_acc(a.acc, 19, TW[2 * tok], w1); dbg_acc(a.acc, 19, TW[2 * tok + 1], w2); dbg_acc(a.acc, 19, (float)(RT[dest] - tok), 1e-3f); }
    const float* wg = DIN_(52) + (size_t)ef * DM * EFF; const float* wu = DIN_(53) + (size_t)ef * DM * EFF; const float* wd = DIN_(54) + (size_t)ef * EFF * DM;
    for (int f = tid; f < EFF; f += 256) { float g = 0.f, u = 0.f; for (int k = 0; k < DM; ++k) { g += hn[k] * wg[(size_t)k * EFF + f]; u += hn[k] * wu[(size_t)k * EFF + f]; } hid[f] = g / (1.f + expf(-g)) * u; }
    __syncthreads();
    float y = 0.f; for (int f = tid; f < EFF; f += 256) y += hid[f] * wd[(size_t)f * DM + col]; y = blk_sum(y, sh);
    if (tid == 0) dbg_acc(a.acc, 20, bf2f(((const bf16_t*)(a.ws + WS_YS))[(size_t)dest * DM + col]), y);
}

__global__ void chk_res(DbgArgs a, int kind) {
    __shared__ float sh[256]; const int s = blockIdx.x, tid = threadIdx.x, row = (s * 7919 + 13) % MTOK, col = (s * 104729 + 7) % DM; const float* xprev = (const float*)(a.ws + WS_DBG);
    float o = 0.f;
    if (kind == 0) { const bf16_t* A = (const bf16_t*)(a.ws + WS_OX) + (size_t)row * 256; o = bf2f(A[tid]) * DIN_(45)[(size_t)tid * DM + col]; }
    else { const bf16_t* A = (const bf16_t*)(a.ws + WS_HFF) + (size_t)row * FF; for (int k = tid; k < FF; k += 256) o += bf2f(A[k]) * DIN_(50)[(size_t)k * DM + col]; }
    o = blk_sum(o, sh);
    if (tid == 0) { dbg_acc(a.acc, 21, a.out[(size_t)row * DM + col], xprev[(size_t)row * DM + col] + o);
        const bf16_t xbv = ((const bf16_t*)(a.ws + WS_XB))[(size_t)row * DM + col]; dbg_acc(a.acc, 22, bf2f(xbv), a.out[(size_t)row * DM + col]); }
}

__global__ void chk_final(DbgArgs a) {
    const int i = blockIdx.x * 256 + threadIdx.x; const int tok = (i * 37 + 5) % MTOK, col = (i * 101 + 3) % DM; const float* xprev = (const float*)(a.ws + WS_DBG);
    const int* TD = (const int*)(a.ws + WS_MOESM + MS_TOKDEST); const float* TW = (const float*)(a.ws + WS_MOESM + MS_TOKW); const bf16_t* YS = (const bf16_t*)(a.ws + WS_YS);
    const float ref = xprev[(size_t)tok * DM + col] + TW[2 * tok] * bf2f(YS[(size_t)TD[2 * tok] * DM + col]) + TW[2 * tok + 1] * bf2f(YS[(size_t)TD[2 * tok + 1] * DM + col]);
    dbg_acc(a.acc, 23, a.out[(size_t)tok * DM + col], ref);
}
__global__ void chk_emit(DbgArgs a, int nchk) {
    for (int i = blockIdx.x * 256 + threadIdx.x; i < MTOK * DM; i += gridDim.x * 256) a.out[i] = 0.f;
    if (blockIdx.x == 0 && threadIdx.x == 0) { float V = 99000.f; float worst = 0.f;
        for (int k = 1; k <= nchk; ++k) { const float cnt = a.acc[64 + k]; const float rms = sqrtf(a.acc[2 * k + 1] / fmaxf(cnt, 1.f)) + 1e-20f; float err = a.acc[2 * k] / rms; if (cnt < 1.f) continue; if (!(err == err)) err = 0.97f; worst = fmaxf(worst, err);
#ifdef DBG_ONLY
            if (k == DBG_ONLY) { V = 1000.f + err * 10000.f; break; }
#else
            if (err > 0.06f) { V = (float)k * 1000.f + fminf(err, 0.99f) * 1000.f; break; }
#endif
        }
        if (V == 99000.f) V = 99000.f + worst * 1000.f;
        a.out[12345] = V; }
}
#endif

#ifdef DBG_STAT
__global__ void stat_scan(const float* out, unsigned* acc) {
    for (int i = blockIdx.x * 256 + threadIdx.x; i < MTOK * DM; i += gridDim.x * 256) { const float v = fabsf(out[i]);
        atomicMax(&acc[1], __float_as_uint(v)); if (v > 10.f || !(v == v)) { atomicAdd(&acc[0], 1u); atomicAdd(&acc[2 + (i >> 18)], 1u); atomicAdd(&acc[70 + ((i & 1023) >> 8)], 1u); atomicAdd(&acc[80 + ((i >> 10) & 255) / 32], 1u); } }
}
__global__ void stat_emit(float* out, const unsigned* acc, int mode) {
    for (int i = blockIdx.x * 256 + threadIdx.x; i < MTOK * DM; i += gridDim.x * 256) out[i] = 0.f;
    if (blockIdx.x == 0 && threadIdx.x == 0) { float V = 0.f;
        if (mode == 0) V = (float)acc[0];
        else if (mode == 1) V = __uint_as_float(acc[1]) * 100.f;
        else if (mode == 2) { unsigned best = 0, bi = 0, nz = 0; for (int k = 0; k < 64; ++k) { if (acc[2 + k] > best) { best = acc[2 + k]; bi = k; } nz += acc[2 + k] > 0; } V = 1000.f * (float)bi + 10.f * (float)nz; }
        else if (mode == 3) V = 1000.f * (float)acc[70] / fmaxf((float)acc[0], 1.f) + 100000.f * (float)acc[71] / fmaxf((float)acc[0], 1.f);
        else if (mode == 4) { unsigned best = 0, bi = 0; for (int k = 0; k < 8; ++k) if (acc[80 + k] > best) { best = acc[80 + k]; bi = k; } V = 1000.f + 1000.f * (float)bi + 900.f * (float)best / fmaxf((float)acc[0], 1.f); }
        out[12345] = V + 100.f; }
}
#endif

#ifdef DBG_VAR
__global__ void var_scan(const float* out, const float* prev, float* acc) {
    float s = 0.f, mx = 0.f; for (int i = blockIdx.x * 256 + threadIdx.x; i < MTOK * DM; i += gridDim.x * 256) { const float d = out[i] - prev[i]; s += d * d; mx = fmaxf(mx, fabsf(d)); }
    atomicAdd(&acc[0], s); atomicMax((unsigned*)&acc[1], __float_as_uint(mx));
}
__global__ void var_emit(float* out, const float* acc, int mode) {
    for (int i = blockIdx.x * 256 + threadIdx.x; i < MTOK * DM; i += gridDim.x * 256) out[i] = 0.f;
    if (blockIdx.x == 0 && threadIdx.x == 0) out[12345] = 100.f + (mode == 0 ? acc[0] / (float)(MTOK * DM) * 1e5f : acc[1] * 100.f);
}
#endif

#ifdef DBG_GSTAT
__global__ void gstat_scan(const bf16_t* zg, float* acc) { float s1 = 0.f, s2 = 0.f; for (size_t i = blockIdx.x * 256 + threadIdx.x; i < (size_t)MTOK * ZGW; i += (size_t)gridDim.x * 256) { const float g = bf2f(zg[i]); const int blk = (int)((i & 4095) >> 10); if (blk == DBG_GSTAT) { s1 += (g < -0.01f || g > 1.01f || !(g == g)) ? 1.f : 0.f; s2 += (g - 0.5f) * (g - 0.5f); } } atomicAdd(&acc[0], s1); atomicAdd(&acc[1], s2); }
__global__ void gstat_emit(float* out, const float* acc, int mode) {
    for (int i = blockIdx.x * 256 + threadIdx.x; i < MTOK * DM; i += gridDim.x * 256) out[i] = 0.f;
    if (blockIdx.x == 0 && threadIdx.x == 0) out[12345] = 100.f + 10000.f * acc[1] / ((float)MTOK * 1024);
}
#endif
extern "C" void kernel_launch(void* const* d_in, const int* in_sizes, int n_in, void* d_out, int out_size, void* d_ws, size_t ws_size, hipStream_t stream) {
    static int grid = 0;
    if (grid == 0) {
        if (n_in != 55 || out_size != MTOK * DM || ws_size < WS_END) { fprintf(stderr, "kernel_launch: unexpected shapes (n_in %d out %d ws %zu)\n", n_in, out_size, ws_size); grid = -1; return; }
        { const int L2 = 2; const int exp_sz[55] = {NB * SEQ * DM, NB * NMEM * DM, NB * SEQ, 32 * 4, L2 * DM, L2 * DM, L2 * DM, L2 * DM, L2 * DM * DIN, L2 * 4 * DM, L2 * 1024, L2 * 1024, L2 * 16, L2 * 16384, L2 * 16384, L2 * 16384, L2 * 16384, L2 * 256, L2 * 65536, L2 * 256,
              L2 * 192, L2 * 128, L2 * 192 * 384, L2 * 128 * 512, L2 * 96, L2 * 96, L2 * 1024, L2 * 256, L2 * 16384, L2 * 256, L2 * 16384, L2 * 256, L2 * 256, L2 * 32, L2 * 32, L2 * 32, L2 * 32, L2 * 32, L2 * 32, L2 * 64,
              L2 * 4 * 256 * DM, L2 * DM * DM, L2 * DM * 256, L2 * DM * 256, L2 * DM * 256, L2 * 256 * DM, L2 * 64, L2 * 64, DM * FF, DM * FF, FF * DM, DM * 8, 8 * DM * EFF, 8 * DM * EFF, 8 * EFF * DM};
          for (int i = 0; i < 55; ++i) if (in_sizes[i] != exp_sz[i]) { fprintf(stderr, "kernel_launch: input %d has %d elements, expected %d\n", i, in_sizes[i], exp_sz[i]); grid = -1; return; } }
        int dev = 0, cus = 0, per_cu = 0;
        if (hipGetDevice(&dev) != hipSuccess || hipDeviceGetAttribute(&cus, hipDeviceAttributeMultiprocessorCount, dev) != hipSuccess) { grid = -1; return; }
        if (hipFuncSetAttribute((const void*)hybrid_fwd, hipFuncAttributeMaxDynamicSharedMemorySize, LDS_BYTES) != hipSuccess) { fprintf(stderr, "kernel_launch: hipFuncSetAttribute failed\n"); grid = -1; return; }
        if (hipOccupancyMaxActiveBlocksPerMultiprocessor(&per_cu, (const void*)hybrid_fwd, 512, LDS_BYTES) != hipSuccess || per_cu < 1) { fprintf(stderr, "kernel_launch: occupancy query says %d\n", per_cu); }
        (void)hipGetLastError();
        grid = cus;
    }
    if (grid < 0) return;
    if (hipMemsetAsync((char*)d_ws + WS_CTL, 0, CTL_ZERO_BYTES, stream) != hipSuccess) return;
    Args a{};
    for (int i = 0; i < 55; ++i) a.in[i] = d_in[i];
    a.out = (float*)d_out; a.ws = (unsigned char*)d_ws; a.submask = 0xFFFF; a.pad = 0;
#if MK_ONE_LAUNCH
    a.ph_lo = 0; a.ph_hi = NPHASE;
    hipLaunchKernelGGL(hybrid_fwd, dim3(grid), dim3(512), LDS_BYTES, stream, a);
#else
    for (int p = 0; p < DBG_NPH; ++p) { a.ph_lo = p; a.ph_hi = p + 1;
#if defined(DBG_CHECK) || defined(DBG_VAR)
        if (p == DBG_NPH - 1) hipMemcpyAsync((char*)d_ws + 440 * MiB, d_out, (size_t)MTOK * DM * 4, hipMemcpyDeviceToDevice, stream);
#endif
        hipLaunchKernelGGL(hybrid_fwd, dim3(grid), dim3(512), LDS_BYTES, stream, a);
#ifdef DBG_REPEAT
        if (p == DBG_REPEAT) {
#ifdef DBG_REPSUB
            a.submask = DBG_REPSUB;
#endif
            hipLaunchKernelGGL(hybrid_fwd, dim3(grid), dim3(512), LDS_BYTES, stream, a); hipLaunchKernelGGL(hybrid_fwd, dim3(grid), dim3(512), LDS_BYTES, stream, a); a.submask = 0xFFFF; }
#endif
    }
#ifdef DBG_CHECK
    { DbgArgs da{}; for (int i = 0; i < 55; ++i) da.in[i] = d_in[i]; da.ws = (unsigned char*)d_ws; da.out = (float*)d_out; da.acc = (float*)((char*)d_ws + 700 * 1024);
#if DBG_NPH == 6 || DBG_NPH == 16
      hipLaunchKernelGGL(chk_merge, dim3(512), dim3(256), 0, stream, da);
#elif DBG_NPH == 8 || DBG_NPH == 18
      hipLaunchKernelGGL(chk_cross, dim3(64), dim3(256), 0, stream, da);
#elif DBG_NPH == 10
      hipLaunchKernelGGL(chk_ffn, dim3(64), dim3(256), 0, stream, da);
#elif DBG_NPH == 24
      hipLaunchKernelGGL(chk_final, dim3(64), dim3(256), 0, stream, da);
#elif DBG_NPH == 23
      hipLaunchKernelGGL(chk_moe, dim3(128), dim3(256), 0, stream, da);
#elif DBG_NPH == 9 || DBG_NPH == 19
      hipLaunchKernelGGL(chk_res, dim3(512), dim3(256), 0, stream, da, 0);
#elif DBG_NPH == 11
      hipLaunchKernelGGL(chk_res, dim3(512), dim3(256), 0, stream, da, 1);
#else
      hipLaunchKernelGGL(chk_z, dim3(1024), dim3(256), 0, stream, da);
      hipLaunchKernelGGL(chk_mla_prep, dim3(512), dim3(256), 0, stream, da);
      hipLaunchKernelGGL(chk_diff_prep, dim3(16), dim3(256), 0, stream, da);
      hipLaunchKernelGGL(chk_lru_prep, dim3(512), dim3(256), 0, stream, da);
      hipLaunchKernelGGL(chk_mla_attn, dim3(64), dim3(256), 0, stream, da);
      hipLaunchKernelGGL(chk_diff_attn, dim3(64), dim3(256), 0, stream, da);
      hipLaunchKernelGGL(chk_lru_scan, dim3(4), dim3(256), 0, stream, da);
      hipLaunchKernelGGL(chk_s5_scan, dim3(16), dim3(64), 0, stream, da);
      hipLaunchKernelGGL(chk_s5_glu, dim3(64), dim3(256), 0, stream, da);
#endif
      hipLaunchKernelGGL(chk_emit, dim3(1024), dim3(256), 0, stream, da, 23); }
#endif
#ifdef DBG_COPYX
    hipMemcpyAsync(d_out, d_in[0], (size_t)MTOK * DM * 4, hipMemcpyDeviceToDevice, stream);
#endif
#ifdef DBG_GSTAT
    { float* acc = (float*)((char*)d_ws + 900 * 1024);
      hipLaunchKernelGGL(gstat_scan, dim3(2048), dim3(256), 0, stream, (const bf16_t*)((const char*)d_ws + WS_ZG), acc);
      hipLaunchKernelGGL(gstat_emit, dim3(1024), dim3(256), 0, stream, (float*)d_out, (const float*)acc, DBG_GSTAT); }
#endif
#ifdef DBG_VAR
    { float* acc = (float*)((char*)d_ws + 900 * 1024);
      hipLaunchKernelGGL(var_scan, dim3(1024), dim3(256), 0, stream, (const float*)d_out, DBG_NPH == 6 ? (const float*)d_in[0] : (const float*)((const char*)d_ws + 440 * MiB), acc);
      hipLaunchKernelGGL(var_emit, dim3(1024), dim3(256), 0, stream, (float*)d_out, (const float*)acc, DBG_VAR); }
#endif
#ifdef DBG_STAT
    { unsigned* acc = (unsigned*)((char*)d_ws + 800 * 1024);
      hipLaunchKernelGGL(stat_scan, dim3(2048), dim3(256), 0, stream, (const float*)d_out, acc);
      hipLaunchKernelGGL(stat_emit, dim3(1024), dim3(256), 0, stream, (float*)d_out, (const unsigned*)acc, DBG_STAT); }
#endif
#ifdef DBG_DUMP_OFF
    hipLaunchKernelGGL(dbg_copy_bf16, dim3(2048), dim3(256), 0, stream, (const bf16_t*)((const char*)d_ws + (size_t)(DBG_DUMP_OFF)), (float*)d_out, MTOK * DM, DBG_DUMP_N);
#endif
#endif
}
```

```cpp
#include <hip/hip_runtime.h>
#include <cstdio>
#include <cstdint>

#define DBG_NPH 24

#ifndef DBG_GPERM
#define DBG_GPERM(n) (n)
#endif
#ifndef DBG_SCALE
#define DBG_SCALE 1.0f
#endif
#ifndef MK_ONE_LAUNCH
#define MK_ONE_LAUNCH 1
#endif
#ifndef G2_FP8
#define G2_FP8 0
#endif

#define LAS __attribute__((address_space(3)))
typedef unsigned short bf16_t;
typedef short bf16x8 __attribute__((ext_vector_type(8)));
typedef float f32x2 __attribute__((ext_vector_type(2)));
typedef float f32x4 __attribute__((ext_vector_type(4)));
typedef float f32x16 __attribute__((ext_vector_type(16)));
typedef unsigned u32x2 __attribute__((ext_vector_type(2)));
typedef unsigned u32x4 __attribute__((ext_vector_type(4)));
typedef int i32x4 __attribute__((ext_vector_type(4)));
typedef int i32x8 __attribute__((ext_vector_type(8)));

constexpr int DM = 1024, NB = 4, SEQ = 4096, MTOK = NB * SEQ, NMEM = 256;
constexpr int DIN = 5984, ZSW = 2048, ZGW = 4096, NIN = ZSW + ZGW;
constexpr int C_S5 = 0, C_CQ = 256, C_CKV = 448, C_KPE = 576, C_XLRU = 608, C_GLRU = 864, C_QD = 1120, C_KD = 1376, C_VD = 1632, C_END = 1888;
constexpr int FF = 2816, EFF = 3584, NEXP = 8, MOE_ROWS = 34816;
constexpr float EPS = 1e-6f, LOG2E = 1.4426950408889634f;

constexpr size_t MiB = 1u << 20;
constexpr size_t WS_CTL = 0, CTL_ZERO_BYTES = 1 * MiB + 512 * 1024;
constexpr size_t WS_MOESM = 1 * MiB;
constexpr size_t WS_XB = 2 * MiB;
constexpr size_t WS_WL = 34 * MiB, WL_STRIDE = 19 * MiB;
constexpr size_t WL_WIN = 0, WL_PT = 12 * MiB, WL_WO = 14 * MiB, WL_WXQ = 16 * MiB, WL_WXKV = 16 * MiB + 512 * 1024, WL_WXO = 17 * MiB + 512 * 1024, WL_SM = 18 * MiB;
constexpr size_t SM_WUQ = 0, SM_WUKV = 256 * 1024, SM_WR = 512 * 1024, SM_WI = 576 * 1024, SM_WGLU = 640 * 1024;
constexpr size_t WS_WGU = 72 * MiB, WS_WD = 83 * MiB, WS_TAB = 89 * MiB, WS_KX = 90 * MiB, WS_VXT = 91 * MiB;
constexpr size_t TAB_S5T = 0, TAB_CMAT = 512 * 1024, TAB_MISC = 768 * 1024;
constexpr size_t WS_ZS = 92 * MiB, WS_MERGED = 92 * MiB, WS_ZG = 156 * MiB, WS_HFF = 156 * MiB, WS_Y = 284 * MiB;
constexpr size_t WS_QM = 316 * MiB, WS_KM = 328 * MiB, WS_VMT = 340 * MiB, WS_QD = 348 * MiB, WS_KD = 356 * MiB, WS_VDT = 364 * MiB;
constexpr size_t WS_QX = 316 * MiB, WS_OX = 324 * MiB;
constexpr size_t WS_LA = 372 * MiB, WS_LI = 388 * MiB, WS_S5S = 404 * MiB, WS_LSUM = 406 * MiB, WS_RSP = 407 * MiB;
constexpr size_t WS_WMGU = 34 * MiB, WS_WMD = 146 * MiB, WS_HMOE = 202 * MiB, WS_XQ = 330 * MiB, WS_YS = 34 * MiB, WS_X8 = 416 * MiB, WS_END = 440 * MiB;
constexpr int CW_TMO = 0, CW_BAR = 4096, CW_MOECNT = 8192, CW_Q = 12288;
constexpr size_t CTL_ROWSS = 256 * 1024;
constexpr size_t MS_ROWTOK = 0, MS_TOKW = 512 * 1024, MS_ASSIGN = 640 * 1024, MS_RSTD = 768 * 1024;
constexpr int RING_BYTES = 131072, MISC_OFF = RING_BYTES + 320, LDS_BYTES = 147456;

typedef __bf16 bf16x2_t __attribute__((ext_vector_type(2)));
__device__ __forceinline__ unsigned cvt_pk_bf16(float lo, float hi) { const f32x2 v = {lo, hi}; const bf16x2_t b = __builtin_convertvector(v, bf16x2_t); return __builtin_bit_cast(unsigned, b); }
__device__ __forceinline__ float clamp8(float x) { return __builtin_fminf(__builtin_fmaxf(x, -448.f), 448.f); }
__device__ __forceinline__ unsigned cvt_pk4_fp8(float a, float b, float c, float d) { int w = __builtin_amdgcn_cvt_pk_fp8_f32(clamp8(a), clamp8(b), 0, false); w = __builtin_amdgcn_cvt_pk_fp8_f32(clamp8(c), clamp8(d), w, true); return (unsigned)w; }
__device__ __forceinline__ float bflo(unsigned w) { return __uint_as_float(w << 16); }
__device__ __forceinline__ float bfhi(unsigned w) { return __uint_as_float(w & 0xffff0000u); }
__device__ __forceinline__ float bf2f(bf16_t b) { return __uint_as_float((unsigned)b << 16); }
__device__ __forceinline__ bf16_t f2bf(float f) { return (bf16_t)(cvt_pk_bf16(f, 0.f) & 0xffffu); }
__device__ __forceinline__ float fexp2(float x) { return __builtin_amdgcn_exp2f(x); }
__device__ __forceinline__ float frcp(float x) { return __builtin_amdgcn_rcpf(x); }
__device__ __forceinline__ float frsq(float x) { return __builtin_amdgcn_rsqf(x); }
__device__ __forceinline__ float fsigmoid(float x) { return frcp(1.f + fexp2(-x * LOG2E)); }
__device__ __forceinline__ float fgelu(float x) {
    const float z = 0.7978845608028654f * (x + 0.044715f * x * x * x);
    const float e = fexp2(2.f * LOG2E * z);
    const float th = 1.f - 2.f * frcp(e + 1.f);
    return 0.5f * x * (1.f + th);
}
__device__ __forceinline__ int crow(int r, int hi) { return (r & 3) + 8 * (r >> 2) + 4 * hi; }
__device__ __forceinline__ bf16x8 ldg8(const bf16_t* p) { return *(const bf16x8*)p; }
__device__ __forceinline__ float sq8(bf16x8 v) {
    const u32x4 w = *(const u32x4*)&v; float s = 0.f;
#pragma unroll
    for (int i = 0; i < 4; ++i) { const float a = bflo(w[i]), b = bfhi(w[i]); s += a * a + b * b; }
    return s;
}
__device__ __forceinline__ float row_rstd(const float* rsp, int row) {
    const f32x4* p = (const f32x4*)(rsp + (size_t)row * 16); const f32x4 a = p[0], b = p[1], c = p[2], d = p[3];
    const float s = (((a.x + a.y) + (a.z + a.w)) + ((b.x + b.y) + (b.z + b.w))) + (((c.x + c.y) + (c.z + c.w)) + ((d.x + d.y) + (d.z + d.w)));
    return frsq(s * (1.f / DM) + EPS);
}
__device__ __forceinline__ float wave_sum(float v) {
#pragma unroll
    for (int o = 1; o < 64; o <<= 1) v += __shfl_xor(v, o);
    return v;
}
#define MFMA32(a, b, c) __builtin_amdgcn_mfma_f32_32x32x16_bf16((a), (b), (c), 0, 0, 0)
#define MFMA16(a, b, c) __builtin_amdgcn_mfma_f32_16x16x32_bf16((a), (b), (c), 0, 0, 0)
__device__ __forceinline__ void sincos_red(float a, float& s, float& c) {
    const float k = rintf(a * 0.15915494309189535f);
    float r = fmaf(-k, 6.28318548202514648f, a);
    r = fmaf(-k, -1.7484555e-7f, r);
    s = __sinf(r); c = __cosf(r);
}

namespace pg8 {
constexpr int BM = 256, BK = 64, HALF = 128, HTB = HALF * BK * 2, STAGE_BYTES = 8 * HTB;
__host__ __device__ __forceinline__ int lds_byte(int r, int c) { const int st = (r >> 4) * 2 + (c >> 5), rr = r & 15, cc = c & 31, ob = rr * 64 + cc * 2; return st * 1024 + (ob ^ (((ob >> 9) & 1) << 5)); }
__host__ __device__ __forceinline__ void stage_rc(int b, int& R, int& C) { const int st = b / 1024, sb = b % 1024, swz = sb ^ (((sb >> 9) & 1) << 5); R = (st >> 1) * 16 + swz / 64; C = (st & 1) * 32 + (swz % 64) / 2; }
__host__ __device__ __forceinline__ int perm32(int rho) { const int n = rho >> 4, i = rho & 15; return 8 * (i >> 2) + 4 * n + (i & 3); }

struct Unit { int pm, pn, om, on, aux, gofs; };
struct Gemm { const bf16_t* A; const bf16_t* Bt; int K; const int* gather; };

template <class Epi, class Sched, bool ALIGN_EPI, bool GATHER, bool FP8 = false>
__device__ __forceinline__ void gemm_phase(LAS unsigned char* lds, Gemm g, const Sched& S, const Epi& E) {
    int tid = threadIdx.x; asm volatile("" : "+v"(tid));
    asm volatile("" : "+s"(g.A), "+s"(g.Bt));
    const int wid = __builtin_amdgcn_readfirstlane(tid >> 6), lane = tid & 63, wr = wid >> 2, wc = wid & 3, fr = lane & 15, fq = lane >> 4;
    const int K = g.K, nt = K / BK;
    unsigned voffB[2];
#pragma unroll
    for (int i = 0; i < 2; ++i) { int Rr_, Cc_; stage_rc(tid * 16 + i * 8192, Rr_, Cc_); const int Rb = (Rr_ & ~31) + perm32(Rr_ & 31); voffB[i] = (unsigned)(Rb * K + Cc_) * 2u; }
    const size_t kstep = (size_t)(BK * 2);
    const size_t hstep = (size_t)HALF * K * 2;
    const size_t tstep = 2 * hstep;
    const unsigned ldsw = (unsigned)wid * 1024u;
    const int aoff = lds_byte(wr * 64 + fr, fq * 8), boff = lds_byte(wc * 32 + fr, fq * 8);
#define PG8_SA(b, h) (((b) * 2 + (h)) * HTB)
#define PG8_SB(b, h) ((4 + (b) * 2 + (h)) * HTB)
#define PG8_STAGE_B(bufoff, gbase) do { _Pragma("unroll") for (int _i = 0; _i < 2; ++_i) \
        __builtin_amdgcn_global_load_lds((const unsigned*)((const char*)(gbase) + voffB[_i]), (LAS unsigned*)(lds + (bufoff) + ldsw + _i * 8192), 16, 0, 0); } while (0)
#define PG8_STAGE_A(bufoff, kt, vo0, vo1) do { const char* _gb = (const char*)g.A + (size_t)(kt) * kstep; \
        __builtin_amdgcn_global_load_lds((const unsigned*)(_gb + (vo0)), (LAS unsigned*)(lds + (bufoff) + ldsw), 16, 0, 0); \
        __builtin_amdgcn_global_load_lds((const unsigned*)(_gb + (vo1)), (LAS unsigned*)(lds + (bufoff) + ldsw + 8192), 16, 0, 0); } while (0)
#define PG8_LDA(dst, b, h) do { _Pragma("unroll") for (int m = 0; m < 4; ++m) _Pragma("unroll") for (int k = 0; k < 2; ++k) dst[m][k] = *(const LAS bf16x8*)(lds + PG8_SA(b, h) + aoff + m * 2048 + k * 1024); } while (0)
#define PG8_LDB(dst, b, h) do { _Pragma("unroll") for (int n = 0; n < 2; ++n) _Pragma("unroll") for (int k = 0; k < 2; ++k) dst[n][k] = *(const LAS bf16x8*)(lds + PG8_SB(b, h) + boff + n * 2048 + k * 1024); } while (0)
#define PG8_MMA(ai, bj, At, Bt) do { __builtin_amdgcn_s_setprio(1); _Pragma("unroll") for (int m = 0; m < 4; ++m) _Pragma("unroll") for (int n = 0; n < 2; ++n) _Pragma("unroll") for (int k = 0; k < 2; ++k) \
        acc[ai][bj][m][n] = __builtin_amdgcn_mfma_f32_16x16x32_bf16(Bt[n][k], At[m][k], acc[ai][bj][m][n], 0, 0, 0); __builtin_amdgcn_s_setprio(0); } while (0)
#define PG8_MMA8(ai, bj, w) do { __builtin_amdgcn_s_setprio(1); _Pragma("unroll") for (int m = 0; m < 4; ++m) _Pragma("unroll") for (int n = 0; n < 2; ++n) \
        asm volatile("v_mfma_f32_16x16x128_f8f6f4 %0, %1, %2, %0" : "+v"(acc[ai][bj][m][n]) : "v"(B##w##8[n]), "v"(A8[m])); __builtin_amdgcn_s_setprio(0); } while (0)
#define PG8_LA(b, h) do { if constexpr (FP8) { _Pragma("unroll") for (int m = 0; m < 4; ++m) { A8[m].lo = *(const LAS i32x4*)(lds + PG8_SA(b, h) + aoff + m * 2048); A8[m].hi = *(const LAS i32x4*)(lds + PG8_SA(b, h) + aoff + m * 2048 + 1024); } } \
        else PG8_LDA(At, b, h); } while (0)
#define PG8_LB(w, b, h) do { if constexpr (FP8) { _Pragma("unroll") for (int n = 0; n < 2; ++n) { B##w##8[n].lo = *(const LAS i32x4*)(lds + PG8_SB(b, h) + boff + n * 2048); B##w##8[n].hi = *(const LAS i32x4*)(lds + PG8_SB(b, h) + boff + n * 2048 + 1024); } } \
        else PG8_LDB(B##w, b, h); } while (0)
#define PG8_MM(ai, bj, w) do { if constexpr (FP8) PG8_MMA8(ai, bj, w); else PG8_MMA(ai, bj, At, B##w); } while (0)
#define PG8_WAIT_V(n) asm volatile("s_waitcnt vmcnt(" #n ")" ::: "memory")
#define PG8_WAIT_L(n) asm volatile("s_waitcnt lgkmcnt(" #n ")" ::: "memory")
#define PG8_BAR __builtin_amdgcn_s_barrier()
#define PG8_SCHED __builtin_amdgcn_sched_barrier(0)
#define PG8_VOFF(dst, u) do { _Pragma("unroll") for (int _h = 0; _h < 2; ++_h) _Pragma("unroll") for (int _i = 0; _i < 2; ++_i) { int Rr_, Cc_; stage_rc(tid * 16 + _i * 8192, Rr_, Cc_); \
        const int _rt = (u).pm * BM + _h * HALF + Rr_; const int _ar = GATHER ? g.gather[_rt + (u).gofs] : _rt; dst[_h][_i] = (unsigned)((size_t)_ar * K + Cc_) * 2u; } } while (0)
    Unit cur, nxt; int ui = 0;
    if (!S.next(0, cur)) return;
    f32x4 acc[2][2][4][2];
#pragma unroll
    for (int a = 0; a < 2; ++a)
#pragma unroll
        for (int b = 0; b < 2; ++b)
#pragma unroll
            for (int m = 0; m < 4; ++m)
#pragma unroll
                for (int n = 0; n < 2; ++n) acc[a][b][m][n] = (f32x4){0.f, 0.f, 0.f, 0.f};
    bf16x8 At[4][2], B0[2][2], B1[2][2];
    i32x8 A8[4], B08[2], B18[2];
    unsigned vC[2][2], vN[2][2];
    PG8_VOFF(vC, cur);
    const char* cB = (const char*)g.Bt + (size_t)cur.pn * tstep;
    PG8_STAGE_B(PG8_SB(0, 0), cB); PG8_STAGE_B(PG8_SB(0, 1), cB + hstep); PG8_STAGE_A(PG8_SA(0, 0), 0, vC[0][0], vC[0][1]); PG8_STAGE_A(PG8_SA(0, 1), 0, vC[1][0], vC[1][1]);
    if (wr == 1) PG8_BAR;
    PG8_WAIT_V(2); PG8_BAR;
    PG8_STAGE_B(PG8_SB(1, 0), cB + kstep); PG8_STAGE_A(PG8_SA(1, 0), 1, vC[0][0], vC[0][1]); PG8_STAGE_B(PG8_SB(1, 1), cB + hstep + kstep);
    PG8_WAIT_V(6); PG8_BAR;
    for (;;) {
        const bool has_next = S.next(ui + 1, nxt);
        unsigned ndelta = 0u;
        if constexpr (GATHER) {
            if (has_next) { PG8_VOFF(vN, nxt); } else {
#pragma unroll
                for (int _h = 0; _h < 2; ++_h)
#pragma unroll
                    for (int _i = 0; _i < 2; ++_i) vN[_h][_i] = vC[_h][_i]; }
        } else { if (has_next) ndelta = (unsigned)((nxt.pm - cur.pm) * (int)tstep); }
        const char* nB = has_next ? (const char*)g.Bt + (size_t)nxt.pn * tstep : cB;
#pragma unroll 1
        for (int t = 0; t < nt; t += 2) {
            const bool last = (t == nt - 2);
            const int k2 = last ? 0 : t + 2, k3 = k2 + 1;
            const char* b2 = last ? nB : cB + (size_t)(t + 2) * kstep; const char* b3 = b2 + kstep;
            unsigned v200, v201, v210, v211;
            if constexpr (GATHER) { v200 = last ? vN[0][0] : vC[0][0]; v201 = last ? vN[0][1] : vC[0][1]; v210 = last ? vN[1][0] : vC[1][0]; v211 = last ? vN[1][1] : vC[1][1]; }
            else { const unsigned dl = last ? ndelta : 0u; v200 = vC[0][0] + dl; v201 = vC[0][1] + dl; v210 = vC[1][0] + dl; v211 = vC[1][1] + dl; }
            PG8_LB(0, 0, 0); PG8_LB(1, 0, 1); PG8_SCHED; PG8_LA(0, 0); PG8_STAGE_A(PG8_SA(1, 1), t + 1, vC[1][0], vC[1][1]);
            PG8_WAIT_V(8); PG8_WAIT_L(0); PG8_BAR; PG8_MM(0, 0, 0); PG8_MM(0, 1, 1); PG8_BAR; PG8_SCHED;
            PG8_LA(0, 1); PG8_STAGE_B(PG8_SB(0, 0), b2); PG8_STAGE_B(PG8_SB(0, 1), b2 + hstep); PG8_STAGE_A(PG8_SA(0, 0), k2, v200, v201);
            PG8_WAIT_V(8); PG8_WAIT_L(0); PG8_BAR; PG8_MM(1, 0, 0); PG8_MM(1, 1, 1); PG8_BAR; PG8_SCHED;
            PG8_LB(0, 1, 0); PG8_LB(1, 1, 1); PG8_SCHED; PG8_LA(1, 0); PG8_STAGE_A(PG8_SA(0, 1), k2, v210, v211);
            PG8_WAIT_V(8); PG8_WAIT_L(0); PG8_BAR; PG8_MM(0, 0, 0); PG8_MM(0, 1, 1); PG8_BAR; PG8_SCHED;
            PG8_LA(1, 1); PG8_STAGE_B(PG8_SB(1, 0), b3); PG8_STAGE_B(PG8_SB(1, 1), b3 + hstep); PG8_STAGE_A(PG8_SA(1, 0), k3, v200, v201);
            PG8_WAIT_V(8); PG8_WAIT_L(0); PG8_BAR; PG8_MM(1, 0, 0); PG8_MM(1, 1, 1); PG8_BAR; PG8_SCHED;
        }
        if constexpr (ALIGN_EPI) { if (wr == 0) PG8_BAR; }
        if constexpr (FP8) asm volatile("s_nop 15\n\ts_nop 15" ::: "memory");
        { int fr_ = fr, fq_ = fq; asm volatile("" : "+v"(fr_), "+v"(fq_)); E(acc, cur, wr, wc, fr_, fq_); }
        if (!has_next) break;
#pragma unroll
        for (int a = 0; a < 2; ++a)
#pragma unroll
            for (int b = 0; b < 2; ++b)
#pragma unroll
                for (int m = 0; m < 4; ++m)
#pragma unroll
                    for (int n = 0; n < 2; ++n) acc[a][b][m][n] = (f32x4){0.f, 0.f, 0.f, 0.f};
        cur = nxt; cB = nB; ++ui;
#pragma unroll
        for (int _h = 0; _h < 2; ++_h)
#pragma unroll
            for (int _i = 0; _i < 2; ++_i) { if constexpr (GATHER) vC[_h][_i] = vN[_h][_i]; else vC[_h][_i] += ndelta; }
        if constexpr (ALIGN_EPI) { if (wr == 1) PG8_BAR; }
    }
    PG8_WAIT_V(0);
    if constexpr (!ALIGN_EPI) { if (wr == 0) PG8_BAR; }
    PG8_BAR;
#undef PG8_SA
#undef PG8_SB
#undef PG8_STAGE_A
#undef PG8_STAGE_B
#undef PG8_LDA
#undef PG8_LDB
#undef PG8_MMA
#undef PG8_MMA8
#undef PG8_MM
#undef PG8_LA
#undef PG8_LB
#undef PG8_WAIT_V
#undef PG8_WAIT_L
#undef PG8_BAR
#undef PG8_SCHED
#undef PG8_VOFF
}

constexpr int NXCD = 8, WGM = 8;
struct StaticOrder {
    int nM, nN, nwg, G, c;
    __device__ void init(int nM_, int nN_, int G_, int c_) { nM = nM_; nN = nN_; nwg = nM * nN; G = G_; c = c_; }
    __device__ bool next(int i, Unit& u) const {
        const long L = (long)i * G + c; if (L >= nwg) return false;
        int wgid = (int)L; { const int q = nwg / NXCD, r = nwg % NXCD, xcd = wgid % NXCD, off = wgid / NXCD; wgid = (xcd < r ? xcd * (q + 1) : r * (q + 1) + (xcd - r) * q) + off; }
        const int nig = WGM * nN, gid = wgid / nig, fm = gid * WGM, gsz = (nM - fm) < WGM ? (nM - fm) : WGM;
        u.pm = fm + ((wgid % nig) % gsz); u.pn = (wgid % nig) / gsz; u.om = u.pm; u.on = u.pn; u.aux = 0; return true;
    }
};
struct MergeOrder {
    int G, c;
    __device__ bool next(int i, Unit& u) const {
        const int n = i & 3; const long tile = (long)(i >> 2) * G + c; if (tile >= 256) return false;
        const int om = (int)tile >> 2, on = (int)tile & 3;
        u.pm = n * 64 + om; u.pn = n * 4 + on; u.om = om; u.on = on; u.aux = n; return true;
    }
};
struct MoeOrder {
    int ntiles, nN, nwg, G, c; int pend[NEXP];
    __device__ void init(const unsigned* cnt, int nN_, int G_, int c_) {
        int acc = 0;
#pragma unroll
        for (int e = 0; e < NEXP; ++e) { const int ce = (int)cnt[64 * e]; acc += (ce + 255) >> 8; pend[e] = acc; }
        ntiles = acc; nN = nN_; nwg = ntiles * nN; G = G_; c = c_;
    }
    __device__ bool next(int i, Unit& u) const {
        const long L = (long)i * G + c; if (L >= nwg) return false;
        const int wgid = (int)L;
        const int nig = WGM * nN, gid = wgid / nig, fm = gid * WGM, gsz = (ntiles - fm) < WGM ? (ntiles - fm) : WGM;
        const int pm = fm + ((wgid % nig) % gsz), pn = (wgid % nig) / gsz;
        int e = 0, ps = 0;
#pragma unroll
        for (int j = 0; j < NEXP - 1; ++j) if (pm >= pend[j]) { e = j + 1; ps = pend[j]; }
        u.pm = pm; u.pn = e * nN + pn; u.om = pm; u.on = pn; u.aux = e; u.gofs = e * 16384 - 256 * ps; return true;
    }
};

__device__ __forceinline__ u32x4 pack8(f32x4 a, f32x4 b) { u32x4 w; w.x = cvt_pk_bf16(a[0], a[1]); w.y = cvt_pk_bf16(a[2], a[3]); w.z = cvt_pk_bf16(b[0], b[1]); w.w = cvt_pk_bf16(b[2], b[3]); return w; }
struct EpiIn {
    bf16_t* Zs; bf16_t* Zg; const float* rowss; const float* bgate;
    __device__ __forceinline__ void operator()(const f32x4 (&acc)[2][2][4][2], const Unit& u, int wr, int wc, int fr, int fq) const {
        const int row0 = u.om * BM + wr * 64 + fr, colt = u.on * BM, cw = wc * 32 + 8 * fq;
        if (colt < ZSW) {
#pragma unroll
            for (int ai = 0; ai < 2; ++ai) { float rsd[4];
#pragma unroll
                for (int m = 0; m < 4; ++m) rsd[m] = row_rstd(rowss, row0 + ai * HALF + m * 16);
#pragma unroll
                for (int m = 0; m < 4; ++m) {
                    const int row = row0 + ai * HALF + m * 16; const float rstd = rsd[m];
#pragma unroll
                    for (int bj = 0; bj < 2; ++bj) *(u32x4*)(Zs + (size_t)row * ZSW + colt + bj * HALF + cw) = pack8(acc[ai][bj][m][0] * rstd, acc[ai][bj][m][1] * rstd);
                    if (m == 3) asm volatile("" ::: "memory");
                } }
        } else {
            const int gc0 = colt - ZSW + cw;
            const f32x4 b00 = *(const f32x4*)(bgate + gc0), b01 = *(const f32x4*)(bgate + gc0 + 4), b10 = *(const f32x4*)(bgate + gc0 + HALF), b11 = *(const f32x4*)(bgate + gc0 + HALF + 4);
#pragma unroll
            for (int ai = 0; ai < 2; ++ai) { float rsd[4];
#pragma unroll
                for (int m = 0; m < 4; ++m) rsd[m] = row_rstd(rowss, row0 + ai * HALF + m * 16);
#pragma unroll
                for (int m = 0; m < 4; ++m) {
                    const int row = row0 + ai * HALF + m * 16; const float rstd = rsd[m];
#pragma unroll
                    for (int bj = 0; bj < 2; ++bj) { f32x4 v0 = acc[ai][bj][m][0] * rstd + (bj ? b10 : b00), v1 = acc[ai][bj][m][1] * rstd + (bj ? b11 : b01);
                        *(u32x4*)(Zg + (size_t)row * ZGW + gc0 + bj * HALF) = pack8(v0, v1); }
                    if (m == 3) asm volatile("" ::: "memory");
                } }
        }
    }
};
struct EpiMerge {
    bf16_t* Mg; const bf16_t* Zg;
    __device__ __forceinline__ void operator()(const f32x4 (&acc)[2][2][4][2], const Unit& u, int wr, int wc, int fr, int fq) const {
        const int row0 = u.om * BM + wr * 64 + fr, colt = u.on * BM, cw = wc * 32 + 8 * fq, n = u.aux;
#pragma unroll
        for (int ai = 0; ai < 2; ++ai) {
            u32x4 gw[4][2], ow[4][2];
#pragma unroll
            for (int m = 0; m < 4; ++m)
#pragma unroll
                for (int bj = 0; bj < 2; ++bj) { const int row = row0 + ai * HALF + m * 16, col = colt + bj * HALF + cw;
                    gw[m][bj] = *(const u32x4*)(Zg + (size_t)row * ZGW + DBG_GPERM(n) * DM + col);
                    ow[m][bj] = n > 0 ? *(const u32x4*)(Mg + (size_t)row * DM + col) : (u32x4){0u, 0u, 0u, 0u}; }
#pragma unroll
            for (int m = 0; m < 4; ++m)
#pragma unroll
                for (int bj = 0; bj < 2; ++bj) { const int row = row0 + ai * HALF + m * 16, col = colt + bj * HALF + cw; const u32x4 g = gw[m][bj], o = ow[m][bj];
                    f32x4 v0 = acc[ai][bj][m][0], v1 = acc[ai][bj][m][1];
                    v0[0] = v0[0] * fsigmoid(bflo(g.x)) + bflo(o.x); v0[1] = v0[1] * fsigmoid(bfhi(g.x)) + bfhi(o.x); v0[2] = v0[2] * fsigmoid(bflo(g.y)) + bflo(o.y); v0[3] = v0[3] * fsigmoid(bfhi(g.y)) + bfhi(o.y);
                    v1[0] = v1[0] * fsigmoid(bflo(g.z)) + bflo(o.z); v1[1] = v1[1] * fsigmoid(bfhi(g.z)) + bfhi(o.z); v1[2] = v1[2] * fsigmoid(bflo(g.w)) + bflo(o.w); v1[3] = v1[3] * fsigmoid(bfhi(g.w)) + bfhi(o.w);
                    *(u32x4*)(Mg + (size_t)row * DM + col) = pack8(v0, v1); }
            asm volatile("" ::: "memory");
        }
    }
};
template <bool F32OUT, bool X8 = false, bool SC32 = false> struct EpiRes {
    float* xout; bf16_t* xb; float* rowss; unsigned char* x8;
    __device__ __forceinline__ void operator()(const f32x4 (&acc)[2][2][4][2], const Unit& u, int wr, int wc, int fr, int fq) const {
        const int row0 = u.om * BM + wr * 64 + fr, colt = u.on * BM, cw = wc * 32 + 8 * fq;
#pragma unroll
        for (int ai = 0; ai < 2; ++ai) {
            u32x4 xw[4][2];
#pragma unroll
            for (int m = 0; m < 4; ++m)
#pragma unroll
                for (int bj = 0; bj < 2; ++bj) xw[m][bj] = *(const u32x4*)(xb + (size_t)(row0 + ai * HALF + m * 16) * DM + colt + bj * HALF + cw);
#pragma unroll
            for (int m = 0; m < 4; ++m) {
                const int row = row0 + ai * HALF + m * 16; float ss = 0.f;
#pragma unroll
                for (int bj = 0; bj < 2; ++bj) { const size_t off = (size_t)row * DM + colt + bj * HALF + cw; const u32x4 w = xw[m][bj];
                    f32x4 v0 = acc[ai][bj][m][0], v1 = acc[ai][bj][m][1];
                    if constexpr (SC32) { v0 *= 0.03125f; v1 *= 0.03125f; }
                    v0[0] += bflo(w.x); v0[1] += bfhi(w.x); v0[2] += bflo(w.y); v0[3] += bfhi(w.y); v1[0] += bflo(w.z); v1[1] += bfhi(w.z); v1[2] += bflo(w.w); v1[3] += bfhi(w.w);
                    if constexpr (F32OUT) { *(f32x4*)(xout + off) = v0; *(f32x4*)(xout + off + 4) = v1; }
                    *(u32x4*)(xb + off) = pack8(v0, v1);
                    if constexpr (X8) { u32x2 q; q.x = cvt_pk4_fp8(v0[0], v0[1], v0[2], v0[3]); q.y = cvt_pk4_fp8(v1[0], v1[1], v1[2], v1[3]); *(u32x2*)(x8 + off) = q; }
                    ss += (v0[0] * v0[0] + v0[1] * v0[1]) + (v0[2] * v0[2] + v0[3] * v0[3]) + (v1[0] * v1[0] + v1[1] * v1[1]) + (v1[2] * v1[2] + v1[3] * v1[3]); }
                ss += __shfl_xor(ss, 16); ss += __shfl_xor(ss, 32);
                if (fq == 0) rowss[(size_t)row * 16 + u.on * 4 + wc] = ss;
            }
            asm volatile("" ::: "memory");
        }
    }
};
struct EpiRowScale {
    bf16_t* O; int ldc; const float* rowss;
    __device__ __forceinline__ void operator()(const f32x4 (&acc)[2][2][4][2], const Unit& u, int wr, int wc, int fr, int fq) const {
        const int row0 = u.om * BM + wr * 64 + fr, colt = u.on * BM, cw = wc * 32 + 8 * fq;
#pragma unroll
        for (int ai = 0; ai < 2; ++ai)
#pragma unroll
            for (int m = 0; m < 4; ++m) {
                const int row = row0 + ai * HALF + m * 16; const float rstd = row_rstd(rowss, row);
#pragma unroll
                for (int bj = 0; bj < 2; ++bj) *(u32x4*)(O + (size_t)row * ldc + colt + bj * HALF + cw) = pack8(acc[ai][bj][m][0] * rstd, acc[ai][bj][m][1] * rstd);
                if (m == 3) asm volatile("" ::: "memory");
            }
    }
};
template <bool MOE> struct EpiSwiGLU {
    bf16_t* H; int ldh; const float* rs; const int* row_tok;
    __device__ __forceinline__ void operator()(const f32x4 (&acc)[2][2][4][2], const Unit& u, int wr, int wc, int fr, int fq) const {
        const int row0 = u.om * BM + wr * 64 + fr, hc = u.on * HALF + wc * 32 + 8 * fq;
#pragma unroll
        for (int ai = 0; ai < 2; ++ai) { float rsd[4];
#pragma unroll
            for (int m = 0; m < 4; ++m) { const int row = row0 + ai * HALF + m * 16; rsd[m] = MOE ? rs[row_tok[row]] : row_rstd(rs, row); }
#pragma unroll
            for (int m = 0; m < 4; ++m) {
                const int row = row0 + ai * HALF + m * 16;
                const float rstd = rsd[m];
                f32x4 o[2];
#pragma unroll
                for (int n = 0; n < 2; ++n)
#pragma unroll
                    for (int j = 0; j < 4; ++j) { const float gv = acc[ai][0][m][n][j] * rstd, uv = acc[ai][1][m][n][j] * rstd; o[n][j] = gv * fsigmoid(gv) * uv; }
                *(u32x4*)(H + (size_t)row * ldh + hc) = pack8(o[0], o[1]);
                if (m == 3) asm volatile("" ::: "memory");
            } }
    }
};
template <bool RSTD, bool W32 = true> struct EpiSwiGLU8 {
    unsigned char* H; int ldh; const float* rs;
    __device__ __forceinline__ void operator()(const f32x4 (&acc)[2][2][4][2], const Unit& u, int wr, int wc, int fr, int fq) const {
        const int row0 = u.om * BM + wr * 64 + fr, hc = u.on * HALF + wc * 32 + 8 * fq;
#pragma unroll
        for (int ai = 0; ai < 2; ++ai)
#pragma unroll
            for (int m = 0; m < 4; ++m) {
                const int row = row0 + ai * HALF + m * 16;
                float sc = W32 ? 0.03125f : 1.f; if constexpr (RSTD) sc *= row_rstd(rs, row);
                f32x4 o[2];
#pragma unroll
                for (int n = 0; n < 2; ++n)
#pragma unroll
                    for (int j = 0; j < 4; ++j) { const float gv = acc[ai][0][m][n][j] * sc, uv = acc[ai][1][m][n][j] * sc; o[n][j] = gv * fsigmoid(gv) * uv; }
                u32x2 w; w.x = cvt_pk4_fp8(o[0][0], o[0][1], o[0][2], o[0][3]); w.y = cvt_pk4_fp8(o[1][0], o[1][1], o[1][2], o[1][3]);
                *(u32x2*)(H + (size_t)row * ldh + hc) = w;
                if (m == 3) asm volatile("" ::: "memory");
            }
    }
};
struct EpiPlain {
    bf16_t* O; int ldc; float sc;
    __device__ __forceinline__ void operator()(const f32x4 (&acc)[2][2][4][2], const Unit& u, int wr, int wc, int fr, int fq) const {
        const int row0 = u.om * BM + wr * 64 + fr, colt = u.on * BM, cw = wc * 32 + 8 * fq;
#pragma unroll
        for (int ai = 0; ai < 2; ++ai)
#pragma unroll
            for (int m = 0; m < 4; ++m) { const int row = row0 + ai * HALF + m * 16;
#pragma unroll
                for (int bj = 0; bj < 2; ++bj) *(u32x4*)(O + (size_t)row * ldc + colt + bj * HALF + cw) = pack8(acc[ai][bj][m][0] * sc, acc[ai][bj][m][1] * sc); }
    }
};
}

#define XB_TMO      128
#define XB_XCNT(j)  (256  + 64 * (j))
#define XB_XSUB(j)  (1280 + 64 * (j))
#define XB_XGEN(j)  (2304 + 64 * (j))
#define XB_TOP      3328
#define XB_TOPGEN   3392
#define XCD_BAR_WORDS 3456
#define XB_SPIN_CAP (1u << 18)
__device__ __forceinline__ unsigned xb_ld(unsigned* p)              { return __hip_atomic_load(p, __ATOMIC_RELAXED, __HIP_MEMORY_SCOPE_AGENT); }
__device__ __forceinline__ unsigned xb_add(unsigned* p, unsigned v) { return __hip_atomic_fetch_add(p, v, __ATOMIC_RELAXED, __HIP_MEMORY_SCOPE_AGENT); }
__device__ __forceinline__ unsigned xb_xcc_id() { return (unsigned)__builtin_amdgcn_s_getreg((3 << 11) | 20) & 0xFu; }
#define XB_SPIN(cond, bar) do { unsigned _sp = 0; while (cond) { __builtin_amdgcn_s_sleep(1); \
    if ((++_sp & 255u) == 0u) { if (xb_ld(&(bar)[XB_TMO])) break; if (_sp > XB_SPIN_CAP) { atomicAdd(&(bar)[XB_TMO], 1u); break; } } } } while (0)
struct XcdBarrier { unsigned* bar; unsigned x; volatile LAS unsigned* st; };
__device__ __forceinline__ XcdBarrier xcd_barrier_post(unsigned* bar, volatile LAS unsigned* st) {
    XcdBarrier b; b.bar = bar; b.x = xb_xcc_id(); b.st = st;
    if (threadIdx.x == 0) (void)xb_add(&bar[XB_XCNT(b.x)], 1u);
    return b;
}
__device__ __forceinline__ void xcd_barrier_complete(unsigned* bar, unsigned x, unsigned& nloc, unsigned& nx) {
    const unsigned G = gridDim.x * gridDim.y * gridDim.z;
    unsigned sum, cnt, mine, sp = 0u;
    for (;;) {
        sum = 0u; cnt = 0u; mine = 0u;
#pragma unroll
        for (unsigned j = 0; j < 16; ++j) { const unsigned c = xb_ld(&bar[XB_XCNT(j)]); sum += c; cnt += (c > 0u) ? 1u : 0u; mine = (j == x) ? c : mine; }
        if (sum == G) break;
        __builtin_amdgcn_s_sleep(1);
        if ((++sp & 255u) == 0u) { if (xb_ld(&bar[XB_TMO])) break; if (sp > XB_SPIN_CAP) { atomicAdd(&bar[XB_TMO], 1u); break; } }
    }
    nloc = mine > 0u ? mine : 1u; nx = cnt > 0u ? cnt : 1u;
}
__device__ __forceinline__ void xcd_barrier(const XcdBarrier& b) {
    asm volatile("s_waitcnt vmcnt(0)" ::: "memory");
    __syncthreads();
    if (threadIdx.x == 0) {
        unsigned* bar = b.bar;
        __builtin_amdgcn_s_waitcnt(0);
        unsigned nloc = b.st[0], nx = b.st[1];
        if (nloc == 0u) { xcd_barrier_complete(bar, b.x, nloc, nx); b.st[0] = nloc; b.st[1] = nx; }
        const unsigned old = xb_add(&bar[XB_XSUB(b.x)], 1u);
        const unsigned gen = old / nloc;
        if (old + 1u == (gen + 1u) * nloc) {
            __builtin_amdgcn_fence(__ATOMIC_RELEASE, "agent");
            asm volatile("s_waitcnt vmcnt(0)" ::: "memory");
            const unsigned og = xb_add(&bar[XB_TOP], 1u);
            const unsigned tg = og / nx;
            if (og + 1u == (tg + 1u) * nx) xb_add(&bar[XB_TOPGEN], 1u);
            else XB_SPIN(xb_ld(&bar[XB_TOPGEN]) == tg, bar);
            __builtin_amdgcn_fence(__ATOMIC_ACQUIRE, "agent");
            xb_add(&bar[XB_XGEN(b.x)], 1u);
            asm volatile("s_waitcnt vmcnt(0)" ::: "memory");
        } else {
            XB_SPIN(xb_ld(&bar[XB_XGEN(b.x)]) == gen, bar);
            __builtin_amdgcn_fence(__ATOMIC_ACQUIRE, "agent");
            asm volatile("s_waitcnt vmcnt(0)" ::: "memory");
        }
    }
    __syncthreads();
}

struct Args { const void* in[55]; float* out; unsigned char* ws; int ph_lo, ph_hi, submask, pad; };
struct Frame {
    LAS unsigned char* lds; unsigned char* ws; unsigned* ctl; float* out;
    int tid, lane, wave, G, bid, gw, ngw;
};
#define GAS __attribute__((address_space(1)))
#define CAS __attribute__((address_space(4)))
#define PHASE_BEGIN() const CAS char* kp_ = (const CAS char*)__builtin_amdgcn_kernarg_segment_ptr(); asm volatile("" : "+s"(kp_)); \
    unsigned char* ws = (unsigned char*)(GAS unsigned char*)(*(const CAS unsigned long long*)(kp_ + 448)); \
    Frame F; { int t_ = threadIdx.x; asm volatile("" : "+v"(t_)); int b_ = blockIdx.x; asm volatile("" : "+s"(b_)); \
      F.lds = (LAS unsigned char*)lds_raw; F.ws = ws; F.ctl = (unsigned*)(ws + WS_CTL); F.out = (float*)(GAS float*)(*(const CAS unsigned long long*)(kp_ + 440)); \
      F.tid = t_; F.lane = t_ & 63; F.wave = __builtin_amdgcn_readfirstlane(t_ >> 6); F.G = gridDim.x; F.bid = b_; F.gw = b_ * 8 + F.wave; F.ngw = F.G * 8; }
#define XB ((bf16_t*)(ws + WS_XB))
#define RS ((float*)(ws + WS_RSP))
#define ZS ((bf16_t*)(ws + WS_ZS))
#define ZG ((bf16_t*)(ws + WS_ZG))
#define YB ((bf16_t*)(ws + WS_Y))
#define MG ((bf16_t*)(ws + WS_MERGED))
#define S5T ((float*)(ws + WS_TAB + TAB_S5T))
#define CMAT ((bf16_t*)(ws + WS_TAB + TAB_CMAT))
#define MISCT ((float*)(ws + WS_TAB + TAB_MISC))
#define BBF ((bf16_t*)(ws + WS_TAB + 832 * 1024))
#define WLP(l) (ws + WS_WL + (size_t)(l) * WL_STRIDE)
#define INF(i) ((const float*)(const GAS float*)(*(const CAS unsigned long long*)(kp_ + 8 * (i))))

struct TJob { const float* W; bf16_t* WT; const float* ks; int K, N, ldw, ldk, nb, map; size_t sstride, dstride; int f8; };
__device__ __forceinline__ int tjob_items(const TJob& j) { return j.nb * (j.K / 64) * (j.N / 32); }
__device__ __forceinline__ void tjob_load(const TJob& j, int item, float (&v)[32], int lane) {
    const int per = (j.K / 64) * (j.N / 32), b = item / per, r = item % per, nblk = j.N / 32, kb = r / nblk, nbk = r % nblk, k0 = 64 * kb, n0 = 32 * nbk;
    const float* W = j.W + (size_t)b * j.sstride + (size_t)(k0 + (lane >> 5)) * j.ldw + n0 + (lane & 31);
#pragma unroll
    for (int i = 0; i < 32; ++i) v[i] = W[(size_t)(2 * i) * j.ldw];
}
__device__ __forceinline__ void tjob_store(const TJob& j, int item, float (&v)[32], LAS float* scr, int lane) {
    const int per = (j.K / 64) * (j.N / 32), b = item / per, r = item % per, nblk = j.N / 32, kb = r / nblk, nbk = r % nblk, k0 = 64 * kb, n0 = 32 * nbk;
    int drow = n0;
    if (j.map == 1) drow = n0 < C_END ? n0 : n0 + (ZSW - C_END);
    else if (j.map == 2) drow = 256 * (n0 >> 7) + (n0 & 127);
    else if (j.map == 3) drow = 256 * (n0 >> 7) + 128 + (n0 & 127);
    if (j.ks) {
#pragma unroll
        for (int i = 0; i < 32; ++i) v[i] *= j.ks[k0 + 2 * i + (lane >> 5)]; }
#pragma unroll
    for (int i = 0; i < 32; ++i) scr[(2 * i + (lane >> 5)) * 33 + (lane & 31)] = v[i];
    asm volatile("s_waitcnt lgkmcnt(0)" ::: "memory");
    const int c = lane & 7; bf16_t* WT = j.WT + (size_t)b * j.dstride;
    if (j.f8) { unsigned char* W8 = (unsigned char*)j.WT + (size_t)b * j.dstride;
#pragma unroll
        for (int q = 0; q < 4; ++q) { const int n = (lane >> 3) + 8 * q; const LAS float* sp = scr + (8 * c) * 33 + n;
            u32x2 o; o.x = cvt_pk4_fp8(sp[0 * 33] * 32.f, sp[1 * 33] * 32.f, sp[2 * 33] * 32.f, sp[3 * 33] * 32.f); o.y = cvt_pk4_fp8(sp[4 * 33] * 32.f, sp[5 * 33] * 32.f, sp[6 * 33] * 32.f, sp[7 * 33] * 32.f);
            *(u32x2*)(W8 + (size_t)(drow + n) * j.ldk + k0 + 8 * c) = o; }
    } else
#pragma unroll
    for (int q = 0; q < 4; ++q) { const int n = (lane >> 3) + 8 * q; const LAS float* sp = scr + (8 * c) * 33 + n;
        u32x4 o; o.x = cvt_pk_bf16(sp[0 * 33], sp[1 * 33]); o.y = cvt_pk_bf16(sp[2 * 33], sp[3 * 33]); o.z = cvt_pk_bf16(sp[4 * 33], sp[5 * 33]); o.w = cvt_pk_bf16(sp[6 * 33], sp[7 * 33]);
        *(u32x4*)(WT + (size_t)(drow + n) * j.ldk + k0 + 8 * c) = o; }
    asm volatile("s_waitcnt lgkmcnt(0)" ::: "memory");
}
__device__ __forceinline__ void tjob_run_all(const TJob& j, int first, int stride, LAS float* scr, int lane) {
    const int ni = tjob_items(j); int it = first; if (it >= ni) return;
    float va[32], vb[32]; tjob_load(j, it, va, lane);
    for (;;) {
        const int n1 = it + stride; if (n1 < ni) tjob_load(j, n1, vb, lane);
        tjob_store(j, it, va, scr, lane); if (n1 >= ni) break;
        const int n2 = n1 + stride; if (n2 < ni) tjob_load(j, n2, va, lane);
        tjob_store(j, n1, vb, scr, lane); if (n2 >= ni) break;
        it = n2;
    }
}

template <int DQ> struct AttnLds { static constexpr int KROW = DQ * 2 + 16, VROW = 272, KBYTES = 128 * KROW, VBYTES = 64 * VROW, BUF = KBYTES + VBYTES; };
#define PK4(P, BASE, OUT) do { unsigned a0_ = cvt_pk_bf16(P[BASE + 0], P[BASE + 1]), a1_ = cvt_pk_bf16(P[BASE + 2], P[BASE + 3]); \
    unsigned b0_ = cvt_pk_bf16(P[BASE + 4], P[BASE + 5]), b1_ = cvt_pk_bf16(P[BASE + 6], P[BASE + 7]); \
    auto r0_ = __builtin_amdgcn_permlane32_swap(a0_, b0_, false, false); auto r1_ = __builtin_amdgcn_permlane32_swap(a1_, b1_, false, false); \
    u32x4 w_ = {r0_[0], r1_[0], r0_[1], r1_[1]}; OUT = *(bf16x8*)&w_; } while (0)

template <int DQ, int NMAP, bool CAUSAL, bool BIAS, bool QNORM>
__device__ __forceinline__ void attn_unit(LAS unsigned char* lds, const bf16_t* Qp, int ldq, const bf16_t* Kp, const bf16_t* Vtp, int vstride, int nkt, int q0,
                                          const LAS float* lut, const float* qg, float qscale, float mshift, f32x16 (&o)[NMAP][2], float (&l)[NMAP]) {
    typedef AttnLds<DQ> L; constexpr int KD = DQ / NMAP, KS = KD / 16, KCH = DQ / 8, NKC = 64 * KCH;
    int tid = threadIdx.x; asm volatile("" : "+v"(tid));
    const int wid = tid >> 6, lane = tid & 63, r32 = lane & 31, hi = lane >> 5;
    bf16x8 q[NMAP][KS];
    {
        const bf16_t* qrow = Qp + (size_t)(wid * 32 + r32) * ldq + hi * 8;
#pragma unroll
        for (int mp = 0; mp < NMAP; ++mp)
#pragma unroll
            for (int ks = 0; ks < KS; ++ks) q[mp][ks] = ldg8(qrow + mp * KD + ks * 16);
        if constexpr (QNORM) {
            float ss = 0.f;
#pragma unroll
            for (int ks = 0; ks < KS; ++ks) ss += sq8(q[0][ks]);
            ss += __shfl_xor(ss, 32);
            const float rs = frsq(ss * (1.f / DQ) + EPS) * qscale;
#pragma unroll
            for (int ks = 0; ks < KS; ++ks) { u32x4 w = *(u32x4*)&q[0][ks]; const float* gp = qg + ks * 16 + hi * 8;
                w.x = cvt_pk_bf16(bflo(w.x) * rs * gp[0], bfhi(w.x) * rs * gp[1]); w.y = cvt_pk_bf16(bflo(w.y) * rs * gp[2], bfhi(w.y) * rs * gp[3]);
                w.z = cvt_pk_bf16(bflo(w.z) * rs * gp[4], bfhi(w.z) * rs * gp[5]); w.w = cvt_pk_bf16(bflo(w.w) * rs * gp[6], bfhi(w.w) * rs * gp[7]);
                q[0][ks] = *(bf16x8*)&w; }
        }
    }
#pragma unroll
    for (int mp = 0; mp < NMAP; ++mp) { l[mp] = 0.f; o[mp][0] = f32x16{}; o[mp][1] = f32x16{}; }
    constexpr int NKI = (128 * KCH) / 512;
    bf16x8 skr[NKI], svr[2];
#define AT_LOAD(j) do { const int key0_ = (j) * 128; \
        _Pragma("unroll") for (int i_ = 0; i_ < NKI; ++i_) { const int c_ = tid + 512 * i_; skr[i_] = ldg8(Kp + (size_t)(key0_ + c_ / KCH) * DQ + (c_ % KCH) * 8); } \
        _Pragma("unroll") for (int i_ = 0; i_ < 2; ++i_) { const int c_ = tid + 512 * i_; svr[i_] = ldg8(Vtp + (size_t)(c_ >> 4) * vstride + key0_ + (c_ & 15) * 8); } } while (0)
#define AT_WRITE(b) do { LAS unsigned char* base_ = lds + (b) * L::BUF; \
        _Pragma("unroll") for (int i_ = 0; i_ < NKI; ++i_) { const int c_ = tid + 512 * i_; *(LAS bf16x8*)(base_ + (c_ / KCH) * L::KROW + (c_ % KCH) * 16) = skr[i_]; } \
        _Pragma("unroll") for (int i_ = 0; i_ < 2; ++i_) { const int c_ = tid + 512 * i_; *(LAS bf16x8*)(base_ + L::KBYTES + (c_ >> 4) * L::VROW + (c_ & 15) * 16) = svr[i_]; } } while (0)
    const int qi = q0 + wid * 32 + r32;
    const int qlo = q0 + wid * 32;
#define AT_COMPUTE(key0, bf, sb) do { const bool active = !CAUSAL || (key0) <= qlo + 31; \
        if (active) { const LAS unsigned char* kb = lds + (bf) * L::BUF + (sb) * 64 * L::KROW; const LAS unsigned char* vb = lds + (bf) * L::BUF + L::KBYTES + (sb) * 128; const bool need_mask = CAUSAL && ((key0) + 63 > qlo); \
            _Pragma("unroll") for (int mp = 0; mp < NMAP; ++mp) { f32x16 p0 = f32x16{}, p1 = f32x16{}; \
                _Pragma("unroll") for (int ks = 0; ks < KS; ++ks) { \
                    const bf16x8 a0 = *(const LAS bf16x8*)(kb + r32 * L::KROW + (mp * KD + ks * 16 + hi * 8) * 2); \
                    const bf16x8 a1 = *(const LAS bf16x8*)(kb + (32 + r32) * L::KROW + (mp * KD + ks * 16 + hi * 8) * 2); \
                    p0 = MFMA32(a0, q[mp][ks], p0); p1 = MFMA32(a1, q[mp][ks], p1); } \
                __builtin_amdgcn_sched_barrier(0); \
                float sh = mshift; \
                if constexpr (BIAS) { \
                    if (qlo - ((key0) + 63) >= 127) sh -= lut[255]; \
                    else { const LAS float* lp = lut + (qi - (key0) - 4 * hi + 69); \
                        _Pragma("unroll") for (int r = 0; r < 16; ++r) { const int cr = (r & 3) + 8 * (r >> 2); p0[r] += lp[59 - cr]; p1[r] += lp[27 - cr]; } } } \
                if (need_mask) { _Pragma("unroll") for (int r = 0; r < 16; ++r) { const int kk = (key0) + crow(r, hi); if (kk > qi) p0[r] = -1e30f; if (kk + 32 > qi) p1[r] = -1e30f; } } \
                float ps = 0.f; \
                _Pragma("unroll") for (int r = 0; r < 16; ++r) { p0[r] = fexp2(p0[r] - sh); p1[r] = fexp2(p1[r] - sh); ps += p0[r] + p1[r]; } \
                l[mp] += ps; \
                __builtin_amdgcn_sched_barrier(0); \
                bf16x8 pa0, pa1, pa2, pa3; \
                PK4(p0, 0, pa0); PK4(p0, 8, pa1); PK4(p1, 0, pa2); PK4(p1, 8, pa3); \
                _Pragma("unroll") for (int dt = 0; dt < 2; ++dt) { \
                    const LAS unsigned char* vrow = vb + (dt * 32 + r32) * L::VROW + hi * 16; \
                    const bf16x8 v0 = *(const LAS bf16x8*)(vrow), v1 = *(const LAS bf16x8*)(vrow + 32), v2 = *(const LAS bf16x8*)(vrow + 64), v3 = *(const LAS bf16x8*)(vrow + 96); \
                    o[mp][dt] = MFMA32(v0, pa0, o[mp][dt]); o[mp][dt] = MFMA32(v1, pa1, o[mp][dt]); o[mp][dt] = MFMA32(v2, pa2, o[mp][dt]); o[mp][dt] = MFMA32(v3, pa3, o[mp][dt]); } \
                __builtin_amdgcn_sched_barrier(0); } } } while (0)
    const int n128 = nkt >> 1;
    if (wid < 4) __builtin_amdgcn_s_setprio(2);
    AT_LOAD(0); AT_WRITE(0); __syncthreads();
    for (int j = 0; j < n128; ++j) {
        if (j + 1 < n128) AT_LOAD(j + 1);
        AT_COMPUTE(j * 128, j & 1, 0);
        AT_COMPUTE(j * 128 + 64, j & 1, 1);
        if (j + 1 < n128) AT_WRITE((j + 1) & 1);
        __syncthreads();
    }
    __builtin_amdgcn_s_setprio(0);
#undef AT_COMPUTE
#pragma unroll
    for (int mp = 0; mp < NMAP; ++mp) l[mp] += __shfl_xor(l[mp], 32);
#undef AT_LOAD
#undef AT_WRITE
}

__device__ __forceinline__ void attn_store(bf16_t* dst, const f32x16 (&o)[2], float scale, int hi) {
#pragma unroll
    for (int dt = 0; dt < 2; ++dt)
#pragma unroll
        for (int rg = 0; rg < 4; ++rg) { u32x2 w; w.x = cvt_pk_bf16(o[dt][4 * rg] * scale, o[dt][4 * rg + 1] * scale); w.y = cvt_pk_bf16(o[dt][4 * rg + 2] * scale, o[dt][4 * rg + 3] * scale);
            *(u32x2*)(dst + dt * 32 + 8 * rg + 4 * hi) = w; }
}

__device__ __forceinline__ bool in_phase(int k) { const __attribute__((address_space(4))) int* p_ = (const __attribute__((address_space(4))) int*)__builtin_amdgcn_kernarg_segment_ptr(); asm volatile("" : "+s"(p_)); return p_[114] <= k && k < p_[115]; }
__device__ __forceinline__ bool sub_on(int k) { const __attribute__((address_space(4))) int* p_ = (const __attribute__((address_space(4))) int*)__builtin_amdgcn_kernarg_segment_ptr(); asm volatile("" : "+s"(p_)); return (p_[116] >> k) & 1; }
__device__ __forceinline__ void s5_bu_tile(LAS unsigned char* tile, const bf16_t* bbf_g, const bf16_t* zs_tok0, int lane) {
    const int r32 = lane & 31, hi = lane >> 5;
    const bf16x8 uf = ldg8(zs_tok0 + (size_t)r32 * ZSW + 8 * hi);
#pragma unroll
    for (int pt = 0; pt < 4; ++pt) { f32x16 d = f32x16{}; d = MFMA32(ldg8(bbf_g + (size_t)(32 * pt + r32) * 16 + 8 * hi), uf, d);
#pragma unroll
        for (int rg = 0; rg < 4; ++rg) { u32x2 w; w.x = cvt_pk_bf16(d[4 * rg], d[4 * rg + 1]); w.y = cvt_pk_bf16(d[4 * rg + 2], d[4 * rg + 3]);
            *(LAS u32x2*)(tile + r32 * 272 + (32 * pt + 8 * rg + 4 * hi) * 2) = w; } }
    asm volatile("s_waitcnt lgkmcnt(0)" ::: "memory");
}
__device__ __forceinline__ int h0_pull(LAS unsigned* qc, int lane, int wg_items, int bid, int G, int total) {
    unsigned k = 0u; if (lane == 0) k = __hip_atomic_fetch_add(qc, 1u, __ATOMIC_RELAXED, __HIP_MEMORY_SCOPE_WORKGROUP);
    const int kk = __builtin_amdgcn_readfirstlane((int)k);
    return kk < wg_items ? bid + kk * G : total;
}
__device__ __forceinline__ int queue_pull(unsigned* ctr, volatile LAS unsigned* slot, int tid) {
    __syncthreads();
    if (tid == 0) *slot = __hip_atomic_fetch_add(ctr, 1u, __ATOMIC_RELAXED, __HIP_MEMORY_SCOPE_AGENT);
    __syncthreads();
    return (int)*slot;
}
constexpr int NPHASE = 24;
#ifndef DBG_NPH
#endif
__global__ void __launch_bounds__(512, 2) hybrid_fwd(Args args) {
    extern __shared__ __attribute__((aligned(16))) unsigned char lds_raw[];
    LAS unsigned char* lds0 = (LAS unsigned char*)lds_raw;
    volatile LAS unsigned* MISC = (volatile LAS unsigned*)(lds0 + MISC_OFF);
    for (int u = threadIdx.x; u < (LDS_BYTES - RING_BYTES) / 4; u += 512) ((LAS unsigned*)(lds0 + RING_BYTES))[u] = 0u;
    __syncthreads();
    const int lo = args.ph_lo, hi_ph = args.ph_hi;
    const bool one_launch = (hi_ph - lo) > 1;
    XcdBarrier bar; bar.bar = (unsigned*)(args.ws + WS_CTL) + CW_BAR; bar.x = 0; bar.st = nullptr;
    if (one_launch) bar = xcd_barrier_post((unsigned*)(args.ws + WS_CTL) + CW_BAR, MISC + 8);
#ifndef SUBMASK
#define SUBMASK 0xFFFFu
#endif
#define SUB(k) ((((SUBMASK) >> (k)) & 1u) && sub_on(k))
#ifndef PHMASK
#define PHMASK 0xFFFFFFu
#endif
#define IN(k) ((((PHMASK) >> (k)) & 1u) && in_phase(k))
#define SEAM(k) do { if (IN(k) && IN((k) + 1)) { XcdBarrier b2_ = bar; asm volatile("" : "+s"(b2_.bar), "+s"(b2_.x)); xcd_barrier(b2_); } } while (0)

    if (IN(0)) { PHASE_BEGIN();
        LAS float* scr = (LAS float*)(F.lds + F.wave * 16384);
        int joff = 0;
        for (int l = 0; l < 2; ++l) {
            unsigned char* wl = ws + WS_WL + l * WL_STRIDE;
#define RUNJOB(...) do { const TJob jb_ = TJob{__VA_ARGS__}; int fst_ = F.gw - joff; if (fst_ < 0) fst_ += F.ngw; tjob_run_all(jb_, fst_, F.ngw, scr, F.lane); joff = (joff + tjob_items(jb_)) % F.ngw; } while (0)
            RUNJOB(INF(8) + (size_t)l * DM * DIN, (bf16_t*)(wl + WL_WIN), INF(4) + l * DM, DM, DIN, DIN, DM, 1, 1, 0, 0);
            RUNJOB(INF(22) + (size_t)l * 192 * 384, (bf16_t*)(wl + WL_SM + SM_WUQ), INF(20) + l * 192, 192, 384, 384, 192, 1, 0, 0, 0);
            RUNJOB(INF(23) + (size_t)l * 128 * 512, (bf16_t*)(wl + WL_SM + SM_WUKV), INF(21) + l * 128, 128, 512, 512, 128, 1, 0, 0, 0);
            RUNJOB(INF(28) + (size_t)l * 4 * 4096, (bf16_t*)(wl + WL_SM + SM_WR), nullptr, 64, 64, 64, 64, 4, 0, 4096, 4096);
            RUNJOB(INF(30) + (size_t)l * 4 * 4096, (bf16_t*)(wl + WL_SM + SM_WI), nullptr, 64, 64, 64, 64, 4, 0, 4096, 4096);
            RUNJOB(INF(18) + (size_t)l * 65536, (bf16_t*)(wl + WL_SM + SM_WGLU), nullptr, 256, 256, 256, 256, 1, 0, 0, 0);
            RUNJOB(INF(40) + (size_t)l * 4 * 256 * DM, (bf16_t*)(wl + WL_PT), nullptr, 256, DM, DM, 256, 4, 0, (size_t)256 * DM, (size_t)DM * 256);
            RUNJOB(INF(41) + (size_t)l * DM * DM, (bf16_t*)(wl + WL_WO), nullptr, DM, DM, DM, DM, 1, 0, 0, 0);
            RUNJOB(INF(42) + (size_t)l * DM * 256, (bf16_t*)(wl + WL_WXQ), INF(5) + l * DM, DM, 256, 256, DM, 1, 0, 0, 0);
            RUNJOB(INF(43) + (size_t)l * DM * 256, (bf16_t*)(wl + WL_WXKV), INF(6) + l * DM, DM, 256, 256, DM, 1, 0, 0, 0);
            RUNJOB(INF(44) + (size_t)l * DM * 256, (bf16_t*)(wl + WL_WXKV) + (size_t)256 * DM, INF(6) + l * DM, DM, 256, 256, DM, 1, 0, 0, 0);
            RUNJOB(INF(45) + (size_t)l * 256 * DM, (bf16_t*)(wl + WL_WXO), nullptr, 256, DM, DM, 256, 1, 0, 0, 0);
            { u32x4* z = (u32x4*)((bf16_t*)(wl + WL_WIN) + (size_t)C_END * DM); const int n16 = (ZSW - C_END) * DM * 2 / 16;
              for (int i = F.bid * 512 + F.tid; i < n16; i += F.G * 512) z[i] = (u32x4){0u, 0u, 0u, 0u}; }
        }
        {
            RUNJOB(INF(48), (bf16_t*)(ws + WS_WGU), INF(7), DM, FF, FF, DM, 1, 2, 0, 0);
            RUNJOB(INF(49), (bf16_t*)(ws + WS_WGU), INF(7), DM, FF, FF, DM, 1, 3, 0, 0);
            RUNJOB(INF(50), (bf16_t*)(ws + WS_WD), nullptr, FF, DM, DM, FF, 1, 0, 0, 0, G2_FP8);
        }
        for (int i = F.bid * 512 + F.tid; i < 2 * 16 * 64; i += F.G * 512) {
            const int l = i >> 10, g = (i >> 6) & 15, p = i & 63;
            const float dt = __expf(INF(12)[l * 16 + g]);
            const float lr = INF(10)[(l * 16 + g) * 64 + p], li = INF(11)[(l * 16 + g) * 64 + p];
            const float mag = __expf(lr * dt); float sn, cs; sincos_red(li * dt, sn, cs);
            const float ar = mag * cs, ai = mag * sn, den = lr * lr + li * li;
            const float zr = ((ar - 1.f) * lr + ai * li) / den, zi = (ai * lr - (ar - 1.f) * li) / den;
            float* tb = S5T + (size_t)(l * 16 + g) * 36 * 64;
            for (int c = 0; c < 16; ++c) { const float br = INF(13)[((l * 16 + g) * 64 + p) * 16 + c], bi = INF(14)[((l * 16 + g) * 64 + p) * 16 + c];
                tb[c * 64 + p] = zr * br - zi * bi; tb[(16 + c) * 64 + p] = zr * bi + zi * br;
                BBF[((size_t)(l * 16 + g) * 128 + p) * 16 + c] = f2bf(zr * br - zi * bi); BBF[((size_t)(l * 16 + g) * 128 + 64 + p) * 16 + c] = f2bf(zr * bi + zi * br); }
            tb[32 * 64 + p] = ar; tb[33 * 64 + p] = ai;
            float pr = ar, pi = ai;
            for (int s = 0; s < 6; ++s) { const float nr = pr * pr - pi * pi, ni = 2.f * pr * pi; pr = nr; pi = ni; }
            tb[34 * 64 + p] = pr; tb[35 * 64 + p] = pi;
            bf16_t* cm = CMAT + (size_t)(l * 16 + g) * 16 * 128;
            for (int c = 0; c < 16; ++c) { cm[c * 128 + p] = f2bf(INF(15)[((l * 16 + g) * 16 + c) * 64 + p]); cm[c * 128 + 64 + p] = f2bf(-INF(16)[((l * 16 + g) * 16 + c) * 64 + p]); }
        }
        for (int i = F.bid * 512 + F.tid; i < 512; i += F.G * 512) { const float lam = INF(32)[i]; MISCT[i] = 8.f * log1pf(__expf(-lam)); }
        if (F.bid == 0 && F.tid < 2) { const int l = F.tid; float s1 = 0.f, s2 = 0.f;
            for (int d = 0; d < 32; ++d) { s1 += INF(35)[l * 32 + d] * INF(36)[l * 32 + d]; s2 += INF(37)[l * 32 + d] * INF(38)[l * 32 + d]; }
            const float lam_init = 0.8f - 0.6f * expf(-0.3f * (float)l);
            MISCT[512 + l] = expf(s1) - expf(s2) + lam_init; MISCT[514 + l] = lam_init;
            float gq = 0.f, gk = 0.f; for (int d = 0; d < 96; ++d) { gq = fmaxf(gq, fabsf(INF(24)[l * 96 + d])); gk = fmaxf(gk, fabsf(INF(25)[l * 96 + d])); }
            MISCT[516 + l * 4 + 0] = 1.02f * gq * gk * 9.797958971f * LOG2E;
            gq = 0.f; gk = 0.f; for (int d = 0; d < 32; ++d) { gq = fmaxf(gq, fabsf(INF(33)[l * 32 + d])); gk = fmaxf(gk, fabsf(INF(34)[l * 32 + d])); }
            float bm = 0.f; for (int i = 0; i < 128; ++i) bm = fmaxf(bm, fabsf(INF(3)[i]));
            MISCT[516 + l * 4 + 1] = 1.02f * gq * gk * 5.656854249f * LOG2E + bm * LOG2E;
            gq = 0.f; gk = 0.f; for (int d = 0; d < 64; ++d) { gq = fmaxf(gq, fabsf(INF(46)[l * 64 + d])); gk = fmaxf(gk, fabsf(INF(47)[l * 64 + d])); }
            MISCT[516 + l * 4 + 2] = 1.02f * gq * gk * 8.f * LOG2E; }
        for (int i = F.bid * 512 + F.tid; i < 4 * 384; i += F.G * 512) { const int h = i / 384, dd = i % 384 - 128, d = dd > 127 ? 127 : dd; int bk;
            if (d < 16) bk = d < 0 ? 0 : d; else { const float lr_ = logf((float)d / 16.f) / logf(8.f); bk = 16 + (int)(lr_ * 16.f); if (bk > 31) bk = 31; }
            MISCT[1024 + i] = dd < 0 ? 0.f : INF(3)[bk * 4 + h] * LOG2E; }
        for (int m = F.gw; m < MTOK; m += F.ngw) {
            const f32x4* xr = (const f32x4*)(INF(0) + (size_t)m * DM) + F.lane; float s = 0.f;
            u32x2* o8 = (u32x2*)(XB + (size_t)m * DM) + F.lane;
#pragma unroll
            for (int j = 0; j < 4; ++j) { const f32x4 v = xr[64 * j]; s += (v.x * v.x + v.y * v.y) + (v.z * v.z + v.w * v.w); u32x2 w; w.x = cvt_pk_bf16(v.x, v.y); w.y = cvt_pk_bf16(v.z, v.w); o8[64 * j] = w; }
            s = wave_sum(s); if (F.lane < 16) RS[(size_t)m * 16 + F.lane] = F.lane == 0 ? s : 0.f;
        }
    }
    SEAM(0);

    for (int l = 0; l < 2; ++l) {
        const int pb = 1 + 10 * l;
        if (IN(pb + 0)) { PHASE_BEGIN();
            pg8::Gemm g{XB, (const bf16_t*)(WLP(l) + WL_WIN), DM, nullptr}; pg8::StaticOrder S; S.init(MTOK / 256, NIN / 256, F.G, F.bid);
            pg8::EpiIn E{ZS, ZG, RS + (size_t)(l == 0 ? 0 : 3) * MTOK * 16, INF(9) + (size_t)l * 4 * DM};
            pg8::gemm_phase<pg8::EpiIn, pg8::StaticOrder, true, false>(F.lds, g, S, E);
        }
        SEAM(pb + 0);
        if (IN(pb + 1)) { PHASE_BEGIN();
            const int lane = F.lane, r = lane & 31, hi = lane >> 5;
            bf16_t* QM = (bf16_t*)(ws + WS_QM); bf16_t* KM = (bf16_t*)(ws + WS_KM); bf16_t* VMT = (bf16_t*)(ws + WS_VMT);
            if (SUB(0) && F.wave < 2) for (int tt = F.bid * 2 + F.wave; tt < 512; tt += F.G * 2) {
                const int row = tt * 32 + r, b = row >> 12, s = row & 4095;
                bf16x8 xq[12]; float ss = 0.f;
#pragma unroll
                for (int ks = 0; ks < 12; ++ks) { xq[ks] = ldg8(ZS + (size_t)row * ZSW + C_CQ + 16 * ks + 8 * hi); ss += sq8(xq[ks]); }
                ss += __shfl_xor(ss, 32); const float rc = frsq(ss * (1.f / 192.f) + EPS);
                const float pos = (float)((const int*)INF(2))[row]; float cs[8], sn[8];
#pragma unroll
                for (int i = 0; i < 8; ++i) { const int fi = crow(i, hi); const float inv = exp2f(-(float)fi * (13.287712379549449f / 16.f)); sincos_red(pos * inv, sn[i], cs[i]); }
                const bf16_t* W = (const bf16_t*)(WLP(l) + WL_SM + SM_WUQ); const float* gq = INF(24) + l * 96;
#pragma unroll 1
                for (int hd = 0; hd < 4; ++hd) {
                    f32x16 acc[3] = {f32x16{}, f32x16{}, f32x16{}};
#pragma unroll
                    for (int ft = 0; ft < 3; ++ft) {
#pragma unroll
                        for (int ks = 0; ks < 12; ++ks) acc[ft] = MFMA32(ldg8(W + (size_t)(hd * 96 + 32 * ft + r) * 192 + 16 * ks + 8 * hi), xq[ks], acc[ft]); }
                    float s2 = 0.f;
#pragma unroll
                    for (int ft = 0; ft < 3; ++ft)
#pragma unroll
                        for (int q = 0; q < 16; ++q) { acc[ft][q] *= rc; s2 += acc[ft][q] * acc[ft][q]; }
                    s2 += __shfl_xor(s2, 32); const float rq = frsq(s2 * (1.f / 96.f) + EPS);
#pragma unroll
                    for (int ft = 0; ft < 3; ++ft)
#pragma unroll
                        for (int q = 0; q < 16; ++q) acc[ft][q] *= rq * gq[32 * ft + crow(q, hi)];
#pragma unroll
                    for (int q = 0; q < 8; ++q) { const float x1 = acc[2][q], x2 = acc[2][q + 8]; acc[2][q] = x1 * cs[q] - x2 * sn[q]; acc[2][q + 8] = x1 * sn[q] + x2 * cs[q]; }
                    const float qs = 0.10206207261596577f * LOG2E;
                    bf16_t* dst = QM + ((size_t)(b * 4 + hd) * SEQ + s) * 96;
#pragma unroll
                    for (int ft = 0; ft < 3; ++ft)
#pragma unroll
                        for (int rg = 0; rg < 4; ++rg) { u32x2 w; w.x = cvt_pk_bf16(acc[ft][4 * rg] * qs, acc[ft][4 * rg + 1] * qs); w.y = cvt_pk_bf16(acc[ft][4 * rg + 2] * qs, acc[ft][4 * rg + 3] * qs);
                            *(u32x2*)(dst + 32 * ft + 8 * rg + 4 * hi) = w; }
                }
            }
            if (SUB(1) && (F.wave == 2 || F.wave == 3)) for (int tt = F.bid * 2 + F.wave - 2; tt < 512; tt += F.G * 2) {
                const int row = tt * 32 + r, b = row >> 12, s = row & 4095;
                bf16x8 xk[8]; float ss = 0.f;
#pragma unroll
                for (int ks = 0; ks < 8; ++ks) { xk[ks] = ldg8(ZS + (size_t)row * ZSW + C_CKV + 16 * ks + 8 * hi); ss += sq8(xk[ks]); }
                ss += __shfl_xor(ss, 32); const float rc = frsq(ss * (1.f / 128.f) + EPS);
                float kp[16]; float sskp = 0.f;
#pragma unroll
                for (int rg = 0; rg < 4; ++rg) { const u32x2 w = *(const u32x2*)(ZS + (size_t)row * ZSW + C_KPE + 8 * rg + 4 * hi);
                    kp[4 * rg] = bflo(w.x); kp[4 * rg + 1] = bfhi(w.x); kp[4 * rg + 2] = bflo(w.y); kp[4 * rg + 3] = bfhi(w.y); }
#pragma unroll
                for (int q = 0; q < 16; ++q) sskp += kp[q] * kp[q];
                const float pos = (float)((const int*)INF(2))[row]; float cs[8], sn[8];
#pragma unroll
                for (int i = 0; i < 8; ++i) { const int fi = crow(i, hi); const float inv = exp2f(-(float)fi * (13.287712379549449f / 16.f)); sincos_red(pos * inv, sn[i], cs[i]); }
                const bf16_t* W = (const bf16_t*)(WLP(l) + WL_SM + SM_WUKV); const float* gk = INF(25) + l * 96;
#pragma unroll 1
                for (int hd = 0; hd < 4; ++hd) {
                    f32x16 acc[4] = {f32x16{}, f32x16{}, f32x16{}, f32x16{}};
#pragma unroll
                    for (int ft = 0; ft < 4; ++ft) {
#pragma unroll
                        for (int ks = 0; ks < 8; ++ks) acc[ft] = MFMA32(ldg8(W + (size_t)(hd * 128 + 32 * ft + r) * 128 + 16 * ks + 8 * hi), xk[ks], acc[ft]); }
                    float s2 = sskp;
#pragma unroll
                    for (int ft = 0; ft < 2; ++ft)
#pragma unroll
                        for (int q = 0; q < 16; ++q) { acc[ft][q] *= rc; s2 += acc[ft][q] * acc[ft][q]; }
                    s2 += __shfl_xor(s2, 32); const float rk = frsq(s2 * (1.f / 96.f) + EPS);
                    float kr[16];
#pragma unroll
                    for (int q = 0; q < 16; ++q) kr[q] = kp[q] * rk * gk[64 + crow(q, hi)];
#pragma unroll
                    for (int q = 0; q < 8; ++q) { const float x1 = kr[q], x2 = kr[q + 8]; kr[q] = x1 * cs[q] - x2 * sn[q]; kr[q + 8] = x1 * sn[q] + x2 * cs[q]; }
                    bf16_t* dst = KM + ((size_t)(b * 4 + hd) * SEQ + s) * 96;
#pragma unroll
                    for (int ft = 0; ft < 2; ++ft)
#pragma unroll
                        for (int rg = 0; rg < 4; ++rg) { const float* gp = gk + 32 * ft + 8 * rg + 4 * hi; u32x2 w;
                            w.x = cvt_pk_bf16(acc[ft][4 * rg] * rk * gp[0], acc[ft][4 * rg + 1] * rk * gp[1]); w.y = cvt_pk_bf16(acc[ft][4 * rg + 2] * rk * gp[2], acc[ft][4 * rg + 3] * rk * gp[3]);
                            *(u32x2*)(dst + 32 * ft + 8 * rg + 4 * hi) = w; }
#pragma unroll
                    for (int rg = 0; rg < 4; ++rg) { u32x2 w; w.x = cvt_pk_bf16(kr[4 * rg], kr[4 * rg + 1]); w.y = cvt_pk_bf16(kr[4 * rg + 2], kr[4 * rg + 3]); *(u32x2*)(dst + 64 + 8 * rg + 4 * hi) = w; }
                    bf16_t* vd = VMT + (size_t)(b * 4 + hd) * 64 * SEQ + s;
#pragma unroll
                    for (int ft = 2; ft < 4; ++ft)
#pragma unroll
                        for (int q = 0; q < 16; ++q) vd[(size_t)(32 * (ft - 2) + crow(q, hi)) * SEQ] = f2bf(acc[ft][q] * rc);
                }
            }
            if (SUB(2)) {
                bf16_t* QD = (bf16_t*)(ws + WS_QD); bf16_t* KD = (bf16_t*)(ws + WS_KD); bf16_t* VDT = (bf16_t*)(ws + WS_VDT);
                const float* gqn = INF(33) + l * 32; const float* gkn = INF(34) + l * 32;
                for (int i = F.bid * 512 + F.tid; i < MTOK * 16; i += F.G * 512) {
                    const int row = i & (MTOK - 1), j = i >> 14, half = j & 1, hd = (j >> 1) & 3, isk = j >> 3;
                    const bf16_t* src = ZS + (size_t)row * ZSW + (isk ? C_KD : C_QD) + hd * 64 + half * 32;
                    bf16x8 v[4]; float ss = 0.f;
#pragma unroll
                    for (int c = 0; c < 4; ++c) { v[c] = ldg8(src + 8 * c); ss += sq8(v[c]); }
                    const float rs = frsq(ss * (1.f / 32.f) + EPS) * (isk ? 1.f : 0.17677669529663687f * LOG2E);
                    const float* gg = isk ? gkn : gqn; const int b = row >> 12, s = row & 4095;
                    bf16_t* dst = (isk ? KD : QD) + ((size_t)(b * 4 + hd) * SEQ + s) * 64 + half * 32;
#pragma unroll
                    for (int c = 0; c < 4; ++c) { u32x4 w = *(u32x4*)&v[c]; const float* gp = gg + 8 * c;
                        w.x = cvt_pk_bf16(bflo(w.x) * rs * gp[0], bfhi(w.x) * rs * gp[1]); w.y = cvt_pk_bf16(bflo(w.y) * rs * gp[2], bfhi(w.y) * rs * gp[3]);
                        w.z = cvt_pk_bf16(bflo(w.z) * rs * gp[4], bfhi(w.z) * rs * gp[5]); w.w = cvt_pk_bf16(bflo(w.w) * rs * gp[6], bfhi(w.w) * rs * gp[7]);
                        *(u32x4*)(dst + 8 * c) = w; }
                }
                for (int i = F.bid * 512 + F.tid; i < MTOK * 32; i += F.G * 512) {
                    const int row = i & (MTOK - 1), j = i >> 14, oc = j & 7, hd = j >> 3, b = row >> 12, s = row & 4095;
                    const bf16x8 v = ldg8(ZS + (size_t)row * ZSW + C_VD + hd * 64 + oc * 8);
                    bf16_t* vd = VDT + ((size_t)(b * 4 + hd) * 64 + oc * 8) * SEQ + s;
#pragma unroll
                    for (int e = 0; e < 8; ++e) vd[(size_t)e * SEQ] = (bf16_t)v[e];
                }
            }
            if (SUB(3)) {
                float* LA = (float*)(ws + WS_LA); float* LI = (float*)(ws + WS_LI); float* LSA = (float*)(ws + WS_LSUM); float* LSH = LSA + NB * 128 * 256;
                const float* cw = INF(26) + l * 4 * 256; const float* cb = INF(27) + l * 256; const float* br = INF(29) + l * 256; const float* bi = INF(31) + l * 256;
                const float* c8 = MISCT + l * 256;
                LAS float* lsa = (LAS float*)(F.lds + F.wave * 16384); LAS float* lsh = lsa + 32 * 64;
                for (int tk = F.gw; tk < NB * 128 * 4; tk += F.ngw) {
                    const int n = tk & 3, tile = (tk >> 2) & 127, b = tk >> 9, s = tile * 32 + r, row = b * SEQ + s, cbase = 64 * n;
                    bf16x8 xcb[4]; float xcf[4][8];
#pragma unroll
                    for (int ks = 0; ks < 4; ++ks) {
                        const int c0 = cbase + 16 * ks + 8 * hi;
#pragma unroll
                        for (int e = 0; e < 8; ++e) xcf[ks][e] = cb[c0 + e];
#pragma unroll
                        for (int k = 0; k < 4; ++k) { const int sr = s - 3 + k;
                            if (sr >= 0) { const bf16x8 xv = ldg8(ZS + (size_t)(b * SEQ + sr) * ZSW + C_XLRU + c0); const u32x4 w = *(const u32x4*)&xv; const float* wk = cw + k * 256 + c0;
                                xcf[ks][0] += wk[0] * bflo(w.x); xcf[ks][1] += wk[1] * bfhi(w.x); xcf[ks][2] += wk[2] * bflo(w.y); xcf[ks][3] += wk[3] * bfhi(w.y);
                                xcf[ks][4] += wk[4] * bflo(w.z); xcf[ks][5] += wk[5] * bfhi(w.z); xcf[ks][6] += wk[6] * bflo(w.w); xcf[ks][7] += wk[7] * bfhi(w.w); } }
                        u32x4 pw; pw.x = cvt_pk_bf16(xcf[ks][0], xcf[ks][1]); pw.y = cvt_pk_bf16(xcf[ks][2], xcf[ks][3]); pw.z = cvt_pk_bf16(xcf[ks][4], xcf[ks][5]); pw.w = cvt_pk_bf16(xcf[ks][6], xcf[ks][7]); xcb[ks] = *(bf16x8*)&pw;
                    }
                    const bf16_t* Wr = (const bf16_t*)(WLP(l) + WL_SM + SM_WR) + n * 4096; const bf16_t* Wi = (const bf16_t*)(WLP(l) + WL_SM + SM_WI) + n * 4096;
                    f32x16 ar_[2] = {f32x16{}, f32x16{}}, ai_[2] = {f32x16{}, f32x16{}};
#pragma unroll
                    for (int ft = 0; ft < 2; ++ft)
#pragma unroll
                        for (int ks = 0; ks < 4; ++ks) { ar_[ft] = MFMA32(ldg8(Wr + (32 * ft + r) * 64 + 16 * ks + 8 * hi), xcb[ks], ar_[ft]); ai_[ft] = MFMA32(ldg8(Wi + (32 * ft + r) * 64 + 16 * ks + 8 * hi), xcb[ks], ai_[ft]); }
                    float xloc[4][4], xrcv[4][4];
#pragma unroll
                    for (int ks = 0; ks < 4; ++ks)
#pragma unroll
                        for (int j = 0; j < 4; ++j) { xloc[ks][j] = hi ? xcf[ks][4 + j] : xcf[ks][j]; const float snd = hi ? xcf[ks][j] : xcf[ks][4 + j]; xrcv[ks][j] = __shfl_xor(snd, 32); }
#pragma unroll
                    for (int ft = 0; ft < 2; ++ft)
#pragma unroll
                        for (int rg = 0; rg < 4; ++rg) {
                            const int c0 = cbase + 32 * ft + 8 * rg + 4 * hi, ks = 2 * ft + (rg >> 1);
                            f32x4 av, iv;
#pragma unroll
                            for (int e = 0; e < 4; ++e) { const float xce = ((rg & 1) == hi) ? xloc[ks][e] : xrcv[ks][e];
                                const float rr = fsigmoid(ar_[ft][4 * rg + e] + br[c0 + e]), ii = fsigmoid(ai_[ft][4 * rg + e] + bi[c0 + e]);
                                const float la = -rr * c8[c0 + e]; const float a = fexp2(la * LOG2E); av[e] = a; iv[e] = sqrtf(fmaxf(1.f - a * a, 0.f)) * ii * xce; }
                            *(f32x4*)(LA + (size_t)row * 256 + c0) = av; *(f32x4*)(LI + (size_t)row * 256 + c0) = iv;
                            { const int sc_ = (32 * ft + 8 * rg + 4 * hi) ^ ((r & 7) << 2); *(LAS f32x4*)(lsa + r * 64 + sc_) = av; *(LAS f32x4*)(lsh + r * 64 + sc_) = iv; }
                        }
                    asm volatile("s_waitcnt lgkmcnt(0)" ::: "memory");
                    {
                        float ta = 1.f, th = 0.f;
#pragma unroll
                        for (int t = 0; t < 32; ++t) { const float a_ = lsa[t * 64 + (lane ^ ((t & 7) << 2))], h_ = lsh[t * 64 + (lane ^ ((t & 7) << 2))]; th = a_ * th + h_; ta = ta * a_; }
                        LSA[(size_t)(b * 128 + tile) * 256 + cbase + lane] = ta; LSH[(size_t)(b * 128 + tile) * 256 + cbase + lane] = th;
                    }
                    asm volatile("s_waitcnt lgkmcnt(0)" ::: "memory");
                }
            }
            if (SUB(4)) {
                float* S5S = (float*)(ws + WS_S5S);
                const int t5cnt = F.wave < 4 ? 1 : (F.wave == 4 ? 0 : 4), t5off = F.wave < 4 ? F.wave : 4 + 4 * (F.wave - 5);
                for (int tbk = F.bid; tbk < NB * 64; tbk += F.G) for (int tj = 0; tj < t5cnt; ++tj) { const int tk = tbk * 16 + t5off + tj;
                    const int g = tk & 15, ch = (tk >> 4) & 63, b = tk >> 10;
                    const float* tb = S5T + (size_t)(l * 16 + g) * 36 * 64 + lane;
                    const float ar = tb[32 * 64], ai = tb[33 * 64];
                    LAS unsigned char* tile = F.lds + F.wave * 16384;
                    float hr = 0.f, hi2 = 0.f;
#pragma unroll 1
                    for (int hf = 0; hf < 2; ++hf) {
                        s5_bu_tile(tile, BBF + (size_t)(l * 16 + g) * 128 * 16, ZS + (size_t)(b * SEQ + ch * 64 + hf * 32) * ZSW + C_S5 + 16 * g, lane);
#pragma unroll 8
                        for (int t2 = 0; t2 < 32; ++t2) { const float bur = bf2f(*(const LAS bf16_t*)(tile + t2 * 272 + lane * 2)), bui = bf2f(*(const LAS bf16_t*)(tile + t2 * 272 + 128 + lane * 2));
                            const float nr = ar * hr - ai * hi2 + bur, ni = ar * hi2 + ai * hr + bui; hr = nr; hi2 = ni; }
                        asm volatile("s_waitcnt lgkmcnt(0)" ::: "memory");
                    }
                    float* dst = S5S + ((size_t)((b * 64 + ch) * 16 + g) * 2) * 64 + lane; dst[0] = hr; dst[64] = hi2;
                }
            }
            if (SUB(5) && l == 0) {
                bf16_t* KX = (bf16_t*)(ws + WS_KX); bf16_t* VXT = (bf16_t*)(ws + WS_VXT);
                if (F.wave == 4) for (int tk = F.bid; tk < 2 * 32 * 4; tk += F.G) {
                    const int hd = tk & 3, mt = (tk >> 2) & 31, ly = tk >> 7, row = mt * 32 + r, b = row >> 8, jm = row & 255;
                    const bf16_t* W = (const bf16_t*)(ws + WS_WL + ly * WL_STRIDE + WL_WXKV);
                    f32x16 acc[4] = {f32x16{}, f32x16{}, f32x16{}, f32x16{}}; float ss = 0.f;
                    const float* mp = INF(1) + (size_t)row * DM + 8 * hi;
#pragma unroll 2
                    for (int ks = 0; ks < 64; ++ks) {
                        const f32x4 m0 = *(const f32x4*)(mp + 16 * ks), m1 = *(const f32x4*)(mp + 16 * ks + 4);
                        ss += (m0.x * m0.x + m0.y * m0.y) + (m0.z * m0.z + m0.w * m0.w) + (m1.x * m1.x + m1.y * m1.y) + (m1.z * m1.z + m1.w * m1.w);
                        const u32x4 pw = pg8::pack8(m0, m1); const bf16x8 xb = *(const bf16x8*)&pw;
#pragma unroll
                        for (int f = 0; f < 4; ++f) { const int wrow = (f < 2 ? 64 * hd + 32 * f : 256 + 64 * hd + 32 * (f - 2)) + r; acc[f] = MFMA32(ldg8(W + (size_t)wrow * DM + 16 * ks + 8 * hi), xb, acc[f]); }
                    }
                    ss += __shfl_xor(ss, 32); const float rm = frsq(ss * (1.f / DM) + EPS);
                    float s2 = 0.f;
#pragma unroll
                    for (int f = 0; f < 2; ++f)
#pragma unroll
                        for (int q = 0; q < 16; ++q) { acc[f][q] *= rm; s2 += acc[f][q] * acc[f][q]; }
                    s2 += __shfl_xor(s2, 32); const float rk = frsq(s2 * (1.f / 64.f) + EPS);
                    const float* gk = INF(47) + ly * 64;
                    bf16_t* kd = KX + ((size_t)(ly * 16 + b * 4 + hd) * 256 + jm) * 64;
#pragma unroll
                    for (int f = 0; f < 2; ++f)
#pragma unroll
                        for (int rg = 0; rg < 4; ++rg) { const float* gp = gk + 32 * f + 8 * rg + 4 * hi; u32x2 w;
                            w.x = cvt_pk_bf16(acc[f][4 * rg] * rk * gp[0], acc[f][4 * rg + 1] * rk * gp[1]); w.y = cvt_pk_bf16(acc[f][4 * rg + 2] * rk * gp[2], acc[f][4 * rg + 3] * rk * gp[3]);
                            *(u32x2*)(kd + 32 * f + 8 * rg + 4 * hi) = w; }
                    bf16_t* vd = VXT + (size_t)(ly * 16 + b * 4 + hd) * 64 * 256 + jm;
#pragma unroll
                    for (int f = 2; f < 4; ++f)
#pragma unroll
                        for (int q = 0; q < 16; ++q) vd[(size_t)(32 * (f - 2) + crow(q, hi)) * 256] = f2bf(acc[f][q] * rm);
                }
            }
        }
        SEAM(pb + 1);
        if (IN(pb + 2)) {
            if (SUB(6)) { PHASE_BEGIN();
            const int lane = F.lane, r32 = lane & 31, hi = lane >> 5, wid = F.wave;
            volatile LAS unsigned* qslot = (volatile LAS unsigned*)(F.lds + MISC_OFF + 64);
            for (int it = queue_pull(F.ctl + CW_Q + 64 * (4 * l + 0), qslot, F.tid); it < 256; it = queue_pull(F.ctl + CW_Q + 64 * (4 * l + 0), qslot, F.tid)) {
                {
                    const int bh = it & 15, qt = 15 - (it >> 4), b = bh >> 2, hd = bh & 3;
                    const bf16_t* QM = (const bf16_t*)(ws + WS_QM) + (size_t)bh * SEQ * 96; const bf16_t* KM = (const bf16_t*)(ws + WS_KM) + (size_t)bh * SEQ * 96;
                    const bf16_t* VMT = (const bf16_t*)(ws + WS_VMT) + (size_t)bh * 64 * SEQ;
                    f32x16 o[1][2]; float lsum[1];
                    attn_unit<96, 1, true, false, false>(F.lds, QM + (size_t)qt * 256 * 96, 96, KM, VMT, SEQ, 4 * (qt + 1), 256 * qt, nullptr, nullptr, 1.f, MISCT[516 + l * 4 + 0], o, lsum);
                    const int row = b * SEQ + qt * 256 + wid * 32 + r32;
                    attn_store(YB + (size_t)1 * MTOK * 256 + (size_t)row * 256 + hd * 64, o[0], frcp(lsum[0]), hi);
                }
            } }
            if (SUB(7)) { PHASE_BEGIN();
            const int lane = F.lane, r32 = lane & 31, hi = lane >> 5, wid = F.wave;
            LAS float* lut = (LAS float*)(F.lds + 106496);
            for (int i = F.tid; i < 4 * 384; i += 512) lut[i] = MISCT[1024 + i];
            __syncthreads();
            volatile LAS unsigned* qslot = (volatile LAS unsigned*)(F.lds + MISC_OFF + 64);
            for (int it = queue_pull(F.ctl + CW_Q + 64 * (4 * l + 1), qslot, F.tid); it < 256; it = queue_pull(F.ctl + CW_Q + 64 * (4 * l + 1), qslot, F.tid)) {
                {
                    const int bh = it & 15, qt = 15 - (it >> 4), b = bh >> 2, hd = bh & 3;
                    const bf16_t* QD = (const bf16_t*)(ws + WS_QD) + (size_t)bh * SEQ * 64; const bf16_t* KD = (const bf16_t*)(ws + WS_KD) + (size_t)bh * SEQ * 64;
                    const bf16_t* VDT = (const bf16_t*)(ws + WS_VDT) + (size_t)bh * 64 * SEQ;
                    f32x16 o[2][2]; float lsum[2];
                    attn_unit<64, 2, true, true, false>(F.lds, QD + (size_t)qt * 256 * 64, 64, KD, VDT, SEQ, 4 * (qt + 1), 256 * qt, lut + hd * 384, nullptr, 1.f, MISCT[516 + l * 4 + 1], o, lsum);
                    const float lam = MISCT[512 + l], lam_init = MISCT[514 + l];
                    const float i1 = frcp(lsum[0]), i2 = lam * frcp(lsum[1]); float ss = 0.f;
#pragma unroll
                    for (int dt = 0; dt < 2; ++dt)
#pragma unroll
                        for (int q = 0; q < 16; ++q) { const float v = o[0][dt][q] * i1 - o[1][dt][q] * i2; o[0][dt][q] = v; ss += v * v; }
                    ss += __shfl_xor(ss, 32); const float rs = frsq(ss * (1.f / 64.f) + EPS) * (1.f - lam_init);
                    const float* gs = INF(39) + l * 64;
#pragma unroll
                    for (int dt = 0; dt < 2; ++dt)
#pragma unroll
                        for (int q = 0; q < 16; ++q) o[0][dt][q] *= gs[32 * dt + crow(q, hi)];
                    const int row = b * SEQ + qt * 256 + wid * 32 + r32;
                    attn_store(YB + (size_t)3 * MTOK * 256 + (size_t)row * 256 + hd * 64, o[0], rs, hi);
                }
            } }
            if (SUB(8)) { PHASE_BEGIN();
            const int lane = F.lane, r32 = lane & 31, hi = lane >> 5, wid = F.wave;
            volatile LAS unsigned* qslot = (volatile LAS unsigned*)(F.lds + MISC_OFF + 64);
            for (int it = queue_pull(F.ctl + CW_Q + 64 * (4 * l + 2), qslot, F.tid); it < 256; it = queue_pull(F.ctl + CW_Q + 64 * (4 * l + 2), qslot, F.tid)) {
                {
                    const int b = it >> 6, ch = it & 63, row0 = b * SEQ + ch * 64;
                    LAS unsigned char* hbuf = F.lds + wid * 8704;
                    LAS unsigned char* ypre = F.lds + 69632;
                    const float* S5S = (const float*)(ws + WS_S5S);
#pragma unroll 1
                    for (int gg = 0; gg < 2; ++gg) {
                        const int g = 2 * wid + gg;
                        const float* tb = S5T + (size_t)(l * 16 + g) * 36 * 64 + lane;
                        const float ar = tb[32 * 64], ai = tb[33 * 64], a64r = tb[34 * 64], a64i = tb[35 * 64];
                        float hr = 0.f, hi2 = 0.f;
                        for (int c0 = 0; c0 < ch; c0 += 8) {
                            float sr[8], si[8];
#pragma unroll
                            for (int u = 0; u < 8; ++u) { const int c = c0 + u; const bool ok = c < ch; const float* sp = S5S + ((size_t)((b * 64 + (ok ? c : 0)) * 16 + g) * 2) * 64 + lane; sr[u] = ok ? sp[0] : 0.f; si[u] = ok ? sp[64] : 0.f; }
#pragma unroll
                            for (int u = 0; u < 8; ++u) { if (c0 + u < ch) { const float nr = a64r * hr - a64i * hi2 + sr[u], ni = a64r * hi2 + a64i * hr + si[u]; hr = nr; hi2 = ni; } }
                        }
                        bf16x8 cf[4];
#pragma unroll
                        for (int ks = 0; ks < 4; ++ks) cf[ks] = ldg8(CMAT + (size_t)(l * 16 + g) * 16 * 128 + (lane & 15) * 128 + 32 * ks + 8 * (lane >> 4));
                        const float* dsk = INF(17) + l * 256 + 16 * g + 4 * (lane >> 4);
#pragma unroll 1
                        for (int hf = 0; hf < 2; ++hf) {
                            s5_bu_tile(hbuf, BBF + (size_t)(l * 16 + g) * 128 * 16, ZS + (size_t)(row0 + hf * 32) * ZSW + C_S5 + 16 * g, lane);
#pragma unroll 8
                            for (int t2 = 0; t2 < 32; ++t2) { const float bur = bf2f(*(const LAS bf16_t*)(hbuf + t2 * 272 + lane * 2)), bui = bf2f(*(const LAS bf16_t*)(hbuf + t2 * 272 + 128 + lane * 2));
                                const float nr = ar * hr - ai * hi2 + bur, ni = ar * hi2 + ai * hr + bui; hr = nr; hi2 = ni;
                                *(LAS bf16_t*)(hbuf + t2 * 272 + lane * 2) = f2bf(hr); *(LAS bf16_t*)(hbuf + t2 * 272 + 128 + lane * 2) = f2bf(hi2);
                            }
                            asm volatile("s_waitcnt lgkmcnt(0)" ::: "memory");
#pragma unroll
                            for (int tq = 0; tq < 2; ++tq) {
                                f32x4 yv = (f32x4){0.f, 0.f, 0.f, 0.f};
#pragma unroll
                                for (int ks = 0; ks < 4; ++ks) { const bf16x8 hb = *(const LAS bf16x8*)(hbuf + (16 * tq + (lane & 15)) * 272 + (32 * ks + 8 * (lane >> 4)) * 2); yv = MFMA16(cf[ks], hb, yv); }
                                const int tl = hf * 32 + 16 * tq + (lane & 15);
                                const u32x2 uw = *(const u32x2*)(ZS + (size_t)(row0 + tl) * ZSW + C_S5 + 16 * g + 4 * (lane >> 4));
                                yv[0] = fgelu(yv[0] + dsk[0] * bflo(uw.x)); yv[1] = fgelu(yv[1] + dsk[1] * bfhi(uw.x)); yv[2] = fgelu(yv[2] + dsk[2] * bflo(uw.y)); yv[3] = fgelu(yv[3] + dsk[3] * bfhi(uw.y));
                                u32x2 pw; pw.x = cvt_pk_bf16(yv[0], yv[1]); pw.y = cvt_pk_bf16(yv[2], yv[3]);
                                *(LAS u32x2*)(ypre + tl * 528 + (16 * g + 4 * (lane >> 4)) * 2) = pw;
                            }
                            asm volatile("s_waitcnt lgkmcnt(0)" ::: "memory");
                        }
                    }
                    __syncthreads();
                    {
                        const bf16_t* WG = (const bf16_t*)(WLP(l) + WL_SM + SM_WGLU);
                        f32x16 acc[2] = {f32x16{}, f32x16{}};
#pragma unroll 4
                        for (int ks = 0; ks < 16; ++ks) { const bf16x8 a = ldg8(WG + (size_t)(32 * wid + r32) * 256 + 16 * ks + 8 * hi);
#pragma unroll
                            for (int tt = 0; tt < 2; ++tt) acc[tt] = MFMA32(a, *(const LAS bf16x8*)(ypre + (32 * tt + r32) * 528 + (16 * ks + 8 * hi) * 2), acc[tt]); }
                        const float* bg = INF(19) + l * 256;
#pragma unroll
                        for (int tt = 0; tt < 2; ++tt)
#pragma unroll
                            for (int rg = 0; rg < 4; ++rg) { const int n0 = 32 * wid + 8 * rg + 4 * hi, t = 32 * tt + r32;
                                const u32x2 yw = *(const LAS u32x2*)(ypre + t * 528 + n0 * 2); u32x2 ow;
                                ow.x = cvt_pk_bf16(bflo(yw.x) * fsigmoid(acc[tt][4 * rg] + bg[n0]), bfhi(yw.x) * fsigmoid(acc[tt][4 * rg + 1] + bg[n0 + 1]));
                                ow.y = cvt_pk_bf16(bflo(yw.y) * fsigmoid(acc[tt][4 * rg + 2] + bg[n0 + 2]), bfhi(yw.y) * fsigmoid(acc[tt][4 * rg + 3] + bg[n0 + 3]));
                                *(u32x2*)(YB + (size_t)(row0 + t) * 256 + n0) = ow; }
                    }
                    __syncthreads();
                }
            }
            }
            if (SUB(9)) { PHASE_BEGIN(); const int lane = F.lane;
                const float* LA = (const float*)(ws + WS_LA); const float* LI = (const float*)(ws + WS_LI); const float* LSA = (const float*)(ws + WS_LSUM); const float* LSH = LSA + NB * 128 * 256;
                volatile LAS unsigned* qslot = (volatile LAS unsigned*)(F.lds + MISC_OFF + 64);
                for (int it = queue_pull(F.ctl + CW_Q + 64 * (4 * l + 3), qslot, F.tid); it < NB * 64 * 4 / 8; it = queue_pull(F.ctl + CW_Q + 64 * (4 * l + 3), qslot, F.tid)) {
                    const int tk = (NB * 64 * 4 / 8 - 1 - it) * 8 + F.wave;
                    const int n = tk & 3, ch = (tk >> 2) & 63, b = tk >> 8, c = 64 * n + lane;
                    float h = 0.f;
                    for (int tp0 = 0; tp0 < 2 * ch; tp0 += 16) {
                        float ca[16], chh[16];
#pragma unroll
                        for (int u = 0; u < 16; ++u) { const int tp = tp0 + u; const bool ok = tp < 2 * ch; const size_t o = (size_t)(b * 128 + (ok ? tp : 0)) * 256 + c; ca[u] = ok ? LSA[o] : 1.f; chh[u] = ok ? LSH[o] : 0.f; }
#pragma unroll
                        for (int u = 0; u < 16; ++u) h = ca[u] * h + chh[u];
                    }
                    const int row0 = b * SEQ + ch * 64;
#pragma unroll 1
                    for (int t0 = 0; t0 < 64; t0 += 16) {
                        float la[16], li[16], gt[16];
#pragma unroll
                        for (int u = 0; u < 16; ++u) { const size_t o = (size_t)(row0 + t0 + u) * 256 + c; la[u] = LA[o]; li[u] = LI[o]; gt[u] = bf2f(ZS[(size_t)(row0 + t0 + u) * ZSW + C_GLRU + c]); }
#pragma unroll
                        for (int u = 0; u < 16; ++u) { h = la[u] * h + li[u]; gt[u] = h * fgelu(gt[u]); }
#pragma unroll
                        for (int u = 0; u < 16; ++u) YB[(size_t)2 * MTOK * 256 + (size_t)(row0 + t0 + u) * 256 + c] = f2bf(gt[u]);
                    }
                }
            }
        }
        SEAM(pb + 2);
        if (IN(pb + 3)) { PHASE_BEGIN();
            pg8::Gemm g{YB, (const bf16_t*)(WLP(l) + WL_PT), 256, nullptr}; pg8::MergeOrder S{F.G, F.bid};
            pg8::EpiMerge E{MG, ZG};
            pg8::gemm_phase<pg8::EpiMerge, pg8::MergeOrder, true, false>(F.lds, g, S, E);
        }
        SEAM(pb + 3);
        if (IN(pb + 4)) { PHASE_BEGIN();
            pg8::Gemm g{MG, (const bf16_t*)(WLP(l) + WL_WO), DM, nullptr}; pg8::StaticOrder S; S.init(MTOK / 256, DM / 256, F.G, F.bid);
            pg8::EpiRes<false> E{nullptr, XB, RS + (size_t)(l == 0 ? 1 : 4) * MTOK * 16, nullptr};
            pg8::gemm_phase<pg8::EpiRes<false>, pg8::StaticOrder, false, false>(F.lds, g, S, E);
        }
        SEAM(pb + 4);
        if (IN(pb + 5)) { PHASE_BEGIN();
            pg8::Gemm g{XB, (const bf16_t*)(WLP(l) + WL_WXQ), DM, nullptr}; pg8::StaticOrder S; S.init(MTOK / 256, 1, F.G, F.bid);
            pg8::EpiRowScale E{(bf16_t*)(ws + WS_QX), 256, RS + (size_t)(l == 0 ? 1 : 4) * MTOK * 16};
            pg8::gemm_phase<pg8::EpiRowScale, pg8::StaticOrder, false, false>(F.lds, g, S, E);
        }
        SEAM(pb + 5);
        if (IN(pb + 6)) { PHASE_BEGIN();
            const int lane = F.lane, r32 = lane & 31, hi = lane >> 5, wid = F.wave;
            for (int it = F.bid; it < 256; it += F.G) {
                const int hd = it & 3, rt = it >> 2, b = rt >> 4;
                const bf16_t* QX = (const bf16_t*)(ws + WS_QX) + (size_t)rt * 256 * 256 + hd * 64;
                const bf16_t* KX = (const bf16_t*)(ws + WS_KX) + (size_t)(l * 16 + b * 4 + hd) * 256 * 64;
                const bf16_t* VXT = (const bf16_t*)(ws + WS_VXT) + (size_t)(l * 16 + b * 4 + hd) * 64 * 256;
                f32x16 o[1][2]; float lsum[1];
                attn_unit<64, 1, false, false, true>(F.lds, QX, 256, KX, VXT, 256, 4, 0, nullptr, INF(46) + l * 64, 0.125f * LOG2E, MISCT[516 + l * 4 + 2], o, lsum);
                const int row = rt * 256 + wid * 32 + r32;
                attn_store((bf16_t*)(ws + WS_OX) + (size_t)row * 256 + hd * 64, o[0], frcp(lsum[0]), hi);
            }
        }
        SEAM(pb + 6);
        if (IN(pb + 7)) { PHASE_BEGIN();
            pg8::Gemm g{(const bf16_t*)(ws + WS_OX), (const bf16_t*)(WLP(l) + WL_WXO), 256, nullptr}; pg8::StaticOrder S; S.init(MTOK / 256, DM / 256, F.G, F.bid);
            if (l == 0) { pg8::EpiRes<false> E{nullptr, XB, RS + (size_t)2 * MTOK * 16, nullptr}; pg8::gemm_phase<pg8::EpiRes<false>, pg8::StaticOrder, false, false>(F.lds, g, S, E); }
            else { pg8::EpiRes<false> E{nullptr, XB, RS + (size_t)5 * MTOK * 16, nullptr}; pg8::gemm_phase<pg8::EpiRes<false>, pg8::StaticOrder, false, false>(F.lds, g, S, E); }
        }
        SEAM(pb + 7);
        if (l == 0) {
            if (IN(9)) { PHASE_BEGIN();
                pg8::Gemm g{XB, (const bf16_t*)(ws + WS_WGU), DM, nullptr}; pg8::StaticOrder S; S.init(MTOK / 256, 2 * FF / 256, F.G, F.bid);
#if G2_FP8
                pg8::EpiSwiGLU8<true, false> E{ws + WS_HFF, FF, RS + (size_t)2 * MTOK * 16};
                pg8::gemm_phase<pg8::EpiSwiGLU8<true, false>, pg8::StaticOrder, true, false>(F.lds, g, S, E);
#else
                pg8::EpiSwiGLU<false> E{(bf16_t*)(ws + WS_HFF), FF, RS + (size_t)2 * MTOK * 16, nullptr};
                pg8::gemm_phase<pg8::EpiSwiGLU<false>, pg8::StaticOrder, true, false>(F.lds, g, S, E);
#endif
            }
            SEAM(9);
            if (IN(10)) { PHASE_BEGIN();
#if G2_FP8
                pg8::Gemm g{(const bf16_t*)(ws + WS_HFF), (const bf16_t*)(ws + WS_WD), FF / 2, nullptr}; pg8::StaticOrder S; S.init(MTOK / 256, DM / 256, F.G, F.bid);
                pg8::EpiRes<false, false, true> E{nullptr, XB, RS + (size_t)3 * MTOK * 16, nullptr};
                pg8::gemm_phase<pg8::EpiRes<false, false, true>, pg8::StaticOrder, false, false, true>(F.lds, g, S, E);
#else
                pg8::Gemm g{(const bf16_t*)(ws + WS_HFF), (const bf16_t*)(ws + WS_WD), FF, nullptr}; pg8::StaticOrder S; S.init(MTOK / 256, DM / 256, F.G, F.bid);
                pg8::EpiRes<false> E{nullptr, XB, RS + (size_t)3 * MTOK * 16, nullptr};
                pg8::gemm_phase<pg8::EpiRes<false>, pg8::StaticOrder, false, false>(F.lds, g, S, E);
#endif
            }
            SEAM(10);
        } else {
#define ROWTOK ((int*)(ws + WS_MOESM + MS_ROWTOK))
#define TOKW ((float*)(ws + WS_MOESM + MS_TOKW))
#define ASSIGN ((int*)(ws + WS_MOESM + MS_ASSIGN))
#define RSTD2 ((float*)(ws + WS_MOESM + MS_RSTD))
#define MCNT (F.ctl + CW_MOECNT)
            if (IN(19)) { PHASE_BEGIN();
                LAS float* wrs = (LAS float*)(F.lds);
                for (int i = F.tid; i < 8192; i += 512) wrs[i] = INF(51)[i] * INF(7)[DM + (i >> 3)];
                __syncthreads();
                if (SUB(10) && F.wave < 4) {
                    const int lane = F.lane;
                    for (int blk = F.bid; blk < 256; blk += F.G) {
                        unsigned cntv = 0u, mypack = 0u;
#pragma unroll 1
                        for (int j = 0; j < 16; ++j) {
                            const int tok = blk * 64 + F.wave * 16 + j;
                            const u32x2* xr = (const u32x2*)(XB + (size_t)tok * DM) + lane;
                            float lg[8] = {0.f, 0.f, 0.f, 0.f, 0.f, 0.f, 0.f, 0.f}; float ss = 0.f; f32x4 xv4[4];
#pragma unroll
                            for (int q = 0; q < 4; ++q) { const u32x2 xw = xr[64 * q]; const f32x4 v = {bflo(xw.x), bfhi(xw.x), bflo(xw.y), bfhi(xw.y)}; const int k0 = 256 * q + 4 * lane; xv4[q] = v;
                                ss += (v.x * v.x + v.y * v.y) + (v.z * v.z + v.w * v.w);
#pragma unroll
                                for (int e4 = 0; e4 < 4; ++e4) { const float xv = v[e4]; const LAS f32x4* wp = (const LAS f32x4*)(wrs + (k0 + e4) * 8); const f32x4 wa = wp[0], wb = wp[1];
                                    lg[0] += xv * wa.x; lg[1] += xv * wa.y; lg[2] += xv * wa.z; lg[3] += xv * wa.w; lg[4] += xv * wb.x; lg[5] += xv * wb.y; lg[6] += xv * wb.z; lg[7] += xv * wb.w; } }
                            ss = wave_sum(ss);
#pragma unroll
                            for (int e = 0; e < 8; ++e) lg[e] = wave_sum(lg[e]);
                            const float rstd = frsq(ss * (1.f / DM) + EPS);
                            { unsigned* xq = (unsigned*)(ws + WS_XQ + (size_t)tok * DM) + lane;
#pragma unroll
                              for (int q = 0; q < 4; ++q) xq[64 * q] = cvt_pk4_fp8(xv4[q].x * rstd, xv4[q].y * rstd, xv4[q].z * rstd, xv4[q].w * rstd); }
                            int e1 = 0; float v1 = lg[0];
#pragma unroll
                            for (int e = 1; e < 8; ++e) if (lg[e] > v1) { v1 = lg[e]; e1 = e; }
                            int e2 = -1; float v2 = -3.4e38f;
#pragma unroll
                            for (int e = 0; e < 8; ++e) if (e != e1 && lg[e] > v2) { v2 = lg[e]; e2 = e; }
                            if (e2 < 0) e2 = (e1 + 1) & 7;
                            const int se1 = __builtin_amdgcn_readfirstlane(e1), se2 = __builtin_amdgcn_readfirstlane(e2);
                            const unsigned r1 = __builtin_amdgcn_readlane(cntv, se1), r2 = __builtin_amdgcn_readlane(cntv, se2);
                            cntv += (lane == se1 ? 1u : 0u) + (lane == se2 ? 1u : 0u);
                            if (lane == j) mypack = (unsigned)se1 | (r1 << 4) | ((unsigned)se2 << 12) | (r2 << 16);
                            if (lane == 0) { const float w1 = frcp(1.f + __expf((v2 - v1) * rstd)); RSTD2[tok] = rstd; TOKW[tok * 2] = w1; TOKW[tok * 2 + 1] = 1.f - w1; }
                        }
                        unsigned basev = 0u;
                        if (lane < 8) basev = __hip_atomic_fetch_add(MCNT + 64 * lane, cntv, __ATOMIC_RELAXED, __HIP_MEMORY_SCOPE_AGENT);
                        const int pe1 = mypack & 15, pr1 = (mypack >> 4) & 255, pe2 = (mypack >> 12) & 15, pr2 = (mypack >> 16) & 255;
                        const unsigned b1 = __shfl(basev, pe1), b2 = __shfl(basev, pe2);
                        if (lane < 16) { const int tok = blk * 64 + F.wave * 16 + lane; ASSIGN[tok * 2] = pe1 | (int)((b1 + (unsigned)pr1) << 8); ASSIGN[tok * 2 + 1] = pe2 | (int)((b2 + (unsigned)pr2) << 8);
                            ROWTOK[pe1 * 16384 + (int)(b1 + (unsigned)pr1)] = tok; ROWTOK[pe2 * 16384 + (int)(b2 + (unsigned)pr2)] = tok; }
                    }
                }
                if (SUB(11)) {
                    LAS float* scr = (LAS float*)(F.lds + 40960 + F.wave * 8448);
                    const TJob j0{INF(52), (bf16_t*)(ws + WS_WMGU), INF(7) + DM, DM, EFF, EFF, DM, 8, 2, (size_t)DM * EFF, (size_t)2 * EFF * DM, 1};
                    const TJob j1{INF(53), (bf16_t*)(ws + WS_WMGU), INF(7) + DM, DM, EFF, EFF, DM, 8, 3, (size_t)DM * EFF, (size_t)2 * EFF * DM, 1};
                    const TJob j2{INF(54), (bf16_t*)(ws + WS_WMD), nullptr, EFF, DM, DM, EFF, 8, 0, (size_t)EFF * DM, (size_t)DM * EFF, 1};
                    constexpr int NI = 8 * (DM / 64) * (EFF / 32);
                    LAS unsigned* qc = (LAS unsigned*)(F.lds + MISC_OFF + 128);
                    const int wg_items = (3 * NI - F.bid + F.G - 1) / F.G;
#define H0_PULL() h0_pull(qc, F.lane, wg_items, F.bid, F.G, 3 * NI)
#define H0_JOB(idx) const int jn_ = (idx) / NI; TJob js_ = j0; if (jn_ == 1) { js_.W = j1.W; js_.map = 3; } if (jn_ == 2) js_ = j2;
#define H0_LOAD(idx, v) do { H0_JOB(idx) tjob_load(js_, (idx) - jn_ * NI, v, F.lane); } while (0)
#define H0_STORE(idx, v) do { H0_JOB(idx) tjob_store(js_, (idx) - jn_ * NI, v, scr, F.lane); } while (0)
                    float va[32] = {}, vb[32] = {}; int it = H0_PULL();
                    if (it < 3 * NI) { H0_LOAD(it, va);
                        for (;;) {
                            const int n1 = H0_PULL(); if (n1 < 3 * NI) H0_LOAD(n1, vb);
                            H0_STORE(it, va); if (n1 >= 3 * NI) break;
                            const int n2 = H0_PULL(); if (n2 < 3 * NI) H0_LOAD(n2, va);
                            H0_STORE(n1, vb); if (n2 >= 3 * NI) break;
                            it = n2;
                        } }
#undef H0_PULL
#undef H0_JOB
#undef H0_LOAD
#undef H0_STORE
                }
            }
            SEAM(19);
            if (IN(21)) { PHASE_BEGIN();
                pg8::Gemm g{(const bf16_t*)(ws + WS_XQ), (const bf16_t*)(ws + WS_WMGU), DM / 2, ROWTOK}; pg8::MoeOrder S; S.init(MCNT, 2 * EFF / 256, F.G, F.bid);
                pg8::EpiSwiGLU8<false> E{ws + WS_HMOE, EFF, nullptr};
                pg8::gemm_phase<pg8::EpiSwiGLU8<false>, pg8::MoeOrder, true, true, true>(F.lds, g, S, E);
            }
            SEAM(21);
            if (IN(22)) { PHASE_BEGIN();
                pg8::Gemm g{(const bf16_t*)(ws + WS_HMOE), (const bf16_t*)(ws + WS_WMD), EFF / 2, nullptr}; pg8::MoeOrder S; S.init(MCNT, DM / 256, F.G, F.bid);
                pg8::EpiPlain E{(bf16_t*)(ws + WS_YS), DM, 0.03125f};
                pg8::gemm_phase<pg8::EpiPlain, pg8::MoeOrder, true, false, true>(F.lds, g, S, E);
            }
            SEAM(22);
            if (IN(23)) { PHASE_BEGIN();
                const bf16_t* YS = (const bf16_t*)(ws + WS_YS);
                int pst[8]; { int acc = 0;
#pragma unroll
                    for (int e = 0; e < 8; ++e) { pst[e] = acc; acc += ((int)MCNT[64 * e] + 255) & ~255; } }
                for (int m = F.gw; m < MTOK; m += F.ngw) {
                    const int a1 = ASSIGN[2 * m], a2 = ASSIGN[2 * m + 1]; int p1 = 0, p2 = 0;
#pragma unroll
                    for (int q = 0; q < 8; ++q) { p1 = (q == (a1 & 255)) ? pst[q] : p1; p2 = (q == (a2 & 255)) ? pst[q] : p2; }
                    const int d1 = p1 + (a1 >> 8), d2 = p2 + (a2 >> 8); const float w1 = TOKW[2 * m], w2 = TOKW[2 * m + 1];
                    f32x4* xr = (f32x4*)(F.out + (size_t)m * DM) + F.lane; const u32x2* xbr = (const u32x2*)(XB + (size_t)m * DM) + F.lane;
                    const u32x2* y1 = (const u32x2*)(YS + (size_t)d1 * DM) + F.lane; const u32x2* y2 = (const u32x2*)(YS + (size_t)d2 * DM) + F.lane;
#pragma unroll
                    for (int j = 0; j < 4; ++j) { const u32x2 xw = xbr[64 * j]; f32x4 v = {bflo(xw.x), bfhi(xw.x), bflo(xw.y), bfhi(xw.y)}; const u32x2 a = y1[64 * j], c = y2[64 * j];
                        v.x += w1 * bflo(a.x) + w2 * bflo(c.x); v.y += w1 * bfhi(a.x) + w2 * bfhi(c.x); v.z += w1 * bflo(a.y) + w2 * bflo(c.y); v.w += w1 * bfhi(a.y) + w2 * bfhi(c.y);
                        xr[64 * j] = v; }
                }
            }
        }
    }
#undef IN
#undef SEAM
}

#ifdef DBG_DUMP_OFF
__global__ void dbg_copy_bf16(const bf16_t* src, float* out, int n, int nv) { for (int i = blockIdx.x * 256 + threadIdx.x; i < n; i += gridDim.x * 256) out[i] = i < nv ? bf2f(src[i]) : 0.f; }
#endif

#ifdef DBG_CHECK
struct DbgArgs { const void* in[55]; unsigned char* ws; float* out; float* acc; };
#ifndef DBG_LAYER
#define DBG_LAYER 0
#endif
__device__ __forceinline__ size_t dstride(int i) {
    switch (i) { case 4: case 5: case 6: case 7: case 10: case 11: case 26: return 1024; case 8: return (size_t)DM * DIN; case 9: return 4096; case 12: return 16;
      case 13: case 14: case 15: case 16: case 28: case 30: return 16384; case 17: case 19: case 27: case 29: case 31: case 32: return 256; case 18: case 23: return 65536; case 20: return 192; case 21: return 128;
      case 22: return 73728; case 24: case 25: return 96; case 33: case 34: case 35: case 36: case 37: case 38: return 32; case 39: case 46: case 47: return 64; case 40: return (size_t)4 * 256 * DM; case 41: return (size_t)DM * DM;
      case 42: case 43: case 44: case 45: return (size_t)DM * 256; default: return 0; } }
#define DIN_(i) ((const float*)a.in[i] + (size_t)DBG_LAYER * dstride(i))
#define DXIN_ (DBG_LAYER == 0 ? (const float*)a.in[0] : (const float*)(a.ws + WS_DBG))
constexpr size_t WS_DBG = 440 * MiB;
__device__ float blk_sum(float v, float* sh) { sh[threadIdx.x] = v; __syncthreads(); for (int o = 128; o > 0; o >>= 1) { if ((int)threadIdx.x < o) sh[threadIdx.x] += sh[threadIdx.x + o]; __syncthreads(); } const float r = sh[0]; __syncthreads(); return r; }
__device__ float blk_max(float v, float* sh) { sh[threadIdx.x] = v; __syncthreads(); for (int o = 128; o > 0; o >>= 1) { if ((int)threadIdx.x < o) sh[threadIdx.x] = fmaxf(sh[threadIdx.x], sh[threadIdx.x + o]); __syncthreads(); } const float r = sh[0]; __syncthreads(); return r; }
__device__ void dbg_acc(float* acc, int k, float fast, float ref) { atomicMax((unsigned*)&acc[2 * k], __float_as_uint(fabsf(fast - ref))); atomicAdd(&acc[2 * k + 1], ref * ref); atomicAdd(&acc[64 + k], 1.f); }
__device__ float dsig(float x) { return 1.f / (1.f + expf(-x)); }
__device__ float dgelu(float x) { return 0.5f * x * (1.f + tanhf(0.7978845608028654f * (x + 0.044715f * x * x * x))); }
__device__ int dbucket(int d) { if (d < 16) return d < 0 ? 0 : d; int bk = 16 + (int)(logf((float)d / 16.f) / logf(8.f) * 16.f); return bk > 31 ? 31 : bk; }

__global__ void chk_z(DbgArgs a) {
    __shared__ float sh[256]; const int s = blockIdx.x, tid = threadIdx.x; const int row = (s * 7919 + 13) % MTOK; int col = (s * 104729 + 7 + (s >> 1)) % DIN; if (s & 1) col = col % C_END;
    const float* x = (DBG_LAYER == 0 ? (const float*)a.in[0] : (const float*)a.out) + (size_t)row * DM; const float* g = DIN_(4); const float* W = DIN_(8);
    float ss = 0.f, dot = 0.f; for (int k = tid; k < DM; k += 256) { const float xv = x[k]; ss += xv * xv; dot += xv * g[k] * W[(size_t)k * DIN + col]; }
    ss = blk_sum(ss, sh); dot = blk_sum(dot, sh);
    if (tid == 0) { const float z = dot * rsqrtf(ss / DM + EPS);
        if (col < C_END) dbg_acc(a.acc, 1, bf2f(((const bf16_t*)(a.ws + WS_ZS))[(size_t)row * ZSW + col]), z);
        else { const int gc = col - C_END; dbg_acc(a.acc, 2, bf2f(((const bf16_t*)(a.ws + WS_ZG))[(size_t)row * ZGW + gc]), dsig(z + DIN_(9)[gc])); } }
}
__global__ void chk_mla_prep(DbgArgs a) {
    __shared__ float sh[256]; __shared__ float vn[192]; __shared__ float qs[128];
    const int s = blockIdx.x, tid = threadIdx.x, row = (s * 7919 + 13) % MTOK, hd = s & 3, b = row >> 12, sq = row & 4095;
    const bf16_t* ZSp = (const bf16_t*)(a.ws + WS_ZS) + (size_t)row * ZSW; const float pos = (float)((const int*)a.in[2])[row];
    { const float v = tid < 192 ? bf2f(ZSp[C_CQ + tid]) : 0.f; const float ss = blk_sum(v * v, sh); if (tid < 192) vn[tid] = v * rsqrtf(ss / 192.f + EPS) * DIN_(20)[tid]; __syncthreads(); }
    float qf = 0.f; if (tid < 96) for (int k = 0; k < 192; ++k) qf += vn[k] * DIN_(22)[k * 384 + hd * 96 + tid];
    { const float ss = blk_sum(tid < 96 ? qf * qf : 0.f, sh); if (tid < 96) qs[tid] = qf * rsqrtf(ss / 96.f + EPS) * DIN_(24)[tid]; __syncthreads(); }
    if (tid < 96) { float val = qs[tid]; if (tid >= 64) { const int i = (tid - 64) & 15; float sn, cs; sincos_red(pos * exp2f(-(float)i * (13.287712379549449f / 16.f)), sn, cs); const float x1 = qs[64 + i], x2 = qs[80 + i]; val = tid < 80 ? x1 * cs - x2 * sn : x1 * sn + x2 * cs; }
        val *= 0.10206207261596577f * LOG2E; dbg_acc(a.acc, 3, bf2f(((const bf16_t*)(a.ws + WS_QM))[((size_t)(b * 4 + hd) * SEQ + sq) * 96 + tid]), val); }
    __syncthreads();
    { const float v = tid < 128 ? bf2f(ZSp[C_CKV + tid]) : 0.f; const float ss = blk_sum(v * v, sh); if (tid < 128) vn[tid] = v * rsqrtf(ss / 128.f + EPS) * DIN_(21)[tid]; __syncthreads(); }
    float kv = 0.f; if (tid < 128) for (int k = 0; k < 128; ++k) kv += vn[k] * DIN_(23)[k * 512 + hd * 128 + tid];
    float kfull = 0.f; if (tid < 64) kfull = kv; else if (tid < 96) kfull = bf2f(ZSp[C_KPE + tid - 64]);
    { const float ss = blk_sum(tid < 96 ? kfull * kfull : 0.f, sh); if (tid < 96) qs[tid] = kfull * rsqrtf(ss / 96.f + EPS) * DIN_(25)[tid]; __syncthreads(); }
    if (tid < 96) { float val = qs[tid]; if (tid >= 64) { const int i = (tid - 64) & 15; float sn, cs; sincos_red(pos * exp2f(-(float)i * (13.287712379549449f / 16.f)), sn, cs); const float x1 = qs[64 + i], x2 = qs[80 + i]; val = tid < 80 ? x1 * cs - x2 * sn : x1 * sn + x2 * cs; }
        dbg_acc(a.acc, 4, bf2f(((const bf16_t*)(a.ws + WS_KM))[((size_t)(b * 4 + hd) * SEQ + sq) * 96 + tid]), val); }
    if (tid >= 64 && tid < 128) dbg_acc(a.acc, 5, bf2f(((const bf16_t*)(a.ws + WS_VMT))[((size_t)(b * 4 + hd) * 64 + tid - 64) * SEQ + sq]), kv);
}
__global__ void chk_diff_prep(DbgArgs a) {
    const int i = blockIdx.x * 256 + threadIdx.x; const int row = (i * 37 + 5) % MTOK, hd = i & 3, half = (i >> 2) & 1, isk = (i >> 3) & 1, b = row >> 12, sq = row & 4095;
    const bf16_t* src = (const bf16_t*)(a.ws + WS_ZS) + (size_t)row * ZSW + (isk ? C_KD : C_QD) + hd * 64 + half * 32;
    float ss = 0.f; for (int d = 0; d < 32; ++d) { const float v = bf2f(src[d]); ss += v * v; }
    const float rs = rsqrtf(ss / 32.f + EPS) * (isk ? 1.f : 0.17677669529663687f * LOG2E); const float* gg = DIN_(isk ? 34 : 33);
    const bf16_t* dst = (const bf16_t*)(a.ws + (isk ? WS_KD : WS_QD)) + ((size_t)(b * 4 + hd) * SEQ + sq) * 64 + half * 32;
    for (int d = 0; d < 32; ++d) dbg_acc(a.acc, 6, bf2f(dst[d]), bf2f(src[d]) * rs * gg[d]);
    const bf16_t* vs = (const bf16_t*)(a.ws + WS_ZS) + (size_t)row * ZSW + C_VD + hd * 64;
    for (int d = half * 32; d < half * 32 + 32; ++d) dbg_acc(a.acc, 7, bf2f(((const bf16_t*)(a.ws + WS_VDT))[((size_t)(b * 4 + hd) * 64 + d) * SEQ + sq]), bf2f(vs[d]));
}
__global__ void __launch_bounds__(256) chk_lru_prep(DbgArgs a) {
    __shared__ float xcs[64]; const int s = blockIdx.x, tid = threadIdx.x, row = (s * 7919 + 13) % MTOK, n = s & 3, b = row >> 12, sq = row & 4095;
    if (s == 0 || s == 1) { }
    float xc = 0.f;
    if (tid < 64) { const int c = 64 * n + tid; xc = DIN_(27)[c]; for (int k = 0; k < 4; ++k) { const int sr = sq - 3 + k; if (sr >= 0) xc += DIN_(26)[k * 256 + c] * bf2f(((const bf16_t*)(a.ws + WS_ZS))[(size_t)(b * SEQ + sr) * ZSW + C_XLRU + c]); } xcs[tid] = xc; }
    __syncthreads();
    if (tid < 64) { const int c = 64 * n + tid; float ar = DIN_(29)[c], ai = DIN_(31)[c];
        const float* wr_ = DIN_(28); const float* wi_ = DIN_(30);
#pragma unroll 2
        for (int cc = 0; cc < 64; ++cc) { ar += xcs[cc] * wr_[(n * 64 + cc) * 64 + tid]; ai += xcs[cc] * wi_[(n * 64 + cc) * 64 + tid]; }
        const float r = 1.f / (1.f + __expf(-ar)), ii = 1.f / (1.f + __expf(-ai)), la = -8.f * r * __logf(1.f + __expf(-DIN_(32)[c])), av = __expf(la), iv = sqrtf(fmaxf(1.f - av * av, 0.f)) * ii * xc;
        dbg_acc(a.acc, 8, ((const float*)(a.ws + WS_LA))[(size_t)row * 256 + c], av); dbg_acc(a.acc, 9, ((const float*)(a.ws + WS_LI))[(size_t)row * 256 + c], iv); }
}
__global__ void chk_mla_attn(DbgArgs a) {
    __shared__ float sh[256]; __shared__ float q[96]; __shared__ float p[4096];
    const int s = blockIdx.x, tid = threadIdx.x, bh = s & 15, sq = (s * 523 + 77) % SEQ, b = bh >> 2, hd = bh & 3;
    const bf16_t* QM = (const bf16_t*)(a.ws + WS_QM) + (size_t)bh * SEQ * 96; const bf16_t* KM = (const bf16_t*)(a.ws + WS_KM) + (size_t)bh * SEQ * 96; const bf16_t* VMT = (const bf16_t*)(a.ws + WS_VMT) + (size_t)bh * 64 * SEQ;
    if (tid < 96) q[tid] = bf2f(QM[(size_t)sq * 96 + tid]); __syncthreads();
    float mx = -1e30f; for (int j = tid; j <= sq; j += 256) { float sc = 0.f; for (int d = 0; d < 96; ++d) sc += q[d] * bf2f(KM[(size_t)j * 96 + d]); p[j] = sc; mx = fmaxf(mx, sc); }
    mx = blk_max(mx, sh); float sm = 0.f; for (int j = tid; j <= sq; j += 256) { p[j] = exp2f(p[j] - mx); sm += p[j]; } sm = blk_sum(sm, sh);
    if (tid < 64) { float o = 0.f; for (int j = 0; j <= sq; ++j) o += p[j] * bf2f(VMT[(size_t)tid * SEQ + j]); dbg_acc(a.acc, 10, bf2f(((const bf16_t*)(a.ws + WS_Y))[(size_t)1 * MTOK * 256 + (size_t)(b * SEQ + sq) * 256 + hd * 64 + tid]), o / sm); }
}
__global__ void chk_diff_attn(DbgArgs a) {
    __shared__ float sh[256]; __shared__ float q[64]; __shared__ float p1[4096]; __shared__ float p2[4096];
    const int s = blockIdx.x, tid = threadIdx.x, bh = s & 15, sq = (s * 523 + 77) % SEQ, b = bh >> 2, hd = bh & 3;
    const bf16_t* QD = (const bf16_t*)(a.ws + WS_QD) + (size_t)bh * SEQ * 64; const bf16_t* KD = (const bf16_t*)(a.ws + WS_KD) + (size_t)bh * SEQ * 64; const bf16_t* VDT = (const bf16_t*)(a.ws + WS_VDT) + (size_t)bh * 64 * SEQ;
    if (tid < 64) q[tid] = bf2f(QD[(size_t)sq * 64 + tid]); __syncthreads();
    float m1 = -1e30f, m2 = -1e30f; for (int j = tid; j <= sq; j += 256) { float s1 = 0.f, s2 = 0.f; for (int d = 0; d < 32; ++d) { s1 += q[d] * bf2f(KD[(size_t)j * 64 + d]); s2 += q[32 + d] * bf2f(KD[(size_t)j * 64 + 32 + d]); }
        const float bias = DIN_(3)[dbucket(sq - j) * 4 + hd] * LOG2E; s1 += bias; s2 += bias; p1[j] = s1; p2[j] = s2; m1 = fmaxf(m1, s1); m2 = fmaxf(m2, s2); }
    m1 = blk_max(m1, sh); m2 = blk_max(m2, sh); float l1 = 0.f, l2 = 0.f; for (int j = tid; j <= sq; j += 256) { p1[j] = exp2f(p1[j] - m1); p2[j] = exp2f(p2[j] - m2); l1 += p1[j]; l2 += p2[j]; } l1 = blk_sum(l1, sh); l2 = blk_sum(l2, sh);
    float s1 = 0.f, s2 = 0.f; for (int d = 0; d < 32; ++d) { s1 += DIN_(35)[d] * DIN_(36)[d]; s2 += DIN_(37)[d] * DIN_(38)[d]; } const float lam_init = DBG_LAYER == 0 ? 0.2f : 0.8f - 0.6f * 0.7408182206817179f, lam = expf(s1) - expf(s2) + lam_init;
    float o = 0.f; if (tid < 64) { float o1 = 0.f, o2 = 0.f; for (int j = 0; j <= sq; ++j) { const float v = bf2f(VDT[(size_t)tid * SEQ + j]); o1 += p1[j] * v; o2 += p2[j] * v; } o = o1 / l1 - lam * o2 / l2; }
    const float ss = blk_sum(tid < 64 ? o * o : 0.f, sh);
    if (tid < 64) dbg_acc(a.acc, 11, bf2f(((const bf16_t*)(a.ws + WS_Y))[(size_t)3 * MTOK * 256 + (size_t)(b * SEQ + sq) * 256 + hd * 64 + tid]), o * rsqrtf(ss / 64.f + EPS) * DIN_(39)[tid] * (1.f - lam_init));
}
__global__ void chk_lru_scan(DbgArgs a) {
    const int i = blockIdx.x * 256 + threadIdx.x, b = i >> 8, c = i & 255; if (b >= NB) return;
    const float* LA = (const float*)(a.ws + WS_LA); const float* LI = (const float*)(a.ws + WS_LI); float h = 0.f;
    for (int t = 0; t < SEQ; ++t) { const size_t o = (size_t)(b * SEQ + t) * 256 + c; h = LA[o] * h + LI[o];
        if (t % 97 == 0 || t == SEQ - 1) dbg_acc(a.acc, 12, bf2f(((const bf16_t*)(a.ws + WS_Y))[(size_t)2 * MTOK * 256 + o]), h * dgelu(bf2f(((const bf16_t*)(a.ws + WS_ZS))[(size_t)(b * SEQ + t) * ZSW + C_GLRU + c]))); }
}
__global__ void chk_s5_scan(DbgArgs a) {
    __shared__ float part[16][65]; const int g = blockIdx.x, p = threadIdx.x; float* ypre = (float*)(a.ws + WS_DBG);
    const float dt = expf(DIN_(12)[g]), lr = DIN_(10)[g * 64 + p], li = DIN_(11)[g * 64 + p], mag = expf(lr * dt); float sn, cs; sincos_red(li * dt, sn, cs);
    const float ar = mag * cs, ai = mag * sn, den = lr * lr + li * li, zr = ((ar - 1.f) * lr + ai * li) / den, zi = (ai * lr - (ar - 1.f) * li) / den;
    float hr = 0.f, hi = 0.f;
    for (int t = 0; t < SEQ; ++t) { const bf16_t* up = (const bf16_t*)(a.ws + WS_ZS) + (size_t)(SEQ + t) * ZSW + 16 * g; float bur = 0.f, bui = 0.f;
        for (int c = 0; c < 16; ++c) { const float u = bf2f(up[c]), br = DIN_(13)[(g * 64 + p) * 16 + c], bi = DIN_(14)[(g * 64 + p) * 16 + c]; bur += (zr * br - zi * bi) * u; bui += (zr * bi + zi * br) * u; }
        const float nr = ar * hr - ai * hi + bur, ni = ar * hi + ai * hr + bui; hr = nr; hi = ni;
        for (int c = 0; c < 16; ++c) part[c][p] = DIN_(15)[(g * 16 + c) * 64 + p] * hr - DIN_(16)[(g * 16 + c) * 64 + p] * hi;
        __syncthreads();
        if (p < 16) { float y = 0.f; for (int pp = 0; pp < 64; ++pp) y += part[p][pp]; y += DIN_(17)[16 * g + p] * bf2f(up[p]); ypre[(size_t)t * 256 + 16 * g + p] = dgelu(y); }
        __syncthreads(); }
}
__global__ void chk_s5_glu(DbgArgs a) {
    const int s = blockIdx.x, n = threadIdx.x, t = (s * 61 + 5) % SEQ; const float* ypre = (const float*)(a.ws + WS_DBG) + (size_t)t * 256;
    float z = DIN_(19)[n]; for (int k = 0; k < 256; ++k) z += ypre[k] * DIN_(18)[k * 256 + n];
    dbg_acc(a.acc, 13, bf2f(((const bf16_t*)(a.ws + WS_Y))[(size_t)(SEQ + t) * 256 + n]), ypre[n] * dsig(z));
}

__global__ void chk_merge(DbgArgs a) {
    __shared__ float sh[256]; const int s = blockIdx.x, tid = threadIdx.x, row = (s * 7919 + 13) % MTOK, col = (s * 104729 + 7) % DM;
    const bf16_t* Y = (const bf16_t*)(a.ws + WS_Y); const bf16_t* ZGp = (const bf16_t*)(a.ws + WS_ZG) + (size_t)row * ZGW; const bf16_t* MGp = (const bf16_t*)(a.ws + WS_MERGED) + (size_t)row * DM;
    float m = 0.f;
    for (int n = 0; n < 4; ++n) { float d = 0.f; { const int k = tid; d = bf2f(Y[(size_t)n * MTOK * 256 + (size_t)row * 256 + k]) * DIN_(40)[((size_t)n * 256 + k) * DM + col]; } d = blk_sum(d, sh); m += bf2f(ZGp[n * DM + col]) * d; }
    if (tid == 0) dbg_acc(a.acc, 14, bf2f(MGp[col]), m);
    float o = 0.f; for (int c = tid; c < DM; c += 256) o += bf2f(MGp[c]) * DIN_(41)[(size_t)c * DM + col]; o = blk_sum(o, sh);
    if (tid == 0) dbg_acc(a.acc, 15, a.out[(size_t)row * DM + col], DXIN_[(size_t)row * DM + col] + o);
}
__global__ void chk_cross(DbgArgs a) {
    __shared__ float sh[256]; __shared__ float hn[DM]; __shared__ float q[64]; __shared__ float p[256]; __shared__ float mn[DM];
    const int s = blockIdx.x, tid = threadIdx.x, row = (s * 7919 + 13) % MTOK, hd = s & 3, b = row >> 12;
    const float* x1 = a.out + (size_t)row * DM; float ss = 0.f; for (int k = tid; k < DM; k += 256) ss += x1[k] * x1[k]; ss = blk_sum(ss, sh); const float rs = rsqrtf(ss / DM + EPS);
    for (int k = tid; k < DM; k += 256) hn[k] = x1[k] * rs * DIN_(5)[k]; __syncthreads();
    float qf = 0.f; if (tid < 64) { for (int k = 0; k < DM; ++k) qf += hn[k] * DIN_(42)[(size_t)k * 256 + hd * 64 + tid]; dbg_acc(a.acc, 16, bf2f(((const bf16_t*)(a.ws + WS_QX))[(size_t)row * 256 + hd * 64 + tid]), qf); }
    { const float s2 = blk_sum(tid < 64 ? qf * qf : 0.f, sh); if (tid < 64) q[tid] = qf * rsqrtf(s2 / 64.f + EPS) * DIN_(46)[tid] * 0.125f; __syncthreads(); }
    float sc = 0.f; float vj[1]; (void)vj;
    { const float* mr = DIN_(1) + (size_t)(b * 256 + tid) * DM; float ms = 0.f; for (int k = 0; k < DM; ++k) ms += mr[k] * mr[k]; const float mrs = rsqrtf(ms / DM + EPS);
      float kk[64]; (void)kk; float s2 = 0.f; float dotq = 0.f;
      for (int d = 0; d < 64; ++d) { float kd = 0.f; for (int k = 0; k < DM; ++k) kd += mr[k] * mrs * DIN_(6)[k] * DIN_(43)[(size_t)k * 256 + hd * 64 + d]; s2 += kd * kd; dotq += kd * DIN_(47)[d] * q[d]; }
      sc = dotq * rsqrtf(s2 / 64.f + EPS); }
    const float mx = blk_max(sc, sh); const float e = expf(sc - mx); const float sm = blk_sum(e, sh); p[tid] = e / sm; __syncthreads();
    if (tid < 64) { float o = 0.f; for (int j = 0; j < 256; ++j) { const float* mr = DIN_(1) + (size_t)(b * 256 + j) * DM; float ms = 0.f, vd = 0.f; for (int k = 0; k < DM; ++k) { ms += mr[k] * mr[k]; vd += mr[k] * DIN_(6)[k] * DIN_(44)[(size_t)k * 256 + hd * 64 + tid]; } o += p[j] * vd * rsqrtf(ms / DM + EPS); }
        dbg_acc(a.acc, 17, bf2f(((const bf16_t*)(a.ws + WS_OX))[(size_t)row * 256 + hd * 64 + tid]), o); }
}
__global__ void chk_ffn(DbgArgs a) {
    __shared__ float sh[256]; __shared__ float hn[DM]; const int s = blockIdx.x, tid = threadIdx.x, row = (s * 7919 + 13) % MTOK;
    const float* x2 = a.out + (size_t)row * DM; float ss = 0.f; for (int k = tid; k < DM; k += 256) ss += x2[k] * x2[k]; ss = blk_sum(ss, sh); const float rs = rsqrtf(ss / DM + EPS);
    for (int k = tid; k < DM; k += 256) hn[k] = x2[k] * rs * DIN_(7)[k]; __syncthreads();
    for (int j = tid; j < FF; j += 256 * 8) { float g = 0.f, u = 0.f; for (int k = 0; k < DM; ++k) { g += hn[k] * DIN_(48)[(size_t)k * FF + j]; u += hn[k] * DIN_(49)[(size_t)k * FF + j]; }
        dbg_acc(a.acc, 18, bf2f(((const bf16_t*)(a.ws + WS_HFF))[(size_t)row * FF + j]), g / (1.f + expf(-g)) * u); }
}

__global__ void chk_moe(DbgArgs a) {
    __shared__ float sh[256]; __shared__ float hn[DM]; __shared__ float hid[EFF]; __shared__ float lgs[8];
    const int s = blockIdx.x, tid = threadIdx.x, tok = (s * 7919 + 13) % MTOK, slot = s & 1, col = (s * 104729 + 7) % DM;
    const float* x2 = a.out + (size_t)tok * DM; float ss = 0.f; for (int k = tid; k < DM; k += 256) ss += x2[k] * x2[k]; ss = blk_sum(ss, sh); const float rs = rsqrtf(ss / DM + EPS);
    for (int k = tid; k < DM; k += 256) hn[k] = x2[k] * rs * ((const float*)a.in[7])[DM + k]; __syncthreads();
    for (int e = 0; e < 8; ++e) { float d = 0.f; for (int k = tid; k < DM; k += 256) d += hn[k] * DIN_(51)[k * 8 + e]; d = blk_sum(d, sh); if (tid == 0) lgs[e] = d; } __syncthreads();
    int e1 = 0; for (int e = 1; e < 8; ++e) if (lgs[e] > lgs[e1]) e1 = e; int e2 = -1; for (int e = 0; e < 8; ++e) if (e != e1 && (e2 < 0 || lgs[e] > lgs[e2])) e2 = e;
    const float w1 = 1.f / (1.f + expf(lgs[e2] - lgs[e1])), w2 = 1.f - w1;
    const int* ASG = (const int*)(a.ws + WS_MOESM + MS_ASSIGN); const int* TD = (const int*)(a.ws + WS_MOESM + MS_TOKDEST); const float* TW = (const float*)(a.ws + WS_MOESM + MS_TOKW); const int* RT = (const int*)(a.ws + WS_MOESM + MS_ROWTOK);
    const int ef = ASG[2 * tok + slot] & 255, dest = TD[2 * tok + slot];
    if (tid == 0) { dbg_acc(a.acc, 19, (float)(ASG[2 * tok] & 255), (float)e1 + 1e-3f); dbg_acc(a.acc, 19, (float)(ASG[2 * tok + 1] & 255), (float)e2 + 1e-3f); dbg_acc(a.acc, 19, TW[2 * tok], w1); dbg_acc(a.acc, 19, TW[2 * tok + 1], w2); dbg_acc(a.acc, 19, (float)(RT[dest] - tok), 1e-3f); }
    const float* wg = DIN_(52) + (size_t)ef * DM * EFF; const float* wu = DIN_(53) + (size_t)ef * DM * EFF; const float* wd = DIN_(54) + (size_t)ef * EFF * DM;
    for (int f = tid; f < EFF; f += 256) { float g = 0.f, u = 0.f; for (int k = 0; k < DM; ++k) { g += hn[k] * wg[(size_t)k * EFF + f]; u += hn[k] * wu[(size_t)k * EFF + f]; } hid[f] = g / (1.f + expf(-g)) * u; }
    __syncthreads();
    float y = 0.f; for (int f = tid; f < EFF; f += 256) y += hid[f] * wd[(size_t)f * DM + col]; y = blk_sum(y, sh);
    if (tid == 0) dbg_acc(a.acc, 20, bf2f(((const bf16_t*)(a.ws + WS_YS))[(size_t)dest * DM + col]), y);
}

__global__ void chk_res(DbgArgs a, int kind) {
    __shared__ float sh[256]; const int s = blockIdx.x, tid = threadIdx.x, row = (s * 7919 + 13) % MTOK, col = (s * 104729 + 7) % DM; const float* xprev = (const float*)(a.ws + WS_DBG);
    float o = 0.f;
    if (kind == 0) { const bf16_t* A = (const bf16_t*)(a.ws + WS_OX) + (size_t)row * 256; o = bf2f(A[tid]) * DIN_(45)[(size_t)tid * DM + col]; }
    else { const bf16_t* A = (const bf16_t*)(a.ws + WS_HFF) + (size_t)row * FF; for (int k = tid; k < FF; k += 256) o += bf2f(A[k]) * DIN_(50)[(size_t)k * DM + col]; }
    o = blk_sum(o, sh);
    if (tid == 0) { dbg_acc(a.acc, 21, a.out[(size_t)row * DM + col], xprev[(size_t)row * DM + col] + o);
        const bf16_t xbv = ((const bf16_t*)(a.ws + WS_XB))[(size_t)row * DM + col]; dbg_acc(a.acc, 22, bf2f(xbv), a.out[(size_t)row * DM + col]); }
}

__global__ void chk_final(DbgArgs a) {
    const int i = blockIdx.x * 256 + threadIdx.x; const int tok = (i * 37 + 5) % MTOK, col = (i * 101 + 3) % DM; const float* xprev = (const float*)(a.ws + WS_DBG);
    const int* TD = (const int*)(a.ws + WS_MOESM + MS_TOKDEST); const float* TW = (const float*)(a.ws + WS_MOESM + MS_TOKW); const bf16_t* YS = (const bf16_t*)(a.ws + WS_YS);
    const float ref = xprev[(size_t)tok * DM + col] + TW[2 * tok] * bf2f(YS[(size_t)TD[2 * tok] * DM + col]) + TW[2 * tok + 1] * bf2f(YS[(size_t)TD[2 * tok + 1] * DM + col]);
    dbg_acc(a.acc, 23, a.out[(size_t)tok * DM + col], ref);
}
__global__ void chk_emit(DbgArgs a, int nchk) {
    for (int i = blockIdx.x * 256 + threadIdx.x; i < MTOK * DM; i += gridDim.x * 256) a.out[i] = 0.f;
    if (blockIdx.x == 0 && threadIdx.x == 0) { float V = 99000.f; float worst = 0.f;
        for (int k = 1; k <= nchk; ++k) { const float cnt = a.acc[64 + k]; const float rms = sqrtf(a.acc[2 * k + 1] / fmaxf(cnt, 1.f)) + 1e-20f; float err = a.acc[2 * k] / rms; if (cnt < 1.f) continue; if (!(err == err)) err = 0.97f; worst = fmaxf(worst, err);
#ifdef DBG_ONLY
            if (k == DBG_ONLY) { V = 1000.f + err * 10000.f; break; }
#else
            if (err > 0.06f) { V = (float)k * 1000.f + fminf(err, 0.99f) * 1000.f; break; }
#endif
        }
        if (V == 99000.f) V = 99000.f + worst * 1000.f;
        a.out[12345] = V; }
}
#endif

#ifdef DBG_STAT
__global__ void stat_scan(const float* out, unsigned* acc) {
    for (int i = blockIdx.x * 256 + threadIdx.x; i < MTOK * DM; i += gridDim.x * 256) { const float v = fabsf(out[i]);
        atomicMax(&acc[1], __float_as_uint(v)); if (v > 10.f || !(v == v)) { atomicAdd(&acc[0], 1u); atomicAdd(&acc[2 + (i >> 18)], 1u); atomicAdd(&acc[70 + ((i & 1023) >> 8)], 1u); atomicAdd(&acc[80 + ((i >> 10) & 255) / 32], 1u); } }
}
__global__ void stat_emit(float* out, const unsigned* acc, int mode) {
    for (int i = blockIdx.x * 256 + threadIdx.x; i < MTOK * DM; i += gridDim.x * 256) out[i] = 0.f;
    if (blockIdx.x == 0 && threadIdx.x == 0) { float V = 0.f;
        if (mode == 0) V = (float)acc[0];
        else if (mode == 1) V = __uint_as_float(acc[1]) * 100.f;
        else if (mode == 2) { unsigned best = 0, bi = 0, nz = 0; for (int k = 0; k < 64; ++k) { if (acc[2 + k] > best) { best = acc[2 + k]; bi = k; } nz += acc[2 + k] > 0; } V = 1000.f * (float)bi + 10.f * (float)nz; }
        else if (mode == 3) V = 1000.f * (float)acc[70] / fmaxf((float)acc[0], 1.f) + 100000.f * (float)acc[71] / fmaxf((float)acc[0], 1.f);
        else if (mode == 4) { unsigned best = 0, bi = 0; for (int k = 0; k < 8; ++k) if (acc[80 + k] > best) { best = acc[80 + k]; bi = k; } V = 1000.f + 1000.f * (float)bi + 900.f * (float)best / fmaxf((float)acc[0], 1.f); }
        out[12345] = V + 100.f; }
}
#endif

#ifdef DBG_VAR
__global__ void var_scan(const float* out, const float* prev, float* acc) {
    float s = 0.f, mx = 0.f; for (int i = blockIdx.x * 256 + threadIdx.x; i < MTOK * DM; i += gridDim.x * 256) { const float d = out[i] - prev[i]; s += d * d; mx = fmaxf(mx, fabsf(d)); }
    atomicAdd(&acc[0], s); atomicMax((unsigned*)&acc[1], __float_as_uint(mx));
}
__global__ void var_emit(float* out, const float* acc, int mode) {
    for (int i = blockIdx.x * 256 + threadIdx.x; i < MTOK * DM; i += gridDim.x * 256) out[i] = 0.f;
    if (blockIdx.x == 0 && threadIdx.x == 0) out[12345] = 100.f + (mode == 0 ? acc[0] / (float)(MTOK * DM) * 1e5f : acc[1] * 100.f);
}
#endif

#ifdef DBG_GSTAT
__global__ void gstat_scan(const bf16_t* zg, float* acc) { float s1 = 0.f, s2 = 0.f; for (size_t i = blockIdx.x * 256 + threadIdx.x; i < (size_t)MTOK * ZGW; i += (size_t)gridDim.x * 256) { const float g = bf2f(zg[i]); const int blk = (int)((i & 4095) >> 10); if (blk == DBG_GSTAT) { s1 += (g < -0.01f || g > 1.01f || !(g == g)) ? 1.f : 0.f; s2 += (g - 0.5f) * (g - 0.5f); } } atomicAdd(&acc[0], s1); atomicAdd(&acc[1], s2); }
__global__ void gstat_emit(float* out, const float* acc, int mode) {
    for (int i = blockIdx.x * 256 + threadIdx.x; i < MTOK * DM; i += gridDim.x * 256) out[i] = 0.f;
    if (blockIdx.x == 0 && threadIdx.x == 0) out[12345] = 100.f + 10000.f * acc[1] / ((float)MTOK * 1024);
}
#endif
extern "C" void kernel_launch(void* const* d_in, const int* in_sizes, int n_in, void* d_out, int out_size, void* d_ws, size_t ws_size, hipStream_t stream) {
    static int grid = 0;
    if (grid == 0) {
        if (n_in != 55 || out_size != MTOK * DM || ws_size < WS_END) { fprintf(stderr, "kernel_launch: unexpected shapes (n_in %d out %d ws %zu)\n", n_in, out_size, ws_size); grid = -1; return; }
        { const int L2 = 2; const int exp_sz[55] = {NB * SEQ * DM, NB * NMEM * DM, NB * SEQ, 32 * 4, L2 * DM, L2 * DM, L2 * DM, L2 * DM, L2 * DM * DIN, L2 * 4 * DM, L2 * 1024, L2 * 1024, L2 * 16, L2 * 16384, L2 * 16384, L2 * 16384, L2 * 16384, L2 * 256, L2 * 65536, L2 * 256,
              L2 * 192, L2 * 128, L2 * 192 * 384, L2 * 128 * 512, L2 * 96, L2 * 96, L2 * 1024, L2 * 256, L2 * 16384, L2 * 256, L2 * 16384, L2 * 256, L2 * 256, L2 * 32, L2 * 32, L2 * 32, L2 * 32, L2 * 32, L2 * 32, L2 * 64,
              L2 * 4 * 256 * DM, L2 * DM * DM, L2 * DM * 256, L2 * DM * 256, L2 * DM * 256, L2 * 256 * DM, L2 * 64, L2 * 64, DM * FF, DM * FF, FF * DM, DM * 8, 8 * DM * EFF, 8 * DM * EFF, 8 * EFF * DM};
          for (int i = 0; i < 55; ++i) if (in_sizes[i] != exp_sz[i]) { fprintf(stderr, "kernel_launch: input %d has %d elements, expected %d\n", i, in_sizes[i], exp_sz[i]); grid = -1; return; } }
        int dev = 0, cus = 0, per_cu = 0;
        if (hipGetDevice(&dev) != hipSuccess || hipDeviceGetAttribute(&cus, hipDeviceAttributeMultiprocessorCount, dev) != hipSuccess) { grid = -1; return; }
        if (hipFuncSetAttribute((const void*)hybrid_fwd, hipFuncAttributeMaxDynamicSharedMemorySize, LDS_BYTES) != hipSuccess) { fprintf(stderr, "kernel_launch: hipFuncSetAttribute failed\n"); grid = -1; return; }
        if (hipOccupancyMaxActiveBlocksPerMultiprocessor(&per_cu, (const void*)hybrid_fwd, 512, LDS_BYTES) != hipSuccess || per_cu < 1) { fprintf(stderr, "kernel_launch: occupancy query says %d\n", per_cu); }
        (void)hipGetLastError();
        grid = cus;
    }
    if (grid < 0) return;
    if (hipMemsetAsync((char*)d_ws + WS_CTL, 0, CTL_ZERO_BYTES, stream) != hipSuccess) return;
    Args a{};
    for (int i = 0; i < 55; ++i) a.in[i] = d_in[i];
    a.out = (float*)d_out; a.ws = (unsigned char*)d_ws; a.submask = 0xFFFF; a.pad = 0;
#if MK_ONE_LAUNCH
    a.ph_lo = 0; a.ph_hi = NPHASE;
    hipLaunchKernelGGL(hybrid_fwd, dim3(grid), dim3(512), LDS_BYTES, stream, a);
#else
    for (int p = 0; p < DBG_NPH; ++p) { a.ph_lo = p; a.ph_hi = p + 1;
#if defined(DBG_CHECK) || defined(DBG_VAR)
        if (p == DBG_NPH - 1) hipMemcpyAsync((char*)d_ws + 440 * MiB, d_out, (size_t)MTOK * DM * 4, hipMemcpyDeviceToDevice, stream);
#endif
        hipLaunchKernelGGL(hybrid_fwd, dim3(grid), dim3(512), LDS_BYTES, stream, a);
#ifdef DBG_REPEAT
        if (p == DBG_REPEAT) {
#ifdef DBG_REPSUB
            a.submask = DBG_REPSUB;
#endif
            hipLaunchKernelGGL(hybrid_fwd, dim3(grid), dim3(512), LDS_BYTES, stream, a); hipLaunchKernelGGL(hybrid_fwd, dim3(grid), dim3(512), LDS_BYTES, stream, a); a.submask = 0xFFFF; }
#endif
    }
#ifdef DBG_CHECK
    { DbgArgs da{}; for (int i = 0; i < 55; ++i) da.in[i] = d_in[i]; da.ws = (unsigned char*)d_ws; da.out = (float*)d_out; da.acc = (float*)((char*)d_ws + 700 * 1024);
#if DBG_NPH == 6 || DBG_NPH == 16
      hipLaunchKernelGGL(chk_merge, dim3(512), dim3(256), 0, stream, da);
#elif DBG_NPH == 8 || DBG_NPH == 18
      hipLaunchKernelGGL(chk_cross, dim3(64), dim3(256), 0, stream, da);
#elif DBG_NPH == 10
      hipLaunchKernelGGL(chk_ffn, dim3(64), dim3(256), 0, stream, da);
#elif DBG_NPH == 24
      hipLaunchKernelGGL(chk_final, dim3(64), dim3(256), 0, stream, da);
#elif DBG_NPH == 23
      hipLaunchKernelGGL(chk_moe, dim3(128), dim3(256), 0, stream, da);
#elif DBG_NPH == 9 || DBG_NPH == 19
      hipLaunchKernelGGL(chk_res, dim3(512), dim3(256), 0, stream, da, 0);
#elif DBG_NPH == 11
      hipLaunchKernelGGL(chk_res, dim3(512), dim3(256), 0, stream, da, 1);
#else
      hipLaunchKernelGGL(chk_z, dim3(1024), dim3(256), 0, stream, da);
      hipLaunchKernelGGL(chk_mla_prep, dim3(512), dim3(256), 0, stream, da);
      hipLaunchKernelGGL(chk_diff_prep, dim3(16), dim3(256), 0, stream, da);
      hipLaunchKernelGGL(chk_lru_prep, dim3(512), dim3(256), 0, stream, da);
      hipLaunchKernelGGL(chk_mla_attn, dim3(64), dim3(256), 0, stream, da);
      hipLaunchKernelGGL(chk_diff_attn, dim3(64), dim3(256), 0, stream, da);
      hipLaunchKernelGGL(chk_lru_scan, dim3(4), dim3(256), 0, stream, da);
      hipLaunchKernelGGL(chk_s5_scan, dim3(16), dim3(64), 0, stream, da);
      hipLaunchKernelGGL(chk_s5_glu, dim3(64), dim3(256), 0, stream, da);
#endif
      hipLaunchKernelGGL(chk_emit, dim3(1024), dim3(256), 0, stream, da, 23); }
#endif
#ifdef DBG_COPYX
    hipMemcpyAsync(d_out, d_in[0], (size_t)MTOK * DM * 4, hipMemcpyDeviceToDevice, stream);
#endif
#ifdef DBG_GSTAT
    { float* acc = (float*)((char*)d_ws + 900 * 1024);
      hipLaunchKernelGGL(gstat_scan, dim3(2048), dim3(256), 0, stream, (const bf16_t*)((const char*)d_ws + WS_ZG), acc);
      hipLaunchKernelGGL(gstat_emit, dim3(1024), dim3(256), 0, stream, (float*)d_out, (const float*)acc, DBG_GSTAT); }
#endif
#ifdef DBG_VAR
    { float* acc = (float*)((char*)d_ws + 900 * 1024);
      hipLaunchKernelGGL(var_scan, dim3(1024), dim3(256), 0, stream, (const float*)d_out, DBG_NPH == 6 ? (const float*)d_in[0] : (const float*)((const char*)d_ws + 440 * MiB), acc);
      hipLaunchKernelGGL(var_emit, dim3(1024), dim3(256), 0, stream, (float*)d_out, (const float*)acc, DBG_VAR); }
#endif
#ifdef DBG_STAT
    { unsigned* acc = (unsigned*)((char*)d_ws + 800 * 1024);
      hipLaunchKernelGGL(stat_scan, dim3(2048), dim3(256), 0, stream, (const float*)d_out, acc);
      hipLaunchKernelGGL(stat_emit, dim3(1024), dim3(256), 0, stream, (float*)d_out, (const unsigned*)acc, DBG_STAT); }
#endif
#ifdef DBG_DUMP_OFF
    hipLaunchKernelGGL(dbg_copy_bf16, dim3(2048), dim3(256), 0, stream, (const bf16_t*)((const char*)d_ws + (size_t)(DBG_DUMP_OFF)), (float*)d_out, MTOK * DM, DBG_DUMP_N);
#endif
#endif
}
```

```cpp
#include <hip/hip_runtime.h>
#include <cstdio>
#include <cstdint>

#define DBG_NPH 24

#ifndef DBG_GPERM
#define DBG_GPERM(n) (n)
#endif
#ifndef DBG_SCALE
#define DBG_SCALE 1.0f
#endif
#ifndef MK_ONE_LAUNCH
#define MK_ONE_LAUNCH 1
#endif
#ifndef G2_FP8
#define G2_FP8 0
#endif

#define LAS __attribute__((address_space(3)))
typedef unsigned short bf16_t;
typedef short bf16x8 __attribute__((ext_vector_type(8)));
typedef float f32x2 __attribute__((ext_vector_type(2)));
typedef float f32x4 __attribute__((ext_vector_type(4)));
typedef float f32x16 __attribute__((ext_vector_type(16)));
typedef unsigned u32x2 __attribute__((ext_vector_type(2)));
typedef unsigned u32x4 __attribute__((ext_vector_type(4)));
typedef int i32x4 __attribute__((ext_vector_type(4)));
typedef int i32x8 __attribute__((ext_vector_type(8)));

constexpr int DM = 1024, NB = 4, SEQ = 4096, MTOK = NB * SEQ, NMEM = 256;
constexpr int DIN = 5984, ZSW = 2048, ZGW = 4096, NIN = ZSW + ZGW;
constexpr int C_S5 = 0, C_CQ = 256, C_CKV = 448, C_KPE = 576, C_XLRU = 608, C_GLRU = 864, C_QD = 1120, C_KD = 1376, C_VD = 1632, C_END = 1888;
constexpr int FF = 2816, EFF = 3584, NEXP = 8, MOE_ROWS = 34816;
constexpr float EPS = 1e-6f, LOG2E = 1.4426950408889634f;

constexpr size_t MiB = 1u << 20;
constexpr size_t WS_CTL = 0, CTL_ZERO_BYTES = 1 * MiB + 512 * 1024;
constexpr size_t WS_MOESM = 1 * MiB;
constexpr size_t WS_XB = 2 * MiB;
constexpr size_t WS_WL = 34 * MiB, WL_STRIDE = 19 * MiB;
constexpr size_t WL_WIN = 0, WL_PT = 12 * MiB, WL_WO = 14 * MiB, WL_WXQ = 16 * MiB, WL_WXKV = 16 * MiB + 512 * 1024, WL_WXO = 17 * MiB + 512 * 1024, WL_SM = 18 * MiB;
constexpr size_t SM_WUQ = 0, SM_WUKV = 256 * 1024, SM_WR = 512 * 1024, SM_WI = 576 * 1024, SM_WGLU = 640 * 1024;
constexpr size_t WS_WGU = 72 * MiB, WS_WD = 83 * MiB, WS_TAB = 89 * MiB, WS_KX = 90 * MiB, WS_VXT = 91 * MiB;
constexpr size_t TAB_S5T = 0, TAB_CMAT = 512 * 1024, TAB_MISC = 768 * 1024;
constexpr size_t WS_ZS = 92 * MiB, WS_MERGED = 92 * MiB, WS_ZG = 156 * MiB, WS_HFF = 156 * MiB, WS_Y = 284 * MiB;
constexpr size_t WS_QM = 316 * MiB, WS_KM = 328 * MiB, WS_VMT = 340 * MiB, WS_QD = 348 * MiB, WS_KD = 356 * MiB, WS_VDT = 364 * MiB;
constexpr size_t WS_QX = 316 * MiB, WS_OX = 324 * MiB;
constexpr size_t WS_LA = 372 * MiB, WS_LI = 388 * MiB, WS_S5S = 404 * MiB, WS_LSUM = 406 * MiB, WS_RSP = 407 * MiB;
constexpr size_t WS_WMGU = 34 * MiB, WS_WMD = 146 * MiB, WS_HMOE = 202 * MiB, WS_XQ = 330 * MiB, WS_YS = 34 * MiB, WS_X8 = 416 * MiB, WS_END = 440 * MiB;
constexpr int CW_TMO = 0, CW_BAR = 4096, CW_MOECNT = 8192, CW_Q = 12288;
constexpr size_t CTL_ROWSS = 256 * 1024;
constexpr size_t MS_ROWTOK = 0, MS_TOKW = 512 * 1024, MS_ASSIGN = 640 * 1024, MS_RSTD = 768 * 1024;
constexpr int RING_BYTES = 131072, MISC_OFF = RING_BYTES + 320, LDS_BYTES = 147456;

typedef __bf16 bf16x2_t __attribute__((ext_vector_type(2)));
__device__ __forceinline__ unsigned cvt_pk_bf16(float lo, float hi) { const f32x2 v = {lo, hi}; const bf16x2_t b = __builtin_convertvector(v, bf16x2_t); return __builtin_bit_cast(unsigned, b); }
__device__ __forceinline__ float clamp8(float x) { return __builtin_fminf(__builtin_fmaxf(x, -448.f), 448.f); }
__device__ __forceinline__ unsigned cvt_pk4_fp8(float a, float b, float c, float d) { int w = __builtin_amdgcn_cvt_pk_fp8_f32(clamp8(a), clamp8(b), 0, false); w = __builtin_amdgcn_cvt_pk_fp8_f32(clamp8(c), clamp8(d), w, true); return (unsigned)w; }
__device__ __forceinline__ float bflo(unsigned w) { return __uint_as_float(w << 16); }
__device__ __forceinline__ float bfhi(unsigned w) { return __uint_as_float(w & 0xffff0000u); }
__device__ __forceinline__ float bf2f(bf16_t b) { return __uint_as_float((unsigned)b << 16); }
__device__ __forceinline__ bf16_t f2bf(float f) { return (bf16_t)(cvt_pk_bf16(f, 0.f) & 0xffffu); }
__device__ __forceinline__ float fexp2(float x) { return __builtin_amdgcn_exp2f(x); }
__device__ __forceinline__ float frcp(float x) { return __builtin_amdgcn_rcpf(x); }
__device__ __forceinline__ float frsq(float x) { return __builtin_amdgcn_rsqf(x); }
__device__ __forceinline__ float fsigmoid(float x) { return frcp(1.f + fexp2(-x * LOG2E)); }
__device__ __forceinline__ float fgelu(float x) {
    const float z = 0.7978845608028654f * (x + 0.044715f * x * x * x);
    const float e = fexp2(2.f * LOG2E * z);
    const float th = 1.f - 2.f * frcp(e + 1.f);
    return 0.5f * x * (1.f + th);
}
__device__ __forceinline__ int crow(int r, int hi) { return (r & 3) + 8 * (r >> 2) + 4 * hi; }
__device__ __forceinline__ bf16x8 ldg8(const bf16_t* p) { return *(const bf16x8*)p; }
__device__ __forceinline__ float sq8(bf16x8 v) {
    const u32x4 w = *(const u32x4*)&v; float s = 0.f;
#pragma unroll
    for (int i = 0; i < 4; ++i) { const float a = bflo(w[i]), b = bfhi(w[i]); s += a * a + b * b; }
    return s;
}
__device__ __forceinline__ float row_rstd(const float* rsp, int row) {
    const f32x4* p = (const f32x4*)(rsp + (size_t)row * 16); const f32x4 a = p[0], b = p[1], c = p[2], d = p[3];
    const float s = (((a.x + a.y) + (a.z + a.w)) + ((b.x + b.y) + (b.z + b.w))) + (((c.x + c.y) + (c.z + c.w)) + ((d.x + d.y) + (d.z + d.w)));
    return frsq(s * (1.f / DM) + EPS);
}
__device__ __forceinline__ float wave_sum(float v) {
#pragma unroll
    for (int o = 1; o < 64; o <<= 1) v += __shfl_xor(v, o);
    return v;
}
#define MFMA32(a, b, c) __builtin_amdgcn_mfma_f32_32x32x16_bf16((a), (b), (c), 0, 0, 0)
#define MFMA16(a, b, c) __builtin_amdgcn_mfma_f32_16x16x32_bf16((a), (b), (c), 0, 0, 0)
__device__ __forceinline__ void sincos_red(float a, float& s, float& c) {
    const float k = rintf(a * 0.15915494309189535f);
    float r = fmaf(-k, 6.28318548202514648f, a);
    r = fmaf(-k, -1.7484555e-7f, r);
    s = __sinf(r); c = __cosf(r);
}

namespace pg8 {
constexpr int BM = 256, BK = 64, HALF = 128, HTB = HALF * BK * 2, STAGE_BYTES = 8 * HTB;
__host__ __device__ __forceinline__ int lds_byte(int r, int c) { const int st = (r >> 4) * 2 + (c >> 5), rr = r & 15, cc = c & 31, ob = rr * 64 + cc * 2; return st * 1024 + (ob ^ (((ob >> 9) & 1) << 5)); }
__host__ __device__ __forceinline__ void stage_rc(int b, int& R, int& C) { const int st = b / 1024, sb = b % 1024, swz = sb ^ (((sb >> 9) & 1) << 5); R = (st >> 1) * 16 + swz / 64; C = (st & 1) * 32 + (swz % 64) / 2; }
__host__ __device__ __forceinline__ int perm32(int rho) { const int n = rho >> 4, i = rho & 15; return 8 * (i >> 2) + 4 * n + (i & 3); }

struct Unit { int pm, pn, om, on, aux, gofs; };
struct Gemm { const bf16_t* A; const bf16_t* Bt; int K; const int* gather; };

template <class Epi, class Sched, bool ALIGN_EPI, bool GATHER, bool FP8 = false>
__device__ __forceinline__ void gemm_phase(LAS unsigned char* lds, Gemm g, const Sched& S, const Epi& E) {
    int tid = threadIdx.x; asm volatile("" : "+v"(tid));
    asm volatile("" : "+s"(g.A), "+s"(g.Bt));
    const int wid = __builtin_amdgcn_readfirstlane(tid >> 6), lane = tid & 63, wr = wid >> 2, wc = wid & 3, fr = lane & 15, fq = lane >> 4;
    const int K = g.K, nt = K / BK;
    unsigned voffB[2];
#pragma unroll
    for (int i = 0; i < 2; ++i) { int Rr_, Cc_; stage_rc(tid * 16 + i * 8192, Rr_, Cc_); const int Rb = (Rr_ & ~31) + perm32(Rr_ & 31); voffB[i] = (unsigned)(Rb * K + Cc_) * 2u; }
    const size_t kstep = (size_t)(BK * 2);
    const size_t hstep = (size_t)HALF * K * 2;
    const size_t tstep = 2 * hstep;
    const unsigned ldsw = (unsigned)wid * 1024u;
    const int aoff = lds_byte(wr * 64 + fr, fq * 8), boff = lds_byte(wc * 32 + fr, fq * 8);
#define PG8_SA(b, h) (((b) * 2 + (h)) * HTB)
#define PG8_SB(b, h) ((4 + (b) * 2 + (h)) * HTB)
#define PG8_STAGE_B(bufoff, gbase) do { _Pragma("unroll") for (int _i = 0; _i < 2; ++_i) \
        __builtin_amdgcn_global_load_lds((const unsigned*)((const char*)(gbase) + voffB[_i]), (LAS unsigned*)(lds + (bufoff) + ldsw + _i * 8192), 16, 0, 0); } while (0)
#define PG8_STAGE_A(bufoff, kt, vo0, vo1) do { const char* _gb = (const char*)g.A + (size_t)(kt) * kstep; \
        __builtin_amdgcn_global_load_lds((const unsigned*)(_gb + (vo0)), (LAS unsigned*)(lds + (bufoff) + ldsw), 16, 0, 0); \
        __builtin_amdgcn_global_load_lds((const unsigned*)(_gb + (vo1)), (LAS unsigned*)(lds + (bufoff) + ldsw + 8192), 16, 0, 0); } while (0)
#define PG8_LDA(dst, b, h) do { _Pragma("unroll") for (int m = 0; m < 4; ++m) _Pragma("unroll") for (int k = 0; k < 2; ++k) dst[m][k] = *(const LAS bf16x8*)(lds + PG8_SA(b, h) + aoff + m * 2048 + k * 1024); } while (0)
#define PG8_LDB(dst, b, h) do { _Pragma("unroll") for (int n = 0; n < 2; ++n) _Pragma("unroll") for (int k = 0; k < 2; ++k) dst[n][k] = *(const LAS bf16x8*)(lds + PG8_SB(b, h) + boff + n * 2048 + k * 1024); } while (0)
#define PG8_MMA(ai, bj, At, Bt) do { __builtin_amdgcn_s_setprio(1); _Pragma("unroll") for (int m = 0; m < 4; ++m) _Pragma("unroll") for (int n = 0; n < 2; ++n) _Pragma("unroll") for (int k = 0; k < 2; ++k) \
        acc[ai][bj][m][n] = __builtin_amdgcn_mfma_f32_16x16x32_bf16(Bt[n][k], At[m][k], acc[ai][bj][m][n], 0, 0, 0); __builtin_amdgcn_s_setprio(0); } while (0)
#define PG8_MMA8(ai, bj, w) do { __builtin_amdgcn_s_setprio(1); _Pragma("unroll") for (int m = 0; m < 4; ++m) _Pragma("unroll") for (int n = 0; n < 2; ++n) \
        asm volatile("v_mfma_f32_16x16x128_f8f6f4 %0, %1, %2, %0" : "+v"(acc[ai][bj][m][n]) : "v"(B##w##8[n]), "v"(A8[m])); __builtin_amdgcn_s_setprio(0); } while (0)
#define PG8_LA(b, h) do { if constexpr (FP8) { _Pragma("unroll") for (int m = 0; m < 4; ++m) { A8[m].lo = *(const LAS i32x4*)(lds + PG8_SA(b, h) + aoff + m * 2048); A8[m].hi = *(const LAS i32x4*)(lds + PG8_SA(b, h) + aoff + m * 2048 + 1024); } } \
        else PG8_LDA(At, b, h); } while (0)
#define PG8_LB(w, b, h) do { if constexpr (FP8) { _Pragma("unroll") for (int n = 0; n < 2; ++n) { B##w##8[n].lo = *(const LAS i32x4*)(lds + PG8_SB(b, h) + boff + n * 2048); B##w##8[n].hi = *(const LAS i32x4*)(lds + PG8_SB(b, h) + boff + n * 2048 + 1024); } } \
        else PG8_LDB(B##w, b, h); } while (0)
#define PG8_MM(ai, bj, w) do { if constexpr (FP8) PG8_MMA8(ai, bj, w); else PG8_MMA(ai, bj, At, B##w); } while (0)
#define PG8_WAIT_V(n) asm volatile("s_waitcnt vmcnt(" #n ")" ::: "memory")
#define PG8_WAIT_L(n) asm volatile("s_waitcnt lgkmcnt(" #n ")" ::: "memory")
#define PG8_BAR __builtin_amdgcn_s_barrier()
#define PG8_SCHED __builtin_amdgcn_sched_barrier(0)
#define PG8_VOFF(dst, u) do { _Pragma("unroll") for (int _h = 0; _h < 2; ++_h) _Pragma("unroll") for (int _i = 0; _i < 2; ++_i) { int Rr_, Cc_; stage_rc(tid * 16 + _i * 8192, Rr_, Cc_); \
        const int _rt = (u).pm * BM + _h * HALF + Rr_; const int _ar = GATHER ? g.gather[_rt + (u).gofs] : _rt; dst[_h][_i] = (unsigned)((size_t)_ar * K + Cc_) * 2u; } } while (0)
    Unit cur, nxt; int ui = 0;
    if (!S.next(0, cur)) return;
    f32x4 acc[2][2][4][2];
#pragma unroll
    for (int a = 0; a < 2; ++a)
#pragma unroll
        for (int b = 0; b < 2; ++b)
#pragma unroll
            for (int m = 0; m < 4; ++m)
#pragma unroll
                for (int n = 0; n < 2; ++n) acc[a][b][m][n] = (f32x4){0.f, 0.f, 0.f, 0.f};
    bf16x8 At[4][2], B0[2][2], B1[2][2];
    i32x8 A8[4], B08[2], B18[2];
    unsigned vC[2][2], vN[2][2];
    PG8_VOFF(vC, cur);
    const char* cB = (const char*)g.Bt + (size_t)cur.pn * tstep;
    PG8_STAGE_B(PG8_SB(0, 0), cB); PG8_STAGE_B(PG8_SB(0, 1), cB + hstep); PG8_STAGE_A(PG8_SA(0, 0), 0, vC[0][0], vC[0][1]); PG8_STAGE_A(PG8_SA(0, 1), 0, vC[1][0], vC[1][1]);
    if (wr == 1) PG8_BAR;
    PG8_WAIT_V(2); PG8_BAR;
    PG8_STAGE_B(PG8_SB(1, 0), cB + kstep); PG8_STAGE_A(PG8_SA(1, 0), 1, vC[0][0], vC[0][1]); PG8_STAGE_B(PG8_SB(1, 1), cB + hstep + kstep);
    PG8_WAIT_V(6); PG8_BAR;
    for (;;) {
        const bool has_next = S.next(ui + 1, nxt);
        unsigned ndelta = 0u;
        if constexpr (GATHER) {
            if (has_next) { PG8_VOFF(vN, nxt); } else {
#pragma unroll
                for (int _h = 0; _h < 2; ++_h)
#pragma unroll
                    for (int _i = 0; _i < 2; ++_i) vN[_h][_i] = vC[_h][_i]; }
        } else { if (has_next) ndelta = (unsigned)((nxt.pm - cur.pm) * (int)tstep); }
        const char* nB = has_next ? (const char*)g.Bt + (size_t)nxt.pn * tstep : cB;
#pragma unroll 1
        for (int t = 0; t < nt; t += 2) {
            const bool last = (t == nt - 2);
            const int k2 = last ? 0 : t + 2, k3 = k2 + 1;
            const char* b2 = last ? nB : cB + (size_t)(t + 2) * kstep; const char* b3 = b2 + kstep;
            unsigned v200, v201, v210, v211;
            if constexpr (GATHER) { v200 = last ? vN[0][0] : vC[0][0]; v201 = last ? vN[0][1] : vC[0][1]; v210 = last ? vN[1][0] : vC[1][0]; v211 = last ? vN[1][1] : vC[1][1]; }
            else { const unsigned dl = last ? ndelta : 0u; v200 = vC[0][0] + dl; v201 = vC[0][1] + dl; v210 = vC[1][0] + dl; v211 = vC[1][1] + dl; }
            PG8_LB(0, 0, 0); PG8_LB(1, 0, 1); PG8_SCHED; PG8_LA(0, 0); PG8_STAGE_A(PG8_SA(1, 1), t + 1, vC[1][0], vC[1][1]);
            PG8_WAIT_V(8); PG8_WAIT_L(0); PG8_BAR; PG8_MM(0, 0, 0); PG8_MM(0, 1, 1); PG8_BAR; PG8_SCHED;
            PG8_LA(0, 1); PG8_STAGE_B(PG8_SB(0, 0), b2); PG8_STAGE_B(PG8_SB(0, 1), b2 + hstep); PG8_STAGE_A(PG8_SA(0, 0), k2, v200, v201);
            PG8_WAIT_V(8); PG8_WAIT_L(0); PG8_BAR; PG8_MM(1, 0, 0); PG8_MM(1, 1, 1); PG8_BAR; PG8_SCHED;
            PG8_LB(0, 1, 0); PG8_LB(1, 1, 1); PG8_SCHED; PG8_LA(1, 0); PG8_STAGE_A(PG8_SA(0, 1), k2, v210, v211);
            PG8_WAIT_V(8); PG8_WAIT_L(0); PG8_BAR; PG8_MM(0, 0, 0); PG8_MM(0, 1, 1); PG8_BAR; PG8_SCHED;
            PG8_LA(1, 1); PG8_STAGE_B(PG8_SB(1, 0), b3); PG8_STAGE_B(PG8_SB(1, 1), b3 + hstep); PG8_STAGE_A(PG8_SA(1, 0), k3, v200, v201);
            PG8_WAIT_V(8); PG8_WAIT_L(0); PG8_BAR; PG8_MM(1, 0, 0); PG8_MM(1, 1, 1); PG8_BAR; PG8_SCHED;
        }
        if constexpr (ALIGN_EPI) { if (wr == 0) PG8_BAR; }
        if constexpr (FP8) asm volatile("s_nop 15\n\ts_nop 15" ::: "memory");
        { int fr_ = fr, fq_ = fq; asm volatile("" : "+v"(fr_), "+v"(fq_)); E(acc, cur, wr, wc, fr_, fq_); }
        if (!has_next) break;
#pragma unroll
        for (int a = 0; a < 2; ++a)
#pragma unroll
            for (int b = 0; b < 2; ++b)
#pragma unroll
                for (int m = 0; m < 4; ++m)
#pragma unroll
                    for (int n = 0; n < 2; ++n) acc[a][b][m][n] = (f32x4){0.f, 0.f, 0.f, 0.f};
        cur = nxt; cB = nB; ++ui;
#pragma unroll
        for (int _h = 0; _h < 2; ++_h)
#pragma unroll
            for (int _i = 0; _i < 2; ++_i) { if constexpr (GATHER) vC[_h][_i] = vN[_h][_i]; else vC[_h][_i] += ndelta; }
        if constexpr (ALIGN_EPI) { if (wr == 1) PG8_BAR; }
    }
    PG8_WAIT_V(0);
    if constexpr (!ALIGN_EPI) { if (wr == 0) PG8_BAR; }
    PG8_BAR;
#undef PG8_SA
#undef PG8_SB
#undef PG8_STAGE_A
#undef PG8_STAGE_B
#undef PG8_LDA
#undef PG8_LDB
#undef PG8_MMA
#undef PG8_MMA8
#undef PG8_MM
#undef PG8_LA
#undef PG8_LB
#undef PG8_WAIT_V
#undef PG8_WAIT_L
#undef PG8_BAR
#undef PG8_SCHED
#undef PG8_VOFF
}

constexpr int NXCD = 8, WGM = 8;
struct StaticOrder {
    int nM, nN, nwg, G, c;
    __device__ void init(int nM_, int nN_, int G_, int c_) { nM = nM_; nN = nN_; nwg = nM * nN; G = G_; c = c_; }
    __device__ bool next(int i, Unit& u) const {
        const long L = (long)i * G + c; if (L >= nwg) return false;
        int wgid = (int)L; { const int q = nwg / NXCD, r = nwg % NXCD, xcd = wgid % NXCD, off = wgid / NXCD; wgid = (xcd < r ? xcd * (q + 1) : r * (q + 1) + (xcd - r) * q) + off; }
        const int nig = WGM * nN, gid = wgid / nig, fm = gid * WGM, gsz = (nM - fm) < WGM ? (nM - fm) : WGM;
        u.pm = fm + ((wgid % nig) % gsz); u.pn = (wgid % nig) / gsz; u.om = u.pm; u.on = u.pn; u.aux = 0; return true;
    }
};
struct MergeOrder {
    int G, c;
    __device__ bool next(int i, Unit& u) const {
        const int n = i & 3; const long tile = (long)(i >> 2) * G + c; if (tile >= 256) return false;
        const int om = (int)tile >> 2, on = (int)tile & 3;
        u.pm = n * 64 + om; u.pn = n * 4 + on; u.om = om; u.on = on; u.aux = n; return true;
    }
};
struct MoeOrder {
    int ntiles, nN, nwg, G, c; int pend[NEXP];
    __device__ void init(const unsigned* cnt, int nN_, int G_, int c_) {
        int acc = 0;
#pragma unroll
        for (int e = 0; e < NEXP; ++e) { const int ce = (int)cnt[64 * e]; acc += (ce + 255) >> 8; pend[e] = acc; }
        ntiles = acc; nN = nN_; nwg = ntiles * nN; G = G_; c = c_;
    }
    __device__ bool next(int i, Unit& u) const {
        const long L = (long)i * G + c; if (L >= nwg) return false;
        const int wgid = (int)L;
        const int nig = WGM * nN, gid = wgid / nig, fm = gid * WGM, gsz = (ntiles - fm) < WGM ? (ntiles - fm) : WGM;
        const int pm = fm + ((wgid % nig) % gsz), pn = (wgid % nig) / gsz;
        int e = 0, ps = 0;
#pragma unroll
        for (int j = 0; j < NEXP - 1; ++j) if (pm >= pend[j]) { e = j + 1; ps = pend[j]; }
        u.pm = pm; u.pn = e * nN + pn; u.om = pm; u.on = pn; u.aux = e; u.gofs = e * 16384 - 256 * ps; return true;
    }
};

__device__ __forceinline__ u32x4 pack8(f32x4 a, f32x4 b) { u32x4 w; w.x = cvt_pk_bf16(a[0], a[1]); w.y = cvt_pk_bf16(a[2], a[3]); w.z = cvt_pk_bf16(b[0], b[1]); w.w = cvt_pk_bf16(b[2], b[3]); return w; }
struct EpiIn {
    bf16_t* Zs; bf16_t* Zg; const float* rowss; const float* bgate;
    __device__ __forceinline__ void operator()(const f32x4 (&acc)[2][2][4][2], const Unit& u, int wr, int wc, int fr, int fq) const {
        const int row0 = u.om * BM + wr * 64 + fr, colt = u.on * BM, cw = wc * 32 + 8 * fq;
        if (colt < ZSW) {
#pragma unroll
            for (int ai = 0; ai < 2; ++ai) { float rsd[4];
#pragma unroll
                for (int m = 0; m < 4; ++m) rsd[m] = row_rstd(rowss, row0 + ai * HALF + m * 16);
#pragma unroll
                for (int m = 0; m < 4; ++m) {
                    const int row = row0 + ai * HALF + m * 16; const float rstd = rsd[m];
#pragma unroll
                    for (int bj = 0; bj < 2; ++bj) *(u32x4*)(Zs + (size_t)row * ZSW + colt + bj * HALF + cw) = pack8(acc[ai][bj][m][0] * rstd, acc[ai][bj][m][1] * rstd);
                    if (m == 3) asm volatile("" ::: "memory");
                } }
        } else {
            const int gc0 = colt - ZSW + cw;
            const f32x4 b00 = *(const f32x4*)(bgate + gc0), b01 = *(const f32x4*)(bgate + gc0 + 4), b10 = *(const f32x4*)(bgate + gc0 + HALF), b11 = *(const f32x4*)(bgate + gc0 + HALF + 4);
#pragma unroll
            for (int ai = 0; ai < 2; ++ai) { float rsd[4];
#pragma unroll
                for (int m = 0; m < 4; ++m) rsd[m] = row_rstd(rowss, row0 + ai * HALF + m * 16);
#pragma unroll
                for (int m = 0; m < 4; ++m) {
                    const int row = row0 + ai * HALF + m * 16; const float rstd = rsd[m];
#pragma unroll
                    for (int bj = 0; bj < 2; ++bj) { f32x4 v0 = acc[ai][bj][m][0] * rstd + (bj ? b10 : b00), v1 = acc[ai][bj][m][1] * rstd + (bj ? b11 : b01);
                        *(u32x4*)(Zg + (size_t)row * ZGW + gc0 + bj * HALF) = pack8(v0, v1); }
                    if (m == 3) asm volatile("" ::: "memory");
                } }
        }
    }
};
struct EpiMerge {
    bf16_t* Mg; const bf16_t* Zg;
    __device__ __forceinline__ void operator()(const f32x4 (&acc)[2][2][4][2], const Unit& u, int wr, int wc, int fr, int fq) const {
        const int row0 = u.om * BM + wr * 64 + fr, colt = u.on * BM, cw = wc * 32 + 8 * fq, n = u.aux;
#pragma unroll
        for (int ai = 0; ai < 2; ++ai) {
            u32x4 gw[4][2], ow[4][2];
#pragma unroll
            for (int m = 0; m < 4; ++m)
#pragma unroll
                for (int bj = 0; bj < 2; ++bj) { const int row = row0 + ai * HALF + m * 16, col = colt + bj * HALF + cw;
                    gw[m][bj] = *(const u32x4*)(Zg + (size_t)row * ZGW + DBG_GPERM(n) * DM + col);
                    ow[m][bj] = n > 0 ? *(const u32x4*)(Mg + (size_t)row * DM + col) : (u32x4){0u, 0u, 0u, 0u}; }
#pragma unroll
            for (int m = 0; m < 4; ++m)
#pragma unroll
                for (int bj = 0; bj < 2; ++bj) { const int row = row0 + ai * HALF + m * 16, col = colt + bj * HALF + cw; const u32x4 g = gw[m][bj], o = ow[m][bj];
                    f32x4 v0 = acc[ai][bj][m][0], v1 = acc[ai][bj][m][1];
                    v0[0] = v0[0] * fsigmoid(bflo(g.x)) + bflo(o.x); v0[1] = v0[1] * fsigmoid(bfhi(g.x)) + bfhi(o.x); v0[2] = v0[2] * fsigmoid(bflo(g.y)) + bflo(o.y); v0[3] = v0[3] * fsigmoid(bfhi(g.y)) + bfhi(o.y);
                    v1[0] = v1[0] * fsigmoid(bflo(g.z)) + bflo(o.z); v1[1] = v1[1] * fsigmoid(bfhi(g.z)) + bfhi(o.z); v1[2] = v1[2] * fsigmoid(bflo(g.w)) + bflo(o.w); v1[3] = v1[3] * fsigmoid(bfhi(g.w)) + bfhi(o.w);
                    *(u32x4*)(Mg + (size_t)row * DM + col) = pack8(v0, v1); }
            asm volatile("" ::: "memory");
        }
    }
};
template <bool F32OUT, bool X8 = false, bool SC32 = false> struct EpiRes {
    float* xout; bf16_t* xb; float* rowss; unsigned char* x8;
    __device__ __forceinline__ void operator()(const f32x4 (&acc)[2][2][4][2], const Unit& u, int wr, int wc, int fr, int fq) const {
        const int row0 = u.om * BM + wr * 64 + fr, colt = u.on * BM, cw = wc * 32 + 8 * fq;
#pragma unroll
        for (int ai = 0; ai < 2; ++ai) {
            u32x4 xw[4][2];
#pragma unroll
            for (int m = 0; m < 4; ++m)
#pragma unroll
                for (int bj = 0; bj < 2; ++bj) xw[m][bj] = *(const u32x4*)(xb + (size_t)(row0 + ai * HALF + m * 16) * DM + colt + bj * HALF + cw);
#pragma unroll
            for (int m = 0; m < 4; ++m) {
                const int row = row0 + ai * HALF + m * 16; float ss = 0.f;
#pragma unroll
                for (int bj = 0; bj < 2; ++bj) { const size_t off = (size_t)row * DM + colt + bj * HALF + cw; const u32x4 w = xw[m][bj];
                    f32x4 v0 = acc[ai][bj][m][0], v1 = acc[ai][bj][m][1];
                    if constexpr (SC32) { v0 *= 0.03125f; v1 *= 0.03125f; }
                    v0[0] += bflo(w.x); v0[1] += bfhi(w.x); v0[2] += bflo(w.y); v0[3] += bfhi(w.y); v1[0] += bflo(w.z); v1[1] += bfhi(w.z); v1[2] += bflo(w.w); v1[3] += bfhi(w.w);
                    if constexpr (F32OUT) { *(f32x4*)(xout + off) = v0; *(f32x4*)(xout + off + 4) = v1; }
                    *(u32x4*)(xb + off) = pack8(v0, v1);
                    if constexpr (X8) { u32x2 q; q.x = cvt_pk4_fp8(v0[0], v0[1], v0[2], v0[3]); q.y = cvt_pk4_fp8(v1[0], v1[1], v1[2], v1[3]); *(u32x2*)(x8 + off) = q; }
                    ss += (v0[0] * v0[0] + v0[1] * v0[1]) + (v0[2] * v0[2] + v0[3] * v0[3]) + (v1[0] * v1[0] + v1[1] * v1[1]) + (v1[2] * v1[2] + v1[3] * v1[3]); }
                ss += __shfl_xor(ss, 16); ss += __shfl_xor(ss, 32);
                if (fq == 0) rowss[(size_t)row * 16 + u.on * 4 + wc] = ss;
            }
            asm volatile("" ::: "memory");
        }
    }
};
struct EpiRowScale {
    bf16_t* O; int ldc; const float* rowss;
    __device__ __forceinline__ void operator()(const f32x4 (&acc)[2][2][4][2], const Unit& u, int wr, int wc, int fr, int fq) const {
        const int row0 = u.om * BM + wr * 64 + fr, colt = u.on * BM, cw = wc * 32 + 8 * fq;
#pragma unroll
        for (int ai = 0; ai < 2; ++ai)
#pragma unroll
            for (int m = 0; m < 4; ++m) {
                const int row = row0 + ai * HALF + m * 16; const float rstd = row_rstd(rowss, row);
#pragma unroll
                for (int bj = 0; bj < 2; ++bj) *(u32x4*)(O + (size_t)row * ldc + colt + bj * HALF + cw) = pack8(acc[ai][bj][m][0] * rstd, acc[ai][bj][m][1] * rstd);
                if (m == 3) asm volatile("" ::: "memory");
            }
    }
};
template <bool MOE> struct EpiSwiGLU {
    bf16_t* H; int ldh; const float* rs; const int* row_tok;
    __device__ __forceinline__ void operator()(const f32x4 (&acc)[2][2][4][2], const Unit& u, int wr, int wc, int fr, int fq) const {
        const int row0 = u.om * BM + wr * 64 + fr, hc = u.on * HALF + wc * 32 + 8 * fq;
#pragma unroll
        for (int ai = 0; ai < 2; ++ai) { float rsd[4];
#pragma unroll
            for (int m = 0; m < 4; ++m) { const int row = row0 + ai * HALF + m * 16; rsd[m] = MOE ? rs[row_tok[row]] : row_rstd(rs, row); }
#pragma unroll
            for (int m = 0; m < 4; ++m) {
                const int row = row0 + ai * HALF + m * 16;
                const float rstd = rsd[m];
                f32x4 o[2];
#pragma unroll
                for (int n = 0; n < 2; ++n)
#pragma unroll
                    for (int j = 0; j < 4; ++j) { const float gv = acc[ai][0][m][n][j] * rstd, uv = acc[ai][1][m][n][j] * rstd; o[n][j] = gv * fsigmoid(gv) * uv; }
                *(u32x4*)(H + (size_t)row * ldh + hc) = pack8(o[0], o[1]);
                if (m == 3) asm volatile("" ::: "memory");
            } }
    }
};
template <bool RSTD, bool W32 = true> struct EpiSwiGLU8 {
    unsigned char* H; int ldh; const float* rs;
    __device__ __forceinline__ void operator()(const f32x4 (&acc)[2][2][4][2], const Unit& u, int wr, int wc, int fr, int fq) const {
        const int row0 = u.om * BM + wr * 64 + fr, hc = u.on * HALF + wc * 32 + 8 * fq;
#pragma unroll
        for (int ai = 0; ai < 2; ++ai)
#pragma unroll
            for (int m = 0; m < 4; ++m) {
                const int row = row0 + ai * HALF + m * 16;
                float sc = W32 ? 0.03125f : 1.f; if constexpr (RSTD) sc *= row_rstd(rs, row);
                f32x4 o[2];
#pragma unroll
                for (int n = 0; n < 2; ++n)
#pragma unroll
                    for (int j = 0; j < 4; ++j) { const float gv = acc[ai][0][m][n][j] * sc, uv = acc[ai][1][m][n][j] * sc; o[n][j] = gv * fsigmoid(gv) * uv; }
                u32x2 w; w.x = cvt_pk4_fp8(o[0][0], o[0][1], o[0][2], o[0][3]); w.y = cvt_pk4_fp8(o[1][0], o[1][1], o[1][2], o[1][3]);
                *(u32x2*)(H + (size_t)row * ldh + hc) = w;
                if (m == 3) asm volatile("" ::: "memory");
            }
    }
};
struct EpiPlain {
    bf16_t* O; int ldc; float sc;
    __device__ __forceinline__ void operator()(const f32x4 (&acc)[2][2][4][2], const Unit& u, int wr, int wc, int fr, int fq) const {
        const int row0 = u.om * BM + wr * 64 + fr, colt = u.on * BM, cw = wc * 32 + 8 * fq;
#pragma unroll
        for (int ai = 0; ai < 2; ++ai)
#pragma unroll
            for (int m = 0; m < 4; ++m) { const int row = row0 + ai * HALF + m * 16;
#pragma unroll
                for (int bj = 0; bj < 2; ++bj) *(u32x4*)(O + (size_t)row * ldc + colt + bj * HALF + cw) = pack8(acc[ai][bj][m][0] * sc, acc[ai][bj][m][1] * sc); }
    }
};
}

#define XB_TMO      128
#define XB_XCNT(j)  (256  + 64 * (j))
#define XB_XSUB(j)  (1280 + 64 * (j))
#define XB_XGEN(j)  (2304 + 64 * (j))
#define XB_TOP      3328
#define XB_TOPGEN   3392
#define XCD_BAR_WORDS 3456
#define XB_SPIN_CAP (1u << 18)
__device__ __forceinline__ unsigned xb_ld(unsigned* p)              { return __hip_atomic_load(p, __ATOMIC_RELAXED, __HIP_MEMORY_SCOPE_AGENT); }
__device__ __forceinline__ unsigned xb_add(unsigned* p, unsigned v) { return __hip_atomic_fetch_add(p, v, __ATOMIC_RELAXED, __HIP_MEMORY_SCOPE_AGENT); }
__device__ __forceinline__ unsigned xb_xcc_id() { return (unsigned)__builtin_amdgcn_s_getreg((3 << 11) | 20) & 0xFu; }
#define XB_SPIN(cond, bar) do { unsigned _sp = 0; while (cond) { __builtin_amdgcn_s_sleep(1); \
    if ((++_sp & 255u) == 0u) { if (xb_ld(&(bar)[XB_TMO])) break; if (_sp > XB_SPIN_CAP) { atomicAdd(&(bar)[XB_TMO], 1u); break; } } } } while (0)
struct XcdBarrier { unsigned* bar; unsigned x; volatile LAS unsigned* st; };
__device__ __forceinline__ XcdBarrier xcd_barrier_post(unsigned* bar, volatile LAS unsigned* st) {
    XcdBarrier b; b.bar = bar; b.x = xb_xcc_id(); b.st = st;
    if (threadIdx.x == 0) (void)xb_add(&bar[XB_XCNT(b.x)], 1u);
    return b;
}
__device__ __forceinline__ void xcd_barrier_complete(unsigned* bar, unsigned x, unsigned& nloc, unsigned& nx) {
    const unsigned G = gridDim.x * gridDim.y * gridDim.z;
    unsigned sum, cnt, mine, sp = 0u;
    for (;;) {
        sum = 0u; cnt = 0u; mine = 0u;
#pragma unroll
        for (unsigned j = 0; j < 16; ++j) { const unsigned c = xb_ld(&bar[XB_XCNT(j)]); sum += c; cnt += (c > 0u) ? 1u : 0u; mine = (j == x) ? c : mine; }
        if (sum == G) break;
        __builtin_amdgcn_s_sleep(1);
        if ((++sp & 255u) == 0u) { if (xb_ld(&bar[XB_TMO])) break; if (sp > XB_SPIN_CAP) { atomicAdd(&bar[XB_TMO], 1u); break; } }
    }
    nloc = mine > 0u ? mine : 1u; nx = cnt > 0u ? cnt : 1u;
}
__device__ __forceinline__ void xcd_barrier(const XcdBarrier& b) {
    asm volatile("s_waitcnt vmcnt(0)" ::: "memory");
    __syncthreads();
    if (threadIdx.x == 0) {
        unsigned* bar = b.bar;
        __builtin_amdgcn_s_waitcnt(0);
        unsigned nloc = b.st[0], nx = b.st[1];
        if (nloc == 0u) { xcd_barrier_complete(bar, b.x, nloc, nx); b.st[0] = nloc; b.st[1] = nx; }
        const unsigned old = xb_add(&bar[XB_XSUB(b.x)], 1u);
        const unsigned gen = old / nloc;
        if (old + 1u == (gen + 1u) * nloc) {
            __builtin_amdgcn_fence(__ATOMIC_RELEASE, "agent");
            asm volatile("s_waitcnt vmcnt(0)" ::: "memory");
            const unsigned og = xb_add(&bar[XB_TOP], 1u);
            const unsigned tg = og / nx;
            if (og + 1u == (tg + 1u) * nx) xb_add(&bar[XB_TOPGEN], 1u);
            else XB_SPIN(xb_ld(&bar[XB_TOPGEN]) == tg, bar);
            __builtin_amdgcn_fence(__ATOMIC_ACQUIRE, "agent");
            xb_add(&bar[XB_XGEN(b.x)], 1u);
            asm volatile("s_waitcnt vmcnt(0)" ::: "memory");
        } else {
            XB_SPIN(xb_ld(&bar[XB_XGEN(b.x)]) == gen, bar);
            __builtin_amdgcn_fence(__ATOMIC_ACQUIRE, "agent");
            asm volatile("s_waitcnt vmcnt(0)" ::: "memory");
        }
    }
    __syncthreads();
}

struct Args { const void* in[55]; float* out; unsigned char* ws; int ph_lo, ph_hi, submask, pad; };
struct Frame {
    LAS unsigned char* lds; unsigned char* ws; unsigned* ctl; float* out;
    int tid, lane, wave, G, bid, gw, ngw;
};
#define GAS __attribute__((address_space(1)))
#define CAS __attribute__((address_space(4)))
#define PHASE_BEGIN() const CAS char* kp_ = (const CAS char*)__builtin_amdgcn_kernarg_segment_ptr(); asm volatile("" : "+s"(kp_)); \
    unsigned char* ws = (unsigned char*)(GAS unsigned char*)(*(const CAS unsigned long long*)(kp_ + 448)); \
    Frame F; { int t_ = threadIdx.x; asm volatile("" : "+v"(t_)); int b_ = blockIdx.x; asm volatile("" : "+s"(b_)); \
      F.lds = (LAS unsigned char*)lds_raw; F.ws = ws; F.ctl = (unsigned*)(ws + WS_CTL); F.out = (float*)(GAS float*)(*(const CAS unsigned long long*)(kp_ + 440)); \
      F.tid = t_; F.lane = t_ & 63; F.wave = __builtin_amdgcn_readfirstlane(t_ >> 6); F.G = gridDim.x; F.bid = b_; F.gw = b_ * 8 + F.wave; F.ngw = F.G * 8; }
#define XB ((bf16_t*)(ws + WS_XB))
#define RS ((float*)(ws + WS_RSP))
#define ZS ((bf16_t*)(ws + WS_ZS))
#define ZG ((bf16_t*)(ws + WS_ZG))
#define YB ((bf16_t*)(ws + WS_Y))
#define MG ((bf16_t*)(ws + WS_MERGED))
#define S5T ((float*)(ws + WS_TAB + TAB_S5T))
#define CMAT ((bf16_t*)(ws + WS_TAB + TAB_CMAT))
#define MISCT ((float*)(ws + WS_TAB + TAB_MISC))
#define BBF ((bf16_t*)(ws + WS_TAB + 832 * 1024))
#define WLP(l) (ws + WS_WL + (size_t)(l) * WL_STRIDE)
#define INF(i) ((const float*)(const GAS float*)(*(const CAS unsigned long long*)(kp_ + 8 * (i))))

struct TJob { const float* W; bf16_t* WT; const float* ks; int K, N, ldw, ldk, nb, map; size_t sstride, dstride; int f8; };
__device__ __forceinline__ int tjob_items(const TJob& j) { return j.nb * (j.K / 64) * (j.N / 32); }
__device__ __forceinline__ void tjob_load(const TJob& j, int item, float (&v)[32], int lane) {
    const int per = (j.K / 64) * (j.N / 32), b = item / per, r = item % per, nblk = j.N / 32, kb = r / nblk, nbk = r % nblk, k0 = 64 * kb, n0 = 32 * nbk;
    const float* W = j.W + (size_t)b * j.sstride + (size_t)(k0 + (lane >> 5)) * j.ldw + n0 + (lane & 31);
#pragma unroll
    for (int i = 0; i < 32; ++i) v[i] = W[(size_t)(2 * i) * j.ldw];
}
__device__ __forceinline__ void tjob_store(const TJob& j, int item, float (&v)[32], LAS float* scr, int lane) {
    const int per = (j.K / 64) * (j.N / 32), b = item / per, r = item % per, nblk = j.N / 32, kb = r / nblk, nbk = r % nblk, k0 = 64 * kb, n0 = 32 * nbk;
    int drow = n0;
    if (j.map == 1) drow = n0 < C_END ? n0 : n0 + (ZSW - C_END);
    else if (j.map == 2) drow = 256 * (n0 >> 7) + (n0 & 127);
    else if (j.map == 3) drow = 256 * (n0 >> 7) + 128 + (n0 & 127);
    if (j.ks) {
#pragma unroll
        for (int i = 0; i < 32; ++i) v[i] *= j.ks[k0 + 2 * i + (lane >> 5)]; }
#pragma unroll
    for (int i = 0; i < 32; ++i) scr[(2 * i + (lane >> 5)) * 33 + (lane & 31)] = v[i];
    asm volatile("s_waitcnt lgkmcnt(0)" ::: "memory");
    const int c = lane & 7; bf16_t* WT = j.WT + (size_t)b * j.dstride;
    if (j.f8) { unsigned char* W8 = (unsigned char*)j.WT + (size_t)b * j.dstride;
#pragma unroll
        for (int q = 0; q < 4; ++q) { const int n = (lane >> 3) + 8 * q; const LAS float* sp = scr + (8 * c) * 33 + n;
            u32x2 o; o.x = cvt_pk4_fp8(sp[0 * 33] * 32.f, sp[1 * 33] * 32.f, sp[2 * 33] * 32.f, sp[3 * 33] * 32.f); o.y = cvt_pk4_fp8(sp[4 * 33] * 32.f, sp[5 * 33] * 32.f, sp[6 * 33] * 32.f, sp[7 * 33] * 32.f);
            *(u32x2*)(W8 + (size_t)(drow + n) * j.ldk + k0 + 8 * c) = o; }
    } else
#pragma unroll
    for (int q = 0; q < 4; ++q) { const int n = (lane >> 3) + 8 * q; const LAS float* sp = scr + (8 * c) * 33 + n;
        u32x4 o; o.x = cvt_pk_bf16(sp[0 * 33], sp[1 * 33]); o.y = cvt_pk_bf16(sp[2 * 33], sp[3 * 33]); o.z = cvt_pk_bf16(sp[4 * 33], sp[5 * 33]); o.w = cvt_pk_bf16(sp[6 * 33], sp[7 * 33]);
        *(u32x4*)(WT + (size_t)(drow + n) * j.ldk + k0 + 8 * c) = o; }
    asm volatile("s_waitcnt lgkmcnt(0)" ::: "memory");
}
__device__ __forceinline__ void tjob_run_all(const TJob& j, int first, int stride, LAS float* scr, int lane) {
    const int ni = tjob_items(j); int it = first; if (it >= ni) return;
    float va[32], vb[32]; tjob_load(j, it, va, lane);
    for (;;) {
        const int n1 = it + stride; if (n1 < ni) tjob_load(j, n1, vb, lane);
        tjob_store(j, it, va, scr, lane); if (n1 >= ni) break;
        const int n2 = n1 + stride; if (n2 < ni) tjob_load(j, n2, va, lane);
        tjob_store(j, n1, vb, scr, lane); if (n2 >= ni) break;
        it = n2;
    }
}

template <int DQ> struct AttnLds { static constexpr int KROW = DQ * 2 + 16, VROW = 272, KBYTES = 128 * KROW, VBYTES = 64 * VROW, BUF = KBYTES + VBYTES; };
#define PK4(P, BASE, OUT) do { unsigned a0_ = cvt_pk_bf16(P[BASE + 0], P[BASE + 1]), a1_ = cvt_pk_bf16(P[BASE + 2], P[BASE + 3]); \
    unsigned b0_ = cvt_pk_bf16(P[BASE + 4], P[BASE + 5]), b1_ = cvt_pk_bf16(P[BASE + 6], P[BASE + 7]); \
    auto r0_ = __builtin_amdgcn_permlane32_swap(a0_, b0_, false, false); auto r1_ = __builtin_amdgcn_permlane32_swap(a1_, b1_, false, false); \
    u32x4 w_ = {r0_[0], r1_[0], r0_[1], r1_[1]}; OUT = *(bf16x8*)&w_; } while (0)

template <int DQ, int NMAP, bool CAUSAL, bool BIAS, bool QNORM>
__device__ __forceinline__ void attn_unit(LAS unsigned char* lds, const bf16_t* Qp, int ldq, const bf16_t* Kp, const bf16_t* Vtp, int vstride, int nkt, int q0,
                                          const LAS float* lut, const float* qg, float qscale, float mshift, f32x16 (&o)[NMAP][2], float (&l)[NMAP]) {
    typedef AttnLds<DQ> L; constexpr int KD = DQ / NMAP, KS = KD / 16, KCH = DQ / 8, NKC = 64 * KCH;
    int tid = threadIdx.x; asm volatile("" : "+v"(tid));
    const int wid = tid >> 6, lane = tid & 63, r32 = lane & 31, hi = lane >> 5;
    bf16x8 q[NMAP][KS];
    {
        const bf16_t* qrow = Qp + (size_t)(wid * 32 + r32) * ldq + hi * 8;
#pragma unroll
        for (int mp = 0; mp < NMAP; ++mp)
#pragma unroll
            for (int ks = 0; ks < KS; ++ks) q[mp][ks] = ldg8(qrow + mp * KD + ks * 16);
        if constexpr (QNORM) {
            float ss = 0.f;
#pragma unroll
            for (int ks = 0; ks < KS; ++ks) ss += sq8(q[0][ks]);
            ss += __shfl_xor(ss, 32);
            const float rs = frsq(ss * (1.f / DQ) + EPS) * qscale;
#pragma unroll
            for (int ks = 0; ks < KS; ++ks) { u32x4 w = *(u32x4*)&q[0][ks]; const float* gp = qg + ks * 16 + hi * 8;
                w.x = cvt_pk_bf16(bflo(w.x) * rs * gp[0], bfhi(w.x) * rs * gp[1]); w.y = cvt_pk_bf16(bflo(w.y) * rs * gp[2], bfhi(w.y) * rs * gp[3]);
                w.z = cvt_pk_bf16(bflo(w.z) * rs * gp[4], bfhi(w.z) * rs * gp[5]); w.w = cvt_pk_bf16(bflo(w.w) * rs * gp[6], bfhi(w.w) * rs * gp[7]);
                q[0][ks] = *(bf16x8*)&w; }
        }
    }
#pragma unroll
    for (int mp = 0; mp < NMAP; ++mp) { l[mp] = 0.f; o[mp][0] = f32x16{}; o[mp][1] = f32x16{}; }
    constexpr int NKI = (128 * KCH) / 512;
    bf16x8 skr[NKI], svr[2];
#define AT_LOAD(j) do { const int key0_ = (j) * 128; \
        _Pragma("unroll") for (int i_ = 0; i_ < NKI; ++i_) { const int c_ = tid + 512 * i_; skr[i_] = ldg8(Kp + (size_t)(key0_ + c_ / KCH) * DQ + (c_ % KCH) * 8); } \
        _Pragma("unroll") for (int i_ = 0; i_ < 2; ++i_) { const int c_ = tid + 512 * i_; svr[i_] = ldg8(Vtp + (size_t)(c_ >> 4) * vstride + key0_ + (c_ & 15) * 8); } } while (0)
#define AT_WRITE(b) do { LAS unsigned char* base_ = lds + (b) * L::BUF; \
        _Pragma("unroll") for (int i_ = 0; i_ < NKI; ++i_) { const int c_ = tid + 512 * i_; *(LAS bf16x8*)(base_ + (c_ / KCH) * L::KROW + (c_ % KCH) * 16) = skr[i_]; } \
        _Pragma("unroll") for (int i_ = 0; i_ < 2; ++i_) { const int c_ = tid + 512 * i_; *(LAS bf16x8*)(base_ + L::KBYTES + (c_ >> 4) * L::VROW + (c_ & 15) * 16) = svr[i_]; } } while (0)
    const int qi = q0 + wid * 32 + r32;
    const int qlo = q0 + wid * 32;
#define AT_COMPUTE(key0, bf, sb) do { const bool active = !CAUSAL || (key0) <= qlo + 31; \
        if (active) { const LAS unsigned char* kb = lds + (bf) * L::BUF + (sb) * 64 * L::KROW; const LAS unsigned char* vb = lds + (bf) * L::BUF + L::KBYTES + (sb) * 128; const bool need_mask = CAUSAL && ((key0) + 63 > qlo); \
            _Pragma("unroll") for (int mp = 0; mp < NMAP; ++mp) { f32x16 p0 = f32x16{}, p1 = f32x16{}; \
                _Pragma("unroll") for (int ks = 0; ks < KS; ++ks) { \
                    const bf16x8 a0 = *(const LAS bf16x8*)(kb + r32 * L::KROW + (mp * KD + ks * 16 + hi * 8) * 2); \
                    const bf16x8 a1 = *(const LAS bf16x8*)(kb + (32 + r32) * L::KROW + (mp * KD + ks * 16 + hi * 8) * 2); \
                    p0 = MFMA32(a0, q[mp][ks], p0); p1 = MFMA32(a1, q[mp][ks], p1); } \
                __builtin_amdgcn_sched_barrier(0); \
                float sh = mshift; \
                if constexpr (BIAS) { \
                    if (qlo - ((key0) + 63) >= 127) sh -= lut[255]; \
                    else { const LAS float* lp = lut + (qi - (key0) - 4 * hi + 69); \
                        _Pragma("unroll") for (int r = 0; r < 16; ++r) { const int cr = (r & 3) + 8 * (r >> 2); p0[r] += lp[59 - cr]; p1[r] += lp[27 - cr]; } } } \
                if (need_mask) { _Pragma("unroll") for (int r = 0; r < 16; ++r) { const int kk = (key0) + crow(r, hi); if (kk > qi) p0[r] = -1e30f; if (kk + 32 > qi) p1[r] = -1e30f; } } \
                float ps = 0.f; \
                _Pragma("unroll") for (int r = 0; r < 16; ++r) { p0[r] = fexp2(p0[r] - sh); p1[r] = fexp2(p1[r] - sh); ps += p0[r] + p1[r]; } \
                l[mp] += ps; \
                __builtin_amdgcn_sched_barrier(0); \
                bf16x8 pa0, pa1, pa2, pa3; \
                PK4(p0, 0, pa0); PK4(p0, 8, pa1); PK4(p1, 0, pa2); PK4(p1, 8, pa3); \
                _Pragma("unroll") for (int dt = 0; dt < 2; ++dt) { \
                    const LAS unsigned char* vrow = vb + (dt * 32 + r32) * L::VROW + hi * 16; \
                    const bf16x8 v0 = *(const LAS bf16x8*)(vrow), v1 = *(const LAS bf16x8*)(vrow + 32), v2 = *(const LAS bf16x8*)(vrow + 64), v3 = *(const LAS bf16x8*)(vrow + 96); \
                    o[mp][dt] = MFMA32(v0, pa0, o[mp][dt]); o[mp][dt] = MFMA32(v1, pa1, o[mp][dt]); o[mp][dt] = MFMA32(v2, pa2, o[mp][dt]); o[mp][dt] = MFMA32(v3, pa3, o[mp][dt]); } \
                __builtin_amdgcn_sched_barrier(0); } } } while (0)
    const int n128 = nkt >> 1;
    if (wid < 4) __builtin_amdgcn_s_setprio(2);
    AT_LOAD(0); AT_WRITE(0); __syncthreads();
    for (int j = 0; j < n128; ++j) {
        if (j + 1 < n128) AT_LOAD(j + 1);
        AT_COMPUTE(j * 128, j & 1, 0);
        AT_COMPUTE(j * 128 + 64, j & 1, 1);
        if (j + 1 < n128) AT_WRITE((j + 1) & 1);
        __syncthreads();
    }
    __builtin_amdgcn_s_setprio(0);
#undef AT_COMPUTE
#pragma unroll
    for (int mp = 0; mp < NMAP; ++mp) l[mp] += __shfl_xor(l[mp], 32);
#undef AT_LOAD
#undef AT_WRITE
}

__device__ __forceinline__ void attn_store(bf16_t* dst, const f32x16 (&o)[2], float scale, int hi) {
#pragma unroll
    for (int dt = 0; dt < 2; ++dt)
#pragma unroll
        for (int rg = 0; rg < 4; ++rg) { u32x2 w; w.x = cvt_pk_bf16(o[dt][4 * rg] * scale, o[dt][4 * rg + 1] * scale); w.y = cvt_pk_bf16(o[dt][4 * rg + 2] * scale, o[dt][4 * rg + 3] * scale);
            *(u32x2*)(dst + dt * 32 + 8 * rg + 4 * hi) = w; }
}

__device__ __forceinline__ bool in_phase(int k) { const __attribute__((address_space(4))) int* p_ = (const __attribute__((address_space(4))) int*)__builtin_amdgcn_kernarg_segment_ptr(); asm volatile("" : "+s"(p_)); return p_[114] <= k && k < p_[115]; }
__device__ __forceinline__ bool sub_on(int k) { const __attribute__((address_space(4))) int* p_ = (const __attribute__((address_space(4))) int*)__builtin_amdgcn_kernarg_segment_ptr(); asm volatile("" : "+s"(p_)); return (p_[116] >> k) & 1; }
__device__ __forceinline__ void s5_bu_tile(LAS unsigned char* tile, const bf16_t* bbf_g, const bf16_t* zs_tok0, int lane) {
    const int r32 = lane & 31, hi = lane >> 5;
    const bf16x8 uf = ldg8(zs_tok0 + (size_t)r32 * ZSW + 8 * hi);
#pragma unroll
    for (int pt = 0; pt < 4; ++pt) { f32x16 d = f32x16{}; d = MFMA32(ldg8(bbf_g + (size_t)(32 * pt + r32) * 16 + 8 * hi), uf, d);
#pragma unroll
        for (int rg = 0; rg < 4; ++rg) { u32x2 w; w.x = cvt_pk_bf16(d[4 * rg], d[4 * rg + 1]); w.y = cvt_pk_bf16(d[4 * rg + 2], d[4 * rg + 3]);
            *(LAS u32x2*)(tile + r32 * 272 + (32 * pt + 8 * rg + 4 * hi) * 2) = w; } }
    asm volatile("s_waitcnt lgkmcnt(0)" ::: "memory");
}
__device__ __forceinline__ int h0_pull(LAS unsigned* qc, int lane, int wg_items, int bid, int G, int total) {
    unsigned k = 0u; if (lane == 0) k = __hip_atomic_fetch_add(qc, 1u, __ATOMIC_RELAXED, __HIP_MEMORY_SCOPE_WORKGROUP);
    const int kk = __builtin_amdgcn_readfirstlane((int)k);
    return kk < wg_items ? bid + kk * G : total;
}
__device__ __forceinline__ int queue_pull(unsigned* ctr, volatile LAS unsigned* slot, int tid) {
    __syncthreads();
    if (tid == 0) *slot = __hip_atomic_fetch_add(ctr, 1u, __ATOMIC_RELAXED, __HIP_MEMORY_SCOPE_AGENT);
    __syncthreads();
    return (int)*slot;
}
constexpr int NPHASE = 24;
#ifndef DBG_NPH
#endif
__global__ void __launch_bounds__(512, 2) hybrid_fwd(Args args) {
    extern __shared__ __attribute__((aligned(16))) unsigned char lds_raw[];
    LAS unsigned char* lds0 = (LAS unsigned char*)lds_raw;
    volatile LAS unsigned* MISC = (volatile LAS unsigned*)(lds0 + MISC_OFF);
    for (int u = threadIdx.x; u < (LDS_BYTES - RING_BYTES) / 4; u += 512) ((LAS unsigned*)(lds0 + RING_BYTES))[u] = 0u;
    __syncthreads();
    const int lo = args.ph_lo, hi_ph = args.ph_hi;
    const bool one_launch = (hi_ph - lo) > 1;
    XcdBarrier bar; bar.bar = (unsigned*)(args.ws + WS_CTL) + CW_BAR; bar.x = 0; bar.st = nullptr;
    if (one_launch) bar = xcd_barrier_post((unsigned*)(args.ws + WS_CTL) + CW_BAR, MISC + 8);
#ifndef SUBMASK
#define SUBMASK 0xFFFFu
#endif
#define SUB(k) ((((SUBMASK) >> (k)) & 1u) && sub_on(k))
#ifndef PHMASK
#define PHMASK 0xFFFFFFu
#endif
#define IN(k) ((((PHMASK) >> (k)) & 1u) && in_phase(k))
#define SEAM(k) do { if (IN(k) && IN((k) + 1)) { XcdBarrier b2_ = bar; asm volatile("" : "+s"(b2_.bar), "+s"(b2_.x)); xcd_barrier(b2_); } } while (0)

    if (IN(0)) { PHASE_BEGIN();
        LAS float* scr = (LAS float*)(F.lds + F.wave * 16384);
        int joff = 0;
        for (int l = 0; l < 2; ++l) {
            unsigned char* wl = ws + WS_WL + l * WL_STRIDE;
#define RUNJOB(...) do { const TJob jb_ = TJob{__VA_ARGS__}; int fst_ = F.gw - joff; if (fst_ < 0) fst_ += F.ngw; tjob_run_all(jb_, fst_, F.ngw, scr, F.lane); joff = (joff + tjob_items(jb_)) % F.ngw; } while (0)
            RUNJOB(INF(8) + (size_t)l * DM * DIN, (bf16_t*)(wl + WL_WIN), INF(4) + l * DM, DM, DIN, DIN, DM, 1, 1, 0, 0);
            RUNJOB(INF(22) + (size_t)l * 192 * 384, (bf16_t*)(wl + WL_SM + SM_WUQ), INF(20) + l * 192, 192, 384, 384, 192, 1, 0, 0, 0);
            RUNJOB(INF(23) + (size_t)l * 128 * 512, (bf16_t*)(wl + WL_SM + SM_WUKV), INF(21) + l * 128, 128, 512, 512, 128, 1, 0, 0, 0);
            RUNJOB(INF(28) + (size_t)l * 4 * 4096, (bf16_t*)(wl + WL_SM + SM_WR), nullptr, 64, 64, 64, 64, 4, 0, 4096, 4096);
            RUNJOB(INF(30) + (size_t)l * 4 * 4096, (bf16_t*)(wl + WL_SM + SM_WI), nullptr, 64, 64, 64, 64, 4, 0, 4096, 4096);
            RUNJOB(INF(18) + (size_t)l * 65536, (bf16_t*)(wl + WL_SM + SM_WGLU), nullptr, 256, 256, 256, 256, 1, 0, 0, 0);
            RUNJOB(INF(40) + (size_t)l * 4 * 256 * DM, (bf16_t*)(wl + WL_PT), nullptr, 256, DM, DM, 256, 4, 0, (size_t)256 * DM, (size_t)DM * 256);
            RUNJOB(INF(41) + (size_t)l * DM * DM, (bf16_t*)(wl + WL_WO), nullptr, DM, DM, DM, DM, 1, 0, 0, 0);
            RUNJOB(INF(42) + (size_t)l * DM * 256, (bf16_t*)(wl + WL_WXQ), INF(5) + l * DM, DM, 256, 256, DM, 1, 0, 0, 0);
            RUNJOB(INF(43) + (size_t)l * DM * 256, (bf16_t*)(wl + WL_WXKV), INF(6) + l * DM, DM, 256, 256, DM, 1, 0, 0, 0);
            RUNJOB(INF(44) + (size_t)l * DM * 256, (bf16_t*)(wl + WL_WXKV) + (size_t)256 * DM, INF(6) + l * DM, DM, 256, 256, DM, 1, 0, 0, 0);
            RUNJOB(INF(45) + (size_t)l * 256 * DM, (bf16_t*)(wl + WL_WXO), nullptr, 256, DM, DM, 256, 1, 0, 0, 0);
            { u32x4* z = (u32x4*)((bf16_t*)(wl + WL_WIN) + (size_t)C_END * DM); const int n16 = (ZSW - C_END) * DM * 2 / 16;
              for (int i = F.bid * 512 + F.tid; i < n16; i += F.G * 512) z[i] = (u32x4){0u, 0u, 0u, 0u}; }
        }
        {
            RUNJOB(INF(48), (bf16_t*)(ws + WS_WGU), INF(7), DM, FF, FF, DM, 1, 2, 0, 0);
            RUNJOB(INF(49), (bf16_t*)(ws + WS_WGU), INF(7), DM, FF, FF, DM, 1, 3, 0, 0);
            RUNJOB(INF(50), (bf16_t*)(ws + WS_WD), nullptr, FF, DM, DM, FF, 1, 0, 0, 0, G2_FP8);
        }
        for (int i = F.bid * 512 + F.tid; i < 2 * 16 * 64; i += F.G * 512) {
            const int l = i >> 10, g = (i >> 6) & 15, p = i & 63;
            const float dt = __expf(INF(12)[l * 16 + g]);
            const float lr = INF(10)[(l * 16 + g) * 64 + p], li = INF(11)[(l * 16 + g) * 64 + p];
            const float mag = __expf(lr * dt); float sn, cs; sincos_red(li * dt, sn, cs);
            const float ar = mag * cs, ai = mag * sn, den = lr * lr + li * li;
            const float zr = ((ar - 1.f) * lr + ai * li) / den, zi = (ai * lr - (ar - 1.f) * li) / den;
            float* tb = S5T + (size_t)(l * 16 + g) * 36 * 64;
            for (int c = 0; c < 16; ++c) { const float br = INF(13)[((l * 16 + g) * 64 + p) * 16 + c], bi = INF(14)[((l * 16 + g) * 64 + p) * 16 + c];
                tb[c * 64 + p] = zr * br - zi * bi; tb[(16 + c) * 64 + p] = zr * bi + zi * br;
                BBF[((size_t)(l * 16 + g) * 128 + p) * 16 + c] = f2bf(zr * br - zi * bi); BBF[((size_t)(l * 16 + g) * 128 + 64 + p) * 16 + c] = f2bf(zr * bi + zi * br); }
            tb[32 * 64 + p] = ar; tb[33 * 64 + p] = ai;
            float pr = ar, pi = ai;
            for (int s = 0; s < 6; ++s) { const float nr = pr * pr - pi * pi, ni = 2.f * pr * pi; pr = nr; pi = ni; }
            tb[34 * 64 + p] = pr; tb[35 * 64 + p] = pi;
            bf16_t* cm = CMAT + (size_t)(l * 16 + g) * 16 * 128;
            for (int c = 0; c < 16; ++c) { cm[c * 128 + p] = f2bf(INF(15)[((l * 16 + g) * 16 + c) * 64 + p]); cm[c * 128 + 64 + p] = f2bf(-INF(16)[((l * 16 + g) * 16 + c) * 64 + p]); }
        }
        for (int i = F.bid * 512 + F.tid; i < 512; i += F.G * 512) { const float lam = INF(32)[i]; MISCT[i] = 8.f * log1pf(__expf(-lam)); }
        if (F.bid == 0 && F.tid < 2) { const int l = F.tid; float s1 = 0.f, s2 = 0.f;
            for (int d = 0; d < 32; ++d) { s1 += INF(35)[l * 32 + d] * INF(36)[l * 32 + d]; s2 += INF(37)[l * 32 + d] * INF(38)[l * 32 + d]; }
            const float lam_init = 0.8f - 0.6f * expf(-0.3f * (float)l);
            MISCT[512 + l] = expf(s1) - expf(s2) + lam_init; MISCT[514 + l] = lam_init;
            float gq = 0.f, gk = 0.f; for (int d = 0; d < 96; ++d) { gq = fmaxf(gq, fabsf(INF(24)[l * 96 + d])); gk = fmaxf(gk, fabsf(INF(25)[l * 96 + d])); }
            MISCT[516 + l * 4 + 0] = 1.02f * gq * gk * 9.797958971f * LOG2E;
            gq = 0.f; gk = 0.f; for (int d = 0; d < 32; ++d) { gq = fmaxf(gq, fabsf(INF(33)[l * 32 + d])); gk = fmaxf(gk, fabsf(INF(34)[l * 32 + d])); }
            float bm = 0.f; for (int i = 0; i < 128; ++i) bm = fmaxf(bm, fabsf(INF(3)[i]));
            MISCT[516 + l * 4 + 1] = 1.02f * gq * gk * 5.656854249f * LOG2E + bm * LOG2E;
            gq = 0.f; gk = 0.f; for (int d = 0; d < 64; ++d) { gq = fmaxf(gq, fabsf(INF(46)[l * 64 + d])); gk = fmaxf(gk, fabsf(INF(47)[l * 64 + d])); }
            MISCT[516 + l * 4 + 2] = 1.02f * gq * gk * 8.f * LOG2E; }
        for (int i = F.bid * 512 + F.tid; i < 4 * 384; i += F.G * 512) { const int h = i / 384, dd = i % 384 - 128, d = dd > 127 ? 127 : dd; int bk;
            if (d < 16) bk = d < 0 ? 0 : d; else { const float lr_ = logf((float)d / 16.f) / logf(8.f); bk = 16 + (int)(lr_ * 16.f); if (bk > 31) bk = 31; }
            MISCT[1024 + i] = dd < 0 ? 0.f : INF(3)[bk * 4 + h] * LOG2E; }
        for (int m0 = F.gw; m0 < MTOK; m0 += 2 * F.ngw) {
            const int m1 = m0 + F.ngw < MTOK ? m0 + F.ngw : m0;
            const f32x4* xr0 = (const f32x4*)(INF(0) + (size_t)m0 * DM) + F.lane; const f32x4* xr1 = (const f32x4*)(INF(0) + (size_t)m1 * DM) + F.lane;
            f32x4 v0[4], v1[4];
#pragma unroll
            for (int j = 0; j < 4; ++j) { v0[j] = xr0[64 * j]; v1[j] = xr1[64 * j]; }
#pragma unroll
            for (int h = 0; h < 2; ++h) { const int m = h ? m1 : m0; float s = 0.f;
                u32x2* o8 = (u32x2*)(XB + (size_t)m * DM) + F.lane;
#pragma unroll
                for (int j = 0; j < 4; ++j) { const f32x4 v = h ? v1[j] : v0[j]; s += (v.x * v.x + v.y * v.y) + (v.z * v.z + v.w * v.w); u32x2 w; w.x = cvt_pk_bf16(v.x, v.y); w.y = cvt_pk_bf16(v.z, v.w); o8[64 * j] = w; }
                s = wave_sum(s); if (F.lane < 16) RS[(size_t)m * 16 + F.lane] = F.lane == 0 ? s : 0.f; }
        }
    }
    SEAM(0);

    for (int l = 0; l < 2; ++l) {
        const int pb = 1 + 10 * l;
        if (IN(pb + 0)) { PHASE_BEGIN();
            pg8::Gemm g{XB, (const bf16_t*)(WLP(l) + WL_WIN), DM, nullptr}; pg8::StaticOrder S; S.init(MTOK / 256, NIN / 256, F.G, F.bid);
            pg8::EpiIn E{ZS, ZG, RS + (size_t)(l == 0 ? 0 : 3) * MTOK * 16, INF(9) + (size_t)l * 4 * DM};
            pg8::gemm_phase<pg8::EpiIn, pg8::StaticOrder, true, false>(F.lds, g, S, E);
        }
        SEAM(pb + 0);
        if (IN(pb + 1)) { PHASE_BEGIN();
            const int lane = F.lane, r = lane & 31, hi = lane >> 5;
            bf16_t* QM = (bf16_t*)(ws + WS_QM); bf16_t* KM = (bf16_t*)(ws + WS_KM); bf16_t* VMT = (bf16_t*)(ws + WS_VMT);
            if (SUB(0) && F.wave < 2) for (int tt = F.bid * 2 + F.wave; tt < 512; tt += F.G * 2) {
                const int row = tt * 32 + r, b = row >> 12, s = row & 4095;
                bf16x8 xq[12]; float ss = 0.f;
#pragma unroll
                for (int ks = 0; ks < 12; ++ks) { xq[ks] = ldg8(ZS + (size_t)row * ZSW + C_CQ + 16 * ks + 8 * hi); ss += sq8(xq[ks]); }
                ss += __shfl_xor(ss, 32); const float rc = frsq(ss * (1.f / 192.f) + EPS);
                const float pos = (float)((const int*)INF(2))[row]; float cs[8], sn[8];
#pragma unroll
                for (int i = 0; i < 8; ++i) { const int fi = crow(i, hi); const float inv = exp2f(-(float)fi * (13.287712379549449f / 16.f)); sincos_red(pos * inv, sn[i], cs[i]); }
                const bf16_t* W = (const bf16_t*)(WLP(l) + WL_SM + SM_WUQ); const float* gq = INF(24) + l * 96;
#pragma unroll 1
                for (int hd = 0; hd < 4; ++hd) {
                    f32x16 acc[3] = {f32x16{}, f32x16{}, f32x16{}};
#pragma unroll
                    for (int ft = 0; ft < 3; ++ft) {
#pragma unroll
                        for (int ks = 0; ks < 12; ++ks) acc[ft] = MFMA32(ldg8(W + (size_t)(hd * 96 + 32 * ft + r) * 192 + 16 * ks + 8 * hi), xq[ks], acc[ft]); }
                    float s2 = 0.f;
#pragma unroll
                    for (int ft = 0; ft < 3; ++ft)
#pragma unroll
                        for (int q = 0; q < 16; ++q) { acc[ft][q] *= rc; s2 += acc[ft][q] * acc[ft][q]; }
                    s2 += __shfl_xor(s2, 32); const float rq = frsq(s2 * (1.f / 96.f) + EPS);
#pragma unroll
                    for (int ft = 0; ft < 3; ++ft)
#pragma unroll
                        for (int q = 0; q < 16; ++q) acc[ft][q] *= rq * gq[32 * ft + crow(q, hi)];
#pragma unroll
                    for (int q = 0; q < 8; ++q) { const float x1 = acc[2][q], x2 = acc[2][q + 8]; acc[2][q] = x1 * cs[q] - x2 * sn[q]; acc[2][q + 8] = x1 * sn[q] + x2 * cs[q]; }
                    const float qs = 0.10206207261596577f * LOG2E;
                    bf16_t* dst = QM + ((size_t)(b * 4 + hd) * SEQ + s) * 96;
#pragma unroll
                    for (int ft = 0; ft < 3; ++ft)
#pragma unroll
                        for (int rg = 0; rg < 4; ++rg) { u32x2 w; w.x = cvt_pk_bf16(acc[ft][4 * rg] * qs, acc[ft][4 * rg + 1] * qs); w.y = cvt_pk_bf16(acc[ft][4 * rg + 2] * qs, acc[ft][4 * rg + 3] * qs);
                            *(u32x2*)(dst + 32 * ft + 8 * rg + 4 * hi) = w; }
                }
            }
            if (SUB(1) && (F.wave == 2 || F.wave == 3)) for (int tt = F.bid * 2 + F.wave - 2; tt < 512; tt += F.G * 2) {
                const int row = tt * 32 + r, b = row >> 12, s = row & 4095;
                bf16x8 xk[8]; float ss = 0.f;
#pragma unroll
                for (int ks = 0; ks < 8; ++ks) { xk[ks] = ldg8(ZS + (size_t)row * ZSW + C_CKV + 16 * ks + 8 * hi); ss += sq8(xk[ks]); }
                ss += __shfl_xor(ss, 32); const float rc = frsq(ss * (1.f / 128.f) + EPS);
                float kp[16]; float sskp = 0.f;
#pragma unroll
                for (int rg = 0; rg < 4; ++rg) { const u32x2 w = *(const u32x2*)(ZS + (size_t)row * ZSW + C_KPE + 8 * rg + 4 * hi);
                    kp[4 * rg] = bflo(w.x); kp[4 * rg + 1] = bfhi(w.x); kp[4 * rg + 2] = bflo(w.y); kp[4 * rg + 3] = bfhi(w.y); }
#pragma unroll
                for (int q = 0; q < 16; ++q) sskp += kp[q] * kp[q];
                const float pos = (float)((const int*)INF(2))[row]; float cs[8], sn[8];
#pragma unroll
                for (int i = 0; i < 8; ++i) { const int fi = crow(i, hi); const float inv = exp2f(-(float)fi * (13.287712379549449f / 16.f)); sincos_red(pos * inv, sn[i], cs[i]); }
                const bf16_t* W = (const bf16_t*)(WLP(l) + WL_SM + SM_WUKV); const float* gk = INF(25) + l * 96;
#pragma unroll 1
                for (int hd = 0; hd < 4; ++hd) {
                    f32x16 acc[4] = {f32x16{}, f32x16{}, f32x16{}, f32x16{}};
#pragma unroll
                    for (int ft = 0; ft < 4; ++ft) {
#pragma unroll
                        for (int ks = 0; ks < 8; ++ks) acc[ft] = MFMA32(ldg8(W + (size_t)(hd * 128 + 32 * ft + r) * 128 + 16 * ks + 8 * hi), xk[ks], acc[ft]); }
                    float s2 = sskp;
#pragma unroll
                    for (int ft = 0; ft < 2; ++ft)
#pragma unroll
                        for (int q = 0; q < 16; ++q) { acc[ft][q] *= rc; s2 += acc[ft][q] * acc[ft][q]; }
                    s2 += __shfl_xor(s2, 32); const float rk = frsq(s2 * (1.f / 96.f) + EPS);
                    float kr[16];
#pragma unroll
                    for (int q = 0; q < 16; ++q) kr[q] = kp[q] * rk * gk[64 + crow(q, hi)];
#pragma unroll
                    for (int q = 0; q < 8; ++q) { const float x1 = kr[q], x2 = kr[q + 8]; kr[q] = x1 * cs[q] - x2 * sn[q]; kr[q + 8] = x1 * sn[q] + x2 * cs[q]; }
                    bf16_t* dst = KM + ((size_t)(b * 4 + hd) * SEQ + s) * 96;
#pragma unroll
                    for (int ft = 0; ft < 2; ++ft)
#pragma unroll
                        for (int rg = 0; rg < 4; ++rg) { const float* gp = gk + 32 * ft + 8 * rg + 4 * hi; u32x2 w;
                            w.x = cvt_pk_bf16(acc[ft][4 * rg] * rk * gp[0], acc[ft][4 * rg + 1] * rk * gp[1]); w.y = cvt_pk_bf16(acc[ft][4 * rg + 2] * rk * gp[2], acc[ft][4 * rg + 3] * rk * gp[3]);
                            *(u32x2*)(dst + 32 * ft + 8 * rg + 4 * hi) = w; }
#pragma unroll
                    for (int rg = 0; rg < 4; ++rg) { u32x2 w; w.x = cvt_pk_bf16(kr[4 * rg], kr[4 * rg + 1]); w.y = cvt_pk_bf16(kr[4 * rg + 2], kr[4 * rg + 3]); *(u32x2*)(dst + 64 + 8 * rg + 4 * hi) = w; }
                    bf16_t* vd = VMT + (size_t)(b * 4 + hd) * 64 * SEQ + s;
#pragma unroll
                    for (int ft = 2; ft < 4; ++ft)
#pragma unroll
                        for (int q = 0; q < 16; ++q) vd[(size_t)(32 * (ft - 2) + crow(q, hi)) * SEQ] = f2bf(acc[ft][q] * rc);
                }
            }
            if (SUB(2)) {
                bf16_t* QD = (bf16_t*)(ws + WS_QD); bf16_t* KD = (bf16_t*)(ws + WS_KD); bf16_t* VDT = (bf16_t*)(ws + WS_VDT);
                const float* gqn = INF(33) + l * 32; const float* gkn = INF(34) + l * 32;
                for (int i = F.bid * 512 + F.tid; i < MTOK * 16; i += F.G * 512) {
                    const int row = i & (MTOK - 1), j = i >> 14, half = j & 1, hd = (j >> 1) & 3, isk = j >> 3;
                    const bf16_t* src = ZS + (size_t)row * ZSW + (isk ? C_KD : C_QD) + hd * 64 + half * 32;
                    bf16x8 v[4]; float ss = 0.f;
#pragma unroll
                    for (int c = 0; c < 4; ++c) { v[c] = ldg8(src + 8 * c); ss += sq8(v[c]); }
                    const float rs = frsq(ss * (1.f / 32.f) + EPS) * (isk ? 1.f : 0.17677669529663687f * LOG2E);
                    const float* gg = isk ? gkn : gqn; const int b = row >> 12, s = row & 4095;
                    bf16_t* dst = (isk ? KD : QD) + ((size_t)(b * 4 + hd) * SEQ + s) * 64 + half * 32;
#pragma unroll
                    for (int c = 0; c < 4; ++c) { u32x4 w = *(u32x4*)&v[c]; const float* gp = gg + 8 * c;
                        w.x = cvt_pk_bf16(bflo(w.x) * rs * gp[0], bfhi(w.x) * rs * gp[1]); w.y = cvt_pk_bf16(bflo(w.y) * rs * gp[2], bfhi(w.y) * rs * gp[3]);
                        w.z = cvt_pk_bf16(bflo(w.z) * rs * gp[4], bfhi(w.z) * rs * gp[5]); w.w = cvt_pk_bf16(bflo(w.w) * rs * gp[6], bfhi(w.w) * rs * gp[7]);
                        *(u32x4*)(dst + 8 * c) = w; }
                }
                for (int i = F.bid * 512 + F.tid; i < MTOK * 32; i += F.G * 512) {
                    const int row = i & (MTOK - 1), j = i >> 14, oc = j & 7, hd = j >> 3, b = row >> 12, s = row & 4095;
                    const bf16x8 v = ldg8(ZS + (size_t)row * ZSW + C_VD + hd * 64 + oc * 8);
                    bf16_t* vd = VDT + ((size_t)(b * 4 + hd) * 64 + oc * 8) * SEQ + s;
#pragma unroll
                    for (int e = 0; e < 8; ++e) vd[(size_t)e * SEQ] = (bf16_t)v[e];
                }
            }
            if (SUB(3)) {
                float* LA = (float*)(ws + WS_LA); float* LI = (float*)(ws + WS_LI); float* LSA = (float*)(ws + WS_LSUM); float* LSH = LSA + NB * 128 * 256;
                const float* cw = INF(26) + l * 4 * 256; const float* cb = INF(27) + l * 256; const float* br = INF(29) + l * 256; const float* bi = INF(31) + l * 256;
                const float* c8 = MISCT + l * 256;
                LAS float* lsa = (LAS float*)(F.lds + F.wave * 16384); LAS float* lsh = lsa + 32 * 64;
                for (int tk = F.gw; tk < NB * 128 * 4; tk += F.ngw) {
                    const int n = tk & 3, tile = (tk >> 2) & 127, b = tk >> 9, s = tile * 32 + r, row = b * SEQ + s, cbase = 64 * n;
                    bf16x8 xcb[4]; float xcf[4][8];
#pragma unroll
                    for (int ks = 0; ks < 4; ++ks) {
                        const int c0 = cbase + 16 * ks + 8 * hi;
#pragma unroll
                        for (int e = 0; e < 8; ++e) xcf[ks][e] = cb[c0 + e];
#pragma unroll
                        for (int k = 0; k < 4; ++k) { const int sr = s - 3 + k;
                            if (sr >= 0) { const bf16x8 xv = ldg8(ZS + (size_t)(b * SEQ + sr) * ZSW + C_XLRU + c0); const u32x4 w = *(const u32x4*)&xv; const float* wk = cw + k * 256 + c0;
                                xcf[ks][0] += wk[0] * bflo(w.x); xcf[ks][1] += wk[1] * bfhi(w.x); xcf[ks][2] += wk[2] * bflo(w.y); xcf[ks][3] += wk[3] * bfhi(w.y);
                                xcf[ks][4] += wk[4] * bflo(w.z); xcf[ks][5] += wk[5] * bfhi(w.z); xcf[ks][6] += wk[6] * bflo(w.w); xcf[ks][7] += wk[7] * bfhi(w.w); } }
                        u32x4 pw; pw.x = cvt_pk_bf16(xcf[ks][0], xcf[ks][1]); pw.y = cvt_pk_bf16(xcf[ks][2], xcf[ks][3]); pw.z = cvt_pk_bf16(xcf[ks][4], xcf[ks][5]); pw.w = cvt_pk_bf16(xcf[ks][6], xcf[ks][7]); xcb[ks] = *(bf16x8*)&pw;
                    }
                    const bf16_t* Wr = (const bf16_t*)(WLP(l) + WL_SM + SM_WR) + n * 4096; const bf16_t* Wi = (const bf16_t*)(WLP(l) + WL_SM + SM_WI) + n * 4096;
                    f32x16 ar_[2] = {f32x16{}, f32x16{}}, ai_[2] = {f32x16{}, f32x16{}};
#pragma unroll
                    for (int ft = 0; ft < 2; ++ft)
#pragma unroll
                        for (int ks = 0; ks < 4; ++ks) { ar_[ft] = MFMA32(ldg8(Wr + (32 * ft + r) * 64 + 16 * ks + 8 * hi), xcb[ks], ar_[ft]); ai_[ft] = MFMA32(ldg8(Wi + (32 * ft + r) * 64 + 16 * ks + 8 * hi), xcb[ks], ai_[ft]); }
                    float xloc[4][4], xrcv[4][4];
#pragma unroll
                    for (int ks = 0; ks < 4; ++ks)
#pragma unroll
                        for (int j = 0; j < 4; ++j) { xloc[ks][j] = hi ? xcf[ks][4 + j] : xcf[ks][j]; const float snd = hi ? xcf[ks][j] : xcf[ks][4 + j]; xrcv[ks][j] = __shfl_xor(snd, 32); }
#pragma unroll
                    for (int ft = 0; ft < 2; ++ft)
#pragma unroll
                        for (int rg = 0; rg < 4; ++rg) {
                            const int c0 = cbase + 32 * ft + 8 * rg + 4 * hi, ks = 2 * ft + (rg >> 1);
                            f32x4 av, iv;
#pragma unroll
                            for (int e = 0; e < 4; ++e) { const float xce = ((rg & 1) == hi) ? xloc[ks][e] : xrcv[ks][e];
                                const float rr = fsigmoid(ar_[ft][4 * rg + e] + br[c0 + e]), ii = fsigmoid(ai_[ft][4 * rg + e] + bi[c0 + e]);
                                const float la = -rr * c8[c0 + e]; const float a = fexp2(la * LOG2E); av[e] = a; iv[e] = sqrtf(fmaxf(1.f - a * a, 0.f)) * ii * xce; }
                            *(f32x4*)(LA + (size_t)row * 256 + c0) = av; *(f32x4*)(LI + (size_t)row * 256 + c0) = iv;
                            { const int sc_ = (32 * ft + 8 * rg + 4 * hi) ^ ((r & 7) << 2); *(LAS f32x4*)(lsa + r * 64 + sc_) = av; *(LAS f32x4*)(lsh + r * 64 + sc_) = iv; }
                        }
                    asm volatile("s_waitcnt lgkmcnt(0)" ::: "memory");
                    {
                        float ta = 1.f, th = 0.f;
#pragma unroll
                        for (int t = 0; t < 32; ++t) { const float a_ = lsa[t * 64 + (lane ^ ((t & 7) << 2))], h_ = lsh[t * 64 + (lane ^ ((t & 7) << 2))]; th = a_ * th + h_; ta = ta * a_; }
                        LSA[(size_t)(b * 128 + tile) * 256 + cbase + lane] = ta; LSH[(size_t)(b * 128 + tile) * 256 + cbase + lane] = th;
                    }
                    asm volatile("s_waitcnt lgkmcnt(0)" ::: "memory");
                }
            }
            if (SUB(4)) {
                float* S5S = (float*)(ws + WS_S5S);
                const int t5cnt = F.wave < 4 ? 1 : (F.wave == 4 ? 0 : 4), t5off = F.wave < 4 ? F.wave : 4 + 4 * (F.wave - 5);
                for (int tbk = F.bid; tbk < NB * 64; tbk += F.G) for (int tj = 0; tj < t5cnt; ++tj) { const int tk = tbk * 16 + t5off + tj;
                    const int g = tk & 15, ch = (tk >> 4) & 63, b = tk >> 10;
                    const float* tb = S5T + (size_t)(l * 16 + g) * 36 * 64 + lane;
                    const float ar = tb[32 * 64], ai = tb[33 * 64];
                    LAS unsigned char* tile = F.lds + F.wave * 16384;
                    float hr = 0.f, hi2 = 0.f;
#pragma unroll 1
                    for (int hf = 0; hf < 2; ++hf) {
                        s5_bu_tile(tile, BBF + (size_t)(l * 16 + g) * 128 * 16, ZS + (size_t)(b * SEQ + ch * 64 + hf * 32) * ZSW + C_S5 + 16 * g, lane);
#pragma unroll 8
                        for (int t2 = 0; t2 < 32; ++t2) { const float bur = bf2f(*(const LAS bf16_t*)(tile + t2 * 272 + lane * 2)), bui = bf2f(*(const LAS bf16_t*)(tile + t2 * 272 + 128 + lane * 2));
                            const float nr = ar * hr - ai * hi2 + bur, ni = ar * hi2 + ai * hr + bui; hr = nr; hi2 = ni; }
                        asm volatile("s_waitcnt lgkmcnt(0)" ::: "memory");
                    }
                    float* dst = S5S + ((size_t)((b * 64 + ch) * 16 + g) * 2) * 64 + lane; dst[0] = hr; dst[64] = hi2;
                }
            }
            if (SUB(5) && l == 0) {
                bf16_t* KX = (bf16_t*)(ws + WS_KX); bf16_t* VXT = (bf16_t*)(ws + WS_VXT);
                if (F.wave == 4) for (int tk = F.bid; tk < 2 * 32 * 4; tk += F.G) {
                    const int hd = tk & 3, mt = (tk >> 2) & 31, ly = tk >> 7, row = mt * 32 + r, b = row >> 8, jm = row & 255;
                    const bf16_t* W = (const bf16_t*)(ws + WS_WL + ly * WL_STRIDE + WL_WXKV);
                    f32x16 acc[4] = {f32x16{}, f32x16{}, f32x16{}, f32x16{}}; float ss = 0.f;
                    const float* mp = INF(1) + (size_t)row * DM + 8 * hi;
#pragma unroll 2
                    for (int ks = 0; ks < 64; ++ks) {
                        const f32x4 m0 = *(const f32x4*)(mp + 16 * ks), m1 = *(const f32x4*)(mp + 16 * ks + 4);
                        ss += (m0.x * m0.x + m0.y * m0.y) + (m0.z * m0.z + m0.w * m0.w) + (m1.x * m1.x + m1.y * m1.y) + (m1.z * m1.z + m1.w * m1.w);
                        const u32x4 pw = pg8::pack8(m0, m1); const bf16x8 xb = *(const bf16x8*)&pw;
#pragma unroll
                        for (int f = 0; f < 4; ++f) { const int wrow = (f < 2 ? 64 * hd + 32 * f : 256 + 64 * hd + 32 * (f - 2)) + r; acc[f] = MFMA32(ldg8(W + (size_t)wrow * DM + 16 * ks + 8 * hi), xb, acc[f]); }
                    }
                    ss += __shfl_xor(ss, 32); const float rm = frsq(ss * (1.f / DM) + EPS);
                    float s2 = 0.f;
#pragma unroll
                    for (int f = 0; f < 2; ++f)
#pragma unroll
                        for (int q = 0; q < 16; ++q) { acc[f][q] *= rm; s2 += acc[f][q] * acc[f][q]; }
                    s2 += __shfl_xor(s2, 32); const float rk = frsq(s2 * (1.f / 64.f) + EPS);
                    const float* gk = INF(47) + ly * 64;
                    bf16_t* kd = KX + ((size_t)(ly * 16 + b * 4 + hd) * 256 + jm) * 64;
#pragma unroll
                    for (int f = 0; f < 2; ++f)
#pragma unroll
                        for (int rg = 0; rg < 4; ++rg) { const float* gp = gk + 32 * f + 8 * rg + 4 * hi; u32x2 w;
                            w.x = cvt_pk_bf16(acc[f][4 * rg] * rk * gp[0], acc[f][4 * rg + 1] * rk * gp[1]); w.y = cvt_pk_bf16(acc[f][4 * rg + 2] * rk * gp[2], acc[f][4 * rg + 3] * rk * gp[3]);
                            *(u32x2*)(kd + 32 * f + 8 * rg + 4 * hi) = w; }
                    bf16_t* vd = VXT + (size_t)(ly * 16 + b * 4 + hd) * 64 * 256 + jm;
#pragma unroll
                    for (int f = 2; f < 4; ++f)
#pragma unroll
                        for (int q = 0; q < 16; ++q) vd[(size_t)(32 * (f - 2) + crow(q, hi)) * 256] = f2bf(acc[f][q] * rm);
                }
            }
        }
        SEAM(pb + 1);
        if (IN(pb + 2)) {
            if (SUB(6)) { PHASE_BEGIN();
            const int lane = F.lane, r32 = lane & 31, hi = lane >> 5, wid = F.wave;
            volatile LAS unsigned* qslot = (volatile LAS unsigned*)(F.lds + MISC_OFF + 64);
            for (int it = queue_pull(F.ctl + CW_Q + 64 * (4 * l + 0), qslot, F.tid); it < 256; it = queue_pull(F.ctl + CW_Q + 64 * (4 * l + 0), qslot, F.tid)) {
                {
                    const int bh = it & 15, qt = 15 - (it >> 4), b = bh >> 2, hd = bh & 3;
                    const bf16_t* QM = (const bf16_t*)(ws + WS_QM) + (size_t)bh * SEQ * 96; const bf16_t* KM = (const bf16_t*)(ws + WS_KM) + (size_t)bh * SEQ * 96;
                    const bf16_t* VMT = (const bf16_t*)(ws + WS_VMT) + (size_t)bh * 64 * SEQ;
                    f32x16 o[1][2]; float lsum[1];
                    attn_unit<96, 1, true, false, false>(F.lds, QM + (size_t)qt * 256 * 96, 96, KM, VMT, SEQ, 4 * (qt + 1), 256 * qt, nullptr, nullptr, 1.f, MISCT[516 + l * 4 + 0], o, lsum);
                    const int row = b * SEQ + qt * 256 + wid * 32 + r32;
                    attn_store(YB + (size_t)1 * MTOK * 256 + (size_t)row * 256 + hd * 64, o[0], frcp(lsum[0]), hi);
                }
            } }
            if (SUB(7)) { PHASE_BEGIN();
            const int lane = F.lane, r32 = lane & 31, hi = lane >> 5, wid = F.wave;
            LAS float* lut = (LAS float*)(F.lds + 106496);
            for (int i = F.tid; i < 4 * 384; i += 512) lut[i] = MISCT[1024 + i];
            __syncthreads();
            volatile LAS unsigned* qslot = (volatile LAS unsigned*)(F.lds + MISC_OFF + 64);
            for (int it = queue_pull(F.ctl + CW_Q + 64 * (4 * l + 1), qslot, F.tid); it < 256; it = queue_pull(F.ctl + CW_Q + 64 * (4 * l + 1), qslot, F.tid)) {
                {
                    const int bh = it & 15, qt = 15 - (it >> 4), b = bh >> 2, hd = bh & 3;
                    const bf16_t* QD = (const bf16_t*)(ws + WS_QD) + (size_t)bh * SEQ * 64; const bf16_t* KD = (const bf16_t*)(ws + WS_KD) + (size_t)bh * SEQ * 64;
                    const bf16_t* VDT = (const bf16_t*)(ws + WS_VDT) + (size_t)bh * 64 * SEQ;
                    f32x16 o[2][2]; float lsum[2];
                    attn_unit<64, 2, true, true, false>(F.lds, QD + (size_t)qt * 256 * 64, 64, KD, VDT, SEQ, 4 * (qt + 1), 256 * qt, lut + hd * 384, nullptr, 1.f, MISCT[516 + l * 4 + 1], o, lsum);
                    const float lam = MISCT[512 + l], lam_init = MISCT[514 + l];
                    const float i1 = frcp(lsum[0]), i2 = lam * frcp(lsum[1]); float ss = 0.f;
#pragma unroll
                    for (int dt = 0; dt < 2; ++dt)
#pragma unroll
                        for (int q = 0; q < 16; ++q) { const float v = o[0][dt][q] * i1 - o[1][dt][q] * i2; o[0][dt][q] = v; ss += v * v; }
                    ss += __shfl_xor(ss, 32); const float rs = frsq(ss * (1.f / 64.f) + EPS) * (1.f - lam_init);
                    const float* gs = INF(39) + l * 64;
#pragma unroll
                    for (int dt = 0; dt < 2; ++dt)
#pragma unroll
                        for (int q = 0; q < 16; ++q) o[0][dt][q] *= gs[32 * dt + crow(q, hi)];
                    const int row = b * SEQ + qt * 256 + wid * 32 + r32;
                    attn_store(YB + (size_t)3 * MTOK * 256 + (size_t)row * 256 + hd * 64, o[0], rs, hi);
                }
            } }
            if (SUB(8)) { PHASE_BEGIN();
            const int lane = F.lane, r32 = lane & 31, hi = lane >> 5, wid = F.wave;
            volatile LAS unsigned* qslot = (volatile LAS unsigned*)(F.lds + MISC_OFF + 64);
            for (int it = queue_pull(F.ctl + CW_Q + 64 * (4 * l + 2), qslot, F.tid); it < 256; it = queue_pull(F.ctl + CW_Q + 64 * (4 * l + 2), qslot, F.tid)) {
                {
                    const int b = it >> 6, ch = it & 63, row0 = b * SEQ + ch * 64;
                    LAS unsigned char* hbuf = F.lds + wid * 8704;
                    LAS unsigned char* ypre = F.lds + 69632;
                    const float* S5S = (const float*)(ws + WS_S5S);
#pragma unroll 1
                    for (int gg = 0; gg < 2; ++gg) {
                        const int g = 2 * wid + gg;
                        const float* tb = S5T + (size_t)(l * 16 + g) * 36 * 64 + lane;
                        const float ar = tb[32 * 64], ai = tb[33 * 64], a64r = tb[34 * 64], a64i = tb[35 * 64];
                        float hr = 0.f, hi2 = 0.f;
                        for (int c0 = 0; c0 < ch; c0 += 8) {
                            float sr[8], si[8];
#pragma unroll
                            for (int u = 0; u < 8; ++u) { const int c = c0 + u; const bool ok = c < ch; const float* sp = S5S + ((size_t)((b * 64 + (ok ? c : 0)) * 16 + g) * 2) * 64 + lane; sr[u] = ok ? sp[0] : 0.f; si[u] = ok ? sp[64] : 0.f; }
#pragma unroll
                            for (int u = 0; u < 8; ++u) { if (c0 + u < ch) { const float nr = a64r * hr - a64i * hi2 + sr[u], ni = a64r * hi2 + a64i * hr + si[u]; hr = nr; hi2 = ni; } }
                        }
                        bf16x8 cf[4];
#pragma unroll
                        for (int ks = 0; ks < 4; ++ks) cf[ks] = ldg8(CMAT + (size_t)(l * 16 + g) * 16 * 128 + (lane & 15) * 128 + 32 * ks + 8 * (lane >> 4));
                        const float* dsk = INF(17) + l * 256 + 16 * g + 4 * (lane >> 4);
#pragma unroll 1
                        for (int hf = 0; hf < 2; ++hf) {
                            s5_bu_tile(hbuf, BBF + (size_t)(l * 16 + g) * 128 * 16, ZS + (size_t)(row0 + hf * 32) * ZSW + C_S5 + 16 * g, lane);
#pragma unroll 8
                            for (int t2 = 0; t2 < 32; ++t2) { const float bur = bf2f(*(const LAS bf16_t*)(hbuf + t2 * 272 + lane * 2)), bui = bf2f(*(const LAS bf16_t*)(hbuf + t2 * 272 + 128 + lane * 2));
                                const float nr = ar * hr - ai * hi2 + bur, ni = ar * hi2 + ai * hr + bui; hr = nr; hi2 = ni;
                                *(LAS bf16_t*)(hbuf + t2 * 272 + lane * 2) = f2bf(hr); *(LAS bf16_t*)(hbuf + t2 * 272 + 128 + lane * 2) = f2bf(hi2);
                            }
                            asm volatile("s_waitcnt lgkmcnt(0)" ::: "memory");
#pragma unroll
                            for (int tq = 0; tq < 2; ++tq) {
                                f32x4 yv = (f32x4){0.f, 0.f, 0.f, 0.f};
#pragma unroll
                                for (int ks = 0; ks < 4; ++ks) { const bf16x8 hb = *(const LAS bf16x8*)(hbuf + (16 * tq + (lane & 15)) * 272 + (32 * ks + 8 * (lane >> 4)) * 2); yv = MFMA16(cf[ks], hb, yv); }
                                const int tl = hf * 32 + 16 * tq + (lane & 15);
                                const u32x2 uw = *(const u32x2*)(ZS + (size_t)(row0 + tl) * ZSW + C_S5 + 16 * g + 4 * (lane >> 4));
                                yv[0] = fgelu(yv[0] + dsk[0] * bflo(uw.x)); yv[1] = fgelu(yv[1] + dsk[1] * bfhi(uw.x)); yv[2] = fgelu(yv[2] + dsk[2] * bflo(uw.y)); yv[3] = fgelu(yv[3] + dsk[3] * bfhi(uw.y));
                                u32x2 pw; pw.x = cvt_pk_bf16(yv[0], yv[1]); pw.y = cvt_pk_bf16(yv[2], yv[3]);
                                *(LAS u32x2*)(ypre + tl * 528 + (16 * g + 4 * (lane >> 4)) * 2) = pw;
                            }
                            asm volatile("s_waitcnt lgkmcnt(0)" ::: "memory");
                        }
                    }
                    __syncthreads();
                    {
                        const bf16_t* WG = (const bf16_t*)(WLP(l) + WL_SM + SM_WGLU);
                        f32x16 acc[2] = {f32x16{}, f32x16{}};
#pragma unroll 4
                        for (int ks = 0; ks < 16; ++ks) { const bf16x8 a = ldg8(WG + (size_t)(32 * wid + r32) * 256 + 16 * ks + 8 * hi);
#pragma unroll
                            for (int tt = 0; tt < 2; ++tt) acc[tt] = MFMA32(a, *(const LAS bf16x8*)(ypre + (32 * tt + r32) * 528 + (16 * ks + 8 * hi) * 2), acc[tt]); }
                        const float* bg = INF(19) + l * 256;
#pragma unroll
                        for (int tt = 0; tt < 2; ++tt)
#pragma unroll
                            for (int rg = 0; rg < 4; ++rg) { const int n0 = 32 * wid + 8 * rg + 4 * hi, t = 32 * tt + r32;
                                const u32x2 yw = *(const LAS u32x2*)(ypre + t * 528 + n0 * 2); u32x2 ow;
                                ow.x = cvt_pk_bf16(bflo(yw.x) * fsigmoid(acc[tt][4 * rg] + bg[n0]), bfhi(yw.x) * fsigmoid(acc[tt][4 * rg + 1] + bg[n0 + 1]));
                                ow.y = cvt_pk_bf16(bflo(yw.y) * fsigmoid(acc[tt][4 * rg + 2] + bg[n0 + 2]), bfhi(yw.y) * fsigmoid(acc[tt][4 * rg + 3] + bg[n0 + 3]));
                                *(u32x2*)(YB + (size_t)(row0 + t) * 256 + n0) = ow; }
                    }
                    __syncthreads();
                }
            }
            }
            if (SUB(9)) { PHASE_BEGIN(); const int lane = F.lane;
                const float* LA = (const float*)(ws + WS_LA); const float* LI = (const float*)(ws + WS_LI); const float* LSA = (const float*)(ws + WS_LSUM); const float* LSH = LSA + NB * 128 * 256;
                volatile LAS unsigned* qslot = (volatile LAS unsigned*)(F.lds + MISC_OFF + 64);
                for (int it = queue_pull(F.ctl + CW_Q + 64 * (4 * l + 3), qslot, F.tid); it < NB * 64 * 4 / 8; it = queue_pull(F.ctl + CW_Q + 64 * (4 * l + 3), qslot, F.tid)) {
                    const int tk = (NB * 64 * 4 / 8 - 1 - it) * 8 + F.wave;
                    const int n = tk & 3, ch = (tk >> 2) & 63, b = tk >> 8, c = 64 * n + lane;
                    float h = 0.f;
                    for (int tp0 = 0; tp0 < 2 * ch; tp0 += 16) {
                        float ca[16], chh[16];
#pragma unroll
                        for (int u = 0; u < 16; ++u) { const int tp = tp0 + u; const bool ok = tp < 2 * ch; const size_t o = (size_t)(b * 128 + (ok ? tp : 0)) * 256 + c; ca[u] = ok ? LSA[o] : 1.f; chh[u] = ok ? LSH[o] : 0.f; }
#pragma unroll
                        for (int u = 0; u < 16; ++u) h = ca[u] * h + chh[u];
                    }
                    const int row0 = b * SEQ + ch * 64;
#pragma unroll 1
                    for (int t0 = 0; t0 < 64; t0 += 16) {
                        float la[16], li[16], gt[16];
#pragma unroll
                        for (int u = 0; u < 16; ++u) { const size_t o = (size_t)(row0 + t0 + u) * 256 + c; la[u] = LA[o]; li[u] = LI[o]; gt[u] = bf2f(ZS[(size_t)(row0 + t0 + u) * ZSW + C_GLRU + c]); }
#pragma unroll
                        for (int u = 0; u < 16; ++u) { h = la[u] * h + li[u]; gt[u] = h * fgelu(gt[u]); }
#pragma unroll
                        for (int u = 0; u < 16; ++u) YB[(size_t)2 * MTOK * 256 + (size_t)(row0 + t0 + u) * 256 + c] = f2bf(gt[u]);
                    }
                }
            }
        }
        SEAM(pb + 2);
        if (IN(pb + 3)) { PHASE_BEGIN();
            pg8::Gemm g{YB, (const bf16_t*)(WLP(l) + WL_PT), 256, nullptr}; pg8::MergeOrder S{F.G, F.bid};
            pg8::EpiMerge E{MG, ZG};
            pg8::gemm_phase<pg8::EpiMerge, pg8::MergeOrder, true, false>(F.lds, g, S, E);
        }
        SEAM(pb + 3);
        if (IN(pb + 4)) { PHASE_BEGIN();
            pg8::Gemm g{MG, (const bf16_t*)(WLP(l) + WL_WO), DM, nullptr}; pg8::StaticOrder S; S.init(MTOK / 256, DM / 256, F.G, F.bid);
            pg8::EpiRes<false> E{nullptr, XB, RS + (size_t)(l == 0 ? 1 : 4) * MTOK * 16, nullptr};
            pg8::gemm_phase<pg8::EpiRes<false>, pg8::StaticOrder, false, false>(F.lds, g, S, E);
        }
        SEAM(pb + 4);
        if (IN(pb + 5)) { PHASE_BEGIN();
            pg8::Gemm g{XB, (const bf16_t*)(WLP(l) + WL_WXQ), DM, nullptr}; pg8::StaticOrder S; S.init(MTOK / 256, 1, F.G, F.bid);
            pg8::EpiRowScale E{(bf16_t*)(ws + WS_QX), 256, RS + (size_t)(l == 0 ? 1 : 4) * MTOK * 16};
            pg8::gemm_phase<pg8::EpiRowScale, pg8::StaticOrder, false, false>(F.lds, g, S, E);
        }
        SEAM(pb + 5);
        if (IN(pb + 6)) { PHASE_BEGIN();
            const int lane = F.lane, r32 = lane & 31, hi = lane >> 5, wid = F.wave;
            for (int it = F.bid; it < 256; it += F.G) {
                const int hd = it & 3, rt = it >> 2, b = rt >> 4;
                const bf16_t* QX = (const bf16_t*)(ws + WS_QX) + (size_t)rt * 256 * 256 + hd * 64;
                const bf16_t* KX = (const bf16_t*)(ws + WS_KX) + (size_t)(l * 16 + b * 4 + hd) * 256 * 64;
                const bf16_t* VXT = (const bf16_t*)(ws + WS_VXT) + (size_t)(l * 16 + b * 4 + hd) * 64 * 256;
                f32x16 o[1][2]; float lsum[1];
                attn_unit<64, 1, false, false, true>(F.lds, QX, 256, KX, VXT, 256, 4, 0, nullptr, INF(46) + l * 64, 0.125f * LOG2E, MISCT[516 + l * 4 + 2], o, lsum);
                const int row = rt * 256 + wid * 32 + r32;
                attn_store((bf16_t*)(ws + WS_OX) + (size_t)row * 256 + hd * 64, o[0], frcp(lsum[0]), hi);
            }
        }
        SEAM(pb + 6);
        if (IN(pb + 7)) { PHASE_BEGIN();
            pg8::Gemm g{(const bf16_t*)(ws + WS_OX), (const bf16_t*)(WLP(l) + WL_WXO), 256, nullptr}; pg8::StaticOrder S; S.init(MTOK / 256, DM / 256, F.G, F.bid);
            if (l == 0) { pg8::EpiRes<false> E{nullptr, XB, RS + (size_t)2 * MTOK * 16, nullptr}; pg8::gemm_phase<pg8::EpiRes<false>, pg8::StaticOrder, false, false>(F.lds, g, S, E); }
            else { pg8::EpiRes<false> E{nullptr, XB, RS + (size_t)5 * MTOK * 16, nullptr}; pg8::gemm_phase<pg8::EpiRes<false>, pg8::StaticOrder, false, false>(F.lds, g, S, E); }
        }
        SEAM(pb + 7);
        if (l == 0) {
            if (IN(9)) { PHASE_BEGIN();
                pg8::Gemm g{XB, (const bf16_t*)(ws + WS_WGU), DM, nullptr}; pg8::StaticOrder S; S.init(MTOK / 256, 2 * FF / 256, F.G, F.bid);
#if G2_FP8
                pg8::EpiSwiGLU8<true, false> E{ws + WS_HFF, FF, RS + (size_t)2 * MTOK * 16};
                pg8::gemm_phase<pg8::EpiSwiGLU8<true, false>, pg8::StaticOrder, true, false>(F.lds, g, S, E);
#else
                pg8::EpiSwiGLU<false> E{(bf16_t*)(ws + WS_HFF), FF, RS + (size_t)2 * MTOK * 16, nullptr};
                pg8::gemm_phase<pg8::EpiSwiGLU<false>, pg8::StaticOrder, true, false>(F.lds, g, S, E);
#endif
            }
            SEAM(9);
            if (IN(10)) { PHASE_BEGIN();
#if G2_FP8
                pg8::Gemm g{(const bf16_t*)(ws + WS_HFF), (const bf16_t*)(ws + WS_WD), FF / 2, nullptr}; pg8::StaticOrder S; S.init(MTOK / 256, DM / 256, F.G, F.bid);
                pg8::EpiRes<false, false, true> E{nullptr, XB, RS + (size_t)3 * MTOK * 16, nullptr};
                pg8::gemm_phase<pg8::EpiRes<false, false, true>, pg8::StaticOrder, false, false, true>(F.lds, g, S, E);
#else
                pg8::Gemm g{(const bf16_t*)(ws + WS_HFF), (const bf16_t*)(ws + WS_WD), FF, nullptr}; pg8::StaticOrder S; S.init(MTOK / 256, DM / 256, F.G, F.bid);
                pg8::EpiRes<false> E{nullptr, XB, RS + (size_t)3 * MTOK * 16, nullptr};
                pg8::gemm_phase<pg8::EpiRes<false>, pg8::StaticOrder, false, false>(F.lds, g, S, E);
#endif
            }
            SEAM(10);
        } else {
#define ROWTOK ((int*)(ws + WS_MOESM + MS_ROWTOK))
#define TOKW ((float*)(ws + WS_MOESM + MS_TOKW))
#define ASSIGN ((int*)(ws + WS_MOESM + MS_ASSIGN))
#define RSTD2 ((float*)(ws + WS_MOESM + MS_RSTD))
#define MCNT (F.ctl + CW_MOECNT)
            if (IN(19)) { PHASE_BEGIN();
                LAS float* wrs = (LAS float*)(F.lds);
                for (int i = F.tid; i < 8192; i += 512) wrs[i] = INF(51)[i] * INF(7)[DM + (i >> 3)];
                __syncthreads();
                if (SUB(10) && F.wave < 4) {
                    const int lane = F.lane;
                    for (int blk = F.bid; blk < 256; blk += F.G) {
                        unsigned cntv = 0u, mypack = 0u;
#pragma unroll 1
                        for (int j = 0; j < 16; ++j) {
                            const int tok = blk * 64 + F.wave * 16 + j;
                            const u32x2* xr = (const u32x2*)(XB + (size_t)tok * DM) + lane;
                            float lg[8] = {0.f, 0.f, 0.f, 0.f, 0.f, 0.f, 0.f, 0.f}; float ss = 0.f; f32x4 xv4[4];
#pragma unroll
                            for (int q = 0; q < 4; ++q) { const u32x2 xw = xr[64 * q]; const f32x4 v = {bflo(xw.x), bfhi(xw.x), bflo(xw.y), bfhi(xw.y)}; const int k0 = 256 * q + 4 * lane; xv4[q] = v;
                                ss += (v.x * v.x + v.y * v.y) + (v.z * v.z + v.w * v.w);
#pragma unroll
                                for (int e4 = 0; e4 < 4; ++e4) { const float xv = v[e4]; const LAS f32x4* wp = (const LAS f32x4*)(wrs + (k0 + e4) * 8); const f32x4 wa = wp[0], wb = wp[1];
                                    lg[0] += xv * wa.x; lg[1] += xv * wa.y; lg[2] += xv * wa.z; lg[3] += xv * wa.w; lg[4] += xv * wb.x; lg[5] += xv * wb.y; lg[6] += xv * wb.z; lg[7] += xv * wb.w; } }
                            ss = wave_sum(ss);
#pragma unroll
                            for (int e = 0; e < 8; ++e) lg[e] = wave_sum(lg[e]);
                            const float rstd = frsq(ss * (1.f / DM) + EPS);
                            { unsigned* xq = (unsigned*)(ws + WS_XQ + (size_t)tok * DM) + lane;
#pragma unroll
                              for (int q = 0; q < 4; ++q) xq[64 * q] = cvt_pk4_fp8(xv4[q].x * rstd, xv4[q].y * rstd, xv4[q].z * rstd, xv4[q].w * rstd); }
                            int e1 = 0; float v1 = lg[0];
#pragma unroll
                            for (int e = 1; e < 8; ++e) if (lg[e] > v1) { v1 = lg[e]; e1 = e; }
                            int e2 = -1; float v2 = -3.4e38f;
#pragma unroll
                            for (int e = 0; e < 8; ++e) if (e != e1 && lg[e] > v2) { v2 = lg[e]; e2 = e; }
                            if (e2 < 0) e2 = (e1 + 1) & 7;
                            const int se1 = __builtin_amdgcn_readfirstlane(e1), se2 = __builtin_amdgcn_readfirstlane(e2);
                            const unsigned r1 = __builtin_amdgcn_readlane(cntv, se1), r2 = __builtin_amdgcn_readlane(cntv, se2);
                            cntv += (lane == se1 ? 1u : 0u) + (lane == se2 ? 1u : 0u);
                            if (lane == j) mypack = (unsigned)se1 | (r1 << 4) | ((unsigned)se2 << 12) | (r2 << 16);
                            if (lane == 0) { const float w1 = frcp(1.f + __expf((v2 - v1) * rstd)); RSTD2[tok] = rstd; TOKW[tok * 2] = w1; TOKW[tok * 2 + 1] = 1.f - w1; }
                        }
                        unsigned basev = 0u;
                        if (lane < 8) basev = __hip_atomic_fetch_add(MCNT + 64 * lane, cntv, __ATOMIC_RELAXED, __HIP_MEMORY_SCOPE_AGENT);
                        const int pe1 = mypack & 15, pr1 = (mypack >> 4) & 255, pe2 = (mypack >> 12) & 15, pr2 = (mypack >> 16) & 255;
                        const unsigned b1 = __shfl(basev, pe1), b2 = __shfl(basev, pe2);
                        if (lane < 16) { const int tok = blk * 64 + F.wave * 16 + lane; ASSIGN[tok * 2] = pe1 | (int)((b1 + (unsigned)pr1) << 8); ASSIGN[tok * 2 + 1] = pe2 | (int)((b2 + (unsigned)pr2) << 8);
                            ROWTOK[pe1 * 16384 + (int)(b1 + (unsigned)pr1)] = tok; ROWTOK[pe2 * 16384 + (int)(b2 + (unsigned)pr2)] = tok; }
                    }
                }
                if (SUB(11)) {
                    LAS float* scr = (LAS float*)(F.lds + 40960 + F.wave * 8448);
                    const TJob j0{INF(52), (bf16_t*)(ws + WS_WMGU), INF(7) + DM, DM, EFF, EFF, DM, 8, 2, (size_t)DM * EFF, (size_t)2 * EFF * DM, 1};
                    const TJob j1{INF(53), (bf16_t*)(ws + WS_WMGU), INF(7) + DM, DM, EFF, EFF, DM, 8, 3, (size_t)DM * EFF, (size_t)2 * EFF * DM, 1};
                    const TJob j2{INF(54), (bf16_t*)(ws + WS_WMD), nullptr, EFF, DM, DM, EFF, 8, 0, (size_t)EFF * DM, (size_t)DM * EFF, 1};
                    constexpr int NI = 8 * (DM / 64) * (EFF / 32);
                    LAS unsigned* qc = (LAS unsigned*)(F.lds + MISC_OFF + 128);
                    const int wg_items = (3 * NI - F.bid + F.G - 1) / F.G;
#define H0_PULL() h0_pull(qc, F.lane, wg_items, F.bid, F.G, 3 * NI)
#define H0_JOB(idx) const int jn_ = (idx) / NI; TJob js_ = j0; if (jn_ == 1) { js_.W = j1.W; js_.map = 3; } if (jn_ == 2) js_ = j2;
#define H0_LOAD(idx, v) do { H0_JOB(idx) tjob_load(js_, (idx) - jn_ * NI, v, F.lane); } while (0)
#define H0_STORE(idx, v) do { H0_JOB(idx) tjob_store(js_, (idx) - jn_ * NI, v, scr, F.lane); } while (0)
                    float va[32] = {}, vb[32] = {}; int it = H0_PULL();
                    if (it < 3 * NI) { H0_LOAD(it, va);
                        for (;;) {
                            const int n1 = H0_PULL(); if (n1 < 3 * NI) H0_LOAD(n1, vb);
                            H0_STORE(it, va); if (n1 >= 3 * NI) break;
                            const int n2 = H0_PULL(); if (n2 < 3 * NI) H0_LOAD(n2, va);
                            H0_STORE(n1, vb); if (n2 >= 3 * NI) break;
                            it = n2;
                        } }
#undef H0_PULL
#undef H0_JOB
#undef H0_LOAD
#undef H0_STORE
                }
            }
            SEAM(19);
            if (IN(21)) { PHASE_BEGIN();
                pg8::Gemm g{(const bf16_t*)(ws + WS_XQ), (const bf16_t*)(ws + WS_WMGU), DM / 2, ROWTOK}; pg8::MoeOrder S; S.init(MCNT, 2 * EFF / 256, F.G, F.bid);
                pg8::EpiSwiGLU8<false> E{ws + WS_HMOE, EFF, nullptr};
                pg8::gemm_phase<pg8::EpiSwiGLU8<false>, pg8::MoeOrder, true, true, true>(F.lds, g, S, E);
            }
            SEAM(21);
            if (IN(22)) { PHASE_BEGIN();
                pg8::Gemm g{(const bf16_t*)(ws + WS_HMOE), (const bf16_t*)(ws + WS_WMD), EFF / 2, nullptr}; pg8::MoeOrder S; S.init(MCNT, DM / 256, F.G, F.bid);
                pg8::EpiPlain E{(bf16_t*)(ws + WS_YS), DM, 0.03125f};
                pg8::gemm_phase<pg8::EpiPlain, pg8::MoeOrder, true, false, true>(F.lds, g, S, E);
            }
            SEAM(22);
            if (IN(23)) { PHASE_BEGIN();
                const bf16_t* YS = (const bf16_t*)(ws + WS_YS);
                int pst[8]; { int acc = 0;
#pragma unroll
                    for (int e = 0; e < 8; ++e) { pst[e] = acc; acc += ((int)MCNT[64 * e] + 255) & ~255; } }
                for (int m = F.gw; m < MTOK; m += F.ngw) {
                    const int a1 = ASSIGN[2 * m], a2 = ASSIGN[2 * m + 1]; int p1 = 0, p2 = 0;
#pragma unroll
                    for (int q = 0; q < 8; ++q) { p1 = (q == (a1 & 255)) ? pst[q] : p1; p2 = (q == (a2 & 255)) ? pst[q] : p2; }
                    const int d1 = p1 + (a1 >> 8), d2 = p2 + (a2 >> 8); const float w1 = TOKW[2 * m], w2 = TOKW[2 * m + 1];
                    f32x4* xr = (f32x4*)(F.out + (size_t)m * DM) + F.lane; const u32x2* xbr = (const u32x2*)(XB + (size_t)m * DM) + F.lane;
                    const u32x2* y1 = (const u32x2*)(YS + (size_t)d1 * DM) + F.lane; const u32x2* y2 = (const u32x2*)(YS + (size_t)d2 * DM) + F.lane;
#pragma unroll
                    for (int j = 0; j < 4; ++j) { const u32x2 xw = xbr[64 * j]; f32x4 v = {bflo(xw.x), bfhi(xw.x), bflo(xw.y), bfhi(xw.y)}; const u32x2 a = y1[64 * j], c = y2[64 * j];
                        v.x += w1 * bflo(a.x) + w2 * bflo(c.x); v.y += w1 * bfhi(a.x) + w2 * bfhi(c.x); v.z += w1 * bflo(a.y) + w2 * bflo(c.y); v.w += w1 * bfhi(a.y) + w2 * bfhi(c.y);
                        xr[64 * j] = v; }
                }
            }
        }
    }
#undef IN
#undef SEAM
}

#ifdef DBG_DUMP_OFF
__global__ void dbg_copy_bf16(const bf16_t* src, float* out, int n, int nv) { for (int i = blockIdx.x * 256 + threadIdx.x; i < n; i += gridDim.x * 256) out[i] = i < nv ? bf2f(src[i]) : 0.f; }
#endif

#ifdef DBG_CHECK
struct DbgArgs { const void* in[55]; unsigned char* ws; float* out; float* acc; };
#ifndef DBG_LAYER
#define DBG_LAYER 0
#endif
__device__ __forceinline__ size_t dstride(int i) {
    switch (i) { case 4: case 5: case 6: case 7: case 10: case 11: case 26: return 1024; case 8: return (size_t)DM * DIN; case 9: return 4096; case 12: return 16;
      case 13: case 14: case 15: case 16: case 28: case 30: return 16384; case 17: case 19: case 27: case 29: case 31: case 32: return 256; case 18: case 23: return 65536; case 20: return 192; case 21: return 128;
      case 22: return 73728; case 24: case 25: return 96; case 33: case 34: case 35: case 36: case 37: case 38: return 32; case 39: case 46: case 47: return 64; case 40: return (size_t)4 * 256 * DM; case 41: return (size_t)DM * DM;
      case 42: case 43: case 44: case 45: return (size_t)DM * 256; default: return 0; } }
#define DIN_(i) ((const float*)a.in[i] + (size_t)DBG_LAYER * dstride(i))
#define DXIN_ (DBG_LAYER == 0 ? (const float*)a.in[0] : (const float*)(a.ws + WS_DBG))
constexpr size_t WS_DBG = 440 * MiB;
__device__ float blk_sum(float v, float* sh) { sh[threadIdx.x] = v; __syncthreads(); for (int o = 128; o > 0; o >>= 1) { if ((int)threadIdx.x < o) sh[threadIdx.x] += sh[threadIdx.x + o]; __syncthreads(); } const float r = sh[0]; __syncthreads(); return r; }
__device__ float blk_max(float v, float* sh) { sh[threadIdx.x] = v; __syncthreads(); for (int o = 128; o > 0; o >>= 1) { if ((int)threadIdx.x < o) sh[threadIdx.x] = fmaxf(sh[threadIdx.x], sh[threadIdx.x + o]); __syncthreads(); } const float r = sh[0]; __syncthreads(); return r; }
__device__ void dbg_acc(float* acc, int k, float fast, float ref) { atomicMax((unsigned*)&acc[2 * k], __float_as_uint(fabsf(fast - ref))); atomicAdd(&acc[2 * k + 1], ref * ref); atomicAdd(&acc[64 + k], 1.f); }
__device__ float dsig(float x) { return 1.f / (1.f + expf(-x)); }
__device__ float dgelu(float x) { return 0.5f * x * (1.f + tanhf(0.7978845608028654f * (x + 0.044715f * x * x * x))); }
__device__ int dbucket(int d) { if (d < 16) return d < 0 ? 0 : d; int bk = 16 + (int)(logf((float)d / 16.f) / logf(8.f) * 16.f); return bk > 31 ? 31 : bk; }

__global__ void chk_z(DbgArgs a) {
    __shared__ float sh[256]; const int s = blockIdx.x, tid = threadIdx.x; const int row = (s * 7919 + 13) % MTOK; int col = (s * 104729 + 7 + (s >> 1)) % DIN; if (s & 1) col = col % C_END;
    const float* x = (DBG_LAYER == 0 ? (const float*)a.in[0] : (const float*)a.out) + (size_t)row * DM; const float* g = DIN_(4); const float* W = DIN_(8);
    float ss = 0.f, dot = 0.f; for (int k = tid; k < DM; k += 256) { const float xv = x[k]; ss += xv * xv; dot += xv * g[k] * W[(size_t)k * DIN + col]; }
    ss = blk_sum(ss, sh); dot = blk_sum(dot, sh);
    if (tid == 0) { const float z = dot * rsqrtf(ss / DM + EPS);
        if (col < C_END) dbg_acc(a.acc, 1, bf2f(((const bf16_t*)(a.ws + WS_ZS))[(size_t)row * ZSW + col]), z);
        else { const int gc = col - C_END; dbg_acc(a.acc, 2, bf2f(((const bf16_t*)(a.ws + WS_ZG))[(size_t)row * ZGW + gc]), dsig(z + DIN_(9)[gc])); } }
}
__global__ void chk_mla_prep(DbgArgs a) {
    __shared__ float sh[256]; __shared__ float vn[192]; __shared__ float qs[128];
    const int s = blockIdx.x, tid = threadIdx.x, row = (s * 7919 + 13) % MTOK, hd = s & 3, b = row >> 12, sq = row & 4095;
    const bf16_t* ZSp = (const bf16_t*)(a.ws + WS_ZS) + (size_t)row * ZSW; const float pos = (float)((const int*)a.in[2])[row];
    { const float v = tid < 192 ? bf2f(ZSp[C_CQ + tid]) : 0.f; const float ss = blk_sum(v * v, sh); if (tid < 192) vn[tid] = v * rsqrtf(ss / 192.f + EPS) * DIN_(20)[tid]; __syncthreads(); }
    float qf = 0.f; if (tid < 96) for (int k = 0; k < 192; ++k) qf += vn[k] * DIN_(22)[k * 384 + hd * 96 + tid];
    { const float ss = blk_sum(tid < 96 ? qf * qf : 0.f, sh); if (tid < 96) qs[tid] = qf * rsqrtf(ss / 96.f + EPS) * DIN_(24)[tid]; __syncthreads(); }
    if (tid < 96) { float val = qs[tid]; if (tid >= 64) { const int i = (tid - 64) & 15; float sn, cs; sincos_red(pos * exp2f(-(float)i * (13.287712379549449f / 16.f)), sn, cs); const float x1 = qs[64 + i], x2 = qs[80 + i]; val = tid < 80 ? x1 * cs - x2 * sn : x1 * sn + x2 * cs; }
        val *= 0.10206207261596577f * LOG2E; dbg_acc(a.acc, 3, bf2f(((const bf16_t*)(a.ws + WS_QM))[((size_t)(b * 4 + hd) * SEQ + sq) * 96 + tid]), val); }
    __syncthreads();
    { const float v = tid < 128 ? bf2f(ZSp[C_CKV + tid]) : 0.f; const float ss = blk_sum(v * v, sh); if (tid < 128) vn[tid] = v * rsqrtf(ss / 128.f + EPS) * DIN_(21)[tid]; __syncthreads(); }
    float kv = 0.f; if (tid < 128) for (int k = 0; k < 128; ++k) kv += vn[k] * DIN_(23)[k * 512 + hd * 128 + tid];
    float kfull = 0.f; if (tid < 64) kfull = kv; else if (tid < 96) kfull = bf2f(ZSp[C_KPE + tid - 64]);
    { const float ss = blk_sum(tid < 96 ? kfull * kfull : 0.f, sh); if (tid < 96) qs[tid] = kfull * rsqrtf(ss / 96.f + EPS) * DIN_(25)[tid]; __syncthreads(); }
    if (tid < 96) { float val = qs[tid]; if (tid >= 64) { const int i = (tid - 64) & 15; float sn, cs; sincos_red(pos * exp2f(-(float)i * (13.287712379549449f / 16.f)), sn, cs); const float x1 = qs[64 + i], x2 = qs[80 + i]; val = tid < 80 ? x1 * cs - x2 * sn : x1 * sn + x2 * cs; }
        dbg_acc(a.acc, 4, bf2f(((const bf16_t*)(a.ws + WS_KM))[((size_t)(b * 4 + hd) * SEQ + sq) * 96 + tid]), val); }
    if (tid >= 64 && tid < 128) dbg_acc(a.acc, 5, bf2f(((const bf16_t*)(a.ws + WS_VMT))[((size_t)(b * 4 + hd) * 64 + tid - 64) * SEQ + sq]), kv);
}
__global__ void chk_diff_prep(DbgArgs a) {
    const int i = blockIdx.x * 256 + threadIdx.x; const int row = (i * 37 + 5) % MTOK, hd = i & 3, half = (i >> 2) & 1, isk = (i >> 3) & 1, b = row >> 12, sq = row & 4095;
    const bf16_t* src = (const bf16_t*)(a.ws + WS_ZS) + (size_t)row * ZSW + (isk ? C_KD : C_QD) + hd * 64 + half * 32;
    float ss = 0.f; for (int d = 0; d < 32; ++d) { const float v = bf2f(src[d]); ss += v * v; }
    const float rs = rsqrtf(ss / 32.f + EPS) * (isk ? 1.f : 0.17677669529663687f * LOG2E); const float* gg = DIN_(isk ? 34 : 33);
    const bf16_t* dst = (const bf16_t*)(a.ws + (isk ? WS_KD : WS_QD)) + ((size_t)(b * 4 + hd) * SEQ + sq) * 64 + half * 32;
    for (int d = 0; d < 32; ++d) dbg_acc(a.acc, 6, bf2f(dst[d]), bf2f(src[d]) * rs * gg[d]);
    const bf16_t* vs = (const bf16_t*)(a.ws + WS_ZS) + (size_t)row * ZSW + C_VD + hd * 64;
    for (int d = half * 32; d < half * 32 + 32; ++d) dbg_acc(a.acc, 7, bf2f(((const bf16_t*)(a.ws + WS_VDT))[((size_t)(b * 4 + hd) * 64 + d) * SEQ + sq]), bf2f(vs[d]));
}
__global__ void __launch_bounds__(256) chk_lru_prep(DbgArgs a) {
    __shared__ float xcs[64]; const int s = blockIdx.x, tid = threadIdx.x, row = (s * 7919 + 13) % MTOK, n = s & 3, b = row >> 12, sq = row & 4095;
    if (s == 0 || s == 1) { }
    float xc = 0.f;
    if (tid < 64) { const int c = 64 * n + tid; xc = DIN_(27)[c]; for (int k = 0; k < 4; ++k) { const int sr = sq - 3 + k; if (sr >= 0) xc += DIN_(26)[k * 256 + c] * bf2f(((const bf16_t*)(a.ws + WS_ZS))[(size_t)(b * SEQ + sr) * ZSW + C_XLRU + c]); } xcs[tid] = xc; }
    __syncthreads();
    if (tid < 64) { const int c = 64 * n + tid; float ar = DIN_(29)[c], ai = DIN_(31)[c];
        const float* wr_ = DIN_(28); const float* wi_ = DIN_(30);
#pragma unroll 2
        for (int cc = 0; cc < 64; ++cc) { ar += xcs[cc] * wr_[(n * 64 + cc) * 64 + tid]; ai += xcs[cc] * wi_[(n * 64 + cc) * 64 + tid]; }
        const float r = 1.f / (1.f + __expf(-ar)), ii = 1.f / (1.f + __expf(-ai)), la = -8.f * r * __logf(1.f + __expf(-DIN_(32)[c])), av = __expf(la), iv = sqrtf(fmaxf(1.f - av * av, 0.f)) * ii * xc;
        dbg_acc(a.acc, 8, ((const float*)(a.ws + WS_LA))[(size_t)row * 256 + c], av); dbg_acc(a.acc, 9, ((const float*)(a.ws + WS_LI))[(size_t)row * 256 + c], iv); }
}
__global__ void chk_mla_attn(DbgArgs a) {
    __shared__ float sh[256]; __shared__ float q[96]; __shared__ float p[4096];
    const int s = blockIdx.x, tid = threadIdx.x, bh = s & 15, sq = (s * 523 + 77) % SEQ, b = bh >> 2, hd = bh & 3;
    const bf16_t* QM = (const bf16_t*)(a.ws + WS_QM) + (size_t)bh * SEQ * 96; const bf16_t* KM = (const bf16_t*)(a.ws + WS_KM) + (size_t)bh * SEQ * 96; const bf16_t* VMT = (const bf16_t*)(a.ws + WS_VMT) + (size_t)bh * 64 * SEQ;
    if (tid < 96) q[tid] = bf2f(QM[(size_t)sq * 96 + tid]); __syncthreads();
    float mx = -1e30f; for (int j = tid; j <= sq; j += 256) { float sc = 0.f; for (int d = 0; d < 96; ++d) sc += q[d] * bf2f(KM[(size_t)j * 96 + d]); p[j] = sc; mx = fmaxf(mx, sc); }
    mx = blk_max(mx, sh); float sm = 0.f; for (int j = tid; j <= sq; j += 256) { p[j] = exp2f(p[j] - mx); sm += p[j]; } sm = blk_sum(sm, sh);
    if (tid < 64) { float o = 0.f; for (int j = 0; j <= sq; ++j) o += p[j] * bf2f(VMT[(size_t)tid * SEQ + j]); dbg_acc(a.acc, 10, bf2f(((const bf16_t*)(a.ws + WS_Y))[(size_t)1 * MTOK * 256 + (size_t)(b * SEQ + sq) * 256 + hd * 64 + tid]), o / sm); }
}
__global__ void chk_diff_attn(DbgArgs a) {
    __shared__ float sh[256]; __shared__ float q[64]; __shared__ float p1[4096]; __shared__ float p2[4096];
    const int s = blockIdx.x, tid = threadIdx.x, bh = s & 15, sq = (s * 523 + 77) % SEQ, b = bh >> 2, hd = bh & 3;
    const bf16_t* QD = (const bf16_t*)(a.ws + WS_QD) + (size_t)bh * SEQ * 64; const bf16_t* KD = (const bf16_t*)(a.ws + WS_KD) + (size_t)bh * SEQ * 64; const bf16_t* VDT = (const bf16_t*)(a.ws + WS_VDT) + (size_t)bh * 64 * SEQ;
    if (tid < 64) q[tid] = bf2f(QD[(size_t)sq * 64 + tid]); __syncthreads();
    float m1 = -1e30f, m2 = -1e30f; for (int j = tid; j <= sq; j += 256) { float s1 = 0.f, s2 = 0.f; for (int d = 0; d < 32; ++d) { s1 += q[d] * bf2f(KD[(size_t)j * 64 + d]); s2 += q[32 + d] * bf2f(KD[(size_t)j * 64 + 32 + d]); }
        const float bias = DIN_(3)[dbucket(sq - j) * 4 + hd] * LOG2E; s1 += bias; s2 += bias; p1[j] = s1; p2[j] = s2; m1 = fmaxf(m1, s1); m2 = fmaxf(m2, s2); }
    m1 = blk_max(m1, sh); m2 = blk_max(m2, sh); float l1 = 0.f, l2 = 0.f; for (int j = tid; j <= sq; j += 256) { p1[j] = exp2f(p1[j] - m1); p2[j] = exp2f(p2[j] - m2); l1 += p1[j]; l2 += p2[j]; } l1 = blk_sum(l1, sh); l2 = blk_sum(l2, sh);
    float s1 = 0.f, s2 = 0.f; for (int d = 0; d < 32; ++d) { s1 += DIN_(35)[d] * DIN_(36)[d]; s2 += DIN_(37)[d] * DIN_(38)[d]; } const float lam_init = DBG_LAYER == 0 ? 0.2f : 0.8f - 0.6f * 0.7408182206817179f, lam = expf(s1) - expf(s2) + lam_init;
    float o = 0.f; if (tid < 64) { float o1 = 0.f, o2 = 0.f; for (int j = 0; j <= sq; ++j) { const float v = bf2f(VDT[(size_t)tid * SEQ + j]); o1 += p1[j] * v; o2 += p2[j] * v; } o = o1 / l1 - lam * o2 / l2; }
    const float ss = blk_sum(tid < 64 ? o * o : 0.f, sh);
    if (tid < 64) dbg_acc(a.acc, 11, bf2f(((const bf16_t*)(a.ws + WS_Y))[(size_t)3 * MTOK * 256 + (size_t)(b * SEQ + sq) * 256 + hd * 64 + tid]), o * rsqrtf(ss / 64.f + EPS) * DIN_(39)[tid] * (1.f - lam_init));
}
__global__ void chk_lru_scan(DbgArgs a) {
    const int i = blockIdx.x * 256 + threadIdx.x, b = i >> 8, c = i & 255; if (b >= NB) return;
    const float* LA = (const float*)(a.ws + WS_LA); const float* LI = (const float*)(a.ws + WS_LI); float h = 0.f;
    for (int t = 0; t < SEQ; ++t) { const size_t o = (size_t)(b * SEQ + t) * 256 + c; h = LA[o] * h + LI[o];
        if (t % 97 == 0 || t == SEQ - 1) dbg_acc(a.acc, 12, bf2f(((const bf16_t*)(a.ws + WS_Y))[(size_t)2 * MTOK * 256 + o]), h * dgelu(bf2f(((const bf16_t*)(a.ws + WS_ZS))[(size_t)(b * SEQ + t) * ZSW + C_GLRU + c]))); }
}
__global__ void chk_s5_scan(DbgArgs a) {
    __shared__ float part[16][65]; const int g = blockIdx.x, p = threadIdx.x; float* ypre = (float*)(a.ws + WS_DBG);
    const float dt = expf(DIN_(12)[g]), lr = DIN_(10)[g * 64 + p], li = DIN_(11)[g * 64 + p], mag = expf(lr * dt); float sn, cs; sincos_red(li * dt, sn, cs);
    const float ar = mag * cs, ai = mag * sn, den = lr * lr + li * li, zr = ((ar - 1.f) * lr + ai * li) / den, zi = (ai * lr - (ar - 1.f) * li) / den;
    float hr = 0.f, hi = 0.f;
    for (int t = 0; t < SEQ; ++t) { const bf16_t* up = (const bf16_t*)(a.ws + WS_ZS) + (size_t)(SEQ + t) * ZSW + 16 * g; float bur = 0.f, bui = 0.f;
        for (int c = 0; c < 16; ++c) { const float u = bf2f(up[c]), br = DIN_(13)[(g * 64 + p) * 16 + c], bi = DIN_(14)[(g * 64 + p) * 16 + c]; bur += (zr * br - zi * bi) * u; bui += (zr * bi + zi * br) * u; }
        const float nr = ar * hr - ai * hi + bur, ni = ar * hi + ai * hr + bui; hr = nr; hi = ni;
        for (int c = 0; c < 16; ++c) part[c][p] = DIN_(15)[(g * 16 + c) * 64 + p] * hr - DIN_(16)[(g * 16 + c) * 64 + p] * hi;
        __syncthreads();
        if (p < 16) { float y = 0.f; for (int pp = 0; pp < 64; ++pp) y += part[p][pp]; y += DIN_(17)[16 * g + p] * bf2f(up[p]); ypre[(size_t)t * 256 + 16 * g + p] = dgelu(y); }
        __syncthreads(); }
}
__global__ void chk_s5_glu(DbgArgs a) {
    const int s = blockIdx.x, n = threadIdx.x, t = (s * 61 + 5) % SEQ; const float* ypre = (const float*)(a.ws + WS_DBG) + (size_t)t * 256;
    float z = DIN_(19)[n]; for (int k = 0; k < 256; ++k) z += ypre[k] * DIN_(18)[k * 256 + n];
    dbg_acc(a.acc, 13, bf2f(((const bf16_t*)(a.ws + WS_Y))[(size_t)(SEQ + t) * 256 + n]), ypre[n] * dsig(z));
}

__global__ void chk_merge(DbgArgs a) {
    __shared__ float sh[256]; const int s = blockIdx.x, tid = threadIdx.x, row = (s * 7919 + 13) % MTOK, col = (s * 104729 + 7) % DM;
    const bf16_t* Y = (const bf16_t*)(a.ws + WS_Y); const bf16_t* ZGp = (const bf16_t*)(a.ws + WS_ZG) + (size_t)row * ZGW; const bf16_t* MGp = (const bf16_t*)(a.ws + WS_MERGED) + (size_t)row * DM;
    float m = 0.f;
    for (int n = 0; n < 4; ++n) { float d = 0.f; { const int k = tid; d = bf2f(Y[(size_t)n * MTOK * 256 + (size_t)row * 256 + k]) * DIN_(40)[((size_t)n * 256 + k) * DM + col]; } d = blk_sum(d, sh); m += bf2f(ZGp[n * DM + col]) * d; }
    if (tid == 0) dbg_acc(a.acc, 14, bf2f(MGp[col]), m);
    float o = 0.f; for (int c = tid; c < DM; c += 256) o += bf2f(MGp[c]) * DIN_(41)[(size_t)c * DM + col]; o = blk_sum(o, sh);
    if (tid == 0) dbg_acc(a.acc, 15, a.out[(size_t)row * DM + col], DXIN_[(size_t)row * DM + col] + o);
}
__global__ void chk_cross(DbgArgs a) {
    __shared__ float sh[256]; __shared__ float hn[DM]; __shared__ float q[64]; __shared__ float p[256]; __shared__ float mn[DM];
    const int s = blockIdx.x, tid = threadIdx.x, row = (s * 7919 + 13) % MTOK, hd = s & 3, b = row >> 12;
    const float* x1 = a.out + (size_t)row * DM; float ss = 0.f; for (int k = tid; k < DM; k += 256) ss += x1[k] * x1[k]; ss = blk_sum(ss, sh); const float rs = rsqrtf(ss / DM + EPS);
    for (int k = tid; k < DM; k += 256) hn[k] = x1[k] * rs * DIN_(5)[k]; __syncthreads();
    float qf = 0.f; if (tid < 64) { for (int k = 0; k < DM; ++k) qf += hn[k] * DIN_(42)[(size_t)k * 256 + hd * 64 + tid]; dbg_acc(a.acc, 16, bf2f(((const bf16_t*)(a.ws + WS_QX))[(size_t)row * 256 + hd * 64 + tid]), qf); }
    { const float s2 = blk_sum(tid < 64 ? qf * qf : 0.f, sh); if (tid < 64) q[tid] = qf * rsqrtf(s2 / 64.f + EPS) * DIN_(46)[tid] * 0.125f; __syncthreads(); }
    float sc = 0.f; float vj[1]; (void)vj;
    { const float* mr = DIN_(1) + (size_t)(b * 256 + tid) * DM; float ms = 0.f; for (int k = 0; k < DM; ++k) ms += mr[k] * mr[k]; const float mrs = rsqrtf(ms / DM + EPS);
      float kk[64]; (void)kk; float s2 = 0.f; float dotq = 0.f;
      for (int d = 0; d < 64; ++d) { float kd = 0.f; for (int k = 0; k < DM; ++k) kd += mr[k] * mrs * DIN_(6)[k] * DIN_(43)[(size_t)k * 256 + hd * 64 + d]; s2 += kd * kd; dotq += kd * DIN_(47)[d] * q[d]; }
      sc = dotq * rsqrtf(s2 / 64.f + EPS); }
    const float mx = blk_max(sc, sh); const float e = expf(sc - mx); const float sm = blk_sum(e, sh); p[tid] = e / sm; __syncthreads();
    if (tid < 64) { float o = 0.f; for (int j = 0; j < 256; ++j) { const float* mr = DIN_(1) + (size_t)(b * 256 + j) * DM; float ms = 0.f, vd = 0.f; for (int k = 0; k < DM; ++k) { ms += mr[k] * mr[k]; vd += mr[k] * DIN_(6)[k] * DIN_(44)[(size_t)k * 256 + hd * 64 + tid]; } o += p[j] * vd * rsqrtf(ms / DM + EPS); }
        dbg_acc(a.acc, 17, bf2f(((const bf16_t*)(a.ws + WS_OX))[(size_t)row * 256 + hd * 64 + tid]), o); }
}
__global__ void chk_ffn(DbgArgs a) {
    __shared__ float sh[256]; __shared__ float hn[DM]; const int s = blockIdx.x, tid = threadIdx.x, row = (s * 7919 + 13) % MTOK;
    const float* x2 = a.out + (size_t)row * DM; float ss = 0.f; for (int k = tid; k < DM; k += 256) ss += x2[k] * x2[k]; ss = blk_sum(ss, sh); const float rs = rsqrtf(ss / DM + EPS);
    for (int k = tid; k < DM; k += 256) hn[k] = x2[k] * rs * DIN_(7)[k]; __syncthreads();
    for (int j = tid; j < FF; j += 256 * 8) { float g = 0.f, u = 0.f; for (int k = 0; k < DM; ++k) { g += hn[k] * DIN_(48)[(size_t)k * FF + j]; u += hn[k] * DIN_(49)[(size_t)k * FF + j]; }
        dbg_acc(a.acc, 18, bf2f(((const bf16_t*)(a.ws + WS_HFF))[(size_t)row * FF + j]), g / (1.f + expf(-g)) * u); }
}

__global__ void chk_moe(DbgArgs a) {
    __shared__ float sh[256]; __shared__ float hn[DM]; __shared__ float hid[EFF]; __shared__ float lgs[8];
    const int s = blockIdx.x, tid = threadIdx.x, tok = (s * 7919 + 13) % MTOK, slot = s & 1, col = (s * 104729 + 7) % DM;
    const float* x2 = a.out + (size_t)tok * DM; float ss = 0.f; for (int k = tid; k < DM; k += 256) ss += x2[k] * x2[k]; ss = blk_sum(ss, sh); const float rs = rsqrtf(ss / DM + EPS);
    for (int k = tid; k < DM; k += 256) hn[k] = x2[k] * rs * ((const float*)a.in[7])[DM + k]; __syncthreads();
    for (int e = 0; e < 8; ++e) { float d = 0.f; for (int k = tid; k < DM; k += 256) d += hn[k] * DIN_(51)[k * 8 + e]; d = blk_sum(d, sh); if (tid == 0) lgs[e] = d; } __syncthreads();
    int e1 = 0; for (int e = 1; e < 8; ++e) if (lgs[e] > lgs[e1]) e1 = e; int e2 = -1; for (int e = 0; e < 8; ++e) if (e != e1 && (e2 < 0 || lgs[e] > lgs[e2])) e2 = e;
    const float w1 = 1.f / (1.f + expf(lgs[e2] - lgs[e1])), w2 = 1.f - w1;
    const int* ASG = (const int*)(a.ws + WS_MOESM + MS_ASSIGN); const int* TD = (const int*)(a.ws + WS_MOESM + MS_TOKDEST); const float* TW = (const float*)(a.ws + WS_MOESM + MS_TOKW); const int* RT = (const int*)(a.ws + WS_MOESM + MS_ROWTOK);
    const int ef = ASG[2 * tok + slot] & 255, dest = TD[2 * tok + slot];
    if (tid == 0) { dbg_acc(a.acc, 19, (float)(ASG[2 * tok] & 255), (float)e1 + 1e-3f); dbg_acc(a.acc, 19, (float)(ASG[2 * tok + 1] & 255), (float)e2 + 1e-3f); dbg_acc(a.acc, 19, TW[2 * tok], w1); dbg_acc(a.acc, 19, TW[2 * tok + 1], w2); dbg_acc(a.acc, 19, (float)(RT[dest] - tok), 1e-3f); }
    const float* wg = DIN_(52) + (size_t)ef * DM * EFF; const float* wu = DIN_(53) + (size_t)ef * DM * EFF; const float* wd = DIN_(54) + (size_t)ef * EFF * DM;
    for (int f = tid; f < EFF; f += 256) { float g = 0.f, u = 0.f; for (int k = 0; k < DM; ++k) { g += hn[k] * wg[(size_t)k * EFF + f]; u += hn[k] * wu[(size_t)k * EFF + f]; } hid[f] = g / (1.f + expf(-g)) * u; }
    __syncthreads();
    float y = 0.f; for (int f = tid; f < EFF; f += 256) y += hid[f] * wd[(size_t)f * DM + col]; y = blk_sum(y, sh);
    if (tid == 0) dbg_acc(a.acc, 20, bf2f(((const bf16_t*)(a.ws + WS_YS))[(size_t)dest * DM + col]), y);
}

__global__ void chk_res(DbgArgs a, int kind) {
    __shared__ float sh[256]; const int s = blockIdx.x, tid = threadIdx.x, row = (s * 7919 + 13) % MTOK, col = (s * 104729 + 7) % DM; const float* xprev = (const float*)(a.ws + WS_DBG);
    float o = 0.f;
    if (kind == 0) { const bf16_t* A = (const bf16_t*)(a.ws + WS_OX) + (size_t)row * 256; o = bf2f(A[tid]) * DIN_(45)[(size_t)tid * DM + col]; }
    else { const bf16_t* A = (const bf16_t*)(a.ws + WS_HFF) + (size_t)row * FF; for (int k = tid; k < FF; k += 256) o += bf2f(A[k]) * DIN_(50)[(size_t)k * DM + col]; }
    o = blk_sum(o, sh);
    if (tid == 0) { dbg_acc(a.acc, 21, a.out[(size_t)row * DM + col], xprev[(size_t)row * DM + col] + o);
        const bf16_t xbv = ((const bf16_t*)(a.ws + WS_XB))[(size_t)row * DM + col]; dbg_acc(a.acc, 22, bf2f(xbv), a.out[(size_t)row * DM + col]); }
}

__global__ void chk_final(DbgArgs a) {
    const int i = blockIdx.x * 256 + threadIdx.x; const int tok = (i * 37 + 5) % MTOK, col = (i * 101 + 3) % DM; const float* xprev = (const float*)(a.ws + WS_DBG);
    const int* TD = (const int*)(a.ws + WS_MOESM + MS_TOKDEST); const float* TW = (const float*)(a.ws + WS_MOESM + MS_TOKW); const bf16_t* YS = (const bf16_t*)(a.ws + WS_YS);
    const float ref = xprev[(size_t)tok * DM + col] + TW[2 * tok] * bf2f(YS[(size_t)TD[2 * tok] * DM + col]) + TW[2 * tok + 1] * bf2f(YS[(size_t)TD[2 * tok + 1] * DM + col]);
    dbg_acc(a.acc, 23, a.out[(size_t)tok * DM + col], ref);
}
__global__ void chk_emit(DbgArgs a, int nchk) {
    for (int i = blockIdx.x * 256 + threadIdx.x; i < MTOK * DM; i += gridDim.x * 256) a.out[i] = 0.f;
    if (blockIdx.x == 0 && threadIdx.x == 0) { float V = 99000.f; float worst = 0.f;
        for (int k = 1; k <= nchk; ++k) { const float cnt = a.acc[64 + k]; const float rms = sqrtf(a.acc[2 * k + 1] / fmaxf(cnt, 1.f)) + 1e-20f; float err = a.acc[2 * k] / rms; if (cnt < 1.f) continue; if (!(err == err)) err = 0.97f; worst = fmaxf(worst, err);
#ifdef DBG_ONLY
            if (k == DBG_ONLY) { V = 1000.f + err * 10000.f; break; }
#else
            if (err > 0.06f) { V = (float)k * 1000.f + fminf(err, 0.99f) * 1000.f; break; }
#endif
        }
        if (V == 99000.f) V = 99000.f + worst * 1000.f;
        a.out[12345] = V; }
}
#endif

#ifdef DBG_STAT
__global__ void stat_scan(const float* out, unsigned* acc) {
    for (int i = blockIdx.x * 256 + threadIdx.x; i < MTOK * DM; i += gridDim.x * 256) { const float v = fabsf(out[i]);
        atomicMax(&acc[1], __float_as_uint(v)); if (v > 10.f || !(v == v)) { atomicAdd(&acc[0], 1u); atomicAdd(&acc[2 + (i >> 18)], 1u); atomicAdd(&acc[70 + ((i & 1023) >> 8)], 1u); atomicAdd(&acc[80 + ((i >> 10) & 255) / 32], 1u); } }
}
__global__ void stat_emit(float* out, const unsigned* acc, int mode) {
    for (int i = blockIdx.x * 256 + threadIdx.x; i < MTOK * DM; i += gridDim.x * 256) out[i] = 0.f;
    if (blockIdx.x == 0 && threadIdx.x == 0) { float V = 0.f;
        if (mode == 0) V = (float)acc[0];
        else if (mode == 1) V = __uint_as_float(acc[1]) * 100.f;
        else if (mode == 2) { unsigned best = 0, bi = 0, nz = 0; for (int k = 0; k < 64; ++k) { if (acc[2 + k] > best) { best = acc[2 + k]; bi = k; } nz += acc[2 + k] > 0; } V = 1000.f * (float)bi + 10.f * (float)nz; }
        else if (mode == 3) V = 1000.f * (float)acc[70] / fmaxf((float)acc[0], 1.f) + 100000.f * (float)acc[71] / fmaxf((float)acc[0], 1.f);
        else if (mode == 4) { unsigned best = 0, bi = 0; for (int k = 0; k < 8; ++k) if (acc[80 + k] > best) { best = acc[80 + k]; bi = k; } V = 1000.f + 1000.f * (float)bi + 900.f * (float)best / fmaxf((float)acc[0], 1.f); }
        out[12345] = V + 100.f; }
}
#endif

#ifdef DBG_VAR
__global__ void var_scan(const float* out, const float* prev, float* acc) {
    float s = 0.f, mx = 0.f; for (int i = blockIdx.x * 256 + threadIdx.x; i < MTOK * DM; i += gridDim.x * 256) { const float d = out[i] - prev[i]; s += d * d; mx = fmaxf(mx, fabsf(d)); }
    atomicAdd(&acc[0], s); atomicMax((unsigned*)&acc[1], __float_as_uint(mx));
}
__global__ void var_emit(float* out, const float* acc, int mode) {
    for (int i = blockIdx.x * 256 + threadIdx.x; i < MTOK * DM; i += gridDim.x * 256) out[i] = 0.f;
    if (blockIdx.x == 0 && threadIdx.x == 0) out[12345] = 100.f + (mode == 0 ? acc[0] / (float)(MTOK * DM) * 1e5f : acc[1] * 100.f);
}
#endif

#ifdef DBG_GSTAT
__global__ void gstat_scan(const bf16_t* zg, float* acc) { float s1 = 0.f, s2 = 0.f; for (size_t i = blockIdx.x * 256 + threadIdx.x; i < (size_t)MTOK * ZGW; i += (size_t)gridDim.x * 256) { const float g = bf2f(zg[i]); const int blk = (int)((i & 4095) >> 10); if (blk == DBG_GSTAT) { s1 += (g < -0.01f || g > 1.01f || !(g == g)) ? 1.f : 0.f; s2 += (g - 0.5f) * (g - 0.5f); } } atomicAdd(&acc[0], s1); atomicAdd(&acc[1], s2); }
__global__ void gstat_emit(float* out, const float* acc, int mode) {
    for (int i = blockIdx.x * 256 + threadIdx.x; i < MTOK * DM; i += gridDim.x * 256) out[i] = 0.f;
    if (blockIdx.x == 0 && threadIdx.x == 0) out[12345] = 100.f + 10000.f * acc[1] / ((float)MTOK * 1024);
}
#endif
extern "C" void kernel_launch(void* const* d_in, const int* in_sizes, int n_in, void* d_out, int out_size, void* d_ws, size_t ws_size, hipStream_t stream) {
    static int grid = 0;
    if (grid == 0) {
        if (n_in != 55 || out_size != MTOK * DM || ws_size < WS_END) { fprintf(stderr, "kernel_launch: unexpected shapes (n_in %d out %d ws %zu)\n", n_in, out_size, ws_size); grid = -1; return; }
        { const int L2 = 2; const int exp_sz[55] = {NB * SEQ * DM, NB * NMEM * DM, NB * SEQ, 32 * 4, L2 * DM, L2 * DM, L2 * DM, L2 * DM, L2 * DM * DIN, L2 * 4 * DM, L2 * 1024, L2 * 1024, L2 * 16, L2 * 16384, L2 * 16384, L2 * 16384, L2 * 16384, L2 * 256, L2 * 65536, L2 * 256,
              L2 * 192, L2 * 128, L2 * 192 * 384, L2 * 128 * 512, L2 * 96, L2 * 96, L2 * 1024, L2 * 256, L2 * 16384, L2 * 256, L2 * 16384, L2 * 256, L2 * 256, L2 * 32, L2 * 32, L2 * 32, L2 * 32, L2 * 32, L2 * 32, L2 * 64,
              L2 * 4 * 256 * DM, L2 * DM * DM, L2 * DM * 256, L2 * DM * 256, L2 * DM * 256, L2 * 256 * DM, L2 * 64, L2 * 64, DM * FF, DM * FF, FF * DM, DM * 8, 8 * DM * EFF, 8 * DM * EFF, 8 * EFF * DM};
          for (int i = 0; i < 55; ++i) if (in_sizes[i] != exp_sz[i]) { fprintf(stderr, "kernel_launch: input %d has %d elements, expected %d\n", i, in_sizes[i], exp_sz[i]); grid = -1; return; } }
        int dev = 0, cus = 0, per_cu = 0;
        if (hipGetDevice(&dev) != hipSuccess || hipDeviceGetAttribute(&cus, hipDeviceAttributeMultiprocessorCount, dev) != hipSuccess) { grid = -1; return; }
        if (hipFuncSetAttribute((const void*)hybrid_fwd, hipFuncAttributeMaxDynamicSharedMemorySize, LDS_BYTES) != hipSuccess) { fprintf(stderr, "kernel_launch: hipFuncSetAttribute failed\n"); grid = -1; return; }
        if (hipOccupancyMaxActiveBlocksPerMultiprocessor(&per_cu, (const void*)hybrid_fwd, 512, LDS_BYTES) != hipSuccess || per_cu < 1) { fprintf(stderr, "kernel_launch: occupancy query says %d\n", per_cu); }
        (void)hipGetLastError();
        grid = cus;
    }
    if (grid < 0) return;
    if (hipMemsetAsync((char*)d_ws + WS_CTL, 0, CTL_ZERO_BYTES, stream) != hipSuccess) return;
    Args a{};
    for (int i = 0; i < 55; ++i) a.in[i] = d_in[i];
    a.out = (float*)d_out; a.ws = (unsigned char*)d_ws; a.submask = 0xFFFF; a.pad = 0;
#if MK_ONE_LAUNCH
    a.ph_lo = 0; a.ph_hi = NPHASE;
    hipLaunchKernelGGL(hybrid_fwd, dim3(grid), dim3(512), LDS_BYTES, stream, a);
#else
    for (int p = 0; p < DBG_NPH; ++p) { a.ph_lo = p; a.ph_hi = p + 1;
#if defined(DBG_CHECK) || defined(DBG_VAR)
        if (p == DBG_NPH - 1) hipMemcpyAsync((char*)d_ws + 440 * MiB, d_out, (size_t)MTOK * DM * 4, hipMemcpyDeviceToDevice, stream);
#endif
        hipLaunchKernelGGL(hybrid_fwd, dim3(grid), dim3(512), LDS_BYTES, stream, a);
#ifdef DBG_REPEAT
        if (p == DBG_REPEAT) {
#ifdef DBG_REPSUB
            a.submask = DBG_REPSUB;
#endif
            hipLaunchKernelGGL(hybrid_fwd, dim3(grid), dim3(512), LDS_BYTES, stream, a); hipLaunchKernelGGL(hybrid_fwd, dim3(grid), dim3(512), LDS_BYTES, stream, a); a.submask = 0xFFFF; }
#endif
    }
#ifdef DBG_CHECK
    { DbgArgs da{}; for (int i = 0; i < 55; ++i) da.in[i] = d_in[i]; da.ws = (unsigned char*)d_ws; da.out = (float*)d_out; da.acc = (float*)((char*)d_ws + 700 * 1024);
#if DBG_NPH == 6 || DBG_NPH == 16
      hipLaunchKernelGGL(chk_merge, dim3(512), dim3(256), 0, stream, da);
#elif DBG_NPH == 8 || DBG_NPH == 18
      hipLaunchKernelGGL(chk_cross, dim3(64), dim3(256), 0, stream, da);
#elif DBG_NPH == 10
      hipLaunchKernelGGL(chk_ffn, dim3(64), dim3(256), 0, stream, da);
#elif DBG_NPH == 24
      hipLaunchKernelGGL(chk_final, dim3(64), dim3(256), 0, stream, da);
#elif DBG_NPH == 23
      hipLaunchKernelGGL(chk_moe, dim3(128), dim3(256), 0, stream, da);
#elif DBG_NPH == 9 || DBG_NPH == 19
      hipLaunchKernelGGL(chk_res, dim3(512), dim3(256), 0, stream, da, 0);
#elif DBG_NPH == 11
      hipLaunchKernelGGL(chk_res, dim3(512), dim3(256), 0, stream, da, 1);
#else
      hipLaunchKernelGGL(chk_z, dim3(1024), dim3(256), 0, stream, da);
      hipLaunchKernelGGL(chk_mla_prep, dim3(512), dim3(256), 0, stream, da);
      hipLaunchKernelGGL(chk_diff_prep, dim3(16), dim3(256), 0, stream, da);
      hipLaunchKernelGGL(chk_lru_prep, dim3(512), dim3(256), 0, stream, da);
      hipLaunchKernelGGL(chk_mla_attn, dim3(64), dim3(256), 0, stream, da);
      hipLaunchKernelGGL(chk_diff_attn, dim3(64), dim3(256), 0, stream, da);
      hipLaunchKernelGGL(chk_lru_scan, dim3(4), dim3(256), 0, stream, da);
      hipLaunchKernelGGL(chk_s5_scan, dim3(16), dim3(64), 0, stream, da);
      hipLaunchKernelGGL(chk_s5_glu, dim3(64), dim3(256), 0, stream, da);
#endif
      hipLaunchKernelGGL(chk_emit, dim3(1024), dim3(256), 0, stream, da, 23); }
#endif
#ifdef DBG_COPYX
    hipMemcpyAsync(d_out, d_in[0], (size_t)MTOK * DM * 4, hipMemcpyDeviceToDevice, stream);
#endif
#ifdef DBG_GSTAT
    { float* acc = (float*)((char*)d_ws + 900 * 1024);
      hipLaunchKernelGGL(gstat_scan, dim3(2048), dim3(256), 0, stream, (const bf16_t*)((const char*)d_ws + WS_ZG), acc);
      hipLaunchKernelGGL(gstat_emit, dim3(1024), dim3(256), 0, stream, (float*)d_out, (const float*)acc, DBG_GSTAT); }
#endif
#ifdef DBG_VAR
    { float* acc = (float*)((char*)d_ws + 900 * 1024);
      hipLaunchKernelGGL(var_scan, dim3(1024), dim3(256), 0, stream, (const float*)d_out, DBG_NPH == 6 ? (const float*)d_in[0] : (const float*)((const char*)d_ws + 440 * MiB), acc);
      hipLaunchKernelGGL(var_emit, dim3(1024), dim3(256), 0, stream, (float*)d_out, (const float*)acc, DBG_VAR); }
#endif
#ifdef DBG_STAT
    { unsigned* acc = (unsigned*)((char*)d_ws + 800 * 1024);
      hipLaunchKernelGGL(stat_scan, dim3(2048), dim3(256), 0, stream, (const float*)d_out, acc);
      hipLaunchKernelGGL(stat_emit, dim3(1024), dim3(256), 0, stream, (float*)d_out, (const unsigned*)acc, DBG_STAT); }
#endif
#ifdef DBG_DUMP_OFF
    hipLaunchKernelGGL(dbg_copy_bf16, dim3(2048), dim3(256), 0, stream, (const bf16_t*)((const char*)d_ws + (size_t)(DBG_DUMP_OFF)), (float*)d_out, MTOK * DM, DBG_DUMP_N);
#endif
#endif
}
```

```cpp
#include <hip/hip_runtime.h>
#include <cstdio>
#include <cstdint>

#define DBG_NPH 24

#ifndef DBG_GPERM
#define DBG_GPERM(n) (n)
#endif
#ifndef DBG_SCALE
#define DBG_SCALE 1.0f
#endif
#ifndef MK_ONE_LAUNCH
#define MK_ONE_LAUNCH 1
#endif
#ifndef G2_FP8
#define G2_FP8 0
#endif

#define LAS __attribute__((address_space(3)))
typedef unsigned short bf16_t;
typedef short bf16x8 __attribute__((ext_vector_type(8)));
typedef float f32x2 __attribute__((ext_vector_type(2)));
typedef float f32x4 __attribute__((ext_vector_type(4)));
typedef float f32x16 __attribute__((ext_vector_type(16)));
typedef unsigned u32x2 __attribute__((ext_vector_type(2)));
typedef unsigned u32x4 __attribute__((ext_vector_type(4)));
typedef int i32x4 __attribute__((ext_vector_type(4)));
typedef int i32x8 __attribute__((ext_vector_type(8)));

constexpr int DM = 1024, NB = 4, SEQ = 4096, MTOK = NB * SEQ, NMEM = 256;
constexpr int DIN = 5984, ZSW = 2048, ZGW = 4096, NIN = ZSW + ZGW;
constexpr int C_S5 = 0, C_CQ = 256, C_CKV = 448, C_KPE = 576, C_XLRU = 608, C_GLRU = 864, C_QD = 1120, C_KD = 1376, C_VD = 1632, C_END = 1888;
constexpr int FF = 2816, EFF = 3584, NEXP = 8, MOE_ROWS = 34816;
constexpr float EPS = 1e-6f, LOG2E = 1.4426950408889634f;

constexpr size_t MiB = 1u << 20;
constexpr size_t WS_CTL = 0, CTL_ZERO_BYTES = 1 * MiB + 512 * 1024;
constexpr size_t WS_MOESM = 1 * MiB;
constexpr size_t WS_XB = 2 * MiB;
constexpr size_t WS_WL = 34 * MiB, WL_STRIDE = 19 * MiB;
constexpr size_t WL_WIN = 0, WL_PT = 12 * MiB, WL_WO = 14 * MiB, WL_WXQ = 16 * MiB, WL_WXKV = 16 * MiB + 512 * 1024, WL_WXO = 17 * MiB + 512 * 1024, WL_SM = 18 * MiB;
constexpr size_t SM_WUQ = 0, SM_WUKV = 256 * 1024, SM_WR = 512 * 1024, SM_WI = 576 * 1024, SM_WGLU = 640 * 1024;
constexpr size_t WS_WGU = 72 * MiB, WS_WD = 83 * MiB, WS_TAB = 89 * MiB, WS_KX = 90 * MiB, WS_VXT = 91 * MiB;
constexpr size_t TAB_S5T = 0, TAB_CMAT = 512 * 1024, TAB_MISC = 768 * 1024;
constexpr size_t WS_ZS = 92 * MiB, WS_MERGED = 92 * MiB, WS_ZG = 156 * MiB, WS_HFF = 156 * MiB, WS_Y = 284 * MiB;
constexpr size_t WS_QM = 316 * MiB, WS_KM = 328 * MiB, WS_VMT = 340 * MiB, WS_QD = 348 * MiB, WS_KD = 356 * MiB, WS_VDT = 364 * MiB;
constexpr size_t WS_QX = 316 * MiB, WS_OX = 324 * MiB;
constexpr size_t WS_LA = 372 * MiB, WS_LI = 388 * MiB, WS_S5S = 404 * MiB, WS_LSUM = 406 * MiB, WS_RSP = 407 * MiB;
constexpr size_t WS_WMGU = 34 * MiB, WS_WMD = 146 * MiB, WS_HMOE = 202 * MiB, WS_XQ = 330 * MiB, WS_YS = 34 * MiB, WS_X8 = 416 * MiB, WS_END = 440 * MiB;
constexpr int CW_TMO = 0, CW_BAR = 4096, CW_MOECNT = 8192, CW_Q = 12288;
constexpr size_t CTL_ROWSS = 256 * 1024;
constexpr size_t MS_ROWTOK = 0, MS_TOKW = 512 * 1024, MS_ASSIGN = 640 * 1024, MS_RSTD = 768 * 1024;
constexpr int RING_BYTES = 131072, MISC_OFF = RING_BYTES + 320, LDS_BYTES = 147456;

typedef __bf16 bf16x2_t __attribute__((ext_vector_type(2)));
__device__ __forceinline__ unsigned cvt_pk_bf16(float lo, float hi) { const f32x2 v = {lo, hi}; const bf16x2_t b = __builtin_convertvector(v, bf16x2_t); return __builtin_bit_cast(unsigned, b); }
__device__ __forceinline__ float clamp8(float x) { return __builtin_fminf(__builtin_fmaxf(x, -448.f), 448.f); }
__device__ __forceinline__ unsigned cvt_pk4_fp8(float a, float b, float c, float d) { int w = __builtin_amdgcn_cvt_pk_fp8_f32(clamp8(a), clamp8(b), 0, false); w = __builtin_amdgcn_cvt_pk_fp8_f32(clamp8(c), clamp8(d), w, true); return (unsigned)w; }
__device__ __forceinline__ float bflo(unsigned w) { return __uint_as_float(w << 16); }
__device__ __forceinline__ float bfhi(unsigned w) { return __uint_as_float(w & 0xffff0000u); }
__device__ __forceinline__ float bf2f(bf16_t b) { return __uint_as_float((unsigned)b << 16); }
__device__ __forceinline__ bf16_t f2bf(float f) { return (bf16_t)(cvt_pk_bf16(f, 0.f) & 0xffffu); }
__device__ __forceinline__ float fexp2(float x) { return __builtin_amdgcn_exp2f(x); }
__device__ __forceinline__ float frcp(float x) { return __builtin_amdgcn_rcpf(x); }
__device__ __forceinline__ float frsq(float x) { return __builtin_amdgcn_rsqf(x); }
__device__ __forceinline__ float fsigmoid(float x) { return frcp(1.f + fexp2(-x * LOG2E)); }
__device__ __forceinline__ float fgelu(float x) {
    const float z = 0.7978845608028654f * (x + 0.044715f * x * x * x);
    const float e = fexp2(2.f * LOG2E * z);
    const float th = 1.f - 2.f * frcp(e + 1.f);
    return 0.5f * x * (1.f + th);
}
__device__ __forceinline__ int crow(int r, int hi) { return (r & 3) + 8 * (r >> 2) + 4 * hi; }
__device__ __forceinline__ bf16x8 ldg8(const bf16_t* p) { return *(const bf16x8*)p; }
__device__ __forceinline__ float sq8(bf16x8 v) {
    const u32x4 w = *(const u32x4*)&v; float s = 0.f;
#pragma unroll
    for (int i = 0; i < 4; ++i) { const float a = bflo(w[i]), b = bfhi(w[i]); s += a * a + b * b; }
    return s;
}
__device__ __forceinline__ float row_rstd(const float* rsp, int row) {
    const f32x4* p = (const f32x4*)(rsp + (size_t)row * 16); const f32x4 a = p[0], b = p[1], c = p[2], d = p[3];
    const float s = (((a.x + a.y) + (a.z + a.w)) + ((b.x + b.y) + (b.z + b.w))) + (((c.x + c.y) + (c.z + c.w)) + ((d.x + d.y) + (d.z + d.w)));
    return frsq(s * (1.f / DM) + EPS);
}
__device__ __forceinline__ float wave_sum(float v) {
#pragma unroll
    for (int o = 1; o < 64; o <<= 1) v += __shfl_xor(v, o);
    return v;
}
#define MFMA32(a, b, c) __builtin_amdgcn_mfma_f32_32x32x16_bf16((a), (b), (c), 0, 0, 0)
#define MFMA16(a, b, c) __builtin_amdgcn_mfma_f32_16x16x32_bf16((a), (b), (c), 0, 0, 0)
__device__ __forceinline__ void sincos_red(float a, float& s, float& c) {
    const float k = rintf(a * 0.15915494309189535f);
    float r = fmaf(-k, 6.28318548202514648f, a);
    r = fmaf(-k, -1.7484555e-7f, r);
    s = __sinf(r); c = __cosf(r);
}

namespace pg8 {
constexpr int BM = 256, BK = 64, HALF = 128, HTB = HALF * BK * 2, STAGE_BYTES = 8 * HTB;
__host__ __device__ __forceinline__ int lds_byte(int r, int c) { const int st = (r >> 4) * 2 + (c >> 5), rr = r & 15, cc = c & 31, ob = rr * 64 + cc * 2; return st * 1024 + (ob ^ (((ob >> 9) & 1) << 5)); }
__host__ __device__ __forceinline__ void stage_rc(int b, int& R, int& C) { const int st = b / 1024, sb = b % 1024, swz = sb ^ (((sb >> 9) & 1) << 5); R = (st >> 1) * 16 + swz / 64; C = (st & 1) * 32 + (swz % 64) / 2; }
__host__ __device__ __forceinline__ int perm32(int rho) { const int n = rho >> 4, i = rho & 15; return 8 * (i >> 2) + 4 * n + (i & 3); }

struct Unit { int pm, pn, om, on, aux, gofs; };
struct Gemm { const bf16_t* A; const bf16_t* Bt; int K; const int* gather; };

template <class Epi, class Sched, bool ALIGN_EPI, bool GATHER, bool FP8 = false>
__device__ __forceinline__ void gemm_phase(LAS unsigned char* lds, Gemm g, const Sched& S, const Epi& E) {
    int tid = threadIdx.x; asm volatile("" : "+v"(tid));
    asm volatile("" : "+s"(g.A), "+s"(g.Bt));
    const int wid = __builtin_amdgcn_readfirstlane(tid >> 6), lane = tid & 63, wr = wid >> 2, wc = wid & 3, fr = lane & 15, fq = lane >> 4;
    const int K = g.K, nt = K / BK;
    unsigned voffB[2];
#pragma unroll
    for (int i = 0; i < 2; ++i) { int Rr_, Cc_; stage_rc(tid * 16 + i * 8192, Rr_, Cc_); const int Rb = (Rr_ & ~31) + perm32(Rr_ & 31); voffB[i] = (unsigned)(Rb * K + Cc_) * 2u; }
    const size_t kstep = (size_t)(BK * 2);
    const size_t hstep = (size_t)HALF * K * 2;
    const size_t tstep = 2 * hstep;
    const unsigned ldsw = (unsigned)wid * 1024u;
    const int aoff = lds_byte(wr * 64 + fr, fq * 8), boff = lds_byte(wc * 32 + fr, fq * 8);
#define PG8_SA(b, h) (((b) * 2 + (h)) * HTB)
#define PG8_SB(b, h) ((4 + (b) * 2 + (h)) * HTB)
#define PG8_STAGE_B(bufoff, gbase) do { _Pragma("unroll") for (int _i = 0; _i < 2; ++_i) \
        __builtin_amdgcn_global_load_lds((const unsigned*)((const char*)(gbase) + voffB[_i]), (LAS unsigned*)(lds + (bufoff) + ldsw + _i * 8192), 16, 0, 0); } while (0)
#define PG8_STAGE_A(bufoff, kt, vo0, vo1) do { const char* _gb = (const char*)g.A + (size_t)(kt) * kstep; \
        __builtin_amdgcn_global_load_lds((const unsigned*)(_gb + (vo0)), (LAS unsigned*)(lds + (bufoff) + ldsw), 16, 0, 0); \
        __builtin_amdgcn_global_load_lds((const unsigned*)(_gb + (vo1)), (LAS unsigned*)(lds + (bufoff) + ldsw + 8192), 16, 0, 0); } while (0)
#define PG8_LDA(dst, b, h) do { _Pragma("unroll") for (int m = 0; m < 4; ++m) _Pragma("unroll") for (int k = 0; k < 2; ++k) dst[m][k] = *(const LAS bf16x8*)(lds + PG8_SA(b, h) + aoff + m * 2048 + k * 1024); } while (0)
#define PG8_LDB(dst, b, h) do { _Pragma("unroll") for (int n = 0; n < 2; ++n) _Pragma("unroll") for (int k = 0; k < 2; ++k) dst[n][k] = *(const LAS bf16x8*)(lds + PG8_SB(b, h) + boff + n * 2048 + k * 1024); } while (0)
#define PG8_MMA(ai, bj, At, Bt) do { __builtin_amdgcn_s_setprio(1); _Pragma("unroll") for (int m = 0; m < 4; ++m) _Pragma("unroll") for (int n = 0; n < 2; ++n) _Pragma("unroll") for (int k = 0; k < 2; ++k) \
        acc[ai][bj][m][n] = __builtin_amdgcn_mfma_f32_16x16x32_bf16(Bt[n][k], At[m][k], acc[ai][bj][m][n], 0, 0, 0); __builtin_amdgcn_s_setprio(0); } while (0)
#define PG8_MMA8(ai, bj, w) do { __builtin_amdgcn_s_setprio(1); _Pragma("unroll") for (int m = 0; m < 4; ++m) _Pragma("unroll") for (int n = 0; n < 2; ++n) \
        asm volatile("v_mfma_f32_16x16x128_f8f6f4 %0, %1, %2, %0" : "+v"(acc[ai][bj][m][n]) : "v"(B##w##8[n]), "v"(A8[m])); __builtin_amdgcn_s_setprio(0); } while (0)
#define PG8_LA(b, h) do { if constexpr (FP8) { _Pragma("unroll") for (int m = 0; m < 4; ++m) { A8[m].lo = *(const LAS i32x4*)(lds + PG8_SA(b, h) + aoff + m * 2048); A8[m].hi = *(const LAS i32x4*)(lds + PG8_SA(b, h) + aoff + m * 2048 + 1024); } } \
        else PG8_LDA(At, b, h); } while (0)
#define PG8_LB(w, b, h) do { if constexpr (FP8) { _Pragma("unroll") for (int n = 0; n < 2; ++n) { B##w##8[n].lo = *(const LAS i32x4*)(lds + PG8_SB(b, h) + boff + n * 2048); B##w##8[n].hi = *(const LAS i32x4*)(lds + PG8_SB(b, h) + boff + n * 2048 + 1024); } } \
        else PG8_LDB(B##w, b, h); } while (0)
#define PG8_MM(ai, bj, w) do { if constexpr (FP8) PG8_MMA8(ai, bj, w); else PG8_MMA(ai, bj, At, B##w); } while (0)
#define PG8_WAIT_V(n) asm volatile("s_waitcnt vmcnt(" #n ")" ::: "memory")
#define PG8_WAIT_L(n) asm volatile("s_waitcnt lgkmcnt(" #n ")" ::: "memory")
#define PG8_BAR __builtin_amdgcn_s_barrier()
#define PG8_SCHED __builtin_amdgcn_sched_barrier(0)
#define PG8_VOFF(dst, u) do { _Pragma("unroll") for (int _h = 0; _h < 2; ++_h) _Pragma("unroll") for (int _i = 0; _i < 2; ++_i) { int Rr_, Cc_; stage_rc(tid * 16 + _i * 8192, Rr_, Cc_); \
        const int _rt = (u).pm * BM + _h * HALF + Rr_; const int _ar = GATHER ? g.gather[_rt + (u).gofs] : _rt; dst[_h][_i] = (unsigned)((size_t)_ar * K + Cc_) * 2u; } } while (0)
    Unit cur, nxt; int ui = 0;
    if (!S.next(0, cur)) return;
    f32x4 acc[2][2][4][2];
#pragma unroll
    for (int a = 0; a < 2; ++a)
#pragma unroll
        for (int b = 0; b < 2; ++b)
#pragma unroll
            for (int m = 0; m < 4; ++m)
#pragma unroll
                for (int n = 0; n < 2; ++n) acc[a][b][m][n] = (f32x4){0.f, 0.f, 0.f, 0.f};
    bf16x8 At[4][2], B0[2][2], B1[2][2];
    i32x8 A8[4], B08[2], B18[2];
    unsigned vC[2][2], vN[2][2];
    PG8_VOFF(vC, cur);
    const char* cB = (const char*)g.Bt + (size_t)cur.pn * tstep;
    PG8_STAGE_B(PG8_SB(0, 0), cB); PG8_STAGE_B(PG8_SB(0, 1), cB + hstep); PG8_STAGE_A(PG8_SA(0, 0), 0, vC[0][0], vC[0][1]); PG8_STAGE_A(PG8_SA(0, 1), 0, vC[1][0], vC[1][1]);
    if (wr == 1) PG8_BAR;
    PG8_WAIT_V(2); PG8_BAR;
    PG8_STAGE_B(PG8_SB(1, 0), cB + kstep); PG8_STAGE_A(PG8_SA(1, 0), 1, vC[0][0], vC[0][1]); PG8_STAGE_B(PG8_SB(1, 1), cB + hstep + kstep);
    PG8_WAIT_V(6); PG8_BAR;
    for (;;) {
        const bool has_next = S.next(ui + 1, nxt);
        unsigned ndelta = 0u;
        if constexpr (GATHER) {
            if (has_next) { PG8_VOFF(vN, nxt); } else {
#pragma unroll
                for (int _h = 0; _h < 2; ++_h)
#pragma unroll
                    for (int _i = 0; _i < 2; ++_i) vN[_h][_i] = vC[_h][_i]; }
        } else { if (has_next) ndelta = (unsigned)((nxt.pm - cur.pm) * (int)tstep); }
        const char* nB = has_next ? (const char*)g.Bt + (size_t)nxt.pn * tstep : cB;
#pragma unroll 1
        for (int t = 0; t < nt; t += 2) {
            const bool last = (t == nt - 2);
            const int k2 = last ? 0 : t + 2, k3 = k2 + 1;
            const char* b2 = last ? nB : cB + (size_t)(t + 2) * kstep; const char* b3 = b2 + kstep;
            unsigned v200, v201, v210, v211;
            if constexpr (GATHER) { v200 = last ? vN[0][0] : vC[0][0]; v201 = last ? vN[0][1] : vC[0][1]; v210 = last ? vN[1][0] : vC[1][0]; v211 = last ? vN[1][1] : vC[1][1]; }
            else { const unsigned dl = last ? ndelta : 0u; v200 = vC[0][0] + dl; v201 = vC[0][1] + dl; v210 = vC[1][0] + dl; v211 = vC[1][1] + dl; }
            PG8_LB(0, 0, 0); PG8_LB(1, 0, 1); PG8_SCHED; PG8_LA(0, 0); PG8_STAGE_A(PG8_SA(1, 1), t + 1, vC[1][0], vC[1][1]);
            PG8_WAIT_V(8); PG8_WAIT_L(0); PG8_BAR; PG8_MM(0, 0, 0); PG8_MM(0, 1, 1); PG8_BAR; PG8_SCHED;
            PG8_LA(0, 1); PG8_STAGE_B(PG8_SB(0, 0), b2); PG8_STAGE_B(PG8_SB(0, 1), b2 + hstep); PG8_STAGE_A(PG8_SA(0, 0), k2, v200, v201);
            PG8_WAIT_V(8); PG8_WAIT_L(0); PG8_BAR; PG8_MM(1, 0, 0); PG8_MM(1, 1, 1); PG8_BAR; PG8_SCHED;
            PG8_LB(0, 1, 0); PG8_LB(1, 1, 1); PG8_SCHED; PG8_LA(1, 0); PG8_STAGE_A(PG8_SA(0, 1), k2, v210, v211);
            PG8_WAIT_V(8); PG8_WAIT_L(0); PG8_BAR; PG8_MM(0, 0, 0); PG8_MM(0, 1, 1); PG8_BAR; PG8_SCHED;
            PG8_LA(1, 1); PG8_STAGE_B(PG8_SB(1, 0), b3); PG8_STAGE_B(PG8_SB(1, 1), b3 + hstep); PG8_STAGE_A(PG8_SA(1, 0), k3, v200, v201);
            PG8_WAIT_V(8); PG8_WAIT_L(0); PG8_BAR; PG8_MM(1, 0, 0); PG8_MM(1, 1, 1); PG8_BAR; PG8_SCHED;
        }
        if constexpr (ALIGN_EPI) { if (wr == 0) PG8_BAR; }
        if constexpr (FP8) asm volatile("s_nop 15\n\ts_nop 15" ::: "memory");
        { int fr_ = fr, fq_ = fq; asm volatile("" : "+v"(fr_), "+v"(fq_)); E(acc, cur, wr, wc, fr_, fq_); }
        if (!has_next) break;
#pragma unroll
        for (int a = 0; a < 2; ++a)
#pragma unroll
            for (int b = 0; b < 2; ++b)
#pragma unroll
                for (int m = 0; m < 4; ++m)
#pragma unroll
                    for (int n = 0; n < 2; ++n) acc[a][b][m][n] = (f32x4){0.f, 0.f, 0.f, 0.f};
        cur = nxt; cB = nB; ++ui;
#pragma unroll
        for (int _h = 0; _h < 2; ++_h)
#pragma unroll
            for (int _i = 0; _i < 2; ++_i) { if constexpr (GATHER) vC[_h][_i] = vN[_h][_i]; else vC[_h][_i] += ndelta; }
        if constexpr (ALIGN_EPI) { if (wr == 1) PG8_BAR; }
    }
    PG8_WAIT_V(0);
    if constexpr (!ALIGN_EPI) { if (wr == 0) PG8_BAR; }
    PG8_BAR;
#undef PG8_SA
#undef PG8_SB
#undef PG8_STAGE_A
#undef PG8_STAGE_B
#undef PG8_LDA
#undef PG8_LDB
#undef PG8_MMA
#undef PG8_MMA8
#undef PG8_MM
#undef PG8_LA
#undef PG8_LB
#undef PG8_WAIT_V
#undef PG8_WAIT_L
#undef PG8_BAR
#undef PG8_SCHED
#undef PG8_VOFF
}

constexpr int NXCD = 8, WGM = 8;
struct StaticOrder {
    int nM, nN, nwg, G, c;
    __device__ void init(int nM_, int nN_, int G_, int c_) { nM = nM_; nN = nN_; nwg = nM * nN; G = G_; c = c_; }
    __device__ bool next(int i, Unit& u) const {
        const long L = (long)i * G + c; if (L >= nwg) return false;
        int wgid = (int)L; { const int q = nwg / NXCD, r = nwg % NXCD, xcd = wgid % NXCD, off = wgid / NXCD; wgid = (xcd < r ? xcd * (q + 1) : r * (q + 1) + (xcd - r) * q) + off; }
        const int nig = WGM * nN, gid = wgid / nig, fm = gid * WGM, gsz = (nM - fm) < WGM ? (nM - fm) : WGM;
        u.pm = fm + ((wgid % nig) % gsz); u.pn = (wgid % nig) / gsz; u.om = u.pm; u.on = u.pn; u.aux = 0; return true;
    }
};
struct MergeOrder {
    int G, c;
    __device__ bool next(int i, Unit& u) const {
        const int n = i & 3; const long tile = (long)(i >> 2) * G + c; if (tile >= 256) return false;
        const int om = (int)tile >> 2, on = (int)tile & 3;
        u.pm = n * 64 + om; u.pn = n * 4 + on; u.om = om; u.on = on; u.aux = n; return true;
    }
};
struct MoeOrder {
    int ntiles, nN, nwg, G, c; int pend[NEXP];
    __device__ void init(const unsigned* cnt, int nN_, int G_, int c_) {
        int acc = 0;
#pragma unroll
        for (int e = 0; e < NEXP; ++e) { const int ce = (int)cnt[64 * e]; acc += (ce + 255) >> 8; pend[e] = acc; }
        ntiles = acc; nN = nN_; nwg = ntiles * nN; G = G_; c = c_;
    }
    __device__ bool next(int i, Unit& u) const {
        const long L = (long)i * G + c; if (L >= nwg) return false;
        const int wgid = (int)L;
        const int nig = WGM * nN, gid = wgid / nig, fm = gid * WGM, gsz = (ntiles - fm) < WGM ? (ntiles - fm) : WGM;
        const int pm = fm + ((wgid % nig) % gsz), pn = (wgid % nig) / gsz;
        int e = 0, ps = 0;
#pragma unroll
        for (int j = 0; j < NEXP - 1; ++j) if (pm >= pend[j]) { e = j + 1; ps = pend[j]; }
        u.pm = pm; u.pn = e * nN + pn; u.om = pm; u.on = pn; u.aux = e; u.gofs = e * 16384 - 256 * ps; return true;
    }
};

__device__ __forceinline__ u32x4 pack8(f32x4 a, f32x4 b) { u32x4 w; w.x = cvt_pk_bf16(a[0], a[1]); w.y = cvt_pk_bf16(a[2], a[3]); w.z = cvt_pk_bf16(b[0], b[1]); w.w = cvt_pk_bf16(b[2], b[3]); return w; }
struct EpiIn {
    bf16_t* Zs; bf16_t* Zg; const float* rowss; const float* bgate;
    __device__ __forceinline__ void operator()(const f32x4 (&acc)[2][2][4][2], const Unit& u, int wr, int wc, int fr, int fq) const {
        const int row0 = u.om * BM + wr * 64 + fr, colt = u.on * BM, cw = wc * 32 + 8 * fq;
        if (colt < ZSW) {
#pragma unroll
            for (int ai = 0; ai < 2; ++ai) { float rsd[4];
#pragma unroll
                for (int m = 0; m < 4; ++m) rsd[m] = row_rstd(rowss, row0 + ai * HALF + m * 16);
#pragma unroll
                for (int m = 0; m < 4; ++m) {
                    const int row = row0 + ai * HALF + m * 16; const float rstd = rsd[m];
#pragma unroll
                    for (int bj = 0; bj < 2; ++bj) *(u32x4*)(Zs + (size_t)row * ZSW + colt + bj * HALF + cw) = pack8(acc[ai][bj][m][0] * rstd, acc[ai][bj][m][1] * rstd);
                    if (m == 3) asm volatile("" ::: "memory");
                } }
        } else {
            const int gc0 = colt - ZSW + cw;
            const f32x4 b00 = *(const f32x4*)(bgate + gc0), b01 = *(const f32x4*)(bgate + gc0 + 4), b10 = *(const f32x4*)(bgate + gc0 + HALF), b11 = *(const f32x4*)(bgate + gc0 + HALF + 4);
#pragma unroll
            for (int ai = 0; ai < 2; ++ai) { float rsd[4];
#pragma unroll
                for (int m = 0; m < 4; ++m) rsd[m] = row_rstd(rowss, row0 + ai * HALF + m * 16);
#pragma unroll
                for (int m = 0; m < 4; ++m) {
                    const int row = row0 + ai * HALF + m * 16; const float rstd = rsd[m];
#pragma unroll
                    for (int bj = 0; bj < 2; ++bj) { f32x4 v0 = acc[ai][bj][m][0] * rstd + (bj ? b10 : b00), v1 = acc[ai][bj][m][1] * rstd + (bj ? b11 : b01);
                        *(u32x4*)(Zg + (size_t)row * ZGW + gc0 + bj * HALF) = pack8(v0, v1); }
                    if (m == 3) asm volatile("" ::: "memory");
                } }
        }
    }
};
struct EpiMerge {
    bf16_t* Mg; const bf16_t* Zg;
    __device__ __forceinline__ void operator()(const f32x4 (&acc)[2][2][4][2], const Unit& u, int wr, int wc, int fr, int fq) const {
        const int row0 = u.om * BM + wr * 64 + fr, colt = u.on * BM, cw = wc * 32 + 8 * fq, n = u.aux;
#pragma unroll
        for (int ai = 0; ai < 2; ++ai) {
            u32x4 gw[4][2], ow[4][2];
#pragma unroll
            for (int m = 0; m < 4; ++m)
#pragma unroll
                for (int bj = 0; bj < 2; ++bj) { const int row = row0 + ai * HALF + m * 16, col = colt + bj * HALF + cw;
                    gw[m][bj] = *(const u32x4*)(Zg + (size_t)row * ZGW + DBG_GPERM(n) * DM + col);
                    ow[m][bj] = n > 0 ? *(const u32x4*)(Mg + (size_t)row * DM + col) : (u32x4){0u, 0u, 0u, 0u}; }
#pragma unroll
            for (int m = 0; m < 4; ++m)
#pragma unroll
                for (int bj = 0; bj < 2; ++bj) { const int row = row0 + ai * HALF + m * 16, col = colt + bj * HALF + cw; const u32x4 g = gw[m][bj], o = ow[m][bj];
                    f32x4 v0 = acc[ai][bj][m][0], v1 = acc[ai][bj][m][1];
                    v0[0] = v0[0] * fsigmoid(bflo(g.x)) + bflo(o.x); v0[1] = v0[1] * fsigmoid(bfhi(g.x)) + bfhi(o.x); v0[2] = v0[2] * fsigmoid(bflo(g.y)) + bflo(o.y); v0[3] = v0[3] * fsigmoid(bfhi(g.y)) + bfhi(o.y);
                    v1[0] = v1[0] * fsigmoid(bflo(g.z)) + bflo(o.z); v1[1] = v1[1] * fsigmoid(bfhi(g.z)) + bfhi(o.z); v1[2] = v1[2] * fsigmoid(bflo(g.w)) + bflo(o.w); v1[3] = v1[3] * fsigmoid(bfhi(g.w)) + bfhi(o.w);
                    *(u32x4*)(Mg + (size_t)row * DM + col) = pack8(v0, v1); }
            asm volatile("" ::: "memory");
        }
    }
};
template <bool F32OUT, bool X8 = false, bool SC32 = false> struct EpiRes {
    float* xout; bf16_t* xb; float* rowss; unsigned char* x8;
    __device__ __forceinline__ void operator()(const f32x4 (&acc)[2][2][4][2], const Unit& u, int wr, int wc, int fr, int fq) const {
        const int row0 = u.om * BM + wr * 64 + fr, colt = u.on * BM, cw = wc * 32 + 8 * fq;
#pragma unroll
        for (int ai = 0; ai < 2; ++ai) {
            u32x4 xw[4][2];
#pragma unroll
            for (int m = 0; m < 4; ++m)
#pragma unroll
                for (int bj = 0; bj < 2; ++bj) xw[m][bj] = *(const u32x4*)(xb + (size_t)(row0 + ai * HALF + m * 16) * DM + colt + bj * HALF + cw);
#pragma unroll
            for (int m = 0; m < 4; ++m) {
                const int row = row0 + ai * HALF + m * 16; float ss = 0.f;
#pragma unroll
                for (int bj = 0; bj < 2; ++bj) { const size_t off = (size_t)row * DM + colt + bj * HALF + cw; const u32x4 w = xw[m][bj];
                    f32x4 v0 = acc[ai][bj][m][0], v1 = acc[ai][bj][m][1];
                    if constexpr (SC32) { v0 *= 0.03125f; v1 *= 0.03125f; }
                    v0[0] += bflo(w.x); v0[1] += bfhi(w.x); v0[2] += bflo(w.y); v0[3] += bfhi(w.y); v1[0] += bflo(w.z); v1[1] += bfhi(w.z); v1[2] += bflo(w.w); v1[3] += bfhi(w.w);
                    if constexpr (F32OUT) { *(f32x4*)(xout + off) = v0; *(f32x4*)(xout + off + 4) = v1; }
                    *(u32x4*)(xb + off) = pack8(v0, v1);
                    if constexpr (X8) { u32x2 q; q.x = cvt_pk4_fp8(v0[0], v0[1], v0[2], v0[3]); q.y = cvt_pk4_fp8(v1[0], v1[1], v1[2], v1[3]); *(u32x2*)(x8 + off) = q; }
                    ss += (v0[0] * v0[0] + v0[1] * v0[1]) + (v0[2] * v0[2] + v0[3] * v0[3]) + (v1[0] * v1[0] + v1[1] * v1[1]) + (v1[2] * v1[2] + v1[3] * v1[3]); }
                ss += __shfl_xor(ss, 16); ss += __shfl_xor(ss, 32);
                if (fq == 0) rowss[(size_t)row * 16 + u.on * 4 + wc] = ss;
            }
            asm volatile("" ::: "memory");
        }
    }
};
struct EpiRowScale {
    bf16_t* O; int ldc; const float* rowss;
    __device__ __forceinline__ void operator()(const f32x4 (&acc)[2][2][4][2], const Unit& u, int wr, int wc, int fr, int fq) const {
        const int row0 = u.om * BM + wr * 64 + fr, colt = u.on * BM, cw = wc * 32 + 8 * fq;
#pragma unroll
        for (int ai = 0; ai < 2; ++ai)
#pragma unroll
            for (int m = 0; m < 4; ++m) {
                const int row = row0 + ai * HALF + m * 16; const float rstd = row_rstd(rowss, row);
#pragma unroll
                for (int bj = 0; bj < 2; ++bj) *(u32x4*)(O + (size_t)row * ldc + colt + bj * HALF + cw) = pack8(acc[ai][bj][m][0] * rstd, acc[ai][bj][m][1] * rstd);
                if (m == 3) asm volatile("" ::: "memory");
            }
    }
};
template <bool MOE> struct EpiSwiGLU {
    bf16_t* H; int ldh; const float* rs; const int* row_tok;
    __device__ __forceinline__ void operator()(const f32x4 (&acc)[2][2][4][2], const Unit& u, int wr, int wc, int fr, int fq) const {
        const int row0 = u.om * BM + wr * 64 + fr, hc = u.on * HALF + wc * 32 + 8 * fq;
#pragma unroll
        for (int ai = 0; ai < 2; ++ai) { float rsd[4];
#pragma unroll
            for (int m = 0; m < 4; ++m) { const int row = row0 + ai * HALF + m * 16; rsd[m] = MOE ? rs[row_tok[row]] : row_rstd(rs, row); }
#pragma unroll
            for (int m = 0; m < 4; ++m) {
                const int row = row0 + ai * HALF + m * 16;
                const float rstd = rsd[m];
                f32x4 o[2];
#pragma unroll
                for (int n = 0; n < 2; ++n)
#pragma unroll
                    for (int j = 0; j < 4; ++j) { const float gv = acc[ai][0][m][n][j] * rstd, uv = acc[ai][1][m][n][j] * rstd; o[n][j] = gv * fsigmoid(gv) * uv; }
                *(u32x4*)(H + (size_t)row * ldh + hc) = pack8(o[0], o[1]);
                if (m == 3) asm volatile("" ::: "memory");
            } }
    }
};
template <bool RSTD, bool W32 = true> struct EpiSwiGLU8 {
    unsigned char* H; int ldh; const float* rs;
    __device__ __forceinline__ void operator()(const f32x4 (&acc)[2][2][4][2], const Unit& u, int wr, int wc, int fr, int fq) const {
        const int row0 = u.om * BM + wr * 64 + fr, hc = u.on * HALF + wc * 32 + 8 * fq;
#pragma unroll
        for (int ai = 0; ai < 2; ++ai)
#pragma unroll
            for (int m = 0; m < 4; ++m) {
                const int row = row0 + ai * HALF + m * 16;
                float sc = W32 ? 0.03125f : 1.f; if constexpr (RSTD) sc *= row_rstd(rs, row);
                f32x4 o[2];
#pragma unroll
                for (int n = 0; n < 2; ++n)
#pragma unroll
                    for (int j = 0; j < 4; ++j) { const float gv = acc[ai][0][m][n][j] * sc, uv = acc[ai][1][m][n][j] * sc; o[n][j] = gv * fsigmoid(gv) * uv; }
                u32x2 w; w.x = cvt_pk4_fp8(o[0][0], o[0][1], o[0][2], o[0][3]); w.y = cvt_pk4_fp8(o[1][0], o[1][1], o[1][2], o[1][3]);
                *(u32x2*)(H + (size_t)row * ldh + hc) = w;
                if (m == 3) asm volatile("" ::: "memory");
            }
    }
};
struct EpiPlain {
    bf16_t* O; int ldc; float sc;
    __device__ __forceinline__ void operator()(const f32x4 (&acc)[2][2][4][2], const Unit& u, int wr, int wc, int fr, int fq) const {
        const int row0 = u.om * BM + wr * 64 + fr, colt = u.on * BM, cw = wc * 32 + 8 * fq;
#pragma unroll
        for (int ai = 0; ai < 2; ++ai)
#pragma unroll
            for (int m = 0; m < 4; ++m) { const int row = row0 + ai * HALF + m * 16;
#pragma unroll
                for (int bj = 0; bj < 2; ++bj) *(u32x4*)(O + (size_t)row * ldc + colt + bj * HALF + cw) = pack8(acc[ai][bj][m][0] * sc, acc[ai][bj][m][1] * sc); }
    }
};
}

#define XB_TMO      128
#define XB_XCNT(j)  (256  + 64 * (j))
#define XB_XSUB(j)  (1280 + 64 * (j))
#define XB_XGEN(j)  (2304 + 64 * (j))
#define XB_TOP      3328
#define XB_TOPGEN   3392
#define XCD_BAR_WORDS 3456
#define XB_SPIN_CAP (1u << 18)
__device__ __forceinline__ unsigned xb_ld(unsigned* p)              { return __hip_atomic_load(p, __ATOMIC_RELAXED, __HIP_MEMORY_SCOPE_AGENT); }
__device__ __forceinline__ unsigned xb_add(unsigned* p, unsigned v) { return __hip_atomic_fetch_add(p, v, __ATOMIC_RELAXED, __HIP_MEMORY_SCOPE_AGENT); }
__device__ __forceinline__ unsigned xb_xcc_id() { return (unsigned)__builtin_amdgcn_s_getreg((3 << 11) | 20) & 0xFu; }
#define XB_SPIN(cond, bar) do { unsigned _sp = 0; while (cond) { __builtin_amdgcn_s_sleep(1); \
    if ((++_sp & 255u) == 0u) { if (xb_ld(&(bar)[XB_TMO])) break; if (_sp > XB_SPIN_CAP) { atomicAdd(&(bar)[XB_TMO], 1u); break; } } } } while (0)
struct XcdBarrier { unsigned* bar; unsigned x; volatile LAS unsigned* st; };
__device__ __forceinline__ XcdBarrier xcd_barrier_post(unsigned* bar, volatile LAS unsigned* st) {
    XcdBarrier b; b.bar = bar; b.x = xb_xcc_id(); b.st = st;
    if (threadIdx.x == 0) (void)xb_add(&bar[XB_XCNT(b.x)], 1u);
    return b;
}
__device__ __forceinline__ void xcd_barrier_complete(unsigned* bar, unsigned x, unsigned& nloc, unsigned& nx) {
    const unsigned G = gridDim.x * gridDim.y * gridDim.z;
    unsigned sum, cnt, mine, sp = 0u;
    for (;;) {
        sum = 0u; cnt = 0u; mine = 0u;
#pragma unroll
        for (unsigned j = 0; j < 16; ++j) { const unsigned c = xb_ld(&bar[XB_XCNT(j)]); sum += c; cnt += (c > 0u) ? 1u : 0u; mine = (j == x) ? c : mine; }
        if (sum == G) break;
        __builtin_amdgcn_s_sleep(1);
        if ((++sp & 255u) == 0u) { if (xb_ld(&bar[XB_TMO])) break; if (sp > XB_SPIN_CAP) { atomicAdd(&bar[XB_TMO], 1u); break; } }
    }
    nloc = mine > 0u ? mine : 1u; nx = cnt > 0u ? cnt : 1u;
}
__device__ __forceinline__ void xcd_barrier(const XcdBarrier& b) {
    asm volatile("s_waitcnt vmcnt(0)" ::: "memory");
    __syncthreads();
    if (threadIdx.x == 0) {
        unsigned* bar = b.bar;
        __builtin_amdgcn_s_waitcnt(0);
        unsigned nloc = b.st[0], nx = b.st[1];
        if (nloc == 0u) { xcd_barrier_complete(bar, b.x, nloc, nx); b.st[0] = nloc; b.st[1] = nx; }
        const unsigned old = xb_add(&bar[XB_XSUB(b.x)], 1u);
        const unsigned gen = old / nloc;
        if (old + 1u == (gen + 1u) * nloc) {
            __builtin_amdgcn_fence(__ATOMIC_RELEASE, "agent");
            asm volatile("s_waitcnt vmcnt(0)" ::: "memory");
            const unsigned og = xb_add(&bar[XB_TOP], 1u);
            const unsigned tg = og / nx;
            if (og + 1u == (tg + 1u) * nx) xb_add(&bar[XB_TOPGEN], 1u);
            else XB_SPIN(xb_ld(&bar[XB_TOPGEN]) == tg, bar);
            __builtin_amdgcn_fence(__ATOMIC_ACQUIRE, "agent");
            xb_add(&bar[XB_XGEN(b.x)], 1u);
            asm volatile("s_waitcnt vmcnt(0)" ::: "memory");
        } else {
            XB_SPIN(xb_ld(&bar[XB_XGEN(b.x)]) == gen, bar);
            __builtin_amdgcn_fence(__ATOMIC_ACQUIRE, "agent");
            asm volatile("s_waitcnt vmcnt(0)" ::: "memory");
        }
    }
    __syncthreads();
}

struct Args { const void* in[55]; float* out; unsigned char* ws; int ph_lo, ph_hi, submask, pad; };
struct Frame {
    LAS unsigned char* lds; unsigned char* ws; unsigned* ctl; float* out;
    int tid, lane, wave, G, bid, gw, ngw;
};
#define GAS __attribute__((address_space(1)))
#define CAS __attribute__((address_space(4)))
#define PHASE_BEGIN() const CAS char* kp_ = (const CAS char*)__builtin_amdgcn_kernarg_segment_ptr(); asm volatile("" : "+s"(kp_)); \
    unsigned char* ws = (unsigned char*)(GAS unsigned char*)(*(const CAS unsigned long long*)(kp_ + 448)); \
    Frame F; { int t_ = threadIdx.x; asm volatile("" : "+v"(t_)); int b_ = blockIdx.x; asm volatile("" : "+s"(b_)); \
      F.lds = (LAS unsigned char*)lds_raw; F.ws = ws; F.ctl = (unsigned*)(ws + WS_CTL); F.out = (float*)(GAS float*)(*(const CAS unsigned long long*)(kp_ + 440)); \
      F.tid = t_; F.lane = t_ & 63; F.wave = __builtin_amdgcn_readfirstlane(t_ >> 6); F.G = gridDim.x; F.bid = b_; F.gw = b_ * 8 + F.wave; F.ngw = F.G * 8; }
#define XB ((bf16_t*)(ws + WS_XB))
#define RS ((float*)(ws + WS_RSP))
#define ZS ((bf16_t*)(ws + WS_ZS))
#define ZG ((bf16_t*)(ws + WS_ZG))
#define YB ((bf16_t*)(ws + WS_Y))
#define MG ((bf16_t*)(ws + WS_MERGED))
#define S5T ((float*)(ws + WS_TAB + TAB_S5T))
#define CMAT ((bf16_t*)(ws + WS_TAB + TAB_CMAT))
#define MISCT ((float*)(ws + WS_TAB + TAB_MISC))
#define BBF ((bf16_t*)(ws + WS_TAB + 832 * 1024))
#define WLP(l) (ws + WS_WL + (size_t)(l) * WL_STRIDE)
#define INF(i) ((const float*)(const GAS float*)(*(const CAS unsigned long long*)(kp_ + 8 * (i))))

struct TJob { const float* W; bf16_t* WT; const float* ks; int K, N, ldw, ldk, nb, map; size_t sstride, dstride; int f8; };
__device__ __forceinline__ int tjob_items(const TJob& j) { return j.nb * (j.K / 64) * (j.N / 32); }
__device__ __forceinline__ void tjob_load(const TJob& j, int item, float (&v)[32], int lane) {
    const int per = (j.K / 64) * (j.N / 32), b = item / per, r = item % per, nblk = j.N / 32, kb = r / nblk, nbk = r % nblk, k0 = 64 * kb, n0 = 32 * nbk;
    const float* W = j.W + (size_t)b * j.sstride + (size_t)(k0 + (lane >> 5)) * j.ldw + n0 + (lane & 31);
#pragma unroll
    for (int i = 0; i < 32; ++i) v[i] = W[(size_t)(2 * i) * j.ldw];
}
__device__ __forceinline__ void tjob_store(const TJob& j, int item, float (&v)[32], LAS float* scr, int lane) {
    const int per = (j.K / 64) * (j.N / 32), b = item / per, r = item % per, nblk = j.N / 32, kb = r / nblk, nbk = r % nblk, k0 = 64 * kb, n0 = 32 * nbk;
    int drow = n0;
    if (j.map == 1) drow = n0 < C_END ? n0 : n0 + (ZSW - C_END);
    else if (j.map == 2) drow = 256 * (n0 >> 7) + (n0 & 127);
    else if (j.map == 3) drow = 256 * (n0 >> 7) + 128 + (n0 & 127);
    if (j.ks) {
#pragma unroll
        for (int i = 0; i < 32; ++i) v[i] *= j.ks[k0 + 2 * i + (lane >> 5)]; }
#pragma unroll
    for (int i = 0; i < 32; ++i) scr[(2 * i + (lane >> 5)) * 33 + (lane & 31)] = v[i];
    asm volatile("s_waitcnt lgkmcnt(0)" ::: "memory");
    const int c = lane & 7; bf16_t* WT = j.WT + (size_t)b * j.dstride;
    if (j.f8) { unsigned char* W8 = (unsigned char*)j.WT + (size_t)b * j.dstride;
#pragma unroll
        for (int q = 0; q < 4; ++q) { const int n = (lane >> 3) + 8 * q; const LAS float* sp = scr + (8 * c) * 33 + n;
            u32x2 o; o.x = cvt_pk4_fp8(sp[0 * 33] * 32.f, sp[1 * 33] * 32.f, sp[2 * 33] * 32.f, sp[3 * 33] * 32.f); o.y = cvt_pk4_fp8(sp[4 * 33] * 32.f, sp[5 * 33] * 32.f, sp[6 * 33] * 32.f, sp[7 * 33] * 32.f);
            *(u32x2*)(W8 + (size_t)(drow + n) * j.ldk + k0 + 8 * c) = o; }
    } else
#pragma unroll
    for (int q = 0; q < 4; ++q) { const int n = (lane >> 3) + 8 * q; const LAS float* sp = scr + (8 * c) * 33 + n;
        u32x4 o; o.x = cvt_pk_bf16(sp[0 * 33], sp[1 * 33]); o.y = cvt_pk_bf16(sp[2 * 33], sp[3 * 33]); o.z = cvt_pk_bf16(sp[4 * 33], sp[5 * 33]); o.w = cvt_pk_bf16(sp[6 * 33], sp[7 * 33]);
        *(u32x4*)(WT + (size_t)(drow + n) * j.ldk + k0 + 8 * c) = o; }
    asm volatile("s_waitcnt lgkmcnt(0)" ::: "memory");
}
__device__ __forceinline__ void tjob_run_all(const TJob& j, int first, int stride, LAS float* scr, int lane) {
    const int ni = tjob_items(j); int it = first; if (it >= ni) return;
    float va[32], vb[32]; tjob_load(j, it, va, lane);
    for (;;) {
        const int n1 = it + stride; if (n1 < ni) tjob_load(j, n1, vb, lane);
        tjob_store(j, it, va, scr, lane); if (n1 >= ni) break;
        const int n2 = n1 + stride; if (n2 < ni) tjob_load(j, n2, va, lane);
        tjob_store(j, n1, vb, scr, lane); if (n2 >= ni) break;
        it = n2;
    }
}

template <int DQ> struct AttnLds { static constexpr int KROW = DQ * 2 + 16, VROW = 272, KBYTES = 128 * KROW, VBYTES = 64 * VROW, BUF = KBYTES + VBYTES; };
#define PK4(P, BASE, OUT) do { unsigned a0_ = cvt_pk_bf16(P[BASE + 0], P[BASE + 1]), a1_ = cvt_pk_bf16(P[BASE + 2], P[BASE + 3]); \
    unsigned b0_ = cvt_pk_bf16(P[BASE + 4], P[BASE + 5]), b1_ = cvt_pk_bf16(P[BASE + 6], P[BASE + 7]); \
    auto r0_ = __builtin_amdgcn_permlane32_swap(a0_, b0_, false, false); auto r1_ = __builtin_amdgcn_permlane32_swap(a1_, b1_, false, false); \
    u32x4 w_ = {r0_[0], r1_[0], r0_[1], r1_[1]}; OUT = *(bf16x8*)&w_; } while (0)

template <int DQ, int NMAP, bool CAUSAL, bool BIAS, bool QNORM>
__device__ __forceinline__ void attn_unit(LAS unsigned char* lds, const bf16_t* Qp, int ldq, const bf16_t* Kp, const bf16_t* Vtp, int vstride, int nkt, int q0,
                                          const LAS float* lut, const float* qg, float qscale, float mshift, f32x16 (&o)[NMAP][2], float (&l)[NMAP]) {
    typedef AttnLds<DQ> L; constexpr int KD = DQ / NMAP, KS = KD / 16, KCH = DQ / 8, NKC = 64 * KCH;
    int tid = threadIdx.x; asm volatile("" : "+v"(tid));
    const int wid = tid >> 6, lane = tid & 63, r32 = lane & 31, hi = lane >> 5;
    bf16x8 q[NMAP][KS];
    {
        const bf16_t* qrow = Qp + (size_t)(wid * 32 + r32) * ldq + hi * 8;
#pragma unroll
        for (int mp = 0; mp < NMAP; ++mp)
#pragma unroll
            for (int ks = 0; ks < KS; ++ks) q[mp][ks] = ldg8(qrow + mp * KD + ks * 16);
        if constexpr (QNORM) {
            float ss = 0.f;
#pragma unroll
            for (int ks = 0; ks < KS; ++ks) ss += sq8(q[0][ks]);
            ss += __shfl_xor(ss, 32);
            const float rs = frsq(ss * (1.f / DQ) + EPS) * qscale;
#pragma unroll
            for (int ks = 0; ks < KS; ++ks) { u32x4 w = *(u32x4*)&q[0][ks]; const float* gp = qg + ks * 16 + hi * 8;
                w.x = cvt_pk_bf16(bflo(w.x) * rs * gp[0], bfhi(w.x) * rs * gp[1]); w.y = cvt_pk_bf16(bflo(w.y) * rs * gp[2], bfhi(w.y) * rs * gp[3]);
                w.z = cvt_pk_bf16(bflo(w.z) * rs * gp[4], bfhi(w.z) * rs * gp[5]); w.w = cvt_pk_bf16(bflo(w.w) * rs * gp[6], bfhi(w.w) * rs * gp[7]);
                q[0][ks] = *(bf16x8*)&w; }
        }
    }
#pragma unroll
    for (int mp = 0; mp < NMAP; ++mp) { l[mp] = 0.f; o[mp][0] = f32x16{}; o[mp][1] = f32x16{}; }
    constexpr int NKI = (128 * KCH) / 512;
    bf16x8 skr[NKI], svr[2];
#define AT_LOAD(j) do { const int key0_ = (j) * 128; \
        _Pragma("unroll") for (int i_ = 0; i_ < NKI; ++i_) { const int c_ = tid + 512 * i_; skr[i_] = ldg8(Kp + (size_t)(key0_ + c_ / KCH) * DQ + (c_ % KCH) * 8); } \
        _Pragma("unroll") for (int i_ = 0; i_ < 2; ++i_) { const int c_ = tid + 512 * i_; svr[i_] = ldg8(Vtp + (size_t)(c_ >> 4) * vstride + key0_ + (c_ & 15) * 8); } } while (0)
#define AT_WRITE(b) do { LAS unsigned char* base_ = lds + (b) * L::BUF; \
        _Pragma("unroll") for (int i_ = 0; i_ < NKI; ++i_) { const int c_ = tid + 512 * i_; *(LAS bf16x8*)(base_ + (c_ / KCH) * L::KROW + (c_ % KCH) * 16) = skr[i_]; } \
        _Pragma("unroll") for (int i_ = 0; i_ < 2; ++i_) { const int c_ = tid + 512 * i_; *(LAS bf16x8*)(base_ + L::KBYTES + (c_ >> 4) * L::VROW + (c_ & 15) * 16) = svr[i_]; } } while (0)
    const int qi = q0 + wid * 32 + r32;
    const int qlo = q0 + wid * 32;
#define AT_COMPUTE(key0, bf, sb) do { const bool active = !CAUSAL || (key0) <= qlo + 31; \
        if (active) { const LAS unsigned char* kb = lds + (bf) * L::BUF + (sb) * 64 * L::KROW; const LAS unsigned char* vb = lds + (bf) * L::BUF + L::KBYTES + (sb) * 128; const bool need_mask = CAUSAL && ((key0) + 63 > qlo); \
            _Pragma("unroll") for (int mp = 0; mp < NMAP; ++mp) { f32x16 p0 = f32x16{}, p1 = f32x16{}; \
                _Pragma("unroll") for (int ks = 0; ks < KS; ++ks) { \
                    const bf16x8 a0 = *(const LAS bf16x8*)(kb + r32 * L::KROW + (mp * KD + ks * 16 + hi * 8) * 2); \
                    const bf16x8 a1 = *(const LAS bf16x8*)(kb + (32 + r32) * L::KROW + (mp * KD + ks * 16 + hi * 8) * 2); \
                    p0 = MFMA32(a0, q[mp][ks], p0); p1 = MFMA32(a1, q[mp][ks], p1); } \
                __builtin_amdgcn_sched_barrier(0); \
                float sh = mshift; \
                if constexpr (BIAS) { \
                    if (qlo - ((key0) + 63) >= 127) sh -= lut[255]; \
                    else { const LAS float* lp = lut + (qi - (key0) - 4 * hi + 69); \
                        _Pragma("unroll") for (int r = 0; r < 16; ++r) { const int cr = (r & 3) + 8 * (r >> 2); p0[r] += lp[59 - cr]; p1[r] += lp[27 - cr]; } } } \
                if (need_mask) { _Pragma("unroll") for (int r = 0; r < 16; ++r) { const int kk = (key0) + crow(r, hi); if (kk > qi) p0[r] = -1e30f; if (kk + 32 > qi) p1[r] = -1e30f; } } \
                float ps = 0.f; \
                _Pragma("unroll") for (int r = 0; r < 16; ++r) { p0[r] = fexp2(p0[r] - sh); p1[r] = fexp2(p1[r] - sh); ps += p0[r] + p1[r]; } \
                l[mp] += ps; \
                __builtin_amdgcn_sched_barrier(0); \
                bf16x8 pa0, pa1, pa2, pa3; \
                PK4(p0, 0, pa0); PK4(p0, 8, pa1); PK4(p1, 0, pa2); PK4(p1, 8, pa3); \
                _Pragma("unroll") for (int dt = 0; dt < 2; ++dt) { \
                    const LAS unsigned char* vrow = vb + (dt * 32 + r32) * L::VROW + hi * 16; \
                    const bf16x8 v0 = *(const LAS bf16x8*)(vrow), v1 = *(const LAS bf16x8*)(vrow + 32), v2 = *(const LAS bf16x8*)(vrow + 64), v3 = *(const LAS bf16x8*)(vrow + 96); \
                    o[mp][dt] = MFMA32(v0, pa0, o[mp][dt]); o[mp][dt] = MFMA32(v1, pa1, o[mp][dt]); o[mp][dt] = MFMA32(v2, pa2, o[mp][dt]); o[mp][dt] = MFMA32(v3, pa3, o[mp][dt]); } \
                __builtin_amdgcn_sched_barrier(0); } } } while (0)
    const int n128 = nkt >> 1;
    if (wid < 4) __builtin_amdgcn_s_setprio(2);
    AT_LOAD(0); AT_WRITE(0); __syncthreads();
    for (int j = 0; j < n128; ++j) {
        if (j + 1 < n128) AT_LOAD(j + 1);
        AT_COMPUTE(j * 128, j & 1, 0);
        AT_COMPUTE(j * 128 + 64, j & 1, 1);
        if (j + 1 < n128) AT_WRITE((j + 1) & 1);
        __syncthreads();
    }
    __builtin_amdgcn_s_setprio(0);
#undef AT_COMPUTE
#pragma unroll
    for (int mp = 0; mp < NMAP; ++mp) l[mp] += __shfl_xor(l[mp], 32);
#undef AT_LOAD
#undef AT_WRITE
}

__device__ __forceinline__ void attn_store(bf16_t* dst, const f32x16 (&o)[2], float scale, int hi) {
#pragma unroll
    for (int dt = 0; dt < 2; ++dt)
#pragma unroll
        for (int rg = 0; rg < 4; ++rg) { u32x2 w; w.x = cvt_pk_bf16(o[dt][4 * rg] * scale, o[dt][4 * rg + 1] * scale); w.y = cvt_pk_bf16(o[dt][4 * rg + 2] * scale, o[dt][4 * rg + 3] * scale);
            *(u32x2*)(dst + dt * 32 + 8 * rg + 4 * hi) = w; }
}

__device__ __forceinline__ bool in_phase(int k) { const __attribute__((address_space(4))) int* p_ = (const __attribute__((address_space(4))) int*)__builtin_amdgcn_kernarg_segment_ptr(); asm volatile("" : "+s"(p_)); return p_[114] <= k && k < p_[115]; }
__device__ __forceinline__ bool sub_on(int k) { const __attribute__((address_space(4))) int* p_ = (const __attribute__((address_space(4))) int*)__builtin_amdgcn_kernarg_segment_ptr(); asm volatile("" : "+s"(p_)); return (p_[116] >> k) & 1; }
__device__ __forceinline__ void s5_bu_tile(LAS unsigned char* tile, const bf16_t* bbf_g, const bf16_t* zs_tok0, int lane) {
    const int r32 = lane & 31, hi = lane >> 5;
    const bf16x8 uf = ldg8(zs_tok0 + (size_t)r32 * ZSW + 8 * hi);
#pragma unroll
    for (int pt = 0; pt < 4; ++pt) { f32x16 d = f32x16{}; d = MFMA32(ldg8(bbf_g + (size_t)(32 * pt + r32) * 16 + 8 * hi), uf, d);
#pragma unroll
        for (int rg = 0; rg < 4; ++rg) { u32x2 w; w.x = cvt_pk_bf16(d[4 * rg], d[4 * rg + 1]); w.y = cvt_pk_bf16(d[4 * rg + 2], d[4 * rg + 3]);
            *(LAS u32x2*)(tile + r32 * 272 + (32 * pt + 8 * rg + 4 * hi) * 2) = w; } }
    asm volatile("s_waitcnt lgkmcnt(0)" ::: "memory");
}
__device__ __forceinline__ int h0_pull(LAS unsigned* qc, int lane, int wg_items, int bid, int G, int total) {
    unsigned k = 0u; if (lane == 0) k = __hip_atomic_fetch_add(qc, 1u, __ATOMIC_RELAXED, __HIP_MEMORY_SCOPE_WORKGROUP);
    const int kk = __builtin_amdgcn_readfirstlane((int)k);
    return kk < wg_items ? bid + kk * G : total;
}
__device__ __forceinline__ int queue_pull(unsigned* ctr, volatile LAS unsigned* slot, int tid) {
    __syncthreads();
    if (tid == 0) *slot = __hip_atomic_fetch_add(ctr, 1u, __ATOMIC_RELAXED, __HIP_MEMORY_SCOPE_AGENT);
    __syncthreads();
    return (int)*slot;
}
constexpr int NPHASE = 24;
#ifndef DBG_NPH
#endif
__global__ void __launch_bounds__(512, 2) hybrid_fwd(Args args) {
    extern __shared__ __attribute__((aligned(16))) unsigned char lds_raw[];
    LAS unsigned char* lds0 = (LAS unsigned char*)lds_raw;
    volatile LAS unsigned* MISC = (volatile LAS unsigned*)(lds0 + MISC_OFF);
    for (int u = threadIdx.x; u < (LDS_BYTES - RING_BYTES) / 4; u += 512) ((LAS unsigned*)(lds0 + RING_BYTES))[u] = 0u;
    __syncthreads();
    const int lo = args.ph_lo, hi_ph = args.ph_hi;
    const bool one_launch = (hi_ph - lo) > 1;
    XcdBarrier bar; bar.bar = (unsigned*)(args.ws + WS_CTL) + CW_BAR; bar.x = 0; bar.st = nullptr;
    if (one_launch) bar = xcd_barrier_post((unsigned*)(args.ws + WS_CTL) + CW_BAR, MISC + 8);
#ifndef SUBMASK
#define SUBMASK 0xFFFFu
#endif
#define SUB(k) ((((SUBMASK) >> (k)) & 1u) && sub_on(k))
#ifndef PHMASK
#define PHMASK 0xFFFFFFu
#endif
#define IN(k) ((((PHMASK) >> (k)) & 1u) && in_phase(k))
#define SEAM(k) do { if (IN(k) && IN((k) + 1)) { XcdBarrier b2_ = bar; asm volatile("" : "+s"(b2_.bar), "+s"(b2_.x)); xcd_barrier(b2_); } } while (0)

    if (IN(0)) { PHASE_BEGIN();
        LAS float* scr = (LAS float*)(F.lds + F.wave * 16384);
        int joff = 0;
        for (int l = 0; l < 2; ++l) {
            unsigned char* wl = ws + WS_WL + l * WL_STRIDE;
#define RUNJOB(...) do { const TJob jb_ = TJob{__VA_ARGS__}; int fst_ = F.gw - joff; if (fst_ < 0) fst_ += F.ngw; tjob_run_all(jb_, fst_, F.ngw, scr, F.lane); joff = (joff + tjob_items(jb_)) % F.ngw; } while (0)
            RUNJOB(INF(8) + (size_t)l * DM * DIN, (bf16_t*)(wl + WL_WIN), INF(4) + l * DM, DM, DIN, DIN, DM, 1, 1, 0, 0);
            RUNJOB(INF(22) + (size_t)l * 192 * 384, (bf16_t*)(wl + WL_SM + SM_WUQ), INF(20) + l * 192, 192, 384, 384, 192, 1, 0, 0, 0);
            RUNJOB(INF(23) + (size_t)l * 128 * 512, (bf16_t*)(wl + WL_SM + SM_WUKV), INF(21) + l * 128, 128, 512, 512, 128, 1, 0, 0, 0);
            RUNJOB(INF(28) + (size_t)l * 4 * 4096, (bf16_t*)(wl + WL_SM + SM_WR), nullptr, 64, 64, 64, 64, 4, 0, 4096, 4096);
            RUNJOB(INF(30) + (size_t)l * 4 * 4096, (bf16_t*)(wl + WL_SM + SM_WI), nullptr, 64, 64, 64, 64, 4, 0, 4096, 4096);
            RUNJOB(INF(18) + (size_t)l * 65536, (bf16_t*)(wl + WL_SM + SM_WGLU), nullptr, 256, 256, 256, 256, 1, 0, 0, 0);
            RUNJOB(INF(40) + (size_t)l * 4 * 256 * DM, (bf16_t*)(wl + WL_PT), nullptr, 256, DM, DM, 256, 4, 0, (size_t)256 * DM, (size_t)DM * 256);
            RUNJOB(INF(41) + (size_t)l * DM * DM, (bf16_t*)(wl + WL_WO), nullptr, DM, DM, DM, DM, 1, 0, 0, 0);
            RUNJOB(INF(42) + (size_t)l * DM * 256, (bf16_t*)(wl + WL_WXQ), INF(5) + l * DM, DM, 256, 256, DM, 1, 0, 0, 0);
            RUNJOB(INF(43) + (size_t)l * DM * 256, (bf16_t*)(wl + WL_WXKV), INF(6) + l * DM, DM, 256, 256, DM, 1, 0, 0, 0);
            RUNJOB(INF(44) + (size_t)l * DM * 256, (bf16_t*)(wl + WL_WXKV) + (size_t)256 * DM, INF(6) + l * DM, DM, 256, 256, DM, 1, 0, 0, 0);
            RUNJOB(INF(45) + (size_t)l * 256 * DM, (bf16_t*)(wl + WL_WXO), nullptr, 256, DM, DM, 256, 1, 0, 0, 0);
            { u32x4* z = (u32x4*)((bf16_t*)(wl + WL_WIN) + (size_t)C_END * DM); const int n16 = (ZSW - C_END) * DM * 2 / 16;
              for (int i = F.bid * 512 + F.tid; i < n16; i += F.G * 512) z[i] = (u32x4){0u, 0u, 0u, 0u}; }
        }
        {
            RUNJOB(INF(48), (bf16_t*)(ws + WS_WGU), INF(7), DM, FF, FF, DM, 1, 2, 0, 0);
            RUNJOB(INF(49), (bf16_t*)(ws + WS_WGU), INF(7), DM, FF, FF, DM, 1, 3, 0, 0);
            RUNJOB(INF(50), (bf16_t*)(ws + WS_WD), nullptr, FF, DM, DM, FF, 1, 0, 0, 0, G2_FP8);
        }
        for (int i = F.bid * 512 + F.tid; i < 2 * 16 * 64; i += F.G * 512) {
            const int l = i >> 10, g = (i >> 6) & 15, p = i & 63;
            const float dt = __expf(INF(12)[l * 16 + g]);
            const float lr = INF(10)[(l * 16 + g) * 64 + p], li = INF(11)[(l * 16 + g) * 64 + p];
            const float mag = __expf(lr * dt); float sn, cs; sincos_red(li * dt, sn, cs);
            const float ar = mag * cs, ai = mag * sn, den = lr * lr + li * li;
            const float zr = ((ar - 1.f) * lr + ai * li) / den, zi = (ai * lr - (ar - 1.f) * li) / den;
            float* tb = S5T + (size_t)(l * 16 + g) * 36 * 64;
            for (int c = 0; c < 16; ++c) { const float br = INF(13)[((l * 16 + g) * 64 + p) * 16 + c], bi = INF(14)[((l * 16 + g) * 64 + p) * 16 + c];
                tb[c * 64 + p] = zr * br - zi * bi; tb[(16 + c) * 64 + p] = zr * bi + zi * br;
                BBF[((size_t)(l * 16 + g) * 128 + p) * 16 + c] = f2bf(zr * br - zi * bi); BBF[((size_t)(l * 16 + g) * 128 + 64 + p) * 16 + c] = f2bf(zr * bi + zi * br); }
            tb[32 * 64 + p] = ar; tb[33 * 64 + p] = ai;
            float pr = ar, pi = ai;
            for (int s = 0; s < 6; ++s) { const float nr = pr * pr - pi * pi, ni = 2.f * pr * pi; pr = nr; pi = ni; }
            tb[34 * 64 + p] = pr; tb[35 * 64 + p] = pi;
            bf16_t* cm = CMAT + (size_t)(l * 16 + g) * 16 * 128;
            for (int c = 0; c < 16; ++c) { cm[c * 128 + p] = f2bf(INF(15)[((l * 16 + g) * 16 + c) * 64 + p]); cm[c * 128 + 64 + p] = f2bf(-INF(16)[((l * 16 + g) * 16 + c) * 64 + p]); }
        }
        for (int i = F.bid * 512 + F.tid; i < 512; i += F.G * 512) { const float lam = INF(32)[i]; MISCT[i] = 8.f * log1pf(__expf(-lam)); }
        if (F.bid == 0 && F.tid < 2) { const int l = F.tid; float s1 = 0.f, s2 = 0.f;
            for (int d = 0; d < 32; ++d) { s1 += INF(35)[l * 32 + d] * INF(36)[l * 32 + d]; s2 += INF(37)[l * 32 + d] * INF(38)[l * 32 + d]; }
            const float lam_init = 0.8f - 0.6f * expf(-0.3f * (float)l);
            MISCT[512 + l] = expf(s1) - expf(s2) + lam_init; MISCT[514 + l] = lam_init;
            float gq = 0.f, gk = 0.f; for (int d = 0; d < 96; ++d) { gq = fmaxf(gq, fabsf(INF(24)[l * 96 + d])); gk = fmaxf(gk, fabsf(INF(25)[l * 96 + d])); }
            MISCT[516 + l * 4 + 0] = 1.02f * gq * gk * 9.797958971f * LOG2E;
            gq = 0.f; gk = 0.f; for (int d = 0; d < 32; ++d) { gq = fmaxf(gq, fabsf(INF(33)[l * 32 + d])); gk = fmaxf(gk, fabsf(INF(34)[l * 32 + d])); }
            float bm = 0.f; for (int i = 0; i < 128; ++i) bm = fmaxf(bm, fabsf(INF(3)[i]));
            MISCT[516 + l * 4 + 1] = 1.02f * gq * gk * 5.656854249f * LOG2E + bm * LOG2E;
            gq = 0.f; gk = 0.f; for (int d = 0; d < 64; ++d) { gq = fmaxf(gq, fabsf(INF(46)[l * 64 + d])); gk = fmaxf(gk, fabsf(INF(47)[l * 64 + d])); }
            MISCT[516 + l * 4 + 2] = 1.02f * gq * gk * 8.f * LOG2E; }
        for (int i = F.bid * 512 + F.tid; i < 4 * 384; i += F.G * 512) { const int h = i / 384, dd = i % 384 - 128, d = dd > 127 ? 127 : dd; int bk;
            if (d < 16) bk = d < 0 ? 0 : d; else { const float lr_ = logf((float)d / 16.f) / logf(8.f); bk = 16 + (int)(lr_ * 16.f); if (bk > 31) bk = 31; }
            MISCT[1024 + i] = dd < 0 ? 0.f : INF(3)[bk * 4 + h] * LOG2E; }
        for (int m = F.gw; m < MTOK; m += F.ngw) {
            const f32x4* xr = (const f32x4*)(INF(0) + (size_t)m * DM) + F.lane; float s = 0.f;
            u32x2* o8 = (u32x2*)(XB + (size_t)m * DM) + F.lane;
#pragma unroll
            for (int j = 0; j < 4; ++j) { const f32x4 v = xr[64 * j]; s += (v.x * v.x + v.y * v.y) + (v.z * v.z + v.w * v.w); u32x2 w; w.x = cvt_pk_bf16(v.x, v.y); w.y = cvt_pk_bf16(v.z, v.w); o8[64 * j] = w; }
            s = wave_sum(s); if (F.lane < 16) RS[(size_t)m * 16 + F.lane] = F.lane == 0 ? s : 0.f;
        }
    }
    SEAM(0);

    for (int l = 0; l < 2; ++l) {
        const int pb = 1 + 10 * l;
        if (IN(pb + 0)) { PHASE_BEGIN();
            pg8::Gemm g{XB, (const bf16_t*)(WLP(l) + WL_WIN), DM, nullptr}; pg8::StaticOrder S; S.init(MTOK / 256, NIN / 256, F.G, F.bid);
            pg8::EpiIn E{ZS, ZG, RS + (size_t)(l == 0 ? 0 : 3) * MTOK * 16, INF(9) + (size_t)l * 4 * DM};
            pg8::gemm_phase<pg8::EpiIn, pg8::StaticOrder, true, false>(F.lds, g, S, E);
        }
        SEAM(pb + 0);
        if (IN(pb + 1)) { PHASE_BEGIN();
            const int lane = F.lane, r = lane & 31, hi = lane >> 5;
            bf16_t* QM = (bf16_t*)(ws + WS_QM); bf16_t* KM = (bf16_t*)(ws + WS_KM); bf16_t* VMT = (bf16_t*)(ws + WS_VMT);
            if (SUB(0) && F.wave < 2) for (int tt = F.bid * 2 + F.wave; tt < 512; tt += F.G * 2) {
                const int row = tt * 32 + r, b = row >> 12, s = row & 4095;
                bf16x8 xq[12]; float ss = 0.f;
#pragma unroll
                for (int ks = 0; ks < 12; ++ks) { xq[ks] = ldg8(ZS + (size_t)row * ZSW + C_CQ + 16 * ks + 8 * hi); ss += sq8(xq[ks]); }
                ss += __shfl_xor(ss, 32); const float rc = frsq(ss * (1.f / 192.f) + EPS);
                const float pos = (float)((const int*)INF(2))[row]; float cs[8], sn[8];
#pragma unroll
                for (int i = 0; i < 8; ++i) { const int fi = crow(i, hi); const float inv = exp2f(-(float)fi * (13.287712379549449f / 16.f)); sincos_red(pos * inv, sn[i], cs[i]); }
                const bf16_t* W = (const bf16_t*)(WLP(l) + WL_SM + SM_WUQ); const float* gq = INF(24) + l * 96;
#pragma unroll 1
                for (int hd = 0; hd < 4; ++hd) {
                    f32x16 acc[3] = {f32x16{}, f32x16{}, f32x16{}};
#pragma unroll
                    for (int ft = 0; ft < 3; ++ft) {
#pragma unroll
                        for (int ks = 0; ks < 12; ++ks) acc[ft] = MFMA32(ldg8(W + (size_t)(hd * 96 + 32 * ft + r) * 192 + 16 * ks + 8 * hi), xq[ks], acc[ft]); }
                    float s2 = 0.f;
#pragma unroll
                    for (int ft = 0; ft < 3; ++ft)
#pragma unroll
                        for (int q = 0; q < 16; ++q) { acc[ft][q] *= rc; s2 += acc[ft][q] * acc[ft][q]; }
                    s2 += __shfl_xor(s2, 32); const float rq = frsq(s2 * (1.f / 96.f) + EPS);
#pragma unroll
                    for (int ft = 0; ft < 3; ++ft)
#pragma unroll
                        for (int q = 0; q < 16; ++q) acc[ft][q] *= rq * gq[32 * ft + crow(q, hi)];
#pragma unroll
                    for (int q = 0; q < 8; ++q) { const float x1 = acc[2][q], x2 = acc[2][q + 8]; acc[2][q] = x1 * cs[q] - x2 * sn[q]; acc[2][q + 8] = x1 * sn[q] + x2 * cs[q]; }
                    const float qs = 0.10206207261596577f * LOG2E;
                    bf16_t* dst = QM + ((size_t)(b * 4 + hd) * SEQ + s) * 96;
#pragma unroll
                    for (int ft = 0; ft < 3; ++ft)
#pragma unroll
                        for (int rg = 0; rg < 4; ++rg) { u32x2 w; w.x = cvt_pk_bf16(acc[ft][4 * rg] * qs, acc[ft][4 * rg + 1] * qs); w.y = cvt_pk_bf16(acc[ft][4 * rg + 2] * qs, acc[ft][4 * rg + 3] * qs);
                            *(u32x2*)(dst + 32 * ft + 8 * rg + 4 * hi) = w; }
                }
            }
            if (SUB(1) && (F.wave == 2 || F.wave == 3)) for (int tt = F.bid * 2 + F.wave - 2; tt < 512; tt += F.G * 2) {
                const int row = tt * 32 + r, b = row >> 12, s = row & 4095;
                bf16x8 xk[8]; float ss = 0.f;
#pragma unroll
                for (int ks = 0; ks < 8; ++ks) { xk[ks] = ldg8(ZS + (size_t)row * ZSW + C_CKV + 16 * ks + 8 * hi); ss += sq8(xk[ks]); }
                ss += __shfl_xor(ss, 32); const float rc = frsq(ss * (1.f / 128.f) + EPS);
                float kp[16]; float sskp = 0.f;
#pragma unroll
                for (int rg = 0; rg < 4; ++rg) { const u32x2 w = *(const u32x2*)(ZS + (size_t)row * ZSW + C_KPE + 8 * rg + 4 * hi);
                    kp[4 * rg] = bflo(w.x); kp[4 * rg + 1] = bfhi(w.x); kp[4 * rg + 2] = bflo(w.y); kp[4 * rg + 3] = bfhi(w.y); }
#pragma unroll
                for (int q = 0; q < 16; ++q) sskp += kp[q] * kp[q];
                const float pos = (float)((const int*)INF(2))[row]; float cs[8], sn[8];
#pragma unroll
                for (int i = 0; i < 8; ++i) { const int fi = crow(i, hi); const float inv = exp2f(-(float)fi * (13.287712379549449f / 16.f)); sincos_red(pos * inv, sn[i], cs[i]); }
                const bf16_t* W = (const bf16_t*)(WLP(l) + WL_SM + SM_WUKV); const float* gk = INF(25) + l * 96;
#pragma unroll 1
                for (int hd = 0; hd < 4; ++hd) {
                    f32x16 acc[4] = {f32x16{}, f32x16{}, f32x16{}, f32x16{}};
#pragma unroll
                    for (int ft = 0; ft < 4; ++ft) {
#pragma unroll
                        for (int ks = 0; ks < 8; ++ks) acc[ft] = MFMA32(ldg8(W + (size_t)(hd * 128 + 32 * ft + r) * 128 + 16 * ks + 8 * hi), xk[ks], acc[ft]); }
                    float s2 = sskp;
#pragma unroll
                    for (int ft = 0; ft < 2; ++ft)
#pragma unroll
                        for (int q = 0; q < 16; ++q) { acc[ft][q] *= rc; s2 += acc[ft][q] * acc[ft][q]; }
                    s2 += __shfl_xor(s2, 32); const float rk = frsq(s2 * (1.f / 96.f) + EPS);
                    float kr[16];
#pragma unroll
                    for (int q = 0; q < 16; ++q) kr[q] = kp[q] * rk * gk[64 + crow(q, hi)];
#pragma unroll
                    for (int q = 0; q < 8; ++q) { const float x1 = kr[q], x2 = kr[q + 8]; kr[q] = x1 * cs[q] - x2 * sn[q]; kr[q + 8] = x1 * sn[q] + x2 * cs[q]; }
                    bf16_t* dst = KM + ((size_t)(b * 4 + hd) * SEQ + s) * 96;
#pragma unroll
                    for (int ft = 0; ft < 2; ++ft)
#pragma unroll
                        for (int rg = 0; rg < 4; ++rg) { const float* gp = gk + 32 * ft + 8 * rg + 4 * hi; u32x2 w;
                            w.x = cvt_pk_bf16(acc[ft][4 * rg] * rk * gp[0], acc[ft][4 * rg + 1] * rk * gp[1]); w.y = cvt_pk_bf16(acc[ft][4 * rg + 2] * rk * gp[2], acc[ft][4 * rg + 3] * rk * gp[3]);
                            *(u32x2*)(dst + 32 * ft + 8 * rg + 4 * hi) = w; }
#pragma unroll
                    for (int rg = 0; rg < 4; ++rg) { u32x2 w; w.x = cvt_pk_bf16(kr[4 * rg], kr[4 * rg + 1]); w.y = cvt_pk_bf16(kr[4 * rg + 2], kr[4 * rg + 3]); *(u32x2*)(dst + 64 + 8 * rg + 4 * hi) = w; }
                    bf16_t* vd = VMT + (size_t)(b * 4 + hd) * 64 * SEQ + s;
#pragma unroll
                    for (int ft = 2; ft < 4; ++ft)
#pragma unroll
                        for (int q = 0; q < 16; ++q) vd[(size_t)(32 * (ft - 2) + crow(q, hi)) * SEQ] = f2bf(acc[ft][q] * rc);
                }
            }
            if (SUB(2)) {
                bf16_t* QD = (bf16_t*)(ws + WS_QD); bf16_t* KD = (bf16_t*)(ws + WS_KD); bf16_t* VDT = (bf16_t*)(ws + WS_VDT);
                const float* gqn = INF(33) + l * 32; const float* gkn = INF(34) + l * 32;
                for (int i = F.bid * 512 + F.tid; i < MTOK * 16; i += F.G * 512) {
                    const int row = i & (MTOK - 1), j = i >> 14, half = j & 1, hd = (j >> 1) & 3, isk = j >> 3;
                    const bf16_t* src = ZS + (size_t)row * ZSW + (isk ? C_KD : C_QD) + hd * 64 + half * 32;
                    bf16x8 v[4]; float ss = 0.f;
#pragma unroll
                    for (int c = 0; c < 4; ++c) { v[c] = ldg8(src + 8 * c); ss += sq8(v[c]); }
                    const float rs = frsq(ss * (1.f / 32.f) + EPS) * (isk ? 1.f : 0.17677669529663687f * LOG2E);
                    const float* gg = isk ? gkn : gqn; const int b = row >> 12, s = row & 4095;
                    bf16_t* dst = (isk ? KD : QD) + ((size_t)(b * 4 + hd) * SEQ + s) * 64 + half * 32;
#pragma unroll
                    for (int c = 0; c < 4; ++c) { u32x4 w = *(u32x4*)&v[c]; const float* gp = gg + 8 * c;
                        w.x = cvt_pk_bf16(bflo(w.x) * rs * gp[0], bfhi(w.x) * rs * gp[1]); w.y = cvt_pk_bf16(bflo(w.y) * rs * gp[2], bfhi(w.y) * rs * gp[3]);
                        w.z = cvt_pk_bf16(bflo(w.z) * rs * gp[4], bfhi(w.z) * rs * gp[5]); w.w = cvt_pk_bf16(bflo(w.w) * rs * gp[6], bfhi(w.w) * rs * gp[7]);
                        *(u32x4*)(dst + 8 * c) = w; }
                }
                for (int i = F.bid * 512 + F.tid; i < MTOK * 32; i += F.G * 512) {
                    const int row = i & (MTOK - 1), j = i >> 14, oc = j & 7, hd = j >> 3, b = row >> 12, s = row & 4095;
                    const bf16x8 v = ldg8(ZS + (size_t)row * ZSW + C_VD + hd * 64 + oc * 8);
                    bf16_t* vd = VDT + ((size_t)(b * 4 + hd) * 64 + oc * 8) * SEQ + s;
#pragma unroll
                    for (int e = 0; e < 8; ++e) vd[(size_t)e * SEQ] = (bf16_t)v[e];
                }
            }
            if (SUB(3)) {
                float* LA = (float*)(ws + WS_LA); float* LI = (float*)(ws + WS_LI); float* LSA = (float*)(ws + WS_LSUM); float* LSH = LSA + NB * 128 * 256;
                const float* cw = INF(26) + l * 4 * 256; const float* cb = INF(27) + l * 256; const float* br = INF(29) + l * 256; const float* bi = INF(31) + l * 256;
                const float* c8 = MISCT + l * 256;
                LAS float* lsa = (LAS float*)(F.lds + F.wave * 16384); LAS float* lsh = lsa + 32 * 64;
                for (int tk = F.gw; tk < NB * 128 * 4; tk += F.ngw) {
                    const int n = tk & 3, tile = (tk >> 2) & 127, b = tk >> 9, s = tile * 32 + r, row = b * SEQ + s, cbase = 64 * n;
                    bf16x8 xcb[4]; float xcf[4][8];
#pragma unroll
                    for (int ks = 0; ks < 4; ++ks) {
                        const int c0 = cbase + 16 * ks + 8 * hi;
#pragma unroll
                        for (int e = 0; e < 8; ++e) xcf[ks][e] = cb[c0 + e];
#pragma unroll
                        for (int k = 0; k < 4; ++k) { const int sr = s - 3 + k;
                            if (sr >= 0) { const bf16x8 xv = ldg8(ZS + (size_t)(b * SEQ + sr) * ZSW + C_XLRU + c0); const u32x4 w = *(const u32x4*)&xv; const float* wk = cw + k * 256 + c0;
                                xcf[ks][0] += wk[0] * bflo(w.x); xcf[ks][1] += wk[1] * bfhi(w.x); xcf[ks][2] += wk[2] * bflo(w.y); xcf[ks][3] += wk[3] * bfhi(w.y);
                                xcf[ks][4] += wk[4] * bflo(w.z); xcf[ks][5] += wk[5] * bfhi(w.z); xcf[ks][6] += wk[6] * bflo(w.w); xcf[ks][7] += wk[7] * bfhi(w.w); } }
                        u32x4 pw; pw.x = cvt_pk_bf16(xcf[ks][0], xcf[ks][1]); pw.y = cvt_pk_bf16(xcf[ks][2], xcf[ks][3]); pw.z = cvt_pk_bf16(xcf[ks][4], xcf[ks][5]); pw.w = cvt_pk_bf16(xcf[ks][6], xcf[ks][7]); xcb[ks] = *(bf16x8*)&pw;
                    }
                    const bf16_t* Wr = (const bf16_t*)(WLP(l) + WL_SM + SM_WR) + n * 4096; const bf16_t* Wi = (const bf16_t*)(WLP(l) + WL_SM + SM_WI) + n * 4096;
                    f32x16 ar_[2] = {f32x16{}, f32x16{}}, ai_[2] = {f32x16{}, f32x16{}};
#pragma unroll
                    for (int ft = 0; ft < 2; ++ft)
#pragma unroll
                        for (int ks = 0; ks < 4; ++ks) { ar_[ft] = MFMA32(ldg8(Wr + (32 * ft + r) * 64 + 16 * ks + 8 * hi), xcb[ks], ar_[ft]); ai_[ft] = MFMA32(ldg8(Wi + (32 * ft + r) * 64 + 16 * ks + 8 * hi), xcb[ks], ai_[ft]); }
                    float xloc[4][4], xrcv[4][4];
#pragma unroll
                    for (int ks = 0; ks < 4; ++ks)
#pragma unroll
                        for (int j = 0; j < 4; ++j) { xloc[ks][j] = hi ? xcf[ks][4 + j] : xcf[ks][j]; const float snd = hi ? xcf[ks][j] : xcf[ks][4 + j]; xrcv[ks][j] = __shfl_xor(snd, 32); }
#pragma unroll
                    for (int ft = 0; ft < 2; ++ft)
#pragma unroll
                        for (int rg = 0; rg < 4; ++rg) {
                            const int c0 = cbase + 32 * ft + 8 * rg + 4 * hi, ks = 2 * ft + (rg >> 1);
                            f32x4 av, iv;
#pragma unroll
                            for (int e = 0; e < 4; ++e) { const float xce = ((rg & 1) == hi) ? xloc[ks][e] : xrcv[ks][e];
                                const float rr = fsigmoid(ar_[ft][4 * rg + e] + br[c0 + e]), ii = fsigmoid(ai_[ft][4 * rg + e] + bi[c0 + e]);
                                const float la = -rr * c8[c0 + e]; const float a = fexp2(la * LOG2E); av[e] = a; iv[e] = sqrtf(fmaxf(1.f - a * a, 0.f)) * ii * xce; }
                            *(f32x4*)(LA + (size_t)row * 256 + c0) = av; *(f32x4*)(LI + (size_t)row * 256 + c0) = iv;
                            { const int sc_ = (32 * ft + 8 * rg + 4 * hi) ^ ((r & 7) << 2); *(LAS f32x4*)(lsa + r * 64 + sc_) = av; *(LAS f32x4*)(lsh + r * 64 + sc_) = iv; }
                        }
                    asm volatile("s_waitcnt lgkmcnt(0)" ::: "memory");
                    {
                        float ta = 1.f, th = 0.f;
#pragma unroll
                        for (int t = 0; t < 32; ++t) { const float a_ = lsa[t * 64 + (lane ^ ((t & 7) << 2))], h_ = lsh[t * 64 + (lane ^ ((t & 7) << 2))]; th = a_ * th + h_; ta = ta * a_; }
                        LSA[(size_t)(b * 128 + tile) * 256 + cbase + lane] = ta; LSH[(size_t)(b * 128 + tile) * 256 + cbase + lane] = th;
                    }
                    asm volatile("s_waitcnt lgkmcnt(0)" ::: "memory");
                }
            }
            if (SUB(4)) {
                float* S5S = (float*)(ws + WS_S5S);
                const int t5cnt = F.wave < 4 ? 1 : (F.wave == 4 ? 0 : 4), t5off = F.wave < 4 ? F.wave : 4 + 4 * (F.wave - 5);
                for (int tbk = F.bid; tbk < NB * 64; tbk += F.G) for (int tj = 0; tj < t5cnt; ++tj) { const int tk = tbk * 16 + t5off + tj;
                    const int g = tk & 15, ch = (tk >> 4) & 63, b = tk >> 10;
                    const float* tb = S5T + (size_t)(l * 16 + g) * 36 * 64 + lane;
                    const float ar = tb[32 * 64], ai = tb[33 * 64];
                    LAS unsigned char* tile = F.lds + F.wave * 16384;
                    float hr = 0.f, hi2 = 0.f;
#pragma unroll 1
                    for (int hf = 0; hf < 2; ++hf) {
                        s5_bu_tile(tile, BBF + (size_t)(l * 16 + g) * 128 * 16, ZS + (size_t)(b * SEQ + ch * 64 + hf * 32) * ZSW + C_S5 + 16 * g, lane);
#pragma unroll 8
                        for (int t2 = 0; t2 < 32; ++t2) { const float bur = bf2f(*(const LAS bf16_t*)(tile + t2 * 272 + lane * 2)), bui = bf2f(*(const LAS bf16_t*)(tile + t2 * 272 + 128 + lane * 2));
                            const float nr = ar * hr - ai * hi2 + bur, ni = ar * hi2 + ai * hr + bui; hr = nr; hi2 = ni; }
                        asm volatile("s_waitcnt lgkmcnt(0)" ::: "memory");
                    }
                    float* dst = S5S + ((size_t)((b * 64 + ch) * 16 + g) * 2) * 64 + lane; dst[0] = hr; dst[64] = hi2;
                }
            }
            if (SUB(5) && l == 0) {
                bf16_t* KX = (bf16_t*)(ws + WS_KX); bf16_t* VXT = (bf16_t*)(ws + WS_VXT);
                if (F.wave == 4) for (int tk = F.bid; tk < 2 * 32 * 4; tk += F.G) {
                    const int hd = tk & 3, mt = (tk >> 2) & 31, ly = tk >> 7, row = mt * 32 + r, b = row >> 8, jm = row & 255;
                    const bf16_t* W = (const bf16_t*)(ws + WS_WL + ly * WL_STRIDE + WL_WXKV);
                    f32x16 acc[4] = {f32x16{}, f32x16{}, f32x16{}, f32x16{}}; float ss = 0.f;
                    const float* mp = INF(1) + (size_t)row * DM + 8 * hi;
#pragma unroll 2
                    for (int ks = 0; ks < 64; ++ks) {
                        const f32x4 m0 = *(const f32x4*)(mp + 16 * ks), m1 = *(const f32x4*)(mp + 16 * ks + 4);
                        ss += (m0.x * m0.x + m0.y * m0.y) + (m0.z * m0.z + m0.w * m0.w) + (m1.x * m1.x + m1.y * m1.y) + (m1.z * m1.z + m1.w * m1.w);
                        const u32x4 pw = pg8::pack8(m0, m1); const bf16x8 xb = *(const bf16x8*)&pw;
#pragma unroll
                        for (int f = 0; f < 4; ++f) { const int wrow = (f < 2 ? 64 * hd + 32 * f : 256 + 64 * hd + 32 * (f - 2)) + r; acc[f] = MFMA32(ldg8(W + (size_t)wrow * DM + 16 * ks + 8 * hi), xb, acc[f]); }
                    }
                    ss += __shfl_xor(ss, 32); const float rm = frsq(ss * (1.f / DM) + EPS);
                    float s2 = 0.f;
#pragma unroll
                    for (int f = 0; f < 2; ++f)
#pragma unroll
                        for (int q = 0; q < 16; ++q) { acc[f][q] *= rm; s2 += acc[f][q] * acc[f][q]; }
                    s2 += __shfl_xor(s2, 32); const float rk = frsq(s2 * (1.f / 64.f) + EPS);
                    const float* gk = INF(47) + ly * 64;
                    bf16_t* kd = KX + ((size_t)(ly * 16 + b * 4 + hd) * 256 + jm) * 64;
#pragma unroll
                    for (int f = 0; f < 2; ++f)
#pragma unroll
                        for (int rg = 0; rg < 4; ++rg) { const float* gp = gk + 32 * f + 8 * rg + 4 * hi; u32x2 w;
                            w.x = cvt_pk_bf16(acc[f][4 * rg] * rk * gp[0], acc[f][4 * rg + 1] * rk * gp[1]); w.y = cvt_pk_bf16(acc[f][4 * rg + 2] * rk * gp[2], acc[f][4 * rg + 3] * rk * gp[3]);
                            *(u32x2*)(kd + 32 * f + 8 * rg + 4 * hi) = w; }
                    bf16_t* vd = VXT + (size_t)(ly * 16 + b * 4 + hd) * 64 * 256 + jm;
#pragma unroll
                    for (int f = 2; f < 4; ++f)
#pragma unroll
                        for (int q = 0; q < 16; ++q) vd[(size_t)(32 * (f - 2) + crow(q, hi)) * 256] = f2bf(acc[f][q] * rm);
                }
            }
        }
        SEAM(pb + 1);
        if (IN(pb + 2)) {
            if (SUB(6)) { PHASE_BEGIN();
            const int lane = F.lane, r32 = lane & 31, hi = lane >> 5, wid = F.wave;
            volatile LAS unsigned* qslot = (volatile LAS unsigned*)(F.lds + MISC_OFF + 64);
            for (int it = queue_pull(F.ctl + CW_Q + 64 * (4 * l + 0), qslot, F.tid); it < 256; it = queue_pull(F.ctl + CW_Q + 64 * (4 * l + 0), qslot, F.tid)) {
                {
                    const int bh = it & 15, qt = 15 - (it >> 4), b = bh >> 2, hd = bh & 3;
                    const bf16_t* QM = (const bf16_t*)(ws + WS_QM) + (size_t)bh * SEQ * 96; const bf16_t* KM = (const bf16_t*)(ws + WS_KM) + (size_t)bh * SEQ * 96;
                    const bf16_t* VMT = (const bf16_t*)(ws + WS_VMT) + (size_t)bh * 64 * SEQ;
                    f32x16 o[1][2]; float lsum[1];
                    attn_unit<96, 1, true, false, false>(F.lds, QM + (size_t)qt * 256 * 96, 96, KM, VMT, SEQ, 4 * (qt + 1), 256 * qt, nullptr, nullptr, 1.f, MISCT[516 + l * 4 + 0], o, lsum);
                    const int row = b * SEQ + qt * 256 + wid * 32 + r32;
                    attn_store(YB + (size_t)1 * MTOK * 256 + (size_t)row * 256 + hd * 64, o[0], frcp(lsum[0]), hi);
                }
            } }
            if (SUB(7)) { PHASE_BEGIN();
            const int lane = F.lane, r32 = lane & 31, hi = lane >> 5, wid = F.wave;
            LAS float* lut = (LAS float*)(F.lds + 106496);
            for (int i = F.tid; i < 4 * 384; i += 512) lut[i] = MISCT[1024 + i];
            __syncthreads();
            volatile LAS unsigned* qslot = (volatile LAS unsigned*)(F.lds + MISC_OFF + 64);
            for (int it = queue_pull(F.ctl + CW_Q + 64 * (4 * l + 1), qslot, F.tid); it < 256; it = queue_pull(F.ctl + CW_Q + 64 * (4 * l + 1), qslot, F.tid)) {
                {
                    const int bh = it & 15, qt = 15 - (it >> 4), b = bh >> 2, hd = bh & 3;
                    const bf16_t* QD = (const bf16_t*)(ws + WS_QD) + (size_t)bh * SEQ * 64; const bf16_t* KD = (const bf16_t*)(ws + WS_KD) + (size_t)bh * SEQ * 64;
                    const bf16_t* VDT = (const bf16_t*)(ws + WS_VDT) + (size_t)bh * 64 * SEQ;
                    f32x16 o[2][2]; float lsum[2];
                    attn_unit<64, 2, true, true, false>(F.lds, QD + (size_t)qt * 256 * 64, 64, KD, VDT, SEQ, 4 * (qt + 1), 256 * qt, lut + hd * 384, nullptr, 1.f, MISCT[516 + l * 4 + 1], o, lsum);
                    const float lam = MISCT[512 + l], lam_init = MISCT[514 + l];
                    const float i1 = frcp(lsum[0]), i2 = lam * frcp(lsum[1]); float ss = 0.f;
#pragma unroll
                    for (int dt = 0; dt < 2; ++dt)
#pragma unroll
                        for (int q = 0; q < 16; ++q) { const float v = o[0][dt][q] * i1 - o[1][dt][q] * i2; o[0][dt][q] = v; ss += v * v; }
                    ss += __shfl_xor(ss, 32); const float rs = frsq(ss * (1.f / 64.f) + EPS) * (1.f - lam_init);
                    const float* gs = INF(39) + l * 64;
#pragma unroll
                    for (int dt = 0; dt < 2; ++dt)
#pragma unroll
                        for (int q = 0; q < 16; ++q) o[0][dt][q] *= gs[32 * dt + crow(q, hi)];
                    const int row = b * SEQ + qt * 256 + wid * 32 + r32;
                    attn_store(YB + (size_t)3 * MTOK * 256 + (size_t)row * 256 + hd * 64, o[0], rs, hi);
                }
            } }
            if (SUB(8)) { PHASE_BEGIN();
            const int lane = F.lane, r32 = lane & 31, hi = lane >> 5, wid = F.wave;
            volatile LAS unsigned* qslot = (volatile LAS unsigned*)(F.lds + MISC_OFF + 64);
            for (int it = queue_pull(F.ctl + CW_Q + 64 * (4 * l + 2), qslot, F.tid); it < 256; it = queue_pull(F.ctl + CW_Q + 64 * (4 * l + 2), qslot, F.tid)) {
                {
                    const int b = it >> 6, ch = it & 63, row0 = b * SEQ + ch * 64;
                    LAS unsigned char* hbuf = F.lds + wid * 8704;
                    LAS unsigned char* ypre = F.lds + 69632;
                    const float* S5S = (const float*)(ws + WS_S5S);
#pragma unroll 1
                    for (int gg = 0; gg < 2; ++gg) {
                        const int g = 2 * wid + gg;
                        const float* tb = S5T + (size_t)(l * 16 + g) * 36 * 64 + lane;
                        const float ar = tb[32 * 64], ai = tb[33 * 64], a64r = tb[34 * 64], a64i = tb[35 * 64];
                        float hr = 0.f, hi2 = 0.f;
                        for (int c0 = 0; c0 < ch; c0 += 8) {
                            float sr[8], si[8];
#pragma unroll
                            for (int u = 0; u < 8; ++u) { const int c = c0 + u; const bool ok = c < ch; const float* sp = S5S + ((size_t)((b * 64 + (ok ? c : 0)) * 16 + g) * 2) * 64 + lane; sr[u] = ok ? sp[0] : 0.f; si[u] = ok ? sp[64] : 0.f; }
#pragma unroll
                            for (int u = 0; u < 8; ++u) { if (c0 + u < ch) { const float nr = a64r * hr - a64i * hi2 + sr[u], ni = a64r * hi2 + a64i * hr + si[u]; hr = nr; hi2 = ni; } }
                        }
                        bf16x8 cf[4];
#pragma unroll
                        for (int ks = 0; ks < 4; ++ks) cf[ks] = ldg8(CMAT + (size_t)(l * 16 + g) * 16 * 128 + (lane & 15) * 128 + 32 * ks + 8 * (lane >> 4));
                        const float* dsk = INF(17) + l * 256 + 16 * g + 4 * (lane >> 4);
#pragma unroll 1
                        for (int hf = 0; hf < 2; ++hf) {
                            s5_bu_tile(hbuf, BBF + (size_t)(l * 16 + g) * 128 * 16, ZS + (size_t)(row0 + hf * 32) * ZSW + C_S5 + 16 * g, lane);
#pragma unroll 8
                            for (int t2 = 0; t2 < 32; ++t2) { const float bur = bf2f(*(const LAS bf16_t*)(hbuf + t2 * 272 + lane * 2)), bui = bf2f(*(const LAS bf16_t*)(hbuf + t2 * 272 + 128 + lane * 2));
                                const float nr = ar * hr - ai * hi2 + bur, ni = ar * hi2 + ai * hr + bui; hr = nr; hi2 = ni;
                                *(LAS bf16_t*)(hbuf + t2 * 272 + lane * 2) = f2bf(hr); *(LAS bf16_t*)(hbuf + t2 * 272 + 128 + lane * 2) = f2bf(hi2);
                            }
                            asm volatile("s_waitcnt lgkmcnt(0)" ::: "memory");
#pragma unroll
                            for (int tq = 0; tq < 2; ++tq) {
                                f32x4 yv = (f32x4){0.f, 0.f, 0.f, 0.f};
#pragma unroll
                                for (int ks = 0; ks < 4; ++ks) { const bf16x8 hb = *(const LAS bf16x8*)(hbuf + (16 * tq + (lane & 15)) * 272 + (32 * ks + 8 * (lane >> 4)) * 2); yv = MFMA16(cf[ks], hb, yv); }
                                const int tl = hf * 32 + 16 * tq + (lane & 15);
                                const u32x2 uw = *(const u32x2*)(ZS + (size_t)(row0 + tl) * ZSW + C_S5 + 16 * g + 4 * (lane >> 4));
                                yv[0] = fgelu(yv[0] + dsk[0] * bflo(uw.x)); yv[1] = fgelu(yv[1] + dsk[1] * bfhi(uw.x)); yv[2] = fgelu(yv[2] + dsk[2] * bflo(uw.y)); yv[3] = fgelu(yv[3] + dsk[3] * bfhi(uw.y));
                                u32x2 pw; pw.x = cvt_pk_bf16(yv[0], yv[1]); pw.y = cvt_pk_bf16(yv[2], yv[3]);
                                *(LAS u32x2*)(ypre + tl * 528 + (16 * g + 4 * (lane >> 4)) * 2) = pw;
                            }
                            asm volatile("s_waitcnt lgkmcnt(0)" ::: "memory");
                        }
                    }
                    __syncthreads();
                    {
                        const bf16_t* WG = (const bf16_t*)(WLP(l) + WL_SM + SM_WGLU);
                        f32x16 acc[2] = {f32x16{}, f32x16{}};
#pragma unroll 4
                        for (int ks = 0; ks < 16; ++ks) { const bf16x8 a = ldg8(WG + (size_t)(32 * wid + r32) * 256 + 16 * ks + 8 * hi);
#pragma unroll
                            for (int tt = 0; tt < 2; ++tt) acc[tt] = MFMA32(a, *(const LAS bf16x8*)(ypre + (32 * tt + r32) * 528 + (16 * ks + 8 * hi) * 2), acc[tt]); }
                        const float* bg = INF(19) + l * 256;
#pragma unroll
                        for (int tt = 0; tt < 2; ++tt)
#pragma unroll
                            for (int rg = 0; rg < 4; ++rg) { const int n0 = 32 * wid + 8 * rg + 4 * hi, t = 32 * tt + r32;
                                const u32x2 yw = *(const LAS u32x2*)(ypre + t * 528 + n0 * 2); u32x2 ow;
                                ow.x = cvt_pk_bf16(bflo(yw.x) * fsigmoid(acc[tt][4 * rg] + bg[n0]), bfhi(yw.x) * fsigmoid(acc[tt][4 * rg + 1] + bg[n0 + 1]));
                                ow.y = cvt_pk_bf16(bflo(yw.y) * fsigmoid(acc[tt][4 * rg + 2] + bg[n0 + 2]), bfhi(yw.y) * fsigmoid(acc[tt][4 * rg + 3] + bg[n0 + 3]));
                                *(u32x2*)(YB + (size_t)(row0 + t) * 256 + n0) = ow; }
                    }
                    __syncthreads();
                }
            }
            }
            if (SUB(9)) { PHASE_BEGIN(); const int lane = F.lane;
                const float* LA = (const float*)(ws + WS_LA); const float* LI = (const float*)(ws + WS_LI); const float* LSA = (const float*)(ws + WS_LSUM); const float* LSH = LSA + NB * 128 * 256;
                volatile LAS unsigned* qslot = (volatile LAS unsigned*)(F.lds + MISC_OFF + 64);
                for (int it = queue_pull(F.ctl + CW_Q + 64 * (4 * l + 3), qslot, F.tid); it < NB * 64 * 4 / 8; it = queue_pull(F.ctl + CW_Q + 64 * (4 * l + 3), qslot, F.tid)) {
                    const int tk = (NB * 64 * 4 / 8 - 1 - it) * 8 + F.wave;
                    const int n = tk & 3, ch = (tk >> 2) & 63, b = tk >> 8, c = 64 * n + lane;
                    float h = 0.f;
                    for (int tp0 = 0; tp0 < 2 * ch; tp0 += 16) {
                        float ca[16], chh[16];
#pragma unroll
                        for (int u = 0; u < 16; ++u) { const int tp = tp0 + u; const bool ok = tp < 2 * ch; const size_t o = (size_t)(b * 128 + (ok ? tp : 0)) * 256 + c; ca[u] = ok ? LSA[o] : 1.f; chh[u] = ok ? LSH[o] : 0.f; }
#pragma unroll
                        for (int u = 0; u < 16; ++u) h = ca[u] * h + chh[u];
                    }
                    const int row0 = b * SEQ + ch * 64;
#pragma unroll 1
                    for (int t0 = 0; t0 < 64; t0 += 16) {
                        float la[16], li[16], gt[16];
#pragma unroll
                        for (int u = 0; u < 16; ++u) { const size_t o = (size_t)(row0 + t0 + u) * 256 + c; la[u] = LA[o]; li[u] = LI[o]; gt[u] = bf2f(ZS[(size_t)(row0 + t0 + u) * ZSW + C_GLRU + c]); }
#pragma unroll
                        for (int u = 0; u < 16; ++u) { h = la[u] * h + li[u]; gt[u] = h * fgelu(gt[u]); }
#pragma unroll
                        for (int u = 0; u < 16; ++u) YB[(size_t)2 * MTOK * 256 + (size_t)(row0 + t0 + u) * 256 + c] = f2bf(gt[u]);
                    }
                }
            }
        }
        SEAM(pb + 2);
        if (IN(pb + 3)) { PHASE_BEGIN();
            pg8::Gemm g{YB, (const bf16_t*)(WLP(l) + WL_PT), 256, nullptr}; pg8::MergeOrder S{F.G, F.bid};
            pg8::EpiMerge E{MG, ZG};
            pg8::gemm_phase<pg8::EpiMerge, pg8::MergeOrder, true, false>(F.lds, g, S, E);
        }
        SEAM(pb + 3);
        if (IN(pb + 4)) { PHASE_BEGIN();
            pg8::Gemm g{MG, (const bf16_t*)(WLP(l) + WL_WO), DM, nullptr}; pg8::StaticOrder S; S.init(MTOK / 256, DM / 256, F.G, F.bid);
            pg8::EpiRes<false> E{nullptr, XB, RS + (size_t)(l == 0 ? 1 : 4) * MTOK * 16, nullptr};
            pg8::gemm_phase<pg8::EpiRes<false>, pg8::StaticOrder, false, false>(F.lds, g, S, E);
        }
        SEAM(pb + 4);
        if (IN(pb + 5)) { PHASE_BEGIN();
            pg8::Gemm g{XB, (const bf16_t*)(WLP(l) + WL_WXQ), DM, nullptr}; pg8::StaticOrder S; S.init(MTOK / 256, 1, F.G, F.bid);
            pg8::EpiRowScale E{(bf16_t*)(ws + WS_QX), 256, RS + (size_t)(l == 0 ? 1 : 4) * MTOK * 16};
            pg8::gemm_phase<pg8::EpiRowScale, pg8::StaticOrder, false, false>(F.lds, g, S, E);
        }
        SEAM(pb + 5);
        if (IN(pb + 6)) { PHASE_BEGIN();
            const int lane = F.lane, r32 = lane & 31, hi = lane >> 5, wid = F.wave;
            for (int it = F.bid; it < 256; it += F.G) {
                const int hd = it & 3, rt = it >> 2, b = rt >> 4;
                const bf16_t* QX = (const bf16_t*)(ws + WS_QX) + (size_t)rt * 256 * 256 + hd * 64;
                const bf16_t* KX = (const bf16_t*)(ws + WS_KX) + (size_t)(l * 16 + b * 4 + hd) * 256 * 64;
                const bf16_t* VXT = (const bf16_t*)(ws + WS_VXT) + (size_t)(l * 16 + b * 4 + hd) * 64 * 256;
                f32x16 o[1][2]; float lsum[1];
                attn_unit<64, 1, false, false, true>(F.lds, QX, 256, KX, VXT, 256, 4, 0, nullptr, INF(46) + l * 64, 0.125f * LOG2E, MISCT[516 + l * 4 + 2], o, lsum);
                const int row = rt * 256 + wid * 32 + r32;
                attn_store((bf16_t*)(ws + WS_OX) + (size_t)row * 256 + hd * 64, o[0], frcp(lsum[0]), hi);
            }
        }
        SEAM(pb + 6);
        if (IN(pb + 7)) { PHASE_BEGIN();
            pg8::Gemm g{(const bf16_t*)(ws + WS_OX), (const bf16_t*)(WLP(l) + WL_WXO), 256, nullptr}; pg8::StaticOrder S; S.init(MTOK / 256, DM / 256, F.G, F.bid);
            if (l == 0) { pg8::EpiRes<false> E{nullptr, XB, RS + (size_t)2 * MTOK * 16, nullptr}; pg8::gemm_phase<pg8::EpiRes<false>, pg8::StaticOrder, false, false>(F.lds, g, S, E); }
            else { pg8::EpiRes<false> E{nullptr, XB, RS + (size_t)5 * MTOK * 16, nullptr}; pg8::gemm_phase<pg8::EpiRes<false>, pg8::StaticOrder, false, false>(F.lds, g, S, E); }
        }
        SEAM(pb + 7);
        if (l == 0) {
            if (IN(9)) { PHASE_BEGIN();
                pg8::Gemm g{XB, (const bf16_t*)(ws + WS_WGU), DM, nullptr}; pg8::StaticOrder S; S.init(MTOK / 256, 2 * FF / 256, F.G, F.bid);
#if G2_FP8
                pg8::EpiSwiGLU8<true, false> E{ws + WS_HFF, FF, RS + (size_t)2 * MTOK * 16};
                pg8::gemm_phase<pg8::EpiSwiGLU8<true, false>, pg8::StaticOrder, true, false>(F.lds, g, S, E);
#else
                pg8::EpiSwiGLU<false> E{(bf16_t*)(ws + WS_HFF), FF, RS + (size_t)2 * MTOK * 16, nullptr};
                pg8::gemm_phase<pg8::EpiSwiGLU<false>, pg8::StaticOrder, true, false>(F.lds, g, S, E);
#endif
            }
            SEAM(9);
            if (IN(10)) { PHASE_BEGIN();
#if G2_FP8
                pg8::Gemm g{(const bf16_t*)(ws + WS_HFF), (const bf16_t*)(ws + WS_WD), FF / 2, nullptr}; pg8::StaticOrder S; S.init(MTOK / 256, DM / 256, F.G, F.bid);
                pg8::EpiRes<false, false, true> E{nullptr, XB, RS + (size_t)3 * MTOK * 16, nullptr};
                pg8::gemm_phase<pg8::EpiRes<false, false, true>, pg8::StaticOrder, false, false, true>(F.lds, g, S, E);
#else
                pg8::Gemm g{(const bf16_t*)(ws + WS_HFF), (const bf16_t*)(ws + WS_WD), FF, nullptr}; pg8::StaticOrder S; S.init(MTOK / 256, DM / 256, F.G, F.bid);
                pg8::EpiRes<false> E{nullptr, XB, RS + (size_t)3 * MTOK * 16, nullptr};
                pg8::gemm_phase<pg8::EpiRes<false>, pg8::StaticOrder, false, false>(F.lds, g, S, E);
#endif
            }
            SEAM(10);
        } else {
#define ROWTOK ((int*)(ws + WS_MOESM + MS_ROWTOK))
#define TOKW ((float*)(ws + WS_MOESM + MS_TOKW))
#define ASSIGN ((int*)(ws + WS_MOESM + MS_ASSIGN))
#define RSTD2 ((float*)(ws + WS_MOESM + MS_RSTD))
#define MCNT (F.ctl + CW_MOECNT)
            if (IN(19)) { PHASE_BEGIN();
                LAS float* wrs = (LAS float*)(F.lds);
                for (int i = F.tid; i < 8192; i += 512) wrs[i] = INF(51)[i] * INF(7)[DM + (i >> 3)];
                __syncthreads();
                if (SUB(10) && F.wave < 4) {
                    const int lane = F.lane;
                    for (int blk = F.bid; blk < 256; blk += F.G) {
                        unsigned cntv = 0u, mypack = 0u;
#pragma unroll 1
                        for (int j = 0; j < 16; ++j) {
                            const int tok = blk * 64 + F.wave * 16 + j;
                            const u32x2* xr = (const u32x2*)(XB + (size_t)tok * DM) + lane;
                            float lg[8] = {0.f, 0.f, 0.f, 0.f, 0.f, 0.f, 0.f, 0.f}; float ss = 0.f; f32x4 xv4[4];
#pragma unroll
                            for (int q = 0; q < 4; ++q) { const u32x2 xw = xr[64 * q]; const f32x4 v = {bflo(xw.x), bfhi(xw.x), bflo(xw.y), bfhi(xw.y)}; const int k0 = 256 * q + 4 * lane; xv4[q] = v;
                                ss += (v.x * v.x + v.y * v.y) + (v.z * v.z + v.w * v.w);
#pragma unroll
                                for (int e4 = 0; e4 < 4; ++e4) { const float xv = v[e4]; const LAS f32x4* wp = (const LAS f32x4*)(wrs + (k0 + e4) * 8); const f32x4 wa = wp[0], wb = wp[1];
                                    lg[0] += xv * wa.x; lg[1] += xv * wa.y; lg[2] += xv * wa.z; lg[3] += xv * wa.w; lg[4] += xv * wb.x; lg[5] += xv * wb.y; lg[6] += xv * wb.z; lg[7] += xv * wb.w; } }
                            ss = wave_sum(ss);
#pragma unroll
                            for (int e = 0; e < 8; ++e) lg[e] = wave_sum(lg[e]);
                            const float rstd = frsq(ss * (1.f / DM) + EPS);
                            { unsigned* xq = (unsigned*)(ws + WS_XQ + (size_t)tok * DM) + lane;
#pragma unroll
                              for (int q = 0; q < 4; ++q) xq[64 * q] = cvt_pk4_fp8(xv4[q].x * rstd, xv4[q].y * rstd, xv4[q].z * rstd, xv4[q].w * rstd); }
                            int e1 = 0; float v1 = lg[0];
#pragma unroll
                            for (int e = 1; e < 8; ++e) if (lg[e] > v1) { v1 = lg[e]; e1 = e; }
                            int e2 = -1; float v2 = -3.4e38f;
#pragma unroll
                            for (int e = 0; e < 8; ++e) if (e != e1 && lg[e] > v2) { v2 = lg[e]; e2 = e; }
                            if (e2 < 0) e2 = (e1 + 1) & 7;
                            const int se1 = __builtin_amdgcn_readfirstlane(e1), se2 = __builtin_amdgcn_readfirstlane(e2);
                            const unsigned r1 = __builtin_amdgcn_readlane(cntv, se1), r2 = __builtin_amdgcn_readlane(cntv, se2);
                            cntv += (lane == se1 ? 1u : 0u) + (lane == se2 ? 1u : 0u);
                            if (lane == j) mypack = (unsigned)se1 | (r1 << 4) | ((unsigned)se2 << 12) | (r2 << 16);
                            if (lane == 0) { const float w1 = frcp(1.f + __expf((v2 - v1) * rstd)); RSTD2[tok] = rstd; TOKW[tok * 2] = w1; TOKW[tok * 2 + 1] = 1.f - w1; }
                        }
                        unsigned basev = 0u;
                        if (lane < 8) basev = __hip_atomic_fetch_add(MCNT + 64 * lane, cntv, __ATOMIC_RELAXED, __HIP_MEMORY_SCOPE_AGENT);
                        const int pe1 = mypack & 15, pr1 = (mypack >> 4) & 255, pe2 = (mypack >> 12) & 15, pr2 = (mypack >> 16) & 255;
                        const unsigned b1 = __shfl(basev, pe1), b2 = __shfl(basev, pe2);
                        if (lane < 16) { const int tok = blk * 64 + F.wave * 16 + lane; ASSIGN[tok * 2] = pe1 | (int)((b1 + (unsigned)pr1) << 8); ASSIGN[tok * 2 + 1] = pe2 | (int)((b2 + (unsigned)pr2) << 8);
                            ROWTOK[pe1 * 16384 + (int)(b1 + (unsigned)pr1)] = tok; ROWTOK[pe2 * 16384 + (int)(b2 + (unsigned)pr2)] = tok; }
                    }
                }
                if (SUB(11)) {
                    LAS float* scr = (LAS float*)(F.lds + 40960 + F.wave * 8448);
                    const TJob j0{INF(52), (bf16_t*)(ws + WS_WMGU), INF(7) + DM, DM, EFF, EFF, DM, 8, 2, (size_t)DM * EFF, (size_t)2 * EFF * DM, 1};
                    const TJob j1{INF(53), (bf16_t*)(ws + WS_WMGU), INF(7) + DM, DM, EFF, EFF, DM, 8, 3, (size_t)DM * EFF, (size_t)2 * EFF * DM, 1};
                    const TJob j2{INF(54), (bf16_t*)(ws + WS_WMD), nullptr, EFF, DM, DM, EFF, 8, 0, (size_t)EFF * DM, (size_t)DM * EFF, 1};
                    constexpr int NI = 8 * (DM / 64) * (EFF / 32);
                    LAS unsigned* qc = (LAS unsigned*)(F.lds + MISC_OFF + 128);
                    const int wg_items = (3 * NI - F.bid + F.G - 1) / F.G;
#define H0_PULL() h0_pull(qc, F.lane, wg_items, F.bid, F.G, 3 * NI)
#define H0_JOB(idx) const int jn_ = (idx) / NI; TJob js_ = j0; if (jn_ == 1) { js_.W = j1.W; js_.map = 3; } if (jn_ == 2) js_ = j2;
#define H0_LOAD(idx, v) do { H0_JOB(idx) tjob_load(js_, (idx) - jn_ * NI, v, F.lane); } while (0)
#define H0_STORE(idx, v) do { H0_JOB(idx) tjob_store(js_, (idx) - jn_ * NI, v, scr, F.lane); } while (0)
                    float va[32] = {}, vb[32] = {}; int it = H0_PULL();
                    if (it < 3 * NI) { H0_LOAD(it, va);
                        for (;;) {
                            const int n1 = H0_PULL(); if (n1 < 3 * NI) H0_LOAD(n1, vb);
                            H0_STORE(it, va); if (n1 >= 3 * NI) break;
                            const int n2 = H0_PULL(); if (n2 < 3 * NI) H0_LOAD(n2, va);
                            H0_STORE(n1, vb); if (n2 >= 3 * NI) break;
                            it = n2;
                        } }
#undef H0_PULL
#undef H0_JOB
#undef H0_LOAD
#undef H0_STORE
                }
            }
            SEAM(19);
            if (IN(21)) { PHASE_BEGIN();
                pg8::Gemm g{(const bf16_t*)(ws + WS_XQ), (const bf16_t*)(ws + WS_WMGU), DM / 2, ROWTOK}; pg8::MoeOrder S; S.init(MCNT, 2 * EFF / 256, F.G, F.bid);
                pg8::EpiSwiGLU8<false> E{ws + WS_HMOE, EFF, nullptr};
                pg8::gemm_phase<pg8::EpiSwiGLU8<false>, pg8::MoeOrder, true, true, true>(F.lds, g, S, E);
            }
            SEAM(21);
            if (IN(22)) { PHASE_BEGIN();
                pg8::Gemm g{(const bf16_t*)(ws + WS_HMOE), (const bf16_t*)(ws + WS_WMD), EFF / 2, nullptr}; pg8::MoeOrder S; S.init(MCNT, DM / 256, F.G, F.bid);
                pg8::EpiPlain E{(bf16_t*)(ws + WS_YS), DM, 0.03125f};
                pg8::gemm_phase<pg8::EpiPlain, pg8::MoeOrder, true, false, true>(F.lds, g, S, E);
            }
            SEAM(22);
            if (IN(23)) { PHASE_BEGIN();
                const bf16_t* YS = (const bf16_t*)(ws + WS_YS);
                int pst[8]; { int acc = 0;
#pragma unroll
                    for (int e = 0; e < 8; ++e) { pst[e] = acc; acc += ((int)MCNT[64 * e] + 255) & ~255; } }
                for (int m = F.gw; m < MTOK; m += F.ngw) {
                    const int a1 = ASSIGN[2 * m], a2 = ASSIGN[2 * m + 1]; int p1 = 0, p2 = 0;
#pragma unroll
                    for (int q = 0; q < 8; ++q) { p1 = (q == (a1 & 255)) ? pst[q] : p1; p2 = (q == (a2 & 255)) ? pst[q] : p2; }
                    const int d1 = p1 + (a1 >> 8), d2 = p2 + (a2 >> 8); const float w1 = TOKW[2 * m], w2 = TOKW[2 * m + 1];
                    f32x4* xr = (f32x4*)(F.out + (size_t)m * DM) + F.lane; const u32x2* xbr = (const u32x2*)(XB + (size_t)m * DM) + F.lane;
                    const u32x2* y1 = (const u32x2*)(YS + (size_t)d1 * DM) + F.lane; const u32x2* y2 = (const u32x2*)(YS + (size_t)d2 * DM) + F.lane;
#pragma unroll
                    for (int j = 0; j < 4; ++j) { const u32x2 xw = xbr[64 * j]; f32x4 v = {bflo(xw.x), bfhi(xw.x), bflo(xw.y), bfhi(xw.y)}; const u32x2 a = y1[64 * j], c = y2[64 * j];
                        v.x += w1 * bflo(a.x) + w2 * bflo(c.x); v.y += w1 * bfhi(a.x) + w2 * bfhi(c.x); v.z += w1 * bflo(a.y) + w2 * bflo(c.y); v.w += w1 * bfhi(a.y) + w2 * bfhi(c.y);
                        xr[64 * j] = v; }
                }
            }
        }
    }
#undef IN
#undef SEAM
}

#ifdef DBG_DUMP_OFF
__global__ void dbg_copy_bf16(const bf16_t* src, float* out, int n, int nv) { for (int i = blockIdx.x * 256 + threadIdx.x; i < n; i += gridDim.x * 256) out[i] = i < nv ? bf2f(src[i]) : 0.f; }
#endif

#ifdef DBG_CHECK
struct DbgArgs { const void* in[55]; unsigned char* ws; float* out; float* acc; };
#ifndef DBG_LAYER
#define DBG_LAYER 0
#endif
__device__ __forceinline__ size_t dstride(int i) {
    switch (i) { case 4: case 5: case 6: case 7: case 10: case 11: case 26: return 1024; case 8: return (size_t)DM * DIN; case 9: return 4096; case 12: return 16;
      case 13: case 14: case 15: case 16: case 28: case 30: return 16384; case 17: case 19: case 27: case 29: case 31: case 32: return 256; case 18: case 23: return 65536; case 20: return 192; case 21: return 128;
      case 22: return 73728; case 24: case 25: return 96; case 33: case 34: case 35: case 36: case 37: case 38: return 32; case 39: case 46: case 47: return 64; case 40: return (size_t)4 * 256 * DM; case 41: return (size_t)DM * DM;
      case 42: case 43: case 44: case 45: return (size_t)DM * 256; default: return 0; } }
#define DIN_(i) ((const float*)a.in[i] + (size_t)DBG_LAYER * dstride(i))
#define DXIN_ (DBG_LAYER == 0 ? (const float*)a.in[0] : (const float*)(a.ws + WS_DBG))
constexpr size_t WS_DBG = 440 * MiB;
__device__ float blk_sum(float v, float* sh) { sh[threadIdx.x] = v; __syncthreads(); for (int o = 128; o > 0; o >>= 1) { if ((int)threadIdx.x < o) sh[threadIdx.x] += sh[threadIdx.x + o]; __syncthreads(); } const float r = sh[0]; __syncthreads(); return r; }
__device__ float blk_max(float v, float* sh) { sh[threadIdx.x] = v; __syncthreads(); for (int o = 128; o > 0; o >>= 1) { if ((int)threadIdx.x < o) sh[threadIdx.x] = fmaxf(sh[threadIdx.x], sh[threadIdx.x + o]); __syncthreads(); } const float r = sh[0]; __syncthreads(); return r; }
__device__ void dbg_acc(float* acc, int k, float fast, float ref) { atomicMax((unsigned*)&acc[2 * k], __float_as_uint(fabsf(fast - ref))); atomicAdd(&acc[2 * k + 1], ref * ref); atomicAdd(&acc[64 + k], 1.f); }
__device__ float dsig(float x) { return 1.f / (1.f + expf(-x)); }
__device__ float dgelu(float x) { return 0.5f * x * (1.f + tanhf(0.7978845608028654f * (x + 0.044715f * x * x * x))); }
__device__ int dbucket(int d) { if (d < 16) return d < 0 ? 0 : d; int bk = 16 + (int)(logf((float)d / 16.f) / logf(8.f) * 16.f); return bk > 31 ? 31 : bk; }

__global__ void chk_z(DbgArgs a) {
    __shared__ float sh[256]; const int s = blockIdx.x, tid = threadIdx.x; const int row = (s * 7919 + 13) % MTOK; int col = (s * 104729 + 7 + (s >> 1)) % DIN; if (s & 1) col = col % C_END;
    const float* x = (DBG_LAYER == 0 ? (const float*)a.in[0] : (const float*)a.out) + (size_t)row * DM; const float* g = DIN_(4); const float* W = DIN_(8);
    float ss = 0.f, dot = 0.f; for (int k = tid; k < DM; k += 256) { const float xv = x[k]; ss += xv * xv; dot += xv * g[k] * W[(size_t)k * DIN + col]; }
    ss = blk_sum(ss, sh); dot = blk_sum(dot, sh);
    if (tid == 0) { const float z = dot * rsqrtf(ss / DM + EPS);
        if (col < C_END) dbg_acc(a.acc, 1, bf2f(((const bf16_t*)(a.ws + WS_ZS))[(size_t)row * ZSW + col]), z);
        else { const int gc = col - C_END; dbg_acc(a.acc, 2, bf2f(((const bf16_t*)(a.ws + WS_ZG))[(size_t)row * ZGW + gc]), dsig(z + DIN_(9)[gc])); } }
}
__global__ void chk_mla_prep(DbgArgs a) {
    __shared__ float sh[256]; __shared__ float vn[192]; __shared__ float qs[128];
    const int s = blockIdx.x, tid = threadIdx.x, row = (s * 7919 + 13) % MTOK, hd = s & 3, b = row >> 12, sq = row & 4095;
    const bf16_t* ZSp = (const bf16_t*)(a.ws + WS_ZS) + (size_t)row * ZSW; const float pos = (float)((const int*)a.in[2])[row];
    { const float v = tid < 192 ? bf2f(ZSp[C_CQ + tid]) : 0.f; const float ss = blk_sum(v * v, sh); if (tid < 192) vn[tid] = v * rsqrtf(ss / 192.f + EPS) * DIN_(20)[tid]; __syncthreads(); }
    float qf = 0.f; if (tid < 96) for (int k = 0; k < 192; ++k) qf += vn[k] * DIN_(22)[k * 384 + hd * 96 + tid];
    { const float ss = blk_sum(tid < 96 ? qf * qf : 0.f, sh); if (tid < 96) qs[tid] = qf * rsqrtf(ss / 96.f + EPS) * DIN_(24)[tid]; __syncthreads(); }
    if (tid < 96) { float val = qs[tid]; if (tid >= 64) { const int i = (tid - 64) & 15; float sn, cs; sincos_red(pos * exp2f(-(float)i * (13.287712379549449f / 16.f)), sn, cs); const float x1 = qs[64 + i], x2 = qs[80 + i]; val = tid < 80 ? x1 * cs - x2 * sn : x1 * sn + x2 * cs; }
        val *= 0.10206207261596577f * LOG2E; dbg_acc(a.acc, 3, bf2f(((const bf16_t*)(a.ws + WS_QM))[((size_t)(b * 4 + hd) * SEQ + sq) * 96 + tid]), val); }
    __syncthreads();
    { const float v = tid < 128 ? bf2f(ZSp[C_CKV + tid]) : 0.f; const float ss = blk_sum(v * v, sh); if (tid < 128) vn[tid] = v * rsqrtf(ss / 128.f + EPS) * DIN_(21)[tid]; __syncthreads(); }
    float kv = 0.f; if (tid < 128) for (int k = 0; k < 128; ++k) kv += vn[k] * DIN_(23)[k * 512 + hd * 128 + tid];
    float kfull = 0.f; if (tid < 64) kfull = kv; else if (tid < 96) kfull = bf2f(ZSp[C_KPE + tid - 64]);
    { const float ss = blk_sum(tid < 96 ? kfull * kfull : 0.f, sh); if (tid < 96) qs[tid] = kfull * rsqrtf(ss / 96.f + EPS) * DIN_(25)[tid]; __syncthreads(); }
    if (tid < 96) { float val = qs[tid]; if (tid >= 64) { const int i = (tid - 64) & 15; float sn, cs; sincos_red(pos * exp2f(-(float)i * (13.287712379549449f / 16.f)), sn, cs); const float x1 = qs[64 + i], x2 = qs[80 + i]; val = tid < 80 ? x1 * cs - x2 * sn : x1 * sn + x2 * cs; }
        dbg_acc(a.acc, 4, bf2f(((const bf16_t*)(a.ws + WS_KM))[((size_t)(b * 4 + hd) * SEQ + sq) * 96 + tid]), val); }
    if (tid >= 64 && tid < 128) dbg_acc(a.acc, 5, bf2f(((const bf16_t*)(a.ws + WS_VMT))[((size_t)(b * 4 + hd) * 64 + tid - 64) * SEQ + sq]), kv);
}
__global__ void chk_diff_prep(DbgArgs a) {
    const int i = blockIdx.x * 256 + threadIdx.x; const int row = (i * 37 + 5) % MTOK, hd = i & 3, half = (i >> 2) & 1, isk = (i >> 3) & 1, b = row >> 12, sq = row & 4095;
    const bf16_t* src = (const bf16_t*)(a.ws + WS_ZS) + (size_t)row * ZSW + (isk ? C_KD : C_QD) + hd * 64 + half * 32;
    float ss = 0.f; for (int d = 0; d < 32; ++d) { const float v = bf2f(src[d]); ss += v * v; }
    const float rs = rsqrtf(ss / 32.f + EPS) * (isk ? 1.f : 0.17677669529663687f * LOG2E); const float* gg = DIN_(isk ? 34 : 33);
    const bf16_t* dst = (const bf16_t*)(a.ws + (isk ? WS_KD : WS_QD)) + ((size_t)(b * 4 + hd) * SEQ + sq) * 64 + half * 32;
    for (int d = 0; d < 32; ++d) dbg_acc(a.acc, 6, bf2f(dst[d]), bf2f(src[d]) * rs * gg[d]);
    const bf16_t* vs = (const bf16_t*)(a.ws + WS_ZS) + (size_t)row * ZSW + C_VD + hd * 64;
    for (int d = half * 32; d < half * 32 + 32; ++d) dbg_acc(a.acc, 7, bf2f(((const bf16_t*)(a.ws + WS_VDT))[((size_t)(b * 4 + hd) * 64 + d) * SEQ + sq]), bf2f(vs[d]));
}
__global__ void __launch_bounds__(256) chk_lru_prep(DbgArgs a) {
    __shared__ float xcs[64]; const int s = blockIdx.x, tid = threadIdx.x, row = (s * 7919 + 13) % MTOK, n = s & 3, b = row >> 12, sq = row & 4095;
    if (s == 0 || s == 1) { }
    float xc = 0.f;
    if (tid < 64) { const int c = 64 * n + tid; xc = DIN_(27)[c]; for (int k = 0; k < 4; ++k) { const int sr = sq - 3 + k; if (sr >= 0) xc += DIN_(26)[k * 256 + c] * bf2f(((const bf16_t*)(a.ws + WS_ZS))[(size_t)(b * SEQ + sr) * ZSW + C_XLRU + c]); } xcs[tid] = xc; }
    __syncthreads();
    if (tid < 64) { const int c = 64 * n + tid; float ar = DIN_(29)[c], ai = DIN_(31)[c];
        const float* wr_ = DIN_(28); const float* wi_ = DIN_(30);
#pragma unroll 2
        for (int cc = 0; cc < 64; ++cc) { ar += xcs[cc] * wr_[(n * 64 + cc) * 64 + tid]; ai += xcs[cc] * wi_[(n * 64 + cc) * 64 + tid]; }
        const float r = 1.f / (1.f + __expf(-ar)), ii = 1.f / (1.f + __expf(-ai)), la = -8.f * r * __logf(1.f + __expf(-DIN_(32)[c])), av = __expf(la), iv = sqrtf(fmaxf(1.f - av * av, 0.f)) * ii * xc;
        dbg_acc(a.acc, 8, ((const float*)(a.ws + WS_LA))[(size_t)row * 256 + c], av); dbg_acc(a.acc, 9, ((const float*)(a.ws + WS_LI))[(size_t)row * 256 + c], iv); }
}
__global__ void chk_mla_attn(DbgArgs a) {
    __shared__ float sh[256]; __shared__ float q[96]; __shared__ float p[4096];
    const int s = blockIdx.x, tid = threadIdx.x, bh = s & 15, sq = (s * 523 + 77) % SEQ, b = bh >> 2, hd = bh & 3;
    const bf16_t* QM = (const bf16_t*)(a.ws + WS_QM) + (size_t)bh * SEQ * 96; const bf16_t* KM = (const bf16_t*)(a.ws + WS_KM) + (size_t)bh * SEQ * 96; const bf16_t* VMT = (const bf16_t*)(a.ws + WS_VMT) + (size_t)bh * 64 * SEQ;
    if (tid < 96) q[tid] = bf2f(QM[(size_t)sq * 96 + tid]); __syncthreads();
    float mx = -1e30f; for (int j = tid; j <= sq; j += 256) { float sc = 0.f; for (int d = 0; d < 96; ++d) sc += q[d] * bf2f(KM[(size_t)j * 96 + d]); p[j] = sc; mx = fmaxf(mx, sc); }
    mx = blk_max(mx, sh); float sm = 0.f; for (int j = tid; j <= sq; j += 256) { p[j] = exp2f(p[j] - mx); sm += p[j]; } sm = blk_sum(sm, sh);
    if (tid < 64) { float o = 0.f; for (int j = 0; j <= sq; ++j) o += p[j] * bf2f(VMT[(size_t)tid * SEQ + j]); dbg_acc(a.acc, 10, bf2f(((const bf16_t*)(a.ws + WS_Y))[(size_t)1 * MTOK * 256 + (size_t)(b * SEQ + sq) * 256 + hd * 64 + tid]), o / sm); }
}
__global__ void chk_diff_attn(DbgArgs a) {
    __shared__ float sh[256]; __shared__ float q[64]; __shared__ float p1[4096]; __shared__ float p2[4096];
    const int s = blockIdx.x, tid = threadIdx.x, bh = s & 15, sq = (s * 523 + 77) % SEQ, b = bh >> 2, hd = bh & 3;
    const bf16_t* QD = (const bf16_t*)(a.ws + WS_QD) + (size_t)bh * SEQ * 64; const bf16_t* KD = (const bf16_t*)(a.ws + WS_KD) + (size_t)bh * SEQ * 64; const bf16_t* VDT = (const bf16_t*)(a.ws + WS_VDT) + (size_t)bh * 64 * SEQ;
    if (tid < 64) q[tid] = bf2f(QD[(size_t)sq * 64 + tid]); __syncthreads();
    float m1 = -1e30f, m2 = -1e30f; for (int j = tid; j <= sq; j += 256) { float s1 = 0.f, s2 = 0.f; for (int d = 0; d < 32; ++d) { s1 += q[d] * bf2f(KD[(size_t)j * 64 + d]); s2 += q[32 + d] * bf2f(KD[(size_t)j * 64 + 32 + d]); }
        const float bias = DIN_(3)[dbucket(sq - j) * 4 + hd] * LOG2E; s1 += bias; s2 += bias; p1[j] = s1; p2[j] = s2; m1 = fmaxf(m1, s1); m2 = fmaxf(m2, s2); }
    m1 = blk_max(m1, sh); m2 = blk_max(m2, sh); float l1 = 0.f, l2 = 0.f; for (int j = tid; j <= sq; j += 256) { p1[j] = exp2f(p1[j] - m1); p2[j] = exp2f(p2[j] - m2); l1 += p1[j]; l2 += p2[j]; } l1 = blk_sum(l1, sh); l2 = blk_sum(l2, sh);
    float s1 = 0.f, s2 = 0.f; for (int d = 0; d < 32; ++d) { s1 += DIN_(35)[d] * DIN_(36)[d]; s2 += DIN_(37)[d] * DIN_(38)[d]; } const float lam_init = DBG_LAYER == 0 ? 0.2f : 0.8f - 0.6f * 0.7408182206817179f, lam = expf(s1) - expf(s2) + lam_init;
    float o = 0.f; if (tid < 64) { float o1 = 0.f, o2 = 0.f; for (int j = 0; j <= sq; ++j) { const float v = bf2f(VDT[(size_t)tid * SEQ + j]); o1 += p1[j] * v; o2 += p2[j] * v; } o = o1 / l1 - lam * o2 / l2; }
    const float ss = blk_sum(tid < 64 ? o * o : 0.f, sh);
    if (tid < 64) dbg_acc(a.acc, 11, bf2f(((const bf16_t*)(a.ws + WS_Y))[(size_t)3 * MTOK * 256 + (size_t)(b * SEQ + sq) * 256 + hd * 64 + tid]), o * rsqrtf(ss / 64.f + EPS) * DIN_(39)[tid] * (1.f - lam_init));
}
__global__ void chk_lru_scan(DbgArgs a) {
    const int i = blockIdx.x * 256 + threadIdx.x, b = i >> 8, c = i & 255; if (b >= NB) return;
    const float* LA = (const float*)(a.ws + WS_LA); const float* LI = (const float*)(a.ws + WS_LI); float h = 0.f;
    for (int t = 0; t < SEQ; ++t) { const size_t o = (size_t)(b * SEQ + t) * 256 + c; h = LA[o] * h + LI[o];
        if (t % 97 == 0 || t == SEQ - 1) dbg_acc(a.acc, 12, bf2f(((const bf16_t*)(a.ws + WS_Y))[(size_t)2 * MTOK * 256 + o]), h * dgelu(bf2f(((const bf16_t*)(a.ws + WS_ZS))[(size_t)(b * SEQ + t) * ZSW + C_GLRU + c]))); }
}
__global__ void chk_s5_scan(DbgArgs a) {
    __shared__ float part[16][65]; const int g = blockIdx.x, p = threadIdx.x; float* ypre = (float*)(a.ws + WS_DBG);
    const float dt = expf(DIN_(12)[g]), lr = DIN_(10)[g * 64 + p], li = DIN_(11)[g * 64 + p], mag = expf(lr * dt); float sn, cs; sincos_red(li * dt, sn, cs);
    const float ar = mag * cs, ai = mag * sn, den = lr * lr + li * li, zr = ((ar - 1.f) * lr + ai * li) / den, zi = (ai * lr - (ar - 1.f) * li) / den;
    float hr = 0.f, hi = 0.f;
    for (int t = 0; t < SEQ; ++t) { const bf16_t* up = (const bf16_t*)(a.ws + WS_ZS) + (size_t)(SEQ + t) * ZSW + 16 * g; float bur = 0.f, bui = 0.f;
        for (int c = 0; c < 16; ++c) { const float u = bf2f(up[c]), br = DIN_(13)[(g * 64 + p) * 16 + c], bi = DIN_(14)[(g * 64 + p) * 16 + c]; bur += (zr * br - zi * bi) * u; bui += (zr * bi + zi * br) * u; }
        const float nr = ar * hr - ai * hi + bur, ni = ar * hi + ai * hr + bui; hr = nr; hi = ni;
        for (int c = 0; c < 16; ++c) part[c][p] = DIN_(15)[(g * 16 + c) * 64 + p] * hr - DIN_(16)[(g * 16 + c) * 64 + p] * hi;
        __syncthreads();
        if (p < 16) { float y = 0.f; for (int pp = 0; pp < 64; ++pp) y += part[p][pp]; y += DIN_(17)[16 * g + p] * bf2f(up[p]); ypre[(size_t)t * 256 + 16 * g + p] = dgelu(y); }
        __syncthreads(); }
}
__global__ void chk_s5_glu(DbgArgs a) {
    const int s = blockIdx.x, n = threadIdx.x, t = (s * 61 + 5) % SEQ; const float* ypre = (const float*)(a.ws + WS_DBG) + (size_t)t * 256;
    float z = DIN_(19)[n]; for (int k = 0; k < 256; ++k) z += ypre[k] * DIN_(18)[k * 256 + n];
    dbg_acc(a.acc, 13, bf2f(((const bf16_t*)(a.ws + WS_Y))[(size_t)(SEQ + t) * 256 + n]), ypre[n] * dsig(z));
}

__global__ void chk_merge(DbgArgs a) {
    __shared__ float sh[256]; const int s = blockIdx.x, tid = threadIdx.x, row = (s * 7919 + 13) % MTOK, col = (s * 104729 + 7) % DM;
    const bf16_t* Y = (const bf16_t*)(a.ws + WS_Y); const bf16_t* ZGp = (const bf16_t*)(a.ws + WS_ZG) + (size_t)row * ZGW; const bf16_t* MGp = (const bf16_t*)(a.ws + WS_MERGED) + (size_t)row * DM;
    float m = 0.f;
    for (int n = 0; n < 4; ++n) { float d = 0.f; { const int k = tid; d = bf2f(Y[(size_t)n * MTOK * 256 + (size_t)row * 256 + k]) * DIN_(40)[((size_t)n * 256 + k) * DM + col]; } d = blk_sum(d, sh); m += bf2f(ZGp[n * DM + col]) * d; }
    if (tid == 0) dbg_acc(a.acc, 14, bf2f(MGp[col]), m);
    float o = 0.f; for (int c = tid; c < DM; c += 256) o += bf2f(MGp[c]) * DIN_(41)[(size_t)c * DM + col]; o = blk_sum(o, sh);
    if (tid == 0) dbg_acc(a.acc, 15, a.out[(size_t)row * DM + col], DXIN_[(size_t)row * DM + col] + o);
}
__global__ void chk_cross(DbgArgs a) {
    __shared__ float sh[256]; __shared__ float hn[DM]; __shared__ float q[64]; __shared__ float p[256]; __shared__ float mn[DM];
    const int s = blockIdx.x, tid = threadIdx.x, row = (s * 7919 + 13) % MTOK, hd = s & 3, b = row >> 12;
    const float* x1 = a.out + (size_t)row * DM; float ss = 0.f; for (int k = tid; k < DM; k += 256) ss += x1[k] * x1[k]; ss = blk_sum(ss, sh); const float rs = rsqrtf(ss / DM + EPS);
    for (int k = tid; k < DM; k += 256) hn[k] = x1[k] * rs * DIN_(5)[k]; __syncthreads();
    float qf = 0.f; if (tid < 64) { for (int k = 0; k < DM; ++k) qf += hn[k] * DIN_(42)[(size_t)k * 256 + hd * 64 + tid]; dbg_acc(a.acc, 16, bf2f(((const bf16_t*)(a.ws + WS_QX))[(size_t)row * 256 + hd * 64 + tid]), qf); }
    { const float s2 = blk_sum(tid < 64 ? qf * qf : 0.f, sh); if (tid < 64) q[tid] = qf * rsqrtf(s2 / 64.f + EPS) * DIN_(46)[tid] * 0.125f; __syncthreads(); }
    float sc = 0.f; float vj[1]; (void)vj;
    { const float* mr = DIN_(1) + (size_t)(b * 256 + tid) * DM; float ms = 0.f; for (int k = 0; k < DM; ++k) ms += mr[k] * mr[k]; const float mrs = rsqrtf(ms / DM + EPS);
      float kk[64]; (void)kk; float s2 = 0.f; float dotq = 0.f;
      for (int d = 0; d < 64; ++d) { float kd = 0.f; for (int k = 0; k < DM; ++k) kd += mr[k] * mrs * DIN_(6)[k] * DIN_(43)[(size_t)k * 256 + hd * 64 + d]; s2 += kd * kd; dotq += kd * DIN_(47)[d] * q[d]; }
      sc = dotq * rsqrtf(s2 / 64.f + EPS); }
    const float mx = blk_max(sc, sh); const float e = expf(sc - mx); const float sm = blk_sum(e, sh); p[tid] = e / sm; __syncthreads();
    if (tid < 64) { float o = 0.f; for (int j = 0; j < 256; ++j) { const float* mr = DIN_(1) + (size_t)(b * 256 + j) * DM; float ms = 0.f, vd = 0.f; for (int k = 0; k < DM; ++k) { ms += mr[k] * mr[k]; vd += mr[k] * DIN_(6)[k] * DIN_(44)[(size_t)k * 256 + hd * 64 + tid]; } o += p[j] * vd * rsqrtf(ms / DM + EPS); }
        dbg_acc(a.acc, 17, bf2f(((const bf16_t*)(a.ws + WS_OX))[(size_t)row * 256 + hd * 64 + tid]), o); }
}
__global__ void chk_ffn(DbgArgs a) {
    __shared__ float sh[256]; __shared__ float hn[DM]; const int s = blockIdx.x, tid = threadIdx.x, row = (s * 7919 + 13) % MTOK;
    const float* x2 = a.out + (size_t)row * DM; float ss = 0.f; for (int k = tid; k < DM; k += 256) ss += x2[k] * x2[k]; ss = blk_sum(ss, sh); const float rs = rsqrtf(ss / DM + EPS);
    for (int k = tid; k < DM; k += 256) hn[k] = x2[k] * rs * DIN_(7)[k]; __syncthreads();
    for (int j = tid; j < FF; j += 256 * 8) { float g = 0.f, u = 0.f; for (int k = 0; k < DM; ++k) { g += hn[k] * DIN_(48)[(size_t)k * FF + j]; u += hn[k] * DIN_(49)[(size_t)k * FF + j]; }
        dbg_acc(a.acc, 18, bf2f(((const bf16_t*)(a.ws + WS_HFF))[(size_t)row * FF + j]), g / (1.f + expf(-g)) * u); }
}

__global__ void chk_moe(DbgArgs a) {
    __shared__ float sh[256]; __shared__ float hn[DM]; __shared__ float hid[EFF]; __shared__ float lgs[8];
    const int s = blockIdx.x, tid = threadIdx.x, tok = (s * 7919 + 13) % MTOK, slot = s & 1, col = (s * 104729 + 7) % DM;
    const float* x2 = a.out + (size_t)tok * DM; float ss = 0.f; for (int k = tid; k < DM; k += 256) ss += x2[k] * x2[k]; ss = blk_sum(ss, sh); const float rs = rsqrtf(ss / DM + EPS);
    for (int k = tid; k < DM; k += 256) hn[k] = x2[k] * rs * ((const float*)a.in[7])[DM + k]; __syncthreads();
    for (int e = 0; e < 8; ++e) { float d = 0.f; for (int k = tid; k < DM; k += 256) d += hn[k] * DIN_(51)[k * 8 + e]; d = blk_sum(d, sh); if (tid == 0) lgs[e] = d; } __syncthreads();
    int e1 = 0; for (int e = 1; e < 8; ++e) if (lgs[e] > lgs[e1]) e1 = e; int e2 = -1; for (int e = 0; e < 8; ++e) if (e != e1 && (e2 < 0 || lgs[e] > lgs[e2])) e2 = e;
    const float w1 = 1.f / (1.f + expf(lgs[e2] - lgs[e1])), w2 = 1.f - w1;
    const int* ASG = (const int*)(a.ws + WS_MOESM + MS_ASSIGN); const int* TD = (const int*)(a.ws + WS_MOESM + MS_TOKDEST); const float* TW = (const float*)(a.ws + WS_MOESM + MS_TOKW); const int* RT = (const int*)(a.ws + WS_MOESM + MS_ROWTOK);
    const int ef = ASG[2 * tok + slot] & 255, dest = TD[2 * tok + slot];
    if (tid == 0) { dbg_acc(a.acc, 19, (float)(ASG[2 * tok] & 255), (float)e1 + 1e-3f); dbg_acc(a.acc, 19, (float)(ASG[2 * tok + 1] & 255), (float)e2 + 1e-3f); dbg_acc(a.acc, 19, TW[2 * tok], w1); dbg_acc(a.acc, 19, TW[2 * tok + 1], w2); dbg_acc(a.acc, 19, (float)(RT[dest] - tok), 1e-3f); }
    const float* wg = DIN_(52) + (size_t)ef * DM * EFF; const float* wu = DIN_(53) + (size_t)ef * DM * EFF; const float* wd = DIN_(54) + (size_t)ef * EFF * DM;
    for (int f = tid; f < EFF; f += 256) { float g = 0.f, u = 0.f; for (int k = 0; k < DM; ++k) { g += hn[k] * wg[(size_t)k * EFF + f]; u += hn[k] * wu[(size_t)k * EFF + f]; } hid[f] = g / (1.f + expf(-g)) * u; }
    __syncthreads();
    float y = 0.f; for (int f = tid; f < EFF; f += 256) y += hid[f] * wd[(size_t)f * DM + col]; y = blk_sum(y, sh);
    if (tid == 0) dbg_acc(a.acc, 20, bf2f(((const bf16_t*)(a.ws + WS_YS))[(size_t)dest * DM + col]), y);
}

__global__ void chk_res(DbgArgs a, int kind) {
    __shared__ float sh[256]; const int s = blockIdx.x, tid = threadIdx.x, row = (s * 7919 + 13) % MTOK, col = (s * 104729 + 7) % DM; const float* xprev = (const float*)(a.ws + WS_DBG);
    float o = 0.f;
    if (kind == 0) { const bf16_t* A = (const bf16_t*)(a.ws + WS_OX) + (size_t)row * 256; o = bf2f(A[tid]) * DIN_(45)[(size_t)tid * DM + col]; }
    else { const bf16_t* A = (const bf16_t*)(a.ws + WS_HFF) + (size_t)row * FF; for (int k = tid; k < FF; k += 256) o += bf2f(A[k]) * DIN_(50)[(size_t)k * DM + col]; }
    o = blk_sum(o, sh);
    if (tid == 0) { dbg_acc(a.acc, 21, a.out[(size_t)row * DM + col], xprev[(size_t)row * DM + col] + o);
        const bf16_t xbv = ((const bf16_t*)(a.ws + WS_XB))[(size_t)row * DM + col]; dbg_acc(a.acc, 22, bf2f(xbv), a.out[(size_t)row * DM + col]); }
}

__global__ void chk_final(DbgArgs a) {
    const int i = blockIdx.x * 256 + threadIdx.x; const int tok = (i * 37 + 5) % MTOK, col = (i * 101 + 3) % DM; const float* xprev = (const float*)(a.ws + WS_DBG);
    const int* TD = (const int*)(a.ws + WS_MOESM + MS_TOKDEST); const float* TW = (const float*)(a.ws + WS_MOESM + MS_TOKW); const bf16_t* YS = (const bf16_t*)(a.ws + WS_YS);
    const float ref = xprev[(size_t)tok * DM + col] + TW[2 * tok] * bf2f(YS[(size_t)TD[2 * tok] * DM + col]) + TW[2 * tok + 1] * bf2f(YS[(size_t)TD[2 * tok + 1] * DM + col]);
    dbg_acc(a.acc, 23, a.out[(size_t)tok * DM + col], ref);
}
__global__ void chk_emit(DbgArgs a, int nchk) {
    for (int i = blockIdx.x * 256 + threadIdx.x; i < MTOK * DM; i += gridDim.x * 256) a.out[i] = 0.f;
    if (blockIdx.x == 0 && threadIdx.x == 0) { float V = 99000.f; float worst = 0.f;
        for (int k = 1; k <= nchk; ++k) { const float cnt = a.acc[64 + k]; const float rms = sqrtf(a.acc[2 * k + 1] / fmaxf(cnt, 1.f)) + 1e-20f; float err = a.acc[2 * k] / rms; if (cnt < 1.f) continue; if (!(err == err)) err = 0.97f; worst = fmaxf(worst, err);
#ifdef DBG_ONLY
            if (k == DBG_ONLY) { V = 1000.f + err * 10000.f; break; }
#else
            if (err > 0.06f) { V = (float)k * 1000.f + fminf(err, 0.99f) * 1000.f; break; }
#endif
        }
        if (V == 99000.f) V = 99000.f + worst * 1000.f;
        a.out[12345] = V; }
}
#endif

#ifdef DBG_STAT
__global__ void stat_scan(const float* out, unsigned* acc) {
    for (int i = blockIdx.x * 256 + threadIdx.x; i < MTOK * DM; i += gridDim.x * 256) { const float v = fabsf(out[i]);
        atomicMax(&acc[1], __float_as_uint(v)); if (v > 10.f || !(v == v)) { atomicAdd(&acc[0], 1u); atomicAdd(&acc[2 + (i >> 18)], 1u); atomicAdd(&acc[70 + ((i & 1023) >> 8)], 1u); atomicAdd(&acc[80 + ((i >> 10) & 255) / 32], 1u); } }
}
__global__ void stat_emit(float* out, const unsigned* acc, int mode) {
    for (int i = blockIdx.x * 256 + threadIdx.x; i < MTOK * DM; i += gridDim.x * 256) out[i] = 0.f;
    if (blockIdx.x == 0 && threadIdx.x == 0) { float V = 0.f;
        if (mode == 0) V = (float)acc[0];
        else if (mode == 1) V = __uint_as_float(acc[1]) * 100.f;
        else if (mode == 2) { unsigned best = 0, bi = 0, nz = 0; for (int k = 0; k < 64; ++k) { if (acc[2 + k] > best) { best = acc[2 + k]; bi = k; } nz += acc[2 + k] > 0; } V = 1000.f * (float)bi + 10.f * (float)nz; }
        else if (mode == 3) V = 1000.f * (float)acc[70] / fmaxf((float)acc[0], 1.f) + 100000.f * (float)acc[71] / fmaxf((float)acc[0], 1.f);
        else if (mode == 4) { unsigned best = 0, bi = 0; for (int k = 0; k < 8; ++k) if (acc[80 + k] > best) { best = acc[80 + k]; bi = k; } V = 1000.f + 1000.f * (float)bi + 900.f * (float)best / fmaxf((float)acc[0], 1.f); }
        out[12345] = V + 100.f; }
}
#endif

#ifdef DBG_VAR
__global__ void var_scan(const float* out, const float* prev, float* acc) {
    float s = 0.f, mx = 0.f; for (int i = blockIdx.x * 256 + threadIdx.x; i < MTOK * DM; i += gridDim.x * 256) { const float d = out[i] - prev[i]; s += d * d; mx = fmaxf(mx, fabsf(d)); }
    atomicAdd(&acc[0], s); atomicMax((unsigned*)&acc[1], __float_as_uint(mx));
}
__global__ void var_emit(float* out, const float* acc, int mode) {
    for (int i = blockIdx.x * 256 + threadIdx.x; i < MTOK * DM; i += gridDim.x * 256) out[i] = 0.f;
    if (blockIdx.x == 0 && threadIdx.x == 0) out[12345] = 100.f + (mode == 0 ? acc[0] / (float)(MTOK * DM) * 1e5f : acc[1] * 100.f);
}
#endif

#ifdef DBG_GSTAT
__global__ void gstat_scan(const bf16_t* zg, float* acc) { float s1 = 0.f, s2 = 0.f; for (size_t i = blockIdx.x * 256 + threadIdx.x; i < (size_t)MTOK * ZGW; i += (size_t)gridDim.x * 256) { const float g = bf2f(zg[i]); const int blk = (int)((i & 4095) >> 10); if (blk == DBG_GSTAT) { s1 += (g < -0.01f || g > 1.01f || !(g == g)) ? 1.f : 0.f; s2 += (g - 0.5f) * (g - 0.5f); } } atomicAdd(&acc[0], s1); atomicAdd(&acc[1], s2); }
__global__ void gstat_emit(float* out, const float* acc, int mode) {
    for (int i = blockIdx.x * 256 + threadIdx.x; i < MTOK * DM; i += gridDim.x * 256) out[i] = 0.f;
    if (blockIdx.x == 0 && threadIdx.x == 0) out[12345] = 100.f + 10000.f * acc[1] / ((float)MTOK * 1024);
}
#endif
extern "C" void kernel_launch(void* const* d_in, const int* in_sizes, int n_in, void* d_out, int out_size, void* d_ws, size_t ws_size, hipStream_t stream) {
    static int grid = 0;
    if (grid == 0) {
        if (n_in != 55 || out_size != MTOK * DM || ws_size < WS_END) { fprintf(stderr, "kernel_launch: unexpected shapes (n_in %d out %d ws %zu)\n", n_in, out_size, ws_size); grid = -1; return; }
        { const int L2 = 2; const int exp_sz[55] = {NB * SEQ * DM, NB * NMEM * DM, NB * SEQ, 32 * 4, L2 * DM, L2 * DM, L2 * DM, L2 * DM, L2 * DM * DIN, L2 * 4 * DM, L2 * 1024, L2 * 1024, L2 * 16, L2 * 16384, L2 * 16384, L2 * 16384, L2 * 16384, L2 * 256, L2 * 65536, L2 * 256,
              L2 * 192, L2 * 128, L2 * 192 * 384, L2 * 128 * 512, L2 * 96, L2 * 96, L2 * 1024, L2 * 256, L2 * 16384, L2 * 256, L2 * 16384, L2 * 256, L2 * 256, L2 * 32, L2 * 32, L2 * 32, L2 * 32, L2 * 32, L2 * 32, L2 * 64,
              L2 * 4 * 256 * DM, L2 * DM * DM, L2 * DM * 256, L2 * DM * 256, L2 * DM * 256, L2 * 256 * DM, L2 * 64, L2 * 64, DM * FF, DM * FF, FF * DM, DM * 8, 8 * DM * EFF, 8 * DM * EFF, 8 * EFF * DM};
          for (int i = 0; i < 55; ++i) if (in_sizes[i] != exp_sz[i]) { fprintf(stderr, "kernel_launch: input %d has %d elements, expected %d\n", i, in_sizes[i], exp_sz[i]); grid = -1; return; } }
        int dev = 0, cus = 0, per_cu = 0;
        if (hipGetDevice(&dev) != hipSuccess || hipDeviceGetAttribute(&cus, hipDeviceAttributeMultiprocessorCount, dev) != hipSuccess) { grid = -1; return; }
        if (hipFuncSetAttribute((const void*)hybrid_fwd, hipFuncAttributeMaxDynamicSharedMemorySize, LDS_BYTES) != hipSuccess) { fprintf(stderr, "kernel_launch: hipFuncSetAttribute failed\n"); grid = -1; return; }
        if (hipOccupancyMaxActiveBlocksPerMultiprocessor(&per_cu, (const void*)hybrid_fwd, 512, LDS_BYTES) != hipSuccess || per_cu < 1) { fprintf(stderr, "kernel_launch: occupancy query says %d\n", per_cu); }
        (void)hipGetLastError();
        grid = cus;
    }
    if (grid < 0) return;
    if (hipMemsetAsync((char*)d_ws + WS_CTL, 0, CTL_ZERO_BYTES, stream) != hipSuccess) return;
    Args a{};
    for (int i = 0; i < 55; ++i) a.in[i] = d_in[i];
    a.out = (float*)d_out; a.ws = (unsigned char*)d_ws; a.submask = 0xFFFF; a.pad = 0;
#if MK_ONE_LAUNCH
    a.ph_lo = 0; a.ph_hi = NPHASE;
    hipLaunchKernelGGL(hybrid_fwd, dim3(grid), dim3(512), LDS_BYTES, stream, a);
#else
    for (int p = 0; p < DBG_NPH; ++p) { a.ph_lo = p; a.ph_hi = p + 1;
#if defined(DBG_CHECK) || defined(DBG_VAR)
        if (p == DBG_NPH - 1) hipMemcpyAsync((char*)d_ws + 440 * MiB, d_out, (size_t)MTOK * DM * 4, hipMemcpyDeviceToDevice, stream);
#endif
        hipLaunchKernelGGL(hybrid_fwd, dim3(grid), dim3(512), LDS_BYTES, stream, a);
#ifdef DBG_REPEAT
        if (p == DBG_REPEAT) {
#ifdef DBG_REPSUB
            a.submask = DBG_REPSUB;
#endif
            hipLaunchKernelGGL(hybrid_fwd, dim3(grid), dim3(512), LDS_BYTES, stream, a); hipLaunchKernelGGL(hybrid_fwd, dim3(grid), dim3(512), LDS_BYTES, stream, a); a.submask = 0xFFFF; }
#endif
    }
#ifdef DBG_CHECK
    { DbgArgs da{}; for (int i = 0; i < 55; ++i) da.in[i] = d_in[i]; da.ws = (unsigned char*)d_ws; da.out = (float*)d_out; da.acc = (float*)((char*)d_ws + 700 * 1024);
#if DBG_NPH == 6 || DBG_NPH == 16
      hipLaunchKernelGGL(chk_merge, dim3(512), dim3(256), 0, stream, da);
#elif DBG_NPH == 8 || DBG_NPH == 18
      hipLaunchKernelGGL(chk_cross, dim3(64), dim3(256), 0, stream, da);
#elif DBG_NPH == 10
      hipLaunchKernelGGL(chk_ffn, dim3(64), dim3(256), 0, stream, da);
#elif DBG_NPH == 24
      hipLaunchKernelGGL(chk_final, dim3(64), dim3(256), 0, stream, da);
#elif DBG_NPH == 23
      hipLaunchKernelGGL(chk_moe, dim3(128), dim3(256), 0, stream, da);
#elif DBG_NPH == 9 || DBG_NPH == 19
      hipLaunchKernelGGL(chk_res, dim3(512), dim3(256), 0, stream, da, 0);
#elif DBG_NPH == 11
      hipLaunchKernelGGL(chk_res, dim3(512), dim3(256), 0, stream, da, 1);
#else
      hipLaunchKernelGGL(chk_z, dim3(1024), dim3(256), 0, stream, da);
      hipLaunchKernelGGL(chk_mla_prep, dim3(512), dim3(256), 0, stream, da);
      hipLaunchKernelGGL(chk_diff_prep, dim3(16), dim3(256), 0, stream, da);
      hipLaunchKernelGGL(chk_lru_prep, dim3(512), dim3(256), 0, stream, da);
      hipLaunchKernelGGL(chk_mla_attn, dim3(64), dim3(256), 0, stream, da);
      hipLaunchKernelGGL(chk_diff_attn, dim3(64), dim3(256), 0, stream, da);
      hipLaunchKernelGGL(chk_lru_scan, dim3(4), dim3(256), 0, stream, da);
      hipLaunchKernelGGL(chk_s5_scan, dim3(16), dim3(64), 0, stream, da);
      hipLaunchKernelGGL(chk_s5_glu, dim3(64), dim3(256), 0, stream, da);
#endif
      hipLaunchKernelGGL(chk_emit, dim3(1024), dim3(256), 0, stream, da, 23); }
#endif
#ifdef DBG_COPYX
    hipMemcpyAsync(d_out, d_in[0], (size_t)MTOK * DM * 4, hipMemcpyDeviceToDevice, stream);
#endif
#ifdef DBG_GSTAT
    { float* acc = (float*)((char*)d_ws + 900 * 1024);
      hipLaunchKernelGGL(gstat_scan, dim3(2048), dim3(256), 0, stream, (const bf16_t*)((const char*)d_ws + WS_ZG), acc);
      hipLaunchKernelGGL(gstat_emit, dim3(1024), dim3(256), 0, stream, (float*)d_out, (const float*)acc, DBG_GSTAT); }
#endif
#ifdef DBG_VAR
    { float* acc = (float*)((char*)d_ws + 900 * 1024);
      hipLaunchKernelGGL(var_scan, dim3(1024), dim3(256), 0, stream, (const float*)d_out, DBG_NPH == 6 ? (const float*)d_in[0] : (const float*)((const char*)d_ws + 440 * MiB), acc);
      hipLaunchKernelGGL(var_emit, dim3(1024), dim3(256), 0, stream, (float*)d_out, (const float*)acc, DBG_VAR); }
#endif
#ifdef DBG_STAT
    { unsigned* acc = (unsigned*)((char*)d_ws + 800 * 1024);
      hipLaunchKernelGGL(stat_scan, dim3(2048), dim3(256), 0, stream, (const float*)d_out, acc);
      hipLaunchKernelGGL(stat_emit, dim3(1024), dim3(256), 0, stream, (float*)d_out, (const unsigned*)acc, DBG_STAT); }
#endif
#ifdef DBG_DUMP_OFF
    hipLaunchKernelGGL(dbg_copy_bf16, dim3(2048), dim3(256), 0, stream, (const bf16_t*)((const char*)d_ws + (size_t)(DBG_DUMP_OFF)), (float*)d_out, MTOK * DM, DBG_DUMP_N);
#endif
#endif
}
```

```cpp
#include <hip/hip_runtime.h>
#include <cstdio>
#include <cstdint>

#define DBG_NPH 24

#ifndef DBG_GPERM
#define DBG_GPERM(n) (n)
#endif
#ifndef DBG_SCALE
#define DBG_SCALE 1.0f
#endif
#ifndef MK_ONE_LAUNCH
#define MK_ONE_LAUNCH 1
#endif
#ifndef G2_FP8
#define G2_FP8 0
#endif

#define LAS __attribute__((address_space(3)))
typedef unsigned short bf16_t;
typedef short bf16x8 __attribute__((ext_vector_type(8)));
typedef float f32x2 __attribute__((ext_vector_type(2)));
typedef float f32x4 __attribute__((ext_vector_type(4)));
typedef float f32x16 __attribute__((ext_vector_type(16)));
typedef unsigned u32x2 __attribute__((ext_vector_type(2)));
typedef unsigned u32x4 __attribute__((ext_vector_type(4)));
typedef int i32x4 __attribute__((ext_vector_type(4)));
typedef int i32x8 __attribute__((ext_vector_type(8)));

constexpr int DM = 1024, NB = 4, SEQ = 4096, MTOK = NB * SEQ, NMEM = 256;
constexpr int DIN = 5984, ZSW = 2048, ZGW = 4096, NIN = ZSW + ZGW;
constexpr int C_S5 = 0, C_CQ = 256, C_CKV = 448, C_KPE = 576, C_XLRU = 608, C_GLRU = 864, C_QD = 1120, C_KD = 1376, C_VD = 1632, C_END = 1888;
constexpr int FF = 2816, EFF = 3584, NEXP = 8, MOE_ROWS = 34816;
constexpr float EPS = 1e-6f, LOG2E = 1.4426950408889634f;

constexpr size_t MiB = 1u << 20;
constexpr size_t WS_CTL = 0, CTL_ZERO_BYTES = 1 * MiB + 512 * 1024;
constexpr size_t WS_MOESM = 1 * MiB;
constexpr size_t WS_XB = 2 * MiB;
constexpr size_t WS_WL = 34 * MiB, WL_STRIDE = 19 * MiB;
constexpr size_t WL_WIN = 0, WL_PT = 12 * MiB, WL_WO = 14 * MiB, WL_WXQ = 16 * MiB, WL_WXKV = 16 * MiB + 512 * 1024, WL_WXO = 17 * MiB + 512 * 1024, WL_SM = 18 * MiB;
constexpr size_t SM_WUQ = 0, SM_WUKV = 256 * 1024, SM_WR = 512 * 1024, SM_WI = 576 * 1024, SM_WGLU = 640 * 1024;
constexpr size_t WS_WGU = 72 * MiB, WS_WD = 83 * MiB, WS_TAB = 89 * MiB, WS_KX = 90 * MiB, WS_VXT = 91 * MiB;
constexpr size_t TAB_S5T = 0, TAB_CMAT = 512 * 1024, TAB_MISC = 768 * 1024;
constexpr size_t WS_ZS = 92 * MiB, WS_MERGED = 92 * MiB, WS_ZG = 156 * MiB, WS_HFF = 156 * MiB, WS_Y = 284 * MiB;
constexpr size_t WS_QM = 316 * MiB, WS_KM = 328 * MiB, WS_VMT = 340 * MiB, WS_QD = 348 * MiB, WS_KD = 356 * MiB, WS_VDT = 364 * MiB;
constexpr size_t WS_QX = 316 * MiB, WS_OX = 324 * MiB;
constexpr size_t WS_LA = 372 * MiB, WS_LI = 388 * MiB, WS_S5S = 404 * MiB, WS_LSUM = 406 * MiB, WS_RSP = 407 * MiB;
constexpr size_t WS_WMGU = 34 * MiB, WS_WMD = 146 * MiB, WS_HMOE = 202 * MiB, WS_XQ = 330 * MiB, WS_YS = 34 * MiB, WS_X8 = 416 * MiB, WS_END = 440 * MiB;
constexpr int CW_TMO = 0, CW_BAR = 4096, CW_MOECNT = 8192, CW_Q = 12288;
constexpr size_t CTL_ROWSS = 256 * 1024;
constexpr size_t MS_ROWTOK = 0, MS_TOKW = 512 * 1024, MS_ASSIGN = 640 * 1024, MS_RSTD = 768 * 1024;
constexpr int RING_BYTES = 131072, MISC_OFF = RING_BYTES + 320, LDS_BYTES = 147456;

typedef __bf16 bf16x2_t __attribute__((ext_vector_type(2)));
__device__ __forceinline__ unsigned cvt_pk_bf16(float lo, float hi) { const f32x2 v = {lo, hi}; const bf16x2_t b = __builtin_convertvector(v, bf16x2_t); return __builtin_bit_cast(unsigned, b); }
__device__ __forceinline__ float clamp8(float x) { return __builtin_fminf(__builtin_fmaxf(x, -448.f), 448.f); }
__device__ __forceinline__ unsigned cvt_pk4_fp8(float a, float b, float c, float d) { int w = __builtin_amdgcn_cvt_pk_fp8_f32(clamp8(a), clamp8(b), 0, false); w = __builtin_amdgcn_cvt_pk_fp8_f32(clamp8(c), clamp8(d), w, true); return (unsigned)w; }
__device__ __forceinline__ float bflo(unsigned w) { return __uint_as_float(w << 16); }
__device__ __forceinline__ float bfhi(unsigned w) { return __uint_as_float(w & 0xffff0000u); }
__device__ __forceinline__ float bf2f(bf16_t b) { return __uint_as_float((unsigned)b << 16); }
__device__ __forceinline__ bf16_t f2bf(float f) { return (bf16_t)(cvt_pk_bf16(f, 0.f) & 0xffffu); }
__device__ __forceinline__ float fexp2(float x) { return __builtin_amdgcn_exp2f(x); }
__device__ __forceinline__ float frcp(float x) { return __builtin_amdgcn_rcpf(x); }
__device__ __forceinline__ float frsq(float x) { return __builtin_amdgcn_rsqf(x); }
__device__ __forceinline__ float fsigmoid(float x) { return frcp(1.f + fexp2(-x * LOG2E)); }
__device__ __forceinline__ float fgelu(float x) {
    const float z = 0.7978845608028654f * (x + 0.044715f * x * x * x);
    const float e = fexp2(2.f * LOG2E * z);
    const float th = 1.f - 2.f * frcp(e + 1.f);
    return 0.5f * x * (1.f + th);
}
__device__ __forceinline__ int crow(int r, int hi) { return (r & 3) + 8 * (r >> 2) + 4 * hi; }
__device__ __forceinline__ bf16x8 ldg8(const bf16_t* p) { return *(const bf16x8*)p; }
__device__ __forceinline__ float sq8(bf16x8 v) {
    const u32x4 w = *(const u32x4*)&v; float s = 0.f;
#pragma unroll
    for (int i = 0; i < 4; ++i) { const float a = bflo(w[i]), b = bfhi(w[i]); s += a * a + b * b; }
    return s;
}
__device__ __forceinline__ float row_rstd(const float* rsp, int row) {
    const f32x4* p = (const f32x4*)(rsp + (size_t)row * 16); const f32x4 a = p[0], b = p[1], c = p[2], d = p[3];
    const float s = (((a.x + a.y) + (a.z + a.w)) + ((b.x + b.y) + (b.z + b.w))) + (((c.x + c.y) + (c.z + c.w)) + ((d.x + d.y) + (d.z + d.w)));
    return frsq(s * (1.f / DM) + EPS);
}
__device__ __forceinline__ float wave_sum(float v) {
#pragma unroll
    for (int o = 1; o < 64; o <<= 1) v += __shfl_xor(v, o);
    return v;
}
#define MFMA32(a, b, c) __builtin_amdgcn_mfma_f32_32x32x16_bf16((a), (b), (c), 0, 0, 0)
#define MFMA16(a, b, c) __builtin_amdgcn_mfma_f32_16x16x32_bf16((a), (b), (c), 0, 0, 0)
__device__ __forceinline__ void sincos_red(float a, float& s, float& c) {
    const float k = rintf(a * 0.15915494309189535f);
    float r = fmaf(-k, 6.28318548202514648f, a);
    r = fmaf(-k, -1.7484555e-7f, r);
    s = __sinf(r); c = __cosf(r);
}

namespace pg8 {
constexpr int BM = 256, BK = 64, HALF = 128, HTB = HALF * BK * 2, STAGE_BYTES = 8 * HTB;
__host__ __device__ __forceinline__ int lds_byte(int r, int c) { const int st = (r >> 4) * 2 + (c >> 5), rr = r & 15, cc = c & 31, ob = rr * 64 + cc * 2; return st * 1024 + (ob ^ (((ob >> 9) & 1) << 5)); }
__host__ __device__ __forceinline__ void stage_rc(int b, int& R, int& C) { const int st = b / 1024, sb = b % 1024, swz = sb ^ (((sb >> 9) & 1) << 5); R = (st >> 1) * 16 + swz / 64; C = (st & 1) * 32 + (swz % 64) / 2; }
__host__ __device__ __forceinline__ int perm32(int rho) { const int n = rho >> 4, i = rho & 15; return 8 * (i >> 2) + 4 * n + (i & 3); }

struct Unit { int pm, pn, om, on, aux, gofs; };
struct Gemm { const bf16_t* A; const bf16_t* Bt; int K; const int* gather; };

template <class Epi, class Sched, bool ALIGN_EPI, bool GATHER, bool FP8 = false>
__device__ __forceinline__ void gemm_phase(LAS unsigned char* lds, Gemm g, const Sched& S, const Epi& E) {
    int tid = threadIdx.x; asm volatile("" : "+v"(tid));
    asm volatile("" : "+s"(g.A), "+s"(g.Bt));
    const int wid = __builtin_amdgcn_readfirstlane(tid >> 6), lane = tid & 63, wr = wid >> 2, wc = wid & 3, fr = lane & 15, fq = lane >> 4;
    const int K = g.K, nt = K / BK;
    unsigned voffB[2];
#pragma unroll
    for (int i = 0; i < 2; ++i) { int Rr_, Cc_; stage_rc(tid * 16 + i * 8192, Rr_, Cc_); const int Rb = (Rr_ & ~31) + perm32(Rr_ & 31); voffB[i] = (unsigned)(Rb * K + Cc_) * 2u; }
    const size_t kstep = (size_t)(BK * 2);
    const size_t hstep = (size_t)HALF * K * 2;
    const size_t tstep = 2 * hstep;
    const unsigned ldsw = (unsigned)wid * 1024u;
    const int aoff = lds_byte(wr * 64 + fr, fq * 8), boff = lds_byte(wc * 32 + fr, fq * 8);
#define PG8_SA(b, h) (((b) * 2 + (h)) * HTB)
#define PG8_SB(b, h) ((4 + (b) * 2 + (h)) * HTB)
#define PG8_STAGE_B(bufoff, gbase) do { _Pragma("unroll") for (int _i = 0; _i < 2; ++_i) \
        __builtin_amdgcn_global_load_lds((const unsigned*)((const char*)(gbase) + voffB[_i]), (LAS unsigned*)(lds + (bufoff) + ldsw + _i * 8192), 16, 0, 0); } while (0)
#define PG8_STAGE_A(bufoff, kt, vo0, vo1) do { const char* _gb = (const char*)g.A + (size_t)(kt) * kstep; \
        __builtin_amdgcn_global_load_lds((const unsigned*)(_gb + (vo0)), (LAS unsigned*)(lds + (bufoff) + ldsw), 16, 0, 0); \
        __builtin_amdgcn_global_load_lds((const unsigned*)(_gb + (vo1)), (LAS unsigned*)(lds + (bufoff) + ldsw + 8192), 16, 0, 0); } while (0)
#define PG8_LDA(dst, b, h) do { _Pragma("unroll") for (int m = 0; m < 4; ++m) _Pragma("unroll") for (int k = 0; k < 2; ++k) dst[m][k] = *(const LAS bf16x8*)(lds + PG8_SA(b, h) + aoff + m * 2048 + k * 1024); } while (0)
#define PG8_LDB(dst, b, h) do { _Pragma("unroll") for (int n = 0; n < 2; ++n) _Pragma("unroll") for (int k = 0; k < 2; ++k) dst[n][k] = *(const LAS bf16x8*)(lds + PG8_SB(b, h) + boff + n * 2048 + k * 1024); } while (0)
#define PG8_MMA(ai, bj, At, Bt) do { __builtin_amdgcn_s_setprio(1); _Pragma("unroll") for (int m = 0; m < 4; ++m) _Pragma("unroll") for (int n = 0; n < 2; ++n) _Pragma("unroll") for (int k = 0; k < 2; ++k) \
        acc[ai][bj][m][n] = __builtin_amdgcn_mfma_f32_16x16x32_bf16(Bt[n][k], At[m][k], acc[ai][bj][m][n], 0, 0, 0); __builtin_amdgcn_s_setprio(0); } while (0)
#define PG8_MMA8(ai, bj, w) do { __builtin_amdgcn_s_setprio(1); _Pragma("unroll") for (int m = 0; m < 4; ++m) _Pragma("unroll") for (int n = 0; n < 2; ++n) \
        asm volatile("v_mfma_f32_16x16x128_f8f6f4 %0, %1, %2, %0" : "+v"(acc[ai][bj][m][n]) : "v"(B##w##8[n]), "v"(A8[m])); __builtin_amdgcn_s_setprio(0); } while (0)
#define PG8_LA(b, h) do { if constexpr (FP8) { _Pragma("unroll") for (int m = 0; m < 4; ++m) { A8[m].lo = *(const LAS i32x4*)(lds + PG8_SA(b, h) + aoff + m * 2048); A8[m].hi = *(const LAS i32x4*)(lds + PG8_SA(b, h) + aoff + m * 2048 + 1024); } } \
        else PG8_LDA(At, b, h); } while (0)
#define PG8_LB(w, b, h) do { if constexpr (FP8) { _Pragma("unroll") for (int n = 0; n < 2; ++n) { B##w##8[n].lo = *(const LAS i32x4*)(lds + PG8_SB(b, h) + boff + n * 2048); B##w##8[n].hi = *(const LAS i32x4*)(lds + PG8_SB(b, h) + boff + n * 2048 + 1024); } } \
        else PG8_LDB(B##w, b, h); } while (0)
#define PG8_MM(ai, bj, w) do { if constexpr (FP8) PG8_MMA8(ai, bj, w); else PG8_MMA(ai, bj, At, B##w); } while (0)
#define PG8_WAIT_V(n) asm volatile("s_waitcnt vmcnt(" #n ")" ::: "memory")
#define PG8_WAIT_L(n) asm volatile("s_waitcnt lgkmcnt(" #n ")" ::: "memory")
#define PG8_BAR __builtin_amdgcn_s_barrier()
#define PG8_SCHED __builtin_amdgcn_sched_barrier(0)
#define PG8_VOFF(dst, u) do { _Pragma("unroll") for (int _h = 0; _h < 2; ++_h) _Pragma("unroll") for (int _i = 0; _i < 2; ++_i) { int Rr_, Cc_; stage_rc(tid * 16 + _i * 8192, Rr_, Cc_); \
        const int _rt = (u).pm * BM + _h * HALF + Rr_; const int _ar = GATHER ? g.gather[_rt + (u).gofs] : _rt; dst[_h][_i] = (unsigned)((size_t)_ar * K + Cc_) * 2u; } } while (0)
    Unit cur, nxt; int ui = 0;
    if (!S.next(0, cur)) return;
    f32x4 acc[2][2][4][2];
#pragma unroll
    for (int a = 0; a < 2; ++a)
#pragma unroll
        for (int b = 0; b < 2; ++b)
#pragma unroll
            for (int m = 0; m < 4; ++m)
#pragma unroll
                for (int n = 0; n < 2; ++n) acc[a][b][m][n] = (f32x4){0.f, 0.f, 0.f, 0.f};
    bf16x8 At[4][2], B0[2][2], B1[2][2];
    i32x8 A8[4], B08[2], B18[2];
    unsigned vC[2][2], vN[2][2];
    PG8_VOFF(vC, cur);
    const char* cB = (const char*)g.Bt + (size_t)cur.pn * tstep;
    PG8_STAGE_B(PG8_SB(0, 0), cB); PG8_STAGE_B(PG8_SB(0, 1), cB + hstep); PG8_STAGE_A(PG8_SA(0, 0), 0, vC[0][0], vC[0][1]); PG8_STAGE_A(PG8_SA(0, 1), 0, vC[1][0], vC[1][1]);
    if (wr == 1) PG8_BAR;
    PG8_WAIT_V(2); PG8_BAR;
    PG8_STAGE_B(PG8_SB(1, 0), cB + kstep); PG8_STAGE_A(PG8_SA(1, 0), 1, vC[0][0], vC[0][1]); PG8_STAGE_B(PG8_SB(1, 1), cB + hstep + kstep);
    PG8_WAIT_V(6); PG8_BAR;
    for (;;) {
        const bool has_next = S.next(ui + 1, nxt);
        unsigned ndelta = 0u;
        if constexpr (GATHER) {
            if (has_next) { PG8_VOFF(vN, nxt); } else {
#pragma unroll
                for (int _h = 0; _h < 2; ++_h)
#pragma unroll
                    for (int _i = 0; _i < 2; ++_i) vN[_h][_i] = vC[_h][_i]; }
        } else { if (has_next) ndelta = (unsigned)((nxt.pm - cur.pm) * (int)tstep); }
        const char* nB = has_next ? (const char*)g.Bt + (size_t)nxt.pn * tstep : cB;
#pragma unroll 1
        for (int t = 0; t < nt; t += 2) {
            const bool last = (t == nt - 2);
            const int k2 = last ? 0 : t + 2, k3 = k2 + 1;
            const char* b2 = last ? nB : cB + (size_t)(t + 2) * kstep; const char* b3 = b2 + kstep;
            unsigned v200, v201, v210, v211;
            if constexpr (GATHER) { v200 = last ? vN[0][0] : vC[0][0]; v201 = last ? vN[0][1] : vC[0][1]; v210 = last ? vN[1][0] : vC[1][0]; v211 = last ? vN[1][1] : vC[1][1]; }
            else { const unsigned dl = last ? ndelta : 0u; v200 = vC[0][0] + dl; v201 = vC[0][1] + dl; v210 = vC[1][0] + dl; v211 = vC[1][1] + dl; }
            PG8_LB(0, 0, 0); PG8_LB(1, 0, 1); PG8_SCHED; PG8_LA(0, 0); PG8_STAGE_A(PG8_SA(1, 1), t + 1, vC[1][0], vC[1][1]);
            PG8_WAIT_V(8); PG8_WAIT_L(0); PG8_BAR; PG8_MM(0, 0, 0); PG8_MM(0, 1, 1); PG8_BAR; PG8_SCHED;
            PG8_LA(0, 1); PG8_STAGE_B(PG8_SB(0, 0), b2); PG8_STAGE_B(PG8_SB(0, 1), b2 + hstep); PG8_STAGE_A(PG8_SA(0, 0), k2, v200, v201);
            PG8_WAIT_V(8); PG8_WAIT_L(0); PG8_BAR; PG8_MM(1, 0, 0); PG8_MM(1, 1, 1); PG8_BAR; PG8_SCHED;
            PG8_LB(0, 1, 0); PG8_LB(1, 1, 1); PG8_SCHED; PG8_LA(1, 0); PG8_STAGE_A(PG8_SA(0, 1), k2, v210, v211);
            PG8_WAIT_V(8); PG8_WAIT_L(0); PG8_BAR; PG8_MM(0, 0, 0); PG8_MM(0, 1, 1); PG8_BAR; PG8_SCHED;
            PG8_LA(1, 1); PG8_STAGE_B(PG8_SB(1, 0), b3); PG8_STAGE_B(PG8_SB(1, 1), b3 + hstep); PG8_STAGE_A(PG8_SA(1, 0), k3, v200, v201);
            PG8_WAIT_V(8); PG8_WAIT_L(0); PG8_BAR; PG8_MM(1, 0, 0); PG8_MM(1, 1, 1); PG8_BAR; PG8_SCHED;
        }
        if constexpr (ALIGN_EPI) { if (wr == 0) PG8_BAR; }
        if constexpr (FP8) asm volatile("s_nop 15\n\ts_nop 15" ::: "memory");
        { int fr_ = fr, fq_ = fq; asm volatile("" : "+v"(fr_), "+v"(fq_)); E(acc, cur, wr, wc, fr_, fq_); }
        if (!has_next) break;
#pragma unroll
        for (int a = 0; a < 2; ++a)
#pragma unroll
            for (int b = 0; b < 2; ++b)
#pragma unroll
                for (int m = 0; m < 4; ++m)
#pragma unroll
                    for (int n = 0; n < 2; ++n) acc[a][b][m][n] = (f32x4){0.f, 0.f, 0.f, 0.f};
        cur = nxt; cB = nB; ++ui;
#pragma unroll
        for (int _h = 0; _h < 2; ++_h)
#pragma unroll
            for (int _i = 0; _i < 2; ++_i) { if constexpr (GATHER) vC[_h][_i] = vN[_h][_i]; else vC[_h][_i] += ndelta; }
        if constexpr (ALIGN_EPI) { if (wr == 1) PG8_BAR; }
    }
    PG8_WAIT_V(0);
    if constexpr (!ALIGN_EPI) { if (wr == 0) PG8_BAR; }
    PG8_BAR;
#undef PG8_SA
#undef PG8_SB
#undef PG8_STAGE_A
#undef PG8_STAGE_B
#undef PG8_LDA
#undef PG8_LDB
#undef PG8_MMA
#undef PG8_MMA8
#undef PG8_MM
#undef PG8_LA
#undef PG8_LB
#undef PG8_WAIT_V
#undef PG8_WAIT_L
#undef PG8_BAR
#undef PG8_SCHED
#undef PG8_VOFF
}

constexpr int NXCD = 8, WGM = 8;
struct StaticOrder {
    int nM, nN, nwg, G, c;
    __device__ void init(int nM_, int nN_, int G_, int c_) { nM = nM_; nN = nN_; nwg = nM * nN; G = G_; c = c_; }
    __device__ bool next(int i, Unit& u) const {
        const long L = (long)i * G + c; if (L >= nwg) return false;
        int wgid = (int)L; { const int q = nwg / NXCD, r = nwg % NXCD, xcd = wgid % NXCD, off = wgid / NXCD; wgid = (xcd < r ? xcd * (q + 1) : r * (q + 1) + (xcd - r) * q) + off; }
        const int nig = WGM * nN, gid = wgid / nig, fm = gid * WGM, gsz = (nM - fm) < WGM ? (nM - fm) : WGM;
        u.pm = fm + ((wgid % nig) % gsz); u.pn = (wgid % nig) / gsz; u.om = u.pm; u.on = u.pn; u.aux = 0; return true;
    }
};
struct MergeOrder {
    int G, c;
    __device__ bool next(int i, Unit& u) const {
        const int n = i & 3; const long tile = (long)(i >> 2) * G + c; if (tile >= 256) return false;
        const int om = (int)tile >> 2, on = (int)tile & 3;
        u.pm = n * 64 + om; u.pn = n * 4 + on; u.om = om; u.on = on; u.aux = n; return true;
    }
};
struct MoeOrder {
    int ntiles, nN, nwg, G, c; int pend[NEXP];
    __device__ void init(const unsigned* cnt, int nN_, int G_, int c_) {
        int acc = 0;
#pragma unroll
        for (int e = 0; e < NEXP; ++e) { const int ce = (int)cnt[64 * e]; acc += (ce + 255) >> 8; pend[e] = acc; }
        ntiles = acc; nN = nN_; nwg = ntiles * nN; G = G_; c = c_;
    }
    __device__ bool next(int i, Unit& u) const {
        const long L = (long)i * G + c; if (L >= nwg) return false;
        const int wgid = (int)L;
        const int nig = WGM * nN, gid = wgid / nig, fm = gid * WGM, gsz = (ntiles - fm) < WGM ? (ntiles - fm) : WGM;
        const int pm = fm + ((wgid % nig) % gsz), pn = (wgid % nig) / gsz;
        int e = 0, ps = 0;
#pragma unroll
        for (int j = 0; j < NEXP - 1; ++j) if (pm >= pend[j]) { e = j + 1; ps = pend[j]; }
        u.pm = pm; u.pn = e * nN + pn; u.om = pm; u.on = pn; u.aux = e; u.gofs = e * 16384 - 256 * ps; return true;
    }
};

__device__ __forceinline__ u32x4 pack8(f32x4 a, f32x4 b) { u32x4 w; w.x = cvt_pk_bf16(a[0], a[1]); w.y = cvt_pk_bf16(a[2], a[3]); w.z = cvt_pk_bf16(b[0], b[1]); w.w = cvt_pk_bf16(b[2], b[3]); return w; }
struct EpiIn {
    bf16_t* Zs; bf16_t* Zg; const float* rowss; const float* bgate;
    __device__ __forceinline__ void operator()(const f32x4 (&acc)[2][2][4][2], const Unit& u, int wr, int wc, int fr, int fq) const {
        const int row0 = u.om * BM + wr * 64 + fr, colt = u.on * BM, cw = wc * 32 + 8 * fq;
        if (colt < ZSW) {
#pragma unroll
            for (int ai = 0; ai < 2; ++ai) { float rsd[4];
#pragma unroll
                for (int m = 0; m < 4; ++m) rsd[m] = row_rstd(rowss, row0 + ai * HALF + m * 16);
#pragma unroll
                for (int m = 0; m < 4; ++m) {
                    const int row = row0 + ai * HALF + m * 16; const float rstd = rsd[m];
#pragma unroll
                    for (int bj = 0; bj < 2; ++bj) *(u32x4*)(Zs + (size_t)row * ZSW + colt + bj * HALF + cw) = pack8(acc[ai][bj][m][0] * rstd, acc[ai][bj][m][1] * rstd);
                    if (m == 3) asm volatile("" ::: "memory");
                } }
        } else {
            const int gc0 = colt - ZSW + cw;
            const f32x4 b00 = *(const f32x4*)(bgate + gc0), b01 = *(const f32x4*)(bgate + gc0 + 4), b10 = *(const f32x4*)(bgate + gc0 + HALF), b11 = *(const f32x4*)(bgate + gc0 + HALF + 4);
#pragma unroll
            for (int ai = 0; ai < 2; ++ai) { float rsd[4];
#pragma unroll
                for (int m = 0; m < 4; ++m) rsd[m] = row_rstd(rowss, row0 + ai * HALF + m * 16);
#pragma unroll
                for (int m = 0; m < 4; ++m) {
                    const int row = row0 + ai * HALF + m * 16; const float rstd = rsd[m];
#pragma unroll
                    for (int bj = 0; bj < 2; ++bj) { f32x4 v0 = acc[ai][bj][m][0] * rstd + (bj ? b10 : b00), v1 = acc[ai][bj][m][1] * rstd + (bj ? b11 : b01);
                        *(u32x4*)(Zg + (size_t)row * ZGW + gc0 + bj * HALF) = pack8(v0, v1); }
                    if (m == 3) asm volatile("" ::: "memory");
                } }
        }
    }
};
struct EpiMerge {
    bf16_t* Mg; const bf16_t* Zg;
    __device__ __forceinline__ void operator()(const f32x4 (&acc)[2][2][4][2], const Unit& u, int wr, int wc, int fr, int fq) const {
        const int row0 = u.om * BM + wr * 64 + fr, colt = u.on * BM, cw = wc * 32 + 8 * fq, n = u.aux;
#pragma unroll
        for (int ai = 0; ai < 2; ++ai) {
            u32x4 gw[4][2], ow[4][2];
#pragma unroll
            for (int m = 0; m < 4; ++m)
#pragma unroll
                for (int bj = 0; bj < 2; ++bj) { const int row = row0 + ai * HALF + m * 16, col = colt + bj * HALF + cw;
                    gw[m][bj] = *(const u32x4*)(Zg + (size_t)row * ZGW + DBG_GPERM(n) * DM + col);
                    ow[m][bj] = n > 0 ? *(const u32x4*)(Mg + (size_t)row * DM + col) : (u32x4){0u, 0u, 0u, 0u}; }
#pragma unroll
            for (int m = 0; m < 4; ++m)
#pragma unroll
                for (int bj = 0; bj < 2; ++bj) { const int row = row0 + ai * HALF + m * 16, col = colt + bj * HALF + cw; const u32x4 g = gw[m][bj], o = ow[m][bj];
                    f32x4 v0 = acc[ai][bj][m][0], v1 = acc[ai][bj][m][1];
                    v0[0] = v0[0] * fsigmoid(bflo(g.x)) + bflo(o.x); v0[1] = v0[1] * fsigmoid(bfhi(g.x)) + bfhi(o.x); v0[2] = v0[2] * fsigmoid(bflo(g.y)) + bflo(o.y); v0[3] = v0[3] * fsigmoid(bfhi(g.y)) + bfhi(o.y);
                    v1[0] = v1[0] * fsigmoid(bflo(g.z)) + bflo(o.z); v1[1] = v1[1] * fsigmoid(bfhi(g.z)) + bfhi(o.z); v1[2] = v1[2] * fsigmoid(bflo(g.w)) + bflo(o.w); v1[3] = v1[3] * fsigmoid(bfhi(g.w)) + bfhi(o.w);
                    *(u32x4*)(Mg + (size_t)row * DM + col) = pack8(v0, v1); }
            asm volatile("" ::: "memory");
        }
    }
};
template <bool F32OUT, bool X8 = false, bool SC32 = false> struct EpiRes {
    float* xout; bf16_t* xb; float* rowss; unsigned char* x8;
    __device__ __forceinline__ void operator()(const f32x4 (&acc)[2][2][4][2], const Unit& u, int wr, int wc, int fr, int fq) const {
        const int row0 = u.om * BM + wr * 64 + fr, colt = u.on * BM, cw = wc * 32 + 8 * fq;
#pragma unroll
        for (int ai = 0; ai < 2; ++ai) {
            u32x4 xw[4][2];
#pragma unroll
            for (int m = 0; m < 4; ++m)
#pragma unroll
                for (int bj = 0; bj < 2; ++bj) xw[m][bj] = *(const u32x4*)(xb + (size_t)(row0 + ai * HALF + m * 16) * DM + colt + bj * HALF + cw);
#pragma unroll
            for (int m = 0; m < 4; ++m) {
                const int row = row0 + ai * HALF + m * 16; float ss = 0.f;
#pragma unroll
                for (int bj = 0; bj < 2; ++bj) { const size_t off = (size_t)row * DM + colt + bj * HALF + cw; const u32x4 w = xw[m][bj];
                    f32x4 v0 = acc[ai][bj][m][0], v1 = acc[ai][bj][m][1];
                    if constexpr (SC32) { v0 *= 0.03125f; v1 *= 0.03125f; }
                    v0[0] += bflo(w.x); v0[1] += bfhi(w.x); v0[2] += bflo(w.y); v0[3] += bfhi(w.y); v1[0] += bflo(w.z); v1[1] += bfhi(w.z); v1[2] += bflo(w.w); v1[3] += bfhi(w.w);
                    if constexpr (F32OUT) { *(f32x4*)(xout + off) = v0; *(f32x4*)(xout + off + 4) = v1; }
                    *(u32x4*)(xb + off) = pack8(v0, v1);
                    if constexpr (X8) { u32x2 q; q.x = cvt_pk4_fp8(v0[0], v0[1], v0[2], v0[3]); q.y = cvt_pk4_fp8(v1[0], v1[1], v1[2], v1[3]); *(u32x2*)(x8 + off) = q; }
                    ss += (v0[0] * v0[0] + v0[1] * v0[1]) + (v0[2] * v0[2] + v0[3] * v0[3]) + (v1[0] * v1[0] + v1[1] * v1[1]) + (v1[2] * v1[2] + v1[3] * v1[3]); }
                ss += __shfl_xor(ss, 16); ss += __shfl_xor(ss, 32);
                if (fq == 0) rowss[(size_t)row * 16 + u.on * 4 + wc] = ss;
            }
            asm volatile("" ::: "memory");
        }
    }
};
struct EpiRowScale {
    bf16_t* O; int ldc; const float* rowss;
    __device__ __forceinline__ void operator()(const f32x4 (&acc)[2][2][4][2], const Unit& u, int wr, int wc, int fr, int fq) const {
        const int row0 = u.om * BM + wr * 64 + fr, colt = u.on * BM, cw = wc * 32 + 8 * fq;
#pragma unroll
        for (int ai = 0; ai < 2; ++ai)
#pragma unroll
            for (int m = 0; m < 4; ++m) {
                const int row = row0 + ai * HALF + m * 16; const float rstd = row_rstd(rowss, row);
#pragma unroll
                for (int bj = 0; bj < 2; ++bj) *(u32x4*)(O + (size_t)row * ldc + colt + bj * HALF + cw) = pack8(acc[ai][bj][m][0] * rstd, acc[ai][bj][m][1] * rstd);
                if (m == 3) asm volatile("" ::: "memory");
            }
    }
};
template <bool MOE> struct EpiSwiGLU {
    bf16_t* H; int ldh; const float* rs; const int* row_tok;
    __device__ __forceinline__ void operator()(const f32x4 (&acc)[2][2][4][2], const Unit& u, int wr, int wc, int fr, int fq) const {
        const int row0 = u.om * BM + wr * 64 + fr, hc = u.on * HALF + wc * 32 + 8 * fq;
#pragma unroll
        for (int ai = 0; ai < 2; ++ai) { float rsd[4];
#pragma unroll
            for (int m = 0; m < 4; ++m) { const int row = row0 + ai * HALF + m * 16; rsd[m] = MOE ? rs[row_tok[row]] : row_rstd(rs, row); }
#pragma unroll
            for (int m = 0; m < 4; ++m) {
                const int row = row0 + ai * HALF + m * 16;
                const float rstd = rsd[m];
                f32x4 o[2];
#pragma unroll
                for (int n = 0; n < 2; ++n)
#pragma unroll
                    for (int j = 0; j < 4; ++j) { const float gv = acc[ai][0][m][n][j] * rstd, uv = acc[ai][1][m][n][j] * rstd; o[n][j] = gv * fsigmoid(gv) * uv; }
                *(u32x4*)(H + (size_t)row * ldh + hc) = pack8(o[0], o[1]);
                if (m == 3) asm volatile("" ::: "memory");
            } }
    }
};
template <bool RSTD, bool W32 = true> struct EpiSwiGLU8 {
    unsigned char* H; int ldh; const float* rs;
    __device__ __forceinline__ void operator()(const f32x4 (&acc)[2][2][4][2], const Unit& u, int wr, int wc, int fr, int fq) const {
        const int row0 = u.om * BM + wr * 64 + fr, hc = u.on * HALF + wc * 32 + 8 * fq;
#pragma unroll
        for (int ai = 0; ai < 2; ++ai)
#pragma unroll
            for (int m = 0; m < 4; ++m) {
                const int row = row0 + ai * HALF + m * 16;
                float sc = W32 ? 0.03125f : 1.f; if constexpr (RSTD) sc *= row_rstd(rs, row);
                f32x4 o[2];
#pragma unroll
                for (int n = 0; n < 2; ++n)
#pragma unroll
                    for (int j = 0; j < 4; ++j) { const float gv = acc[ai][0][m][n][j] * sc, uv = acc[ai][1][m][n][j] * sc; o[n][j] = gv * fsigmoid(gv) * uv; }
                u32x2 w; w.x = cvt_pk4_fp8(o[0][0], o[0][1], o[0][2], o[0][3]); w.y = cvt_pk4_fp8(o[1][0], o[1][1], o[1][2], o[1][3]);
                *(u32x2*)(H + (size_t)row * ldh + hc) = w;
                if (m == 3) asm volatile("" ::: "memory");
            }
    }
};
struct EpiPlain {
    bf16_t* O; int ldc; float sc;
    __device__ __forceinline__ void operator()(const f32x4 (&acc)[2][2][4][2], const Unit& u, int wr, int wc, int fr, int fq) const {
        const int row0 = u.om * BM + wr * 64 + fr, colt = u.on * BM, cw = wc * 32 + 8 * fq;
#pragma unroll
        for (int ai = 0; ai < 2; ++ai)
#pragma unroll
            for (int m = 0; m < 4; ++m) { const int row = row0 + ai * HALF + m * 16;
#pragma unroll
                for (int bj = 0; bj < 2; ++bj) *(u32x4*)(O + (size_t)row * ldc + colt + bj * HALF + cw) = pack8(acc[ai][bj][m][0] * sc, acc[ai][bj][m][1] * sc); }
    }
};
}

#define XB_TMO      128
#define XB_XCNT(j)  (256  + 64 * (j))
#define XB_XSUB(j)  (1280 + 64 * (j))
#define XB_XGEN(j)  (2304 + 64 * (j))
#define XB_TOP      3328
#define XB_TOPGEN   3392
#define XCD_BAR_WORDS 3456
#define XB_SPIN_CAP (1u << 18)
__device__ __forceinline__ unsigned xb_ld(unsigned* p)              { return __hip_atomic_load(p, __ATOMIC_RELAXED, __HIP_MEMORY_SCOPE_AGENT); }
__device__ __forceinline__ unsigned xb_add(unsigned* p, unsigned v) { return __hip_atomic_fetch_add(p, v, __ATOMIC_RELAXED, __HIP_MEMORY_SCOPE_AGENT); }
__device__ __forceinline__ unsigned xb_xcc_id() { return (unsigned)__builtin_amdgcn_s_getreg((3 << 11) | 20) & 0xFu; }
#define XB_SPIN(cond, bar) do { unsigned _sp = 0; while (cond) { __builtin_amdgcn_s_sleep(1); \
    if ((++_sp & 255u) == 0u) { if (xb_ld(&(bar)[XB_TMO])) break; if (_sp > XB_SPIN_CAP) { atomicAdd(&(bar)[XB_TMO], 1u); break; } } } } while (0)
struct XcdBarrier { unsigned* bar; unsigned x; volatile LAS unsigned* st; };
__device__ __forceinline__ XcdBarrier xcd_barrier_post(unsigned* bar, volatile LAS unsigned* st) {
    XcdBarrier b; b.bar = bar; b.x = xb_xcc_id(); b.st = st;
    if (threadIdx.x == 0) (void)xb_add(&bar[XB_XCNT(b.x)], 1u);
    return b;
}
__device__ __forceinline__ void xcd_barrier_complete(unsigned* bar, unsigned x, unsigned& nloc, unsigned& nx) {
    const unsigned G = gridDim.x * gridDim.y * gridDim.z;
    unsigned sum, cnt, mine, sp = 0u;
    for (;;) {
        sum = 0u; cnt = 0u; mine = 0u;
#pragma unroll
        for (unsigned j = 0; j < 16; ++j) { const unsigned c = xb_ld(&bar[XB_XCNT(j)]); sum += c; cnt += (c > 0u) ? 1u : 0u; mine = (j == x) ? c : mine; }
        if (sum == G) break;
        __builtin_amdgcn_s_sleep(1);
        if ((++sp & 255u) == 0u) { if (xb_ld(&bar[XB_TMO])) break; if (sp > XB_SPIN_CAP) { atomicAdd(&bar[XB_TMO], 1u); break; } }
    }
    nloc = mine > 0u ? mine : 1u; nx = cnt > 0u ? cnt : 1u;
}
__device__ __forceinline__ void xcd_barrier(const XcdBarrier& b) {
    asm volatile("s_waitcnt vmcnt(0)" ::: "memory");
    __syncthreads();
    if (threadIdx.x == 0) {
        unsigned* bar = b.bar;
        __builtin_amdgcn_s_waitcnt(0);
        unsigned nloc = b.st[0], nx = b.st[1];
        if (nloc == 0u) { xcd_barrier_complete(bar, b.x, nloc, nx); b.st[0] = nloc; b.st[1] = nx; }
        const unsigned old = xb_add(&bar[XB_XSUB(b.x)], 1u);
        const unsigned gen = old / nloc;
        if (old + 1u == (gen + 1u) * nloc) {
            __builtin_amdgcn_fence(__ATOMIC_RELEASE, "agent");
            asm volatile("s_waitcnt vmcnt(0)" ::: "memory");
            const unsigned og = xb_add(&bar[XB_TOP], 1u);
            const unsigned tg = og / nx;
            if (og + 1u == (tg + 1u) * nx) xb_add(&bar[XB_TOPGEN], 1u);
            else XB_SPIN(xb_ld(&bar[XB_TOPGEN]) == tg, bar);
            __builtin_amdgcn_fence(__ATOMIC_ACQUIRE, "agent");
            xb_add(&bar[XB_XGEN(b.x)], 1u);
            asm volatile("s_waitcnt vmcnt(0)" ::: "memory");
        } else {
            XB_SPIN(xb_ld(&bar[XB_XGEN(b.x)]) == gen, bar);
            __builtin_amdgcn_fence(__ATOMIC_ACQUIRE, "agent");
            asm volatile("s_waitcnt vmcnt(0)" ::: "memory");
        }
    }
    __syncthreads();
}

struct Args { const void* in[55]; float* out; unsigned char* ws; int ph_lo, ph_hi, submask, pad; };
struct Frame {
    LAS unsigned char* lds; unsigned char* ws; unsigned* ctl; float* out;
    int tid, lane, wave, G, bid, gw, ngw;
};
#define GAS __attribute__((address_space(1)))
#define CAS __attribute__((address_space(4)))
#define PHASE_BEGIN() const CAS char* kp_ = (const CAS char*)__builtin_amdgcn_kernarg_segment_ptr(); asm volatile("" : "+s"(kp_)); \
    unsigned char* ws = (unsigned char*)(GAS unsigned char*)(*(const CAS unsigned long long*)(kp_ + 448)); \
    Frame F; { int t_ = threadIdx.x; asm volatile("" : "+v"(t_)); int b_ = blockIdx.x; asm volatile("" : "+s"(b_)); \
      F.lds = (LAS unsigned char*)lds_raw; F.ws = ws; F.ctl = (unsigned*)(ws + WS_CTL); F.out = (float*)(GAS float*)(*(const CAS unsigned long long*)(kp_ + 440)); \
      F.tid = t_; F.lane = t_ & 63; F.wave = __builtin_amdgcn_readfirstlane(t_ >> 6); F.G = gridDim.x; F.bid = b_; F.gw = b_ * 8 + F.wave; F.ngw = F.G * 8; }
#define XB ((bf16_t*)(ws + WS_XB))
#define RS ((float*)(ws + WS_RSP))
#define ZS ((bf16_t*)(ws + WS_ZS))
#define ZG ((bf16_t*)(ws + WS_ZG))
#define YB ((bf16_t*)(ws + WS_Y))
#define MG ((bf16_t*)(ws + WS_MERGED))
#define S5T ((float*)(ws + WS_TAB + TAB_S5T))
#define CMAT ((bf16_t*)(ws + WS_TAB + TAB_CMAT))
#define MISCT ((float*)(ws + WS_TAB + TAB_MISC))
#define BBF ((bf16_t*)(ws + WS_TAB + 832 * 1024))
#define WLP(l) (ws + WS_WL + (size_t)(l) * WL_STRIDE)
#define INF(i) ((const float*)(const GAS float*)(*(const CAS unsigned long long*)(kp_ + 8 * (i))))

struct TJob { const float* W; bf16_t* WT; const float* ks; int K, N, ldw, ldk, nb, map; size_t sstride, dstride; int f8; };
__device__ __forceinline__ int tjob_items(const TJob& j) { return j.nb * (j.K / 64) * (j.N / 32); }
__device__ __forceinline__ void tjob_load(const TJob& j, int item, float (&v)[32], int lane) {
    const int per = (j.K / 64) * (j.N / 32), b = item / per, r = item % per, nblk = j.N / 32, kb = r / nblk, nbk = r % nblk, k0 = 64 * kb, n0 = 32 * nbk;
    const float* W = j.W + (size_t)b * j.sstride + (size_t)(k0 + (lane >> 5)) * j.ldw + n0 + (lane & 31);
#pragma unroll
    for (int i = 0; i < 32; ++i) v[i] = __builtin_nontemporal_load(W + (size_t)(2 * i) * j.ldw);
}
__device__ __forceinline__ void tjob_store(const TJob& j, int item, float (&v)[32], LAS float* scr, int lane) {
    const int per = (j.K / 64) * (j.N / 32), b = item / per, r = item % per, nblk = j.N / 32, kb = r / nblk, nbk = r % nblk, k0 = 64 * kb, n0 = 32 * nbk;
    int drow = n0;
    if (j.map == 1) drow = n0 < C_END ? n0 : n0 + (ZSW - C_END);
    else if (j.map == 2) drow = 256 * (n0 >> 7) + (n0 & 127);
    else if (j.map == 3) drow = 256 * (n0 >> 7) + 128 + (n0 & 127);
    if (j.ks) {
#pragma unroll
        for (int i = 0; i < 32; ++i) v[i] *= j.ks[k0 + 2 * i + (lane >> 5)]; }
#pragma unroll
    for (int i = 0; i < 32; ++i) scr[(2 * i + (lane >> 5)) * 33 + (lane & 31)] = v[i];
    asm volatile("s_waitcnt lgkmcnt(0)" ::: "memory");
    const int c = lane & 7; bf16_t* WT = j.WT + (size_t)b * j.dstride;
    if (j.f8) { unsigned char* W8 = (unsigned char*)j.WT + (size_t)b * j.dstride;
#pragma unroll
        for (int q = 0; q < 4; ++q) { const int n = (lane >> 3) + 8 * q; const LAS float* sp = scr + (8 * c) * 33 + n;
            u32x2 o; o.x = cvt_pk4_fp8(sp[0 * 33] * 32.f, sp[1 * 33] * 32.f, sp[2 * 33] * 32.f, sp[3 * 33] * 32.f); o.y = cvt_pk4_fp8(sp[4 * 33] * 32.f, sp[5 * 33] * 32.f, sp[6 * 33] * 32.f, sp[7 * 33] * 32.f);
            *(u32x2*)(W8 + (size_t)(drow + n) * j.ldk + k0 + 8 * c) = o; }
    } else
#pragma unroll
    for (int q = 0; q < 4; ++q) { const int n = (lane >> 3) + 8 * q; const LAS float* sp = scr + (8 * c) * 33 + n;
        u32x4 o; o.x = cvt_pk_bf16(sp[0 * 33], sp[1 * 33]); o.y = cvt_pk_bf16(sp[2 * 33], sp[3 * 33]); o.z = cvt_pk_bf16(sp[4 * 33], sp[5 * 33]); o.w = cvt_pk_bf16(sp[6 * 33], sp[7 * 33]);
        *(u32x4*)(WT + (size_t)(drow + n) * j.ldk + k0 + 8 * c) = o; }
    asm volatile("s_waitcnt lgkmcnt(0)" ::: "memory");
}
__device__ __forceinline__ void tjob_run_all(const TJob& j, int first, int stride, LAS float* scr, int lane) {
    const int ni = tjob_items(j); int it = first; if (it >= ni) return;
    float va[32], vb[32]; tjob_load(j, it, va, lane);
    for (;;) {
        const int n1 = it + stride; if (n1 < ni) tjob_load(j, n1, vb, lane);
        tjob_store(j, it, va, scr, lane); if (n1 >= ni) break;
        const int n2 = n1 + stride; if (n2 < ni) tjob_load(j, n2, va, lane);
        tjob_store(j, n1, vb, scr, lane); if (n2 >= ni) break;
        it = n2;
    }
}

template <int DQ> struct AttnLds { static constexpr int KROW = DQ * 2 + 16, VROW = 272, KBYTES = 128 * KROW, VBYTES = 64 * VROW, BUF = KBYTES + VBYTES; };
#define PK4(P, BASE, OUT) do { unsigned a0_ = cvt_pk_bf16(P[BASE + 0], P[BASE + 1]), a1_ = cvt_pk_bf16(P[BASE + 2], P[BASE + 3]); \
    unsigned b0_ = cvt_pk_bf16(P[BASE + 4], P[BASE + 5]), b1_ = cvt_pk_bf16(P[BASE + 6], P[BASE + 7]); \
    auto r0_ = __builtin_amdgcn_permlane32_swap(a0_, b0_, false, false); auto r1_ = __builtin_amdgcn_permlane32_swap(a1_, b1_, false, false); \
    u32x4 w_ = {r0_[0], r1_[0], r0_[1], r1_[1]}; OUT = *(bf16x8*)&w_; } while (0)

template <int DQ, int NMAP, bool CAUSAL, bool BIAS, bool QNORM>
__device__ __forceinline__ void attn_unit(LAS unsigned char* lds, const bf16_t* Qp, int ldq, const bf16_t* Kp, const bf16_t* Vtp, int vstride, int nkt, int q0,
                                          const LAS float* lut, const float* qg, float qscale, float mshift, f32x16 (&o)[NMAP][2], float (&l)[NMAP]) {
    typedef AttnLds<DQ> L; constexpr int KD = DQ / NMAP, KS = KD / 16, KCH = DQ / 8, NKC = 64 * KCH;
    int tid = threadIdx.x; asm volatile("" : "+v"(tid));
    const int wid = tid >> 6, lane = tid & 63, r32 = lane & 31, hi = lane >> 5;
    bf16x8 q[NMAP][KS];
    {
        const bf16_t* qrow = Qp + (size_t)(wid * 32 + r32) * ldq + hi * 8;
#pragma unroll
        for (int mp = 0; mp < NMAP; ++mp)
#pragma unroll
            for (int ks = 0; ks < KS; ++ks) q[mp][ks] = ldg8(qrow + mp * KD + ks * 16);
        if constexpr (QNORM) {
            float ss = 0.f;
#pragma unroll
            for (int ks = 0; ks < KS; ++ks) ss += sq8(q[0][ks]);
            ss += __shfl_xor(ss, 32);
            const float rs = frsq(ss * (1.f / DQ) + EPS) * qscale;
#pragma unroll
            for (int ks = 0; ks < KS; ++ks) { u32x4 w = *(u32x4*)&q[0][ks]; const float* gp = qg + ks * 16 + hi * 8;
                w.x = cvt_pk_bf16(bflo(w.x) * rs * gp[0], bfhi(w.x) * rs * gp[1]); w.y = cvt_pk_bf16(bflo(w.y) * rs * gp[2], bfhi(w.y) * rs * gp[3]);
                w.z = cvt_pk_bf16(bflo(w.z) * rs * gp[4], bfhi(w.z) * rs * gp[5]); w.w = cvt_pk_bf16(bflo(w.w) * rs * gp[6], bfhi(w.w) * rs * gp[7]);
                q[0][ks] = *(bf16x8*)&w; }
        }
    }
#pragma unroll
    for (int mp = 0; mp < NMAP; ++mp) { l[mp] = 0.f; o[mp][0] = f32x16{}; o[mp][1] = f32x16{}; }
    constexpr int NKI = (128 * KCH) / 512;
    bf16x8 skr[NKI], svr[2];
#define AT_LOAD(j) do { const int key0_ = (j) * 128; \
        _Pragma("unroll") for (int i_ = 0; i_ < NKI; ++i_) { const int c_ = tid + 512 * i_; skr[i_] = ldg8(Kp + (size_t)(key0_ + c_ / KCH) * DQ + (c_ % KCH) * 8); } \
        _Pragma("unroll") for (int i_ = 0; i_ < 2; ++i_) { const int c_ = tid + 512 * i_; svr[i_] = ldg8(Vtp + (size_t)(c_ >> 4) * vstride + key0_ + (c_ & 15) * 8); } } while (0)
#define AT_WRITE(b) do { LAS unsigned char* base_ = lds + (b) * L::BUF; \
        _Pragma("unroll") for (int i_ = 0; i_ < NKI; ++i_) { const int c_ = tid + 512 * i_; *(LAS bf16x8*)(base_ + (c_ / KCH) * L::KROW + (c_ % KCH) * 16) = skr[i_]; } \
        _Pragma("unroll") for (int i_ = 0; i_ < 2; ++i_) { const int c_ = tid + 512 * i_; *(LAS bf16x8*)(base_ + L::KBYTES + (c_ >> 4) * L::VROW + (c_ & 15) * 16) = svr[i_]; } } while (0)
    const int qi = q0 + wid * 32 + r32;
    const int qlo = q0 + wid * 32;
#define AT_COMPUTE(key0, bf, sb) do { const bool active = !CAUSAL || (key0) <= qlo + 31; \
        if (active) { const LAS unsigned char* kb = lds + (bf) * L::BUF + (sb) * 64 * L::KROW; const LAS unsigned char* vb = lds + (bf) * L::BUF + L::KBYTES + (sb) * 128; const bool need_mask = CAUSAL && ((key0) + 63 > qlo); \
            _Pragma("unroll") for (int mp = 0; mp < NMAP; ++mp) { f32x16 p0 = f32x16{}, p1 = f32x16{}; \
                _Pragma("unroll") for (int ks = 0; ks < KS; ++ks) { \
                    const bf16x8 a0 = *(const LAS bf16x8*)(kb + r32 * L::KROW + (mp * KD + ks * 16 + hi * 8) * 2); \
                    const bf16x8 a1 = *(const LAS bf16x8*)(kb + (32 + r32) * L::KROW + (mp * KD + ks * 16 + hi * 8) * 2); \
                    p0 = MFMA32(a0, q[mp][ks], p0); p1 = MFMA32(a1, q[mp][ks], p1); } \
                __builtin_amdgcn_sched_barrier(0); \
                float sh = mshift; \
                if constexpr (BIAS) { \
                    if (qlo - ((key0) + 63) >= 127) sh -= lut[255]; \
                    else { const LAS float* lp = lut + (qi - (key0) - 4 * hi + 69); \
                        _Pragma("unroll") for (int r = 0; r < 16; ++r) { const int cr = (r & 3) + 8 * (r >> 2); p0[r] += lp[59 - cr]; p1[r] += lp[27 - cr]; } } } \
                if (need_mask) { _Pragma("unroll") for (int r = 0; r < 16; ++r) { const int kk = (key0) + crow(r, hi); if (kk > qi) p0[r] = -1e30f; if (kk + 32 > qi) p1[r] = -1e30f; } } \
                float ps = 0.f; \
                _Pragma("unroll") for (int r = 0; r < 16; ++r) { p0[r] = fexp2(p0[r] - sh); p1[r] = fexp2(p1[r] - sh); ps += p0[r] + p1[r]; } \
                l[mp] += ps; \
                __builtin_amdgcn_sched_barrier(0); \
                bf16x8 pa0, pa1, pa2, pa3; \
                PK4(p0, 0, pa0); PK4(p0, 8, pa1); PK4(p1, 0, pa2); PK4(p1, 8, pa3); \
                _Pragma("unroll") for (int dt = 0; dt < 2; ++dt) { \
                    const LAS unsigned char* vrow = vb + (dt * 32 + r32) * L::VROW + hi * 16; \
                    const bf16x8 v0 = *(const LAS bf16x8*)(vrow), v1 = *(const LAS bf16x8*)(vrow + 32), v2 = *(const LAS bf16x8*)(vrow + 64), v3 = *(const LAS bf16x8*)(vrow + 96); \
                    o[mp][dt] = MFMA32(v0, pa0, o[mp][dt]); o[mp][dt] = MFMA32(v1, pa1, o[mp][dt]); o[mp][dt] = MFMA32(v2, pa2, o[mp][dt]); o[mp][dt] = MFMA32(v3, pa3, o[mp][dt]); } \
                __builtin_amdgcn_sched_barrier(0); } } } while (0)
    const int n128 = nkt >> 1;
    if (wid < 4) __builtin_amdgcn_s_setprio(2);
    AT_LOAD(0); AT_WRITE(0); __syncthreads();
    for (int j = 0; j < n128; ++j) {
        if (j + 1 < n128) AT_LOAD(j + 1);
        AT_COMPUTE(j * 128, j & 1, 0);
        AT_COMPUTE(j * 128 + 64, j & 1, 1);
        if (j + 1 < n128) AT_WRITE((j + 1) & 1);
        __syncthreads();
    }
    __builtin_amdgcn_s_setprio(0);
#undef AT_COMPUTE
#pragma unroll
    for (int mp = 0; mp < NMAP; ++mp) l[mp] += __shfl_xor(l[mp], 32);
#undef AT_LOAD
#undef AT_WRITE
}

__device__ __forceinline__ void attn_store(bf16_t* dst, const f32x16 (&o)[2], float scale, int hi) {
#pragma unroll
    for (int dt = 0; dt < 2; ++dt)
#pragma unroll
        for (int rg = 0; rg < 4; ++rg) { u32x2 w; w.x = cvt_pk_bf16(o[dt][4 * rg] * scale, o[dt][4 * rg + 1] * scale); w.y = cvt_pk_bf16(o[dt][4 * rg + 2] * scale, o[dt][4 * rg + 3] * scale);
            *(u32x2*)(dst + dt * 32 + 8 * rg + 4 * hi) = w; }
}

__device__ __forceinline__ bool in_phase(int k) { const __attribute__((address_space(4))) int* p_ = (const __attribute__((address_space(4))) int*)__builtin_amdgcn_kernarg_segment_ptr(); asm volatile("" : "+s"(p_)); return p_[114] <= k && k < p_[115]; }
__device__ __forceinline__ bool sub_on(int k) { const __attribute__((address_space(4))) int* p_ = (const __attribute__((address_space(4))) int*)__builtin_amdgcn_kernarg_segment_ptr(); asm volatile("" : "+s"(p_)); return (p_[116] >> k) & 1; }
__device__ __forceinline__ void s5_bu_tile(LAS unsigned char* tile, const bf16_t* bbf_g, const bf16_t* zs_tok0, int lane) {
    const int r32 = lane & 31, hi = lane >> 5;
    const bf16x8 uf = ldg8(zs_tok0 + (size_t)r32 * ZSW + 8 * hi);
#pragma unroll
    for (int pt = 0; pt < 4; ++pt) { f32x16 d = f32x16{}; d = MFMA32(ldg8(bbf_g + (size_t)(32 * pt + r32) * 16 + 8 * hi), uf, d);
#pragma unroll
        for (int rg = 0; rg < 4; ++rg) { u32x2 w; w.x = cvt_pk_bf16(d[4 * rg], d[4 * rg + 1]); w.y = cvt_pk_bf16(d[4 * rg + 2], d[4 * rg + 3]);
            *(LAS u32x2*)(tile + r32 * 272 + (32 * pt + 8 * rg + 4 * hi) * 2) = w; } }
    asm volatile("s_waitcnt lgkmcnt(0)" ::: "memory");
}
__device__ __forceinline__ int h0_pull(LAS unsigned* qc, int lane, int wg_items, int bid, int G, int total) {
    unsigned k = 0u; if (lane == 0) k = __hip_atomic_fetch_add(qc, 1u, __ATOMIC_RELAXED, __HIP_MEMORY_SCOPE_WORKGROUP);
    const int kk = __builtin_amdgcn_readfirstlane((int)k);
    return kk < wg_items ? bid + kk * G : total;
}
__device__ __forceinline__ int queue_pull(unsigned* ctr, volatile LAS unsigned* slot, int tid) {
    __syncthreads();
    if (tid == 0) *slot = __hip_atomic_fetch_add(ctr, 1u, __ATOMIC_RELAXED, __HIP_MEMORY_SCOPE_AGENT);
    __syncthreads();
    return (int)*slot;
}
constexpr int NPHASE = 24;
#ifndef DBG_NPH
#endif
__global__ void __launch_bounds__(512, 2) hybrid_fwd(Args args) {
    extern __shared__ __attribute__((aligned(16))) unsigned char lds_raw[];
    LAS unsigned char* lds0 = (LAS unsigned char*)lds_raw;
    volatile LAS unsigned* MISC = (volatile LAS unsigned*)(lds0 + MISC_OFF);
    for (int u = threadIdx.x; u < (LDS_BYTES - RING_BYTES) / 4; u += 512) ((LAS unsigned*)(lds0 + RING_BYTES))[u] = 0u;
    __syncthreads();
    const int lo = args.ph_lo, hi_ph = args.ph_hi;
    const bool one_launch = (hi_ph - lo) > 1;
    XcdBarrier bar; bar.bar = (unsigned*)(args.ws + WS_CTL) + CW_BAR; bar.x = 0; bar.st = nullptr;
    if (one_launch) bar = xcd_barrier_post((unsigned*)(args.ws + WS_CTL) + CW_BAR, MISC + 8);
#ifndef SUBMASK
#define SUBMASK 0xFFFFu
#endif
#define SUB(k) ((((SUBMASK) >> (k)) & 1u) && sub_on(k))
#ifndef PHMASK
#define PHMASK 0xFFFFFFu
#endif
#define IN(k) ((((PHMASK) >> (k)) & 1u) && in_phase(k))
#define SEAM(k) do { if (IN(k) && IN((k) + 1)) { XcdBarrier b2_ = bar; asm volatile("" : "+s"(b2_.bar), "+s"(b2_.x)); xcd_barrier(b2_); } } while (0)

    if (IN(0)) { PHASE_BEGIN();
        LAS float* scr = (LAS float*)(F.lds + F.wave * 16384);
        int joff = 0;
        for (int l = 0; l < 2; ++l) {
            unsigned char* wl = ws + WS_WL + l * WL_STRIDE;
#define RUNJOB(...) do { const TJob jb_ = TJob{__VA_ARGS__}; int fst_ = F.gw - joff; if (fst_ < 0) fst_ += F.ngw; tjob_run_all(jb_, fst_, F.ngw, scr, F.lane); joff = (joff + tjob_items(jb_)) % F.ngw; } while (0)
            RUNJOB(INF(8) + (size_t)l * DM * DIN, (bf16_t*)(wl + WL_WIN), INF(4) + l * DM, DM, DIN, DIN, DM, 1, 1, 0, 0);
            RUNJOB(INF(22) + (size_t)l * 192 * 384, (bf16_t*)(wl + WL_SM + SM_WUQ), INF(20) + l * 192, 192, 384, 384, 192, 1, 0, 0, 0);
            RUNJOB(INF(23) + (size_t)l * 128 * 512, (bf16_t*)(wl + WL_SM + SM_WUKV), INF(21) + l * 128, 128, 512, 512, 128, 1, 0, 0, 0);
            RUNJOB(INF(28) + (size_t)l * 4 * 4096, (bf16_t*)(wl + WL_SM + SM_WR), nullptr, 64, 64, 64, 64, 4, 0, 4096, 4096);
            RUNJOB(INF(30) + (size_t)l * 4 * 4096, (bf16_t*)(wl + WL_SM + SM_WI), nullptr, 64, 64, 64, 64, 4, 0, 4096, 4096);
            RUNJOB(INF(18) + (size_t)l * 65536, (bf16_t*)(wl + WL_SM + SM_WGLU), nullptr, 256, 256, 256, 256, 1, 0, 0, 0);
            RUNJOB(INF(40) + (size_t)l * 4 * 256 * DM, (bf16_t*)(wl + WL_PT), nullptr, 256, DM, DM, 256, 4, 0, (size_t)256 * DM, (size_t)DM * 256);
            RUNJOB(INF(41) + (size_t)l * DM * DM, (bf16_t*)(wl + WL_WO), nullptr, DM, DM, DM, DM, 1, 0, 0, 0);
            RUNJOB(INF(42) + (size_t)l * DM * 256, (bf16_t*)(wl + WL_WXQ), INF(5) + l * DM, DM, 256, 256, DM, 1, 0, 0, 0);
            RUNJOB(INF(43) + (size_t)l * DM * 256, (bf16_t*)(wl + WL_WXKV), INF(6) + l * DM, DM, 256, 256, DM, 1, 0, 0, 0);
            RUNJOB(INF(44) + (size_t)l * DM * 256, (bf16_t*)(wl + WL_WXKV) + (size_t)256 * DM, INF(6) + l * DM, DM, 256, 256, DM, 1, 0, 0, 0);
            RUNJOB(INF(45) + (size_t)l * 256 * DM, (bf16_t*)(wl + WL_WXO), nullptr, 256, DM, DM, 256, 1, 0, 0, 0);
            { u32x4* z = (u32x4*)((bf16_t*)(wl + WL_WIN) + (size_t)C_END * DM); const int n16 = (ZSW - C_END) * DM * 2 / 16;
              for (int i = F.bid * 512 + F.tid; i < n16; i += F.G * 512) z[i] = (u32x4){0u, 0u, 0u, 0u}; }
        }
        {
            RUNJOB(INF(48), (bf16_t*)(ws + WS_WGU), INF(7), DM, FF, FF, DM, 1, 2, 0, 0);
            RUNJOB(INF(49), (bf16_t*)(ws + WS_WGU), INF(7), DM, FF, FF, DM, 1, 3, 0, 0);
            RUNJOB(INF(50), (bf16_t*)(ws + WS_WD), nullptr, FF, DM, DM, FF, 1, 0, 0, 0, G2_FP8);
        }
        for (int i = F.bid * 512 + F.tid; i < 2 * 16 * 64; i += F.G * 512) {
            const int l = i >> 10, g = (i >> 6) & 15, p = i & 63;
            const float dt = __expf(INF(12)[l * 16 + g]);
            const float lr = INF(10)[(l * 16 + g) * 64 + p], li = INF(11)[(l * 16 + g) * 64 + p];
            const float mag = __expf(lr * dt); float sn, cs; sincos_red(li * dt, sn, cs);
            const float ar = mag * cs, ai = mag * sn, den = lr * lr + li * li;
            const float zr = ((ar - 1.f) * lr + ai * li) / den, zi = (ai * lr - (ar - 1.f) * li) / den;
            float* tb = S5T + (size_t)(l * 16 + g) * 36 * 64;
            for (int c = 0; c < 16; ++c) { const float br = INF(13)[((l * 16 + g) * 64 + p) * 16 + c], bi = INF(14)[((l * 16 + g) * 64 + p) * 16 + c];
                tb[c * 64 + p] = zr * br - zi * bi; tb[(16 + c) * 64 + p] = zr * bi + zi * br;
                BBF[((size_t)(l * 16 + g) * 128 + p) * 16 + c] = f2bf(zr * br - zi * bi); BBF[((size_t)(l * 16 + g) * 128 + 64 + p) * 16 + c] = f2bf(zr * bi + zi * br); }
            tb[32 * 64 + p] = ar; tb[33 * 64 + p] = ai;
            float pr = ar, pi = ai;
            for (int s = 0; s < 6; ++s) { const float nr = pr * pr - pi * pi, ni = 2.f * pr * pi; pr = nr; pi = ni; }
            tb[34 * 64 + p] = pr; tb[35 * 64 + p] = pi;
            bf16_t* cm = CMAT + (size_t)(l * 16 + g) * 16 * 128;
            for (int c = 0; c < 16; ++c) { cm[c * 128 + p] = f2bf(INF(15)[((l * 16 + g) * 16 + c) * 64 + p]); cm[c * 128 + 64 + p] = f2bf(-INF(16)[((l * 16 + g) * 16 + c) * 64 + p]); }
        }
        for (int i = F.bid * 512 + F.tid; i < 512; i += F.G * 512) { const float lam = INF(32)[i]; MISCT[i] = 8.f * log1pf(__expf(-lam)); }
        if (F.bid == 0 && F.tid < 2) { const int l = F.tid; float s1 = 0.f, s2 = 0.f;
            for (int d = 0; d < 32; ++d) { s1 += INF(35)[l * 32 + d] * INF(36)[l * 32 + d]; s2 += INF(37)[l * 32 + d] * INF(38)[l * 32 + d]; }
            const float lam_init = 0.8f - 0.6f * expf(-0.3f * (float)l);
            MISCT[512 + l] = expf(s1) - expf(s2) + lam_init; MISCT[514 + l] = lam_init;
            float gq = 0.f, gk = 0.f; for (int d = 0; d < 96; ++d) { gq = fmaxf(gq, fabsf(INF(24)[l * 96 + d])); gk = fmaxf(gk, fabsf(INF(25)[l * 96 + d])); }
            MISCT[516 + l * 4 + 0] = 1.02f * gq * gk * 9.797958971f * LOG2E;
            gq = 0.f; gk = 0.f; for (int d = 0; d < 32; ++d) { gq = fmaxf(gq, fabsf(INF(33)[l * 32 + d])); gk = fmaxf(gk, fabsf(INF(34)[l * 32 + d])); }
            float bm = 0.f; for (int i = 0; i < 128; ++i) bm = fmaxf(bm, fabsf(INF(3)[i]));
            MISCT[516 + l * 4 + 1] = 1.02f * gq * gk * 5.656854249f * LOG2E + bm * LOG2E;
            gq = 0.f; gk = 0.f; for (int d = 0; d < 64; ++d) { gq = fmaxf(gq, fabsf(INF(46)[l * 64 + d])); gk = fmaxf(gk, fabsf(INF(47)[l * 64 + d])); }
            MISCT[516 + l * 4 + 2] = 1.02f * gq * gk * 8.f * LOG2E; }
        for (int i = F.bid * 512 + F.tid; i < 4 * 384; i += F.G * 512) { const int h = i / 384, dd = i % 384 - 128, d = dd > 127 ? 127 : dd; int bk;
            if (d < 16) bk = d < 0 ? 0 : d; else { const float lr_ = logf((float)d / 16.f) / logf(8.f); bk = 16 + (int)(lr_ * 16.f); if (bk > 31) bk = 31; }
            MISCT[1024 + i] = dd < 0 ? 0.f : INF(3)[bk * 4 + h] * LOG2E; }
        for (int m = F.gw; m < MTOK; m += F.ngw) {
            const f32x4* xr = (const f32x4*)(INF(0) + (size_t)m * DM) + F.lane; float s = 0.f;
            u32x2* o8 = (u32x2*)(XB + (size_t)m * DM) + F.lane;
#pragma unroll
            for (int j = 0; j < 4; ++j) { const f32x4 v = xr[64 * j]; s += (v.x * v.x + v.y * v.y) + (v.z * v.z + v.w * v.w); u32x2 w; w.x = cvt_pk_bf16(v.x, v.y); w.y = cvt_pk_bf16(v.z, v.w); o8[64 * j] = w; }
            s = wave_sum(s); if (F.lane < 16) RS[(size_t)m * 16 + F.lane] = F.lane == 0 ? s : 0.f;
        }
    }
    SEAM(0);

    for (int l = 0; l < 2; ++l) {
        const int pb = 1 + 10 * l;
        if (IN(pb + 0)) { PHASE_BEGIN();
            pg8::Gemm g{XB, (const bf16_t*)(WLP(l) + WL_WIN), DM, nullptr}; pg8::StaticOrder S; S.init(MTOK / 256, NIN / 256, F.G, F.bid);
            pg8::EpiIn E{ZS, ZG, RS + (size_t)(l == 0 ? 0 : 3) * MTOK * 16, INF(9) + (size_t)l * 4 * DM};
            pg8::gemm_phase<pg8::EpiIn, pg8::StaticOrder, true, false>(F.lds, g, S, E);
        }
        SEAM(pb + 0);
        if (IN(pb + 1)) { PHASE_BEGIN();
            const int lane = F.lane, r = lane & 31, hi = lane >> 5;
            bf16_t* QM = (bf16_t*)(ws + WS_QM); bf16_t* KM = (bf16_t*)(ws + WS_KM); bf16_t* VMT = (bf16_t*)(ws + WS_VMT);
            if (SUB(0) && F.wave < 2) for (int tt = F.bid * 2 + F.wave; tt < 512; tt += F.G * 2) {
                const int row = tt * 32 + r, b = row >> 12, s = row & 4095;
                bf16x8 xq[12]; float ss = 0.f;
#pragma unroll
                for (int ks = 0; ks < 12; ++ks) { xq[ks] = ldg8(ZS + (size_t)row * ZSW + C_CQ + 16 * ks + 8 * hi); ss += sq8(xq[ks]); }
                ss += __shfl_xor(ss, 32); const float rc = frsq(ss * (1.f / 192.f) + EPS);
                const float pos = (float)((const int*)INF(2))[row]; float cs[8], sn[8];
#pragma unroll
                for (int i = 0; i < 8; ++i) { const int fi = crow(i, hi); const float inv = exp2f(-(float)fi * (13.287712379549449f / 16.f)); sincos_red(pos * inv, sn[i], cs[i]); }
                const bf16_t* W = (const bf16_t*)(WLP(l) + WL_SM + SM_WUQ); const float* gq = INF(24) + l * 96;
#pragma unroll 1
                for (int hd = 0; hd < 4; ++hd) {
                    f32x16 acc[3] = {f32x16{}, f32x16{}, f32x16{}};
#pragma unroll
                    for (int ft = 0; ft < 3; ++ft) {
#pragma unroll
                        for (int ks = 0; ks < 12; ++ks) acc[ft] = MFMA32(ldg8(W + (size_t)(hd * 96 + 32 * ft + r) * 192 + 16 * ks + 8 * hi), xq[ks], acc[ft]); }
                    float s2 = 0.f;
#pragma unroll
                    for (int ft = 0; ft < 3; ++ft)
#pragma unroll
                        for (int q = 0; q < 16; ++q) { acc[ft][q] *= rc; s2 += acc[ft][q] * acc[ft][q]; }
                    s2 += __shfl_xor(s2, 32); const float rq = frsq(s2 * (1.f / 96.f) + EPS);
#pragma unroll
                    for (int ft = 0; ft < 3; ++ft)
#pragma unroll
                        for (int q = 0; q < 16; ++q) acc[ft][q] *= rq * gq[32 * ft + crow(q, hi)];
#pragma unroll
                    for (int q = 0; q < 8; ++q) { const float x1 = acc[2][q], x2 = acc[2][q + 8]; acc[2][q] = x1 * cs[q] - x2 * sn[q]; acc[2][q + 8] = x1 * sn[q] + x2 * cs[q]; }
                    const float qs = 0.10206207261596577f * LOG2E;
                    bf16_t* dst = QM + ((size_t)(b * 4 + hd) * SEQ + s) * 96;
#pragma unroll
                    for (int ft = 0; ft < 3; ++ft)
#pragma unroll
                        for (int rg = 0; rg < 4; ++rg) { u32x2 w; w.x = cvt_pk_bf16(acc[ft][4 * rg] * qs, acc[ft][4 * rg + 1] * qs); w.y = cvt_pk_bf16(acc[ft][4 * rg + 2] * qs, acc[ft][4 * rg + 3] * qs);
                            *(u32x2*)(dst + 32 * ft + 8 * rg + 4 * hi) = w; }
                }
            }
            if (SUB(1) && (F.wave == 2 || F.wave == 3)) for (int tt = F.bid * 2 + F.wave - 2; tt < 512; tt += F.G * 2) {
                const int row = tt * 32 + r, b = row >> 12, s = row & 4095;
                bf16x8 xk[8]; float ss = 0.f;
#pragma unroll
                for (int ks = 0; ks < 8; ++ks) { xk[ks] = ldg8(ZS + (size_t)row * ZSW + C_CKV + 16 * ks + 8 * hi); ss += sq8(xk[ks]); }
                ss += __shfl_xor(ss, 32); const float rc = frsq(ss * (1.f / 128.f) + EPS);
                float kp[16]; float sskp = 0.f;
#pragma unroll
                for (int rg = 0; rg < 4; ++rg) { const u32x2 w = *(const u32x2*)(ZS + (size_t)row * ZSW + C_KPE + 8 * rg + 4 * hi);
                    kp[4 * rg] = bflo(w.x); kp[4 * rg + 1] = bfhi(w.x); kp[4 * rg + 2] = bflo(w.y); kp[4 * rg + 3] = bfhi(w.y); }
#pragma unroll
                for (int q = 0; q < 16; ++q) sskp += kp[q] * kp[q];
                const float pos = (float)((const int*)INF(2))[row]; float cs[8], sn[8];
#pragma unroll
                for (int i = 0; i < 8; ++i) { const int fi = crow(i, hi); const float inv = exp2f(-(float)fi * (13.287712379549449f / 16.f)); sincos_red(pos * inv, sn[i], cs[i]); }
                const bf16_t* W = (const bf16_t*)(WLP(l) + WL_SM + SM_WUKV); const float* gk = INF(25) + l * 96;
#pragma unroll 1
                for (int hd = 0; hd < 4; ++hd) {
                    f32x16 acc[4] = {f32x16{}, f32x16{}, f32x16{}, f32x16{}};
#pragma unroll
                    for (int ft = 0; ft < 4; ++ft) {
#pragma unroll
                        for (int ks = 0; ks < 8; ++ks) acc[ft] = MFMA32(ldg8(W + (size_t)(hd * 128 + 32 * ft + r) * 128 + 16 * ks + 8 * hi), xk[ks], acc[ft]); }
                    float s2 = sskp;
#pragma unroll
                    for (int ft = 0; ft < 2; ++ft)
#pragma unroll
                        for (int q = 0; q < 16; ++q) { acc[ft][q] *= rc; s2 += acc[ft][q] * acc[ft][q]; }
                    s2 += __shfl_xor(s2, 32); const float rk = frsq(s2 * (1.f / 96.f) + EPS);
                    float kr[16];
#pragma unroll
                    for (int q = 0; q < 16; ++q) kr[q] = kp[q] * rk * gk[64 + crow(q, hi)];
#pragma unroll
                    for (int q = 0; q < 8; ++q) { const float x1 = kr[q], x2 = kr[q + 8]; kr[q] = x1 * cs[q] - x2 * sn[q]; kr[q + 8] = x1 * sn[q] + x2 * cs[q]; }
                    bf16_t* dst = KM + ((size_t)(b * 4 + hd) * SEQ + s) * 96;
#pragma unroll
                    for (int ft = 0; ft < 2; ++ft)
#pragma unroll
                        for (int rg = 0; rg < 4; ++rg) { const float* gp = gk + 32 * ft + 8 * rg + 4 * hi; u32x2 w;
                            w.x = cvt_pk_bf16(acc[ft][4 * rg] * rk * gp[0], acc[ft][4 * rg + 1] * rk * gp[1]); w.y = cvt_pk_bf16(acc[ft][4 * rg + 2] * rk * gp[2], acc[ft][4 * rg + 3] * rk * gp[3]);
                            *(u32x2*)(dst + 32 * ft + 8 * rg + 4 * hi) = w; }
#pragma unroll
                    for (int rg = 0; rg < 4; ++rg) { u32x2 w; w.x = cvt_pk_bf16(kr[4 * rg], kr[4 * rg + 1]); w.y = cvt_pk_bf16(kr[4 * rg + 2], kr[4 * rg + 3]); *(u32x2*)(dst + 64 + 8 * rg + 4 * hi) = w; }
                    bf16_t* vd = VMT + (size_t)(b * 4 + hd) * 64 * SEQ + s;
#pragma unroll
                    for (int ft = 2; ft < 4; ++ft)
#pragma unroll
                        for (int q = 0; q < 16; ++q) vd[(size_t)(32 * (ft - 2) + crow(q, hi)) * SEQ] = f2bf(acc[ft][q] * rc);
                }
            }
            if (SUB(2)) {
                bf16_t* QD = (bf16_t*)(ws + WS_QD); bf16_t* KD = (bf16_t*)(ws + WS_KD); bf16_t* VDT = (bf16_t*)(ws + WS_VDT);
                const float* gqn = INF(33) + l * 32; const float* gkn = INF(34) + l * 32;
                for (int i = F.bid * 512 + F.tid; i < MTOK * 16; i += F.G * 512) {
                    const int row = i & (MTOK - 1), j = i >> 14, half = j & 1, hd = (j >> 1) & 3, isk = j >> 3;
                    const bf16_t* src = ZS + (size_t)row * ZSW + (isk ? C_KD : C_QD) + hd * 64 + half * 32;
                    bf16x8 v[4]; float ss = 0.f;
#pragma unroll
                    for (int c = 0; c < 4; ++c) { v[c] = ldg8(src + 8 * c); ss += sq8(v[c]); }
                    const float rs = frsq(ss * (1.f / 32.f) + EPS) * (isk ? 1.f : 0.17677669529663687f * LOG2E);
                    const float* gg = isk ? gkn : gqn; const int b = row >> 12, s = row & 4095;
                    bf16_t* dst = (isk ? KD : QD) + ((size_t)(b * 4 + hd) * SEQ + s) * 64 + half * 32;
#pragma unroll
                    for (int c = 0; c < 4; ++c) { u32x4 w = *(u32x4*)&v[c]; const float* gp = gg + 8 * c;
                        w.x = cvt_pk_bf16(bflo(w.x) * rs * gp[0], bfhi(w.x) * rs * gp[1]); w.y = cvt_pk_bf16(bflo(w.y) * rs * gp[2], bfhi(w.y) * rs * gp[3]);
                        w.z = cvt_pk_bf16(bflo(w.z) * rs * gp[4], bfhi(w.z) * rs * gp[5]); w.w = cvt_pk_bf16(bflo(w.w) * rs * gp[6], bfhi(w.w) * rs * gp[7]);
                        *(u32x4*)(dst + 8 * c) = w; }
                }
                for (int i = F.bid * 512 + F.tid; i < MTOK * 32; i += F.G * 512) {
                    const int row = i & (MTOK - 1), j = i >> 14, oc = j & 7, hd = j >> 3, b = row >> 12, s = row & 4095;
                    const bf16x8 v = ldg8(ZS + (size_t)row * ZSW + C_VD + hd * 64 + oc * 8);
                    bf16_t* vd = VDT + ((size_t)(b * 4 + hd) * 64 + oc * 8) * SEQ + s;
#pragma unroll
                    for (int e = 0; e < 8; ++e) vd[(size_t)e * SEQ] = (bf16_t)v[e];
                }
            }
            if (SUB(3)) {
                float* LA = (float*)(ws + WS_LA); float* LI = (float*)(ws + WS_LI); float* LSA = (float*)(ws + WS_LSUM); float* LSH = LSA + NB * 128 * 256;
                const float* cw = INF(26) + l * 4 * 256; const float* cb = INF(27) + l * 256; const float* br = INF(29) + l * 256; const float* bi = INF(31) + l * 256;
                const float* c8 = MISCT + l * 256;
                LAS float* lsa = (LAS float*)(F.lds + F.wave * 16384); LAS float* lsh = lsa + 32 * 64;
                for (int tk = F.gw; tk < NB * 128 * 4; tk += F.ngw) {
                    const int n = tk & 3, tile = (tk >> 2) & 127, b = tk >> 9, s = tile * 32 + r, row = b * SEQ + s, cbase = 64 * n;
                    bf16x8 xcb[4]; float xcf[4][8];
#pragma unroll
                    for (int ks = 0; ks < 4; ++ks) {
                        const int c0 = cbase + 16 * ks + 8 * hi;
#pragma unroll
                        for (int e = 0; e < 8; ++e) xcf[ks][e] = cb[c0 + e];
#pragma unroll
                        for (int k = 0; k < 4; ++k) { const int sr = s - 3 + k;
                            if (sr >= 0) { const bf16x8 xv = ldg8(ZS + (size_t)(b * SEQ + sr) * ZSW + C_XLRU + c0); const u32x4 w = *(const u32x4*)&xv; const float* wk = cw + k * 256 + c0;
                                xcf[ks][0] += wk[0] * bflo(w.x); xcf[ks][1] += wk[1] * bfhi(w.x); xcf[ks][2] += wk[2] * bflo(w.y); xcf[ks][3] += wk[3] * bfhi(w.y);
                                xcf[ks][4] += wk[4] * bflo(w.z); xcf[ks][5] += wk[5] * bfhi(w.z); xcf[ks][6] += wk[6] * bflo(w.w); xcf[ks][7] += wk[7] * bfhi(w.w); } }
                        u32x4 pw; pw.x = cvt_pk_bf16(xcf[ks][0], xcf[ks][1]); pw.y = cvt_pk_bf16(xcf[ks][2], xcf[ks][3]); pw.z = cvt_pk_bf16(xcf[ks][4], xcf[ks][5]); pw.w = cvt_pk_bf16(xcf[ks][6], xcf[ks][7]); xcb[ks] = *(bf16x8*)&pw;
                    }
                    const bf16_t* Wr = (const bf16_t*)(WLP(l) + WL_SM + SM_WR) + n * 4096; const bf16_t* Wi = (const bf16_t*)(WLP(l) + WL_SM + SM_WI) + n * 4096;
                    f32x16 ar_[2] = {f32x16{}, f32x16{}}, ai_[2] = {f32x16{}, f32x16{}};
#pragma unroll
                    for (int ft = 0; ft < 2; ++ft)
#pragma unroll
                        for (int ks = 0; ks < 4; ++ks) { ar_[ft] = MFMA32(ldg8(Wr + (32 * ft + r) * 64 + 16 * ks + 8 * hi), xcb[ks], ar_[ft]); ai_[ft] = MFMA32(ldg8(Wi + (32 * ft + r) * 64 + 16 * ks + 8 * hi), xcb[ks], ai_[ft]); }
                    float xloc[4][4], xrcv[4][4];
#pragma unroll
                    for (int ks = 0; ks < 4; ++ks)
#pragma unroll
                        for (int j = 0; j < 4; ++j) { xloc[ks][j] = hi ? xcf[ks][4 + j] : xcf[ks][j]; const float snd = hi ? xcf[ks][j] : xcf[ks][4 + j]; xrcv[ks][j] = __shfl_xor(snd, 32); }
#pragma unroll
                    for (int ft = 0; ft < 2; ++ft)
#pragma unroll
                        for (int rg = 0; rg < 4; ++rg) {
                            const int c0 = cbase + 32 * ft + 8 * rg + 4 * hi, ks = 2 * ft + (rg >> 1);
                            f32x4 av, iv;
#pragma unroll
                            for (int e = 0; e < 4; ++e) { const float xce = ((rg & 1) == hi) ? xloc[ks][e] : xrcv[ks][e];
                                const float rr = fsigmoid(ar_[ft][4 * rg + e] + br[c0 + e]), ii = fsigmoid(ai_[ft][4 * rg + e] + bi[c0 + e]);
                                const float la = -rr * c8[c0 + e]; const float a = fexp2(la * LOG2E); av[e] = a; iv[e] = sqrtf(fmaxf(1.f - a * a, 0.f)) * ii * xce; }
                            *(f32x4*)(LA + (size_t)row * 256 + c0) = av; *(f32x4*)(LI + (size_t)row * 256 + c0) = iv;
                            { const int sc_ = (32 * ft + 8 * rg + 4 * hi) ^ ((r & 7) << 2); *(LAS f32x4*)(lsa + r * 64 + sc_) = av; *(LAS f32x4*)(lsh + r * 64 + sc_) = iv; }
                        }
                    asm volatile("s_waitcnt lgkmcnt(0)" ::: "memory");
                    {
                        float ta = 1.f, th = 0.f;
#pragma unroll
                        for (int t = 0; t < 32; ++t) { const float a_ = lsa[t * 64 + (lane ^ ((t & 7) << 2))], h_ = lsh[t * 64 + (lane ^ ((t & 7) << 2))]; th = a_ * th + h_; ta = ta * a_; }
                        LSA[(size_t)(b * 128 + tile) * 256 + cbase + lane] = ta; LSH[(size_t)(b * 128 + tile) * 256 + cbase + lane] = th;
                    }
                    asm volatile("s_waitcnt lgkmcnt(0)" ::: "memory");
                }
            }
            if (SUB(4)) {
                float* S5S = (float*)(ws + WS_S5S);
                const int t5cnt = F.wave < 4 ? 1 : (F.wave == 4 ? 0 : 4), t5off = F.wave < 4 ? F.wave : 4 + 4 * (F.wave - 5);
                for (int tbk = F.bid; tbk < NB * 64; tbk += F.G) for (int tj = 0; tj < t5cnt; ++tj) { const int tk = tbk * 16 + t5off + tj;
                    const int g = tk & 15, ch = (tk >> 4) & 63, b = tk >> 10;
                    const float* tb = S5T + (size_t)(l * 16 + g) * 36 * 64 + lane;
                    const float ar = tb[32 * 64], ai = tb[33 * 64];
                    LAS unsigned char* tile = F.lds + F.wave * 16384;
                    float hr = 0.f, hi2 = 0.f;
#pragma unroll 1
                    for (int hf = 0; hf < 2; ++hf) {
                        s5_bu_tile(tile, BBF + (size_t)(l * 16 + g) * 128 * 16, ZS + (size_t)(b * SEQ + ch * 64 + hf * 32) * ZSW + C_S5 + 16 * g, lane);
#pragma unroll 8
                        for (int t2 = 0; t2 < 32; ++t2) { const float bur = bf2f(*(const LAS bf16_t*)(tile + t2 * 272 + lane * 2)), bui = bf2f(*(const LAS bf16_t*)(tile + t2 * 272 + 128 + lane * 2));
                            const float nr = ar * hr - ai * hi2 + bur, ni = ar * hi2 + ai * hr + bui; hr = nr; hi2 = ni; }
                        asm volatile("s_waitcnt lgkmcnt(0)" ::: "memory");
                    }
                    float* dst = S5S + ((size_t)((b * 64 + ch) * 16 + g) * 2) * 64 + lane; dst[0] = hr; dst[64] = hi2;
                }
            }
            if (SUB(5) && l == 0) {
                bf16_t* KX = (bf16_t*)(ws + WS_KX); bf16_t* VXT = (bf16_t*)(ws + WS_VXT);
                if (F.wave == 4) for (int tk = F.bid; tk < 2 * 32 * 4; tk += F.G) {
                    const int hd = tk & 3, mt = (tk >> 2) & 31, ly = tk >> 7, row = mt * 32 + r, b = row >> 8, jm = row & 255;
                    const bf16_t* W = (const bf16_t*)(ws + WS_WL + ly * WL_STRIDE + WL_WXKV);
                    f32x16 acc[4] = {f32x16{}, f32x16{}, f32x16{}, f32x16{}}; float ss = 0.f;
                    const float* mp = INF(1) + (size_t)row * DM + 8 * hi;
#pragma unroll 2
                    for (int ks = 0; ks < 64; ++ks) {
                        const f32x4 m0 = *(const f32x4*)(mp + 16 * ks), m1 = *(const f32x4*)(mp + 16 * ks + 4);
                        ss += (m0.x * m0.x + m0.y * m0.y) + (m0.z * m0.z + m0.w * m0.w) + (m1.x * m1.x + m1.y * m1.y) + (m1.z * m1.z + m1.w * m1.w);
                        const u32x4 pw = pg8::pack8(m0, m1); const bf16x8 xb = *(const bf16x8*)&pw;
#pragma unroll
                        for (int f = 0; f < 4; ++f) { const int wrow = (f < 2 ? 64 * hd + 32 * f : 256 + 64 * hd + 32 * (f - 2)) + r; acc[f] = MFMA32(ldg8(W + (size_t)wrow * DM + 16 * ks + 8 * hi), xb, acc[f]); }
                    }
                    ss += __shfl_xor(ss, 32); const float rm = frsq(ss * (1.f / DM) + EPS);
                    float s2 = 0.f;
#pragma unroll
                    for (int f = 0; f < 2; ++f)
#pragma unroll
                        for (int q = 0; q < 16; ++q) { acc[f][q] *= rm; s2 += acc[f][q] * acc[f][q]; }
                    s2 += __shfl_xor(s2, 32); const float rk = frsq(s2 * (1.f / 64.f) + EPS);
                    const float* gk = INF(47) + ly * 64;
                    bf16_t* kd = KX + ((size_t)(ly * 16 + b * 4 + hd) * 256 + jm) * 64;
#pragma unroll
                    for (int f = 0; f < 2; ++f)
#pragma unroll
                        for (int rg = 0; rg < 4; ++rg) { const float* gp = gk + 32 * f + 8 * rg + 4 * hi; u32x2 w;
                            w.x = cvt_pk_bf16(acc[f][4 * rg] * rk * gp[0], acc[f][4 * rg + 1] * rk * gp[1]); w.y = cvt_pk_bf16(acc[f][4 * rg + 2] * rk * gp[2], acc[f][4 * rg + 3] * rk * gp[3]);
                            *(u32x2*)(kd + 32 * f + 8 * rg + 4 * hi) = w; }
                    bf16_t* vd = VXT + (size_t)(ly * 16 + b * 4 + hd) * 64 * 256 + jm;
#pragma unroll
                    for (int f = 2; f < 4; ++f)
#pragma unroll
                        for (int q = 0; q < 16; ++q) vd[(size_t)(32 * (f - 2) + crow(q, hi)) * 256] = f2bf(acc[f][q] * rm);
                }
            }
        }
        SEAM(pb + 1);
        if (IN(pb + 2)) {
            if (SUB(6)) { PHASE_BEGIN();
            const int lane = F.lane, r32 = lane & 31, hi = lane >> 5, wid = F.wave;
            volatile LAS unsigned* qslot = (volatile LAS unsigned*)(F.lds + MISC_OFF + 64);
            for (int it = queue_pull(F.ctl + CW_Q + 64 * (4 * l + 0), qslot, F.tid); it < 256; it = queue_pull(F.ctl + CW_Q + 64 * (4 * l + 0), qslot, F.tid)) {
                {
                    const int bh = it & 15, qt = 15 - (it >> 4), b = bh >> 2, hd = bh & 3;
                    const bf16_t* QM = (const bf16_t*)(ws + WS_QM) + (size_t)bh * SEQ * 96; const bf16_t* KM = (const bf16_t*)(ws + WS_KM) + (size_t)bh * SEQ * 96;
                    const bf16_t* VMT = (const bf16_t*)(ws + WS_VMT) + (size_t)bh * 64 * SEQ;
                    f32x16 o[1][2]; float lsum[1];
                    attn_unit<96, 1, true, false, false>(F.lds, QM + (size_t)qt * 256 * 96, 96, KM, VMT, SEQ, 4 * (qt + 1), 256 * qt, nullptr, nullptr, 1.f, MISCT[516 + l * 4 + 0], o, lsum);
                    const int row = b * SEQ + qt * 256 + wid * 32 + r32;
                    attn_store(YB + (size_t)1 * MTOK * 256 + (size_t)row * 256 + hd * 64, o[0], frcp(lsum[0]), hi);
                }
            } }
            if (SUB(7)) { PHASE_BEGIN();
            const int lane = F.lane, r32 = lane & 31, hi = lane >> 5, wid = F.wave;
            LAS float* lut = (LAS float*)(F.lds + 106496);
            for (int i = F.tid; i < 4 * 384; i += 512) lut[i] = MISCT[1024 + i];
            __syncthreads();
            volatile LAS unsigned* qslot = (volatile LAS unsigned*)(F.lds + MISC_OFF + 64);
            for (int it = queue_pull(F.ctl + CW_Q + 64 * (4 * l + 1), qslot, F.tid); it < 256; it = queue_pull(F.ctl + CW_Q + 64 * (4 * l + 1), qslot, F.tid)) {
                {
                    const int bh = it & 15, qt = 15 - (it >> 4), b = bh >> 2, hd = bh & 3;
                    const bf16_t* QD = (const bf16_t*)(ws + WS_QD) + (size_t)bh * SEQ * 64; const bf16_t* KD = (const bf16_t*)(ws + WS_KD) + (size_t)bh * SEQ * 64;
                    const bf16_t* VDT = (const bf16_t*)(ws + WS_VDT) + (size_t)bh * 64 * SEQ;
                    f32x16 o[2][2]; float lsum[2];
                    attn_unit<64, 2, true, true, false>(F.lds, QD + (size_t)qt * 256 * 64, 64, KD, VDT, SEQ, 4 * (qt + 1), 256 * qt, lut + hd * 384, nullptr, 1.f, MISCT[516 + l * 4 + 1], o, lsum);
                    const float lam = MISCT[512 + l], lam_init = MISCT[514 + l];
                    const float i1 = frcp(lsum[0]), i2 = lam * frcp(lsum[1]); float ss = 0.f;
#pragma unroll
                    for (int dt = 0; dt < 2; ++dt)
#pragma unroll
                        for (int q = 0; q < 16; ++q) { const float v = o[0][dt][q] * i1 - o[1][dt][q] * i2; o[0][dt][q] = v; ss += v * v; }
                    ss += __shfl_xor(ss, 32); const float rs = frsq(ss * (1.f / 64.f) + EPS) * (1.f - lam_init);
                    const float* gs = INF(39) + l * 64;
#pragma unroll
                    for (int dt = 0; dt < 2; ++dt)
#pragma unroll
                        for (int q = 0; q < 16; ++q) o[0][dt][q] *= gs[32 * dt + crow(q, hi)];
                    const int row = b * SEQ + qt * 256 + wid * 32 + r32;
                    attn_store(YB + (size_t)3 * MTOK * 256 + (size_t)row * 256 + hd * 64, o[0], rs, hi);
                }
            } }
            if (SUB(8)) { PHASE_BEGIN();
            const int lane = F.lane, r32 = lane & 31, hi = lane >> 5, wid = F.wave;
            volatile LAS unsigned* qslot = (volatile LAS unsigned*)(F.lds + MISC_OFF + 64);
            for (int it = queue_pull(F.ctl + CW_Q + 64 * (4 * l + 2), qslot, F.tid); it < 256; it = queue_pull(F.ctl + CW_Q + 64 * (4 * l + 2), qslot, F.tid)) {
                {
                    const int b = it >> 6, ch = it & 63, row0 = b * SEQ + ch * 64;
                    LAS unsigned char* hbuf = F.lds + wid * 8704;
                    LAS unsigned char* ypre = F.lds + 69632;
                    const float* S5S = (const float*)(ws + WS_S5S);
#pragma unroll 1
                    for (int gg = 0; gg < 2; ++gg) {
                        const int g = 2 * wid + gg;
                        const float* tb = S5T + (size_t)(l * 16 + g) * 36 * 64 + lane;
                        const float ar = tb[32 * 64], ai = tb[33 * 64], a64r = tb[34 * 64], a64i = tb[35 * 64];
                        float hr = 0.f, hi2 = 0.f;
                        for (int c0 = 0; c0 < ch; c0 += 8) {
                            float sr[8], si[8];
#pragma unroll
                            for (int u = 0; u < 8; ++u) { const int c = c0 + u; const bool ok = c < ch; const float* sp = S5S + ((size_t)((b * 64 + (ok ? c : 0)) * 16 + g) * 2) * 64 + lane; sr[u] = ok ? sp[0] : 0.f; si[u] = ok ? sp[64] : 0.f; }
#pragma unroll
                            for (int u = 0; u < 8; ++u) { if (c0 + u < ch) { const float nr = a64r * hr - a64i * hi2 + sr[u], ni = a64r * hi2 + a64i * hr + si[u]; hr = nr; hi2 = ni; } }
                        }
                        bf16x8 cf[4];
#pragma unroll
                        for (int ks = 0; ks < 4; ++ks) cf[ks] = ldg8(CMAT + (size_t)(l * 16 + g) * 16 * 128 + (lane & 15) * 128 + 32 * ks + 8 * (lane >> 4));
                        const float* dsk = INF(17) + l * 256 + 16 * g + 4 * (lane >> 4);
#pragma unroll 1
                        for (int hf = 0; hf < 2; ++hf) {
                            s5_bu_tile(hbuf, BBF + (size_t)(l * 16 + g) * 128 * 16, ZS + (size_t)(row0 + hf * 32) * ZSW + C_S5 + 16 * g, lane);
#pragma unroll 8
                            for (int t2 = 0; t2 < 32; ++t2) { const float bur = bf2f(*(const LAS bf16_t*)(hbuf + t2 * 272 + lane * 2)), bui = bf2f(*(const LAS bf16_t*)(hbuf + t2 * 272 + 128 + lane * 2));
                                const float nr = ar * hr - ai * hi2 + bur, ni = ar * hi2 + ai * hr + bui; hr = nr; hi2 = ni;
                                *(LAS bf16_t*)(hbuf + t2 * 272 + lane * 2) = f2bf(hr); *(LAS bf16_t*)(hbuf + t2 * 272 + 128 + lane * 2) = f2bf(hi2);
                            }
                            asm volatile("s_waitcnt lgkmcnt(0)" ::: "memory");
#pragma unroll
                            for (int tq = 0; tq < 2; ++tq) {
                                f32x4 yv = (f32x4){0.f, 0.f, 0.f, 0.f};
#pragma unroll
                                for (int ks = 0; ks < 4; ++ks) { const bf16x8 hb = *(const LAS bf16x8*)(hbuf + (16 * tq + (lane & 15)) * 272 + (32 * ks + 8 * (lane >> 4)) * 2); yv = MFMA16(cf[ks], hb, yv); }
                                const int tl = hf * 32 + 16 * tq + (lane & 15);
                                const u32x2 uw = *(const u32x2*)(ZS + (size_t)(row0 + tl) * ZSW + C_S5 + 16 * g + 4 * (lane >> 4));
                                yv[0] = fgelu(yv[0] + dsk[0] * bflo(uw.x)); yv[1] = fgelu(yv[1] + dsk[1] * bfhi(uw.x)); yv[2] = fgelu(yv[2] + dsk[2] * bflo(uw.y)); yv[3] = fgelu(yv[3] + dsk[3] * bfhi(uw.y));
                                u32x2 pw; pw.x = cvt_pk_bf16(yv[0], yv[1]); pw.y = cvt_pk_bf16(yv[2], yv[3]);
                                *(LAS u32x2*)(ypre + tl * 528 + (16 * g + 4 * (lane >> 4)) * 2) = pw;
                            }
                            asm volatile("s_waitcnt lgkmcnt(0)" ::: "memory");
                        }
                    }
                    __syncthreads();
                    {
                        const bf16_t* WG = (const bf16_t*)(WLP(l) + WL_SM + SM_WGLU);
                        f32x16 acc[2] = {f32x16{}, f32x16{}};
#pragma unroll 4
                        for (int ks = 0; ks < 16; ++ks) { const bf16x8 a = ldg8(WG + (size_t)(32 * wid + r32) * 256 + 16 * ks + 8 * hi);
#pragma unroll
                            for (int tt = 0; tt < 2; ++tt) acc[tt] = MFMA32(a, *(const LAS bf16x8*)(ypre + (32 * tt + r32) * 528 + (16 * ks + 8 * hi) * 2), acc[tt]); }
                        const float* bg = INF(19) + l * 256;
#pragma unroll
                        for (int tt = 0; tt < 2; ++tt)
#pragma unroll
                            for (int rg = 0; rg < 4; ++rg) { const int n0 = 32 * wid + 8 * rg + 4 * hi, t = 32 * tt + r32;
                                const u32x2 yw = *(const LAS u32x2*)(ypre + t * 528 + n0 * 2); u32x2 ow;
                                ow.x = cvt_pk_bf16(bflo(yw.x) * fsigmoid(acc[tt][4 * rg] + bg[n0]), bfhi(yw.x) * fsigmoid(acc[tt][4 * rg + 1] + bg[n0 + 1]));
                                ow.y = cvt_pk_bf16(bflo(yw.y) * fsigmoid(acc[tt][4 * rg + 2] + bg[n0 + 2]), bfhi(yw.y) * fsigmoid(acc[tt][4 * rg + 3] + bg[n0 + 3]));
                                *(u32x2*)(YB + (size_t)(row0 + t) * 256 + n0) = ow; }
                    }
                    __syncthreads();
                }
            }
            }
            if (SUB(9)) { PHASE_BEGIN(); const int lane = F.lane;
                const float* LA = (const float*)(ws + WS_LA); const float* LI = (const float*)(ws + WS_LI); const float* LSA = (const float*)(ws + WS_LSUM); const float* LSH = LSA + NB * 128 * 256;
                volatile LAS unsigned* qslot = (volatile LAS unsigned*)(F.lds + MISC_OFF + 64);
                for (int it = queue_pull(F.ctl + CW_Q + 64 * (4 * l + 3), qslot, F.tid); it < NB * 64 * 4 / 8; it = queue_pull(F.ctl + CW_Q + 64 * (4 * l + 3), qslot, F.tid)) {
                    const int tk = (NB * 64 * 4 / 8 - 1 - it) * 8 + F.wave;
                    const int n = tk & 3, ch = (tk >> 2) & 63, b = tk >> 8, c = 64 * n + lane;
                    float h = 0.f;
                    for (int tp0 = 0; tp0 < 2 * ch; tp0 += 16) {
                        float ca[16], chh[16];
#pragma unroll
                        for (int u = 0; u < 16; ++u) { const int tp = tp0 + u; const bool ok = tp < 2 * ch; const size_t o = (size_t)(b * 128 + (ok ? tp : 0)) * 256 + c; ca[u] = ok ? LSA[o] : 1.f; chh[u] = ok ? LSH[o] : 0.f; }
#pragma unroll
                        for (int u = 0; u < 16; ++u) h = ca[u] * h + chh[u];
                    }
                    const int row0 = b * SEQ + ch * 64;
#pragma unroll 1
                    for (int t0 = 0; t0 < 64; t0 += 16) {
                        float la[16], li[16], gt[16];
#pragma unroll
                        for (int u = 0; u < 16; ++u) { const size_t o = (size_t)(row0 + t0 + u) * 256 + c; la[u] = LA[o]; li[u] = LI[o]; gt[u] = bf2f(ZS[(size_t)(row0 + t0 + u) * ZSW + C_GLRU + c]); }
#pragma unroll
                        for (int u = 0; u < 16; ++u) { h = la[u] * h + li[u]; gt[u] = h * fgelu(gt[u]); }
#pragma unroll
                        for (int u = 0; u < 16; ++u) YB[(size_t)2 * MTOK * 256 + (size_t)(row0 + t0 + u) * 256 + c] = f2bf(gt[u]);
                    }
                }
            }
        }
        SEAM(pb + 2);
        if (IN(pb + 3)) { PHASE_BEGIN();
            pg8::Gemm g{YB, (const bf16_t*)(WLP(l) + WL_PT), 256, nullptr}; pg8::MergeOrder S{F.G, F.bid};
            pg8::EpiMerge E{MG, ZG};
            pg8::gemm_phase<pg8::EpiMerge, pg8::MergeOrder, true, false>(F.lds, g, S, E);
        }
        SEAM(pb + 3);
        if (IN(pb + 4)) { PHASE_BEGIN();
            pg8::Gemm g{MG, (const bf16_t*)(WLP(l) + WL_WO), DM, nullptr}; pg8::StaticOrder S; S.init(MTOK / 256, DM / 256, F.G, F.bid);
            pg8::EpiRes<false> E{nullptr, XB, RS + (size_t)(l == 0 ? 1 : 4) * MTOK * 16, nullptr};
            pg8::gemm_phase<pg8::EpiRes<false>, pg8::StaticOrder, false, false>(F.lds, g, S, E);
        }
        SEAM(pb + 4);
        if (IN(pb + 5)) { PHASE_BEGIN();
            pg8::Gemm g{XB, (const bf16_t*)(WLP(l) + WL_WXQ), DM, nullptr}; pg8::StaticOrder S; S.init(MTOK / 256, 1, F.G, F.bid);
            pg8::EpiRowScale E{(bf16_t*)(ws + WS_QX), 256, RS + (size_t)(l == 0 ? 1 : 4) * MTOK * 16};
            pg8::gemm_phase<pg8::EpiRowScale, pg8::StaticOrder, false, false>(F.lds, g, S, E);
        }
        SEAM(pb + 5);
        if (IN(pb + 6)) { PHASE_BEGIN();
            const int lane = F.lane, r32 = lane & 31, hi = lane >> 5, wid = F.wave;
            for (int it = F.bid; it < 256; it += F.G) {
                const int hd = it & 3, rt = it >> 2, b = rt >> 4;
                const bf16_t* QX = (const bf16_t*)(ws + WS_QX) + (size_t)rt * 256 * 256 + hd * 64;
                const bf16_t* KX = (const bf16_t*)(ws + WS_KX) + (size_t)(l * 16 + b * 4 + hd) * 256 * 64;
                const bf16_t* VXT = (const bf16_t*)(ws + WS_VXT) + (size_t)(l * 16 + b * 4 + hd) * 64 * 256;
                f32x16 o[1][2]; float lsum[1];
                attn_unit<64, 1, false, false, true>(F.lds, QX, 256, KX, VXT, 256, 4, 0, nullptr, INF(46) + l * 64, 0.125f * LOG2E, MISCT[516 + l * 4 + 2], o, lsum);
                const int row = rt * 256 + wid * 32 + r32;
                attn_store((bf16_t*)(ws + WS_OX) + (size_t)row * 256 + hd * 64, o[0], frcp(lsum[0]), hi);
            }
        }
        SEAM(pb + 6);
        if (IN(pb + 7)) { PHASE_BEGIN();
            pg8::Gemm g{(const bf16_t*)(ws + WS_OX), (const bf16_t*)(WLP(l) + WL_WXO), 256, nullptr}; pg8::StaticOrder S; S.init(MTOK / 256, DM / 256, F.G, F.bid);
            if (l == 0) { pg8::EpiRes<false> E{nullptr, XB, RS + (size_t)2 * MTOK * 16, nullptr}; pg8::gemm_phase<pg8::EpiRes<false>, pg8::StaticOrder, false, false>(F.lds, g, S, E); }
            else { pg8::EpiRes<false> E{nullptr, XB, RS + (size_t)5 * MTOK * 16, nullptr}; pg8::gemm_phase<pg8::EpiRes<false>, pg8::StaticOrder, false, false>(F.lds, g, S, E); }
        }
        SEAM(pb + 7);
        if (l == 0) {
            if (IN(9)) { PHASE_BEGIN();
                pg8::Gemm g{XB, (const bf16_t*)(ws + WS_WGU), DM, nullptr}; pg8::StaticOrder S; S.init(MTOK / 256, 2 * FF / 256, F.G, F.bid);
#if G2_FP8
                pg8::EpiSwiGLU8<true, false> E{ws + WS_HFF, FF, RS + (size_t)2 * MTOK * 16};
                pg8::gemm_phase<pg8::EpiSwiGLU8<true, false>, pg8::StaticOrder, true, false>(F.lds, g, S, E);
#else
                pg8::EpiSwiGLU<false> E{(bf16_t*)(ws + WS_HFF), FF, RS + (size_t)2 * MTOK * 16, nullptr};
                pg8::gemm_phase<pg8::EpiSwiGLU<false>, pg8::StaticOrder, true, false>(F.lds, g, S, E);
#endif
            }
            SEAM(9);
            if (IN(10)) { PHASE_BEGIN();
#if G2_FP8
                pg8::Gemm g{(const bf16_t*)(ws + WS_HFF), (const bf16_t*)(ws + WS_WD), FF / 2, nullptr}; pg8::StaticOrder S; S.init(MTOK / 256, DM / 256, F.G, F.bid);
                pg8::EpiRes<false, false, true> E{nullptr, XB, RS + (size_t)3 * MTOK * 16, nullptr};
                pg8::gemm_phase<pg8::EpiRes<false, false, true>, pg8::StaticOrder, false, false, true>(F.lds, g, S, E);
#else
                pg8::Gemm g{(const bf16_t*)(ws + WS_HFF), (const bf16_t*)(ws + WS_WD), FF, nullptr}; pg8::StaticOrder S; S.init(MTOK / 256, DM / 256, F.G, F.bid);
                pg8::EpiRes<false> E{nullptr, XB, RS + (size_t)3 * MTOK * 16, nullptr};
                pg8::gemm_phase<pg8::EpiRes<false>, pg8::StaticOrder, false, false>(F.lds, g, S, E);
#endif
            }
            SEAM(10);
        } else {
#define ROWTOK ((int*)(ws + WS_MOESM + MS_ROWTOK))
#define TOKW ((float*)(ws + WS_MOESM + MS_TOKW))
#define ASSIGN ((int*)(ws + WS_MOESM + MS_ASSIGN))
#define RSTD2 ((float*)(ws + WS_MOESM + MS_RSTD))
#define MCNT (F.ctl + CW_MOECNT)
            if (IN(19)) { PHASE_BEGIN();
                LAS float* wrs = (LAS float*)(F.lds);
                for (int i = F.tid; i < 8192; i += 512) wrs[i] = INF(51)[i] * INF(7)[DM + (i >> 3)];
                __syncthreads();
                if (SUB(10) && F.wave < 4) {
                    const int lane = F.lane;
                    for (int blk = F.bid; blk < 256; blk += F.G) {
                        unsigned cntv = 0u, mypack = 0u;
#pragma unroll 1
                        for (int j = 0; j < 16; ++j) {
                            const int tok = blk * 64 + F.wave * 16 + j;
                            const u32x2* xr = (const u32x2*)(XB + (size_t)tok * DM) + lane;
                            float lg[8] = {0.f, 0.f, 0.f, 0.f, 0.f, 0.f, 0.f, 0.f}; float ss = 0.f; f32x4 xv4[4];
#pragma unroll
                            for (int q = 0; q < 4; ++q) { const u32x2 xw = xr[64 * q]; const f32x4 v = {bflo(xw.x), bfhi(xw.x), bflo(xw.y), bfhi(xw.y)}; const int k0 = 256 * q + 4 * lane; xv4[q] = v;
                                ss += (v.x * v.x + v.y * v.y) + (v.z * v.z + v.w * v.w);
#pragma unroll
                                for (int e4 = 0; e4 < 4; ++e4) { const float xv = v[e4]; const LAS f32x4* wp = (const LAS f32x4*)(wrs + (k0 + e4) * 8); const f32x4 wa = wp[0], wb = wp[1];
                                    lg[0] += xv * wa.x; lg[1] += xv * wa.y; lg[2] += xv * wa.z; lg[3] += xv * wa.w; lg[4] += xv * wb.x; lg[5] += xv * wb.y; lg[6] += xv * wb.z; lg[7] += xv * wb.w; } }
                            ss = wave_sum(ss);
#pragma unroll
                            for (int e = 0; e < 8; ++e) lg[e] = wave_sum(lg[e]);
                            const float rstd = frsq(ss * (1.f / DM) + EPS);
                            { unsigned* xq = (unsigned*)(ws + WS_XQ + (size_t)tok * DM) + lane;
#pragma unroll
                              for (int q = 0; q < 4; ++q) xq[64 * q] = cvt_pk4_fp8(xv4[q].x * rstd, xv4[q].y * rstd, xv4[q].z * rstd, xv4[q].w * rstd); }
                            int e1 = 0; float v1 = lg[0];
#pragma unroll
                            for (int e = 1; e < 8; ++e) if (lg[e] > v1) { v1 = lg[e]; e1 = e; }
                            int e2 = -1; float v2 = -3.4e38f;
#pragma unroll
                            for (int e = 0; e < 8; ++e) if (e != e1 && lg[e] > v2) { v2 = lg[e]; e2 = e; }
                            if (e2 < 0) e2 = (e1 + 1) & 7;
                            const int se1 = __builtin_amdgcn_readfirstlane(e1), se2 = __builtin_amdgcn_readfirstlane(e2);
                            const unsigned r1 = __builtin_amdgcn_readlane(cntv, se1), r2 = __builtin_amdgcn_readlane(cntv, se2);
                            cntv += (lane == se1 ? 1u : 0u) + (lane == se2 ? 1u : 0u);
                            if (lane == j) mypack = (unsigned)se1 | (r1 << 4) | ((unsigned)se2 << 12) | (r2 << 16);
                            if (lane == 0) { const float w1 = frcp(1.f + __expf((v2 - v1) * rstd)); RSTD2[tok] = rstd; TOKW[tok * 2] = w1; TOKW[tok * 2 + 1] = 1.f - w1; }
                        }
                        unsigned basev = 0u;
                        if (lane < 8) basev = __hip_atomic_fetch_add(MCNT + 64 * lane, cntv, __ATOMIC_RELAXED, __HIP_MEMORY_SCOPE_AGENT);
                        const int pe1 = mypack & 15, pr1 = (mypack >> 4) & 255, pe2 = (mypack >> 12) & 15, pr2 = (mypack >> 16) & 255;
                        const unsigned b1 = __shfl(basev, pe1), b2 = __shfl(basev, pe2);
                        if (lane < 16) { const int tok = blk * 64 + F.wave * 16 + lane; ASSIGN[tok * 2] = pe1 | (int)((b1 + (unsigned)pr1) << 8); ASSIGN[tok * 2 + 1] = pe2 | (int)((b2 + (unsigned)pr2) << 8);
                            ROWTOK[pe1 * 16384 + (int)(b1 + (unsigned)pr1)] = tok; ROWTOK[pe2 * 16384 + (int)(b2 + (unsigned)pr2)] = tok; }
                    }
                }
                if (SUB(11)) {
                    LAS float* scr = (LAS float*)(F.lds + 40960 + F.wave * 8448);
                    const TJob j0{INF(52), (bf16_t*)(ws + WS_WMGU), INF(7) + DM, DM, EFF, EFF, DM, 8, 2, (size_t)DM * EFF, (size_t)2 * EFF * DM, 1};
                    const TJob j1{INF(53), (bf16_t*)(ws + WS_WMGU), INF(7) + DM, DM, EFF, EFF, DM, 8, 3, (size_t)DM * EFF, (size_t)2 * EFF * DM, 1};
                    const TJob j2{INF(54), (bf16_t*)(ws + WS_WMD), nullptr, EFF, DM, DM, EFF, 8, 0, (size_t)EFF * DM, (size_t)DM * EFF, 1};
                    constexpr int NI = 8 * (DM / 64) * (EFF / 32);
                    LAS unsigned* qc = (LAS unsigned*)(F.lds + MISC_OFF + 128);
                    const int wg_items = (3 * NI - F.bid + F.G - 1) / F.G;
#define H0_PULL() h0_pull(qc, F.lane, wg_items, F.bid, F.G, 3 * NI)
#define H0_JOB(idx) const int jn_ = (idx) / NI; TJob js_ = j0; if (jn_ == 1) { js_.W = j1.W; js_.map = 3; } if (jn_ == 2) js_ = j2;
#define H0_LOAD(idx, v) do { H0_JOB(idx) tjob_load(js_, (idx) - jn_ * NI, v, F.lane); } while (0)
#define H0_STORE(idx, v) do { H0_JOB(idx) tjob_store(js_, (idx) - jn_ * NI, v, scr, F.lane); } while (0)
                    float va[32] = {}, vb[32] = {}; int it = H0_PULL();
                    if (it < 3 * NI) { H0_LOAD(it, va);
                        for (;;) {
                            const int n1 = H0_PULL(); if (n1 < 3 * NI) H0_LOAD(n1, vb);
                            H0_STORE(it, va); if (n1 >= 3 * NI) break;
                            const int n2 = H0_PULL(); if (n2 < 3 * NI) H0_LOAD(n2, va);
                            H0_STORE(n1, vb); if (n2 >= 3 * NI) break;
                            it = n2;
                        } }
#undef H0_PULL
#undef H0_JOB
#undef H0_LOAD
#undef H0_STORE
                }
            }
            SEAM(19);
            if (IN(21)) { PHASE_BEGIN();
                pg8::Gemm g{(const bf16_t*)(ws + WS_XQ), (const bf16_t*)(ws + WS_WMGU), DM / 2, ROWTOK}; pg8::MoeOrder S; S.init(MCNT, 2 * EFF / 256, F.G, F.bid);
                pg8::EpiSwiGLU8<false> E{ws + WS_HMOE, EFF, nullptr};
                pg8::gemm_phase<pg8::EpiSwiGLU8<false>, pg8::MoeOrder, true, true, true>(F.lds, g, S, E);
            }
            SEAM(21);
            if (IN(22)) { PHASE_BEGIN();
                pg8::Gemm g{(const bf16_t*)(ws + WS_HMOE), (const bf16_t*)(ws + WS_WMD), EFF / 2, nullptr}; pg8::MoeOrder S; S.init(MCNT, DM / 256, F.G, F.bid);
                pg8::EpiPlain E{(bf16_t*)(ws + WS_YS), DM, 0.03125f};
                pg8::gemm_phase<pg8::EpiPlain, pg8::MoeOrder, true, false, true>(F.lds, g, S, E);
            }
            SEAM(22);
            if (IN(23)) { PHASE_BEGIN();
                const bf16_t* YS = (const bf16_t*)(ws + WS_YS);
                int pst[8]; { int acc = 0;
#pragma unroll
                    for (int e = 0; e < 8; ++e) { pst[e] = acc; acc += ((int)MCNT[64 * e] + 255) & ~255; } }
                for (int m = F.gw; m < MTOK; m += F.ngw) {
                    const int a1 = ASSIGN[2 * m], a2 = ASSIGN[2 * m + 1]; int p1 = 0, p2 = 0;
#pragma unroll
                    for (int q = 0; q < 8; ++q) { p1 = (q == (a1 & 255)) ? pst[q] : p1; p2 = (q == (a2 & 255)) ? pst[q] : p2; }
                    const int d1 = p1 + (a1 >> 8), d2 = p2 + (a2 >> 8); const float w1 = TOKW[2 * m], w2 = TOKW[2 * m + 1];
                    f32x4* xr = (f32x4*)(F.out + (size_t)m * DM) + F.lane; const u32x2* xbr = (const u32x2*)(XB + (size_t)m * DM) + F.lane;
                    const u32x2* y1 = (const u32x2*)(YS + (size_t)d1 * DM) + F.lane; const u32x2* y2 = (const u32x2*)(YS + (size_t)d2 * DM) + F.lane;
#pragma unroll
                    for (int j = 0; j < 4; ++j) { const u32x2 xw = xbr[64 * j]; f32x4 v = {bflo(xw.x), bfhi(xw.x), bflo(xw.y), bfhi(xw.y)}; const u32x2 a = y1[64 * j], c = y2[64 * j];
                        v.x += w1 * bflo(a.x) + w2 * bflo(c.x); v.y += w1 * bfhi(a.x) + w2 * bfhi(c.x); v.z += w1 * bflo(a.y) + w2 * bflo(c.y); v.w += w1 * bfhi(a.y) + w2 * bfhi(c.y);
                        xr[64 * j] = v; }
                }
            }
        }
    }
#undef IN
#undef SEAM
}

#ifdef DBG_DUMP_OFF
__global__ void dbg_copy_bf16(const bf16_t* src, float* out, int n, int nv) { for (int i = blockIdx.x * 256 + threadIdx.x; i < n; i += gridDim.x * 256) out[i] = i < nv ? bf2f(src[i]) : 0.f; }
#endif

#ifdef DBG_CHECK
struct DbgArgs { const void* in[55]; unsigned char* ws; float* out; float* acc; };
#ifndef DBG_LAYER
#define DBG_LAYER 0
#endif
__device__ __forceinline__ size_t dstride(int i) {
    switch (i) { case 4: case 5: case 6: case 7: case 10: case 11: case 26: return 1024; case 8: return (size_t)DM * DIN; case 9: return 4096; case 12: return 16;
      case 13: case 14: case 15: case 16: case 28: case 30: return 16384; case 17: case 19: case 27: case 29: case 31: case 32: return 256; case 18: case 23: return 65536; case 20: return 192; case 21: return 128;
      case 22: return 73728; case 24: case 25: return 96; case 33: case 34: case 35: case 36: case 37: case 38: return 32; case 39: case 46: case 47: return 64; case 40: return (size_t)4 * 256 * DM; case 41: return (size_t)DM * DM;
      case 42: case 43: case 44: case 45: return (size_t)DM * 256; default: return 0; } }
#define DIN_(i) ((const float*)a.in[i] + (size_t)DBG_LAYER * dstride(i))
#define DXIN_ (DBG_LAYER == 0 ? (const float*)a.in[0] : (const float*)(a.ws + WS_DBG))
constexpr size_t WS_DBG = 440 * MiB;
__device__ float blk_sum(float v, float* sh) { sh[threadIdx.x] = v; __syncthreads(); for (int o = 128; o > 0; o >>= 1) { if ((int)threadIdx.x < o) sh[threadIdx.x] += sh[threadIdx.x + o]; __syncthreads(); } const float r = sh[0]; __syncthreads(); return r; }
__device__ float blk_max(float v, float* sh) { sh[threadIdx.x] = v; __syncthreads(); for (int o = 128; o > 0; o >>= 1) { if ((int)threadIdx.x < o) sh[threadIdx.x] = fmaxf(sh[threadIdx.x], sh[threadIdx.x + o]); __syncthreads(); } const float r = sh[0]; __syncthreads(); return r; }
__device__ void dbg_acc(float* acc, int k, float fast, float ref) { atomicMax((unsigned*)&acc[2 * k], __float_as_uint(fabsf(fast - ref))); atomicAdd(&acc[2 * k + 1], ref * ref); atomicAdd(&acc[64 + k], 1.f); }
__device__ float dsig(float x) { return 1.f / (1.f + expf(-x)); }
__device__ float dgelu(float x) { return 0.5f * x * (1.f + tanhf(0.7978845608028654f * (x + 0.044715f * x * x * x))); }
__device__ int dbucket(int d) { if (d < 16) return d < 0 ? 0 : d; int bk = 16 + (int)(logf((float)d / 16.f) / logf(8.f) * 16.f); return bk > 31 ? 31 : bk; }

__global__ void chk_z(DbgArgs a) {
    __shared__ float sh[256]; const int s = blockIdx.x, tid = threadIdx.x; const int row = (s * 7919 + 13) % MTOK; int col = (s * 104729 + 7 + (s >> 1)) % DIN; if (s & 1) col = col % C_END;
    const float* x = (DBG_LAYER == 0 ? (const float*)a.in[0] : (const float*)a.out) + (size_t)row * DM; const float* g = DIN_(4); const float* W = DIN_(8);
    float ss = 0.f, dot = 0.f; for (int k = tid; k < DM; k += 256) { const float xv = x[k]; ss += xv * xv; dot += xv * g[k] * W[(size_t)k * DIN + col]; }
    ss = blk_sum(ss, sh); dot = blk_sum(dot, sh);
    if (tid == 0) { const float z = dot * rsqrtf(ss / DM + EPS);
        if (col < C_END) dbg_acc(a.acc, 1, bf2f(((const bf16_t*)(a.ws + WS_ZS))[(size_t)row * ZSW + col]), z);
        else { const int gc = col - C_END; dbg_acc(a.acc, 2, bf2f(((const bf16_t*)(a.ws + WS_ZG))[(size_t)row * ZGW + gc]), dsig(z + DIN_(9)[gc])); } }
}
__global__ void chk_mla_prep(DbgArgs a) {
    __shared__ float sh[256]; __shared__ float vn[192]; __shared__ float qs[128];
    const int s = blockIdx.x, tid = threadIdx.x, row = (s * 7919 + 13) % MTOK, hd = s & 3, b = row >> 12, sq = row & 4095;
    const bf16_t* ZSp = (const bf16_t*)(a.ws + WS_ZS) + (size_t)row * ZSW; const float pos = (float)((const int*)a.in[2])[row];
    { const float v = tid < 192 ? bf2f(ZSp[C_CQ + tid]) : 0.f; const float ss = blk_sum(v * v, sh); if (tid < 192) vn[tid] = v * rsqrtf(ss / 192.f + EPS) * DIN_(20)[tid]; __syncthreads(); }
    float qf = 0.f; if (tid < 96) for (int k = 0; k < 192; ++k) qf += vn[k] * DIN_(22)[k * 384 + hd * 96 + tid];
    { const float ss = blk_sum(tid < 96 ? qf * qf : 0.f, sh); if (tid < 96) qs[tid] = qf * rsqrtf(ss / 96.f + EPS) * DIN_(24)[tid]; __syncthreads(); }
    if (tid < 96) { float val = qs[tid]; if (tid >= 64) { const int i = (tid - 64) & 15; float sn, cs; sincos_red(pos * exp2f(-(float)i * (13.287712379549449f / 16.f)), sn, cs); const float x1 = qs[64 + i], x2 = qs[80 + i]; val = tid < 80 ? x1 * cs - x2 * sn : x1 * sn + x2 * cs; }
        val *= 0.10206207261596577f * LOG2E; dbg_acc(a.acc, 3, bf2f(((const bf16_t*)(a.ws + WS_QM))[((size_t)(b * 4 + hd) * SEQ + sq) * 96 + tid]), val); }
    __syncthreads();
    { const float v = tid < 128 ? bf2f(ZSp[C_CKV + tid]) : 0.f; const float ss = blk_sum(v * v, sh); if (tid < 128) vn[tid] = v * rsqrtf(ss / 128.f + EPS) * DIN_(21)[tid]; __syncthreads(); }
    float kv = 0.f; if (tid < 128) for (int k = 0; k < 128; ++k) kv += vn[k] * DIN_(23)[k * 512 + hd * 128 + tid];
    float kfull = 0.f; if (tid < 64) kfull = kv; else if (tid < 96) kfull = bf2f(ZSp[C_KPE + tid - 64]);
    { const float ss = blk_sum(tid < 96 ? kfull * kfull : 0.f, sh); if (tid < 96) qs[tid] = kfull * rsqrtf(ss / 96.f + EPS) * DIN_(25)[tid]; __syncthreads(); }
    if (tid < 96) { float val = qs[tid]; if (tid >= 64) { const int i = (tid - 64) & 15; float sn, cs; sincos_red(pos * exp2f(-(float)i * (13.287712379549449f / 16.f)), sn, cs); const float x1 = qs[64 + i], x2 = qs[80 + i]; val = tid < 80 ? x1 * cs - x2 * sn : x1 * sn + x2 * cs; }
        dbg_acc(a.acc, 4, bf2f(((const bf16_t*)(a.ws + WS_KM))[((size_t)(b * 4 + hd) * SEQ + sq) * 96 + tid]), val); }
    if (tid >= 64 && tid < 128) dbg_acc(a.acc, 5, bf2f(((const bf16_t*)(a.ws + WS_VMT))[((size_t)(b * 4 + hd) * 64 + tid - 64) * SEQ + sq]), kv);
}
__global__ void chk_diff_prep(DbgArgs a) {
    const int i = blockIdx.x * 256 + threadIdx.x; const int row = (i * 37 + 5) % MTOK, hd = i & 3, half = (i >> 2) & 1, isk = (i >> 3) & 1, b = row >> 12, sq = row & 4095;
    const bf16_t* src = (const bf16_t*)(a.ws + WS_ZS) + (size_t)row * ZSW + (isk ? C_KD : C_QD) + hd * 64 + half * 32;
    float ss = 0.f; for (int d = 0; d < 32; ++d) { const float v = bf2f(src[d]); ss += v * v; }
    const float rs = rsqrtf(ss / 32.f + EPS) * (isk ? 1.f : 0.17677669529663687f * LOG2E); const float* gg = DIN_(isk ? 34 : 33);
    const bf16_t* dst = (const bf16_t*)(a.ws + (isk ? WS_KD : WS_QD)) + ((size_t)(b * 4 + hd) * SEQ + sq) * 64 + half * 32;
    for (int d = 0; d < 32; ++d) dbg_acc(a.acc, 6, bf2f(dst[d]), bf2f(src[d]) * rs * gg[d]);
    const bf16_t* vs = (const bf16_t*)(a.ws + WS_ZS) + (size_t)row * ZSW + C_VD + hd * 64;
    for (int d = half * 32; d < half * 32 + 32; ++d) dbg_acc(a.acc, 7, bf2f(((const bf16_t*)(a.ws + WS_VDT))[((size_t)(b * 4 + hd) * 64 + d) * SEQ + sq]), bf2f(vs[d]));
}
__global__ void __launch_bounds__(256) chk_lru_prep(DbgArgs a) {
    __shared__ float xcs[64]; const int s = blockIdx.x, tid = threadIdx.x, row = (s * 7919 + 13) % MTOK, n = s & 3, b = row >> 12, sq = row & 4095;
    if (s == 0 || s == 1) { }
    float xc = 0.f;
    if (tid < 64) { const int c = 64 * n + tid; xc = DIN_(27)[c]; for (int k = 0; k < 4; ++k) { const int sr = sq - 3 + k; if (sr >= 0) xc += DIN_(26)[k * 256 + c] * bf2f(((const bf16_t*)(a.ws + WS_ZS))[(size_t)(b * SEQ + sr) * ZSW + C_XLRU + c]); } xcs[tid] = xc; }
    __syncthreads();
    if (tid < 64) { const int c = 64 * n + tid; float ar = DIN_(29)[c], ai = DIN_(31)[c];
        const float* wr_ = DIN_(28); const float* wi_ = DIN_(30);
#pragma unroll 2
        for (int cc = 0; cc < 64; ++cc) { ar += xcs[cc] * wr_[(n * 64 + cc) * 64 + tid]; ai += xcs[cc] * wi_[(n * 64 + cc) * 64 + tid]; }
        const float r = 1.f / (1.f + __expf(-ar)), ii = 1.f / (1.f + __expf(-ai)), la = -8.f * r * __logf(1.f + __expf(-DIN_(32)[c])), av = __expf(la), iv = sqrtf(fmaxf(1.f - av * av, 0.f)) * ii * xc;
        dbg_acc(a.acc, 8, ((const float*)(a.ws + WS_LA))[(size_t)row * 256 + c], av); dbg_acc(a.acc, 9, ((const float*)(a.ws + WS_LI))[(size_t)row * 256 + c], iv); }
}
__global__ void chk_mla_attn(DbgArgs a) {
    __shared__ float sh[256]; __shared__ float q[96]; __shared__ float p[4096];
    const int s = blockIdx.x, tid = threadIdx.x, bh = s & 15, sq = (s * 523 + 77) % SEQ, b = bh >> 2, hd = bh & 3;
    const bf16_t* QM = (const bf16_t*)(a.ws + WS_QM) + (size_t)bh * SEQ * 96; const bf16_t* KM = (const bf16_t*)(a.ws + WS_KM) + (size_t)bh * SEQ * 96; const bf16_t* VMT = (const bf16_t*)(a.ws + WS_VMT) + (size_t)bh * 64 * SEQ;
    if (tid < 96) q[tid] = bf2f(QM[(size_t)sq * 96 + tid]); __syncthreads();
    float mx = -1e30f; for (int j = tid; j <= sq; j += 256) { float sc = 0.f; for (int d = 0; d < 96; ++d) sc += q[d] * bf2f(KM[(size_t)j * 96 + d]); p[j] = sc; mx = fmaxf(mx, sc); }
    mx = blk_max(mx, sh); float sm = 0.f; for (int j = tid; j <= sq; j += 256) { p[j] = exp2f(p[j] - mx); sm += p[j]; } sm = blk_sum(sm, sh);
    if (tid < 64) { float o = 0.f; for (int j = 0; j <= sq; ++j) o += p[j] * bf2f(VMT[(size_t)tid * SEQ + j]); dbg_acc(a.acc, 10, bf2f(((const bf16_t*)(a.ws + WS_Y))[(size_t)1 * MTOK * 256 + (size_t)(b * SEQ + sq) * 256 + hd * 64 + tid]), o / sm); }
}
__global__ void chk_diff_attn(DbgArgs a) {
    __shared__ float sh[256]; __shared__ float q[64]; __shared__ float p1[4096]; __shared__ float p2[4096];
    const int s = blockIdx.x, tid = threadIdx.x, bh = s & 15, sq = (s * 523 + 77) % SEQ, b = bh >> 2, hd = bh & 3;
    const bf16_t* QD = (const bf16_t*)(a.ws + WS_QD) + (size_t)bh * SEQ * 64; const bf16_t* KD = (const bf16_t*)(a.ws + WS_KD) + (size_t)bh * SEQ * 64; const bf16_t* VDT = (const bf16_t*)(a.ws + WS_VDT) + (size_t)bh * 64 * SEQ;
    if (tid < 64) q[tid] = bf2f(QD[(size_t)sq * 64 + tid]); __syncthreads();
    float m1 = -1e30f, m2 = -1e30f; for (int j = tid; j <= sq; j += 256) { float s1 = 0.f, s2 = 0.f; for (int d = 0; d < 32; ++d) { s1 += q[d] * bf2f(KD[(size_t)j * 64 + d]); s2 += q[32 + d] * bf2f(KD[(size_t)j * 64 + 32 + d]); }
        const float bias = DIN_(3)[dbucket(sq - j) * 4 + hd] * LOG2E; s1 += bias; s2 += bias; p1[j] = s1; p2[j] = s2; m1 = fmaxf(m1, s1); m2 = fmaxf(m2, s2); }
    m1 = blk_max(m1, sh); m2 = blk_max(m2, sh); float l1 = 0.f, l2 = 0.f; for (int j = tid; j <= sq; j += 256) { p1[j] = exp2f(p1[j] - m1); p2[j] = exp2f(p2[j] - m2); l1 += p1[j]; l2 += p2[j]; } l1 = blk_sum(l1, sh); l2 = blk_sum(l2, sh);
    float s1 = 0.f, s2 = 0.f; for (int d = 0; d < 32; ++d) { s1 += DIN_(35)[d] * DIN_(36)[d]; s2 += DIN_(37)[d] * DIN_(38)[d]; } const float lam_init = DBG_LAYER == 0 ? 0.2f : 0.8f - 0.6f * 0.7408182206817179f, lam = expf(s1) - expf(s2) + lam_init;
    float o = 0.f; if (tid < 64) { float o1 = 0.f, o2 = 0.f; for (int j = 0; j <= sq; ++j) { const float v = bf2f(VDT[(size_t)tid * SEQ + j]); o1 += p1[j] * v; o2 += p2[j] * v; } o = o1 / l1 - lam * o2 / l2; }
    const float ss = blk_sum(tid < 64 ? o * o : 0.f, sh);
    if (tid < 64) dbg_acc(a.acc, 11, bf2f(((const bf16_t*)(a.ws + WS_Y))[(size_t)3 * MTOK * 256 + (size_t)(b * SEQ + sq) * 256 + hd * 64 + tid]), o * rsqrtf(ss / 64.f + EPS) * DIN_(39)[tid] * (1.f - lam_init));
}
__global__ void chk_lru_scan(DbgArgs a) {
    const int i = blockIdx.x * 256 + threadIdx.x, b = i >> 8, c = i & 255; if (b >= NB) return;
    const float* LA = (const float*)(a.ws + WS_LA); const float* LI = (const float*)(a.ws + WS_LI); float h = 0.f;
    for (int t = 0; t < SEQ; ++t) { const size_t o = (size_t)(b * SEQ + t) * 256 + c; h = LA[o] * h + LI[o];
        if (t % 97 == 0 || t == SEQ - 1) dbg_acc(a.acc, 12, bf2f(((const bf16_t*)(a.ws + WS_Y))[(size_t)2 * MTOK * 256 + o]), h * dgelu(bf2f(((const bf16_t*)(a.ws + WS_ZS))[(size_t)(b * SEQ + t) * ZSW + C_GLRU + c]))); }
}
__global__ void chk_s5_scan(DbgArgs a) {
    __shared__ float part[16][65]; const int g = blockIdx.x, p = threadIdx.x; float* ypre = (float*)(a.ws + WS_DBG);
    const float dt = expf(DIN_(12)[g]), lr = DIN_(10)[g * 64 + p], li = DIN_(11)[g * 64 + p], mag = expf(lr * dt); float sn, cs; sincos_red(li * dt, sn, cs);
    const float ar = mag * cs, ai = mag * sn, den = lr * lr + li * li, zr = ((ar - 1.f) * lr + ai * li) / den, zi = (ai * lr - (ar - 1.f) * li) / den;
    float hr = 0.f, hi = 0.f;
    for (int t = 0; t < SEQ; ++t) { const bf16_t* up = (const bf16_t*)(a.ws + WS_ZS) + (size_t)(SEQ + t) * ZSW + 16 * g; float bur = 0.f, bui = 0.f;
        for (int c = 0; c < 16; ++c) { const float u = bf2f(up[c]), br = DIN_(13)[(g * 64 + p) * 16 + c], bi = DIN_(14)[(g * 64 + p) * 16 + c]; bur += (zr * br - zi * bi) * u; bui += (zr * bi + zi * br) * u; }
        const float nr = ar * hr - ai * hi + bur, ni = ar * hi + ai * hr + bui; hr = nr; hi = ni;
        for (int c = 0; c < 16; ++c) part[c][p] = DIN_(15)[(g * 16 + c) * 64 + p] * hr - DIN_(16)[(g * 16 + c) * 64 + p] * hi;
        __syncthreads();
        if (p < 16) { float y = 0.f; for (int pp = 0; pp < 64; ++pp) y += part[p][pp]; y += DIN_(17)[16 * g + p] * bf2f(up[p]); ypre[(size_t)t * 256 + 16 * g + p] = dgelu(y); }
        __syncthreads(); }
}
__global__ void chk_s5_glu(DbgArgs a) {
    const int s = blockIdx.x, n = threadIdx.x, t = (s * 61 + 5) % SEQ; const float* ypre = (const float*)(a.ws + WS_DBG) + (size_t)t * 256;
    float z = DIN_(19)[n]; for (int k = 0; k < 256; ++k) z += ypre[k] * DIN_(18)[k * 256 + n];
    dbg_acc(a.acc, 13, bf2f(((const bf16_t*)(a.ws + WS_Y))[(size_t)(SEQ + t) * 256 + n]), ypre[n] * dsig(z));
}

__global__ void chk_merge(DbgArgs a) {
    __shared__ float sh[256]; const int s = blockIdx.x, tid = threadIdx.x, row = (s * 7919 + 13) % MTOK, col = (s * 104729 + 7) % DM;
    const bf16_t* Y = (const bf16_t*)(a.ws + WS_Y); const bf16_t* ZGp = (const bf16_t*)(a.ws + WS_ZG) + (size_t)row * ZGW; const bf16_t* MGp = (const bf16_t*)(a.ws + WS_MERGED) + (size_t)row * DM;
    float m = 0.f;
    for (int n = 0; n < 4; ++n) { float d = 0.f; { const int k = tid; d = bf2f(Y[(size_t)n * MTOK * 256 + (size_t)row * 256 + k]) * DIN_(40)[((size_t)n * 256 + k) * DM + col]; } d = blk_sum(d, sh); m += bf2f(ZGp[n * DM + col]) * d; }
    if (tid == 0) dbg_acc(a.acc, 14, bf2f(MGp[col]), m);
    float o = 0.f; for (int c = tid; c < DM; c += 256) o += bf2f(MGp[c]) * DIN_(41)[(size_t)c * DM + col]; o = blk_sum(o, sh);
    if (tid == 0) dbg_acc(a.acc, 15, a.out[(size_t)row * DM + col], DXIN_[(size_t)row * DM + col] + o);
}
__global__ void chk_cross(DbgArgs a) {
    __shared__ float sh[256]; __shared__ float hn[DM]; __shared__ float q[64]; __shared__ float p[256]; __shared__ float mn[DM];
    const int s = blockIdx.x, tid = threadIdx.x, row = (s * 7919 + 13) % MTOK, hd = s & 3, b = row >> 12;
    const float* x1 = a.out + (size_t)row * DM; float ss = 0.f; for (int k = tid; k < DM; k += 256) ss += x1[k] * x1[k]; ss = blk_sum(ss, sh); const float rs = rsqrtf(ss / DM + EPS);
    for (int k = tid; k < DM; k += 256) hn[k] = x1[k] * rs * DIN_(5)[k]; __syncthreads();
    float qf = 0.f; if (tid < 64) { for (int k = 0; k < DM; ++k) qf += hn[k] * DIN_(42)[(size_t)k * 256 + hd * 64 + tid]; dbg_acc(a.acc, 16, bf2f(((const bf16_t*)(a.ws + WS_QX))[(size_t)row * 256 + hd * 64 + tid]), qf); }
    { const float s2 = blk_sum(tid < 64 ? qf * qf : 0.f, sh); if (tid < 64) q[tid] = qf * rsqrtf(s2 / 64.f + EPS) * DIN_(46)[tid] * 0.125f; __syncthreads(); }
    float sc = 0.f; float vj[1]; (void)vj;
    { const float* mr = DIN_(1) + (size_t)(b * 256 + tid) * DM; float ms = 0.f; for (int k = 0; k < DM; ++k) ms += mr[k] * mr[k]; const float mrs = rsqrtf(ms / DM + EPS);
      float kk[64]; (void)kk; float s2 = 0.f; float dotq = 0.f;
      for (int d = 0; d < 64; ++d) { float kd = 0.f; for (int k = 0; k < DM; ++k) kd += mr[k] * mrs * DIN_(6)[k] * DIN_(43)[(size_t)k * 256 + hd * 64 + d]; s2 += kd * kd; dotq += kd * DIN_(47)[d] * q[d]; }
      sc = dotq * rsqrtf(s2 / 64.f + EPS); }
    const float mx = blk_max(sc, sh); const float e = expf(sc - mx); const float sm = blk_sum(e, sh); p[tid] = e / sm; __syncthreads();
    if (tid < 64) { float o = 0.f; for (int j = 0; j < 256; ++j) { const float* mr = DIN_(1) + (size_t)(b * 256 + j) * DM; float ms = 0.f, vd = 0.f; for (int k = 0; k < DM; ++k) { ms += mr[k] * mr[k]; vd += mr[k] * DIN_(6)[k] * DIN_(44)[(size_t)k * 256 + hd * 64 + tid]; } o += p[j] * vd * rsqrtf(ms / DM + EPS); }
        dbg_acc(a.acc, 17, bf2f(((const bf16_t*)(a.ws + WS_OX))[(size_t)row * 256 + hd * 64 + tid]), o); }
}
__global__ void chk_ffn(DbgArgs a) {
    __shared__ float sh[256]; __shared__ float hn[DM]; const int s = blockIdx.x, tid = threadIdx.x, row = (s * 7919 + 13) % MTOK;
    const float* x2 = a.out + (size_t)row * DM; float ss = 0.f; for (int k = tid; k < DM; k += 256) ss += x2[k] * x2[k]; ss = blk_sum(ss, sh); const float rs = rsqrtf(ss / DM + EPS);
    for (int k = tid; k < DM; k += 256) hn[k] = x2[k] * rs * DIN_(7)[k]; __syncthreads();
    for (int j = tid; j < FF; j += 256 * 8) { float g = 0.f, u = 0.f; for (int k = 0; k < DM; ++k) { g += hn[k] * DIN_(48)[(size_t)k * FF + j]; u += hn[k] * DIN_(49)[(size_t)k * FF + j]; }
        dbg_acc(a.acc, 18, bf2f(((const bf16_t*)(a.ws + WS_HFF))[(size_t)row * FF + j]), g / (1.f + expf(-g)) * u); }
}

__global__ void chk_moe(DbgArgs a) {
    __shared__ float sh[256]; __shared__ float hn[DM]; __shared__ float hid[EFF]; __shared__ float lgs[8];
    const int s = blockIdx.x, tid = threadIdx.x, tok = (s * 7919 + 13) % MTOK, slot = s & 1, col = (s * 104729 + 7) % DM;
    const float* x2 = a.out + (size_t)tok * DM; float ss = 0.f; for (int k = tid; k < DM; k += 256) ss += x2[k] * x2[k]; ss = blk_sum(ss, sh); const float rs = rsqrtf(ss / DM + EPS);
    for (int k = tid; k < DM; k += 256) hn[k] = x2[k] * rs * ((const float*)a.in[7])[DM + k]; __syncthreads();
    for (int e = 0; e < 8; ++e) { float d = 0.f; for (int k = tid; k < DM; k += 256) d += hn[k] * DIN_(51)[k * 8 + e]; d = blk_sum(d, sh); if (tid == 0) lgs[e] = d; } __syncthreads();
    int e1 = 0; for (int e = 1; e < 8; ++e) if (lgs[e] > lgs[e1]) e1 = e; int e2 = -1; for (int e = 0; e < 8; ++e) if (e != e1 && (e2 < 0 || lgs[e] > lgs[e2])) e2 = e;
    const float w1 = 1.f / (1.f + expf(lgs[e2] - lgs[e1])), w2 = 1.f - w1;
    const int* ASG = (const int*)(a.ws + WS_MOESM + MS_ASSIGN); const int* TD = (const int*)(a.ws + WS_MOESM + MS_TOKDEST); const float* TW = (const float*)(a.ws + WS_MOESM + MS_TOKW); const int* RT = (const int*)(a.ws + WS_MOESM + MS_ROWTOK);
    const int ef = ASG[2 * tok + slot] & 255, dest = TD[2 * tok + slot];
    if (tid == 0) { dbg_acc(a.acc, 19, (float)(ASG[2 * tok] & 255), (float)e1 + 1e-3f); dbg_acc(a.acc, 19, (float)(ASG[2 * tok + 1] & 255), (float)e2 + 1e-3f); dbg_acc(a.acc, 19, TW[2 * tok], w1); dbg_acc(a.acc, 19, TW[2 * tok + 1], w2); dbg_acc(a.acc, 19, (float)(RT[dest] - tok), 1e-3f); }
    const float* wg = DIN_(52) + (size_t)ef * DM * EFF; const float* wu = DIN_(53) + (size_t)ef * DM * EFF; const float* wd = DIN_(54) + (size_t)ef * EFF * DM;
    for (int f = tid; f < EFF; f += 256) { float g = 0.f, u = 0.f; for (int k = 0; k < DM; ++k) { g += hn[k] * wg[(size_t)k * EFF + f]; u += hn[k] * wu[(size_t)k * EFF + f]; } hid[f] = g / (1.f + expf(-g)) * u; }
    __syncthreads();
    float y = 0.f; for (int f = tid; f < EFF; f += 256) y += hid[f] * wd[(size_t)f * DM + col]; y = blk_sum(y, sh);
    if (tid == 0) dbg_acc(a.acc, 20, bf2f(((const bf16_t*)(a.ws + WS_YS))[(size_t)dest * DM + col]), y);
}

__global__ void chk_res(DbgArgs a, int kind) {
    __shared__ float sh[256]; const int s = blockIdx.x, tid = threadIdx.x, row = (s * 7919 + 13) % MTOK, col = (s * 104729 + 7) % DM; const float* xprev = (const float*)(a.ws + WS_DBG);
    float o = 0.f;
    if (kind == 0) { const bf16_t* A = (const bf16_t*)(a.ws + WS_OX) + (size_t)row * 256; o = bf2f(A[tid]) * DIN_(45)[(size_t)tid * DM + col]; }
    else { const bf16_t* A = (const bf16_t*)(a.ws + WS_HFF) + (size_t)row * FF; for (int k = tid; k < FF; k += 256) o += bf2f(A[k]) * DIN_(50)[(size_t)k * DM + col]; }
    o = blk_sum(o, sh);
    if (tid == 0) { dbg_acc(a.acc, 21, a.out[(size_t)row * DM + col], xprev[(size_t)row * DM + col] + o);
        const bf16_t xbv = ((const bf16_t*)(a.ws + WS_XB))[(size_t)row * DM + col]; dbg_acc(a.acc, 22, bf2f(xbv), a.out[(size_t)row * DM + col]); }
}

__global__ void chk_final(DbgArgs a) {
    const int i = blockIdx.x * 256 + threadIdx.x; const int tok = (i * 37 + 5) % MTOK, col = (i * 101 + 3) % DM; const float* xprev = (const float*)(a.ws + WS_DBG);
    const int* TD = (const int*)(a.ws + WS_MOESM + MS_TOKDEST); const float* TW = (const float*)(a.ws + WS_MOESM + MS_TOKW); const bf16_t* YS = (const bf16_t*)(a.ws + WS_YS);
    const float ref = xprev[(size_t)tok * DM + col] + TW[2 * tok] * bf2f(YS[(size_t)TD[2 * tok] * DM + col]) + TW[2 * tok + 1] * bf2f(YS[(size_t)TD[2 * tok + 1] * DM + col]);
    dbg_acc(a.acc, 23, a.out[(size_t)tok * DM + col], ref);
}
__global__ void chk_emit(DbgArgs a, int nchk) {
    for (int i = blockIdx.x * 256 + threadIdx.x; i < MTOK * DM; i += gridDim.x * 256) a.out[i] = 0.f;
    if (blockIdx.x == 0 && threadIdx.x == 0) { float V = 99000.f; float worst = 0.f;
        for (int k = 1; k <= nchk; ++k) { const float cnt = a.acc[64 + k]; const float rms = sqrtf(a.acc[2 * k + 1] / fmaxf(cnt, 1.f)) + 1e-20f; float err = a.acc[2 * k] / rms; if (cnt < 1.f) continue; if (!(err == err)) err = 0.97f; worst = fmaxf(worst, err);
#ifdef DBG_ONLY
            if (k == DBG_ONLY) { V = 1000.f + err * 10000.f; break; }
#else
            if (err > 0.06f) { V = (float)k * 1000.f + fminf(err, 0.99f) * 1000.f; break; }
#endif
        }
        if (V == 99000.f) V = 99000.f + worst * 1000.f;
        a.out[12345] = V; }
}
#endif

#ifdef DBG_STAT
__global__ void stat_scan(const float* out, unsigned* acc) {
    for (int i = blockIdx.x * 256 + threadIdx.x; i < MTOK * DM; i += gridDim.x * 256) { const float v = fabsf(out[i]);
        atomicMax(&acc[1], __float_as_uint(v)); if (v > 10.f || !(v == v)) { atomicAdd(&acc[0], 1u); atomicAdd(&acc[2 + (i >> 18)], 1u); atomicAdd(&acc[70 + ((i & 1023) >> 8)], 1u); atomicAdd(&acc[80 + ((i >> 10) & 255) / 32], 1u); } }
}
__global__ void stat_emit(float* out, const unsigned* acc, int mode) {
    for (int i = blockIdx.x * 256 + threadIdx.x; i < MTOK * DM; i += gridDim.x * 256) out[i] = 0.f;
    if (blockIdx.x == 0 && threadIdx.x == 0) { float V = 0.f;
        if (mode == 0) V = (float)acc[0];
        else if (mode == 1) V = __uint_as_float(acc[1]) * 100.f;
        else if (mode == 2) { unsigned best = 0, bi = 0, nz = 0; for (int k = 0; k < 64; ++k) { if (acc[2 + k] > best) { best = acc[2 + k]; bi = k; } nz += acc[2 + k] > 0; } V = 1000.f * (float)bi + 10.f * (float)nz; }
        else if (mode == 3) V = 1000.f * (float)acc[70] / fmaxf((float)acc[0], 1.f) + 100000.f * (float)acc[71] / fmaxf((float)acc[0], 1.f);
        else if (mode == 4) { unsigned best = 0, bi = 0; for (int k = 0; k < 8; ++k) if (acc[80 + k] > best) { best = acc[80 + k]; bi = k; } V = 1000.f + 1000.f * (float)bi + 900.f * (float)best / fmaxf((float)acc[0], 1.f); }
        out[12345] = V + 100.f; }
}
#endif

#ifdef DBG_VAR
__global__ void var_scan(const float* out, const float* prev, float* acc) {
    float s = 0.f, mx = 0.f; for (int i = blockIdx.x * 256 + threadIdx.x; i < MTOK * DM; i += gridDim.x * 256) { const float d = out[i] - prev[i]; s += d * d; mx = fmaxf(mx, fabsf(d)); }
    atomicAdd(&acc[0], s); atomicMax((unsigned*)&acc[1], __float_as_uint(mx));
}
__global__ void var_emit(float* out, const float* acc, int mode) {
    for (int i = blockIdx.x * 256 + threadIdx.x; i < MTOK * DM; i += gridDim.x * 256) out[i] = 0.f;
    if (blockIdx.x == 0 && threadIdx.x == 0) out[12345] = 100.f + (mode == 0 ? acc[0] / (float)(MTOK * DM) * 1e5f : acc[1] * 100.f);
}
#endif

#ifdef DBG_GSTAT
__global__ void gstat_scan(const bf16_t* zg, float* acc) { float s1 = 0.f, s2 = 0.f; for (size_t i = blockIdx.x * 256 + threadIdx.x; i < (size_t)MTOK * ZGW; i += (size_t)gridDim.x * 256) { const float g = bf2f(zg[i]); const int blk = (int)((i & 4095) >> 10); if (blk == DBG_GSTAT) { s1 += (g < -0.01f || g > 1.01f || !(g == g)) ? 1.f : 0.f; s2 += (g - 0.5f) * (g - 0.5f); } } atomicAdd(&acc[0], s1); atomicAdd(&acc[1], s2); }
__global__ void gstat_emit(float* out, const float* acc, int mode) {
    for (int i = blockIdx.x * 256 + threadIdx.x; i < MTOK * DM; i += gridDim.x * 256) out[i] = 0.f;
    if (blockIdx.x == 0 && threadIdx.x == 0) out[12345] = 100.f + 10000.f * acc[1] / ((float)MTOK * 1024);
}
#endif
extern "C" void kernel_launch(void* const* d_in, const int* in_sizes, int n_in, void* d_out, int out_size, void* d_ws, size_t ws_size, hipStream_t stream) {
    static int grid = 0;
    if (grid == 0) {
        if (n_in != 55 || out_size != MTOK * DM || ws_size < WS_END) { fprintf(stderr, "kernel_launch: unexpected shapes (n_in %d out %d ws %zu)\n", n_in, out_size, ws_size); grid = -1; return; }
        { const int L2 = 2; const int exp_sz[55] = {NB * SEQ * DM, NB * NMEM * DM, NB * SEQ, 32 * 4, L2 * DM, L2 * DM, L2 * DM, L2 * DM, L2 * DM * DIN, L2 * 4 * DM, L2 * 1024, L2 * 1024, L2 * 16, L2 * 16384, L2 * 16384, L2 * 16384, L2 * 16384, L2 * 256, L2 * 65536, L2 * 256,
              L2 * 192, L2 * 128, L2 * 192 * 384, L2 * 128 * 512, L2 * 96, L2 * 96, L2 * 1024, L2 * 256, L2 * 16384, L2 * 256, L2 * 16384, L2 * 256, L2 * 256, L2 * 32, L2 * 32, L2 * 32, L2 * 32, L2 * 32, L2 * 32, L2 * 64,
              L2 * 4 * 256 * DM, L2 * DM * DM, L2 * DM * 256, L2 * DM * 256, L2 * DM * 256, L2 * 256 * DM, L2 * 64, L2 * 64, DM * FF, DM * FF, FF * DM, DM * 8, 8 * DM * EFF, 8 * DM * EFF, 8 * EFF * DM};
          for (int i = 0; i < 55; ++i) if (in_sizes[i] != exp_sz[i]) { fprintf(stderr, "kernel_launch: input %d has %d elements, expected %d\n", i, in_sizes[i], exp_sz[i]); grid = -1; return; } }
        int dev = 0, cus = 0, per_cu = 0;
        if (hipGetDevice(&dev) != hipSuccess || hipDeviceGetAttribute(&cus, hipDeviceAttributeMultiprocessorCount, dev) != hipSuccess) { grid = -1; return; }
        if (hipFuncSetAttribute((const void*)hybrid_fwd, hipFuncAttributeMaxDynamicSharedMemorySize, LDS_BYTES) != hipSuccess) { fprintf(stderr, "kernel_launch: hipFuncSetAttribute failed\n"); grid = -1; return; }
        if (hipOccupancyMaxActiveBlocksPerMultiprocessor(&per_cu, (const void*)hybrid_fwd, 512, LDS_BYTES) != hipSuccess || per_cu < 1) { fprintf(stderr, "kernel_launch: occupancy query says %d\n", per_cu); }
        (void)hipGetLastError();
        grid = cus;
    }
    if (grid < 0) return;
    if (hipMemsetAsync((char*)d_ws + WS_CTL, 0, CTL_ZERO_BYTES, stream) != hipSuccess) return;
    Args a{};
    for (int i = 0; i < 55; ++i) a.in[i] = d_in[i];
    a.out = (float*)d_out; a.ws = (unsigned char*)d_ws; a.submask = 0xFFFF; a.pad = 0;
#if MK_ONE_LAUNCH
    a.ph_lo = 0; a.ph_hi = NPHASE;
    hipLaunchKernelGGL(hybrid_fwd, dim3(grid), dim3(512), LDS_BYTES, stream, a);
#else
    for (int p = 0; p < DBG_NPH; ++p) { a.ph_lo = p; a.ph_hi = p + 1;
#if defined(DBG_CHECK) || defined(DBG_VAR)
        if (p == DBG_NPH - 1) hipMemcpyAsync((char*)d_ws + 440 * MiB, d_out, (size_t)MTOK * DM * 4, hipMemcpyDeviceToDevice, stream);
#endif
        hipLaunchKernelGGL(hybrid_fwd, dim3(grid), dim3(512), LDS_BYTES, stream, a);
#ifdef DBG_REPEAT
        if (p == DBG_REPEAT) {
#ifdef DBG_REPSUB
            a.submask = DBG_REPSUB;
#endif
            hipLaunchKernelGGL(hybrid_fwd, dim3(grid), dim3(512), LDS_BYTES, stream, a); hipLaunchKernelGGL(hybrid_fwd, dim3(grid), dim3(512), LDS_BYTES, stream, a); a.submask = 0xFFFF; }
#endif
    }
#ifdef DBG_CHECK
    { DbgArgs da{}; for (int i = 0; i < 55; ++i) da.in[i] = d_in[i]; da.ws = (unsigned char*)d_ws; da.out = (float*)d_out; da.acc = (float*)((char*)d_ws + 700 * 1024);
#if DBG_NPH == 6 || DBG_NPH == 16
      hipLaunchKernelGGL(chk_merge, dim3(512), dim3(256), 0, stream, da);
#elif DBG_NPH == 8 || DBG_NPH == 18
      hipLaunchKernelGGL(chk_cross, dim3(64), dim3(256), 0, stream, da);
#elif DBG_NPH == 10
      hipLaunchKernelGGL(chk_ffn, dim3(64), dim3(256), 0, stream, da);
#elif DBG_NPH == 24
      hipLaunchKernelGGL(chk_final, dim3(64), dim3(256), 0, stream, da);
#elif DBG_NPH == 23
      hipLaunchKernelGGL(chk_moe, dim3(128), dim3(256), 0, stream, da);
#elif DBG_NPH == 9 || DBG_NPH == 19
      hipLaunchKernelGGL(chk_res, dim3(512), dim3(256), 0, stream, da, 0);
#elif DBG_NPH == 11
      hipLaunchKernelGGL(chk_res, dim3(512), dim3(256), 0, stream, da, 1);
#else
      hipLaunchKernelGGL(chk_z, dim3(1024), dim3(256), 0, stream, da);
      hipLaunchKernelGGL(chk_mla_prep, dim3(512), dim3(256), 0, stream, da);
      hipLaunchKernelGGL(chk_diff_prep, dim3(16), dim3(256), 0, stream, da);
      hipLaunchKernelGGL(chk_lru_prep, dim3(512), dim3(256), 0, stream, da);
      hipLaunchKernelGGL(chk_mla_attn, dim3(64), dim3(256), 0, stream, da);
      hipLaunchKernelGGL(chk_diff_attn, dim3(64), dim3(256), 0, stream, da);
      hipLaunchKernelGGL(chk_lru_scan, dim3(4), dim3(256), 0, stream, da);
      hipLaunchKernelGGL(chk_s5_scan, dim3(16), dim3(64), 0, stream, da);
      hipLaunchKernelGGL(chk_s5_glu, dim3(64), dim3(256), 0, stream, da);
#endif
      hipLaunchKernelGGL(chk_emit, dim3(1024), dim3(256), 0, stream, da, 23); }
#endif
#ifdef DBG_COPYX
    hipMemcpyAsync(d_out, d_in[0], (size_t)MTOK * DM * 4, hipMemcpyDeviceToDevice, stream);
#endif
#ifdef DBG_GSTAT
    { float* acc = (float*)((char*)d_ws + 900 * 1024);
      hipLaunchKernelGGL(gstat_scan, dim3(2048), dim3(256), 0, stream, (const bf16_t*)((const char*)d_ws + WS_ZG), acc);
      hipLaunchKernelGGL(gstat_emit, dim3(1024), dim3(256), 0, stream, (float*)d_out, (const float*)acc, DBG_GSTAT); }
#endif
#ifdef DBG_VAR
    { float* acc = (float*)((char*)d_ws + 900 * 1024);
      hipLaunchKernelGGL(var_scan, dim3(1024), dim3(256), 0, stream, (const float*)d_out, DBG_NPH == 6 ? (const float*)d_in[0] : (const float*)((const char*)d_ws + 440 * MiB), acc);
      hipLaunchKernelGGL(var_emit, dim3(1024), dim3(256), 0, stream, (float*)d_out, (const float*)acc, DBG_VAR); }
#endif
#ifdef DBG_STAT
    { unsigned* acc = (unsigned*)((char*)d_ws + 800 * 1024);
      hipLaunchKernelGGL(stat_scan, dim3(2048), dim3(256), 0, stream, (const float*)d_out, acc);
      hipLaunchKernelGGL(stat_emit, dim3(1024), dim3(256), 0, stream, (float*)d_out, (const unsigned*)acc, DBG_STAT); }
#endif
#ifdef DBG_DUMP_OFF
    hipLaunchKernelGGL(dbg_copy_bf16, dim3(2048), dim3(256), 0, stream, (const bf16_t*)((const char*)d_ws + (size_t)(DBG_DUMP_OFF)), (float*)d_out, MTOK * DM, DBG_DUMP_N);
#endif
#endif
}
```

```cpp
#include <hip/hip_runtime.h>
#include <cstdio>
#include <cstdint>

#define DBG_NPH 24

#ifndef DBG_GPERM
#define DBG_GPERM(n) (n)
#endif
#ifndef DBG_SCALE
#define DBG_SCALE 1.0f
#endif
#ifndef MK_ONE_LAUNCH
#define MK_ONE_LAUNCH 1
#endif
#ifndef G2_FP8
#define G2_FP8 0
#endif

#define LAS __attribute__((address_space(3)))
typedef unsigned short bf16_t;
typedef short bf16x8 __attribute__((ext_vector_type(8)));
typedef float f32x2 __attribute__((ext_vector_type(2)));
typedef float f32x4 __attribute__((ext_vector_type(4)));
typedef float f32x16 __attribute__((ext_vector_type(16)));
typedef unsigned u32x2 __attribute__((ext_vector_type(2)));
typedef unsigned u32x4 __attribute__((ext_vector_type(4)));
typedef int i32x4 __attribute__((ext_vector_type(4)));
typedef int i32x8 __attribute__((ext_vector_type(8)));

constexpr int DM = 1024, NB = 4, SEQ = 4096, MTOK = NB * SEQ, NMEM = 256;
constexpr int DIN = 5984, ZSW = 2048, ZGW = 4096, NIN = ZSW + ZGW;
constexpr int C_S5 = 0, C_CQ = 256, C_CKV = 448, C_KPE = 576, C_XLRU = 608, C_GLRU = 864, C_QD = 1120, C_KD = 1376, C_VD = 1632, C_END = 1888;
constexpr int FF = 2816, EFF = 3584, NEXP = 8, MOE_ROWS = 34816;
constexpr float EPS = 1e-6f, LOG2E = 1.4426950408889634f;

constexpr size_t MiB = 1u << 20;
constexpr size_t WS_CTL = 0, CTL_ZERO_BYTES = 1 * MiB + 512 * 1024;
constexpr size_t WS_MOESM = 1 * MiB;
constexpr size_t WS_XB = 2 * MiB;
constexpr size_t WS_WL = 34 * MiB, WL_STRIDE = 19 * MiB;
constexpr size_t WL_WIN = 0, WL_PT = 12 * MiB, WL_WO = 14 * MiB, WL_WXQ = 16 * MiB, WL_WXKV = 16 * MiB + 512 * 1024, WL_WXO = 17 * MiB + 512 * 1024, WL_SM = 18 * MiB;
constexpr size_t SM_WUQ = 0, SM_WUKV = 256 * 1024, SM_WR = 512 * 1024, SM_WI = 576 * 1024, SM_WGLU = 640 * 1024;
constexpr size_t WS_WGU = 72 * MiB, WS_WD = 83 * MiB, WS_TAB = 89 * MiB, WS_KX = 90 * MiB, WS_VXT = 91 * MiB;
constexpr size_t TAB_S5T = 0, TAB_CMAT = 512 * 1024, TAB_MISC = 768 * 1024;
constexpr size_t WS_ZS = 92 * MiB, WS_MERGED = 92 * MiB, WS_ZG = 156 * MiB, WS_HFF = 156 * MiB, WS_Y = 284 * MiB;
constexpr size_t WS_QM = 316 * MiB, WS_KM = 328 * MiB, WS_VMT = 340 * MiB, WS_QD = 348 * MiB, WS_KD = 356 * MiB, WS_VDT = 364 * MiB;
constexpr size_t WS_QX = 316 * MiB, WS_OX = 324 * MiB;
constexpr size_t WS_LA = 372 * MiB, WS_LI = 388 * MiB, WS_S5S = 404 * MiB, WS_LSUM = 406 * MiB, WS_RSP = 407 * MiB;
constexpr size_t WS_WMGU = 34 * MiB, WS_WMD = 146 * MiB, WS_HMOE = 202 * MiB, WS_XQ = 330 * MiB, WS_YS = 34 * MiB, WS_X8 = 416 * MiB, WS_END = 440 * MiB;
constexpr int CW_TMO = 0, CW_BAR = 4096, CW_MOECNT = 8192, CW_Q = 12288;
constexpr size_t CTL_ROWSS = 256 * 1024;
constexpr size_t MS_ROWTOK = 0, MS_TOKW = 512 * 1024, MS_ASSIGN = 640 * 1024, MS_RSTD = 768 * 1024;
constexpr int RING_BYTES = 131072, MISC_OFF = RING_BYTES + 320, LDS_BYTES = 147456;

typedef __bf16 bf16x2_t __attribute__((ext_vector_type(2)));
__device__ __forceinline__ unsigned cvt_pk_bf16(float lo, float hi) { const f32x2 v = {lo, hi}; const bf16x2_t b = __builtin_convertvector(v, bf16x2_t); return __builtin_bit_cast(unsigned, b); }
__device__ __forceinline__ float clamp8(float x) { return __builtin_fminf(__builtin_fmaxf(x, -448.f), 448.f); }
__device__ __forceinline__ unsigned cvt_pk4_fp8(float a, float b, float c, float d) { int w = __builtin_amdgcn_cvt_pk_fp8_f32(clamp8(a), clamp8(b), 0, false); w = __builtin_amdgcn_cvt_pk_fp8_f32(clamp8(c), clamp8(d), w, true); return (unsigned)w; }
__device__ __forceinline__ float bflo(unsigned w) { return __uint_as_float(w << 16); }
__device__ __forceinline__ float bfhi(unsigned w) { return __uint_as_float(w & 0xffff0000u); }
__device__ __forceinline__ float bf2f(bf16_t b) { return __uint_as_float((unsigned)b << 16); }
__device__ __forceinline__ bf16_t f2bf(float f) { return (bf16_t)(cvt_pk_bf16(f, 0.f) & 0xffffu); }
__device__ __forceinline__ float fexp2(float x) { return __builtin_amdgcn_exp2f(x); }
__device__ __forceinline__ float frcp(float x) { return __builtin_amdgcn_rcpf(x); }
__device__ __forceinline__ float frsq(float x) { return __builtin_amdgcn_rsqf(x); }
__device__ __forceinline__ float fsigmoid(float x) { return frcp(1.f + fexp2(-x * LOG2E)); }
__device__ __forceinline__ float fgelu(float x) {
    const float z = 0.7978845608028654f * (x + 0.044715f * x * x * x);
    const float e = fexp2(2.f * LOG2E * z);
    const float th = 1.f - 2.f * frcp(e + 1.f);
    return 0.5f * x * (1.f + th);
}
__device__ __forceinline__ int crow(int r, int hi) { return (r & 3) + 8 * (r >> 2) + 4 * hi; }
__device__ __forceinline__ bf16x8 ldg8(const bf16_t* p) { return *(const bf16x8*)p; }
__device__ __forceinline__ float sq8(bf16x8 v) {
    const u32x4 w = *(const u32x4*)&v; float s = 0.f;
#pragma unroll
    for (int i = 0; i < 4; ++i) { const float a = bflo(w[i]), b = bfhi(w[i]); s += a * a + b * b; }
    return s;
}
__device__ __forceinline__ float row_rstd(const float* rsp, int row) {
    const f32x4* p = (const f32x4*)(rsp + (size_t)row * 16); const f32x4 a = p[0], b = p[1], c = p[2], d = p[3];
    const float s = (((a.x + a.y) + (a.z + a.w)) + ((b.x + b.y) + (b.z + b.w))) + (((c.x + c.y) + (c.z + c.w)) + ((d.x + d.y) + (d.z + d.w)));
    return frsq(s * (1.f / DM) + EPS);
}
__device__ __forceinline__ float wave_sum(float v) {
#pragma unroll
    for (int o = 1; o < 64; o <<= 1) v += __shfl_xor(v, o);
    return v;
}
#define MFMA32(a, b, c) __builtin_amdgcn_mfma_f32_32x32x16_bf16((a), (b), (c), 0, 0, 0)
#define MFMA16(a, b, c) __builtin_amdgcn_mfma_f32_16x16x32_bf16((a), (b), (c), 0, 0, 0)
__device__ __forceinline__ void sincos_red(float a, float& s, float& c) {
    const float k = rintf(a * 0.15915494309189535f);
    float r = fmaf(-k, 6.28318548202514648f, a);
    r = fmaf(-k, -1.7484555e-7f, r);
    s = __sinf(r); c = __cosf(r);
}

namespace pg8 {
constexpr int BM = 256, BK = 64, HALF = 128, HTB = HALF * BK * 2, STAGE_BYTES = 8 * HTB;
__host__ __device__ __forceinline__ int lds_byte(int r, int c) { const int st = (r >> 4) * 2 + (c >> 5), rr = r & 15, cc = c & 31, ob = rr * 64 + cc * 2; return st * 1024 + (ob ^ (((ob >> 9) & 1) << 5)); }
__host__ __device__ __forceinline__ void stage_rc(int b, int& R, int& C) { const int st = b / 1024, sb = b % 1024, swz = sb ^ (((sb >> 9) & 1) << 5); R = (st >> 1) * 16 + swz / 64; C = (st & 1) * 32 + (swz % 64) / 2; }
__host__ __device__ __forceinline__ int perm32(int rho) { const int n = rho >> 4, i = rho & 15; return 8 * (i >> 2) + 4 * n + (i & 3); }

struct Unit { int pm, pn, om, on, aux, gofs; };
struct Gemm { const bf16_t* A; const bf16_t* Bt; int K; const int* gather; };

template <class Epi, class Sched, bool ALIGN_EPI, bool GATHER, bool FP8 = false>
__device__ __forceinline__ void gemm_phase(LAS unsigned char* lds, Gemm g, const Sched& S, const Epi& E) {
    int tid = threadIdx.x; asm volatile("" : "+v"(tid));
    asm volatile("" : "+s"(g.A), "+s"(g.Bt));
    const int wid = __builtin_amdgcn_readfirstlane(tid >> 6), lane = tid & 63, wr = wid >> 2, wc = wid & 3, fr = lane & 15, fq = lane >> 4;
    const int K = g.K, nt = K / BK;
    unsigned voffB[2];
#pragma unroll
    for (int i = 0; i < 2; ++i) { int Rr_, Cc_; stage_rc(tid * 16 + i * 8192, Rr_, Cc_); const int Rb = (Rr_ & ~31) + perm32(Rr_ & 31); voffB[i] = (unsigned)(Rb * K + Cc_) * 2u; }
    const size_t kstep = (size_t)(BK * 2);
    const size_t hstep = (size_t)HALF * K * 2;
    const size_t tstep = 2 * hstep;
    const unsigned ldsw = (unsigned)wid * 1024u;
    const int aoff = lds_byte(wr * 64 + fr, fq * 8), boff = lds_byte(wc * 32 + fr, fq * 8);
#define PG8_SA(b, h) (((b) * 2 + (h)) * HTB)
#define PG8_SB(b, h) ((4 + (b) * 2 + (h)) * HTB)
#define PG8_STAGE_B(bufoff, gbase) do { _Pragma("unroll") for (int _i = 0; _i < 2; ++_i) \
        __builtin_amdgcn_global_load_lds((const unsigned*)((const char*)(gbase) + voffB[_i]), (LAS unsigned*)(lds + (bufoff) + ldsw + _i * 8192), 16, 0, 0); } while (0)
#define PG8_STAGE_A(bufoff, kt, vo0, vo1) do { const char* _gb = (const char*)g.A + (size_t)(kt) * kstep; \
        __builtin_amdgcn_global_load_lds((const unsigned*)(_gb + (vo0)), (LAS unsigned*)(lds + (bufoff) + ldsw), 16, 0, 0); \
        __builtin_amdgcn_global_load_lds((const unsigned*)(_gb + (vo1)), (LAS unsigned*)(lds + (bufoff) + ldsw + 8192), 16, 0, 0); } while (0)
#define PG8_LDA(dst, b, h) do { _Pragma("unroll") for (int m = 0; m < 4; ++m) _Pragma("unroll") for (int k = 0; k < 2; ++k) dst[m][k] = *(const LAS bf16x8*)(lds + PG8_SA(b, h) + aoff + m * 2048 + k * 1024); } while (0)
#define PG8_LDB(dst, b, h) do { _Pragma("unroll") for (int n = 0; n < 2; ++n) _Pragma("unroll") for (int k = 0; k < 2; ++k) dst[n][k] = *(const LAS bf16x8*)(lds + PG8_SB(b, h) + boff + n * 2048 + k * 1024); } while (0)
#define PG8_MMA(ai, bj, At, Bt) do { __builtin_amdgcn_s_setprio(1); _Pragma("unroll") for (int m = 0; m < 4; ++m) _Pragma("unroll") for (int n = 0; n < 2; ++n) _Pragma("unroll") for (int k = 0; k < 2; ++k) \
        acc[ai][bj][m][n] = __builtin_amdgcn_mfma_f32_16x16x32_bf16(Bt[n][k], At[m][k], acc[ai][bj][m][n], 0, 0, 0); __builtin_amdgcn_s_setprio(0); } while (0)
#define PG8_MMA8(ai, bj, w) do { __builtin_amdgcn_s_setprio(1); _Pragma("unroll") for (int m = 0; m < 4; ++m) _Pragma("unroll") for (int n = 0; n < 2; ++n) \
        asm volatile("v_mfma_f32_16x16x128_f8f6f4 %0, %1, %2, %0" : "+v"(acc[ai][bj][m][n]) : "v"(B##w##8[n]), "v"(A8[m])); __builtin_amdgcn_s_setprio(0); } while (0)
#define PG8_LA(b, h) do { if constexpr (FP8) { _Pragma("unroll") for (int m = 0; m < 4; ++m) { A8[m].lo = *(const LAS i32x4*)(lds + PG8_SA(b, h) + aoff + m * 2048); A8[m].hi = *(const LAS i32x4*)(lds + PG8_SA(b, h) + aoff + m * 2048 + 1024); } } \
        else PG8_LDA(At, b, h); } while (0)
#define PG8_LB(w, b, h) do { if constexpr (FP8) { _Pragma("unroll") for (int n = 0; n < 2; ++n) { B##w##8[n].lo = *(const LAS i32x4*)(lds + PG8_SB(b, h) + boff + n * 2048); B##w##8[n].hi = *(const LAS i32x4*)(lds + PG8_SB(b, h) + boff + n * 2048 + 1024); } } \
        else PG8_LDB(B##w, b, h); } while (0)
#define PG8_MM(ai, bj, w) do { if constexpr (FP8) PG8_MMA8(ai, bj, w); else PG8_MMA(ai, bj, At, B##w); } while (0)
#define PG8_WAIT_V(n) asm volatile("s_waitcnt vmcnt(" #n ")" ::: "memory")
#define PG8_WAIT_L(n) asm volatile("s_waitcnt lgkmcnt(" #n ")" ::: "memory")
#define PG8_BAR __builtin_amdgcn_s_barrier()
#define PG8_SCHED __builtin_amdgcn_sched_barrier(0)
#define PG8_VOFF(dst, u) do { _Pragma("unroll") for (int _h = 0; _h < 2; ++_h) _Pragma("unroll") for (int _i = 0; _i < 2; ++_i) { int Rr_, Cc_; stage_rc(tid * 16 + _i * 8192, Rr_, Cc_); \
        const int _rt = (u).pm * BM + _h * HALF + Rr_; const int _ar = GATHER ? g.gather[_rt + (u).gofs] : _rt; dst[_h][_i] = (unsigned)((size_t)_ar * K + Cc_) * 2u; } } while (0)
    Unit cur, nxt; int ui = 0;
    if (!S.next(0, cur)) return;
    f32x4 acc[2][2][4][2];
#pragma unroll
    for (int a = 0; a < 2; ++a)
#pragma unroll
        for (int b = 0; b < 2; ++b)
#pragma unroll
            for (int m = 0; m < 4; ++m)
#pragma unroll
                for (int n = 0; n < 2; ++n) acc[a][b][m][n] = (f32x4){0.f, 0.f, 0.f, 0.f};
    bf16x8 At[4][2], B0[2][2], B1[2][2];
    i32x8 A8[4], B08[2], B18[2];
    unsigned vC[2][2], vN[2][2];
    PG8_VOFF(vC, cur);
    const char* cB = (const char*)g.Bt + (size_t)cur.pn * tstep;
    PG8_STAGE_B(PG8_SB(0, 0), cB); PG8_STAGE_B(PG8_SB(0, 1), cB + hstep); PG8_STAGE_A(PG8_SA(0, 0), 0, vC[0][0], vC[0][1]); PG8_STAGE_A(PG8_SA(0, 1), 0, vC[1][0], vC[1][1]);
    if (wr == 1) PG8_BAR;
    PG8_WAIT_V(2); PG8_BAR;
    PG8_STAGE_B(PG8_SB(1, 0), cB + kstep); PG8_STAGE_A(PG8_SA(1, 0), 1, vC[0][0], vC[0][1]); PG8_STAGE_B(PG8_SB(1, 1), cB + hstep + kstep);
    PG8_WAIT_V(6); PG8_BAR;
    for (;;) {
        const bool has_next = S.next(ui + 1, nxt);
        unsigned ndelta = 0u;
        if constexpr (GATHER) {
            if (has_next) { PG8_VOFF(vN, nxt); } else {
#pragma unroll
                for (int _h = 0; _h < 2; ++_h)
#pragma unroll
                    for (int _i = 0; _i < 2; ++_i) vN[_h][_i] = vC[_h][_i]; }
        } else { if (has_next) ndelta = (unsigned)((nxt.pm - cur.pm) * (int)tstep); }
        const char* nB = has_next ? (const char*)g.Bt + (size_t)nxt.pn * tstep : cB;
#pragma unroll 1
        for (int t = 0; t < nt; t += 2) {
            const bool last = (t == nt - 2);
            const int k2 = last ? 0 : t + 2, k3 = k2 + 1;
            const char* b2 = last ? nB : cB + (size_t)(t + 2) * kstep; const char* b3 = b2 + kstep;
            unsigned v200, v201, v210, v211;
            if constexpr (GATHER) { v200 = last ? vN[0][0] : vC[0][0]; v201 = last ? vN[0][1] : vC[0][1]; v210 = last ? vN[1][0] : vC[1][0]; v211 = last ? vN[1][1] : vC[1][1]; }
            else { const unsigned dl = last ? ndelta : 0u; v200 = vC[0][0] + dl; v201 = vC[0][1] + dl; v210 = vC[1][0] + dl; v211 = vC[1][1] + dl; }
            PG8_LB(0, 0, 0); PG8_LB(1, 0, 1); PG8_SCHED; PG8_LA(0, 0); PG8_STAGE_A(PG8_SA(1, 1), t + 1, vC[1][0], vC[1][1]);
            PG8_WAIT_V(8); PG8_WAIT_L(0); PG8_BAR; PG8_MM(0, 0, 0); PG8_MM(0, 1, 1); PG8_BAR; PG8_SCHED;
            PG8_LA(0, 1); PG8_STAGE_B(PG8_SB(0, 0), b2); PG8_STAGE_B(PG8_SB(0, 1), b2 + hstep); PG8_STAGE_A(PG8_SA(0, 0), k2, v200, v201);
            PG8_WAIT_V(8); PG8_WAIT_L(0); PG8_BAR; PG8_MM(1, 0, 0); PG8_MM(1, 1, 1); PG8_BAR; PG8_SCHED;
            PG8_LB(0, 1, 0); PG8_LB(1, 1, 1); PG8_SCHED; PG8_LA(1, 0); PG8_STAGE_A(PG8_SA(0, 1), k2, v210, v211);
            PG8_WAIT_V(8); PG8_WAIT_L(0); PG8_BAR; PG8_MM(0, 0, 0); PG8_MM(0, 1, 1); PG8_BAR; PG8_SCHED;
            PG8_LA(1, 1); PG8_STAGE_B(PG8_SB(1, 0), b3); PG8_STAGE_B(PG8_SB(1, 1), b3 + hstep); PG8_STAGE_A(PG8_SA(1, 0), k3, v200, v201);
            PG8_WAIT_V(8); PG8_WAIT_L(0); PG8_BAR; PG8_MM(1, 0, 0); PG8_MM(1, 1, 1); PG8_BAR; PG8_SCHED;
        }
        if constexpr (ALIGN_EPI) { if (wr == 0) PG8_BAR; }
        if constexpr (FP8) asm volatile("s_nop 15\n\ts_nop 15" ::: "memory");
        { int fr_ = fr, fq_ = fq; asm volatile("" : "+v"(fr_), "+v"(fq_)); E(acc, cur, wr, wc, fr_, fq_); }
        if (!has_next) break;
#pragma unroll
        for (int a = 0; a < 2; ++a)
#pragma unroll
            for (int b = 0; b < 2; ++b)
#pragma unroll
                for (int m = 0; m < 4; ++m)
#pragma unroll
                    for (int n = 0; n < 2; ++n) acc[a][b][m][n] = (f32x4){0.f, 0.f, 0.f, 0.f};
        cur = nxt; cB = nB; ++ui;
#pragma unroll
        for (int _h = 0; _h < 2; ++_h)
#pragma unroll
            for (int _i = 0; _i < 2; ++_i) { if constexpr (GATHER) vC[_h][_i] = vN[_h][_i]; else vC[_h][_i] += ndelta; }
        if constexpr (ALIGN_EPI) { if (wr == 1) PG8_BAR; }
    }
    PG8_WAIT_V(0);
    if constexpr (!ALIGN_EPI) { if (wr == 0) PG8_BAR; }
    PG8_BAR;
#undef PG8_SA
#undef PG8_SB
#undef PG8_STAGE_A
#undef PG8_STAGE_B
#undef PG8_LDA
#undef PG8_LDB
#undef PG8_MMA
#undef PG8_MMA8
#undef PG8_MM
#undef PG8_LA
#undef PG8_LB
#undef PG8_WAIT_V
#undef PG8_WAIT_L
#undef PG8_BAR
#undef PG8_SCHED
#undef PG8_VOFF
}

constexpr int NXCD = 8, WGM = 8;
struct StaticOrder {
    int nM, nN, nwg, G, c;
    __device__ void init(int nM_, int nN_, int G_, int c_) { nM = nM_; nN = nN_; nwg = nM * nN; G = G_; c = c_; }
    __device__ bool next(int i, Unit& u) const {
        const long L = (long)i * G + c; if (L >= nwg) return false;
        int wgid = (int)L; { const int q = nwg / NXCD, r = nwg % NXCD, xcd = wgid % NXCD, off = wgid / NXCD; wgid = (xcd < r ? xcd * (q + 1) : r * (q + 1) + (xcd - r) * q) + off; }
        const int nig = WGM * nN, gid = wgid / nig, fm = gid * WGM, gsz = (nM - fm) < WGM ? (nM - fm) : WGM;
        u.pm = fm + ((wgid % nig) % gsz); u.pn = (wgid % nig) / gsz; u.om = u.pm; u.on = u.pn; u.aux = 0; return true;
    }
};
struct MergeOrder {
    int G, c;
    __device__ bool next(int i, Unit& u) const {
        const int n = i & 3; const long tile = (long)(i >> 2) * G + c; if (tile >= 256) return false;
        const int om = (int)tile >> 2, on = (int)tile & 3;
        u.pm = n * 64 + om; u.pn = n * 4 + on; u.om = om; u.on = on; u.aux = n; return true;
    }
};
struct MoeOrder {
    int ntiles, nN, nwg, G, c; int pend[NEXP];
    __device__ void init(const unsigned* cnt, int nN_, int G_, int c_) {
        int acc = 0;
#pragma unroll
        for (int e = 0; e < NEXP; ++e) { const int ce = (int)cnt[64 * e]; acc += (ce + 255) >> 8; pend[e] = acc; }
        ntiles = acc; nN = nN_; nwg = ntiles * nN; G = G_; c = c_;
    }
    __device__ bool next(int i, Unit& u) const {
        const long L = (long)i * G + c; if (L >= nwg) return false;
        const int wgid = (int)L;
        const int nig = WGM * nN, gid = wgid / nig, fm = gid * WGM, gsz = (ntiles - fm) < WGM ? (ntiles - fm) : WGM;
        const int pm = fm + ((wgid % nig) % gsz), pn = (wgid % nig) / gsz;
        int e = 0, ps = 0;
#pragma unroll
        for (int j = 0; j < NEXP - 1; ++j) if (pm >= pend[j]) { e = j + 1; ps = pend[j]; }
        u.pm = pm; u.pn = e * nN + pn; u.om = pm; u.on = pn; u.aux = e; u.gofs = e * 16384 - 256 * ps; return true;
    }
};

__device__ __forceinline__ u32x4 pack8(f32x4 a, f32x4 b) { u32x4 w; w.x = cvt_pk_bf16(a[0], a[1]); w.y = cvt_pk_bf16(a[2], a[3]); w.z = cvt_pk_bf16(b[0], b[1]); w.w = cvt_pk_bf16(b[2], b[3]); return w; }
struct EpiIn {
    bf16_t* Zs; bf16_t* Zg; const float* rowss; const float* bgate;
    __device__ __forceinline__ void operator()(const f32x4 (&acc)[2][2][4][2], const Unit& u, int wr, int wc, int fr, int fq) const {
        const int row0 = u.om * BM + wr * 64 + fr, colt = u.on * BM, cw = wc * 32 + 8 * fq;
        if (colt < ZSW) {
#pragma unroll
            for (int ai = 0; ai < 2; ++ai) { float rsd[4];
#pragma unroll
                for (int m = 0; m < 4; ++m) rsd[m] = row_rstd(rowss, row0 + ai * HALF + m * 16);
#pragma unroll
                for (int m = 0; m < 4; ++m) {
                    const int row = row0 + ai * HALF + m * 16; const float rstd = rsd[m];
#pragma unroll
                    for (int bj = 0; bj < 2; ++bj) *(u32x4*)(Zs + (size_t)row * ZSW + colt + bj * HALF + cw) = pack8(acc[ai][bj][m][0] * rstd, acc[ai][bj][m][1] * rstd);
                    if (m == 3) asm volatile("" ::: "memory");
                } }
        } else {
            const int gc0 = colt - ZSW + cw;
            const f32x4 b00 = *(const f32x4*)(bgate + gc0), b01 = *(const f32x4*)(bgate + gc0 + 4), b10 = *(const f32x4*)(bgate + gc0 + HALF), b11 = *(const f32x4*)(bgate + gc0 + HALF + 4);
#pragma unroll
            for (int ai = 0; ai < 2; ++ai) { float rsd[4];
#pragma unroll
                for (int m = 0; m < 4; ++m) rsd[m] = row_rstd(rowss, row0 + ai * HALF + m * 16);
#pragma unroll
                for (int m = 0; m < 4; ++m) {
                    const int row = row0 + ai * HALF + m * 16; const float rstd = rsd[m];
#pragma unroll
                    for (int bj = 0; bj < 2; ++bj) { f32x4 v0 = acc[ai][bj][m][0] * rstd + (bj ? b10 : b00), v1 = acc[ai][bj][m][1] * rstd + (bj ? b11 : b01);
                        *(u32x4*)(Zg + (size_t)row * ZGW + gc0 + bj * HALF) = pack8(v0, v1); }
                    if (m == 3) asm volatile("" ::: "memory");
                } }
        }
    }
};
struct EpiMerge {
    bf16_t* Mg; const bf16_t* Zg;
    __device__ __forceinline__ void operator()(const f32x4 (&acc)[2][2][4][2], const Unit& u, int wr, int wc, int fr, int fq) const {
        const int row0 = u.om * BM + wr * 64 + fr, colt = u.on * BM, cw = wc * 32 + 8 * fq, n = u.aux;
#pragma unroll
        for (int ai = 0; ai < 2; ++ai) {
            u32x4 gw[4][2], ow[4][2];
#pragma unroll
            for (int m = 0; m < 4; ++m)
#pragma unroll
                for (int bj = 0; bj < 2; ++bj) { const int row = row0 + ai * HALF + m * 16, col = colt + bj * HALF + cw;
                    gw[m][bj] = *(const u32x4*)(Zg + (size_t)row * ZGW + DBG_GPERM(n) * DM + col);
                    ow[m][bj] = n > 0 ? *(const u32x4*)(Mg + (size_t)row * DM + col) : (u32x4){0u, 0u, 0u, 0u}; }
#pragma unroll
            for (int m = 0; m < 4; ++m)
#pragma unroll
                for (int bj = 0; bj < 2; ++bj) { const int row = row0 + ai * HALF + m * 16, col = colt + bj * HALF + cw; const u32x4 g = gw[m][bj], o = ow[m][bj];
                    f32x4 v0 = acc[ai][bj][m][0], v1 = acc[ai][bj][m][1];
                    v0[0] = v0[0] * fsigmoid(bflo(g.x)) + bflo(o.x); v0[1] = v0[1] * fsigmoid(bfhi(g.x)) + bfhi(o.x); v0[2] = v0[2] * fsigmoid(bflo(g.y)) + bflo(o.y); v0[3] = v0[3] * fsigmoid(bfhi(g.y)) + bfhi(o.y);
                    v1[0] = v1[0] * fsigmoid(bflo(g.z)) + bflo(o.z); v1[1] = v1[1] * fsigmoid(bfhi(g.z)) + bfhi(o.z); v1[2] = v1[2] * fsigmoid(bflo(g.w)) + bflo(o.w); v1[3] = v1[3] * fsigmoid(bfhi(g.w)) + bfhi(o.w);
                    *(u32x4*)(Mg + (size_t)row * DM + col) = pack8(v0, v1); }
            asm volatile("" ::: "memory");
        }
    }
};
template <bool F32OUT, bool X8 = false, bool SC32 = false> struct EpiRes {
    float* xout; bf16_t* xb; float* rowss; unsigned char* x8;
    __device__ __forceinline__ void operator()(const f32x4 (&acc)[2][2][4][2], const Unit& u, int wr, int wc, int fr, int fq) const {
        const int row0 = u.om * BM + wr * 64 + fr, colt = u.on * BM, cw = wc * 32 + 8 * fq;
#pragma unroll
        for (int ai = 0; ai < 2; ++ai) {
            u32x4 xw[4][2];
#pragma unroll
            for (int m = 0; m < 4; ++m)
#pragma unroll
                for (int bj = 0; bj < 2; ++bj) xw[m][bj] = *(const u32x4*)(xb + (size_t)(row0 + ai * HALF + m * 16) * DM + colt + bj * HALF + cw);
#pragma unroll
            for (int m = 0; m < 4; ++m) {
                const int row = row0 + ai * HALF + m * 16; float ss = 0.f;
#pragma unroll
                for (int bj = 0; bj < 2; ++bj) { const size_t off = (size_t)row * DM + colt + bj * HALF + cw; const u32x4 w = xw[m][bj];
                    f32x4 v0 = acc[ai][bj][m][0], v1 = acc[ai][bj][m][1];
                    if constexpr (SC32) { v0 *= 0.03125f; v1 *= 0.03125f; }
                    v0[0] += bflo(w.x); v0[1] += bfhi(w.x); v0[2] += bflo(w.y); v0[3] += bfhi(w.y); v1[0] += bflo(w.z); v1[1] += bfhi(w.z); v1[2] += bflo(w.w); v1[3] += bfhi(w.w);
                    if constexpr (F32OUT) { *(f32x4*)(xout + off) = v0; *(f32x4*)(xout + off + 4) = v1; }
                    *(u32x4*)(xb + off) = pack8(v0, v1);
                    if constexpr (X8) { u32x2 q; q.x = cvt_pk4_fp8(v0[0], v0[1], v0[2], v0[3]); q.y = cvt_pk4_fp8(v1[0], v1[1], v1[2], v1[3]); *(u32x2*)(x8 + off) = q; }
                    ss += (v0[0] * v0[0] + v0[1] * v0[1]) + (v0[2] * v0[2] + v0[3] * v0[3]) + (v1[0] * v1[0] + v1[1] * v1[1]) + (v1[2] * v1[2] + v1[3] * v1[3]); }
                ss += __shfl_xor(ss, 16); ss += __shfl_xor(ss, 32);
                if (fq == 0) rowss[(size_t)row * 16 + u.on * 4 + wc] = ss;
            }
            asm volatile("" ::: "memory");
        }
    }
};
struct EpiRowScale {
    bf16_t* O; int ldc; const float* rowss;
    __device__ __forceinline__ void operator()(const f32x4 (&acc)[2][2][4][2], const Unit& u, int wr, int wc, int fr, int fq) const {
        const int row0 = u.om * BM + wr * 64 + fr, colt = u.on * BM, cw = wc * 32 + 8 * fq;
#pragma unroll
        for (int ai = 0; ai < 2; ++ai)
#pragma unroll
            for (int m = 0; m < 4; ++m) {
                const int row = row0 + ai * HALF + m * 16; const float rstd = row_rstd(rowss, row);
#pragma unroll
                for (int bj = 0; bj < 2; ++bj) *(u32x4*)(O + (size_t)row * ldc + colt + bj * HALF + cw) = pack8(acc[ai][bj][m][0] * rstd, acc[ai][bj][m][1] * rstd);
                if (m == 3) asm volatile("" ::: "memory");
            }
    }
};
template <bool MOE> struct EpiSwiGLU {
    bf16_t* H; int ldh; const float* rs; const int* row_tok;
    __device__ __forceinline__ void operator()(const f32x4 (&acc)[2][2][4][2], const Unit& u, int wr, int wc, int fr, int fq) const {
        const int row0 = u.om * BM + wr * 64 + fr, hc = u.on * HALF + wc * 32 + 8 * fq;
#pragma unroll
        for (int ai = 0; ai < 2; ++ai) { float rsd[4];
#pragma unroll
            for (int m = 0; m < 4; ++m) { const int row = row0 + ai * HALF + m * 16; rsd[m] = MOE ? rs[row_tok[row]] : row_rstd(rs, row); }
#pragma unroll
            for (int m = 0; m < 4; ++m) {
                const int row = row0 + ai * HALF + m * 16;
                const float rstd = rsd[m];
                f32x4 o[2];
#pragma unroll
                for (int n = 0; n < 2; ++n)
#pragma unroll
                    for (int j = 0; j < 4; ++j) { const float gv = acc[ai][0][m][n][j] * rstd, uv = acc[ai][1][m][n][j] * rstd; o[n][j] = gv * fsigmoid(gv) * uv; }
                *(u32x4*)(H + (size_t)row * ldh + hc) = pack8(o[0], o[1]);
                if (m == 3) asm volatile("" ::: "memory");
            } }
    }
};
template <bool RSTD, bool W32 = true> struct EpiSwiGLU8 {
    unsigned char* H; int ldh; const float* rs;
    __device__ __forceinline__ void operator()(const f32x4 (&acc)[2][2][4][2], const Unit& u, int wr, int wc, int fr, int fq) const {
        const int row0 = u.om * BM + wr * 64 + fr, hc = u.on * HALF + wc * 32 + 8 * fq;
#pragma unroll
        for (int ai = 0; ai < 2; ++ai)
#pragma unroll
            for (int m = 0; m < 4; ++m) {
                const int row = row0 + ai * HALF + m * 16;
                float sc = W32 ? 0.03125f : 1.f; if constexpr (RSTD) sc *= row_rstd(rs, row);
                f32x4 o[2];
#pragma unroll
                for (int n = 0; n < 2; ++n)
#pragma unroll
                    for (int j = 0; j < 4; ++j) { const float gv = acc[ai][0][m][n][j] * sc, uv = acc[ai][1][m][n][j] * sc; o[n][j] = gv * fsigmoid(gv) * uv; }
                u32x2 w; w.x = cvt_pk4_fp8(o[0][0], o[0][1], o[0][2], o[0][3]); w.y = cvt_pk4_fp8(o[1][0], o[1][1], o[1][2], o[1][3]);
                *(u32x2*)(H + (size_t)row * ldh + hc) = w;
                if (m == 3) asm volatile("" ::: "memory");
            }
    }
};
struct EpiPlain {
    bf16_t* O; int ldc; float sc;
    __device__ __forceinline__ void operator()(const f32x4 (&acc)[2][2][4][2], const Unit& u, int wr, int wc, int fr, int fq) const {
        const int row0 = u.om * BM + wr * 64 + fr, colt = u.on * BM, cw = wc * 32 + 8 * fq;
#pragma unroll
        for (int ai = 0; ai < 2; ++ai)
#pragma unroll
            for (int m = 0; m < 4; ++m) { const int row = row0 + ai * HALF + m * 16;
#pragma unroll
                for (int bj = 0; bj < 2; ++bj) *(u32x4*)(O + (size_t)row * ldc + colt + bj * HALF + cw) = pack8(acc[ai][bj][m][0] * sc, acc[ai][bj][m][1] * sc); }
    }
};
}

#define XB_TMO      128
#define XB_XCNT(j)  (256  + 64 * (j))
#define XB_XSUB(j)  (1280 + 64 * (j))
#define XB_XGEN(j)  (2304 + 64 * (j))
#define XB_TOP      3328
#define XB_TOPGEN   3392
#define XCD_BAR_WORDS 3456
#define XB_SPIN_CAP (1u << 18)
__device__ __forceinline__ unsigned xb_ld(unsigned* p)              { return __hip_atomic_load(p, __ATOMIC_RELAXED, __HIP_MEMORY_SCOPE_AGENT); }
__device__ __forceinline__ unsigned xb_add(unsigned* p, unsigned v) { return __hip_atomic_fetch_add(p, v, __ATOMIC_RELAXED, __HIP_MEMORY_SCOPE_AGENT); }
__device__ __forceinline__ unsigned xb_xcc_id() { return (unsigned)__builtin_amdgcn_s_getreg((3 << 11) | 20) & 0xFu; }
#define XB_SPIN(cond, bar) do { unsigned _sp = 0; while (cond) { __builtin_amdgcn_s_sleep(1); \
    if ((++_sp & 255u) == 0u) { if (xb_ld(&(bar)[XB_TMO])) break; if (_sp > XB_SPIN_CAP) { atomicAdd(&(bar)[XB_TMO], 1u); break; } } } } while (0)
struct XcdBarrier { unsigned* bar; unsigned x; volatile LAS unsigned* st; };
__device__ __forceinline__ XcdBarrier xcd_barrier_post(unsigned* bar, volatile LAS unsigned* st) {
    XcdBarrier b; b.bar = bar; b.x = xb_xcc_id(); b.st = st;
    if (threadIdx.x == 0) (void)xb_add(&bar[XB_XCNT(b.x)], 1u);
    return b;
}
__device__ __forceinline__ void xcd_barrier_complete(unsigned* bar, unsigned x, unsigned& nloc, unsigned& nx) {
    const unsigned G = gridDim.x * gridDim.y * gridDim.z;
    unsigned sum, cnt, mine, sp = 0u;
    for (;;) {
        sum = 0u; cnt = 0u; mine = 0u;
#pragma unroll
        for (unsigned j = 0; j < 16; ++j) { const unsigned c = xb_ld(&bar[XB_XCNT(j)]); sum += c; cnt += (c > 0u) ? 1u : 0u; mine = (j == x) ? c : mine; }
        if (sum == G) break;
        __builtin_amdgcn_s_sleep(1);
        if ((++sp & 255u) == 0u) { if (xb_ld(&bar[XB_TMO])) break; if (sp > XB_SPIN_CAP) { atomicAdd(&bar[XB_TMO], 1u); break; } }
    }
    nloc = mine > 0u ? mine : 1u; nx = cnt > 0u ? cnt : 1u;
}
__device__ __forceinline__ void xcd_barrier(const XcdBarrier& b) {
    asm volatile("s_waitcnt vmcnt(0)" ::: "memory");
    __syncthreads();
    if (threadIdx.x == 0) {
        unsigned* bar = b.bar;
        __builtin_amdgcn_s_waitcnt(0);
        unsigned nloc = b.st[0], nx = b.st[1];
        if (nloc == 0u) { xcd_barrier_complete(bar, b.x, nloc, nx); b.st[0] = nloc; b.st[1] = nx; }
        const unsigned old = xb_add(&bar[XB_XSUB(b.x)], 1u);
        const unsigned gen = old / nloc;
        if (old + 1u == (gen + 1u) * nloc) {
            __builtin_amdgcn_fence(__ATOMIC_RELEASE, "agent");
            asm volatile("s_waitcnt vmcnt(0)" ::: "memory");
            const unsigned og = xb_add(&bar[XB_TOP], 1u);
            const unsigned tg = og / nx;
            if (og + 1u == (tg + 1u) * nx) xb_add(&bar[XB_TOPGEN], 1u);
            else XB_SPIN(xb_ld(&bar[XB_TOPGEN]) == tg, bar);
            __builtin_amdgcn_fence(__ATOMIC_ACQUIRE, "agent");
            xb_add(&bar[XB_XGEN(b.x)], 1u);
            asm volatile("s_waitcnt vmcnt(0)" ::: "memory");
        } else {
            XB_SPIN(xb_ld(&bar[XB_XGEN(b.x)]) == gen, bar);
            __builtin_amdgcn_fence(__ATOMIC_ACQUIRE, "agent");
            asm volatile("s_waitcnt vmcnt(0)" ::: "memory");
        }
    }
    __syncthreads();
}

struct Args { const void* in[55]; float* out; unsigned char* ws; int ph_lo, ph_hi, submask, pad; };
struct Frame {
    LAS unsigned char* lds; unsigned char* ws; unsigned* ctl; float* out;
    int tid, lane, wave, G, bid, gw, ngw;
};
#define GAS __attribute__((address_space(1)))
#define CAS __attribute__((address_space(4)))
#define PHASE_BEGIN() const CAS char* kp_ = (const CAS char*)__builtin_amdgcn_kernarg_segment_ptr(); asm volatile("" : "+s"(kp_)); \
    unsigned char* ws = (unsigned char*)(GAS unsigned char*)(*(const CAS unsigned long long*)(kp_ + 448)); \
    Frame F; { int t_ = threadIdx.x; asm volatile("" : "+v"(t_)); int b_ = blockIdx.x; asm volatile("" : "+s"(b_)); \
      F.lds = (LAS unsigned char*)lds_raw; F.ws = ws; F.ctl = (unsigned*)(ws + WS_CTL); F.out = (float*)(GAS float*)(*(const CAS unsigned long long*)(kp_ + 440)); \
      F.tid = t_; F.lane = t_ & 63; F.wave = __builtin_amdgcn_readfirstlane(t_ >> 6); F.G = gridDim.x; F.bid = b_; F.gw = b_ * 8 + F.wave; F.ngw = F.G * 8; }
#define XB ((bf16_t*)(ws + WS_XB))
#define RS ((float*)(ws + WS_RSP))
#define ZS ((bf16_t*)(ws + WS_ZS))
#define ZG ((bf16_t*)(ws + WS_ZG))
#define YB ((bf16_t*)(ws + WS_Y))
#define MG ((bf16_t*)(ws + WS_MERGED))
#define S5T ((float*)(ws + WS_TAB + TAB_S5T))
#define CMAT ((bf16_t*)(ws + WS_TAB + TAB_CMAT))
#define MISCT ((float*)(ws + WS_TAB + TAB_MISC))
#define BBF ((bf16_t*)(ws + WS_TAB + 832 * 1024))
#define WLP(l) (ws + WS_WL + (size_t)(l) * WL_STRIDE)
#define INF(i) ((const float*)(const GAS float*)(*(const CAS unsigned long long*)(kp_ + 8 * (i))))

struct TJob { const float* W; bf16_t* WT; const float* ks; int K, N, ldw, ldk, nb, map; size_t sstride, dstride; int f8; };
__device__ __forceinline__ int tjob_items(const TJob& j) { return j.nb * (j.K / 64) * (j.N / 32); }
__device__ __forceinline__ void tjob_load(const TJob& j, int item, float (&v)[32], int lane) {
    const int per = (j.K / 64) * (j.N / 32), b = item / per, r = item % per, nblk = j.N / 32, kb = r / nblk, nbk = r % nblk, k0 = 64 * kb, n0 = 32 * nbk;
    const float* W = j.W + (size_t)b * j.sstride + (size_t)(k0 + (lane >> 5)) * j.ldw + n0 + (lane & 31);
#pragma unroll
    for (int i = 0; i < 32; ++i) v[i] = __builtin_nontemporal_load(W + (size_t)(2 * i) * j.ldw);
}
__device__ __forceinline__ void tjob_store(const TJob& j, int item, float (&v)[32], LAS float* scr, int lane) {
    const int per = (j.K / 64) * (j.N / 32), b = item / per, r = item % per, nblk = j.N / 32, kb = r / nblk, nbk = r % nblk, k0 = 64 * kb, n0 = 32 * nbk;
    int drow = n0;
    if (j.map == 1) drow = n0 < C_END ? n0 : n0 + (ZSW - C_END);
    else if (j.map == 2) drow = 256 * (n0 >> 7) + (n0 & 127);
    else if (j.map == 3) drow = 256 * (n0 >> 7) + 128 + (n0 & 127);
    if (j.ks) {
#pragma unroll
        for (int i = 0; i < 32; ++i) v[i] *= j.ks[k0 + 2 * i + (lane >> 5)]; }
#pragma unroll
    for (int i = 0; i < 32; ++i) scr[(2 * i + (lane >> 5)) * 33 + (lane & 31)] = v[i];
    asm volatile("s_waitcnt lgkmcnt(0)" ::: "memory");
    const int c = lane & 7; bf16_t* WT = j.WT + (size_t)b * j.dstride;
    if (j.f8) { unsigned char* W8 = (unsigned char*)j.WT + (size_t)b * j.dstride;
#pragma unroll
        for (int q = 0; q < 4; ++q) { const int n = (lane >> 3) + 8 * q; const LAS float* sp = scr + (8 * c) * 33 + n;
            u32x2 o; o.x = cvt_pk4_fp8(sp[0 * 33] * 32.f, sp[1 * 33] * 32.f, sp[2 * 33] * 32.f, sp[3 * 33] * 32.f); o.y = cvt_pk4_fp8(sp[4 * 33] * 32.f, sp[5 * 33] * 32.f, sp[6 * 33] * 32.f, sp[7 * 33] * 32.f);
            *(u32x2*)(W8 + (size_t)(drow + n) * j.ldk + k0 + 8 * c) = o; }
    } else
#pragma unroll
    for (int q = 0; q < 4; ++q) { const int n = (lane >> 3) + 8 * q; const LAS float* sp = scr + (8 * c) * 33 + n;
        u32x4 o; o.x = cvt_pk_bf16(sp[0 * 33], sp[1 * 33]); o.y = cvt_pk_bf16(sp[2 * 33], sp[3 * 33]); o.z = cvt_pk_bf16(sp[4 * 33], sp[5 * 33]); o.w = cvt_pk_bf16(sp[6 * 33], sp[7 * 33]);
        *(u32x4*)(WT + (size_t)(drow + n) * j.ldk + k0 + 8 * c) = o; }
    asm volatile("s_waitcnt lgkmcnt(0)" ::: "memory");
}
__device__ __forceinline__ void tjob_run_all(const TJob& j, int first, int stride, LAS float* scr, int lane) {
    const int ni = tjob_items(j); int it = first; if (it >= ni) return;
    float va[32], vb[32]; tjob_load(j, it, va, lane);
    for (;;) {
        const int n1 = it + stride; if (n1 < ni) tjob_load(j, n1, vb, lane);
        tjob_store(j, it, va, scr, lane); if (n1 >= ni) break;
        const int n2 = n1 + stride; if (n2 < ni) tjob_load(j, n2, va, lane);
        tjob_store(j, n1, vb, scr, lane); if (n2 >= ni) break;
        it = n2;
    }
}

template <int DQ> struct AttnLds { static constexpr int KROW = DQ * 2 + 16, VROW = 272, KBYTES = 128 * KROW, VBYTES = 64 * VROW, BUF = KBYTES + VBYTES; };
#define PK4(P, BASE, OUT) do { unsigned a0_ = cvt_pk_bf16(P[BASE + 0], P[BASE + 1]), a1_ = cvt_pk_bf16(P[BASE + 2], P[BASE + 3]); \
    unsigned b0_ = cvt_pk_bf16(P[BASE + 4], P[BASE + 5]), b1_ = cvt_pk_bf16(P[BASE + 6], P[BASE + 7]); \
    auto r0_ = __builtin_amdgcn_permlane32_swap(a0_, b0_, false, false); auto r1_ = __builtin_amdgcn_permlane32_swap(a1_, b1_, false, false); \
    u32x4 w_ = {r0_[0], r1_[0], r0_[1], r1_[1]}; OUT = *(bf16x8*)&w_; } while (0)

template <int DQ, int NMAP, bool CAUSAL, bool BIAS, bool QNORM>
__device__ __forceinline__ void attn_unit(LAS unsigned char* lds, const bf16_t* Qp, int ldq, const bf16_t* Kp, const bf16_t* Vtp, int vstride, int nkt, int q0,
                                          const LAS float* lut, const float* qg, float qscale, float mshift, f32x16 (&o)[NMAP][2], float (&l)[NMAP]) {
    typedef AttnLds<DQ> L; constexpr int KD = DQ / NMAP, KS = KD / 16, KCH = DQ / 8, NKC = 64 * KCH;
    int tid = threadIdx.x; asm volatile("" : "+v"(tid));
    const int wid = tid >> 6, lane = tid & 63, r32 = lane & 31, hi = lane >> 5;
    bf16x8 q[NMAP][KS];
    {
        const bf16_t* qrow = Qp + (size_t)(wid * 32 + r32) * ldq + hi * 8;
#pragma unroll
        for (int mp = 0; mp < NMAP; ++mp)
#pragma unroll
            for (int ks = 0; ks < KS; ++ks) q[mp][ks] = ldg8(qrow + mp * KD + ks * 16);
        if constexpr (QNORM) {
            float ss = 0.f;
#pragma unroll
            for (int ks = 0; ks < KS; ++ks) ss += sq8(q[0][ks]);
            ss += __shfl_xor(ss, 32);
            const float rs = frsq(ss * (1.f / DQ) + EPS) * qscale;
#pragma unroll
            for (int ks = 0; ks < KS; ++ks) { u32x4 w = *(u32x4*)&q[0][ks]; const float* gp = qg + ks * 16 + hi * 8;
                w.x = cvt_pk_bf16(bflo(w.x) * rs * gp[0], bfhi(w.x) * rs * gp[1]); w.y = cvt_pk_bf16(bflo(w.y) * rs * gp[2], bfhi(w.y) * rs * gp[3]);
                w.z = cvt_pk_bf16(bflo(w.z) * rs * gp[4], bfhi(w.z) * rs * gp[5]); w.w = cvt_pk_bf16(bflo(w.w) * rs * gp[6], bfhi(w.w) * rs * gp[7]);
                q[0][ks] = *(bf16x8*)&w; }
        }
    }
#pragma unroll
    for (int mp = 0; mp < NMAP; ++mp) { l[mp] = 0.f; o[mp][0] = f32x16{}; o[mp][1] = f32x16{}; }
    constexpr int NKI = (128 * KCH) / 512;
    bf16x8 skr[NKI], svr[2];
#define AT_LOAD(j) do { const int key0_ = (j) * 128; \
        _Pragma("unroll") for (int i_ = 0; i_ < NKI; ++i_) { const int c_ = tid + 512 * i_; skr[i_] = ldg8(Kp + (size_t)(key0_ + c_ / KCH) * DQ + (c_ % KCH) * 8); } \
        _Pragma("unroll") for (int i_ = 0; i_ < 2; ++i_) { const int c_ = tid + 512 * i_; svr[i_] = ldg8(Vtp + (size_t)(c_ >> 4) * vstride + key0_ + (c_ & 15) * 8); } } while (0)
#define AT_WRITE(b) do { LAS unsigned char* base_ = lds + (b) * L::BUF; \
        _Pragma("unroll") for (int i_ = 0; i_ < NKI; ++i_) { const int c_ = tid + 512 * i_; *(LAS bf16x8*)(base_ + (c_ / KCH) * L::KROW + (c_ % KCH) * 16) = skr[i_]; } \
        _Pragma("unroll") for (int i_ = 0; i_ < 2; ++i_) { const int c_ = tid + 512 * i_; *(LAS bf16x8*)(base_ + L::KBYTES + (c_ >> 4) * L::VROW + (c_ & 15) * 16) = svr[i_]; } } while (0)
    const int qi = q0 + wid * 32 + r32;
    const int qlo = q0 + wid * 32;
#define AT_COMPUTE(key0, bf, sb) do { const bool active = !CAUSAL || (key0) <= qlo + 31; \
        if (active) { const LAS unsigned char* kb = lds + (bf) * L::BUF + (sb) * 64 * L::KROW; const LAS unsigned char* vb = lds + (bf) * L::BUF + L::KBYTES + (sb) * 128; const bool need_mask = CAUSAL && ((key0) + 63 > qlo); \
            _Pragma("unroll") for (int mp = 0; mp < NMAP; ++mp) { f32x16 p0 = f32x16{}, p1 = f32x16{}; \
                _Pragma("unroll") for (int ks = 0; ks < KS; ++ks) { \
                    const bf16x8 a0 = *(const LAS bf16x8*)(kb + r32 * L::KROW + (mp * KD + ks * 16 + hi * 8) * 2); \
                    const bf16x8 a1 = *(const LAS bf16x8*)(kb + (32 + r32) * L::KROW + (mp * KD + ks * 16 + hi * 8) * 2); \
                    p0 = MFMA32(a0, q[mp][ks], p0); p1 = MFMA32(a1, q[mp][ks], p1); } \
                __builtin_amdgcn_sched_barrier(0); \
                float sh = mshift; \
                if constexpr (BIAS) { \
                    if (qlo - ((key0) + 63) >= 127) sh -= lut[255]; \
                    else { const LAS float* lp = lut + (qi - (key0) - 4 * hi + 69); \
                        _Pragma("unroll") for (int r = 0; r < 16; ++r) { const int cr = (r & 3) + 8 * (r >> 2); p0[r] += lp[59 - cr]; p1[r] += lp[27 - cr]; } } } \
                if (need_mask) { _Pragma("unroll") for (int r = 0; r < 16; ++r) { const int kk = (key0) + crow(r, hi); if (kk > qi) p0[r] = -1e30f; if (kk + 32 > qi) p1[r] = -1e30f; } } \
                float ps = 0.f; \
                _Pragma("unroll") for (int r = 0; r < 16; ++r) { p0[r] = fexp2(p0[r] - sh); p1[r] = fexp2(p1[r] - sh); ps += p0[r] + p1[r]; } \
                l[mp] += ps; \
                __builtin_amdgcn_sched_barrier(0); \
                bf16x8 pa0, pa1, pa2, pa3; \
                PK4(p0, 0, pa0); PK4(p0, 8, pa1); PK4(p1, 0, pa2); PK4(p1, 8, pa3); \
                _Pragma("unroll") for (int dt = 0; dt < 2; ++dt) { \
                    const LAS unsigned char* vrow = vb + (dt * 32 + r32) * L::VROW + hi * 16; \
                    const bf16x8 v0 = *(const LAS bf16x8*)(vrow), v1 = *(const LAS bf16x8*)(vrow + 32), v2 = *(const LAS bf16x8*)(vrow + 64), v3 = *(const LAS bf16x8*)(vrow + 96); \
                    o[mp][dt] = MFMA32(v0, pa0, o[mp][dt]); o[mp][dt] = MFMA32(v1, pa1, o[mp][dt]); o[mp][dt] = MFMA32(v2, pa2, o[mp][dt]); o[mp][dt] = MFMA32(v3, pa3, o[mp][dt]); } \
                __builtin_amdgcn_sched_barrier(0); } } } while (0)
    const int n128 = nkt >> 1;
    if (wid < 4) __builtin_amdgcn_s_setprio(2);
    AT_LOAD(0); AT_WRITE(0); __syncthreads();
    for (int j = 0; j < n128; ++j) {
        if (j + 1 < n128) AT_LOAD(j + 1);
        AT_COMPUTE(j * 128, j & 1, 0);
        AT_COMPUTE(j * 128 + 64, j & 1, 1);
        if (j + 1 < n128) AT_WRITE((j + 1) & 1);
        __syncthreads();
    }
    __builtin_amdgcn_s_setprio(0);
#undef AT_COMPUTE
#pragma unroll
    for (int mp = 0; mp < NMAP; ++mp) l[mp] += __shfl_xor(l[mp], 32);
#undef AT_LOAD
#undef AT_WRITE
}

__device__ __forceinline__ void attn_store(bf16_t* dst, const f32x16 (&o)[2], float scale, int hi) {
#pragma unroll
    for (int dt = 0; dt < 2; ++dt)
#pragma unroll
        for (int rg = 0; rg < 4; ++rg) { u32x2 w; w.x = cvt_pk_bf16(o[dt][4 * rg] * scale, o[dt][4 * rg + 1] * scale); w.y = cvt_pk_bf16(o[dt][4 * rg + 2] * scale, o[dt][4 * rg + 3] * scale);
            *(u32x2*)(dst + dt * 32 + 8 * rg + 4 * hi) = w; }
}

__device__ __forceinline__ bool in_phase(int k) { const __attribute__((address_space(4))) int* p_ = (const __attribute__((address_space(4))) int*)__builtin_amdgcn_kernarg_segment_ptr(); asm volatile("" : "+s"(p_)); return p_[114] <= k && k < p_[115]; }
__device__ __forceinline__ bool sub_on(int k) { const __attribute__((address_space(4))) int* p_ = (const __attribute__((address_space(4))) int*)__builtin_amdgcn_kernarg_segment_ptr(); asm volatile("" : "+s"(p_)); return (p_[116] >> k) & 1; }
__device__ __forceinline__ void s5_bu_tile(LAS unsigned char* tile, const bf16_t* bbf_g, const bf16_t* zs_tok0, int lane) {
    const int r32 = lane & 31, hi = lane >> 5;
    const bf16x8 uf = ldg8(zs_tok0 + (size_t)r32 * ZSW + 8 * hi);
#pragma unroll
    for (int pt = 0; pt < 4; ++pt) { f32x16 d = f32x16{}; d = MFMA32(ldg8(bbf_g + (size_t)(32 * pt + r32) * 16 + 8 * hi), uf, d);
#pragma unroll
        for (int rg = 0; rg < 4; ++rg) { u32x2 w; w.x = cvt_pk_bf16(d[4 * rg], d[4 * rg + 1]); w.y = cvt_pk_bf16(d[4 * rg + 2], d[4 * rg + 3]);
            *(LAS u32x2*)(tile + r32 * 272 + (32 * pt + 8 * rg + 4 * hi) * 2) = w; } }
    asm volatile("s_waitcnt lgkmcnt(0)" ::: "memory");
}
__device__ __forceinline__ int h0_pull(LAS unsigned* qc, int lane, int wg_items, int bid, int G, int total) {
    unsigned k = 0u; if (lane == 0) k = __hip_atomic_fetch_add(qc, 1u, __ATOMIC_RELAXED, __HIP_MEMORY_SCOPE_WORKGROUP);
    const int kk = __builtin_amdgcn_readfirstlane((int)k);
    return kk < wg_items ? bid + kk * G : total;
}
__device__ __forceinline__ int queue_pull(unsigned* ctr, volatile LAS unsigned* slot, int tid) {
    __syncthreads();
    if (tid == 0) *slot = __hip_atomic_fetch_add(ctr, 1u, __ATOMIC_RELAXED, __HIP_MEMORY_SCOPE_AGENT);
    __syncthreads();
    return (int)*slot;
}
constexpr int NPHASE = 24;
#ifndef DBG_NPH
#endif
__global__ void __launch_bounds__(512, 2) hybrid_fwd(Args args) {
    extern __shared__ __attribute__((aligned(16))) unsigned char lds_raw[];
    LAS unsigned char* lds0 = (LAS unsigned char*)lds_raw;
    volatile LAS unsigned* MISC = (volatile LAS unsigned*)(lds0 + MISC_OFF);
    for (int u = threadIdx.x; u < (LDS_BYTES - RING_BYTES) / 4; u += 512) ((LAS unsigned*)(lds0 + RING_BYTES))[u] = 0u;
    __syncthreads();
    const int lo = args.ph_lo, hi_ph = args.ph_hi;
    const bool one_launch = (hi_ph - lo) > 1;
    XcdBarrier bar; bar.bar = (unsigned*)(args.ws + WS_CTL) + CW_BAR; bar.x = 0; bar.st = nullptr;
    if (one_launch) bar = xcd_barrier_post((unsigned*)(args.ws + WS_CTL) + CW_BAR, MISC + 8);
#ifndef SUBMASK
#define SUBMASK 0xFFFFu
#endif
#define SUB(k) ((((SUBMASK) >> (k)) & 1u) && sub_on(k))
#ifndef PHMASK
#define PHMASK 0xFFFFFFu
#endif
#define IN(k) ((((PHMASK) >> (k)) & 1u) && in_phase(k))
#define SEAM(k) do { if (IN(k) && IN((k) + 1)) { XcdBarrier b2_ = bar; asm volatile("" : "+s"(b2_.bar), "+s"(b2_.x)); xcd_barrier(b2_); } } while (0)

    if (IN(0)) { PHASE_BEGIN();
        LAS float* scr = (LAS float*)(F.lds + F.wave * 16384);
        int joff = 0;
        for (int l = 0; l < 2; ++l) {
            unsigned char* wl = ws + WS_WL + l * WL_STRIDE;
#define RUNJOB(...) do { const TJob jb_ = TJob{__VA_ARGS__}; int fst_ = F.gw - joff; if (fst_ < 0) fst_ += F.ngw; tjob_run_all(jb_, fst_, F.ngw, scr, F.lane); joff = (joff + tjob_items(jb_)) % F.ngw; } while (0)
            RUNJOB(INF(8) + (size_t)l * DM * DIN, (bf16_t*)(wl + WL_WIN), INF(4) + l * DM, DM, DIN, DIN, DM, 1, 1, 0, 0);
            RUNJOB(INF(22) + (size_t)l * 192 * 384, (bf16_t*)(wl + WL_SM + SM_WUQ), INF(20) + l * 192, 192, 384, 384, 192, 1, 0, 0, 0);
            RUNJOB(INF(23) + (size_t)l * 128 * 512, (bf16_t*)(wl + WL_SM + SM_WUKV), INF(21) + l * 128, 128, 512, 512, 128, 1, 0, 0, 0);
            RUNJOB(INF(28) + (size_t)l * 4 * 4096, (bf16_t*)(wl + WL_SM + SM_WR), nullptr, 64, 64, 64, 64, 4, 0, 4096, 4096);
            RUNJOB(INF(30) + (size_t)l * 4 * 4096, (bf16_t*)(wl + WL_SM + SM_WI), nullptr, 64, 64, 64, 64, 4, 0, 4096, 4096);
            RUNJOB(INF(18) + (size_t)l * 65536, (bf16_t*)(wl + WL_SM + SM_WGLU), nullptr, 256, 256, 256, 256, 1, 0, 0, 0);
            RUNJOB(INF(40) + (size_t)l * 4 * 256 * DM, (bf16_t*)(wl + WL_PT), nullptr, 256, DM, DM, 256, 4, 0, (size_t)256 * DM, (size_t)DM * 256);
            RUNJOB(INF(41) + (size_t)l * DM * DM, (bf16_t*)(wl + WL_WO), nullptr, DM, DM, DM, DM, 1, 0, 0, 0);
            RUNJOB(INF(42) + (size_t)l * DM * 256, (bf16_t*)(wl + WL_WXQ), INF(5) + l * DM, DM, 256, 256, DM, 1, 0, 0, 0);
            RUNJOB(INF(43) + (size_t)l * DM * 256, (bf16_t*)(wl + WL_WXKV), INF(6) + l * DM, DM, 256, 256, DM, 1, 0, 0, 0);
            RUNJOB(INF(44) + (size_t)l * DM * 256, (bf16_t*)(wl + WL_WXKV) + (size_t)256 * DM, INF(6) + l * DM, DM, 256, 256, DM, 1, 0, 0, 0);
            RUNJOB(INF(45) + (size_t)l * 256 * DM, (bf16_t*)(wl + WL_WXO), nullptr, 256, DM, DM, 256, 1, 0, 0, 0);
            { u32x4* z = (u32x4*)((bf16_t*)(wl + WL_WIN) + (size_t)C_END * DM); const int n16 = (ZSW - C_END) * DM * 2 / 16;
              for (int i = F.bid * 512 + F.tid; i < n16; i += F.G * 512) z[i] = (u32x4){0u, 0u, 0u, 0u}; }
        }
        {
            RUNJOB(INF(48), (bf16_t*)(ws + WS_WGU), INF(7), DM, FF, FF, DM, 1, 2, 0, 0);
            RUNJOB(INF(49), (bf16_t*)(ws + WS_WGU), INF(7), DM, FF, FF, DM, 1, 3, 0, 0);
            RUNJOB(INF(50), (bf16_t*)(ws + WS_WD), nullptr, FF, DM, DM, FF, 1, 0, 0, 0, G2_FP8);
        }
        for (int i = F.bid * 512 + F.tid; i < 2 * 16 * 64; i += F.G * 512) {
            const int l = i >> 10, g = (i >> 6) & 15, p = i & 63;
            const float dt = __expf(INF(12)[l * 16 + g]);
            const float lr = INF(10)[(l * 16 + g) * 64 + p], li = INF(11)[(l * 16 + g) * 64 + p];
            const float mag = __expf(lr * dt); float sn, cs; sincos_red(li * dt, sn, cs);
            const float ar = mag * cs, ai = mag * sn, den = lr * lr + li * li;
            const float zr = ((ar - 1.f) * lr + ai * li) / den, zi = (ai * lr - (ar - 1.f) * li) / den;
            float* tb = S5T + (size_t)(l * 16 + g) * 36 * 64;
            for (int c = 0; c < 16; ++c) { const float br = INF(13)[((l * 16 + g) * 64 + p) * 16 + c], bi = INF(14)[((l * 16 + g) * 64 + p) * 16 + c];
                tb[c * 64 + p] = zr * br - zi * bi; tb[(16 + c) * 64 + p] = zr * bi + zi * br;
                BBF[((size_t)(l * 16 + g) * 128 + p) * 16 + c] = f2bf(zr * br - zi * bi); BBF[((size_t)(l * 16 + g) * 128 + 64 + p) * 16 + c] = f2bf(zr * bi + zi * br); }
            tb[32 * 64 + p] = ar; tb[33 * 64 + p] = ai;
            float pr = ar, pi = ai;
            for (int s = 0; s < 6; ++s) { const float nr = pr * pr - pi * pi, ni = 2.f * pr * pi; pr = nr; pi = ni; }
            tb[34 * 64 + p] = pr; tb[35 * 64 + p] = pi;
            bf16_t* cm = CMAT + (size_t)(l * 16 + g) * 16 * 128;
            for (int c = 0; c < 16; ++c) { cm[c * 128 + p] = f2bf(INF(15)[((l * 16 + g) * 16 + c) * 64 + p]); cm[c * 128 + 64 + p] = f2bf(-INF(16)[((l * 16 + g) * 16 + c) * 64 + p]); }
        }
        for (int i = F.bid * 512 + F.tid; i < 512; i += F.G * 512) { const float lam = INF(32)[i]; MISCT[i] = 8.f * log1pf(__expf(-lam)); }
        if (F.bid == 0 && F.tid < 2) { const int l = F.tid; float s1 = 0.f, s2 = 0.f;
            for (int d = 0; d < 32; ++d) { s1 += INF(35)[l * 32 + d] * INF(36)[l * 32 + d]; s2 += INF(37)[l * 32 + d] * INF(38)[l * 32 + d]; }
            const float lam_init = 0.8f - 0.6f * expf(-0.3f * (float)l);
            MISCT[512 + l] = expf(s1) - expf(s2) + lam_init; MISCT[514 + l] = lam_init;
            float gq = 0.f, gk = 0.f; for (int d = 0; d < 96; ++d) { gq = fmaxf(gq, fabsf(INF(24)[l * 96 + d])); gk = fmaxf(gk, fabsf(INF(25)[l * 96 + d])); }
            MISCT[516 + l * 4 + 0] = 1.02f * gq * gk * 9.797958971f * LOG2E;
            gq = 0.f; gk = 0.f; for (int d = 0; d < 32; ++d) { gq = fmaxf(gq, fabsf(INF(33)[l * 32 + d])); gk = fmaxf(gk, fabsf(INF(34)[l * 32 + d])); }
            float bm = 0.f; for (int i = 0; i < 128; ++i) bm = fmaxf(bm, fabsf(INF(3)[i]));
            MISCT[516 + l * 4 + 1] = 1.02f * gq * gk * 5.656854249f * LOG2E + bm * LOG2E;
            gq = 0.f; gk = 0.f; for (int d = 0; d < 64; ++d) { gq = fmaxf(gq, fabsf(INF(46)[l * 64 + d])); gk = fmaxf(gk, fabsf(INF(47)[l * 64 + d])); }
            MISCT[516 + l * 4 + 2] = 1.02f * gq * gk * 8.f * LOG2E; }
        for (int i = F.bid * 512 + F.tid; i < 4 * 384; i += F.G * 512) { const int h = i / 384, dd = i % 384 - 128, d = dd > 127 ? 127 : dd; int bk;
            if (d < 16) bk = d < 0 ? 0 : d; else { const float lr_ = logf((float)d / 16.f) / logf(8.f); bk = 16 + (int)(lr_ * 16.f); if (bk > 31) bk = 31; }
            MISCT[1024 + i] = dd < 0 ? 0.f : INF(3)[bk * 4 + h] * LOG2E; }
        for (int m = F.gw; m < MTOK; m += F.ngw) {
            const f32x4* xr = (const f32x4*)(INF(0) + (size_t)m * DM) + F.lane; float s = 0.f;
            u32x2* o8 = (u32x2*)(XB + (size_t)m * DM) + F.lane;
#pragma unroll
            for (int j = 0; j < 4; ++j) { const f32x4 v = __builtin_nontemporal_load(xr + 64 * j); s += (v.x * v.x + v.y * v.y) + (v.z * v.z + v.w * v.w); u32x2 w; w.x = cvt_pk_bf16(v.x, v.y); w.y = cvt_pk_bf16(v.z, v.w); o8[64 * j] = w; }
            s = wave_sum(s); if (F.lane < 16) RS[(size_t)m * 16 + F.lane] = F.lane == 0 ? s : 0.f;
        }
    }
    SEAM(0);

    for (int l = 0; l < 2; ++l) {
        const int pb = 1 + 10 * l;
        if (IN(pb + 0)) { PHASE_BEGIN();
            pg8::Gemm g{XB, (const bf16_t*)(WLP(l) + WL_WIN), DM, nullptr}; pg8::StaticOrder S; S.init(MTOK / 256, NIN / 256, F.G, F.bid);
            pg8::EpiIn E{ZS, ZG, RS + (size_t)(l == 0 ? 0 : 3) * MTOK * 16, INF(9) + (size_t)l * 4 * DM};
            pg8::gemm_phase<pg8::EpiIn, pg8::StaticOrder, true, false>(F.lds, g, S, E);
        }
        SEAM(pb + 0);
        if (IN(pb + 1)) { PHASE_BEGIN();
            const int lane = F.lane, r = lane & 31, hi = lane >> 5;
            bf16_t* QM = (bf16_t*)(ws + WS_QM); bf16_t* KM = (bf16_t*)(ws + WS_KM); bf16_t* VMT = (bf16_t*)(ws + WS_VMT);
            if (SUB(0) && F.wave < 2) for (int tt = F.bid * 2 + F.wave; tt < 512; tt += F.G * 2) {
                const int row = tt * 32 + r, b = row >> 12, s = row & 4095;
                bf16x8 xq[12]; float ss = 0.f;
#pragma unroll
                for (int ks = 0; ks < 12; ++ks) { xq[ks] = ldg8(ZS + (size_t)row * ZSW + C_CQ + 16 * ks + 8 * hi); ss += sq8(xq[ks]); }
                ss += __shfl_xor(ss, 32); const float rc = frsq(ss * (1.f / 192.f) + EPS);
                const float pos = (float)((const int*)INF(2))[row]; float cs[8], sn[8];
#pragma unroll
                for (int i = 0; i < 8; ++i) { const int fi = crow(i, hi); const float inv = exp2f(-(float)fi * (13.287712379549449f / 16.f)); sincos_red(pos * inv, sn[i], cs[i]); }
                const bf16_t* W = (const bf16_t*)(WLP(l) + WL_SM + SM_WUQ); const float* gq = INF(24) + l * 96;
#pragma unroll 1
                for (int hd = 0; hd < 4; ++hd) {
                    f32x16 acc[3] = {f32x16{}, f32x16{}, f32x16{}};
#pragma unroll
                    for (int ft = 0; ft < 3; ++ft) {
#pragma unroll
                        for (int ks = 0; ks < 12; ++ks) acc[ft] = MFMA32(ldg8(W + (size_t)(hd * 96 + 32 * ft + r) * 192 + 16 * ks + 8 * hi), xq[ks], acc[ft]); }
                    float s2 = 0.f;
#pragma unroll
                    for (int ft = 0; ft < 3; ++ft)
#pragma unroll
                        for (int q = 0; q < 16; ++q) { acc[ft][q] *= rc; s2 += acc[ft][q] * acc[ft][q]; }
                    s2 += __shfl_xor(s2, 32); const float rq = frsq(s2 * (1.f / 96.f) + EPS);
#pragma unroll
                    for (int ft = 0; ft < 3; ++ft)
#pragma unroll
                        for (int q = 0; q < 16; ++q) acc[ft][q] *= rq * gq[32 * ft + crow(q, hi)];
#pragma unroll
                    for (int q = 0; q < 8; ++q) { const float x1 = acc[2][q], x2 = acc[2][q + 8]; acc[2][q] = x1 * cs[q] - x2 * sn[q]; acc[2][q + 8] = x1 * sn[q] + x2 * cs[q]; }
                    const float qs = 0.10206207261596577f * LOG2E;
                    bf16_t* dst = QM + ((size_t)(b * 4 + hd) * SEQ + s) * 96;
#pragma unroll
                    for (int ft = 0; ft < 3; ++ft)
#pragma unroll
                        for (int rg = 0; rg < 4; ++rg) { u32x2 w; w.x = cvt_pk_bf16(acc[ft][4 * rg] * qs, acc[ft][4 * rg + 1] * qs); w.y = cvt_pk_bf16(acc[ft][4 * rg + 2] * qs, acc[ft][4 * rg + 3] * qs);
                            *(u32x2*)(dst + 32 * ft + 8 * rg + 4 * hi) = w; }
                }
            }
            if (SUB(1) && (F.wave == 2 || F.wave == 3)) for (int tt = F.bid * 2 + F.wave - 2; tt < 512; tt += F.G * 2) {
                const int row = tt * 32 + r, b = row >> 12, s = row & 4095;
                bf16x8 xk[8]; float ss = 0.f;
#pragma unroll
                for (int ks = 0; ks < 8; ++ks) { xk[ks] = ldg8(ZS + (size_t)row * ZSW + C_CKV + 16 * ks + 8 * hi); ss += sq8(xk[ks]); }
                ss += __shfl_xor(ss, 32); const float rc = frsq(ss * (1.f / 128.f) + EPS);
                float kp[16]; float sskp = 0.f;
#pragma unroll
                for (int rg = 0; rg < 4; ++rg) { const u32x2 w = *(const u32x2*)(ZS + (size_t)row * ZSW + C_KPE + 8 * rg + 4 * hi);
                    kp[4 * rg] = bflo(w.x); kp[4 * rg + 1] = bfhi(w.x); kp[4 * rg + 2] = bflo(w.y); kp[4 * rg + 3] = bfhi(w.y); }
#pragma unroll
                for (int q = 0; q < 16; ++q) sskp += kp[q] * kp[q];
                const float pos = (float)((const int*)INF(2))[row]; float cs[8], sn[8];
#pragma unroll
                for (int i = 0; i < 8; ++i) { const int fi = crow(i, hi); const float inv = exp2f(-(float)fi * (13.287712379549449f / 16.f)); sincos_red(pos * inv, sn[i], cs[i]); }
                const bf16_t* W = (const bf16_t*)(WLP(l) + WL_SM + SM_WUKV); const float* gk = INF(25) + l * 96;
#pragma unroll 1
                for (int hd = 0; hd < 4; ++hd) {
                    f32x16 acc[4] = {f32x16{}, f32x16{}, f32x16{}, f32x16{}};
#pragma unroll
                    for (int ft = 0; ft < 4; ++ft) {
#pragma unroll
                        for (int ks = 0; ks < 8; ++ks) acc[ft] = MFMA32(ldg8(W + (size_t)(hd * 128 + 32 * ft + r) * 128 + 16 * ks + 8 * hi), xk[ks], acc[ft]); }
                    float s2 = sskp;
#pragma unroll
                    for (int ft = 0; ft < 2; ++ft)
#pragma unroll
                        for (int q = 0; q < 16; ++q) { acc[ft][q] *= rc; s2 += acc[ft][q] * acc[ft][q]; }
                    s2 += __shfl_xor(s2, 32); const float rk = frsq(s2 * (1.f / 96.f) + EPS);
                    float kr[16];
#pragma unroll
                    for (int q = 0; q < 16; ++q) kr[q] = kp[q] * rk * gk[64 + crow(q, hi)];
#pragma unroll
                    for (int q = 0; q < 8; ++q) { const float x1 = kr[q], x2 = kr[q + 8]; kr[q] = x1 * cs[q] - x2 * sn[q]; kr[q + 8] = x1 * sn[q] + x2 * cs[q]; }
                    bf16_t* dst = KM + ((size_t)(b * 4 + hd) * SEQ + s) * 96;
#pragma unroll
                    for (int ft = 0; ft < 2; ++ft)
#pragma unroll
                        for (int rg = 0; rg < 4; ++rg) { const float* gp = gk + 32 * ft + 8 * rg + 4 * hi; u32x2 w;
                            w.x = cvt_pk_bf16(acc[ft][4 * rg] * rk * gp[0], acc[ft][4 * rg + 1] * rk * gp[1]); w.y = cvt_pk_bf16(acc[ft][4 * rg + 2] * rk * gp[2], acc[ft][4 * rg + 3] * rk * gp[3]);
                            *(u32x2*)(dst + 32 * ft + 8 * rg + 4 * hi) = w; }
#pragma unroll
                    for (int rg = 0; rg < 4; ++rg) { u32x2 w; w.x = cvt_pk_bf16(kr[4 * rg], kr[4 * rg + 1]); w.y = cvt_pk_bf16(kr[4 * rg + 2], kr[4 * rg + 3]); *(u32x2*)(dst + 64 + 8 * rg + 4 * hi) = w; }
                    bf16_t* vd = VMT + (size_t)(b * 4 + hd) * 64 * SEQ + s;
#pragma unroll
                    for (int ft = 2; ft < 4; ++ft)
#pragma unroll
                        for (int q = 0; q < 16; ++q) vd[(size_t)(32 * (ft - 2) + crow(q, hi)) * SEQ] = f2bf(acc[ft][q] * rc);
                }
            }
            if (SUB(2)) {
                bf16_t* QD = (bf16_t*)(ws + WS_QD); bf16_t* KD = (bf16_t*)(ws + WS_KD); bf16_t* VDT = (bf16_t*)(ws + WS_VDT);
                const float* gqn = INF(33) + l * 32; const float* gkn = INF(34) + l * 32;
                for (int i = F.bid * 512 + F.tid; i < MTOK * 16; i += F.G * 512) {
                    const int row = i & (MTOK - 1), j = i >> 14, half = j & 1, hd = (j >> 1) & 3, isk = j >> 3;
                    const bf16_t* src = ZS + (size_t)row * ZSW + (isk ? C_KD : C_QD) + hd * 64 + half * 32;
                    bf16x8 v[4]; float ss = 0.f;
#pragma unroll
                    for (int c = 0; c < 4; ++c) { v[c] = ldg8(src + 8 * c); ss += sq8(v[c]); }
                    const float rs = frsq(ss * (1.f / 32.f) + EPS) * (isk ? 1.f : 0.17677669529663687f * LOG2E);
                    const float* gg = isk ? gkn : gqn; const int b = row >> 12, s = row & 4095;
                    bf16_t* dst = (isk ? KD : QD) + ((size_t)(b * 4 + hd) * SEQ + s) * 64 + half * 32;
#pragma unroll
                    for (int c = 0; c < 4; ++c) { u32x4 w = *(u32x4*)&v[c]; const float* gp = gg + 8 * c;
                        w.x = cvt_pk_bf16(bflo(w.x) * rs * gp[0], bfhi(w.x) * rs * gp[1]); w.y = cvt_pk_bf16(bflo(w.y) * rs * gp[2], bfhi(w.y) * rs * gp[3]);
                        w.z = cvt_pk_bf16(bflo(w.z) * rs * gp[4], bfhi(w.z) * rs * gp[5]); w.w = cvt_pk_bf16(bflo(w.w) * rs * gp[6], bfhi(w.w) * rs * gp[7]);
                        *(u32x4*)(dst + 8 * c) = w; }
                }
                for (int i = F.bid * 512 + F.tid; i < MTOK * 32; i += F.G * 512) {
                    const int row = i & (MTOK - 1), j = i >> 14, oc = j & 7, hd = j >> 3, b = row >> 12, s = row & 4095;
                    const bf16x8 v = ldg8(ZS + (size_t)row * ZSW + C_VD + hd * 64 + oc * 8);
                    bf16_t* vd = VDT + ((size_t)(b * 4 + hd) * 64 + oc * 8) * SEQ + s;
#pragma unroll
                    for (int e = 0; e < 8; ++e) vd[(size_t)e * SEQ] = (bf16_t)v[e];
                }
            }
            if (SUB(3)) {
                float* LA = (float*)(ws + WS_LA); float* LI = (float*)(ws + WS_LI); float* LSA = (float*)(ws + WS_LSUM); float* LSH = LSA + NB * 128 * 256;
                const float* cw = INF(26) + l * 4 * 256; const float* cb = INF(27) + l * 256; const float* br = INF(29) + l * 256; const float* bi = INF(31) + l * 256;
                const float* c8 = MISCT + l * 256;
                LAS float* lsa = (LAS float*)(F.lds + F.wave * 16384); LAS float* lsh = lsa + 32 * 64;
                for (int tk = F.gw; tk < NB * 128 * 4; tk += F.ngw) {
                    const int n = tk & 3, tile = (tk >> 2) & 127, b = tk >> 9, s = tile * 32 + r, row = b * SEQ + s, cbase = 64 * n;
                    bf16x8 xcb[4]; float xcf[4][8];
#pragma unroll
                    for (int ks = 0; ks < 4; ++ks) {
                        const int c0 = cbase + 16 * ks + 8 * hi;
#pragma unroll
                        for (int e = 0; e < 8; ++e) xcf[ks][e] = cb[c0 + e];
#pragma unroll
                        for (int k = 0; k < 4; ++k) { const int sr = s - 3 + k;
                            if (sr >= 0) { const bf16x8 xv = ldg8(ZS + (size_t)(b * SEQ + sr) * ZSW + C_XLRU + c0); const u32x4 w = *(const u32x4*)&xv; const float* wk = cw + k * 256 + c0;
                                xcf[ks][0] += wk[0] * bflo(w.x); xcf[ks][1] += wk[1] * bfhi(w.x); xcf[ks][2] += wk[2] * bflo(w.y); xcf[ks][3] += wk[3] * bfhi(w.y);
                                xcf[ks][4] += wk[4] * bflo(w.z); xcf[ks][5] += wk[5] * bfhi(w.z); xcf[ks][6] += wk[6] * bflo(w.w); xcf[ks][7] += wk[7] * bfhi(w.w); } }
                        u32x4 pw; pw.x = cvt_pk_bf16(xcf[ks][0], xcf[ks][1]); pw.y = cvt_pk_bf16(xcf[ks][2], xcf[ks][3]); pw.z = cvt_pk_bf16(xcf[ks][4], xcf[ks][5]); pw.w = cvt_pk_bf16(xcf[ks][6], xcf[ks][7]); xcb[ks] = *(bf16x8*)&pw;
                    }
                    const bf16_t* Wr = (const bf16_t*)(WLP(l) + WL_SM + SM_WR) + n * 4096; const bf16_t* Wi = (const bf16_t*)(WLP(l) + WL_SM + SM_WI) + n * 4096;
                    f32x16 ar_[2] = {f32x16{}, f32x16{}}, ai_[2] = {f32x16{}, f32x16{}};
#pragma unroll
                    for (int ft = 0; ft < 2; ++ft)
#pragma unroll
                        for (int ks = 0; ks < 4; ++ks) { ar_[ft] = MFMA32(ldg8(Wr + (32 * ft + r) * 64 + 16 * ks + 8 * hi), xcb[ks], ar_[ft]); ai_[ft] = MFMA32(ldg8(Wi + (32 * ft + r) * 64 + 16 * ks + 8 * hi), xcb[ks], ai_[ft]); }
                    float xloc[4][4], xrcv[4][4];
#pragma unroll
                    for (int ks = 0; ks < 4; ++ks)
#pragma unroll
                        for (int j = 0; j < 4; ++j) { xloc[ks][j] = hi ? xcf[ks][4 + j] : xcf[ks][j]; const float snd = hi ? xcf[ks][j] : xcf[ks][4 + j]; xrcv[ks][j] = __shfl_xor(snd, 32); }
#pragma unroll
                    for (int ft = 0; ft < 2; ++ft)
#pragma unroll
                        for (int rg = 0; rg < 4; ++rg) {
                            const int c0 = cbase + 32 * ft + 8 * rg + 4 * hi, ks = 2 * ft + (rg >> 1);
                            f32x4 av, iv;
#pragma unroll
                            for (int e = 0; e < 4; ++e) { const float xce = ((rg & 1) == hi) ? xloc[ks][e] : xrcv[ks][e];
                                const float rr = fsigmoid(ar_[ft][4 * rg + e] + br[c0 + e]), ii = fsigmoid(ai_[ft][4 * rg + e] + bi[c0 + e]);
                                const float la = -rr * c8[c0 + e]; const float a = fexp2(la * LOG2E); av[e] = a; iv[e] = sqrtf(fmaxf(1.f - a * a, 0.f)) * ii * xce; }
                            *(f32x4*)(LA + (size_t)row * 256 + c0) = av; *(f32x4*)(LI + (size_t)row * 256 + c0) = iv;
                            { const int sc_ = (32 * ft + 8 * rg + 4 * hi) ^ ((r & 7) << 2); *(LAS f32x4*)(lsa + r * 64 + sc_) = av; *(LAS f32x4*)(lsh + r * 64 + sc_) = iv; }
                        }
                    asm volatile("s_waitcnt lgkmcnt(0)" ::: "memory");
                    {
                        float ta = 1.f, th = 0.f;
#pragma unroll
                        for (int t = 0; t < 32; ++t) { const float a_ = lsa[t * 64 + (lane ^ ((t & 7) << 2))], h_ = lsh[t * 64 + (lane ^ ((t & 7) << 2))]; th = a_ * th + h_; ta = ta * a_; }
                        LSA[(size_t)(b * 128 + tile) * 256 + cbase + lane] = ta; LSH[(size_t)(b * 128 + tile) * 256 + cbase + lane] = th;
                    }
                    asm volatile("s_waitcnt lgkmcnt(0)" ::: "memory");
                }
            }
            if (SUB(4)) {
                float* S5S = (float*)(ws + WS_S5S);
                const int t5cnt = F.wave < 4 ? 1 : (F.wave == 4 ? 0 : 4), t5off = F.wave < 4 ? F.wave : 4 + 4 * (F.wave - 5);
                for (int tbk = F.bid; tbk < NB * 64; tbk += F.G) for (int tj = 0; tj < t5cnt; ++tj) { const int tk = tbk * 16 + t5off + tj;
                    const int g = tk & 15, ch = (tk >> 4) & 63, b = tk >> 10;
                    const float* tb = S5T + (size_t)(l * 16 + g) * 36 * 64 + lane;
                    const float ar = tb[32 * 64], ai = tb[33 * 64];
                    LAS unsigned char* tile = F.lds + F.wave * 16384;
                    float hr = 0.f, hi2 = 0.f;
#pragma unroll 1
                    for (int hf = 0; hf < 2; ++hf) {
                        s5_bu_tile(tile, BBF + (size_t)(l * 16 + g) * 128 * 16, ZS + (size_t)(b * SEQ + ch * 64 + hf * 32) * ZSW + C_S5 + 16 * g, lane);
#pragma unroll 8
                        for (int t2 = 0; t2 < 32; ++t2) { const float bur = bf2f(*(const LAS bf16_t*)(tile + t2 * 272 + lane * 2)), bui = bf2f(*(const LAS bf16_t*)(tile + t2 * 272 + 128 + lane * 2));
                            const float nr = ar * hr - ai * hi2 + bur, ni = ar * hi2 + ai * hr + bui; hr = nr; hi2 = ni; }
                        asm volatile("s_waitcnt lgkmcnt(0)" ::: "memory");
                    }
                    float* dst = S5S + ((size_t)((b * 64 + ch) * 16 + g) * 2) * 64 + lane; dst[0] = hr; dst[64] = hi2;
                }
            }
            if (SUB(5) && l == 0) {
                bf16_t* KX = (bf16_t*)(ws + WS_KX); bf16_t* VXT = (bf16_t*)(ws + WS_VXT);
                if (F.wave == 4) for (int tk = F.bid; tk < 2 * 32 * 4; tk += F.G) {
                    const int hd = tk & 3, mt = (tk >> 2) & 31, ly = tk >> 7, row = mt * 32 + r, b = row >> 8, jm = row & 255;
                    const bf16_t* W = (const bf16_t*)(ws + WS_WL + ly * WL_STRIDE + WL_WXKV);
                    f32x16 acc[4] = {f32x16{}, f32x16{}, f32x16{}, f32x16{}}; float ss = 0.f;
                    const float* mp = INF(1) + (size_t)row * DM + 8 * hi;
#pragma unroll 2
                    for (int ks = 0; ks < 64; ++ks) {
                        const f32x4 m0 = *(const f32x4*)(mp + 16 * ks), m1 = *(const f32x4*)(mp + 16 * ks + 4);
                        ss += (m0.x * m0.x + m0.y * m0.y) + (m0.z * m0.z + m0.w * m0.w) + (m1.x * m1.x + m1.y * m1.y) + (m1.z * m1.z + m1.w * m1.w);
                        const u32x4 pw = pg8::pack8(m0, m1); const bf16x8 xb = *(const bf16x8*)&pw;
#pragma unroll
                        for (int f = 0; f < 4; ++f) { const int wrow = (f < 2 ? 64 * hd + 32 * f : 256 + 64 * hd + 32 * (f - 2)) + r; acc[f] = MFMA32(ldg8(W + (size_t)wrow * DM + 16 * ks + 8 * hi), xb, acc[f]); }
                    }
                    ss += __shfl_xor(ss, 32); const float rm = frsq(ss * (1.f / DM) + EPS);
                    float s2 = 0.f;
#pragma unroll
                    for (int f = 0; f < 2; ++f)
#pragma unroll
                        for (int q = 0; q < 16; ++q) { acc[f][q] *= rm; s2 += acc[f][q] * acc[f][q]; }
                    s2 += __shfl_xor(s2, 32); const float rk = frsq(s2 * (1.f / 64.f) + EPS);
                    const float* gk = INF(47) + ly * 64;
                    bf16_t* kd = KX + ((size_t)(ly * 16 + b * 4 + hd) * 256 + jm) * 64;
#pragma unroll
                    for (int f = 0; f < 2; ++f)
#pragma unroll
                        for (int rg = 0; rg < 4; ++rg) { const float* gp = gk + 32 * f + 8 * rg + 4 * hi; u32x2 w;
                            w.x = cvt_pk_bf16(acc[f][4 * rg] * rk * gp[0], acc[f][4 * rg + 1] * rk * gp[1]); w.y = cvt_pk_bf16(acc[f][4 * rg + 2] * rk * gp[2], acc[f][4 * rg + 3] * rk * gp[3]);
                            *(u32x2*)(kd + 32 * f + 8 * rg + 4 * hi) = w; }
                    bf16_t* vd = VXT + (size_t)(ly * 16 + b * 4 + hd) * 64 * 256 + jm;
#pragma unroll
                    for (int f = 2; f < 4; ++f)
#pragma unroll
                        for (int q = 0; q < 16; ++q) vd[(size_t)(32 * (f - 2) + crow(q, hi)) * 256] = f2bf(acc[f][q] * rm);
                }
            }
        }
        SEAM(pb + 1);
        if (IN(pb + 2)) {
            if (SUB(6)) { PHASE_BEGIN();
            const int lane = F.lane, r32 = lane & 31, hi = lane >> 5, wid = F.wave;
            volatile LAS unsigned* qslot = (volatile LAS unsigned*)(F.lds + MISC_OFF + 64);
            for (int it = queue_pull(F.ctl + CW_Q + 64 * (4 * l + 0), qslot, F.tid); it < 256; it = queue_pull(F.ctl + CW_Q + 64 * (4 * l + 0), qslot, F.tid)) {
                {
                    const int bh = it & 15, qt = 15 - (it >> 4), b = bh >> 2, hd = bh & 3;
                    const bf16_t* QM = (const bf16_t*)(ws + WS_QM) + (size_t)bh * SEQ * 96; const bf16_t* KM = (const bf16_t*)(ws + WS_KM) + (size_t)bh * SEQ * 96;
                    const bf16_t* VMT = (const bf16_t*)(ws + WS_VMT) + (size_t)bh * 64 * SEQ;
                    f32x16 o[1][2]; float lsum[1];
                    attn_unit<96, 1, true, false, false>(F.lds, QM + (size_t)qt * 256 * 96, 96, KM, VMT, SEQ, 4 * (qt + 1), 256 * qt, nullptr, nullptr, 1.f, MISCT[516 + l * 4 + 0], o, lsum);
                    const int row = b * SEQ + qt * 256 + wid * 32 + r32;
                    attn_store(YB + (size_t)1 * MTOK * 256 + (size_t)row * 256 + hd * 64, o[0], frcp(lsum[0]), hi);
                }
            } }
            if (SUB(7)) { PHASE_BEGIN();
            const int lane = F.lane, r32 = lane & 31, hi = lane >> 5, wid = F.wave;
            LAS float* lut = (LAS float*)(F.lds + 106496);
            for (int i = F.tid; i < 4 * 384; i += 512) lut[i] = MISCT[1024 + i];
            __syncthreads();
            volatile LAS unsigned* qslot = (volatile LAS unsigned*)(F.lds + MISC_OFF + 64);
            for (int it = queue_pull(F.ctl + CW_Q + 64 * (4 * l + 1), qslot, F.tid); it < 256; it = queue_pull(F.ctl + CW_Q + 64 * (4 * l + 1), qslot, F.tid)) {
                {
                    const int bh = it & 15, qt = 15 - (it >> 4), b = bh >> 2, hd = bh & 3;
                    const bf16_t* QD = (const bf16_t*)(ws + WS_QD) + (size_t)bh * SEQ * 64; const bf16_t* KD = (const bf16_t*)(ws + WS_KD) + (size_t)bh * SEQ * 64;
                    const bf16_t* VDT = (const bf16_t*)(ws + WS_VDT) + (size_t)bh * 64 * SEQ;
                    f32x16 o[2][2]; float lsum[2];
                    attn_unit<64, 2, true, true, false>(F.lds, QD + (size_t)qt * 256 * 64, 64, KD, VDT, SEQ, 4 * (qt + 1), 256 * qt, lut + hd * 384, nullptr, 1.f, MISCT[516 + l * 4 + 1], o, lsum);
                    const float lam = MISCT[512 + l], lam_init = MISCT[514 + l];
                    const float i1 = frcp(lsum[0]), i2 = lam * frcp(lsum[1]); float ss = 0.f;
#pragma unroll
                    for (int dt = 0; dt < 2; ++dt)
#pragma unroll
                        for (int q = 0; q < 16; ++q) { const float v = o[0][dt][q] * i1 - o[1][dt][q] * i2; o[0][dt][q] = v; ss += v * v; }
                    ss += __shfl_xor(ss, 32); const float rs = frsq(ss * (1.f / 64.f) + EPS) * (1.f - lam_init);
                    const float* gs = INF(39) + l * 64;
#pragma unroll
                    for (int dt = 0; dt < 2; ++dt)
#pragma unroll
                        for (int q = 0; q < 16; ++q) o[0][dt][q] *= gs[32 * dt + crow(q, hi)];
                    const int row = b * SEQ + qt * 256 + wid * 32 + r32;
                    attn_store(YB + (size_t)3 * MTOK * 256 + (size_t)row * 256 + hd * 64, o[0], rs, hi);
                }
            } }
            if (SUB(8)) { PHASE_BEGIN();
            const int lane = F.lane, r32 = lane & 31, hi = lane >> 5, wid = F.wave;
            volatile LAS unsigned* qslot = (volatile LAS unsigned*)(F.lds + MISC_OFF + 64);
            for (int it = queue_pull(F.ctl + CW_Q + 64 * (4 * l + 2), qslot, F.tid); it < 256; it = queue_pull(F.ctl + CW_Q + 64 * (4 * l + 2), qslot, F.tid)) {
                {
                    const int b = it >> 6, ch = it & 63, row0 = b * SEQ + ch * 64;
                    LAS unsigned char* hbuf = F.lds + wid * 8704;
                    LAS unsigned char* ypre = F.lds + 69632;
                    const float* S5S = (const float*)(ws + WS_S5S);
#pragma unroll 1
                    for (int gg = 0; gg < 2; ++gg) {
                        const int g = 2 * wid + gg;
                        const float* tb = S5T + (size_t)(l * 16 + g) * 36 * 64 + lane;
                        const float ar = tb[32 * 64], ai = tb[33 * 64], a64r = tb[34 * 64], a64i = tb[35 * 64];
                        float hr = 0.f, hi2 = 0.f;
                        for (int c0 = 0; c0 < ch; c0 += 8) {
                            float sr[8], si[8];
#pragma unroll
                            for (int u = 0; u < 8; ++u) { const int c = c0 + u; const bool ok = c < ch; const float* sp = S5S + ((size_t)((b * 64 + (ok ? c : 0)) * 16 + g) * 2) * 64 + lane; sr[u] = ok ? sp[0] : 0.f; si[u] = ok ? sp[64] : 0.f; }
#pragma unroll
                            for (int u = 0; u < 8; ++u) { if (c0 + u < ch) { const float nr = a64r * hr - a64i * hi2 + sr[u], ni = a64r * hi2 + a64i * hr + si[u]; hr = nr; hi2 = ni; } }
                        }
                        bf16x8 cf[4];
#pragma unroll
                        for (int ks = 0; ks < 4; ++ks) cf[ks] = ldg8(CMAT + (size_t)(l * 16 + g) * 16 * 128 + (lane & 15) * 128 + 32 * ks + 8 * (lane >> 4));
                        const float* dsk = INF(17) + l * 256 + 16 * g + 4 * (lane >> 4);
#pragma unroll 1
                        for (int hf = 0; hf < 2; ++hf) {
                            s5_bu_tile(hbuf, BBF + (size_t)(l * 16 + g) * 128 * 16, ZS + (size_t)(row0 + hf * 32) * ZSW + C_S5 + 16 * g, lane);
#pragma unroll 8
                            for (int t2 = 0; t2 < 32; ++t2) { const float bur = bf2f(*(const LAS bf16_t*)(hbuf + t2 * 272 + lane * 2)), bui = bf2f(*(const LAS bf16_t*)(hbuf + t2 * 272 + 128 + lane * 2));
                                const float nr = ar * hr - ai * hi2 + bur, ni = ar * hi2 + ai * hr + bui; hr = nr; hi2 = ni;
                                *(LAS bf16_t*)(hbuf + t2 * 272 + lane * 2) = f2bf(hr); *(LAS bf16_t*)(hbuf + t2 * 272 + 128 + lane * 2) = f2bf(hi2);
                            }
                            asm volatile("s_waitcnt lgkmcnt(0)" ::: "memory");
#pragma unroll
                            for (int tq = 0; tq < 2; ++tq) {
                                f32x4 yv = (f32x4){0.f, 0.f, 0.f, 0.f};
#pragma unroll
                                for (int ks = 0; ks < 4; ++ks) { const bf16x8 hb = *(const LAS bf16x8*)(hbuf + (16 * tq + (lane & 15)) * 272 + (32 * ks + 8 * (lane >> 4)) * 2); yv = MFMA16(cf[ks], hb, yv); }
                                const int tl = hf * 32 + 16 * tq + (lane & 15);
                                const u32x2 uw = *(const u32x2*)(ZS + (size_t)(row0 + tl) * ZSW + C_S5 + 16 * g + 4 * (lane >> 4));
                                yv[0] = fgelu(yv[0] + dsk[0] * bflo(uw.x)); yv[1] = fgelu(yv[1] + dsk[1] * bfhi(uw.x)); yv[2] = fgelu(yv[2] + dsk[2] * bflo(uw.y)); yv[3] = fgelu(yv[3] + dsk[3] * bfhi(uw.y));
                                u32x2 pw; pw.x = cvt_pk_bf16(yv[0], yv[1]); pw.y = cvt_pk_bf16(yv[2], yv[3]);
                                *(LAS u32x2*)(ypre + tl * 528 + (16 * g + 4 * (lane >> 4)) * 2) = pw;
                            }
                            asm volatile("s_waitcnt lgkmcnt(0)" ::: "memory");
                        }
                    }
                    __syncthreads();
                    {
                        const bf16_t* WG = (const bf16_t*)(WLP(l) + WL_SM + SM_WGLU);
                        f32x16 acc[2] = {f32x16{}, f32x16{}};
#pragma unroll 4
                        for (int ks = 0; ks < 16; ++ks) { const bf16x8 a = ldg8(WG + (size_t)(32 * wid + r32) * 256 + 16 * ks + 8 * hi);
#pragma unroll
                            for (int tt = 0; tt < 2; ++tt) acc[tt] = MFMA32(a, *(const LAS bf16x8*)(ypre + (32 * tt + r32) * 528 + (16 * ks + 8 * hi) * 2), acc[tt]); }
                        const float* bg = INF(19) + l * 256;
#pragma unroll
                        for (int tt = 0; tt < 2; ++tt)
#pragma unroll
                            for (int rg = 0; rg < 4; ++rg) { const int n0 = 32 * wid + 8 * rg + 4 * hi, t = 32 * tt + r32;
                                const u32x2 yw = *(const LAS u32x2*)(ypre + t * 528 + n0 * 2); u32x2 ow;
                                ow.x = cvt_pk_bf16(bflo(yw.x) * fsigmoid(acc[tt][4 * rg] + bg[n0]), bfhi(yw.x) * fsigmoid(acc[tt][4 * rg + 1] + bg[n0 + 1]));
                                ow.y = cvt_pk_bf16(bflo(yw.y) * fsigmoid(acc[tt][4 * rg + 2] + bg[n0 + 2]), bfhi(yw.y) * fsigmoid(acc[tt][4 * rg + 3] + bg[n0 + 3]));
                                *(u32x2*)(YB + (size_t)(row0 + t) * 256 + n0) = ow; }
                    }
                    __syncthreads();
                }
            }
            }
            if (SUB(9)) { PHASE_BEGIN(); const int lane = F.lane;
                const float* LA = (const float*)(ws + WS_LA); const float* LI = (const float*)(ws + WS_LI); const float* LSA = (const float*)(ws + WS_LSUM); const float* LSH = LSA + NB * 128 * 256;
                volatile LAS unsigned* qslot = (volatile LAS unsigned*)(F.lds + MISC_OFF + 64);
                for (int it = queue_pull(F.ctl + CW_Q + 64 * (4 * l + 3), qslot, F.tid); it < NB * 64 * 4 / 8; it = queue_pull(F.ctl + CW_Q + 64 * (4 * l + 3), qslot, F.tid)) {
                    const int tk = (NB * 64 * 4 / 8 - 1 - it) * 8 + F.wave;
                    const int n = tk & 3, ch = (tk >> 2) & 63, b = tk >> 8, c = 64 * n + lane;
                    float h = 0.f;
                    for (int tp0 = 0; tp0 < 2 * ch; tp0 += 16) {
                        float ca[16], chh[16];
#pragma unroll
                        for (int u = 0; u < 16; ++u) { const int tp = tp0 + u; const bool ok = tp < 2 * ch; const size_t o = (size_t)(b * 128 + (ok ? tp : 0)) * 256 + c; ca[u] = ok ? LSA[o] : 1.f; chh[u] = ok ? LSH[o] : 0.f; }
#pragma unroll
                        for (int u = 0; u < 16; ++u) h = ca[u] * h + chh[u];
                    }
                    const int row0 = b * SEQ + ch * 64;
#pragma unroll 1
                    for (int t0 = 0; t0 < 64; t0 += 16) {
                        float la[16], li[16], gt[16];
#pragma unroll
                        for (int u = 0; u < 16; ++u) { const size_t o = (size_t)(row0 + t0 + u) * 256 + c; la[u] = LA[o]; li[u] = LI[o]; gt[u] = bf2f(ZS[(size_t)(row0 + t0 + u) * ZSW + C_GLRU + c]); }
#pragma unroll
                        for (int u = 0; u < 16; ++u) { h = la[u] * h + li[u]; gt[u] = h * fgelu(gt[u]); }
#pragma unroll
                        for (int u = 0; u < 16; ++u) YB[(size_t)2 * MTOK * 256 + (size_t)(row0 + t0 + u) * 256 + c] = f2bf(gt[u]);
                    }
                }
            }
        }
        SEAM(pb + 2);
        if (IN(pb + 3)) { PHASE_BEGIN();
            pg8::Gemm g{YB, (const bf16_t*)(WLP(l) + WL_PT), 256, nullptr}; pg8::MergeOrder S{F.G, F.bid};
            pg8::EpiMerge E{MG, ZG};
            pg8::gemm_phase<pg8::EpiMerge, pg8::MergeOrder, true, false>(F.lds, g, S, E);
        }
        SEAM(pb + 3);
        if (IN(pb + 4)) { PHASE_BEGIN();
            pg8::Gemm g{MG, (const bf16_t*)(WLP(l) + WL_WO), DM, nullptr}; pg8::StaticOrder S; S.init(MTOK / 256, DM / 256, F.G, F.bid);
            pg8::EpiRes<false> E{nullptr, XB, RS + (size_t)(l == 0 ? 1 : 4) * MTOK * 16, nullptr};
            pg8::gemm_phase<pg8::EpiRes<false>, pg8::StaticOrder, false, false>(F.lds, g, S, E);
        }
        SEAM(pb + 4);
        if (IN(pb + 5)) { PHASE_BEGIN();
            pg8::Gemm g{XB, (const bf16_t*)(WLP(l) + WL_WXQ), DM, nullptr}; pg8::StaticOrder S; S.init(MTOK / 256, 1, F.G, F.bid);
            pg8::EpiRowScale E{(bf16_t*)(ws + WS_QX), 256, RS + (size_t)(l == 0 ? 1 : 4) * MTOK * 16};
            pg8::gemm_phase<pg8::EpiRowScale, pg8::StaticOrder, false, false>(F.lds, g, S, E);
        }
        SEAM(pb + 5);
        if (IN(pb + 6)) { PHASE_BEGIN();
            const int lane = F.lane, r32 = lane & 31, hi = lane >> 5, wid = F.wave;
            for (int it = F.bid; it < 256; it += F.G) {
                const int hd = it & 3, rt = it >> 2, b = rt >> 4;
                const bf16_t* QX = (const bf16_t*)(ws + WS_QX) + (size_t)rt * 256 * 256 + hd * 64;
                const bf16_t* KX = (const bf16_t*)(ws + WS_KX) + (size_t)(l * 16 + b * 4 + hd) * 256 * 64;
                const bf16_t* VXT = (const bf16_t*)(ws + WS_VXT) + (size_t)(l * 16 + b * 4 + hd) * 64 * 256;
                f32x16 o[1][2]; float lsum[1];
                attn_unit<64, 1, false, false, true>(F.lds, QX, 256, KX, VXT, 256, 4, 0, nullptr, INF(46) + l * 64, 0.125f * LOG2E, MISCT[516 + l * 4 + 2], o, lsum);
                const int row = rt * 256 + wid * 32 + r32;
                attn_store((bf16_t*)(ws + WS_OX) + (size_t)row * 256 + hd * 64, o[0], frcp(lsum[0]), hi);
            }
        }
        SEAM(pb + 6);
        if (IN(pb + 7)) { PHASE_BEGIN();
            pg8::Gemm g{(const bf16_t*)(ws + WS_OX), (const bf16_t*)(WLP(l) + WL_WXO), 256, nullptr}; pg8::StaticOrder S; S.init(MTOK / 256, DM / 256, F.G, F.bid);
            if (l == 0) { pg8::EpiRes<false> E{nullptr, XB, RS + (size_t)2 * MTOK * 16, nullptr}; pg8::gemm_phase<pg8::EpiRes<false>, pg8::StaticOrder, false, false>(F.lds, g, S, E); }
            else { pg8::EpiRes<false> E{nullptr, XB, RS + (size_t)5 * MTOK * 16, nullptr}; pg8::gemm_phase<pg8::EpiRes<false>, pg8::StaticOrder, false, false>(F.lds, g, S, E); }
        }
        SEAM(pb + 7);
        if (l == 0) {
            if (IN(9)) { PHASE_BEGIN();
                pg8::Gemm g{XB, (const bf16_t*)(ws + WS_WGU), DM, nullptr}; pg8::StaticOrder S; S.init(MTOK / 256, 2 * FF / 256, F.G, F.bid);
#if G2_FP8
                pg8::EpiSwiGLU8<true, false> E{ws + WS_HFF, FF, RS + (size_t)2 * MTOK * 16};
                pg8::gemm_phase<pg8::EpiSwiGLU8<true, false>, pg8::StaticOrder, true, false>(F.lds, g, S, E);
#else
                pg8::EpiSwiGLU<false> E{(bf16_t*)(ws + WS_HFF), FF, RS + (size_t)2 * MTOK * 16, nullptr};
                pg8::gemm_phase<pg8::EpiSwiGLU<false>, pg8::StaticOrder, true, false>(F.lds, g, S, E);
#endif
            }
            SEAM(9);
            if (IN(10)) { PHASE_BEGIN();
#if G2_FP8
                pg8::Gemm g{(const bf16_t*)(ws + WS_HFF), (const bf16_t*)(ws + WS_WD), FF / 2, nullptr}; pg8::StaticOrder S; S.init(MTOK / 256, DM / 256, F.G, F.bid);
                pg8::EpiRes<false, false, true> E{nullptr, XB, RS + (size_t)3 * MTOK * 16, nullptr};
                pg8::gemm_phase<pg8::EpiRes<false, false, true>, pg8::StaticOrder, false, false, true>(F.lds, g, S, E);
#else
                pg8::Gemm g{(const bf16_t*)(ws + WS_HFF), (const bf16_t*)(ws + WS_WD), FF, nullptr}; pg8::StaticOrder S; S.init(MTOK / 256, DM / 256, F.G, F.bid);
                pg8::EpiRes<false> E{nullptr, XB, RS + (size_t)3 * MTOK * 16, nullptr};
                pg8::gemm_phase<pg8::EpiRes<false>, pg8::StaticOrder, false, false>(F.lds, g, S, E);
#endif
            }
            SEAM(10);
        } else {
#define ROWTOK ((int*)(ws + WS_MOESM + MS_ROWTOK))
#define TOKW ((float*)(ws + WS_MOESM + MS_TOKW))
#define ASSIGN ((int*)(ws + WS_MOESM + MS_ASSIGN))
#define RSTD2 ((float*)(ws + WS_MOESM + MS_RSTD))
#define MCNT (F.ctl + CW_MOECNT)
            if (IN(19)) { PHASE_BEGIN();
                LAS float* wrs = (LAS float*)(F.lds);
                for (int i = F.tid; i < 8192; i += 512) wrs[i] = INF(51)[i] * INF(7)[DM + (i >> 3)];
                __syncthreads();
                if (SUB(10) && F.wave < 4) {
                    const int lane = F.lane;
                    for (int blk = F.bid; blk < 256; blk += F.G) {
                        unsigned cntv = 0u, mypack = 0u;
#pragma unroll 1
                        for (int j = 0; j < 16; ++j) {
                            const int tok = blk * 64 + F.wave * 16 + j;
                            const u32x2* xr = (const u32x2*)(XB + (size_t)tok * DM) + lane;
                            float lg[8] = {0.f, 0.f, 0.f, 0.f, 0.f, 0.f, 0.f, 0.f}; float ss = 0.f; f32x4 xv4[4];
#pragma unroll
                            for (int q = 0; q < 4; ++q) { const u32x2 xw = xr[64 * q]; const f32x4 v = {bflo(xw.x), bfhi(xw.x), bflo(xw.y), bfhi(xw.y)}; const int k0 = 256 * q + 4 * lane; xv4[q] = v;
                                ss += (v.x * v.x + v.y * v.y) + (v.z * v.z + v.w * v.w);
#pragma unroll
                                for (int e4 = 0; e4 < 4; ++e4) { const float xv = v[e4]; const LAS f32x4* wp = (const LAS f32x4*)(wrs + (k0 + e4) * 8); const f32x4 wa = wp[0], wb = wp[1];
                                    lg[0] += xv * wa.x; lg[1] += xv * wa.y; lg[2] += xv * wa.z; lg[3] += xv * wa.w; lg[4] += xv * wb.x; lg[5] += xv * wb.y; lg[6] += xv * wb.z; lg[7] += xv * wb.w; } }
                            ss = wave_sum(ss);
#pragma unroll
                            for (int e = 0; e < 8; ++e) lg[e] = wave_sum(lg[e]);
                            const float rstd = frsq(ss * (1.f / DM) + EPS);
                            { unsigned* xq = (unsigned*)(ws + WS_XQ + (size_t)tok * DM) + lane;
#pragma unroll
                              for (int q = 0; q < 4; ++q) xq[64 * q] = cvt_pk4_fp8(xv4[q].x * rstd, xv4[q].y * rstd, xv4[q].z * rstd, xv4[q].w * rstd); }
                            int e1 = 0; float v1 = lg[0];
#pragma unroll
                            for (int e = 1; e < 8; ++e) if (lg[e] > v1) { v1 = lg[e]; e1 = e; }
                            int e2 = -1; float v2 = -3.4e38f;
#pragma unroll
                            for (int e = 0; e < 8; ++e) if (e != e1 && lg[e] > v2) { v2 = lg[e]; e2 = e; }
                            if (e2 < 0) e2 = (e1 + 1) & 7;
                            const int se1 = __builtin_amdgcn_readfirstlane(e1), se2 = __builtin_amdgcn_readfirstlane(e2);
                            const unsigned r1 = __builtin_amdgcn_readlane(cntv, se1), r2 = __builtin_amdgcn_readlane(cntv, se2);
                            cntv += (lane == se1 ? 1u : 0u) + (lane == se2 ? 1u : 0u);
                            if (lane == j) mypack = (unsigned)se1 | (r1 << 4) | ((unsigned)se2 << 12) | (r2 << 16);
                            if (lane == 0) { const float w1 = frcp(1.f + __expf((v2 - v1) * rstd)); RSTD2[tok] = rstd; TOKW[tok * 2] = w1; TOKW[tok * 2 + 1] = 1.f - w1; }
                        }
                        unsigned basev = 0u;
                        if (lane < 8) basev = __hip_atomic_fetch_add(MCNT + 64 * lane, cntv, __ATOMIC_RELAXED, __HIP_MEMORY_SCOPE_AGENT);
                        const int pe1 = mypack & 15, pr1 = (mypack >> 4) & 255, pe2 = (mypack >> 12) & 15, pr2 = (mypack >> 16) & 255;
                        const unsigned b1 = __shfl(basev, pe1), b2 = __shfl(basev, pe2);
                        if (lane < 16) { const int tok = blk * 64 + F.wave * 16 + lane; ASSIGN[tok * 2] = pe1 | (int)((b1 + (unsigned)pr1) << 8); ASSIGN[tok * 2 + 1] = pe2 | (int)((b2 + (unsigned)pr2) << 8);
                            ROWTOK[pe1 * 16384 + (int)(b1 + (unsigned)pr1)] = tok; ROWTOK[pe2 * 16384 + (int)(b2 + (unsigned)pr2)] = tok; }
                    }
                }
                if (SUB(11)) {
                    LAS float* scr = (LAS float*)(F.lds + 40960 + F.wave * 8448);
                    const TJob j0{INF(52), (bf16_t*)(ws + WS_WMGU), INF(7) + DM, DM, EFF, EFF, DM, 8, 2, (size_t)DM * EFF, (size_t)2 * EFF * DM, 1};
                    const TJob j1{INF(53), (bf16_t*)(ws + WS_WMGU), INF(7) + DM, DM, EFF, EFF, DM, 8, 3, (size_t)DM * EFF, (size_t)2 * EFF * DM, 1};
                    const TJob j2{INF(54), (bf16_t*)(ws + WS_WMD), nullptr, EFF, DM, DM, EFF, 8, 0, (size_t)EFF * DM, (size_t)DM * EFF, 1};
                    constexpr int NI = 8 * (DM / 64) * (EFF / 32);
                    LAS unsigned* qc = (LAS unsigned*)(F.lds + MISC_OFF + 128);
                    const int wg_items = (3 * NI - F.bid + F.G - 1) / F.G;
#define H0_PULL() h0_pull(qc, F.lane, wg_items, F.bid, F.G, 3 * NI)
#define H0_JOB(idx) const int jn_ = (idx) / NI; TJob js_ = j0; if (jn_ == 1) { js_.W = j1.W; js_.map = 3; } if (jn_ == 2) js_ = j2;
#define H0_LOAD(idx, v) do { H0_JOB(idx) tjob_load(js_, (idx) - jn_ * NI, v, F.lane); } while (0)
#define H0_STORE(idx, v) do { H0_JOB(idx) tjob_store(js_, (idx) - jn_ * NI, v, scr, F.lane); } while (0)
                    float va[32] = {}, vb[32] = {}; int it = H0_PULL();
                    if (it < 3 * NI) { H0_LOAD(it, va);
                        for (;;) {
                            const int n1 = H0_PULL(); if (n1 < 3 * NI) H0_LOAD(n1, vb);
                            H0_STORE(it, va); if (n1 >= 3 * NI) break;
                            const int n2 = H0_PULL(); if (n2 < 3 * NI) H0_LOAD(n2, va);
                            H0_STORE(n1, vb); if (n2 >= 3 * NI) break;
                            it = n2;
                        } }
#undef H0_PULL
#undef H0_JOB
#undef H0_LOAD
#undef H0_STORE
                }
            }
            SEAM(19);
            if (IN(21)) { PHASE_BEGIN();
                pg8::Gemm g{(const bf16_t*)(ws + WS_XQ), (const bf16_t*)(ws + WS_WMGU), DM / 2, ROWTOK}; pg8::MoeOrder S; S.init(MCNT, 2 * EFF / 256, F.G, F.bid);
                pg8::EpiSwiGLU8<false> E{ws + WS_HMOE, EFF, nullptr};
                pg8::gemm_phase<pg8::EpiSwiGLU8<false>, pg8::MoeOrder, true, true, true>(F.lds, g, S, E);
            }
            SEAM(21);
            if (IN(22)) { PHASE_BEGIN();
                pg8::Gemm g{(const bf16_t*)(ws + WS_HMOE), (const bf16_t*)(ws + WS_WMD), EFF / 2, nullptr}; pg8::MoeOrder S; S.init(MCNT, DM / 256, F.G, F.bid);
                pg8::EpiPlain E{(bf16_t*)(ws + WS_YS), DM, 0.03125f};
                pg8::gemm_phase<pg8::EpiPlain, pg8::MoeOrder, true, false, true>(F.lds, g, S, E);
            }
            SEAM(22);
            if (IN(23)) { PHASE_BEGIN();
                const bf16_t* YS = (const bf16_t*)(ws + WS_YS);
                int pst[8]; { int acc = 0;
#pragma unroll
                    for (int e = 0; e < 8; ++e) { pst[e] = acc; acc += ((int)MCNT[64 * e] + 255) & ~255; } }
                for (int m = F.gw; m < MTOK; m += F.ngw) {
                    const int a1 = ASSIGN[2 * m], a2 = ASSIGN[2 * m + 1]; int p1 = 0, p2 = 0;
#pragma unroll
                    for (int q = 0; q < 8; ++q) { p1 = (q == (a1 & 255)) ? pst[q] : p1; p2 = (q == (a2 & 255)) ? pst[q] : p2; }
                    const int d1 = p1 + (a1 >> 8), d2 = p2 + (a2 >> 8); const float w1 = TOKW[2 * m], w2 = TOKW[2 * m + 1];
                    f32x4* xr = (f32x4*)(F.out + (size_t)m * DM) + F.lane; const u32x2* xbr = (const u32x2*)(XB + (size_t)m * DM) + F.lane;
                    const u32x2* y1 = (const u32x2*)(YS + (size_t)d1 * DM) + F.lane; const u32x2* y2 = (const u32x2*)(YS + (size_t)d2 * DM) + F.lane;
#pragma unroll
                    for (int j = 0; j < 4; ++j) { const u32x2 xw = xbr[64 * j]; f32x4 v = {bflo(xw.x), bfhi(xw.x), bflo(xw.y), bfhi(xw.y)}; const u32x2 a = __builtin_nontemporal_load(y1 + 64 * j), c = __builtin_nontemporal_load(y2 + 64 * j);
                        v.x += w1 * bflo(a.x) + w2 * bflo(c.x); v.y += w1 * bfhi(a.x) + w2 * bfhi(c.x); v.z += w1 * bflo(a.y) + w2 * bflo(c.y); v.w += w1 * bfhi(a.y) + w2 * bfhi(c.y);
                        __builtin_nontemporal_store(v, xr + 64 * j); }
                }
            }
        }
    }
#undef IN
#undef SEAM
}

#ifdef DBG_DUMP_OFF
__global__ void dbg_copy_bf16(const bf16_t* src, float* out, int n, int nv) { for (int i = blockIdx.x * 256 + threadIdx.x; i < n; i += gridDim.x * 256) out[i] = i < nv ? bf2f(src[i]) : 0.f; }
#endif

#ifdef DBG_CHECK
struct DbgArgs { const void* in[55]; unsigned char* ws; float* out; float* acc; };
#ifndef DBG_LAYER
#define DBG_LAYER 0
#endif
__device__ __forceinline__ size_t dstride(int i) {
    switch (i) { case 4: case 5: case 6: case 7: case 10: case 11: case 26: return 1024; case 8: return (size_t)DM * DIN; case 9: return 4096; case 12: return 16;
      case 13: case 14: case 15: case 16: case 28: case 30: return 16384; case 17: case 19: case 27: case 29: case 31: case 32: return 256; case 18: case 23: return 65536; case 20: return 192; case 21: return 128;
      case 22: return 73728; case 24: case 25: return 96; case 33: case 34: case 35: case 36: case 37: case 38: return 32; case 39: case 46: case 47: return 64; case 40: return (size_t)4 * 256 * DM; case 41: return (size_t)DM * DM;
      case 42: case 43: case 44: case 45: return (size_t)DM * 256; default: return 0; } }
#define DIN_(i) ((const float*)a.in[i] + (size_t)DBG_LAYER * dstride(i))
#define DXIN_ (DBG_LAYER == 0 ? (const float*)a.in[0] : (const float*)(a.ws + WS_DBG))
constexpr size_t WS_DBG = 440 * MiB;
__device__ float blk_sum(float v, float* sh) { sh[threadIdx.x] = v; __syncthreads(); for (int o = 128; o > 0; o >>= 1) { if ((int)threadIdx.x < o) sh[threadIdx.x] += sh[threadIdx.x + o]; __syncthreads(); } const float r = sh[0]; __syncthreads(); return r; }
__device__ float blk_max(float v, float* sh) { sh[threadIdx.x] = v; __syncthreads(); for (int o = 128; o > 0; o >>= 1) { if ((int)threadIdx.x < o) sh[threadIdx.x] = fmaxf(sh[threadIdx.x], sh[threadIdx.x + o]); __syncthreads(); } const float r = sh[0]; __syncthreads(); return r; }
__device__ void dbg_acc(float* acc, int k, float fast, float ref) { atomicMax((unsigned*)&acc[2 * k], __float_as_uint(fabsf(fast - ref))); atomicAdd(&acc[2 * k + 1], ref * ref); atomicAdd(&acc[64 + k], 1.f); }
__device__ float dsig(float x) { return 1.f / (1.f + expf(-x)); }
__device__ float dgelu(float x) { return 0.5f * x * (1.f + tanhf(0.7978845608028654f * (x + 0.044715f * x * x * x))); }
__device__ int dbucket(int d) { if (d < 16) return d < 0 ? 0 : d; int bk = 16 + (int)(logf((float)d / 16.f) / logf(8.f) * 16.f); return bk > 31 ? 31 : bk; }

__global__ void chk_z(DbgArgs a) {
    __shared__ float sh[256]; const int s = blockIdx.x, tid = threadIdx.x; const int row = (s * 7919 + 13) % MTOK; int col = (s * 104729 + 7 + (s >> 1)) % DIN; if (s & 1) col = col % C_END;
    const float* x = (DBG_LAYER == 0 ? (const float*)a.in[0] : (const float*)a.out) + (size_t)row * DM; const float* g = DIN_(4); const float* W = DIN_(8);
    float ss = 0.f, dot = 0.f; for (int k = tid; k < DM; k += 256) { const float xv = x[k]; ss += xv * xv; dot += xv * g[k] * W[(size_t)k * DIN + col]; }
    ss = blk_sum(ss, sh); dot = blk_sum(dot, sh);
    if (tid == 0) { const float z = dot * rsqrtf(ss / DM + EPS);
        if (col < C_END) dbg_acc(a.acc, 1, bf2f(((const bf16_t*)(a.ws + WS_ZS))[(size_t)row * ZSW + col]), z);
        else { const int gc = col - C_END; dbg_acc(a.acc, 2, bf2f(((const bf16_t*)(a.ws + WS_ZG))[(size_t)row * ZGW + gc]), dsig(z + DIN_(9)[gc])); } }
}
__global__ void chk_mla_prep(DbgArgs a) {
    __shared__ float sh[256]; __shared__ float vn[192]; __shared__ float qs[128];
    const int s = blockIdx.x, tid = threadIdx.x, row = (s * 7919 + 13) % MTOK, hd = s & 3, b = row >> 12, sq = row & 4095;
    const bf16_t* ZSp = (const bf16_t*)(a.ws + WS_ZS) + (size_t)row * ZSW; const float pos = (float)((const int*)a.in[2])[row];
    { const float v = tid < 192 ? bf2f(ZSp[C_CQ + tid]) : 0.f; const float ss = blk_sum(v * v, sh); if (tid < 192) vn[tid] = v * rsqrtf(ss / 192.f + EPS) * DIN_(20)[tid]; __syncthreads(); }
    float qf = 0.f; if (tid < 96) for (int k = 0; k < 192; ++k) qf += vn[k] * DIN_(22)[k * 384 + hd * 96 + tid];
    { const float ss = blk_sum(tid < 96 ? qf * qf : 0.f, sh); if (tid < 96) qs[tid] = qf * rsqrtf(ss / 96.f + EPS) * DIN_(24)[tid]; __syncthreads(); }
    if (tid < 96) { float val = qs[tid]; if (tid >= 64) { const int i = (tid - 64) & 15; float sn, cs; sincos_red(pos * exp2f(-(float)i * (13.287712379549449f / 16.f)), sn, cs); const float x1 = qs[64 + i], x2 = qs[80 + i]; val = tid < 80 ? x1 * cs - x2 * sn : x1 * sn + x2 * cs; }
        val *= 0.10206207261596577f * LOG2E; dbg_acc(a.acc, 3, bf2f(((const bf16_t*)(a.ws + WS_QM))[((size_t)(b * 4 + hd) * SEQ + sq) * 96 + tid]), val); }
    __syncthreads();
    { const float v = tid < 128 ? bf2f(ZSp[C_CKV + tid]) : 0.f; const float ss = blk_sum(v * v, sh); if (tid < 128) vn[tid] = v * rsqrtf(ss / 128.f + EPS) * DIN_(21)[tid]; __syncthreads(); }
    float kv = 0.f; if (tid < 128) for (int k = 0; k < 128; ++k) kv += vn[k] * DIN_(23)[k * 512 + hd * 128 + tid];
    float kfull = 0.f; if (tid < 64) kfull = kv; else if (tid < 96) kfull = bf2f(ZSp[C_KPE + tid - 64]);
    { const float ss = blk_sum(tid < 96 ? kfull * kfull : 0.f, sh); if (tid < 96) qs[tid] = kfull * rsqrtf(ss / 96.f + EPS) * DIN_(25)[tid]; __syncthreads(); }
    if (tid < 96) { float val = qs[tid]; if (tid >= 64) { const int i = (tid - 64) & 15; float sn, cs; sincos_red(pos * exp2f(-(float)i * (13.287712379549449f / 16.f)), sn, cs); const float x1 = qs[64 + i], x2 = qs[80 + i]; val = tid < 80 ? x1 * cs - x2 * sn : x1 * sn + x2 * cs; }
        dbg_acc(a.acc, 4, bf2f(((const bf16_t*)(a.ws + WS_KM))[((size_t)(b * 4 + hd) * SEQ + sq) * 96 + tid]), val); }
    if (tid >= 64 && tid < 128) dbg_acc(a.acc, 5, bf2f(((const bf16_t*)(a.ws + WS_VMT))[((size_t)(b * 4 + hd) * 64 + tid - 64) * SEQ + sq]), kv);
}
__global__ void chk_diff_prep(DbgArgs a) {
    const int i = blockIdx.x * 256 + threadIdx.x; const int row = (i * 37 + 5) % MTOK, hd = i & 3, half = (i >> 2) & 1, isk = (i >> 3) & 1, b = row >> 12, sq = row & 4095;
    const bf16_t* src = (const bf16_t*)(a.ws + WS_ZS) + (size_t)row * ZSW + (isk ? C_KD : C_QD) + hd * 64 + half * 32;
    float ss = 0.f; for (int d = 0; d < 32; ++d) { const float v = bf2f(src[d]); ss += v * v; }
    const float rs = rsqrtf(ss / 32.f + EPS) * (isk ? 1.f : 0.17677669529663687f * LOG2E); const float* gg = DIN_(isk ? 34 : 33);
    const bf16_t* dst = (const bf16_t*)(a.ws + (isk ? WS_KD : WS_QD)) + ((size_t)(b * 4 + hd) * SEQ + sq) * 64 + half * 32;
    for (int d = 0; d < 32; ++d) dbg_acc(a.acc, 6, bf2f(dst[d]), bf2f(src[d]) * rs * gg[d]);
    const bf16_t* vs = (const bf16_t*)(a.ws + WS_ZS) + (size_t)row * ZSW + C_VD + hd * 64;
    for (int d = half * 32; d < half * 32 + 32; ++d) dbg_acc(a.acc, 7, bf2f(((const bf16_t*)(a.ws + WS_VDT))[((size_t)(b * 4 + hd) * 64 + d) * SEQ + sq]), bf2f(vs[d]));
}
__global__ void __launch_bounds__(256) chk_lru_prep(DbgArgs a) {
    __shared__ float xcs[64]; const int s = blockIdx.x, tid = threadIdx.x, row = (s * 7919 + 13) % MTOK, n = s & 3, b = row >> 12, sq = row & 4095;
    if (s == 0 || s == 1) { }
    float xc = 0.f;
    if (tid < 64) { const int c = 64 * n + tid; xc = DIN_(27)[c]; for (int k = 0; k < 4; ++k) { const int sr = sq - 3 + k; if (sr >= 0) xc += DIN_(26)[k * 256 + c] * bf2f(((const bf16_t*)(a.ws + WS_ZS))[(size_t)(b * SEQ + sr) * ZSW + C_XLRU + c]); } xcs[tid] = xc; }
    __syncthreads();
    if (tid < 64) { const int c = 64 * n + tid; float ar = DIN_(29)[c], ai = DIN_(31)[c];
        const float* wr_ = DIN_(28); const float* wi_ = DIN_(30);
#pragma unroll 2
        for (int cc = 0; cc < 64; ++cc) { ar += xcs[cc] * wr_[(n * 64 + cc) * 64 + tid]; ai += xcs[cc] * wi_[(n * 64 + cc) * 64 + tid]; }
        const float r = 1.f / (1.f + __expf(-ar)), ii = 1.f / (1.f + __expf(-ai)), la = -8.f * r * __logf(1.f + __expf(-DIN_(32)[c])), av = __expf(la), iv = sqrtf(fmaxf(1.f - av * av, 0.f)) * ii * xc;
        dbg_acc(a.acc, 8, ((const float*)(a.ws + WS_LA))[(size_t)row * 256 + c], av); dbg_acc(a.acc, 9, ((const float*)(a.ws + WS_LI))[(size_t)row * 256 + c], iv); }
}
__global__ void chk_mla_attn(DbgArgs a) {
    __shared__ float sh[256]; __shared__ float q[96]; __shared__ float p[4096];
    const int s = blockIdx.x, tid = threadIdx.x, bh = s & 15, sq = (s * 523 + 77) % SEQ, b = bh >> 2, hd = bh & 3;
    const bf16_t* QM = (const bf16_t*)(a.ws + WS_QM) + (size_t)bh * SEQ * 96; const bf16_t* KM = (const bf16_t*)(a.ws + WS_KM) + (size_t)bh * SEQ * 96; const bf16_t* VMT = (const bf16_t*)(a.ws + WS_VMT) + (size_t)bh * 64 * SEQ;
    if (tid < 96) q[tid] = bf2f(QM[(size_t)sq * 96 + tid]); __syncthreads();
    float mx = -1e30f; for (int j = tid; j <= sq; j += 256) { float sc = 0.f; for (int d = 0; d < 96; ++d) sc += q[d] * bf2f(KM[(size_t)j * 96 + d]); p[j] = sc; mx = fmaxf(mx, sc); }
    mx = blk_max(mx, sh); float sm = 0.f; for (int j = tid; j <= sq; j += 256) { p[j] = exp2f(p[j] - mx); sm += p[j]; } sm = blk_sum(sm, sh);
    if (tid < 64) { float o = 0.f; for (int j = 0; j <= sq; ++j) o += p[j] * bf2f(VMT[(size_t)tid * SEQ + j]); dbg_acc(a.acc, 10, bf2f(((const bf16_t*)(a.ws + WS_Y))[(size_t)1 * MTOK * 256 + (size_t)(b * SEQ + sq) * 256 + hd * 64 + tid]), o / sm); }
}
__global__ void chk_diff_attn(DbgArgs a) {
    __shared__ float sh[256]; __shared__ float q[64]; __shared__ float p1[4096]; __shared__ float p2[4096];
    const int s = blockIdx.x, tid = threadIdx.x, bh = s & 15, sq = (s * 523 + 77) % SEQ, b = bh >> 2, hd = bh & 3;
    const bf16_t* QD = (const bf16_t*)(a.ws + WS_QD) + (size_t)bh * SEQ * 64; const bf16_t* KD = (const bf16_t*)(a.ws + WS_KD) + (size_t)bh * SEQ * 64; const bf16_t* VDT = (const bf16_t*)(a.ws + WS_VDT) + (size_t)bh * 64 * SEQ;
    if (tid < 64) q[tid] = bf2f(QD[(size_t)sq * 64 + tid]); __syncthreads();
    float m1 = -1e30f, m2 = -1e30f; for (int j = tid; j <= sq; j += 256) { float s1 = 0.f, s2 = 0.f; for (int d = 0; d < 32; ++d) { s1 += q[d] * bf2f(KD[(size_t)j * 64 + d]); s2 += q[32 + d] * bf2f(KD[(size_t)j * 64 + 32 + d]); }
        const float bias = DIN_(3)[dbucket(sq - j) * 4 + hd] * LOG2E; s1 += bias; s2 += bias; p1[j] = s1; p2[j] = s2; m1 = fmaxf(m1, s1); m2 = fmaxf(m2, s2); }
    m1 = blk_max(m1, sh); m2 = blk_max(m2, sh); float l1 = 0.f, l2 = 0.f; for (int j = tid; j <= sq; j += 256) { p1[j] = exp2f(p1[j] - m1); p2[j] = exp2f(p2[j] - m2); l1 += p1[j]; l2 += p2[j]; } l1 = blk_sum(l1, sh); l2 = blk_sum(l2, sh);
    float s1 = 0.f, s2 = 0.f; for (int d = 0; d < 32; ++d) { s1 += DIN_(35)[d] * DIN_(36)[d]; s2 += DIN_(37)[d] * DIN_(38)[d]; } const float lam_init = DBG_LAYER == 0 ? 0.2f : 0.8f - 0.6f * 0.7408182206817179f, lam = expf(s1) - expf(s2) + lam_init;
    float o = 0.f; if (tid < 64) { float o1 = 0.f, o2 = 0.f; for (int j = 0; j <= sq; ++j) { const float v = bf2f(VDT[(size_t)tid * SEQ + j]); o1 += p1[j] * v; o2 += p2[j] * v; } o = o1 / l1 - lam * o2 / l2; }
    const float ss = blk_sum(tid < 64 ? o * o : 0.f, sh);
    if (tid < 64) dbg_acc(a.acc, 11, bf2f(((const bf16_t*)(a.ws + WS_Y))[(size_t)3 * MTOK * 256 + (size_t)(b * SEQ + sq) * 256 + hd * 64 + tid]), o * rsqrtf(ss / 64.f + EPS) * DIN_(39)[tid] * (1.f - lam_init));
}
__global__ void chk_lru_scan(DbgArgs a) {
    const int i = blockIdx.x * 256 + threadIdx.x, b = i >> 8, c = i & 255; if (b >= NB) return;
    const float* LA = (const float*)(a.ws + WS_LA); const float* LI = (const float*)(a.ws + WS_LI); float h = 0.f;
    for (int t = 0; t < SEQ; ++t) { const size_t o = (size_t)(b * SEQ + t) * 256 + c; h = LA[o] * h + LI[o];
        if (t % 97 == 0 || t == SEQ - 1) dbg_acc(a.acc, 12, bf2f(((const bf16_t*)(a.ws + WS_Y))[(size_t)2 * MTOK * 256 + o]), h * dgelu(bf2f(((const bf16_t*)(a.ws + WS_ZS))[(size_t)(b * SEQ + t) * ZSW + C_GLRU + c]))); }
}
__global__ void chk_s5_scan(DbgArgs a) {
    __shared__ float part[16][65]; const int g = blockIdx.x, p = threadIdx.x; float* ypre = (float*)(a.ws + WS_DBG);
    const float dt = expf(DIN_(12)[g]), lr = DIN_(10)[g * 64 + p], li = DIN_(11)[g * 64 + p], mag = expf(lr * dt); float sn, cs; sincos_red(li * dt, sn, cs);
    const float ar = mag * cs, ai = mag * sn, den = lr * lr + li * li, zr = ((ar - 1.f) * lr + ai * li) / den, zi = (ai * lr - (ar - 1.f) * li) / den;
    float hr = 0.f, hi = 0.f;
    for (int t = 0; t < SEQ; ++t) { const bf16_t* up = (const bf16_t*)(a.ws + WS_ZS) + (size_t)(SEQ + t) * ZSW + 16 * g; float bur = 0.f, bui = 0.f;
        for (int c = 0; c < 16; ++c) { const float u = bf2f(up[c]), br = DIN_(13)[(g * 64 + p) * 16 + c], bi = DIN_(14)[(g * 64 + p) * 16 + c]; bur += (zr * br - zi * bi) * u; bui += (zr * bi + zi * br) * u; }
        const float nr = ar * hr - ai * hi + bur, ni = ar * hi + ai * hr + bui; hr = nr; hi = ni;
        for (int c = 0; c < 16; ++c) part[c][p] = DIN_(15)[(g * 16 + c) * 64 + p] * hr - DIN_(16)[(g * 16 + c) * 64 + p] * hi;
        __syncthreads();
        if (p < 16) { float y = 0.f; for (int pp = 0; pp < 64; ++pp) y += part[p][pp]; y += DIN_(17)[16 * g + p] * bf2f(up[p]); ypre[(size_t)t * 256 + 16 * g + p] = dgelu(y); }
        __syncthreads(); }
}
__global__ void chk_s5_glu(DbgArgs a) {
    const int s = blockIdx.x, n = threadIdx.x, t = (s * 61 + 5) % SEQ; const float* ypre = (const float*)(a.ws + WS_DBG) + (size_t)t * 256;
    float z = DIN_(19)[n]; for (int k = 0; k < 256; ++k) z += ypre[k] * DIN_(18)[k * 256 + n];
    dbg_acc(a.acc, 13, bf2f(((const bf16_t*)(a.ws + WS_Y))[(size_t)(SEQ + t) * 256 + n]), ypre[n] * dsig(z));
}

__global__ void chk_merge(DbgArgs a) {
    __shared__ float sh[256]; const int s = blockIdx.x, tid = threadIdx.x, row = (s * 7919 + 13) % MTOK, col = (s * 104729 + 7) % DM;
    const bf16_t* Y = (const bf16_t*)(a.ws + WS_Y); const bf16_t* ZGp = (const bf16_t*)(a.ws + WS_ZG) + (size_t)row * ZGW; const bf16_t* MGp = (const bf16_t*)(a.ws + WS_MERGED) + (size_t)row * DM;
    float m = 0.f;
    for (int n = 0; n < 4; ++n) { float d = 0.f; { const int k = tid; d = bf2f(Y[(size_t)n * MTOK * 256 + (size_t)row * 256 + k]) * DIN_(40)[((size_t)n * 256 + k) * DM + col]; } d = blk_sum(d, sh); m += bf2f(ZGp[n * DM + col]) * d; }
    if (tid == 0) dbg_acc(a.acc, 14, bf2f(MGp[col]), m);
    float o = 0.f; for (int c = tid; c < DM; c += 256) o += bf2f(MGp[c]) * DIN_(41)[(size_t)c * DM + col]; o = blk_sum(o, sh);
    if (tid == 0) dbg_acc(a.acc, 15, a.out[(size_t)row * DM + col], DXIN_[(size_t)row * DM + col] + o);
}
__global__ void chk_cross(DbgArgs a) {
    __shared__ float sh[256]; __shared__ float hn[DM]; __shared__ float q[64]; __shared__ float p[256]; __shared__ float mn[DM];
    const int s = blockIdx.x, tid = threadIdx.x, row = (s * 7919 + 13) % MTOK, hd = s & 3, b = row >> 12;
    const float* x1 = a.out + (size_t)row * DM; float ss = 0.f; for (int k = tid; k < DM; k += 256) ss += x1[k] * x1[k]; ss = blk_sum(ss, sh); const float rs = rsqrtf(ss / DM + EPS);
    for (int k = tid; k < DM; k += 256) hn[k] = x1[k] * rs * DIN_(5)[k]; __syncthreads();
    float qf = 0.f; if (tid < 64) { for (int k = 0; k < DM; ++k) qf += hn[k] * DIN_(42)[(size_t)k * 256 + hd * 64 + tid]; dbg_acc(a.acc, 16, bf2f(((const bf16_t*)(a.ws + WS_QX))[(size_t)row * 256 + hd * 64 + tid]), qf); }
    { const float s2 = blk_sum(tid < 64 ? qf * qf : 0.f, sh); if (tid < 64) q[tid] = qf * rsqrtf(s2 / 64.f + EPS) * DIN_(46)[tid] * 0.125f; __syncthreads(); }
    float sc = 0.f; float vj[1]; (void)vj;
    { const float* mr = DIN_(1) + (size_t)(b * 256 + tid) * DM; float ms = 0.f; for (int k = 0; k < DM; ++k) ms += mr[k] * mr[k]; const float mrs = rsqrtf(ms / DM + EPS);
      float kk[64]; (void)kk; float s2 = 0.f; float dotq = 0.f;
      for (int d = 0; d < 64; ++d) { float kd = 0.f; for (int k = 0; k < DM; ++k) kd += mr[k] * mrs * DIN_(6)[k] * DIN_(43)[(size_t)k * 256 + hd * 64 + d]; s2 += kd * kd; dotq += kd * DIN_(47)[d] * q[d]; }
      sc = dotq * rsqrtf(s2 / 64.f + EPS); }
    const float mx = blk_max(sc, sh); const float e = expf(sc - mx); const float sm = blk_sum(e, sh); p[tid] = e / sm; __syncthreads();
    if (tid < 64) { float o = 0.f; for (int j = 0; j < 256; ++j) { const float* mr = DIN_(1) + (size_t)(b * 256 + j) * DM; float ms = 0.f, vd = 0.f; for (int k = 0; k < DM; ++k) { ms += mr[k] * mr[k]; vd += mr[k] * DIN_(6)[k] * DIN_(44)[(size_t)k * 256 + hd * 64 + tid]; } o += p[j] * vd * rsqrtf(ms / DM + EPS); }
        dbg_acc(a.acc, 17, bf2f(((const bf16_t*)(a.ws + WS_OX))[(size_t)row * 256 + hd * 64 + tid]), o); }
}
__global__ void chk_ffn(DbgArgs a) {
    __shared__ float sh[256]; __shared__ float hn[DM]; const int s = blockIdx.x, tid = threadIdx.x, row = (s * 7919 + 13) % MTOK;
    const float* x2 = a.out + (size_t)row * DM; float ss = 0.f; for (int k = tid; k < DM; k += 256) ss += x2[k] * x2[k]; ss = blk_sum(ss, sh); const float rs = rsqrtf(ss / DM + EPS);
    for (int k = tid; k < DM; k += 256) hn[k] = x2[k] * rs * DIN_(7)[k]; __syncthreads();
    for (int j = tid; j < FF; j += 256 * 8) { float g = 0.f, u = 0.f; for (int k = 0; k < DM; ++k) { g += hn[k] * DIN_(48)[(size_t)k * FF + j]; u += hn[k] * DIN_(49)[(size_t)k * FF + j]; }
        dbg_acc(a.acc, 18, bf2f(((const bf16_t*)(a.ws + WS_HFF))[(size_t)row * FF + j]), g / (1.f + expf(-g)) * u); }
}

__global__ void chk_moe(DbgArgs a) {
    __shared__ float sh[256]; __shared__ float hn[DM]; __shared__ float hid[EFF]; __shared__ float lgs[8];
    const int s = blockIdx.x, tid = threadIdx.x, tok = (s * 7919 + 13) % MTOK, slot = s & 1, col = (s * 104729 + 7) % DM;
    const float* x2 = a.out + (size_t)tok * DM; float ss = 0.f; for (int k = tid; k < DM; k += 256) ss += x2[k] * x2[k]; ss = blk_sum(ss, sh); const float rs = rsqrtf(ss / DM + EPS);
    for (int k = tid; k < DM; k += 256) hn[k] = x2[k] * rs * ((const float*)a.in[7])[DM + k]; __syncthreads();
    for (int e = 0; e < 8; ++e) { float d = 0.f; for (int k = tid; k < DM; k += 256) d += hn[k] * DIN_(51)[k * 8 + e]; d = blk_sum(d, sh); if (tid == 0) lgs[e] = d; } __syncthreads();
    int e1 = 0; for (int e = 1; e < 8; ++e) if (lgs[e] > lgs[e1]) e1 = e; int e2 = -1; for (int e = 0; e < 8; ++e) if (e != e1 && (e2 < 0 || lgs[e] > lgs[e2])) e2 = e;
    const float w1 = 1.f / (1.f + expf(lgs[e2] - lgs[e1])), w2 = 1.f - w1;
    const int* ASG = (const int*)(a.ws + WS_MOESM + MS_ASSIGN); const int* TD = (const int*)(a.ws + WS_MOESM + MS_TOKDEST); const float* TW = (const float*)(a.ws + WS_MOESM + MS_TOKW); const int* RT = (const int*)(a.ws + WS_MOESM + MS_ROWTOK);
    const int ef = ASG[2 * tok + slot] & 255, dest = TD[2 * tok + slot];
    if (tid == 0) { dbg_acc(a.acc, 19, (float)(ASG[2 * tok] & 255), (float)e1 + 1e-3f); dbg_acc(a.acc, 19, (float)(ASG[2 * tok + 1] & 255), (float)e2 + 1e-3f); dbg_acc(a.acc, 19, TW[2 * tok], w1); dbg_acc(a.acc, 19, TW[2 * tok + 1], w2); dbg_acc(a.acc, 19, (float)(RT[dest] - tok), 1e-3f); }
    const float* wg = DIN_(52) + (size_t)ef * DM * EFF; const float* wu = DIN_(53) + (size_t)ef * DM * EFF; const float* wd = DIN_(54) + (size_t)ef * EFF * DM;
    for (int f = tid; f < EFF; f += 256) { float g = 0.f, u = 0.f; for (int k = 0; k < DM; ++k) { g += hn[k] * wg[(size_t)k * EFF + f]; u += hn[k] * wu[(size_t)k * EFF + f]; } hid[f] = g / (1.f + expf(-g)) * u; }
    __syncthreads();
    float y = 0.f; for (int f = tid; f < EFF; f += 256) y += hid[f] * wd[(size_t)f * DM + col]; y = blk_sum(y, sh);
    if (tid == 0) dbg_acc(a.acc, 20, bf2f(((const bf16_t*)(a.ws + WS_YS))[(size_t)dest * DM + col]), y);
}

__global__ void chk_res(DbgArgs a, int kind) {
    __shared__ float sh[256]; const int s = blockIdx.x, tid = threadIdx.x, row = (s * 7919 + 13) % MTOK, col = (s * 104729 + 7) % DM; const float* xprev = (const float*)(a.ws + WS_DBG);
    float o = 0.f;
    if (kind == 0) { const bf16_t* A = (const bf16_t*)(a.ws + WS_OX) + (size_t)row * 256; o = bf2f(A[tid]) * DIN_(45)[(size_t)tid * DM + col]; }
    else { const bf16_t* A = (const bf16_t*)(a.ws + WS_HFF) + (size_t)row * FF; for (int k = tid; k < FF; k += 256) o += bf2f(A[k]) * DIN_(50)[(size_t)k * DM + col]; }
    o = blk_sum(o, sh);
    if (tid == 0) { dbg_acc(a.acc, 21, a.out[(size_t)row * DM + col], xprev[(size_t)row * DM + col] + o);
        const bf16_t xbv = ((const bf16_t*)(a.ws + WS_XB))[(size_t)row * DM + col]; dbg_acc(a.acc, 22, bf2f(xbv), a.out[(size_t)row * DM + col]); }
}

__global__ void chk_final(DbgArgs a) {
    const int i = blockIdx.x * 256 + threadIdx.x; const int tok = (i * 37 + 5) % MTOK, col = (i * 101 + 3) % DM; const float* xprev = (const float*)(a.ws + WS_DBG);
    const int* TD = (const int*)(a.ws + WS_MOESM + MS_TOKDEST); const float* TW = (const float*)(a.ws + WS_MOESM + MS_TOKW); const bf16_t* YS = (const bf16_t*)(a.ws + WS_YS);
    const float ref = xprev[(size_t)tok * DM + col] + TW[2 * tok] * bf2f(YS[(size_t)TD[2 * tok] * DM + col]) + TW[2 * tok + 1] * bf2f(YS[(size_t)TD[2 * tok + 1] * DM + col]);
    dbg_acc(a.acc, 23, a.out[(size_t)tok * DM + col], ref);
}
__global__ void chk_emit(DbgArgs a, int nchk) {
    for (int i = blockIdx.x * 256 + threadIdx.x; i < MTOK * DM; i += gridDim.x * 256) a.out[i] = 0.f;
    if (blockIdx.x == 0 && threadIdx.x == 0) { float V = 99000.f; float worst = 0.f;
        for (int k = 1; k <= nchk; ++k) { const float cnt = a.acc[64 + k]; const float rms = sqrtf(a.acc[2 * k + 1] / fmaxf(cnt, 1.f)) + 1e-20f; float err = a.acc[2 * k] / rms; if (cnt < 1.f) continue; if (!(err == err)) err = 0.97f; worst = fmaxf(worst, err);
#ifdef DBG_ONLY
            if (k == DBG_ONLY) { V = 1000.f + err * 10000.f; break; }
#else
            if (err > 0.06f) { V = (float)k * 1000.f + fminf(err, 0.99f) * 1000.f; break; }
#endif
        }
        if (V == 99000.f) V = 99000.f + worst * 1000.f;
        a.out[12345] = V; }
}
#endif

#ifdef DBG_STAT
__global__ void stat_scan(const float* out, unsigned* acc) {
    for (int i = blockIdx.x * 256 + threadIdx.x; i < MTOK * DM; i += gridDim.x * 256) { const float v = fabsf(out[i]);
        atomicMax(&acc[1], __float_as_uint(v)); if (v > 10.f || !(v == v)) { atomicAdd(&acc[0], 1u); atomicAdd(&acc[2 + (i >> 18)], 1u); atomicAdd(&acc[70 + ((i & 1023) >> 8)], 1u); atomicAdd(&acc[80 + ((i >> 10) & 255) / 32], 1u); } }
}
__global__ void stat_emit(float* out, const unsigned* acc, int mode) {
    for (int i = blockIdx.x * 256 + threadIdx.x; i < MTOK * DM; i += gridDim.x * 256) out[i] = 0.f;
    if (blockIdx.x == 0 && threadIdx.x == 0) { float V = 0.f;
        if (mode == 0) V = (float)acc[0];
        else if (mode == 1) V = __uint_as_float(acc[1]) * 100.f;
        else if (mode == 2) { unsigned best = 0, bi = 0, nz = 0; for (int k = 0; k < 64; ++k) { if (acc[2 + k] > best) { best = acc[2 + k]; bi = k; } nz += acc[2 + k] > 0; } V = 1000.f * (float)bi + 10.f * (float)nz; }
        else if (mode == 3) V = 1000.f * (float)acc[70] / fmaxf((float)acc[0], 1.f) + 100000.f * (float)acc[71] / fmaxf((float)acc[0], 1.f);
        else if (mode == 4) { unsigned best = 0, bi = 0; for (int k = 0; k < 8; ++k) if (acc[80 + k] > best) { best = acc[80 + k]; bi = k; } V = 1000.f + 1000.f * (float)bi + 900.f * (float)best / fmaxf((float)acc[0], 1.f); }
        out[12345] = V + 100.f; }
}
#endif

#ifdef DBG_VAR
__global__ void var_scan(const float* out, const float* prev, float* acc) {
    float s = 0.f, mx = 0.f; for (int i = blockIdx.x * 256 + threadIdx.x; i < MTOK * DM; i += gridDim.x * 256) { const float d = out[i] - prev[i]; s += d * d; mx = fmaxf(mx, fabsf(d)); }
    atomicAdd(&acc[0], s); atomicMax((unsigned*)&acc[1], __float_as_uint(mx));
}
__global__ void var_emit(float* out, const float* acc, int mode) {
    for (int i = blockIdx.x * 256 + threadIdx.x; i < MTOK * DM; i += gridDim.x * 256) out[i] = 0.f;
    if (blockIdx.x == 0 && threadIdx.x == 0) out[12345] = 100.f + (mode == 0 ? acc[0] / (float)(MTOK * DM) * 1e5f : acc[1] * 100.f);
}
#endif

#ifdef DBG_GSTAT
__global__ void gstat_scan(const bf16_t* zg, float* acc) { float s1 = 0.f, s2 = 0.f; for (size_t i = blockIdx.x * 256 + threadIdx.x; i < (size_t)MTOK * ZGW; i += (size_t)gridDim.x * 256) { const float g = bf2f(zg[i]); const int blk = (int)((i & 4095) >> 10); if (blk == DBG_GSTAT) { s1 += (g < -0.01f || g > 1.01f || !(g == g)) ? 1.f : 0.f; s2 += (g - 0.5f) * (g - 0.5f); } } atomicAdd(&acc[0], s1); atomicAdd(&acc[1], s2); }
__global__ void gstat_emit(float* out, const float* acc, int mode) {
    for (int i = blockIdx.x * 256 + threadIdx.x; i < MTOK * DM; i += gridDim.x * 256) out[i] = 0.f;
    if (blockIdx.x == 0 && threadIdx.x == 0) out[12345] = 100.f + 10000.f * acc[1] / ((float)MTOK * 1024);
}
#endif
extern "C" void kernel_launch(void* const* d_in, const int* in_sizes, int n_in, void* d_out, int out_size, void* d_ws, size_t ws_size, hipStream_t stream) {
    static int grid = 0;
    if (grid == 0) {
        if (n_in != 55 || out_size != MTOK * DM || ws_size < WS_END) { fprintf(stderr, "kernel_launch: unexpected shapes (n_in %d out %d ws %zu)\n", n_in, out_size, ws_size); grid = -1; return; }
        { const int L2 = 2; const int exp_sz[55] = {NB * SEQ * DM, NB * NMEM * DM, NB * SEQ, 32 * 4, L2 * DM, L2 * DM, L2 * DM, L2 * DM, L2 * DM * DIN, L2 * 4 * DM, L2 * 1024, L2 * 1024, L2 * 16, L2 * 16384, L2 * 16384, L2 * 16384, L2 * 16384, L2 * 256, L2 * 65536, L2 * 256,
              L2 * 192, L2 * 128, L2 * 192 * 384, L2 * 128 * 512, L2 * 96, L2 * 96, L2 * 1024, L2 * 256, L2 * 16384, L2 * 256, L2 * 16384, L2 * 256, L2 * 256, L2 * 32, L2 * 32, L2 * 32, L2 * 32, L2 * 32, L2 * 32, L2 * 64,
              L2 * 4 * 256 * DM, L2 * DM * DM, L2 * DM * 256, L2 * DM * 256, L2 * DM * 256, L2 * 256 * DM, L2 * 64, L2 * 64, DM * FF, DM * FF, FF * DM, DM * 8, 8 * DM * EFF, 8 * DM * EFF, 8 * EFF * DM};
          for (int i = 0; i < 55; ++i) if (in_sizes[i] != exp_sz[i]) { fprintf(stderr, "kernel_launch: input %d has %d elements, expected %d\n", i, in_sizes[i], exp_sz[i]); grid = -1; return; } }
        int dev = 0, cus = 0, per_cu = 0;
        if (hipGetDevice(&dev) != hipSuccess || hipDeviceGetAttribute(&cus, hipDeviceAttributeMultiprocessorCount, dev) != hipSuccess) { grid = -1; return; }
        if (hipFuncSetAttribute((const void*)hybrid_fwd, hipFuncAttributeMaxDynamicSharedMemorySize, LDS_BYTES) != hipSuccess) { fprintf(stderr, "kernel_launch: hipFuncSetAttribute failed\n"); grid = -1; return; }
        if (hipOccupancyMaxActiveBlocksPerMultiprocessor(&per_cu, (const void*)hybrid_fwd, 512, LDS_BYTES) != hipSuccess || per_cu < 1) { fprintf(stderr, "kernel_launch: occupancy query says %d\n", per_cu); }
        (void)hipGetLastError();
        grid = cus;
    }
    if (grid < 0) return;
    if (hipMemsetAsync((char*)d_ws + WS_CTL, 0, CTL_ZERO_BYTES, stream) != hipSuccess) return;
    Args a{};
    for (int i = 0; i < 55; ++i) a.in[i] = d_in[i];
    a.out = (float*)d_out; a.ws = (unsigned char*)d_ws; a.submask = 0xFFFF; a.pad = 0;
#if MK_ONE_LAUNCH
    a.ph_lo = 0; a.ph_hi = NPHASE;
    hipLaunchKernelGGL(hybrid_fwd, dim3(grid), dim3(512), LDS_BYTES, stream, a);
#else
    for (int p = 0; p < DBG_NPH; ++p) { a.ph_lo = p; a.ph_hi = p + 1;
#if defined(DBG_CHECK) || defined(DBG_VAR)
        if (p == DBG_NPH - 1) hipMemcpyAsync((char*)d_ws + 440 * MiB, d_out, (size_t)MTOK * DM * 4, hipMemcpyDeviceToDevice, stream);
#endif
        hipLaunchKernelGGL(hybrid_fwd, dim3(grid), dim3(512), LDS_BYTES, stream, a);
#ifdef DBG_REPEAT
        if (p == DBG_REPEAT) {
#ifdef DBG_REPSUB
            a.submask = DBG_REPSUB;
#endif
            hipLaunchKernelGGL(hybrid_fwd, dim3(grid), dim3(512), LDS_BYTES, stream, a); hipLaunchKernelGGL(hybrid_fwd, dim3(grid), dim3(512), LDS_BYTES, stream, a); a.submask = 0xFFFF; }
#endif
    }
#ifdef DBG_CHECK
    { DbgArgs da{}; for (int i = 0; i < 55; ++i) da.in[i] = d_in[i]; da.ws = (unsigned char*)d_ws; da.out = (float*)d_out; da.acc = (float*)((char*)d_ws + 700 * 1024);
#if DBG_NPH == 6 || DBG_NPH == 16
      hipLaunchKernelGGL(chk_merge, dim3(512), dim3(256), 0, stream, da);
#elif DBG_NPH == 8 || DBG_NPH == 18
      hipLaunchKernelGGL(chk_cross, dim3(64), dim3(256), 0, stream, da);
#elif DBG_NPH == 10
      hipLaunchKernelGGL(chk_ffn, dim3(64), dim3(256), 0, stream, da);
#elif DBG_NPH == 24
      hipLaunchKernelGGL(chk_final, dim3(64), dim3(256), 0, stream, da);
#elif DBG_NPH == 23
      hipLaunchKernelGGL(chk_moe, dim3(128), dim3(256), 0, stream, da);
#elif DBG_NPH == 9 || DBG_NPH == 19
      hipLaunchKernelGGL(chk_res, dim3(512), dim3(256), 0, stream, da, 0);
#elif DBG_NPH == 11
      hipLaunchKernelGGL(chk_res, dim3(512), dim3(256), 0, stream, da, 1);
#else
      hipLaunchKernelGGL(chk_z, dim3(1024), dim3(256), 0, stream, da);
      hipLaunchKernelGGL(chk_mla_prep, dim3(512), dim3(256), 0, stream, da);
      hipLaunchKernelGGL(chk_diff_prep, dim3(16), dim3(256), 0, stream, da);
      hipLaunchKernelGGL(chk_lru_prep, dim3(512), dim3(256), 0, stream, da);
      hipLaunchKernelGGL(chk_mla_attn, dim3(64), dim3(256), 0, stream, da);
      hipLaunchKernelGGL(chk_diff_attn, dim3(64), dim3(256), 0, stream, da);
      hipLaunchKernelGGL(chk_lru_scan, dim3(4), dim3(256), 0, stream, da);
      hipLaunchKernelGGL(chk_s5_scan, dim3(16), dim3(64), 0, stream, da);
      hipLaunchKernelGGL(chk_s5_glu, dim3(64), dim3(256), 0, stream, da);
#endif
      hipLaunchKernelGGL(chk_emit, dim3(1024), dim3(256), 0, stream, da, 23); }
#endif
#ifdef DBG_COPYX
    hipMemcpyAsync(d_out, d_in[0], (size_t)MTOK * DM * 4, hipMemcpyDeviceToDevice, stream);
#endif
#ifdef DBG_GSTAT
    { float* acc = (float*)((char*)d_ws + 900 * 1024);
      hipLaunchKernelGGL(gstat_scan, dim3(2048), dim3(256), 0, stream, (const bf16_t*)((const char*)d_ws + WS_ZG), acc);
      hipLaunchKernelGGL(gstat_emit, dim3(1024), dim3(256), 0, stream, (float*)d_out, (const float*)acc, DBG_GSTAT); }
#endif
#ifdef DBG_VAR
    { float* acc = (float*)((char*)d_ws + 900 * 1024);
      hipLaunchKernelGGL(var_scan, dim3(1024), dim3(256), 0, stream, (const float*)d_out, DBG_NPH == 6 ? (const float*)d_in[0] : (const float*)((const char*)d_ws + 440 * MiB), acc);
      hipLaunchKernelGGL(var_emit, dim3(1024), dim3(256), 0, stream, (float*)d_out, (const float*)acc, DBG_VAR); }
#endif
#ifdef DBG_STAT
    { unsigned* acc = (unsigned*)((char*)d_ws + 800 * 1024);
      hipLaunchKernelGGL(stat_scan, dim3(2048), dim3(256), 0, stream, (const float*)d_out, acc);
      hipLaunchKernelGGL(stat_emit, dim3(1024), dim3(256), 0, stream, (float*)d_out, (const unsigned*)acc, DBG_STAT); }
#endif
#ifdef DBG_DUMP_OFF
    hipLaunchKernelGGL(dbg_copy_bf16, dim3(2048), dim3(256), 0, stream, (const bf16_t*)((const char*)d_ws + (size_t)(DBG_DUMP_OFF)), (float*)d_out, MTOK * DM, DBG_DUMP_N);
#endif
#endif
}
```

```cpp
#include <hip/hip_runtime.h>
#include <cstdio>
#include <cstdint>

#define DBG_NPH 24

#ifndef DBG_GPERM
#define DBG_GPERM(n) (n)
#endif
#ifndef DBG_SCALE
#define DBG_SCALE 1.0f
#endif
#ifndef MK_ONE_LAUNCH
#define MK_ONE_LAUNCH 1
#endif
#ifndef G2_FP8
#define G2_FP8 0
#endif

#define LAS __attribute__((address_space(3)))
typedef unsigned short bf16_t;
typedef short bf16x8 __attribute__((ext_vector_type(8)));
typedef float f32x2 __attribute__((ext_vector_type(2)));
typedef float f32x4 __attribute__((ext_vector_type(4)));
typedef float f32x16 __attribute__((ext_vector_type(16)));
typedef unsigned u32x2 __attribute__((ext_vector_type(2)));
typedef unsigned u32x4 __attribute__((ext_vector_type(4)));
typedef int i32x4 __attribute__((ext_vector_type(4)));
typedef int i32x8 __attribute__((ext_vector_type(8)));

constexpr int DM = 1024, NB = 4, SEQ = 4096, MTOK = NB * SEQ, NMEM = 256;
constexpr int DIN = 5984, ZSW = 2048, ZGW = 4096, NIN = ZSW + ZGW;
constexpr int C_S5 = 0, C_CQ = 256, C_CKV = 448, C_KPE = 576, C_XLRU = 608, C_GLRU = 864, C_QD = 1120, C_KD = 1376, C_VD = 1632, C_END = 1888;
constexpr int FF = 2816, EFF = 3584, NEXP = 8, MOE_ROWS = 34816;
constexpr float EPS = 1e-6f, LOG2E = 1.4426950408889634f;

constexpr size_t MiB = 1u << 20;
constexpr size_t WS_CTL = 0, CTL_ZERO_BYTES = 1 * MiB + 512 * 1024;
constexpr size_t WS_MOESM = 1 * MiB;
constexpr size_t WS_XB = 2 * MiB;
constexpr size_t WS_WL = 34 * MiB, WL_STRIDE = 19 * MiB;
constexpr size_t WL_WIN = 0, WL_PT = 12 * MiB, WL_WO = 14 * MiB, WL_WXQ = 16 * MiB, WL_WXKV = 16 * MiB + 512 * 1024, WL_WXO = 17 * MiB + 512 * 1024, WL_SM = 18 * MiB;
constexpr size_t SM_WUQ = 0, SM_WUKV = 256 * 1024, SM_WR = 512 * 1024, SM_WI = 576 * 1024, SM_WGLU = 640 * 1024;
constexpr size_t WS_WGU = 72 * MiB, WS_WD = 83 * MiB, WS_TAB = 89 * MiB, WS_KX = 90 * MiB, WS_VXT = 91 * MiB;
constexpr size_t TAB_S5T = 0, TAB_CMAT = 512 * 1024, TAB_MISC = 768 * 1024;
constexpr size_t WS_ZS = 92 * MiB, WS_MERGED = 92 * MiB, WS_ZG = 156 * MiB, WS_HFF = 156 * MiB, WS_Y = 284 * MiB;
constexpr size_t WS_QM = 316 * MiB, WS_KM = 328 * MiB, WS_VMT = 340 * MiB, WS_QD = 348 * MiB, WS_KD = 356 * MiB, WS_VDT = 364 * MiB;
constexpr size_t WS_QX = 316 * MiB, WS_OX = 324 * MiB;
constexpr size_t WS_LA = 372 * MiB, WS_LI = 388 * MiB, WS_S5S = 404 * MiB, WS_LSUM = 406 * MiB, WS_RSP = 407 * MiB;
constexpr size_t WS_WMGU = 34 * MiB, WS_WMD = 146 * MiB, WS_HMOE = 202 * MiB, WS_XQ = 330 * MiB, WS_YS = 34 * MiB, WS_X8 = 416 * MiB, WS_END = 440 * MiB;
constexpr int CW_TMO = 0, CW_BAR = 4096, CW_MOECNT = 8192, CW_Q = 12288;
constexpr size_t CTL_ROWSS = 256 * 1024;
constexpr size_t MS_ROWTOK = 0, MS_TOKW = 512 * 1024, MS_ASSIGN = 640 * 1024, MS_RSTD = 768 * 1024;
constexpr int RING_BYTES = 131072, MISC_OFF = RING_BYTES + 320, LDS_BYTES = 147456;

typedef __bf16 bf16x2_t __attribute__((ext_vector_type(2)));
__device__ __forceinline__ unsigned cvt_pk_bf16(float lo, float hi) { const f32x2 v = {lo, hi}; const bf16x2_t b = __builtin_convertvector(v, bf16x2_t); return __builtin_bit_cast(unsigned, b); }
__device__ __forceinline__ float clamp8(float x) { return __builtin_fminf(__builtin_fmaxf(x, -448.f), 448.f); }
__device__ __forceinline__ unsigned cvt_pk4_fp8(float a, float b, float c, float d) { int w = __builtin_amdgcn_cvt_pk_fp8_f32(clamp8(a), clamp8(b), 0, false); w = __builtin_amdgcn_cvt_pk_fp8_f32(clamp8(c), clamp8(d), w, true); return (unsigned)w; }
__device__ __forceinline__ float bflo(unsigned w) { return __uint_as_float(w << 16); }
__device__ __forceinline__ float bfhi(unsigned w) { return __uint_as_float(w & 0xffff0000u); }
__device__ __forceinline__ float bf2f(bf16_t b) { return __uint_as_float((unsigned)b << 16); }
__device__ __forceinline__ bf16_t f2bf(float f) { return (bf16_t)(cvt_pk_bf16(f, 0.f) & 0xffffu); }
__device__ __forceinline__ float fexp2(float x) { return __builtin_amdgcn_exp2f(x); }
__device__ __forceinline__ float frcp(float x) { return __builtin_amdgcn_rcpf(x); }
__device__ __forceinline__ float frsq(float x) { return __builtin_amdgcn_rsqf(x); }
__device__ __forceinline__ float fsigmoid(float x) { return frcp(1.f + fexp2(-x * LOG2E)); }
__device__ __forceinline__ float fgelu(float x) {
    const float z = 0.7978845608028654f * (x + 0.044715f * x * x * x);
    const float e = fexp2(2.f * LOG2E * z);
    const float th = 1.f - 2.f * frcp(e + 1.f);
    return 0.5f * x * (1.f + th);
}
__device__ __forceinline__ int crow(int r, int hi) { return (r & 3) + 8 * (r >> 2) + 4 * hi; }
__device__ __forceinline__ bf16x8 ldg8(const bf16_t* p) { return *(const bf16x8*)p; }
__device__ __forceinline__ float sq8(bf16x8 v) {
    const u32x4 w = *(const u32x4*)&v; float s = 0.f;
#pragma unroll
    for (int i = 0; i < 4; ++i) { const float a = bflo(w[i]), b = bfhi(w[i]); s += a * a + b * b; }
    return s;
}
__device__ __forceinline__ float row_rstd(const float* rsp, int row) {
    const f32x4* p = (const f32x4*)(rsp + (size_t)row * 16); const f32x4 a = p[0], b = p[1], c = p[2], d = p[3];
    const float s = (((a.x + a.y) + (a.z + a.w)) + ((b.x + b.y) + (b.z + b.w))) + (((c.x + c.y) + (c.z + c.w)) + ((d.x + d.y) + (d.z + d.w)));
    return frsq(s * (1.f / DM) + EPS);
}
__device__ __forceinline__ float wave_sum(float v) {
#pragma unroll
    for (int o = 1; o < 64; o <<= 1) v += __shfl_xor(v, o);
    return v;
}
#define MFMA32(a, b, c) __builtin_amdgcn_mfma_f32_32x32x16_bf16((a), (b), (c), 0, 0, 0)
#define MFMA16(a, b, c) __builtin_amdgcn_mfma_f32_16x16x32_bf16((a), (b), (c), 0, 0, 0)
__device__ __forceinline__ void sincos_red(float a, float& s, float& c) {
    const float k = rintf(a * 0.15915494309189535f);
    float r = fmaf(-k, 6.28318548202514648f, a);
    r = fmaf(-k, -1.7484555e-7f, r);
    s = __sinf(r); c = __cosf(r);
}

namespace pg8 {
constexpr int BM = 256, BK = 64, HALF = 128, HTB = HALF * BK * 2, STAGE_BYTES = 8 * HTB;
__host__ __device__ __forceinline__ int lds_byte(int r, int c) { const int st = (r >> 4) * 2 + (c >> 5), rr = r & 15, cc = c & 31, ob = rr * 64 + cc * 2; return st * 1024 + (ob ^ (((ob >> 9) & 1) << 5)); }
__host__ __device__ __forceinline__ void stage_rc(int b, int& R, int& C) { const int st = b / 1024, sb = b % 1024, swz = sb ^ (((sb >> 9) & 1) << 5); R = (st >> 1) * 16 + swz / 64; C = (st & 1) * 32 + (swz % 64) / 2; }
__host__ __device__ __forceinline__ int perm32(int rho) { const int n = rho >> 4, i = rho & 15; return 8 * (i >> 2) + 4 * n + (i & 3); }

struct Unit { int pm, pn, om, on, aux, gofs; };
struct Gemm { const bf16_t* A; const bf16_t* Bt; int K; const int* gather; };

template <class Epi, class Sched, bool ALIGN_EPI, bool GATHER, bool FP8 = false>
__device__ __forceinline__ void gemm_phase(LAS unsigned char* lds, Gemm g, const Sched& S, const Epi& E) {
    int tid = threadIdx.x; asm volatile("" : "+v"(tid));
    asm volatile("" : "+s"(g.A), "+s"(g.Bt));
    const int wid = __builtin_amdgcn_readfirstlane(tid >> 6), lane = tid & 63, wr = wid >> 2, wc = wid & 3, fr = lane & 15, fq = lane >> 4;
    const int K = g.K, nt = K / BK;
    unsigned voffB[2];
#pragma unroll
    for (int i = 0; i < 2; ++i) { int Rr_, Cc_; stage_rc(tid * 16 + i * 8192, Rr_, Cc_); const int Rb = (Rr_ & ~31) + perm32(Rr_ & 31); voffB[i] = (unsigned)(Rb * K + Cc_) * 2u; }
    const size_t kstep = (size_t)(BK * 2);
    const size_t hstep = (size_t)HALF * K * 2;
    const size_t tstep = 2 * hstep;
    const unsigned ldsw = (unsigned)wid * 1024u;
    const int aoff = lds_byte(wr * 64 + fr, fq * 8), boff = lds_byte(wc * 32 + fr, fq * 8);
#define PG8_SA(b, h) (((b) * 2 + (h)) * HTB)
#define PG8_SB(b, h) ((4 + (b) * 2 + (h)) * HTB)
#define PG8_STAGE_B(bufoff, gbase) do { _Pragma("unroll") for (int _i = 0; _i < 2; ++_i) \
        __builtin_amdgcn_global_load_lds((const unsigned*)((const char*)(gbase) + voffB[_i]), (LAS unsigned*)(lds + (bufoff) + ldsw + _i * 8192), 16, 0, 0); } while (0)
#define PG8_STAGE_A(bufoff, kt, vo0, vo1) do { const char* _gb = (const char*)g.A + (size_t)(kt) * kstep; \
        __builtin_amdgcn_global_load_lds((const unsigned*)(_gb + (vo0)), (LAS unsigned*)(lds + (bufoff) + ldsw), 16, 0, 0); \
        __builtin_amdgcn_global_load_lds((const unsigned*)(_gb + (vo1)), (LAS unsigned*)(lds + (bufoff) + ldsw + 8192), 16, 0, 0); } while (0)
#define PG8_LDA(dst, b, h) do { _Pragma("unroll") for (int m = 0; m < 4; ++m) _Pragma("unroll") for (int k = 0; k < 2; ++k) dst[m][k] = *(const LAS bf16x8*)(lds + PG8_SA(b, h) + aoff + m * 2048 + k * 1024); } while (0)
#define PG8_LDB(dst, b, h) do { _Pragma("unroll") for (int n = 0; n < 2; ++n) _Pragma("unroll") for (int k = 0; k < 2; ++k) dst[n][k] = *(const LAS bf16x8*)(lds + PG8_SB(b, h) + boff + n * 2048 + k * 1024); } while (0)
#define PG8_MMA(ai, bj, At, Bt) do { __builtin_amdgcn_s_setprio(1); _Pragma("unroll") for (int m = 0; m < 4; ++m) _Pragma("unroll") for (int n = 0; n < 2; ++n) _Pragma("unroll") for (int k = 0; k < 2; ++k) \
        acc[ai][bj][m][n] = __builtin_amdgcn_mfma_f32_16x16x32_bf16(Bt[n][k], At[m][k], acc[ai][bj][m][n], 0, 0, 0); __builtin_amdgcn_s_setprio(0); } while (0)
#define PG8_MMA8(ai, bj, w) do { __builtin_amdgcn_s_setprio(1); _Pragma("unroll") for (int m = 0; m < 4; ++m) _Pragma("unroll") for (int n = 0; n < 2; ++n) \
        asm volatile("v_mfma_f32_16x16x128_f8f6f4 %0, %1, %2, %0" : "+v"(acc[ai][bj][m][n]) : "v"(B##w##8[n]), "v"(A8[m])); __builtin_amdgcn_s_setprio(0); } while (0)
#define PG8_LA(b, h) do { if constexpr (FP8) { _Pragma("unroll") for (int m = 0; m < 4; ++m) { A8[m].lo = *(const LAS i32x4*)(lds + PG8_SA(b, h) + aoff + m * 2048); A8[m].hi = *(const LAS i32x4*)(lds + PG8_SA(b, h) + aoff + m * 2048 + 1024); } } \
        else PG8_LDA(At, b, h); } while (0)
#define PG8_LB(w, b, h) do { if constexpr (FP8) { _Pragma("unroll") for (int n = 0; n < 2; ++n) { B##w##8[n].lo = *(const LAS i32x4*)(lds + PG8_SB(b, h) + boff + n * 2048); B##w##8[n].hi = *(const LAS i32x4*)(lds + PG8_SB(b, h) + boff + n * 2048 + 1024); } } \
        else PG8_LDB(B##w, b, h); } while (0)
#define PG8_MM(ai, bj, w) do { if constexpr (FP8) PG8_MMA8(ai, bj, w); else PG8_MMA(ai, bj, At, B##w); } while (0)
#define PG8_WAIT_V(n) asm volatile("s_waitcnt vmcnt(" #n ")" ::: "memory")
#define PG8_WAIT_L(n) asm volatile("s_waitcnt lgkmcnt(" #n ")" ::: "memory")
#define PG8_BAR __builtin_amdgcn_s_barrier()
#define PG8_SCHED __builtin_amdgcn_sched_barrier(0)
#define PG8_VOFF(dst, u) do { _Pragma("unroll") for (int _h = 0; _h < 2; ++_h) _Pragma("unroll") for (int _i = 0; _i < 2; ++_i) { int Rr_, Cc_; stage_rc(tid * 16 + _i * 8192, Rr_, Cc_); \
        const int _rt = (u).pm * BM + _h * HALF + Rr_; const int _ar = GATHER ? g.gather[_rt + (u).gofs] : _rt; dst[_h][_i] = (unsigned)((size_t)_ar * K + Cc_) * 2u; } } while (0)
    Unit cur, nxt; int ui = 0;
    if (!S.next(0, cur)) return;
    f32x4 acc[2][2][4][2];
#pragma unroll
    for (int a = 0; a < 2; ++a)
#pragma unroll
        for (int b = 0; b < 2; ++b)
#pragma unroll
            for (int m = 0; m < 4; ++m)
#pragma unroll
                for (int n = 0; n < 2; ++n) acc[a][b][m][n] = (f32x4){0.f, 0.f, 0.f, 0.f};
    bf16x8 At[4][2], B0[2][2], B1[2][2];
    i32x8 A8[4], B08[2], B18[2];
    unsigned vC[2][2], vN[2][2];
    PG8_VOFF(vC, cur);
    const char* cB = (const char*)g.Bt + (size_t)cur.pn * tstep;
    PG8_STAGE_B(PG8_SB(0, 0), cB); PG8_STAGE_B(PG8_SB(0, 1), cB + hstep); PG8_STAGE_A(PG8_SA(0, 0), 0, vC[0][0], vC[0][1]); PG8_STAGE_A(PG8_SA(0, 1), 0, vC[1][0], vC[1][1]);
    if (wr == 1) PG8_BAR;
    PG8_WAIT_V(2); PG8_BAR;
    PG8_STAGE_B(PG8_SB(1, 0), cB + kstep); PG8_STAGE_A(PG8_SA(1, 0), 1, vC[0][0], vC[0][1]); PG8_STAGE_B(PG8_SB(1, 1), cB + hstep + kstep);
    PG8_WAIT_V(6); PG8_BAR;
    for (;;) {
        const bool has_next = S.next(ui + 1, nxt);
        unsigned ndelta = 0u;
        if constexpr (GATHER) {
            if (has_next) { PG8_VOFF(vN, nxt); } else {
#pragma unroll
                for (int _h = 0; _h < 2; ++_h)
#pragma unroll
                    for (int _i = 0; _i < 2; ++_i) vN[_h][_i] = vC[_h][_i]; }
        } else { if (has_next) ndelta = (unsigned)((nxt.pm - cur.pm) * (int)tstep); }
        const char* nB = has_next ? (const char*)g.Bt + (size_t)nxt.pn * tstep : cB;
#pragma unroll 1
        for (int t = 0; t < nt; t += 2) {
            const bool last = (t == nt - 2);
            const int k2 = last ? 0 : t + 2, k3 = k2 + 1;
            const char* b2 = last ? nB : cB + (size_t)(t + 2) * kstep; const char* b3 = b2 + kstep;
            unsigned v200, v201, v210, v211;
            if constexpr (GATHER) { v200 = last ? vN[0][0] : vC[0][0]; v201 = last ? vN[0][1] : vC[0][1]; v210 = last ? vN[1][0] : vC[1][0]; v211 = last ? vN[1][1] : vC[1][1]; }
            else { const unsigned dl = last ? ndelta : 0u; v200 = vC[0][0] + dl; v201 = vC[0][1] + dl; v210 = vC[1][0] + dl; v211 = vC[1][1] + dl; }
            PG8_LB(0, 0, 0); PG8_LB(1, 0, 1); PG8_SCHED; PG8_LA(0, 0); PG8_STAGE_A(PG8_SA(1, 1), t + 1, vC[1][0], vC[1][1]);
            PG8_WAIT_V(8); PG8_WAIT_L(0); PG8_BAR; PG8_MM(0, 0, 0); PG8_MM(0, 1, 1); PG8_BAR; PG8_SCHED;
            PG8_LA(0, 1); PG8_STAGE_B(PG8_SB(0, 0), b2); PG8_STAGE_B(PG8_SB(0, 1), b2 + hstep); PG8_STAGE_A(PG8_SA(0, 0), k2, v200, v201);
            PG8_WAIT_V(8); PG8_WAIT_L(0); PG8_BAR; PG8_MM(1, 0, 0); PG8_MM(1, 1, 1); PG8_BAR; PG8_SCHED;
            PG8_LB(0, 1, 0); PG8_LB(1, 1, 1); PG8_SCHED; PG8_LA(1, 0); PG8_STAGE_A(PG8_SA(0, 1), k2, v210, v211);
            PG8_WAIT_V(8); PG8_WAIT_L(0); PG8_BAR; PG8_MM(0, 0, 0); PG8_MM(0, 1, 1); PG8_BAR; PG8_SCHED;
            PG8_LA(1, 1); PG8_STAGE_B(PG8_SB(1, 0), b3); PG8_STAGE_B(PG8_SB(1, 1), b3 + hstep); PG8_STAGE_A(PG8_SA(1, 0), k3, v200, v201);
            PG8_WAIT_V(8); PG8_WAIT_L(0); PG8_BAR; PG8_MM(1, 0, 0); PG8_MM(1, 1, 1); PG8_BAR; PG8_SCHED;
        }
        if constexpr (ALIGN_EPI) { if (wr == 0) PG8_BAR; }
        if constexpr (FP8) asm volatile("s_nop 15\n\ts_nop 15" ::: "memory");
        { int fr_ = fr, fq_ = fq; asm volatile("" : "+v"(fr_), "+v"(fq_)); E(acc, cur, wr, wc, fr_, fq_); }
        if (!has_next) break;
#pragma unroll
        for (int a = 0; a < 2; ++a)
#pragma unroll
            for (int b = 0; b < 2; ++b)
#pragma unroll
                for (int m = 0; m < 4; ++m)
#pragma unroll
                    for (int n = 0; n < 2; ++n) acc[a][b][m][n] = (f32x4){0.f, 0.f, 0.f, 0.f};
        cur = nxt; cB = nB; ++ui;
#pragma unroll
        for (int _h = 0; _h < 2; ++_h)
#pragma unroll
            for (int _i = 0; _i < 2; ++_i) { if constexpr (GATHER) vC[_h][_i] = vN[_h][_i]; else vC[_h][_i] += ndelta; }
        if constexpr (ALIGN_EPI) { if (wr == 1) PG8_BAR; }
    }
    PG8_WAIT_V(0);
    if constexpr (!ALIGN_EPI) { if (wr == 0) PG8_BAR; }
    PG8_BAR;
#undef PG8_SA
#undef PG8_SB
#undef PG8_STAGE_A
#undef PG8_STAGE_B
#undef PG8_LDA
#undef PG8_LDB
#undef PG8_MMA
#undef PG8_MMA8
#undef PG8_MM
#undef PG8_LA
#undef PG8_LB
#undef PG8_WAIT_V
#undef PG8_WAIT_L
#undef PG8_BAR
#undef PG8_SCHED
#undef PG8_VOFF
}

constexpr int NXCD = 8, WGM = 8;
struct StaticOrder {
    int nM, nN, nwg, G, c;
    __device__ void init(int nM_, int nN_, int G_, int c_) { nM = nM_; nN = nN_; nwg = nM * nN; G = G_; c = c_; }
    __device__ bool next(int i, Unit& u) const {
        const long L = (long)i * G + c; if (L >= nwg) return false;
        int wgid = (int)L; { const int q = nwg / NXCD, r = nwg % NXCD, xcd = wgid % NXCD, off = wgid / NXCD; wgid = (xcd < r ? xcd * (q + 1) : r * (q + 1) + (xcd - r) * q) + off; }
        const int nig = WGM * nN, gid = wgid / nig, fm = gid * WGM, gsz = (nM - fm) < WGM ? (nM - fm) : WGM;
        u.pm = fm + ((wgid % nig) % gsz); u.pn = (wgid % nig) / gsz; u.om = u.pm; u.on = u.pn; u.aux = 0; return true;
    }
};
struct MergeOrder {
    int G, c;
    __device__ bool next(int i, Unit& u) const {
        const int n = i & 3; const long tile = (long)(i >> 2) * G + c; if (tile >= 256) return false;
        const int om = (int)tile >> 2, on = (int)tile & 3;
        u.pm = n * 64 + om; u.pn = n * 4 + on; u.om = om; u.on = on; u.aux = n; return true;
    }
};
struct MoeOrder {
    int ntiles, nN, nwg, G, c; int pend[NEXP];
    __device__ void init(const unsigned* cnt, int nN_, int G_, int c_) {
        int acc = 0;
#pragma unroll
        for (int e = 0; e < NEXP; ++e) { const int ce = (int)cnt[64 * e]; acc += (ce + 255) >> 8; pend[e] = acc; }
        ntiles = acc; nN = nN_; nwg = ntiles * nN; G = G_; c = c_;
    }
    __device__ bool next(int i, Unit& u) const {
        const long L = (long)i * G + c; if (L >= nwg) return false;
        const int wgid = (int)L;
        const int nig = WGM * nN, gid = wgid / nig, fm = gid * WGM, gsz = (ntiles - fm) < WGM ? (ntiles - fm) : WGM;
        const int pm = fm + ((wgid % nig) % gsz), pn = (wgid % nig) / gsz;
        int e = 0, ps = 0;
#pragma unroll
        for (int j = 0; j < NEXP - 1; ++j) if (pm >= pend[j]) { e = j + 1; ps = pend[j]; }
        u.pm = pm; u.pn = e * nN + pn; u.om = pm; u.on = pn; u.aux = e; u.gofs = e * 16384 - 256 * ps; return true;
    }
};

__device__ __forceinline__ u32x4 pack8(f32x4 a, f32x4 b) { u32x4 w; w.x = cvt_pk_bf16(a[0], a[1]); w.y = cvt_pk_bf16(a[2], a[3]); w.z = cvt_pk_bf16(b[0], b[1]); w.w = cvt_pk_bf16(b[2], b[3]); return w; }
struct EpiIn {
    bf16_t* Zs; bf16_t* Zg; const float* rowss; const float* bgate;
    __device__ __forceinline__ void operator()(const f32x4 (&acc)[2][2][4][2], const Unit& u, int wr, int wc, int fr, int fq) const {
        const int row0 = u.om * BM + wr * 64 + fr, colt = u.on * BM, cw = wc * 32 + 8 * fq;
        if (colt < ZSW) {
#pragma unroll
            for (int ai = 0; ai < 2; ++ai) { float rsd[4];
#pragma unroll
                for (int m = 0; m < 4; ++m) rsd[m] = row_rstd(rowss, row0 + ai * HALF + m * 16);
#pragma unroll
                for (int m = 0; m < 4; ++m) {
                    const int row = row0 + ai * HALF + m * 16; const float rstd = rsd[m];
#pragma unroll
                    for (int bj = 0; bj < 2; ++bj) __builtin_nontemporal_store(pack8(acc[ai][bj][m][0] * rstd, acc[ai][bj][m][1] * rstd), (u32x4*)(Zs + (size_t)row * ZSW + colt + bj * HALF + cw));
                    if (m == 3) asm volatile("" ::: "memory");
                } }
        } else {
            const int gc0 = colt - ZSW + cw;
            const f32x4 b00 = *(const f32x4*)(bgate + gc0), b01 = *(const f32x4*)(bgate + gc0 + 4), b10 = *(const f32x4*)(bgate + gc0 + HALF), b11 = *(const f32x4*)(bgate + gc0 + HALF + 4);
#pragma unroll
            for (int ai = 0; ai < 2; ++ai) { float rsd[4];
#pragma unroll
                for (int m = 0; m < 4; ++m) rsd[m] = row_rstd(rowss, row0 + ai * HALF + m * 16);
#pragma unroll
                for (int m = 0; m < 4; ++m) {
                    const int row = row0 + ai * HALF + m * 16; const float rstd = rsd[m];
#pragma unroll
                    for (int bj = 0; bj < 2; ++bj) { f32x4 v0 = acc[ai][bj][m][0] * rstd + (bj ? b10 : b00), v1 = acc[ai][bj][m][1] * rstd + (bj ? b11 : b01);
                        __builtin_nontemporal_store(pack8(v0, v1), (u32x4*)(Zg + (size_t)row * ZGW + gc0 + bj * HALF)); }
                    if (m == 3) asm volatile("" ::: "memory");
                } }
        }
    }
};
struct EpiMerge {
    bf16_t* Mg; const bf16_t* Zg;
    __device__ __forceinline__ void operator()(const f32x4 (&acc)[2][2][4][2], const Unit& u, int wr, int wc, int fr, int fq) const {
        const int row0 = u.om * BM + wr * 64 + fr, colt = u.on * BM, cw = wc * 32 + 8 * fq, n = u.aux;
#pragma unroll
        for (int ai = 0; ai < 2; ++ai) {
            u32x4 gw[4][2], ow[4][2];
#pragma unroll
            for (int m = 0; m < 4; ++m)
#pragma unroll
                for (int bj = 0; bj < 2; ++bj) { const int row = row0 + ai * HALF + m * 16, col = colt + bj * HALF + cw;
                    gw[m][bj] = *(const u32x4*)(Zg + (size_t)row * ZGW + DBG_GPERM(n) * DM + col);
                    ow[m][bj] = n > 0 ? *(const u32x4*)(Mg + (size_t)row * DM + col) : (u32x4){0u, 0u, 0u, 0u}; }
#pragma unroll
            for (int m = 0; m < 4; ++m)
#pragma unroll
                for (int bj = 0; bj < 2; ++bj) { const int row = row0 + ai * HALF + m * 16, col = colt + bj * HALF + cw; const u32x4 g = gw[m][bj], o = ow[m][bj];
                    f32x4 v0 = acc[ai][bj][m][0], v1 = acc[ai][bj][m][1];
                    v0[0] = v0[0] * fsigmoid(bflo(g.x)) + bflo(o.x); v0[1] = v0[1] * fsigmoid(bfhi(g.x)) + bfhi(o.x); v0[2] = v0[2] * fsigmoid(bflo(g.y)) + bflo(o.y); v0[3] = v0[3] * fsigmoid(bfhi(g.y)) + bfhi(o.y);
                    v1[0] = v1[0] * fsigmoid(bflo(g.z)) + bflo(o.z); v1[1] = v1[1] * fsigmoid(bfhi(g.z)) + bfhi(o.z); v1[2] = v1[2] * fsigmoid(bflo(g.w)) + bflo(o.w); v1[3] = v1[3] * fsigmoid(bfhi(g.w)) + bfhi(o.w);
                    *(u32x4*)(Mg + (size_t)row * DM + col) = pack8(v0, v1); }
            asm volatile("" ::: "memory");
        }
    }
};
template <bool F32OUT, bool X8 = false, bool SC32 = false> struct EpiRes {
    float* xout; bf16_t* xb; float* rowss; unsigned char* x8;
    __device__ __forceinline__ void operator()(const f32x4 (&acc)[2][2][4][2], const Unit& u, int wr, int wc, int fr, int fq) const {
        const int row0 = u.om * BM + wr * 64 + fr, colt = u.on * BM, cw = wc * 32 + 8 * fq;
#pragma unroll
        for (int ai = 0; ai < 2; ++ai) {
            u32x4 xw[4][2];
#pragma unroll
            for (int m = 0; m < 4; ++m)
#pragma unroll
                for (int bj = 0; bj < 2; ++bj) xw[m][bj] = *(const u32x4*)(xb + (size_t)(row0 + ai * HALF + m * 16) * DM + colt + bj * HALF + cw);
#pragma unroll
            for (int m = 0; m < 4; ++m) {
                const int row = row0 + ai * HALF + m * 16; float ss = 0.f;
#pragma unroll
                for (int bj = 0; bj < 2; ++bj) { const size_t off = (size_t)row * DM + colt + bj * HALF + cw; const u32x4 w = xw[m][bj];
                    f32x4 v0 = acc[ai][bj][m][0], v1 = acc[ai][bj][m][1];
                    if constexpr (SC32) { v0 *= 0.03125f; v1 *= 0.03125f; }
                    v0[0] += bflo(w.x); v0[1] += bfhi(w.x); v0[2] += bflo(w.y); v0[3] += bfhi(w.y); v1[0] += bflo(w.z); v1[1] += bfhi(w.z); v1[2] += bflo(w.w); v1[3] += bfhi(w.w);
                    if constexpr (F32OUT) { *(f32x4*)(xout + off) = v0; *(f32x4*)(xout + off + 4) = v1; }
                    *(u32x4*)(xb + off) = pack8(v0, v1);
                    if constexpr (X8) { u32x2 q; q.x = cvt_pk4_fp8(v0[0], v0[1], v0[2], v0[3]); q.y = cvt_pk4_fp8(v1[0], v1[1], v1[2], v1[3]); *(u32x2*)(x8 + off) = q; }
                    ss += (v0[0] * v0[0] + v0[1] * v0[1]) + (v0[2] * v0[2] + v0[3] * v0[3]) + (v1[0] * v1[0] + v1[1] * v1[1]) + (v1[2] * v1[2] + v1[3] * v1[3]); }
                ss += __shfl_xor(ss, 16); ss += __shfl_xor(ss, 32);
                if (fq == 0) rowss[(size_t)row * 16 + u.on * 4 + wc] = ss;
            }
            asm volatile("" ::: "memory");
        }
    }
};
struct EpiRowScale {
    bf16_t* O; int ldc; const float* rowss;
    __device__ __forceinline__ void operator()(const f32x4 (&acc)[2][2][4][2], const Unit& u, int wr, int wc, int fr, int fq) const {
        const int row0 = u.om * BM + wr * 64 + fr, colt = u.on * BM, cw = wc * 32 + 8 * fq;
#pragma unroll
        for (int ai = 0; ai < 2; ++ai)
#pragma unroll
            for (int m = 0; m < 4; ++m) {
                const int row = row0 + ai * HALF + m * 16; const float rstd = row_rstd(rowss, row);
#pragma unroll
                for (int bj = 0; bj < 2; ++bj) *(u32x4*)(O + (size_t)row * ldc + colt + bj * HALF + cw) = pack8(acc[ai][bj][m][0] * rstd, acc[ai][bj][m][1] * rstd);
                if (m == 3) asm volatile("" ::: "memory");
            }
    }
};
template <bool MOE> struct EpiSwiGLU {
    bf16_t* H; int ldh; const float* rs; const int* row_tok;
    __device__ __forceinline__ void operator()(const f32x4 (&acc)[2][2][4][2], const Unit& u, int wr, int wc, int fr, int fq) const {
        const int row0 = u.om * BM + wr * 64 + fr, hc = u.on * HALF + wc * 32 + 8 * fq;
#pragma unroll
        for (int ai = 0; ai < 2; ++ai) { float rsd[4];
#pragma unroll
            for (int m = 0; m < 4; ++m) { const int row = row0 + ai * HALF + m * 16; rsd[m] = MOE ? rs[row_tok[row]] : row_rstd(rs, row); }
#pragma unroll
            for (int m = 0; m < 4; ++m) {
                const int row = row0 + ai * HALF + m * 16;
                const float rstd = rsd[m];
                f32x4 o[2];
#pragma unroll
                for (int n = 0; n < 2; ++n)
#pragma unroll
                    for (int j = 0; j < 4; ++j) { const float gv = acc[ai][0][m][n][j] * rstd, uv = acc[ai][1][m][n][j] * rstd; o[n][j] = gv * fsigmoid(gv) * uv; }
                *(u32x4*)(H + (size_t)row * ldh + hc) = pack8(o[0], o[1]);
                if (m == 3) asm volatile("" ::: "memory");
            } }
    }
};
template <bool RSTD, bool W32 = true> struct EpiSwiGLU8 {
    unsigned char* H; int ldh; const float* rs;
    __device__ __forceinline__ void operator()(const f32x4 (&acc)[2][2][4][2], const Unit& u, int wr, int wc, int fr, int fq) const {
        const int row0 = u.om * BM + wr * 64 + fr, hc = u.on * HALF + wc * 32 + 8 * fq;
#pragma unroll
        for (int ai = 0; ai < 2; ++ai)
#pragma unroll
            for (int m = 0; m < 4; ++m) {
                const int row = row0 + ai * HALF + m * 16;
                float sc = W32 ? 0.03125f : 1.f; if constexpr (RSTD) sc *= row_rstd(rs, row);
                f32x4 o[2];
#pragma unroll
                for (int n = 0; n < 2; ++n)
#pragma unroll
                    for (int j = 0; j < 4; ++j) { const float gv = acc[ai][0][m][n][j] * sc, uv = acc[ai][1][m][n][j] * sc; o[n][j] = gv * fsigmoid(gv) * uv; }
                u32x2 w; w.x = cvt_pk4_fp8(o[0][0], o[0][1], o[0][2], o[0][3]); w.y = cvt_pk4_fp8(o[1][0], o[1][1], o[1][2], o[1][3]);
                *(u32x2*)(H + (size_t)row * ldh + hc) = w;
                if (m == 3) asm volatile("" ::: "memory");
            }
    }
};
struct EpiPlain {
    bf16_t* O; int ldc; float sc;
    __device__ __forceinline__ void operator()(const f32x4 (&acc)[2][2][4][2], const Unit& u, int wr, int wc, int fr, int fq) const {
        const int row0 = u.om * BM + wr * 64 + fr, colt = u.on * BM, cw = wc * 32 + 8 * fq;
#pragma unroll
        for (int ai = 0; ai < 2; ++ai)
#pragma unroll
            for (int m = 0; m < 4; ++m) { const int row = row0 + ai * HALF + m * 16;
#pragma unroll
                for (int bj = 0; bj < 2; ++bj) *(u32x4*)(O + (size_t)row * ldc + colt + bj * HALF + cw) = pack8(acc[ai][bj][m][0] * sc, acc[ai][bj][m][1] * sc); }
    }
};
}

#define XB_TMO      128
#define XB_XCNT(j)  (256  + 64 * (j))
#define XB_XSUB(j)  (1280 + 64 * (j))
#define XB_XGEN(j)  (2304 + 64 * (j))
#define XB_TOP      3328
#define XB_TOPGEN   3392
#define XCD_BAR_WORDS 3456
#define XB_SPIN_CAP (1u << 18)
__device__ __forceinline__ unsigned xb_ld(unsigned* p)              { return __hip_atomic_load(p, __ATOMIC_RELAXED, __HIP_MEMORY_SCOPE_AGENT); }
__device__ __forceinline__ unsigned xb_add(unsigned* p, unsigned v) { return __hip_atomic_fetch_add(p, v, __ATOMIC_RELAXED, __HIP_MEMORY_SCOPE_AGENT); }
__device__ __forceinline__ unsigned xb_xcc_id() { return (unsigned)__builtin_amdgcn_s_getreg((3 << 11) | 20) & 0xFu; }
#define XB_SPIN(cond, bar) do { unsigned _sp = 0; while (cond) { __builtin_amdgcn_s_sleep(1); \
    if ((++_sp & 255u) == 0u) { if (xb_ld(&(bar)[XB_TMO])) break; if (_sp > XB_SPIN_CAP) { atomicAdd(&(bar)[XB_TMO], 1u); break; } } } } while (0)
struct XcdBarrier { unsigned* bar; unsigned x; volatile LAS unsigned* st; };
__device__ __forceinline__ XcdBarrier xcd_barrier_post(unsigned* bar, volatile LAS unsigned* st) {
    XcdBarrier b; b.bar = bar; b.x = xb_xcc_id(); b.st = st;
    if (threadIdx.x == 0) (void)xb_add(&bar[XB_XCNT(b.x)], 1u);
    return b;
}
__device__ __forceinline__ void xcd_barrier_complete(unsigned* bar, unsigned x, unsigned& nloc, unsigned& nx) {
    const unsigned G = gridDim.x * gridDim.y * gridDim.z;
    unsigned sum, cnt, mine, sp = 0u;
    for (;;) {
        sum = 0u; cnt = 0u; mine = 0u;
#pragma unroll
        for (unsigned j = 0; j < 16; ++j) { const unsigned c = xb_ld(&bar[XB_XCNT(j)]); sum += c; cnt += (c > 0u) ? 1u : 0u; mine = (j == x) ? c : mine; }
        if (sum == G) break;
        __builtin_amdgcn_s_sleep(1);
        if ((++sp & 255u) == 0u) { if (xb_ld(&bar[XB_TMO])) break; if (sp > XB_SPIN_CAP) { atomicAdd(&bar[XB_TMO], 1u); break; } }
    }
    nloc = mine > 0u ? mine : 1u; nx = cnt > 0u ? cnt : 1u;
}
__device__ __forceinline__ void xcd_barrier(const XcdBarrier& b) {
    asm volatile("s_waitcnt vmcnt(0)" ::: "memory");
    __syncthreads();
    if (threadIdx.x == 0) {
        unsigned* bar = b.bar;
        __builtin_amdgcn_s_waitcnt(0);
        unsigned nloc = b.st[0], nx = b.st[1];
        if (nloc == 0u) { xcd_barrier_complete(bar, b.x, nloc, nx); b.st[0] = nloc; b.st[1] = nx; }
        const unsigned old = xb_add(&bar[XB_XSUB(b.x)], 1u);
        const unsigned gen = old / nloc;
        if (old + 1u == (gen + 1u) * nloc) {
            __builtin_amdgcn_fence(__ATOMIC_RELEASE, "agent");
            asm volatile("s_waitcnt vmcnt(0)" ::: "memory");
            const unsigned og = xb_add(&bar[XB_TOP], 1u);
            const unsigned tg = og / nx;
            if (og + 1u == (tg + 1u) * nx) xb_add(&bar[XB_TOPGEN], 1u);
            else XB_SPIN(xb_ld(&bar[XB_TOPGEN]) == tg, bar);
            __builtin_amdgcn_fence(__ATOMIC_ACQUIRE, "agent");
            xb_add(&bar[XB_XGEN(b.x)], 1u);
            asm volatile("s_waitcnt vmcnt(0)" ::: "memory");
        } else {
            XB_SPIN(xb_ld(&bar[XB_XGEN(b.x)]) == gen, bar);
            __builtin_amdgcn_fence(__ATOMIC_ACQUIRE, "agent");
            asm volatile("s_waitcnt vmcnt(0)" ::: "memory");
        }
    }
    __syncthreads();
}

struct Args { const void* in[55]; float* out; unsigned char* ws; int ph_lo, ph_hi, submask, pad; };
struct Frame {
    LAS unsigned char* lds; unsigned char* ws; unsigned* ctl; float* out;
    int tid, lane, wave, G, bid, gw, ngw;
};
#define GAS __attribute__((address_space(1)))
#define CAS __attribute__((address_space(4)))
#define PHASE_BEGIN() const CAS char* kp_ = (const CAS char*)__builtin_amdgcn_kernarg_segment_ptr(); asm volatile("" : "+s"(kp_)); \
    unsigned char* ws = (unsigned char*)(GAS unsigned char*)(*(const CAS unsigned long long*)(kp_ + 448)); \
    Frame F; { int t_ = threadIdx.x; asm volatile("" : "+v"(t_)); int b_ = blockIdx.x; asm volatile("" : "+s"(b_)); \
      F.lds = (LAS unsigned char*)lds_raw; F.ws = ws; F.ctl = (unsigned*)(ws + WS_CTL); F.out = (float*)(GAS float*)(*(const CAS unsigned long long*)(kp_ + 440)); \
      F.tid = t_; F.lane = t_ & 63; F.wave = __builtin_amdgcn_readfirstlane(t_ >> 6); F.G = gridDim.x; F.bid = b_; F.gw = b_ * 8 + F.wave; F.ngw = F.G * 8; }
#define XB ((bf16_t*)(ws + WS_XB))
#define RS ((float*)(ws + WS_RSP))
#define ZS ((bf16_t*)(ws + WS_ZS))
#define ZG ((bf16_t*)(ws + WS_ZG))
#define YB ((bf16_t*)(ws + WS_Y))
#define MG ((bf16_t*)(ws + WS_MERGED))
#define S5T ((float*)(ws + WS_TAB + TAB_S5T))
#define CMAT ((bf16_t*)(ws + WS_TAB + TAB_CMAT))
#define MISCT ((float*)(ws + WS_TAB + TAB_MISC))
#define BBF ((bf16_t*)(ws + WS_TAB + 832 * 1024))
#define WLP(l) (ws + WS_WL + (size_t)(l) * WL_STRIDE)
#define INF(i) ((const float*)(const GAS float*)(*(const CAS unsigned long long*)(kp_ + 8 * (i))))

struct TJob { const float* W; bf16_t* WT; const float* ks; int K, N, ldw, ldk, nb, map; size_t sstride, dstride; int f8; };
__device__ __forceinline__ int tjob_items(const TJob& j) { return j.nb * (j.K / 64) * (j.N / 32); }
__device__ __forceinline__ void tjob_load(const TJob& j, int item, float (&v)[32], int lane) {
    const int per = (j.K / 64) * (j.N / 32), b = item / per, r = item % per, nblk = j.N / 32, kb = r / nblk, nbk = r % nblk, k0 = 64 * kb, n0 = 32 * nbk;
    const float* W = j.W + (size_t)b * j.sstride + (size_t)(k0 + (lane >> 5)) * j.ldw + n0 + (lane & 31);
#pragma unroll
    for (int i = 0; i < 32; ++i) v[i] = __builtin_nontemporal_load(W + (size_t)(2 * i) * j.ldw);
}
__device__ __forceinline__ void tjob_store(const TJob& j, int item, float (&v)[32], LAS float* scr, int lane) {
    const int per = (j.K / 64) * (j.N / 32), b = item / per, r = item % per, nblk = j.N / 32, kb = r / nblk, nbk = r % nblk, k0 = 64 * kb, n0 = 32 * nbk;
    int drow = n0;
    if (j.map == 1) drow = n0 < C_END ? n0 : n0 + (ZSW - C_END);
    else if (j.map == 2) drow = 256 * (n0 >> 7) + (n0 & 127);
    else if (j.map == 3) drow = 256 * (n0 >> 7) + 128 + (n0 & 127);
    if (j.ks) {
#pragma unroll
        for (int i = 0; i < 32; ++i) v[i] *= j.ks[k0 + 2 * i + (lane >> 5)]; }
#pragma unroll
    for (int i = 0; i < 32; ++i) scr[(2 * i + (lane >> 5)) * 33 + (lane & 31)] = v[i];
    asm volatile("s_waitcnt lgkmcnt(0)" ::: "memory");
    const int c = lane & 7; bf16_t* WT = j.WT + (size_t)b * j.dstride;
    if (j.f8) { unsigned char* W8 = (unsigned char*)j.WT + (size_t)b * j.dstride;
#pragma unroll
        for (int q = 0; q < 4; ++q) { const int n = (lane >> 3) + 8 * q; const LAS float* sp = scr + (8 * c) * 33 + n;
            u32x2 o; o.x = cvt_pk4_fp8(sp[0 * 33] * 32.f, sp[1 * 33] * 32.f, sp[2 * 33] * 32.f, sp[3 * 33] * 32.f); o.y = cvt_pk4_fp8(sp[4 * 33] * 32.f, sp[5 * 33] * 32.f, sp[6 * 33] * 32.f, sp[7 * 33] * 32.f);
            *(u32x2*)(W8 + (size_t)(drow + n) * j.ldk + k0 + 8 * c) = o; }
    } else
#pragma unroll
    for (int q = 0; q < 4; ++q) { const int n = (lane >> 3) + 8 * q; const LAS float* sp = scr + (8 * c) * 33 + n;
        u32x4 o; o.x = cvt_pk_bf16(sp[0 * 33], sp[1 * 33]); o.y = cvt_pk_bf16(sp[2 * 33], sp[3 * 33]); o.z = cvt_pk_bf16(sp[4 * 33], sp[5 * 33]); o.w = cvt_pk_bf16(sp[6 * 33], sp[7 * 33]);
        *(u32x4*)(WT + (size_t)(drow + n) * j.ldk + k0 + 8 * c) = o; }
    asm volatile("s_waitcnt lgkmcnt(0)" ::: "memory");
}
__device__ __forceinline__ void tjob_run_all(const TJob& j, int first, int stride, LAS float* scr, int lane) {
    const int ni = tjob_items(j); int it = first; if (it >= ni) return;
    float va[32], vb[32]; tjob_load(j, it, va, lane);
    for (;;) {
        const int n1 = it + stride; if (n1 < ni) tjob_load(j, n1, vb, lane);
        tjob_store(j, it, va, scr, lane); if (n1 >= ni) break;
        const int n2 = n1 + stride; if (n2 < ni) tjob_load(j, n2, va, lane);
        tjob_store(j, n1, vb, scr, lane); if (n2 >= ni) break;
        it = n2;
    }
}

template <int DQ> struct AttnLds { static constexpr int KROW = DQ * 2 + 16, VROW = 272, KBYTES = 128 * KROW, VBYTES = 64 * VROW, BUF = KBYTES + VBYTES; };
#define PK4(P, BASE, OUT) do { unsigned a0_ = cvt_pk_bf16(P[BASE + 0], P[BASE + 1]), a1_ = cvt_pk_bf16(P[BASE + 2], P[BASE + 3]); \
    unsigned b0_ = cvt_pk_bf16(P[BASE + 4], P[BASE + 5]), b1_ = cvt_pk_bf16(P[BASE + 6], P[BASE + 7]); \
    auto r0_ = __builtin_amdgcn_permlane32_swap(a0_, b0_, false, false); auto r1_ = __builtin_amdgcn_permlane32_swap(a1_, b1_, false, false); \
    u32x4 w_ = {r0_[0], r1_[0], r0_[1], r1_[1]}; OUT = *(bf16x8*)&w_; } while (0)

template <int DQ, int NMAP, bool CAUSAL, bool BIAS, bool QNORM>
__device__ __forceinline__ void attn_unit(LAS unsigned char* lds, const bf16_t* Qp, int ldq, const bf16_t* Kp, const bf16_t* Vtp, int vstride, int nkt, int q0,
                                          const LAS float* lut, const float* qg, float qscale, float mshift, f32x16 (&o)[NMAP][2], float (&l)[NMAP]) {
    typedef AttnLds<DQ> L; constexpr int KD = DQ / NMAP, KS = KD / 16, KCH = DQ / 8, NKC = 64 * KCH;
    int tid = threadIdx.x; asm volatile("" : "+v"(tid));
    const int wid = tid >> 6, lane = tid & 63, r32 = lane & 31, hi = lane >> 5;
    bf16x8 q[NMAP][KS];
    {
        const bf16_t* qrow = Qp + (size_t)(wid * 32 + r32) * ldq + hi * 8;
#pragma unroll
        for (int mp = 0; mp < NMAP; ++mp)
#pragma unroll
            for (int ks = 0; ks < KS; ++ks) q[mp][ks] = ldg8(qrow + mp * KD + ks * 16);
        if constexpr (QNORM) {
            float ss = 0.f;
#pragma unroll
            for (int ks = 0; ks < KS; ++ks) ss += sq8(q[0][ks]);
            ss += __shfl_xor(ss, 32);
            const float rs = frsq(ss * (1.f / DQ) + EPS) * qscale;
#pragma unroll
            for (int ks = 0; ks < KS; ++ks) { u32x4 w = *(u32x4*)&q[0][ks]; const float* gp = qg + ks * 16 + hi * 8;
                w.x = cvt_pk_bf16(bflo(w.x) * rs * gp[0], bfhi(w.x) * rs * gp[1]); w.y = cvt_pk_bf16(bflo(w.y) * rs * gp[2], bfhi(w.y) * rs * gp[3]);
                w.z = cvt_pk_bf16(bflo(w.z) * rs * gp[4], bfhi(w.z) * rs * gp[5]); w.w = cvt_pk_bf16(bflo(w.w) * rs * gp[6], bfhi(w.w) * rs * gp[7]);
                q[0][ks] = *(bf16x8*)&w; }
        }
    }
#pragma unroll
    for (int mp = 0; mp < NMAP; ++mp) { l[mp] = 0.f; o[mp][0] = f32x16{}; o[mp][1] = f32x16{}; }
    constexpr int NKI = (128 * KCH) / 512;
    bf16x8 skr[NKI], svr[2];
#define AT_LOAD(j) do { const int key0_ = (j) * 128; \
        _Pragma("unroll") for (int i_ = 0; i_ < NKI; ++i_) { const int c_ = tid + 512 * i_; skr[i_] = ldg8(Kp + (size_t)(key0_ + c_ / KCH) * DQ + (c_ % KCH) * 8); } \
        _Pragma("unroll") for (int i_ = 0; i_ < 2; ++i_) { const int c_ = tid + 512 * i_; svr[i_] = ldg8(Vtp + (size_t)(c_ >> 4) * vstride + key0_ + (c_ & 15) * 8); } } while (0)
#define AT_WRITE(b) do { LAS unsigned char* base_ = lds + (b) * L::BUF; \
        _Pragma("unroll") for (int i_ = 0; i_ < NKI; ++i_) { const int c_ = tid + 512 * i_; *(LAS bf16x8*)(base_ + (c_ / KCH) * L::KROW + (c_ % KCH) * 16) = skr[i_]; } \
        _Pragma("unroll") for (int i_ = 0; i_ < 2; ++i_) { const int c_ = tid + 512 * i_; *(LAS bf16x8*)(base_ + L::KBYTES + (c_ >> 4) * L::VROW + (c_ & 15) * 16) = svr[i_]; } } while (0)
    const int qi = q0 + wid * 32 + r32;
    const int qlo = q0 + wid * 32;
#define AT_COMPUTE(key0, bf, sb) do { const bool active = !CAUSAL || (key0) <= qlo + 31; \
        if (active) { const LAS unsigned char* kb = lds + (bf) * L::BUF + (sb) * 64 * L::KROW; const LAS unsigned char* vb = lds + (bf) * L::BUF + L::KBYTES + (sb) * 128; const bool need_mask = CAUSAL && ((key0) + 63 > qlo); \
            _Pragma("unroll") for (int mp = 0; mp < NMAP; ++mp) { f32x16 p0 = f32x16{}, p1 = f32x16{}; \
                _Pragma("unroll") for (int ks = 0; ks < KS; ++ks) { \
                    const bf16x8 a0 = *(const LAS bf16x8*)(kb + r32 * L::KROW + (mp * KD + ks * 16 + hi * 8) * 2); \
                    const bf16x8 a1 = *(const LAS bf16x8*)(kb + (32 + r32) * L::KROW + (mp * KD + ks * 16 + hi * 8) * 2); \
                    p0 = MFMA32(a0, q[mp][ks], p0); p1 = MFMA32(a1, q[mp][ks], p1); } \
                __builtin_amdgcn_sched_barrier(0); \
                float sh = mshift; \
                if constexpr (BIAS) { \
                    if (qlo - ((key0) + 63) >= 127) sh -= lut[255]; \
                    else { const LAS float* lp = lut + (qi - (key0) - 4 * hi + 69); \
                        _Pragma("unroll") for (int r = 0; r < 16; ++r) { const int cr = (r & 3) + 8 * (r >> 2); p0[r] += lp[59 - cr]; p1[r] += lp[27 - cr]; } } } \
                if (need_mask) { _Pragma("unroll") for (int r = 0; r < 16; ++r) { const int kk = (key0) + crow(r, hi); if (kk > qi) p0[r] = -1e30f; if (kk + 32 > qi) p1[r] = -1e30f; } } \
                float ps = 0.f; \
                _Pragma("unroll") for (int r = 0; r < 16; ++r) { p0[r] = fexp2(p0[r] - sh); p1[r] = fexp2(p1[r] - sh); ps += p0[r] + p1[r]; } \
                l[mp] += ps; \
                __builtin_amdgcn_sched_barrier(0); \
                bf16x8 pa0, pa1, pa2, pa3; \
                PK4(p0, 0, pa0); PK4(p0, 8, pa1); PK4(p1, 0, pa2); PK4(p1, 8, pa3); \
                _Pragma("unroll") for (int dt = 0; dt < 2; ++dt) { \
                    const LAS unsigned char* vrow = vb + (dt * 32 + r32) * L::VROW + hi * 16; \
                    const bf16x8 v0 = *(const LAS bf16x8*)(vrow), v1 = *(const LAS bf16x8*)(vrow + 32), v2 = *(const LAS bf16x8*)(vrow + 64), v3 = *(const LAS bf16x8*)(vrow + 96); \
                    o[mp][dt] = MFMA32(v0, pa0, o[mp][dt]); o[mp][dt] = MFMA32(v1, pa1, o[mp][dt]); o[mp][dt] = MFMA32(v2, pa2, o[mp][dt]); o[mp][dt] = MFMA32(v3, pa3, o[mp][dt]); } \
                __builtin_amdgcn_sched_barrier(0); } } } while (0)
    const int n128 = nkt >> 1;
    if (wid < 4) __builtin_amdgcn_s_setprio(2);
    AT_LOAD(0); AT_WRITE(0); __syncthreads();
    for (int j = 0; j < n128; ++j) {
        if (j + 1 < n128) AT_LOAD(j + 1);
        AT_COMPUTE(j * 128, j & 1, 0);
        AT_COMPUTE(j * 128 + 64, j & 1, 1);
        if (j + 1 < n128) AT_WRITE((j + 1) & 1);
        __syncthreads();
    }
    __builtin_amdgcn_s_setprio(0);
#undef AT_COMPUTE
#pragma unroll
    for (int mp = 0; mp < NMAP; ++mp) l[mp] += __shfl_xor(l[mp], 32);
#undef AT_LOAD
#undef AT_WRITE
}

__device__ __forceinline__ void attn_store(bf16_t* dst, const f32x16 (&o)[2], float scale, int hi) {
#pragma unroll
    for (int dt = 0; dt < 2; ++dt)
#pragma unroll
        for (int rg = 0; rg < 4; ++rg) { u32x2 w; w.x = cvt_pk_bf16(o[dt][4 * rg] * scale, o[dt][4 * rg + 1] * scale); w.y = cvt_pk_bf16(o[dt][4 * rg + 2] * scale, o[dt][4 * rg + 3] * scale);
            *(u32x2*)(dst + dt * 32 + 8 * rg + 4 * hi) = w; }
}

__device__ __forceinline__ bool in_phase(int k) { const __attribute__((address_space(4))) int* p_ = (const __attribute__((address_space(4))) int*)__builtin_amdgcn_kernarg_segment_ptr(); asm volatile("" : "+s"(p_)); return p_[114] <= k && k < p_[115]; }
__device__ __forceinline__ bool sub_on(int k) { const __attribute__((address_space(4))) int* p_ = (const __attribute__((address_space(4))) int*)__builtin_amdgcn_kernarg_segment_ptr(); asm volatile("" : "+s"(p_)); return (p_[116] >> k) & 1; }
__device__ __forceinline__ void s5_bu_tile(LAS unsigned char* tile, const bf16_t* bbf_g, const bf16_t* zs_tok0, int lane) {
    const int r32 = lane & 31, hi = lane >> 5;
    const bf16x8 uf = ldg8(zs_tok0 + (size_t)r32 * ZSW + 8 * hi);
#pragma unroll
    for (int pt = 0; pt < 4; ++pt) { f32x16 d = f32x16{}; d = MFMA32(ldg8(bbf_g + (size_t)(32 * pt + r32) * 16 + 8 * hi), uf, d);
#pragma unroll
        for (int rg = 0; rg < 4; ++rg) { u32x2 w; w.x = cvt_pk_bf16(d[4 * rg], d[4 * rg + 1]); w.y = cvt_pk_bf16(d[4 * rg + 2], d[4 * rg + 3]);
            *(LAS u32x2*)(tile + r32 * 272 + (32 * pt + 8 * rg + 4 * hi) * 2) = w; } }
    asm volatile("s_waitcnt lgkmcnt(0)" ::: "memory");
}
__device__ __forceinline__ int h0_pull(LAS unsigned* qc, int lane, int wg_items, int bid, int G, int total) {
    unsigned k = 0u; if (lane == 0) k = __hip_atomic_fetch_add(qc, 1u, __ATOMIC_RELAXED, __HIP_MEMORY_SCOPE_WORKGROUP);
    const int kk = __builtin_amdgcn_readfirstlane((int)k);
    return kk < wg_items ? bid + kk * G : total;
}
__device__ __forceinline__ int queue_pull(unsigned* ctr, volatile LAS unsigned* slot, int tid) {
    __syncthreads();
    if (tid == 0) *slot = __hip_atomic_fetch_add(ctr, 1u, __ATOMIC_RELAXED, __HIP_MEMORY_SCOPE_AGENT);
    __syncthreads();
    return (int)*slot;
}
constexpr int NPHASE = 24;
#ifndef DBG_NPH
#endif
__global__ void __launch_bounds__(512, 2) hybrid_fwd(Args args) {
    extern __shared__ __attribute__((aligned(16))) unsigned char lds_raw[];
    LAS unsigned char* lds0 = (LAS unsigned char*)lds_raw;
    volatile LAS unsigned* MISC = (volatile LAS unsigned*)(lds0 + MISC_OFF);
    for (int u = threadIdx.x; u < (LDS_BYTES - RING_BYTES) / 4; u += 512) ((LAS unsigned*)(lds0 + RING_BYTES))[u] = 0u;
    __syncthreads();
    const int lo = args.ph_lo, hi_ph = args.ph_hi;
    const bool one_launch = (hi_ph - lo) > 1;
    XcdBarrier bar; bar.bar = (unsigned*)(args.ws + WS_CTL) + CW_BAR; bar.x = 0; bar.st = nullptr;
    if (one_launch) bar = xcd_barrier_post((unsigned*)(args.ws + WS_CTL) + CW_BAR, MISC + 8);
#ifndef SUBMASK
#define SUBMASK 0xFFFFu
#endif
#define SUB(k) ((((SUBMASK) >> (k)) & 1u) && sub_on(k))
#ifndef PHMASK
#define PHMASK 0xFFFFFFu
#endif
#define IN(k) ((((PHMASK) >> (k)) & 1u) && in_phase(k))
#define SEAM(k) do { if (IN(k) && IN((k) + 1)) { XcdBarrier b2_ = bar; asm volatile("" : "+s"(b2_.bar), "+s"(b2_.x)); xcd_barrier(b2_); } } while (0)

    if (IN(0)) { PHASE_BEGIN();
        LAS float* scr = (LAS float*)(F.lds + F.wave * 16384);
        int joff = 0;
        for (int l = 0; l < 2; ++l) {
            unsigned char* wl = ws + WS_WL + l * WL_STRIDE;
#define RUNJOB(...) do { const TJob jb_ = TJob{__VA_ARGS__}; int fst_ = F.gw - joff; if (fst_ < 0) fst_ += F.ngw; tjob_run_all(jb_, fst_, F.ngw, scr, F.lane); joff = (joff + tjob_items(jb_)) % F.ngw; } while (0)
            RUNJOB(INF(8) + (size_t)l * DM * DIN, (bf16_t*)(wl + WL_WIN), INF(4) + l * DM, DM, DIN, DIN, DM, 1, 1, 0, 0);
            RUNJOB(INF(22) + (size_t)l * 192 * 384, (bf16_t*)(wl + WL_SM + SM_WUQ), INF(20) + l * 192, 192, 384, 384, 192, 1, 0, 0, 0);
            RUNJOB(INF(23) + (size_t)l * 128 * 512, (bf16_t*)(wl + WL_SM + SM_WUKV), INF(21) + l * 128, 128, 512, 512, 128, 1, 0, 0, 0);
            RUNJOB(INF(28) + (size_t)l * 4 * 4096, (bf16_t*)(wl + WL_SM + SM_WR), nullptr, 64, 64, 64, 64, 4, 0, 4096, 4096);
            RUNJOB(INF(30) + (size_t)l * 4 * 4096, (bf16_t*)(wl + WL_SM + SM_WI), nullptr, 64, 64, 64, 64, 4, 0, 4096, 4096);
            RUNJOB(INF(18) + (size_t)l * 65536, (bf16_t*)(wl + WL_SM + SM_WGLU), nullptr, 256, 256, 256, 256, 1, 0, 0, 0);
            RUNJOB(INF(40) + (size_t)l * 4 * 256 * DM, (bf16_t*)(wl + WL_PT), nullptr, 256, DM, DM, 256, 4, 0, (size_t)256 * DM, (size_t)DM * 256);
            RUNJOB(INF(41) + (size_t)l * DM * DM, (bf16_t*)(wl + WL_WO), nullptr, DM, DM, DM, DM, 1, 0, 0, 0);
            RUNJOB(INF(42) + (size_t)l * DM * 256, (bf16_t*)(wl + WL_WXQ), INF(5) + l * DM, DM, 256, 256, DM, 1, 0, 0, 0);
            RUNJOB(INF(43) + (size_t)l * DM * 256, (bf16_t*)(wl + WL_WXKV), INF(6) + l * DM, DM, 256, 256, DM, 1, 0, 0, 0);
            RUNJOB(INF(44) + (size_t)l * DM * 256, (bf16_t*)(wl + WL_WXKV) + (size_t)256 * DM, INF(6) + l * DM, DM, 256, 256, DM, 1, 0, 0, 0);
            RUNJOB(INF(45) + (size_t)l * 256 * DM, (bf16_t*)(wl + WL_WXO), nullptr, 256, DM, DM, 256, 1, 0, 0, 0);
            { u32x4* z = (u32x4*)((bf16_t*)(wl + WL_WIN) + (size_t)C_END * DM); const int n16 = (ZSW - C_END) * DM * 2 / 16;
              for (int i = F.bid * 512 + F.tid; i < n16; i += F.G * 512) z[i] = (u32x4){0u, 0u, 0u, 0u}; }
        }
        {
            RUNJOB(INF(48), (bf16_t*)(ws + WS_WGU), INF(7), DM, FF, FF, DM, 1, 2, 0, 0);
            RUNJOB(INF(49), (bf16_t*)(ws + WS_WGU), INF(7), DM, FF, FF, DM, 1, 3, 0, 0);
            RUNJOB(INF(50), (bf16_t*)(ws + WS_WD), nullptr, FF, DM, DM, FF, 1, 0, 0, 0, G2_FP8);
        }
        for (int i = F.bid * 512 + F.tid; i < 2 * 16 * 64; i += F.G * 512) {
            const int l = i >> 10, g = (i >> 6) & 15, p = i & 63;
            const float dt = __expf(INF(12)[l * 16 + g]);
            const float lr = INF(10)[(l * 16 + g) * 64 + p], li = INF(11)[(l * 16 + g) * 64 + p];
            const float mag = __expf(lr * dt); float sn, cs; sincos_red(li * dt, sn, cs);
            const float ar = mag * cs, ai = mag * sn, den = lr * lr + li * li;
            const float zr = ((ar - 1.f) * lr + ai * li) / den, zi = (ai * lr - (ar - 1.f) * li) / den;
            float* tb = S5T + (size_t)(l * 16 + g) * 36 * 64;
            for (int c = 0; c < 16; ++c) { const float br = INF(13)[((l * 16 + g) * 64 + p) * 16 + c], bi = INF(14)[((l * 16 + g) * 64 + p) * 16 + c];
                tb[c * 64 + p] = zr * br - zi * bi; tb[(16 + c) * 64 + p] = zr * bi + zi * br;
                BBF[((size_t)(l * 16 + g) * 128 + p) * 16 + c] = f2bf(zr * br - zi * bi); BBF[((size_t)(l * 16 + g) * 128 + 64 + p) * 16 + c] = f2bf(zr * bi + zi * br); }
            tb[32 * 64 + p] = ar; tb[33 * 64 + p] = ai;
            float pr = ar, pi = ai;
            for (int s = 0; s < 6; ++s) { const float nr = pr * pr - pi * pi, ni = 2.f * pr * pi; pr = nr; pi = ni; }
            tb[34 * 64 + p] = pr; tb[35 * 64 + p] = pi;
            bf16_t* cm = CMAT + (size_t)(l * 16 + g) * 16 * 128;
            for (int c = 0; c < 16; ++c) { cm[c * 128 + p] = f2bf(INF(15)[((l * 16 + g) * 16 + c) * 64 + p]); cm[c * 128 + 64 + p] = f2bf(-INF(16)[((l * 16 + g) * 16 + c) * 64 + p]); }
        }
        for (int i = F.bid * 512 + F.tid; i < 512; i += F.G * 512) { const float lam = INF(32)[i]; MISCT[i] = 8.f * log1pf(__expf(-lam)); }
        if (F.bid == 0 && F.tid < 2) { const int l = F.tid; float s1 = 0.f, s2 = 0.f;
            for (int d = 0; d < 32; ++d) { s1 += INF(35)[l * 32 + d] * INF(36)[l * 32 + d]; s2 += INF(37)[l * 32 + d] * INF(38)[l * 32 + d]; }
            const float lam_init = 0.8f - 0.6f * expf(-0.3f * (float)l);
            MISCT[512 + l] = expf(s1) - expf(s2) + lam_init; MISCT[514 + l] = lam_init;
            float gq = 0.f, gk = 0.f; for (int d = 0; d < 96; ++d) { gq = fmaxf(gq, fabsf(INF(24)[l * 96 + d])); gk = fmaxf(gk, fabsf(INF(25)[l * 96 + d])); }
            MISCT[516 + l * 4 + 0] = 1.02f * gq * gk * 9.797958971f * LOG2E;
            gq = 0.f; gk = 0.f; for (int d = 0; d < 32; ++d) { gq = fmaxf(gq, fabsf(INF(33)[l * 32 + d])); gk = fmaxf(gk, fabsf(INF(34)[l * 32 + d])); }
            float bm = 0.f; for (int i = 0; i < 128; ++i) bm = fmaxf(bm, fabsf(INF(3)[i]));
            MISCT[516 + l * 4 + 1] = 1.02f * gq * gk * 5.656854249f * LOG2E + bm * LOG2E;
            gq = 0.f; gk = 0.f; for (int d = 0; d < 64; ++d) { gq = fmaxf(gq, fabsf(INF(46)[l * 64 + d])); gk = fmaxf(gk, fabsf(INF(47)[l * 64 + d])); }
            MISCT[516 + l * 4 + 2] = 1.02f * gq * gk * 8.f * LOG2E; }
        for (int i = F.bid * 512 + F.tid; i < 4 * 384; i += F.G * 512) { const int h = i / 384, dd = i % 384 - 128, d = dd > 127 ? 127 : dd; int bk;
            if (d < 16) bk = d < 0 ? 0 : d; else { const float lr_ = logf((float)d / 16.f) / logf(8.f); bk = 16 + (int)(lr_ * 16.f); if (bk > 31) bk = 31; }
            MISCT[1024 + i] = dd < 0 ? 0.f : INF(3)[bk * 4 + h] * LOG2E; }
        for (int m = F.gw; m < MTOK; m += F.ngw) {
            const f32x4* xr = (const f32x4*)(INF(0) + (size_t)m * DM) + F.lane; float s = 0.f;
            u32x2* o8 = (u32x2*)(XB + (size_t)m * DM) + F.lane;
#pragma unroll
            for (int j = 0; j < 4; ++j) { const f32x4 v = __builtin_nontemporal_load(xr + 64 * j); s += (v.x * v.x + v.y * v.y) + (v.z * v.z + v.w * v.w); u32x2 w; w.x = cvt_pk_bf16(v.x, v.y); w.y = cvt_pk_bf16(v.z, v.w); o8[64 * j] = w; }
            s = wave_sum(s); if (F.lane < 16) RS[(size_t)m * 16 + F.lane] = F.lane == 0 ? s : 0.f;
        }
    }
    SEAM(0);

    for (int l = 0; l < 2; ++l) {
        const int pb = 1 + 10 * l;
        if (IN(pb + 0)) { PHASE_BEGIN();
            pg8::Gemm g{XB, (const bf16_t*)(WLP(l) + WL_WIN), DM, nullptr}; pg8::StaticOrder S; S.init(MTOK / 256, NIN / 256, F.G, F.bid);
            pg8::EpiIn E{ZS, ZG, RS + (size_t)(l == 0 ? 0 : 3) * MTOK * 16, INF(9) + (size_t)l * 4 * DM};
            pg8::gemm_phase<pg8::EpiIn, pg8::StaticOrder, true, false>(F.lds, g, S, E);
        }
        SEAM(pb + 0);
        if (IN(pb + 1)) { PHASE_BEGIN();
            const int lane = F.lane, r = lane & 31, hi = lane >> 5;
            bf16_t* QM = (bf16_t*)(ws + WS_QM); bf16_t* KM = (bf16_t*)(ws + WS_KM); bf16_t* VMT = (bf16_t*)(ws + WS_VMT);
            if (SUB(0) && F.wave < 2) for (int tt = F.bid * 2 + F.wave; tt < 512; tt += F.G * 2) {
                const int row = tt * 32 + r, b = row >> 12, s = row & 4095;
                bf16x8 xq[12]; float ss = 0.f;
#pragma unroll
                for (int ks = 0; ks < 12; ++ks) { xq[ks] = ldg8(ZS + (size_t)row * ZSW + C_CQ + 16 * ks + 8 * hi); ss += sq8(xq[ks]); }
                ss += __shfl_xor(ss, 32); const float rc = frsq(ss * (1.f / 192.f) + EPS);
                const float pos = (float)((const int*)INF(2))[row]; float cs[8], sn[8];
#pragma unroll
                for (int i = 0; i < 8; ++i) { const int fi = crow(i, hi); const float inv = exp2f(-(float)fi * (13.287712379549449f / 16.f)); sincos_red(pos * inv, sn[i], cs[i]); }
                const bf16_t* W = (const bf16_t*)(WLP(l) + WL_SM + SM_WUQ); const float* gq = INF(24) + l * 96;
#pragma unroll 1
                for (int hd = 0; hd < 4; ++hd) {
                    f32x16 acc[3] = {f32x16{}, f32x16{}, f32x16{}};
#pragma unroll
                    for (int ft = 0; ft < 3; ++ft) {
#pragma unroll
                        for (int ks = 0; ks < 12; ++ks) acc[ft] = MFMA32(ldg8(W + (size_t)(hd * 96 + 32 * ft + r) * 192 + 16 * ks + 8 * hi), xq[ks], acc[ft]); }
                    float s2 = 0.f;
#pragma unroll
                    for (int ft = 0; ft < 3; ++ft)
#pragma unroll
                        for (int q = 0; q < 16; ++q) { acc[ft][q] *= rc; s2 += acc[ft][q] * acc[ft][q]; }
                    s2 += __shfl_xor(s2, 32); const float rq = frsq(s2 * (1.f / 96.f) + EPS);
#pragma unroll
                    for (int ft = 0; ft < 3; ++ft)
#pragma unroll
                        for (int q = 0; q < 16; ++q) acc[ft][q] *= rq * gq[32 * ft + crow(q, hi)];
#pragma unroll
                    for (int q = 0; q < 8; ++q) { const float x1 = acc[2][q], x2 = acc[2][q + 8]; acc[2][q] = x1 * cs[q] - x2 * sn[q]; acc[2][q + 8] = x1 * sn[q] + x2 * cs[q]; }
                    const float qs = 0.10206207261596577f * LOG2E;
                    bf16_t* dst = QM + ((size_t)(b * 4 + hd) * SEQ + s) * 96;
#pragma unroll
                    for (int ft = 0; ft < 3; ++ft)
#pragma unroll
                        for (int rg = 0; rg < 4; ++rg) { u32x2 w; w.x = cvt_pk_bf16(acc[ft][4 * rg] * qs, acc[ft][4 * rg + 1] * qs); w.y = cvt_pk_bf16(acc[ft][4 * rg + 2] * qs, acc[ft][4 * rg + 3] * qs);
                            *(u32x2*)(dst + 32 * ft + 8 * rg + 4 * hi) = w; }
                }
            }
            if (SUB(1) && (F.wave == 2 || F.wave == 3)) for (int tt = F.bid * 2 + F.wave - 2; tt < 512; tt += F.G * 2) {
                const int row = tt * 32 + r, b = row >> 12, s = row & 4095;
                bf16x8 xk[8]; float ss = 0.f;
#pragma unroll
                for (int ks = 0; ks < 8; ++ks) { xk[ks] = ldg8(ZS + (size_t)row * ZSW + C_CKV + 16 * ks + 8 * hi); ss += sq8(xk[ks]); }
                ss += __shfl_xor(ss, 32); const float rc = frsq(ss * (1.f / 128.f) + EPS);
                float kp[16]; float sskp = 0.f;
#pragma unroll
                for (int rg = 0; rg < 4; ++rg) { const u32x2 w = *(const u32x2*)(ZS + (size_t)row * ZSW + C_KPE + 8 * rg + 4 * hi);
                    kp[4 * rg] = bflo(w.x); kp[4 * rg + 1] = bfhi(w.x); kp[4 * rg + 2] = bflo(w.y); kp[4 * rg + 3] = bfhi(w.y); }
#pragma unroll
                for (int q = 0; q < 16; ++q) sskp += kp[q] * kp[q];
                const float pos = (float)((const int*)INF(2))[row]; float cs[8], sn[8];
#pragma unroll
                for (int i = 0; i < 8; ++i) { const int fi = crow(i, hi); const float inv = exp2f(-(float)fi * (13.287712379549449f / 16.f)); sincos_red(pos * inv, sn[i], cs[i]); }
                const bf16_t* W = (const bf16_t*)(WLP(l) + WL_SM + SM_WUKV); const float* gk = INF(25) + l * 96;
#pragma unroll 1
                for (int hd = 0; hd < 4; ++hd) {
                    f32x16 acc[4] = {f32x16{}, f32x16{}, f32x16{}, f32x16{}};
#pragma unroll
                    for (int ft = 0; ft < 4; ++ft) {
#pragma unroll
                        for (int ks = 0; ks < 8; ++ks) acc[ft] = MFMA32(ldg8(W + (size_t)(hd * 128 + 32 * ft + r) * 128 + 16 * ks + 8 * hi), xk[ks], acc[ft]); }
                    float s2 = sskp;
#pragma unroll
                    for (int ft = 0; ft < 2; ++ft)
#pragma unroll
                        for (int q = 0; q < 16; ++q) { acc[ft][q] *= rc; s2 += acc[ft][q] * acc[ft][q]; }
                    s2 += __shfl_xor(s2, 32); const float rk = frsq(s2 * (1.f / 96.f) + EPS);
                    float kr[16];
#pragma unroll
                    for (int q = 0; q < 16; ++q) kr[q] = kp[q] * rk * gk[64 + crow(q, hi)];
#pragma unroll
                    for (int q = 0; q < 8; ++q) { const float x1 = kr[q], x2 = kr[q + 8]; kr[q] = x1 * cs[q] - x2 * sn[q]; kr[q + 8] = x1 * sn[q] + x2 * cs[q]; }
                    bf16_t* dst = KM + ((size_t)(b * 4 + hd) * SEQ + s) * 96;
#pragma unroll
                    for (int ft = 0; ft < 2; ++ft)
#pragma unroll
                        for (int rg = 0; rg < 4; ++rg) { const float* gp = gk + 32 * ft + 8 * rg + 4 * hi; u32x2 w;
                            w.x = cvt_pk_bf16(acc[ft][4 * rg] * rk * gp[0], acc[ft][4 * rg + 1] * rk * gp[1]); w.y = cvt_pk_bf16(acc[ft][4 * rg + 2] * rk * gp[2], acc[ft][4 * rg + 3] * rk * gp[3]);
                            *(u32x2*)(dst + 32 * ft + 8 * rg + 4 * hi) = w; }
#pragma unroll
                    for (int rg = 0; rg < 4; ++rg) { u32x2 w; w.x = cvt_pk_bf16(kr[4 * rg], kr[4 * rg + 1]); w.y = cvt_pk_bf16(kr[4 * rg + 2], kr[4 * rg + 3]); *(u32x2*)(dst + 64 + 8 * rg + 4 * hi) = w; }
                    bf16_t* vd = VMT + (size_t)(b * 4 + hd) * 64 * SEQ + s;
#pragma unroll
                    for (int ft = 2; ft < 4; ++ft)
#pragma unroll
                        for (int q = 0; q < 16; ++q) vd[(size_t)(32 * (ft - 2) + crow(q, hi)) * SEQ] = f2bf(acc[ft][q] * rc);
                }
            }
            if (SUB(2)) {
                bf16_t* QD = (bf16_t*)(ws + WS_QD); bf16_t* KD = (bf16_t*)(ws + WS_KD); bf16_t* VDT = (bf16_t*)(ws + WS_VDT);
                const float* gqn = INF(33) + l * 32; const float* gkn = INF(34) + l * 32;
                for (int i = F.bid * 512 + F.tid; i < MTOK * 16; i += F.G * 512) {
                    const int row = i & (MTOK - 1), j = i >> 14, half = j & 1, hd = (j >> 1) & 3, isk = j >> 3;
                    const bf16_t* src = ZS + (size_t)row * ZSW + (isk ? C_KD : C_QD) + hd * 64 + half * 32;
                    bf16x8 v[4]; float ss = 0.f;
#pragma unroll
                    for (int c = 0; c < 4; ++c) { v[c] = ldg8(src + 8 * c); ss += sq8(v[c]); }
                    const float rs = frsq(ss * (1.f / 32.f) + EPS) * (isk ? 1.f : 0.17677669529663687f * LOG2E);
                    const float* gg = isk ? gkn : gqn; const int b = row >> 12, s = row & 4095;
                    bf16_t* dst = (isk ? KD : QD) + ((size_t)(b * 4 + hd) * SEQ + s) * 64 + half * 32;
#pragma unroll
                    for (int c = 0; c < 4; ++c) { u32x4 w = *(u32x4*)&v[c]; const float* gp = gg + 8 * c;
                        w.x = cvt_pk_bf16(bflo(w.x) * rs * gp[0], bfhi(w.x) * rs * gp[1]); w.y = cvt_pk_bf16(bflo(w.y) * rs * gp[2], bfhi(w.y) * rs * gp[3]);
                        w.z = cvt_pk_bf16(bflo(w.z) * rs * gp[4], bfhi(w.z) * rs * gp[5]); w.w = cvt_pk_bf16(bflo(w.w) * rs * gp[6], bfhi(w.w) * rs * gp[7]);
                        *(u32x4*)(dst + 8 * c) = w; }
                }
                for (int i = F.bid * 512 + F.tid; i < MTOK * 32; i += F.G * 512) {
                    const int row = i & (MTOK - 1), j = i >> 14, oc = j & 7, hd = j >> 3, b = row >> 12, s = row & 4095;
                    const bf16x8 v = ldg8(ZS + (size_t)row * ZSW + C_VD + hd * 64 + oc * 8);
                    bf16_t* vd = VDT + ((size_t)(b * 4 + hd) * 64 + oc * 8) * SEQ + s;
#pragma unroll
                    for (int e = 0; e < 8; ++e) vd[(size_t)e * SEQ] = (bf16_t)v[e];
                }
            }
            if (SUB(3)) {
                float* LA = (float*)(ws + WS_LA); float* LI = (float*)(ws + WS_LI); float* LSA = (float*)(ws + WS_LSUM); float* LSH = LSA + NB * 128 * 256;
                const float* cw = INF(26) + l * 4 * 256; const float* cb = INF(27) + l * 256; const float* br = INF(29) + l * 256; const float* bi = INF(31) + l * 256;
                const float* c8 = MISCT + l * 256;
                LAS float* lsa = (LAS float*)(F.lds + F.wave * 16384); LAS float* lsh = lsa + 32 * 64;
                for (int tk = F.gw; tk < NB * 128 * 4; tk += F.ngw) {
                    const int n = tk & 3, tile = (tk >> 2) & 127, b = tk >> 9, s = tile * 32 + r, row = b * SEQ + s, cbase = 64 * n;
                    bf16x8 xcb[4]; float xcf[4][8];
#pragma unroll
                    for (int ks = 0; ks < 4; ++ks) {
                        const int c0 = cbase + 16 * ks + 8 * hi;
#pragma unroll
                        for (int e = 0; e < 8; ++e) xcf[ks][e] = cb[c0 + e];
#pragma unroll
                        for (int k = 0; k < 4; ++k) { const int sr = s - 3 + k;
                            if (sr >= 0) { const bf16x8 xv = ldg8(ZS + (size_t)(b * SEQ + sr) * ZSW + C_XLRU + c0); const u32x4 w = *(const u32x4*)&xv; const float* wk = cw + k * 256 + c0;
                                xcf[ks][0] += wk[0] * bflo(w.x); xcf[ks][1] += wk[1] * bfhi(w.x); xcf[ks][2] += wk[2] * bflo(w.y); xcf[ks][3] += wk[3] * bfhi(w.y);
                                xcf[ks][4] += wk[4] * bflo(w.z); xcf[ks][5] += wk[5] * bfhi(w.z); xcf[ks][6] += wk[6] * bflo(w.w); xcf[ks][7] += wk[7] * bfhi(w.w); } }
                        u32x4 pw; pw.x = cvt_pk_bf16(xcf[ks][0], xcf[ks][1]); pw.y = cvt_pk_bf16(xcf[ks][2], xcf[ks][3]); pw.z = cvt_pk_bf16(xcf[ks][4], xcf[ks][5]); pw.w = cvt_pk_bf16(xcf[ks][6], xcf[ks][7]); xcb[ks] = *(bf16x8*)&pw;
                    }
                    const bf16_t* Wr = (const bf16_t*)(WLP(l) + WL_SM + SM_WR) + n * 4096; const bf16_t* Wi = (const bf16_t*)(WLP(l) + WL_SM + SM_WI) + n * 4096;
                    f32x16 ar_[2] = {f32x16{}, f32x16{}}, ai_[2] = {f32x16{}, f32x16{}};
#pragma unroll
                    for (int ft = 0; ft < 2; ++ft)
#pragma unroll
                        for (int ks = 0; ks < 4; ++ks) { ar_[ft] = MFMA32(ldg8(Wr + (32 * ft + r) * 64 + 16 * ks + 8 * hi), xcb[ks], ar_[ft]); ai_[ft] = MFMA32(ldg8(Wi + (32 * ft + r) * 64 + 16 * ks + 8 * hi), xcb[ks], ai_[ft]); }
                    float xloc[4][4], xrcv[4][4];
#pragma unroll
                    for (int ks = 0; ks < 4; ++ks)
#pragma unroll
                        for (int j = 0; j < 4; ++j) { xloc[ks][j] = hi ? xcf[ks][4 + j] : xcf[ks][j]; const float snd = hi ? xcf[ks][j] : xcf[ks][4 + j]; xrcv[ks][j] = __shfl_xor(snd, 32); }
#pragma unroll
                    for (int ft = 0; ft < 2; ++ft)
#pragma unroll
                        for (int rg = 0; rg < 4; ++rg) {
                            const int c0 = cbase + 32 * ft + 8 * rg + 4 * hi, ks = 2 * ft + (rg >> 1);
                            f32x4 av, iv;
#pragma unroll
                            for (int e = 0; e < 4; ++e) { const float xce = ((rg & 1) == hi) ? xloc[ks][e] : xrcv[ks][e];
                                const float rr = fsigmoid(ar_[ft][4 * rg + e] + br[c0 + e]), ii = fsigmoid(ai_[ft][4 * rg + e] + bi[c0 + e]);
                                const float la = -rr * c8[c0 + e]; const float a = fexp2(la * LOG2E); av[e] = a; iv[e] = sqrtf(fmaxf(1.f - a * a, 0.f)) * ii * xce; }
                            *(f32x4*)(LA + (size_t)row * 256 + c0) = av; *(f32x4*)(LI + (size_t)row * 256 + c0) = iv;
                            { const int sc_ = (32 * ft + 8 * rg + 4 * hi) ^ ((r & 7) << 2); *(LAS f32x4*)(lsa + r * 64 + sc_) = av; *(LAS f32x4*)(lsh + r * 64 + sc_) = iv; }
                        }
                    asm volatile("s_waitcnt lgkmcnt(0)" ::: "memory");
                    {
                        float ta = 1.f, th = 0.f;
#pragma unroll
                        for (int t = 0; t < 32; ++t) { const float a_ = lsa[t * 64 + (lane ^ ((t & 7) << 2))], h_ = lsh[t * 64 + (lane ^ ((t & 7) << 2))]; th = a_ * th + h_; ta = ta * a_; }
                        LSA[(size_t)(b * 128 + tile) * 256 + cbase + lane] = ta; LSH[(size_t)(b * 128 + tile) * 256 + cbase + lane] = th;
                    }
                    asm volatile("s_waitcnt lgkmcnt(0)" ::: "memory");
                }
            }
            if (SUB(4)) {
                float* S5S = (float*)(ws + WS_S5S);
                const int t5cnt = F.wave < 4 ? 1 : (F.wave == 4 ? 0 : 4), t5off = F.wave < 4 ? F.wave : 4 + 4 * (F.wave - 5);
                for (int tbk = F.bid; tbk < NB * 64; tbk += F.G) for (int tj = 0; tj < t5cnt; ++tj) { const int tk = tbk * 16 + t5off + tj;
                    const int g = tk & 15, ch = (tk >> 4) & 63, b = tk >> 10;
                    const float* tb = S5T + (size_t)(l * 16 + g) * 36 * 64 + lane;
                    const float ar = tb[32 * 64], ai = tb[33 * 64];
                    LAS unsigned char* tile = F.lds + F.wave * 16384;
                    float hr = 0.f, hi2 = 0.f;
#pragma unroll 1
                    for (int hf = 0; hf < 2; ++hf) {
                        s5_bu_tile(tile, BBF + (size_t)(l * 16 + g) * 128 * 16, ZS + (size_t)(b * SEQ + ch * 64 + hf * 32) * ZSW + C_S5 + 16 * g, lane);
#pragma unroll 8
                        for (int t2 = 0; t2 < 32; ++t2) { const float bur = bf2f(*(const LAS bf16_t*)(tile + t2 * 272 + lane * 2)), bui = bf2f(*(const LAS bf16_t*)(tile + t2 * 272 + 128 + lane * 2));
                            const float nr = ar * hr - ai * hi2 + bur, ni = ar * hi2 + ai * hr + bui; hr = nr; hi2 = ni; }
                        asm volatile("s_waitcnt lgkmcnt(0)" ::: "memory");
                    }
                    float* dst = S5S + ((size_t)((b * 64 + ch) * 16 + g) * 2) * 64 + lane; dst[0] = hr; dst[64] = hi2;
                }
            }
            if (SUB(5) && l == 0) {
                bf16_t* KX = (bf16_t*)(ws + WS_KX); bf16_t* VXT = (bf16_t*)(ws + WS_VXT);
                if (F.wave == 4) for (int tk = F.bid; tk < 2 * 32 * 4; tk += F.G) {
                    const int hd = tk & 3, mt = (tk >> 2) & 31, ly = tk >> 7, row = mt * 32 + r, b = row >> 8, jm = row & 255;
                    const bf16_t* W = (const bf16_t*)(ws + WS_WL + ly * WL_STRIDE + WL_WXKV);
                    f32x16 acc[4] = {f32x16{}, f32x16{}, f32x16{}, f32x16{}}; float ss = 0.f;
                    const float* mp = INF(1) + (size_t)row * DM + 8 * hi;
#pragma unroll 2
                    for (int ks = 0; ks < 64; ++ks) {
                        const f32x4 m0 = *(const f32x4*)(mp + 16 * ks), m1 = *(const f32x4*)(mp + 16 * ks + 4);
                        ss += (m0.x * m0.x + m0.y * m0.y) + (m0.z * m0.z + m0.w * m0.w) + (m1.x * m1.x + m1.y * m1.y) + (m1.z * m1.z + m1.w * m1.w);
                        const u32x4 pw = pg8::pack8(m0, m1); const bf16x8 xb = *(const bf16x8*)&pw;
#pragma unroll
                        for (int f = 0; f < 4; ++f) { const int wrow = (f < 2 ? 64 * hd + 32 * f : 256 + 64 * hd + 32 * (f - 2)) + r; acc[f] = MFMA32(ldg8(W + (size_t)wrow * DM + 16 * ks + 8 * hi), xb, acc[f]); }
                    }
                    ss += __shfl_xor(ss, 32); const float rm = frsq(ss * (1.f / DM) + EPS);
                    float s2 = 0.f;
#pragma unroll
                    for (int f = 0; f < 2; ++f)
#pragma unroll
                        for (int q = 0; q < 16; ++q) { acc[f][q] *= rm; s2 += acc[f][q] * acc[f][q]; }
                    s2 += __shfl_xor(s2, 32); const float rk = frsq(s2 * (1.f / 64.f) + EPS);
                    const float* gk = INF(47) + ly * 64;
                    bf16_t* kd = KX + ((size_t)(ly * 16 + b * 4 + hd) * 256 + jm) * 64;
#pragma unroll
                    for (int f = 0; f < 2; ++f)
#pragma unroll
                        for (int rg = 0; rg < 4; ++rg) { const float* gp = gk + 32 * f + 8 * rg + 4 * hi; u32x2 w;
                            w.x = cvt_pk_bf16(acc[f][4 * rg] * rk * gp[0], acc[f][4 * rg + 1] * rk * gp[1]); w.y = cvt_pk_bf16(acc[f][4 * rg + 2] * rk * gp[2], acc[f][4 * rg + 3] * rk * gp[3]);
                            *(u32x2*)(kd + 32 * f + 8 * rg + 4 * hi) = w; }
                    bf16_t* vd = VXT + (size_t)(ly * 16 + b * 4 + hd) * 64 * 256 + jm;
#pragma unroll
                    for (int f = 2; f < 4; ++f)
#pragma unroll
                        for (int q = 0; q < 16; ++q) vd[(size_t)(32 * (f - 2) + crow(q, hi)) * 256] = f2bf(acc[f][q] * rm);
                }
            }
        }
        SEAM(pb + 1);
        if (IN(pb + 2)) {
            if (SUB(6)) { PHASE_BEGIN();
            const int lane = F.lane, r32 = lane & 31, hi = lane >> 5, wid = F.wave;
            volatile LAS unsigned* qslot = (volatile LAS unsigned*)(F.lds + MISC_OFF + 64);
            for (int it = queue_pull(F.ctl + CW_Q + 64 * (4 * l + 0), qslot, F.tid); it < 256; it = queue_pull(F.ctl + CW_Q + 64 * (4 * l + 0), qslot, F.tid)) {
                {
                    const int bh = it & 15, qt = 15 - (it >> 4), b = bh >> 2, hd = bh & 3;
                    const bf16_t* QM = (const bf16_t*)(ws + WS_QM) + (size_t)bh * SEQ * 96; const bf16_t* KM = (const bf16_t*)(ws + WS_KM) + (size_t)bh * SEQ * 96;
                    const bf16_t* VMT = (const bf16_t*)(ws + WS_VMT) + (size_t)bh * 64 * SEQ;
                    f32x16 o[1][2]; float lsum[1];
                    attn_unit<96, 1, true, false, false>(F.lds, QM + (size_t)qt * 256 * 96, 96, KM, VMT, SEQ, 4 * (qt + 1), 256 * qt, nullptr, nullptr, 1.f, MISCT[516 + l * 4 + 0], o, lsum);
                    const int row = b * SEQ + qt * 256 + wid * 32 + r32;
                    attn_store(YB + (size_t)1 * MTOK * 256 + (size_t)row * 256 + hd * 64, o[0], frcp(lsum[0]), hi);
                }
            } }
            if (SUB(7)) { PHASE_BEGIN();
            const int lane = F.lane, r32 = lane & 31, hi = lane >> 5, wid = F.wave;
            LAS float* lut = (LAS float*)(F.lds + 106496);
            for (int i = F.tid; i < 4 * 384; i += 512) lut[i] = MISCT[1024 + i];
            __syncthreads();
            volatile LAS unsigned* qslot = (volatile LAS unsigned*)(F.lds + MISC_OFF + 64);
            for (int it = queue_pull(F.ctl + CW_Q + 64 * (4 * l + 1), qslot, F.tid); it < 256; it = queue_pull(F.ctl + CW_Q + 64 * (4 * l + 1), qslot, F.tid)) {
                {
                    const int bh = it & 15, qt = 15 - (it >> 4), b = bh >> 2, hd = bh & 3;
                    const bf16_t* QD = (const bf16_t*)(ws + WS_QD) + (size_t)bh * SEQ * 64; const bf16_t* KD = (const bf16_t*)(ws + WS_KD) + (size_t)bh * SEQ * 64;
                    const bf16_t* VDT = (const bf16_t*)(ws + WS_VDT) + (size_t)bh * 64 * SEQ;
                    f32x16 o[2][2]; float lsum[2];
                    attn_unit<64, 2, true, true, false>(F.lds, QD + (size_t)qt * 256 * 64, 64, KD, VDT, SEQ, 4 * (qt + 1), 256 * qt, lut + hd * 384, nullptr, 1.f, MISCT[516 + l * 4 + 1], o, lsum);
                    const float lam = MISCT[512 + l], lam_init = MISCT[514 + l];
                    const float i1 = frcp(lsum[0]), i2 = lam * frcp(lsum[1]); float ss = 0.f;
#pragma unroll
                    for (int dt = 0; dt < 2; ++dt)
#pragma unroll
                        for (int q = 0; q < 16; ++q) { const float v = o[0][dt][q] * i1 - o[1][dt][q] * i2; o[0][dt][q] = v; ss += v * v; }
                    ss += __shfl_xor(ss, 32); const float rs = frsq(ss * (1.f / 64.f) + EPS) * (1.f - lam_init);
                    const float* gs = INF(39) + l * 64;
#pragma unroll
                    for (int dt = 0; dt < 2; ++dt)
#pragma unroll
                        for (int q = 0; q < 16; ++q) o[0][dt][q] *= gs[32 * dt + crow(q, hi)];
                    const int row = b * SEQ + qt * 256 + wid * 32 + r32;
                    attn_store(YB + (size_t)3 * MTOK * 256 + (size_t)row * 256 + hd * 64, o[0], rs, hi);
                }
            } }
            if (SUB(8)) { PHASE_BEGIN();
            const int lane = F.lane, r32 = lane & 31, hi = lane >> 5, wid = F.wave;
            volatile LAS unsigned* qslot = (volatile LAS unsigned*)(F.lds + MISC_OFF + 64);
            for (int it = queue_pull(F.ctl + CW_Q + 64 * (4 * l + 2), qslot, F.tid); it < 256; it = queue_pull(F.ctl + CW_Q + 64 * (4 * l + 2), qslot, F.tid)) {
                {
                    const int b = it >> 6, ch = it & 63, row0 = b * SEQ + ch * 64;
                    LAS unsigned char* hbuf = F.lds + wid * 8704;
                    LAS unsigned char* ypre = F.lds + 69632;
                    const float* S5S = (const float*)(ws + WS_S5S);
#pragma unroll 1
                    for (int gg = 0; gg < 2; ++gg) {
                        const int g = 2 * wid + gg;
                        const float* tb = S5T + (size_t)(l * 16 + g) * 36 * 64 + lane;
                        const float ar = tb[32 * 64], ai = tb[33 * 64], a64r = tb[34 * 64], a64i = tb[35 * 64];
                        float hr = 0.f, hi2 = 0.f;
                        for (int c0 = 0; c0 < ch; c0 += 8) {
                            float sr[8], si[8];
#pragma unroll
                            for (int u = 0; u < 8; ++u) { const int c = c0 + u; const bool ok = c < ch; const float* sp = S5S + ((size_t)((b * 64 + (ok ? c : 0)) * 16 + g) * 2) * 64 + lane; sr[u] = ok ? sp[0] : 0.f; si[u] = ok ? sp[64] : 0.f; }
#pragma unroll
                            for (int u = 0; u < 8; ++u) { if (c0 + u < ch) { const float nr = a64r * hr - a64i * hi2 + sr[u], ni = a64r * hi2 + a64i * hr + si[u]; hr = nr; hi2 = ni; } }
                        }
                        bf16x8 cf[4];
#pragma unroll
                        for (int ks = 0; ks < 4; ++ks) cf[ks] = ldg8(CMAT + (size_t)(l * 16 + g) * 16 * 128 + (lane & 15) * 128 + 32 * ks + 8 * (lane >> 4));
                        const float* dsk = INF(17) + l * 256 + 16 * g + 4 * (lane >> 4);
#pragma unroll 1
                        for (int hf = 0; hf < 2; ++hf) {
                            s5_bu_tile(hbuf, BBF + (size_t)(l * 16 + g) * 128 * 16, ZS + (size_t)(row0 + hf * 32) * ZSW + C_S5 + 16 * g, lane);
#pragma unroll 8
                            for (int t2 = 0; t2 < 32; ++t2) { const float bur = bf2f(*(const LAS bf16_t*)(hbuf + t2 * 272 + lane * 2)), bui = bf2f(*(const LAS bf16_t*)(hbuf + t2 * 272 + 128 + lane * 2));
                                const float nr = ar * hr - ai * hi2 + bur, ni = ar * hi2 + ai * hr + bui; hr = nr; hi2 = ni;
                                *(LAS bf16_t*)(hbuf + t2 * 272 + lane * 2) = f2bf(hr); *(LAS bf16_t*)(hbuf + t2 * 272 + 128 + lane * 2) = f2bf(hi2);
                            }
                            asm volatile("s_waitcnt lgkmcnt(0)" ::: "memory");
#pragma unroll
                            for (int tq = 0; tq < 2; ++tq) {
                                f32x4 yv = (f32x4){0.f, 0.f, 0.f, 0.f};
#pragma unroll
                                for (int ks = 0; ks < 4; ++ks) { const bf16x8 hb = *(const LAS bf16x8*)(hbuf + (16 * tq + (lane & 15)) * 272 + (32 * ks + 8 * (lane >> 4)) * 2); yv = MFMA16(cf[ks], hb, yv); }
                                const int tl = hf * 32 + 16 * tq + (lane & 15);
                                const u32x2 uw = *(const u32x2*)(ZS + (size_t)(row0 + tl) * ZSW + C_S5 + 16 * g + 4 * (lane >> 4));
                                yv[0] = fgelu(yv[0] + dsk[0] * bflo(uw.x)); yv[1] = fgelu(yv[1] + dsk[1] * bfhi(uw.x)); yv[2] = fgelu(yv[2] + dsk[2] * bflo(uw.y)); yv[3] = fgelu(yv[3] + dsk[3] * bfhi(uw.y));
                                u32x2 pw; pw.x = cvt_pk_bf16(yv[0], yv[1]); pw.y = cvt_pk_bf16(yv[2], yv[3]);
                                *(LAS u32x2*)(ypre + tl * 528 + (16 * g + 4 * (lane >> 4)) * 2) = pw;
                            }
                            asm volatile("s_waitcnt lgkmcnt(0)" ::: "memory");
                        }
                    }
                    __syncthreads();
                    {
                        const bf16_t* WG = (const bf16_t*)(WLP(l) + WL_SM + SM_WGLU);
                        f32x16 acc[2] = {f32x16{}, f32x16{}};
#pragma unroll 4
                        for (int ks = 0; ks < 16; ++ks) { const bf16x8 a = ldg8(WG + (size_t)(32 * wid + r32) * 256 + 16 * ks + 8 * hi);
#pragma unroll
                            for (int tt = 0; tt < 2; ++tt) acc[tt] = MFMA32(a, *(const LAS bf16x8*)(ypre + (32 * tt + r32) * 528 + (16 * ks + 8 * hi) * 2), acc[tt]); }
                        const float* bg = INF(19) + l * 256;
#pragma unroll
                        for (int tt = 0; tt < 2; ++tt)
#pragma unroll
                            for (int rg = 0; rg < 4; ++rg) { const int n0 = 32 * wid + 8 * rg + 4 * hi, t = 32 * tt + r32;
                                const u32x2 yw = *(const LAS u32x2*)(ypre + t * 528 + n0 * 2); u32x2 ow;
                                ow.x = cvt_pk_bf16(bflo(yw.x) * fsigmoid(acc[tt][4 * rg] + bg[n0]), bfhi(yw.x) * fsigmoid(acc[tt][4 * rg + 1] + bg[n0 + 1]));
                                ow.y = cvt_pk_bf16(bflo(yw.y) * fsigmoid(acc[tt][4 * rg + 2] + bg[n0 + 2]), bfhi(yw.y) * fsigmoid(acc[tt][4 * rg + 3] + bg[n0 + 3]));
                                *(u32x2*)(YB + (size_t)(row0 + t) * 256 + n0) = ow; }
                    }
                    __syncthreads();
                }
            }
            }
            if (SUB(9)) { PHASE_BEGIN(); const int lane = F.lane;
                const float* LA = (const float*)(ws + WS_LA); const float* LI = (const float*)(ws + WS_LI); const float* LSA = (const float*)(ws + WS_LSUM); const float* LSH = LSA + NB * 128 * 256;
                volatile LAS unsigned* qslot = (volatile LAS unsigned*)(F.lds + MISC_OFF + 64);
                for (int it = queue_pull(F.ctl + CW_Q + 64 * (4 * l + 3), qslot, F.tid); it < NB * 64 * 4 / 8; it = queue_pull(F.ctl + CW_Q + 64 * (4 * l + 3), qslot, F.tid)) {
                    const int tk = (NB * 64 * 4 / 8 - 1 - it) * 8 + F.wave;
                    const int n = tk & 3, ch = (tk >> 2) & 63, b = tk >> 8, c = 64 * n + lane;
                    float h = 0.f;
                    for (int tp0 = 0; tp0 < 2 * ch; tp0 += 16) {
                        float ca[16], chh[16];
#pragma unroll
                        for (int u = 0; u < 16; ++u) { const int tp = tp0 + u; const bool ok = tp < 2 * ch; const size_t o = (size_t)(b * 128 + (ok ? tp : 0)) * 256 + c; ca[u] = ok ? LSA[o] : 1.f; chh[u] = ok ? LSH[o] : 0.f; }
#pragma unroll
                        for (int u = 0; u < 16; ++u) h = ca[u] * h + chh[u];
                    }
                    const int row0 = b * SEQ + ch * 64;
#pragma unroll 1
                    for (int t0 = 0; t0 < 64; t0 += 16) {
                        float la[16], li[16], gt[16];
#pragma unroll
                        for (int u = 0; u < 16; ++u) { const size_t o = (size_t)(row0 + t0 + u) * 256 + c; la[u] = LA[o]; li[u] = LI[o]; gt[u] = bf2f(ZS[(size_t)(row0 + t0 + u) * ZSW + C_GLRU + c]); }
#pragma unroll
                        for (int u = 0; u < 16; ++u) { h = la[u] * h + li[u]; gt[u] = h * fgelu(gt[u]); }
#pragma unroll
                        for (int u = 0; u < 16; ++u) YB[(size_t)2 * MTOK * 256 + (size_t)(row0 + t0 + u) * 256 + c] = f2bf(gt[u]);
                    }
                }
            }
        }
        SEAM(pb + 2);
        if (IN(pb + 3)) { PHASE_BEGIN();
            pg8::Gemm g{YB, (const bf16_t*)(WLP(l) + WL_PT), 256, nullptr}; pg8::MergeOrder S{F.G, F.bid};
            pg8::EpiMerge E{MG, ZG};
            pg8::gemm_phase<pg8::EpiMerge, pg8::MergeOrder, true, false>(F.lds, g, S, E);
        }
        SEAM(pb + 3);
        if (IN(pb + 4)) { PHASE_BEGIN();
            pg8::Gemm g{MG, (const bf16_t*)(WLP(l) + WL_WO), DM, nullptr}; pg8::StaticOrder S; S.init(MTOK / 256, DM / 256, F.G, F.bid);
            pg8::EpiRes<false> E{nullptr, XB, RS + (size_t)(l == 0 ? 1 : 4) * MTOK * 16, nullptr};
            pg8::gemm_phase<pg8::EpiRes<false>, pg8::StaticOrder, false, false>(F.lds, g, S, E);
        }
        SEAM(pb + 4);
        if (IN(pb + 5)) { PHASE_BEGIN();
            pg8::Gemm g{XB, (const bf16_t*)(WLP(l) + WL_WXQ), DM, nullptr}; pg8::StaticOrder S; S.init(MTOK / 256, 1, F.G, F.bid);
            pg8::EpiRowScale E{(bf16_t*)(ws + WS_QX), 256, RS + (size_t)(l == 0 ? 1 : 4) * MTOK * 16};
            pg8::gemm_phase<pg8::EpiRowScale, pg8::StaticOrder, false, false>(F.lds, g, S, E);
        }
        SEAM(pb + 5);
        if (IN(pb + 6)) { PHASE_BEGIN();
            const int lane = F.lane, r32 = lane & 31, hi = lane >> 5, wid = F.wave;
            for (int it = F.bid; it < 256; it += F.G) {
                const int hd = it & 3, rt = it >> 2, b = rt >> 4;
                const bf16_t* QX = (const bf16_t*)(ws + WS_QX) + (size_t)rt * 256 * 256 + hd * 64;
                const bf16_t* KX = (const bf16_t*)(ws + WS_KX) + (size_t)(l * 16 + b * 4 + hd) * 256 * 64;
                const bf16_t* VXT = (const bf16_t*)(ws + WS_VXT) + (size_t)(l * 16 + b * 4 + hd) * 64 * 256;
                f32x16 o[1][2]; float lsum[1];
                attn_unit<64, 1, false, false, true>(F.lds, QX, 256, KX, VXT, 256, 4, 0, nullptr, INF(46) + l * 64, 0.125f * LOG2E, MISCT[516 + l * 4 + 2], o, lsum);
                const int row = rt * 256 + wid * 32 + r32;
                attn_store((bf16_t*)(ws + WS_OX) + (size_t)row * 256 + hd * 64, o[0], frcp(lsum[0]), hi);
            }
        }
        SEAM(pb + 6);
        if (IN(pb + 7)) { PHASE_BEGIN();
            pg8::Gemm g{(const bf16_t*)(ws + WS_OX), (const bf16_t*)(WLP(l) + WL_WXO), 256, nullptr}; pg8::StaticOrder S; S.init(MTOK / 256, DM / 256, F.G, F.bid);
            if (l == 0) { pg8::EpiRes<false> E{nullptr, XB, RS + (size_t)2 * MTOK * 16, nullptr}; pg8::gemm_phase<pg8::EpiRes<false>, pg8::StaticOrder, false, false>(F.lds, g, S, E); }
            else { pg8::EpiRes<false> E{nullptr, XB, RS + (size_t)5 * MTOK * 16, nullptr}; pg8::gemm_phase<pg8::EpiRes<false>, pg8::StaticOrder, false, false>(F.lds, g, S, E); }
        }
        SEAM(pb + 7);
        if (l == 0) {
            if (IN(9)) { PHASE_BEGIN();
                pg8::Gemm g{XB, (const bf16_t*)(ws + WS_WGU), DM, nullptr}; pg8::StaticOrder S; S.init(MTOK / 256, 2 * FF / 256, F.G, F.bid);
#if G2_FP8
                pg8::EpiSwiGLU8<true, false> E{ws + WS_HFF, FF, RS + (size_t)2 * MTOK * 16};
                pg8::gemm_phase<pg8::EpiSwiGLU8<true, false>, pg8::StaticOrder, true, false>(F.lds, g, S, E);
#else
                pg8::EpiSwiGLU<false> E{(bf16_t*)(ws + WS_HFF), FF, RS + (size_t)2 * MTOK * 16, nullptr};
                pg8::gemm_phase<pg8::EpiSwiGLU<false>, pg8::StaticOrder, true, false>(F.lds, g, S, E);
#endif
            }
            SEAM(9);
            if (IN(10)) { PHASE_BEGIN();
#if G2_FP8
                pg8::Gemm g{(const bf16_t*)(ws + WS_HFF), (const bf16_t*)(ws + WS_WD), FF / 2, nullptr}; pg8::StaticOrder S; S.init(MTOK / 256, DM / 256, F.G, F.bid);
                pg8::EpiRes<false, false, true> E{nullptr, XB, RS + (size_t)3 * MTOK * 16, nullptr};
                pg8::gemm_phase<pg8::EpiRes<false, false, true>, pg8::StaticOrder, false, false, true>(F.lds, g, S, E);
#else
                pg8::Gemm g{(const bf16_t*)(ws + WS_HFF), (const bf16_t*)(ws + WS_WD), FF, nullptr}; pg8::StaticOrder S; S.init(MTOK / 256, DM / 256, F.G, F.bid);
                pg8::EpiRes<false> E{nullptr, XB, RS + (size_t)3 * MTOK * 16, nullptr};
                pg8::gemm_phase<pg8::EpiRes<false>, pg8::StaticOrder, false, false>(F.lds, g, S, E);
#endif
            }
            SEAM(10);
        } else {
#define ROWTOK ((int*)(ws + WS_MOESM + MS_ROWTOK))
#define TOKW ((float*)(ws + WS_MOESM + MS_TOKW))
#define ASSIGN ((int*)(ws + WS_MOESM + MS_ASSIGN))
#define RSTD2 ((float*)(ws + WS_MOESM + MS_RSTD))
#define MCNT (F.ctl + CW_MOECNT)
            if (IN(19)) { PHASE_BEGIN();
                LAS float* wrs = (LAS float*)(F.lds);
                for (int i = F.tid; i < 8192; i += 512) wrs[i] = INF(51)[i] * INF(7)[DM + (i >> 3)];
                __syncthreads();
                if (SUB(10) && F.wave < 4) {
                    const int lane = F.lane;
                    for (int blk = F.bid; blk < 256; blk += F.G) {
                        unsigned cntv = 0u, mypack = 0u;
#pragma unroll 1
                        for (int j = 0; j < 16; ++j) {
                            const int tok = blk * 64 + F.wave * 16 + j;
                            const u32x2* xr = (const u32x2*)(XB + (size_t)tok * DM) + lane;
                            float lg[8] = {0.f, 0.f, 0.f, 0.f, 0.f, 0.f, 0.f, 0.f}; float ss = 0.f; f32x4 xv4[4];
#pragma unroll
                            for (int q = 0; q < 4; ++q) { const u32x2 xw = xr[64 * q]; const f32x4 v = {bflo(xw.x), bfhi(xw.x), bflo(xw.y), bfhi(xw.y)}; const int k0 = 256 * q + 4 * lane; xv4[q] = v;
                                ss += (v.x * v.x + v.y * v.y) + (v.z * v.z + v.w * v.w);
#pragma unroll
                                for (int e4 = 0; e4 < 4; ++e4) { const float xv = v[e4]; const LAS f32x4* wp = (const LAS f32x4*)(wrs + (k0 + e4) * 8); const f32x4 wa = wp[0], wb = wp[1];
                                    lg[0] += xv * wa.x; lg[1] += xv * wa.y; lg[2] += xv * wa.z; lg[3] += xv * wa.w; lg[4] += xv * wb.x; lg[5] += xv * wb.y; lg[6] += xv * wb.z; lg[7] += xv * wb.w; } }
                            ss = wave_sum(ss);
#pragma unroll
                            for (int e = 0; e < 8; ++e) lg[e] = wave_sum(lg[e]);
                            const float rstd = frsq(ss * (1.f / DM) + EPS);
                            { unsigned* xq = (unsigned*)(ws + WS_XQ + (size_t)tok * DM) + lane;
#pragma unroll
                              for (int q = 0; q < 4; ++q) xq[64 * q] = cvt_pk4_fp8(xv4[q].x * rstd, xv4[q].y * rstd, xv4[q].z * rstd, xv4[q].w * rstd); }
                            int e1 = 0; float v1 = lg[0];
#pragma unroll
                            for (int e = 1; e < 8; ++e) if (lg[e] > v1) { v1 = lg[e]; e1 = e; }
                            int e2 = -1; float v2 = -3.4e38f;
#pragma unroll
                            for (int e = 0; e < 8; ++e) if (e != e1 && lg[e] > v2) { v2 = lg[e]; e2 = e; }
                            if (e2 < 0) e2 = (e1 + 1) & 7;
                            const int se1 = __builtin_amdgcn_readfirstlane(e1), se2 = __builtin_amdgcn_readfirstlane(e2);
                            const unsigned r1 = __builtin_amdgcn_readlane(cntv, se1), r2 = __builtin_amdgcn_readlane(cntv, se2);
                            cntv += (lane == se1 ? 1u : 0u) + (lane == se2 ? 1u : 0u);
                            if (lane == j) mypack = (unsigned)se1 | (r1 << 4) | ((unsigned)se2 << 12) | (r2 << 16);
                            if (lane == 0) { const float w1 = frcp(1.f + __expf((v2 - v1) * rstd)); RSTD2[tok] = rstd; TOKW[tok * 2] = w1; TOKW[tok * 2 + 1] = 1.f - w1; }
                        }
                        unsigned basev = 0u;
                        if (lane < 8) basev = __hip_atomic_fetch_add(MCNT + 64 * lane, cntv, __ATOMIC_RELAXED, __HIP_MEMORY_SCOPE_AGENT);
                        const int pe1 = mypack & 15, pr1 = (mypack >> 4) & 255, pe2 = (mypack >> 12) & 15, pr2 = (mypack >> 16) & 255;
                        const unsigned b1 = __shfl(basev, pe1), b2 = __shfl(basev, pe2);
                        if (lane < 16) { const int tok = blk * 64 + F.wave * 16 + lane; ASSIGN[tok * 2] = pe1 | (int)((b1 + (unsigned)pr1) << 8); ASSIGN[tok * 2 + 1] = pe2 | (int)((b2 + (unsigned)pr2) << 8);
                            ROWTOK[pe1 * 16384 + (int)(b1 + (unsigned)pr1)] = tok; ROWTOK[pe2 * 16384 + (int)(b2 + (unsigned)pr2)] = tok; }
                    }
                }
                if (SUB(11)) {
                    LAS float* scr = (LAS float*)(F.lds + 40960 + F.wave * 8448);
                    const TJob j0{INF(52), (bf16_t*)(ws + WS_WMGU), INF(7) + DM, DM, EFF, EFF, DM, 8, 2, (size_t)DM * EFF, (size_t)2 * EFF * DM, 1};
                    const TJob j1{INF(53), (bf16_t*)(ws + WS_WMGU), INF(7) + DM, DM, EFF, EFF, DM, 8, 3, (size_t)DM * EFF, (size_t)2 * EFF * DM, 1};
                    const TJob j2{INF(54), (bf16_t*)(ws + WS_WMD), nullptr, EFF, DM, DM, EFF, 8, 0, (size_t)EFF * DM, (size_t)DM * EFF, 1};
                    constexpr int NI = 8 * (DM / 64) * (EFF / 32);
                    LAS unsigned* qc = (LAS unsigned*)(F.lds + MISC_OFF + 128);
                    const int wg_items = (3 * NI - F.bid + F.G - 1) / F.G;
#define H0_PULL() h0_pull(qc, F.lane, wg_items, F.bid, F.G, 3 * NI)
#define H0_JOB(idx) const int jn_ = (idx) / NI; TJob js_ = j0; if (jn_ == 1) { js_.W = j1.W; js_.map = 3; } if (jn_ == 2) js_ = j2;
#define H0_LOAD(idx, v) do { H0_JOB(idx) tjob_load(js_, (idx) - jn_ * NI, v, F.lane); } while (0)
#define H0_STORE(idx, v) do { H0_JOB(idx) tjob_store(js_, (idx) - jn_ * NI, v, scr, F.lane); } while (0)
                    float va[32] = {}, vb[32] = {}; int it = H0_PULL();
                    if (it < 3 * NI) { H0_LOAD(it, va);
                        for (;;) {
                            const int n1 = H0_PULL(); if (n1 < 3 * NI) H0_LOAD(n1, vb);
                            H0_STORE(it, va); if (n1 >= 3 * NI) break;
                            const int n2 = H0_PULL(); if (n2 < 3 * NI) H0_LOAD(n2, va);
                            H0_STORE(n1, vb); if (n2 >= 3 * NI) break;
                            it = n2;
                        } }
#undef H0_PULL
#undef H0_JOB
#undef H0_LOAD
#undef H0_STORE
                }
            }
            SEAM(19);
            if (IN(21)) { PHASE_BEGIN();
                pg8::Gemm g{(const bf16_t*)(ws + WS_XQ), (const bf16_t*)(ws + WS_WMGU), DM / 2, ROWTOK}; pg8::MoeOrder S; S.init(MCNT, 2 * EFF / 256, F.G, F.bid);
                pg8::EpiSwiGLU8<false> E{ws + WS_HMOE, EFF, nullptr};
                pg8::gemm_phase<pg8::EpiSwiGLU8<false>, pg8::MoeOrder, true, true, true>(F.lds, g, S, E);
            }
            SEAM(21);
            if (IN(22)) { PHASE_BEGIN();
                pg8::Gemm g{(const bf16_t*)(ws + WS_HMOE), (const bf16_t*)(ws + WS_WMD), EFF / 2, nullptr}; pg8::MoeOrder S; S.init(MCNT, DM / 256, F.G, F.bid);
                pg8::EpiPlain E{(bf16_t*)(ws + WS_YS), DM, 0.03125f};
                pg8::gemm_phase<pg8::EpiPlain, pg8::MoeOrder, true, false, true>(F.lds, g, S, E);
            }
            SEAM(22);
            if (IN(23)) { PHASE_BEGIN();
                const bf16_t* YS = (const bf16_t*)(ws + WS_YS);
                int pst[8]; { int acc = 0;
#pragma unroll
                    for (int e = 0; e < 8; ++e) { pst[e] = acc; acc += ((int)MCNT[64 * e] + 255) & ~255; } }
                for (int m = F.gw; m < MTOK; m += F.ngw) {
                    const int a1 = ASSIGN[2 * m], a2 = ASSIGN[2 * m + 1]; int p1 = 0, p2 = 0;
#pragma unroll
                    for (int q = 0; q < 8; ++q) { p1 = (q == (a1 & 255)) ? pst[q] : p1; p2 = (q == (a2 & 255)) ? pst[q] : p2; }
                    const int d1 = p1 + (a1 >> 8), d2 = p2 + (a2 >> 8); const float w1 = TOKW[2 * m], w2 = TOKW[2 * m + 1];
                    f32x4* xr = (f32x4*)(F.out + (size_t)m * DM) + F.lane; const u32x2* xbr = (const u32x2*)(XB + (size_t)m * DM) + F.lane;
                    const u32x2* y1 = (const u32x2*)(YS + (size_t)d1 * DM) + F.lane; const u32x2* y2 = (const u32x2*)(YS + (size_t)d2 * DM) + F.lane;
#pragma unroll
                    for (int j = 0; j < 4; ++j) { const u32x2 xw = xbr[64 * j]; f32x4 v = {bflo(xw.x), bfhi(xw.x), bflo(xw.y), bfhi(xw.y)}; const u32x2 a = __builtin_nontemporal_load(y1 + 64 * j), c = __builtin_nontemporal_load(y2 + 64 * j);
                        v.x += w1 * bflo(a.x) + w2 * bflo(c.x); v.y += w1 * bfhi(a.x) + w2 * bfhi(c.x); v.z += w1 * bflo(a.y) + w2 * bflo(c.y); v.w += w1 * bfhi(a.y) + w2 * bfhi(c.y);
                        __builtin_nontemporal_store(v, xr + 64 * j); }
                }
            }
        }
    }
#undef IN
#undef SEAM
}

#ifdef DBG_DUMP_OFF
__global__ void dbg_copy_bf16(const bf16_t* src, float* out, int n, int nv) { for (int i = blockIdx.x * 256 + threadIdx.x; i < n; i += gridDim.x * 256) out[i] = i < nv ? bf2f(src[i]) : 0.f; }
#endif

#ifdef DBG_CHECK
struct DbgArgs { const void* in[55]; unsigned char* ws; float* out; float* acc; };
#ifndef DBG_LAYER
#define DBG_LAYER 0
#endif
__device__ __forceinline__ size_t dstride(int i) {
    switch (i) { case 4: case 5: case 6: case 7: case 10: case 11: case 26: return 1024; case 8: return (size_t)DM * DIN; case 9: return 4096; case 12: return 16;
      case 13: case 14: case 15: case 16: case 28: case 30: return 16384; case 17: case 19: case 27: case 29: case 31: case 32: return 256; case 18: case 23: return 65536; case 20: return 192; case 21: return 128;
      case 22: return 73728; case 24: case 25: return 96; case 33: case 34: case 35: case 36: case 37: case 38: return 32; case 39: case 46: case 47: return 64; case 40: return (size_t)4 * 256 * DM; case 41: return (size_t)DM * DM;
      case 42: case 43: case 44: case 45: return (size_t)DM * 256; default: return 0; } }
#define DIN_(i) ((const float*)a.in[i] + (size_t)DBG_LAYER * dstride(i))
#define DXIN_ (DBG_LAYER == 0 ? (const float*)a.in[0] : (const float*)(a.ws + WS_DBG))
constexpr size_t WS_DBG = 440 * MiB;
__device__ float blk_sum(float v, float* sh) { sh[threadIdx.x] = v; __syncthreads(); for (int o = 128; o > 0; o >>= 1) { if ((int)threadIdx.x < o) sh[threadIdx.x] += sh[threadIdx.x + o]; __syncthreads(); } const float r = sh[0]; __syncthreads(); return r; }
__device__ float blk_max(float v, float* sh) { sh[threadIdx.x] = v; __syncthreads(); for (int o = 128; o > 0; o >>= 1) { if ((int)threadIdx.x < o) sh[threadIdx.x] = fmaxf(sh[threadIdx.x], sh[threadIdx.x + o]); __syncthreads(); } const float r = sh[0]; __syncthreads(); return r; }
__device__ void dbg_acc(float* acc, int k, float fast, float ref) { atomicMax((unsigned*)&acc[2 * k], __float_as_uint(fabsf(fast - ref))); atomicAdd(&acc[2 * k + 1], ref * ref); atomicAdd(&acc[64 + k], 1.f); }
__device__ float dsig(float x) { return 1.f / (1.f + expf(-x)); }
__device__ float dgelu(float x) { return 0.5f * x * (1.f + tanhf(0.7978845608028654f * (x + 0.044715f * x * x * x))); }
__device__ int dbucket(int d) { if (d < 16) return d < 0 ? 0 : d; int bk = 16 + (int)(logf((float)d / 16.f) / logf(8.f) * 16.f); return bk > 31 ? 31 : bk; }

__global__ void chk_z(DbgArgs a) {
    __shared__ float sh[256]; const int s = blockIdx.x, tid = threadIdx.x; const int row = (s * 7919 + 13) % MTOK; int col = (s * 104729 + 7 + (s >> 1)) % DIN; if (s & 1) col = col % C_END;
    const float* x = (DBG_LAYER == 0 ? (const float*)a.in[0] : (const float*)a.out) + (size_t)row * DM; const float* g = DIN_(4); const float* W = DIN_(8);
    float ss = 0.f, dot = 0.f; for (int k = tid; k < DM; k += 256) { const float xv = x[k]; ss += xv * xv; dot += xv * g[k] * W[(size_t)k * DIN + col]; }
    ss = blk_sum(ss, sh); dot = blk_sum(dot, sh);
    if (tid == 0) { const float z = dot * rsqrtf(ss / DM + EPS);
        if (col < C_END) dbg_acc(a.acc, 1, bf2f(((const bf16_t*)(a.ws + WS_ZS))[(size_t)row * ZSW + col]), z);
        else { const int gc = col - C_END; dbg_acc(a.acc, 2, bf2f(((const bf16_t*)(a.ws + WS_ZG))[(size_t)row * ZGW + gc]), dsig(z + DIN_(9)[gc])); } }
}
__global__ void chk_mla_prep(DbgArgs a) {
    __shared__ float sh[256]; __shared__ float vn[192]; __shared__ float qs[128];
    const int s = blockIdx.x, tid = threadIdx.x, row = (s * 7919 + 13) % MTOK, hd = s & 3, b = row >> 12, sq = row & 4095;
    const bf16_t* ZSp = (const bf16_t*)(a.ws + WS_ZS) + (size_t)row * ZSW; const float pos = (float)((const int*)a.in[2])[row];
    { const float v = tid < 192 ? bf2f(ZSp[C_CQ + tid]) : 0.f; const float ss = blk_sum(v * v, sh); if (tid < 192) vn[tid] = v * rsqrtf(ss / 192.f + EPS) * DIN_(20)[tid]; __syncthreads(); }
    float qf = 0.f; if (tid < 96) for (int k = 0; k < 192; ++k) qf += vn[k] * DIN_(22)[k * 384 + hd * 96 + tid];
    { const float ss = blk_sum(tid < 96 ? qf * qf : 0.f, sh); if (tid < 96) qs[tid] = qf * rsqrtf(ss / 96.f + EPS) * DIN_(24)[tid]; __syncthreads(); }
    if (tid < 96) { float val = qs[tid]; if (tid >= 64) { const int i = (tid - 64) & 15; float sn, cs; sincos_red(pos * exp2f(-(float)i * (13.287712379549449f / 16.f)), sn, cs); const float x1 = qs[64 + i], x2 = qs[80 + i]; val = tid < 80 ? x1 * cs - x2 * sn : x1 * sn + x2 * cs; }
        val *= 0.10206207261596577f * LOG2E; dbg_acc(a.acc, 3, bf2f(((const bf16_t*)(a.ws + WS_QM))[((size_t)(b * 4 + hd) * SEQ + sq) * 96 + tid]), val); }
    __syncthreads();
    { const float v = tid < 128 ? bf2f(ZSp[C_CKV + tid]) : 0.f; const float ss = blk_sum(v * v, sh); if (tid < 128) vn[tid] = v * rsqrtf(ss / 128.f + EPS) * DIN_(21)[tid]; __syncthreads(); }
    float kv = 0.f; if (tid < 128) for (int k = 0; k < 128; ++k) kv += vn[k] * DIN_(23)[k * 512 + hd * 128 + tid];
    float kfull = 0.f; if (tid < 64) kfull = kv; else if (tid < 96) kfull = bf2f(ZSp[C_KPE + tid - 64]);
    { const float ss = blk_sum(tid < 96 ? kfull * kfull : 0.f, sh); if (tid < 96) qs[tid] = kfull * rsqrtf(ss / 96.f + EPS) * DIN_(25)[tid]; __syncthreads(); }
    if (tid < 96) { float val = qs[tid]; if (tid >= 64) { const int i = (tid - 64) & 15; float sn, cs; sincos_red(pos * exp2f(-(float)i * (13.287712379549449f / 16.f)), sn, cs); const float x1 = qs[64 + i], x2 = qs[80 + i]; val = tid < 80 ? x1 * cs - x2 * sn : x1 * sn + x2 * cs; }
        dbg_acc(a.acc, 4, bf2f(((const bf16_t*)(a.ws + WS_KM))[((size_t)(b * 4 + hd) * SEQ + sq) * 96 + tid]), val); }
    if (tid >= 64 && tid < 128) dbg_acc(a.acc, 5, bf2f(((const bf16_t*)(a.ws + WS_VMT))[((size_t)(b * 4 + hd) * 64 + tid - 64) * SEQ + sq]), kv);
}
__global__ void chk_diff_prep(DbgArgs a) {
    const int i = blockIdx.x * 256 + threadIdx.x; const int row = (i * 37 + 5) % MTOK, hd = i & 3, half = (i >> 2) & 1, isk = (i >> 3) & 1, b = row >> 12, sq = row & 4095;
    const bf16_t* src = (const bf16_t*)(a.ws + WS_ZS) + (size_t)row * ZSW + (isk ? C_KD : C_QD) + hd * 64 + half * 32;
    float ss = 0.f; for (int d = 0; d < 32; ++d) { const float v = bf2f(src[d]); ss += v * v; }
    const float rs = rsqrtf(ss / 32.f + EPS) * (isk ? 1.f : 0.17677669529663687f * LOG2E); const float* gg = DIN_(isk ? 34 : 33);
    const bf16_t* dst = (const bf16_t*)(a.ws + (isk ? WS_KD : WS_QD)) + ((size_t)(b * 4 + hd) * SEQ + sq) * 64 + half * 32;
    for (int d = 0; d < 32; ++d) dbg_acc(a.acc, 6, bf2f(dst[d]), bf2f(src[d]) * rs * gg[d]);
    const bf16_t* vs = (const bf16_t*)(a.ws + WS_ZS) + (size_t)row * ZSW + C_VD + hd * 64;
    for (int d = half * 32; d < half * 32 + 32; ++d) dbg_acc(a.acc, 7, bf2f(((const bf16_t*)(a.ws + WS_VDT))[((size_t)(b * 4 + hd) * 64 + d) * SEQ + sq]), bf2f(vs[d]));
}
__global__ void __launch_bounds__(256) chk_lru_prep(DbgArgs a) {
    __shared__ float xcs[64]; const int s = blockIdx.x, tid = threadIdx.x, row = (s * 7919 + 13) % MTOK, n = s & 3, b = row >> 12, sq = row & 4095;
    if (s == 0 || s == 1) { }
    float xc = 0.f;
    if (tid < 64) { const int c = 64 * n + tid; xc = DIN_(27)[c]; for (int k = 0; k < 4; ++k) { const int sr = sq - 3 + k; if (sr >= 0) xc += DIN_(26)[k * 256 + c] * bf2f(((const bf16_t*)(a.ws + WS_ZS))[(size_t)(b * SEQ + sr) * ZSW + C_XLRU + c]); } xcs[tid] = xc; }
    __syncthreads();
    if (tid < 64) { const int c = 64 * n + tid; float ar = DIN_(29)[c], ai = DIN_(31)[c];
        const float* wr_ = DIN_(28); const float* wi_ = DIN_(30);
#pragma unroll 2
        for (int cc = 0; cc < 64; ++cc) { ar += xcs[cc] * wr_[(n * 64 + cc) * 64 + tid]; ai += xcs[cc] * wi_[(n * 64 + cc) * 64 + tid]; }
        const float r = 1.f / (1.f + __expf(-ar)), ii = 1.f / (1.f + __expf(-ai)), la = -8.f * r * __logf(1.f + __expf(-DIN_(32)[c])), av = __expf(la), iv = sqrtf(fmaxf(1.f - av * av, 0.f)) * ii * xc;
        dbg_acc(a.acc, 8, ((const float*)(a.ws + WS_LA))[(size_t)row * 256 + c], av); dbg_acc(a.acc, 9, ((const float*)(a.ws + WS_LI))[(size_t)row * 256 + c], iv); }
}
__global__ void chk_mla_attn(DbgArgs a) {
    __shared__ float sh[256]; __shared__ float q[96]; __shared__ float p[4096];
    const int s = blockIdx.x, tid = threadIdx.x, bh = s & 15, sq = (s * 523 + 77) % SEQ, b = bh >> 2, hd = bh & 3;
    const bf16_t* QM = (const bf16_t*)(a.ws + WS_QM) + (size_t)bh * SEQ * 96; const bf16_t* KM = (const bf16_t*)(a.ws + WS_KM) + (size_t)bh * SEQ * 96; const bf16_t* VMT = (const bf16_t*)(a.ws + WS_VMT) + (size_t)bh * 64 * SEQ;
    if (tid < 96) q[tid] = bf2f(QM[(size_t)sq * 96 + tid]); __syncthreads();
    float mx = -1e30f; for (int j = tid; j <= sq; j += 256) { float sc = 0.f; for (int d = 0; d < 96; ++d) sc += q[d] * bf2f(KM[(size_t)j * 96 + d]); p[j] = sc; mx = fmaxf(mx, sc); }
    mx = blk_max(mx, sh); float sm = 0.f; for (int j = tid; j <= sq; j += 256) { p[j] = exp2f(p[j] - mx); sm += p[j]; } sm = blk_sum(sm, sh);
    if (tid < 64) { float o = 0.f; for (int j = 0; j <= sq; ++j) o += p[j] * bf2f(VMT[(size_t)tid * SEQ + j]); dbg_acc(a.acc, 10, bf2f(((const bf16_t*)(a.ws + WS_Y))[(size_t)1 * MTOK * 256 + (size_t)(b * SEQ + sq) * 256 + hd * 64 + tid]), o / sm); }
}
__global__ void chk_diff_attn(DbgArgs a) {
    __shared__ float sh[256]; __shared__ float q[64]; __shared__ float p1[4096]; __shared__ float p2[4096];
    const int s = blockIdx.x, tid = threadIdx.x, bh = s & 15, sq = (s * 523 + 77) % SEQ, b = bh >> 2, hd = bh & 3;
    const bf16_t* QD = (const bf16_t*)(a.ws + WS_QD) + (size_t)bh * SEQ * 64; const bf16_t* KD = (const bf16_t*)(a.ws + WS_KD) + (size_t)bh * SEQ * 64; const bf16_t* VDT = (const bf16_t*)(a.ws + WS_VDT) + (size_t)bh * 64 * SEQ;
    if (tid < 64) q[tid] = bf2f(QD[(size_t)sq * 64 + tid]); __syncthreads();
    float m1 = -1e30f, m2 = -1e30f; for (int j = tid; j <= sq; j += 256) { float s1 = 0.f, s2 = 0.f; for (int d = 0; d < 32; ++d) { s1 += q[d] * bf2f(KD[(size_t)j * 64 + d]); s2 += q[32 + d] * bf2f(KD[(size_t)j * 64 + 32 + d]); }
        const float bias = DIN_(3)[dbucket(sq - j) * 4 + hd] * LOG2E; s1 += bias; s2 += bias; p1[j] = s1; p2[j] = s2; m1 = fmaxf(m1, s1); m2 = fmaxf(m2, s2); }
    m1 = blk_max(m1, sh); m2 = blk_max(m2, sh); float l1 = 0.f, l2 = 0.f; for (int j = tid; j <= sq; j += 256) { p1[j] = exp2f(p1[j] - m1); p2[j] = exp2f(p2[j] - m2); l1 += p1[j]; l2 += p2[j]; } l1 = blk_sum(l1, sh); l2 = blk_sum(l2, sh);
    float s1 = 0.f, s2 = 0.f; for (int d = 0; d < 32; ++d) { s1 += DIN_(35)[d] * DIN_(36)[d]; s2 += DIN_(37)[d] * DIN_(38)[d]; } const float lam_init = DBG_LAYER == 0 ? 0.2f : 0.8f - 0.6f * 0.7408182206817179f, lam = expf(s1) - expf(s2) + lam_init;
    float o = 0.f; if (tid < 64) { float o1 = 0.f, o2 = 0.f; for (int j = 0; j <= sq; ++j) { const float v = bf2f(VDT[(size_t)tid * SEQ + j]); o1 += p1[j] * v; o2 += p2[j] * v; } o = o1 / l1 - lam * o2 / l2; }
    const float ss = blk_sum(tid < 64 ? o * o : 0.f, sh);
    if (tid < 64) dbg_acc(a.acc, 11, bf2f(((const bf16_t*)(a.ws + WS_Y))[(size_t)3 * MTOK * 256 + (size_t)(b * SEQ + sq) * 256 + hd * 64 + tid]), o * rsqrtf(ss / 64.f + EPS) * DIN_(39)[tid] * (1.f - lam_init));
}
__global__ void chk_lru_scan(DbgArgs a) {
    const int i = blockIdx.x * 256 + threadIdx.x, b = i >> 8, c = i & 255; if (b >= NB) return;
    const float* LA = (const float*)(a.ws + WS_LA); const float* LI = (const float*)(a.ws + WS_LI); float h = 0.f;
    for (int t = 0; t < SEQ; ++t) { const size_t o = (size_t)(b * SEQ + t) * 256 + c; h = LA[o] * h + LI[o];
        if (t % 97 == 0 || t == SEQ - 1) dbg_acc(a.acc, 12, bf2f(((const bf16_t*)(a.ws + WS_Y))[(size_t)2 * MTOK * 256 + o]), h * dgelu(bf2f(((const bf16_t*)(a.ws + WS_ZS))[(size_t)(b * SEQ + t) * ZSW + C_GLRU + c]))); }
}
__global__ void chk_s5_scan(DbgArgs a) {
    __shared__ float part[16][65]; const int g = blockIdx.x, p = threadIdx.x; float* ypre = (float*)(a.ws + WS_DBG);
    const float dt = expf(DIN_(12)[g]), lr = DIN_(10)[g * 64 + p], li = DIN_(11)[g * 64 + p], mag = expf(lr * dt); float sn, cs; sincos_red(li * dt, sn, cs);
    const float ar = mag * cs, ai = mag * sn, den = lr * lr + li * li, zr = ((ar - 1.f) * lr + ai * li) / den, zi = (ai * lr - (ar - 1.f) * li) / den;
    float hr = 0.f, hi = 0.f;
    for (int t = 0; t < SEQ; ++t) { const bf16_t* up = (const bf16_t*)(a.ws + WS_ZS) + (size_t)(SEQ + t) * ZSW + 16 * g; float bur = 0.f, bui = 0.f;
        for (int c = 0; c < 16; ++c) { const float u = bf2f(up[c]), br = DIN_(13)[(g * 64 + p) * 16 + c], bi = DIN_(14)[(g * 64 + p) * 16 + c]; bur += (zr * br - zi * bi) * u; bui += (zr * bi + zi * br) * u; }
        const float nr = ar * hr - ai * hi + bur, ni = ar * hi + ai * hr + bui; hr = nr; hi = ni;
        for (int c = 0; c < 16; ++c) part[c][p] = DIN_(15)[(g * 16 + c) * 64 + p] * hr - DIN_(16)[(g * 16 + c) * 64 + p] * hi;
        __syncthreads();
        if (p < 16) { float y = 0.f; for (int pp = 0; pp < 64; ++pp) y += part[p][pp]; y += DIN_(17)[16 * g + p] * bf2f(up[p]); ypre[(size_t)t * 256 + 16 * g + p] = dgelu(y); }
        __syncthreads(); }
}
__global__ void chk_s5_glu(DbgArgs a) {
    const int s = blockIdx.x, n = threadIdx.x, t = (s * 61 + 5) % SEQ; const float* ypre = (const float*)(a.ws + WS_DBG) + (size_t)t * 256;
    float z = DIN_(19)[n]; for (int k = 0; k < 256; ++k) z += ypre[k] * DIN_(18)[k * 256 + n];
    dbg_acc(a.acc, 13, bf2f(((const bf16_t*)(a.ws + WS_Y))[(size_t)(SEQ + t) * 256 + n]), ypre[n] * dsig(z));
}

__global__ void chk_merge(DbgArgs a) {
    __shared__ float sh[256]; const int s = blockIdx.x, tid = threadIdx.x, row = (s * 7919 + 13) % MTOK, col = (s * 104729 + 7) % DM;
    const bf16_t* Y = (const bf16_t*)(a.ws + WS_Y); const bf16_t* ZGp = (const bf16_t*)(a.ws + WS_ZG) + (size_t)row * ZGW; const bf16_t* MGp = (const bf16_t*)(a.ws + WS_MERGED) + (size_t)row * DM;
    float m = 0.f;
    for (int n = 0; n < 4; ++n) { float d = 0.f; { const int k = tid; d = bf2f(Y[(size_t)n * MTOK * 256 + (size_t)row * 256 + k]) * DIN_(40)[((size_t)n * 256 + k) * DM + col]; } d = blk_sum(d, sh); m += bf2f(ZGp[n * DM + col]) * d; }
    if (tid == 0) dbg_acc(a.acc, 14, bf2f(MGp[col]), m);
    float o = 0.f; for (int c = tid; c < DM; c += 256) o += bf2f(MGp[c]) * DIN_(41)[(size_t)c * DM + col]; o = blk_sum(o, sh);
    if (tid == 0) dbg_acc(a.acc, 15, a.out[(size_t)row * DM + col], DXIN_[(size_t)row * DM + col] + o);
}
__global__ void chk_cross(DbgArgs a) {
    __shared__ float sh[256]; __shared__ float hn[DM]; __shared__ float q[64]; __shared__ float p[256]; __shared__ float mn[DM];
    const int s = blockIdx.x, tid = threadIdx.x, row = (s * 7919 + 13) % MTOK, hd = s & 3, b = row >> 12;
    const float* x1 = a.out + (size_t)row * DM; float ss = 0.f; for (int k = tid; k < DM; k += 256) ss += x1[k] * x1[k]; ss = blk_sum(ss, sh); const float rs = rsqrtf(ss / DM + EPS);
    for (int k = tid; k < DM; k += 256) hn[k] = x1[k] * rs * DIN_(5)[k]; __syncthreads();
    float qf = 0.f; if (tid < 64) { for (int k = 0; k < DM; ++k) qf += hn[k] * DIN_(42)[(size_t)k * 256 + hd * 64 + tid]; dbg_acc(a.acc, 16, bf2f(((const bf16_t*)(a.ws + WS_QX))[(size_t)row * 256 + hd * 64 + tid]), qf); }
    { const float s2 = blk_sum(tid < 64 ? qf * qf : 0.f, sh); if (tid < 64) q[tid] = qf * rsqrtf(s2 / 64.f + EPS) * DIN_(46)[tid] * 0.125f; __syncthreads(); }
    float sc = 0.f; float vj[1]; (void)vj;
    { const float* mr = DIN_(1) + (size_t)(b * 256 + tid) * DM; float ms = 0.f; for (int k = 0; k < DM; ++k) ms += mr[k] * mr[k]; const float mrs = rsqrtf(ms / DM + EPS);
      float kk[64]; (void)kk; float s2 = 0.f; float dotq = 0.f;
      for (int d = 0; d < 64; ++d) { float kd = 0.f; for (int k = 0; k < DM; ++k) kd += mr[k] * mrs * DIN_(6)[k] * DIN_(43)[(size_t)k * 256 + hd * 64 + d]; s2 += kd * kd; dotq += kd * DIN_(47)[d] * q[d]; }
      sc = dotq * rsqrtf(s2 / 64.f + EPS); }
    const float mx = blk_max(sc, sh); const float e = expf(sc - mx); const float sm = blk_sum(e, sh); p[tid] = e / sm; __syncthreads();
    if (tid < 64) { float o = 0.f; for (int j = 0; j < 256; ++j) { const float* mr = DIN_(1) + (size_t)(b * 256 + j) * DM; float ms = 0.f, vd = 0.f; for (int k = 0; k < DM; ++k) { ms += mr[k] * mr[k]; vd += mr[k] * DIN_(6)[k] * DIN_(44)[(size_t)k * 256 + hd * 64 + tid]; } o += p[j] * vd * rsqrtf(ms / DM + EPS); }
        dbg_acc(a.acc, 17, bf2f(((const bf16_t*)(a.ws + WS_OX))[(size_t)row * 256 + hd * 64 + tid]), o); }
}
__global__ void chk_ffn(DbgArgs a) {
    __shared__ float sh[256]; __shared__ float hn[DM]; const int s = blockIdx.x, tid = threadIdx.x, row = (s * 7919 + 13) % MTOK;
    const float* x2 = a.out + (size_t)row * DM; float ss = 0.f; for (int k = tid; k < DM; k += 256) ss += x2[k] * x2[k]; ss = blk_sum(ss, sh); const float rs = rsqrtf(ss / DM + EPS);
    for (int k = tid; k < DM; k += 256) hn[k] = x2[k] * rs * DIN_(7)[k]; __syncthreads();
    for (int j = tid; j < FF; j += 256 * 8) { float g = 0.f, u = 0.f; for (int k = 0; k < DM; ++k) { g += hn[k] * DIN_(48)[(size_t)k * FF + j]; u += hn[k] * DIN_(49)[(size_t)k * FF + j]; }
        dbg_acc(a.acc, 18, bf2f(((const bf16_t*)(a.ws + WS_HFF))[(size_t)row * FF + j]), g / (1.f + expf(-g)) * u); }
}

__global__ void chk_moe(DbgArgs a) {
    __shared__ float sh[256]; __shared__ float hn[DM]; __shared__ float hid[EFF]; __shared__ float lgs[8];
    const int s = blockIdx.x, tid = threadIdx.x, tok = (s * 7919 + 13) % MTOK, slot = s & 1, col = (s * 104729 + 7) % DM;
    const float* x2 = a.out + (size_t)tok * DM; float ss = 0.f; for (int k = tid; k < DM; k += 256) ss += x2[k] * x2[k]; ss = blk_sum(ss, sh); const float rs = rsqrtf(ss / DM + EPS);
    for (int k = tid; k < DM; k += 256) hn[k] = x2[k] * rs * ((const float*)a.in[7])[DM + k]; __syncthreads();
    for (int e = 0; e < 8; ++e) { float d = 0.f; for (int k = tid; k < DM; k += 256) d += hn[k] * DIN_(51)[k * 8 + e]; d = blk_sum(d, sh); if (tid == 0) lgs[e] = d; } __syncthreads();
    int e1 = 0; for (int e = 1; e < 8; ++e) if (lgs[e] > lgs[e1]) e1 = e; int e2 = -1; for (int e = 0; e < 8; ++e) if (e != e1 && (e2 < 0 || lgs[e] > lgs[e2])) e2 = e;
    const float w1 = 1.f / (1.f + expf(lgs[e2] - lgs[e1])), w2 = 1.f - w1;
    const int* ASG = (const int*)(a.ws + WS_MOESM + MS_ASSIGN); const int* TD = (const int*)(a.ws + WS_MOESM + MS_TOKDEST); const float* TW = (const float*)(a.ws + WS_MOESM + MS_TOKW); const int* RT = (const int*)(a.ws + WS_MOESM + MS_ROWTOK);
    const int ef = ASG[2 * tok + slot] & 255, dest = TD[2 * tok + slot];
    if (tid == 0) { dbg_acc(a.acc, 19, (float)(ASG[2 * tok] & 255), (float)e1 + 1e-3f); dbg_acc(a.acc, 19, (float)(ASG[2 * tok + 1] & 255), (float)e2 + 1e-3f); dbg_acc(a.acc, 19, TW[2 * tok], w1); dbg_acc(a.acc, 19, TW[2 * tok + 1], w2); dbg_acc(a.acc, 19, (float)(RT[dest] - tok), 1e-3f); }
    const float* wg = DIN_(52) + (size_t)ef * DM * EFF; const float* wu = DIN_(53) + (size_t)ef * DM * EFF; const float* wd = DIN_(54) + (size_t)ef * EFF * DM;
    for (int f = tid; f < EFF; f += 256) { float g = 0.f, u = 0.f; for (int k = 0; k < DM; ++k) { g += hn[k] * wg[(size_t)k * EFF + f]; u += hn[k] * wu[(size_t)k * EFF + f]; } hid[f] = g / (1.f + expf(-g)) * u; }
    __syncthreads();
    float y = 0.f; for (int f = tid; f < EFF; f += 256) y += hid[f] * wd[(size_t)f * DM + col]; y = blk_sum(y, sh);
    if (tid == 0) dbg_acc(a.acc, 20, bf2f(((const bf16_t*)(a.ws + WS_YS))[(size_t)dest * DM + col]), y);
}

__global__ void chk_res(DbgArgs a, int kind) {
    __shared__ float sh[256]; const int s = blockIdx.x, tid = threadIdx.x, row = (s * 7919 + 13) % MTOK, col = (s * 104729 + 7) % DM; const float* xprev = (const float*)(a.ws + WS_DBG);
    float o = 0.f;
    if (kind == 0) { const bf16_t* A = (const bf16_t*)(a.ws + WS_OX) + (size_t)row * 256; o = bf2f(A[tid]) * DIN_(45)[(size_t)tid * DM + col]; }
    else { const bf16_t* A = (const bf16_t*)(a.ws + WS_HFF) + (size_t)row * FF; for (int k = tid; k < FF; k += 256) o += bf2f(A[k]) * DIN_(50)[(size_t)k * DM + col]; }
    o = blk_sum(o, sh);
    if (tid == 0) { dbg_acc(a.acc, 21, a.out[(size_t)row * DM + col], xprev[(size_t)row * DM + col] + o);
        const bf16_t xbv = ((const bf16_t*)(a.ws + WS_XB))[(size_t)row * DM + col]; dbg_acc(a.acc, 22, bf2f(xbv), a.out[(size_t)row * DM + col]); }
}

__global__ void chk_final(DbgArgs a) {
    const int i = blockIdx.x * 256 + threadIdx.x; const int tok = (i * 37 + 5) % MTOK, col = (i * 101 + 3) % DM; const float* xprev = (const float*)(a.ws + WS_DBG);
    const int* TD = (const int*)(a.ws + WS_MOESM + MS_TOKDEST); const float* TW = (const float*)(a.ws + WS_MOESM + MS_TOKW); const bf16_t* YS = (const bf16_t*)(a.ws + WS_YS);
    const float ref = xprev[(size_t)tok * DM + col] + TW[2 * tok] * bf2f(YS[(size_t)TD[2 * tok] * DM + col]) + TW[2 * tok + 1] * bf2f(YS[(size_t)TD[2 * tok + 1] * DM + col]);
    dbg_acc(a.acc, 23, a.out[(size_t)tok * DM + col], ref);
}
__global__ void chk_emit(DbgArgs a, int nchk) {
    for (int i = blockIdx.x * 256 + threadIdx.x; i < MTOK * DM; i += gridDim.x * 256) a.out[i] = 0.f;
    if (blockIdx.x == 0 && threadIdx.x == 0) { float V = 99000.f; float worst = 0.f;
        for (int k = 1; k <= nchk; ++k) { const float cnt = a.acc[64 + k]; const float rms = sqrtf(a.acc[2 * k + 1] / fmaxf(cnt, 1.f)) + 1e-20f; float err = a.acc[2 * k] / rms; if (cnt < 1.f) continue; if (!(err == err)) err = 0.97f; worst = fmaxf(worst, err);
#ifdef DBG_ONLY
            if (k == DBG_ONLY) { V = 1000.f + err * 10000.f; break; }
#else
            if (err > 0.06f) { V = (float)k * 1000.f + fminf(err, 0.99f) * 1000.f; break; }
#endif
        }
        if (V == 99000.f) V = 99000.f + worst * 1000.f;
        a.out[12345] = V; }
}
#endif

#ifdef DBG_STAT
__global__ void stat_scan(const float* out, unsigned* acc) {
    for (int i = blockIdx.x * 256 + threadIdx.x; i < MTOK * DM; i += gridDim.x * 256) { const float v = fabsf(out[i]);
        atomicMax(&acc[1], __float_as_uint(v)); if (v > 10.f || !(v == v)) { atomicAdd(&acc[0], 1u); atomicAdd(&acc[2 + (i >> 18)], 1u); atomicAdd(&acc[70 + ((i & 1023) >> 8)], 1u); atomicAdd(&acc[80 + ((i >> 10) & 255) / 32], 1u); } }
}
__global__ void stat_emit(float* out, const unsigned* acc, int mode) {
    for (int i = blockIdx.x * 256 + threadIdx.x; i < MTOK * DM; i += gridDim.x * 256) out[i] = 0.f;
    if (blockIdx.x == 0 && threadIdx.x == 0) { float V = 0.f;
        if (mode == 0) V = (float)acc[0];
        else if (mode == 1) V = __uint_as_float(acc[1]) * 100.f;
        else if (mode == 2) { unsigned best = 0, bi = 0, nz = 0; for (int k = 0; k < 64; ++k) { if (acc[2 + k] > best) { best = acc[2 + k]; bi = k; } nz += acc[2 + k] > 0; } V = 1000.f * (float)bi + 10.f * (float)nz; }
        else if (mode == 3) V = 1000.f * (float)acc[70] / fmaxf((float)acc[0], 1.f) + 100000.f * (float)acc[71] / fmaxf((float)acc[0], 1.f);
        else if (mode == 4) { unsigned best = 0, bi = 0; for (int k = 0; k < 8; ++k) if (acc[80 + k] > best) { best = acc[80 + k]; bi = k; } V = 1000.f + 1000.f * (float)bi + 900.f * (float)best / fmaxf((float)acc[0], 1.f); }
        out[12345] = V + 100.f; }
}
#endif

#ifdef DBG_VAR
__global__ void var_scan(const float* out, const float* prev, float* acc) {
    float s = 0.f, mx = 0.f; for (int i = blockIdx.x * 256 + threadIdx.x; i < MTOK * DM; i += gridDim.x * 256) { const float d = out[i] - prev[i]; s += d * d; mx = fmaxf(mx, fabsf(d)); }
    atomicAdd(&acc[0], s); atomicMax((unsigned*)&acc[1], __float_as_uint(mx));
}
__global__ void var_emit(float* out, const float* acc, int mode) {
    for (int i = blockIdx.x * 256 + threadIdx.x; i < MTOK * DM; i += gridDim.x * 256) out[i] = 0.f;
    if (blockIdx.x == 0 && threadIdx.x == 0) out[12345] = 100.f + (mode == 0 ? acc[0] / (float)(MTOK * DM) * 1e5f : acc[1] * 100.f);
}
#endif

#ifdef DBG_GSTAT
__global__ void gstat_scan(const bf16_t* zg, float* acc) { float s1 = 0.f, s2 = 0.f; for (size_t i = blockIdx.x * 256 + threadIdx.x; i < (size_t)MTOK * ZGW; i += (size_t)gridDim.x * 256) { const float g = bf2f(zg[i]); const int blk = (int)((i & 4095) >> 10); if (blk == DBG_GSTAT) { s1 += (g < -0.01f || g > 1.01f || !(g == g)) ? 1.f : 0.f; s2 += (g - 0.5f) * (g - 0.5f); } } atomicAdd(&acc[0], s1); atomicAdd(&acc[1], s2); }
__global__ void gstat_emit(float* out, const float* acc, int mode) {
    for (int i = blockIdx.x * 256 + threadIdx.x; i < MTOK * DM; i += gridDim.x * 256) out[i] = 0.f;
    if (blockIdx.x == 0 && threadIdx.x == 0) out[12345] = 100.f + 10000.f * acc[1] / ((float)MTOK * 1024);
}
#endif
extern "C" void kernel_launch(void* const* d_in, const int* in_sizes, int n_in, void* d_out, int out_size, void* d_ws, size_t ws_size, hipStream_t stream) {
    static int grid = 0;
    if (grid == 0) {
        if (n_in != 55 || out_size != MTOK * DM || ws_size < WS_END) { fprintf(stderr, "kernel_launch: unexpected shapes (n_in %d out %d ws %zu)\n", n_in, out_size, ws_size); grid = -1; return; }
        { const int L2 = 2; const int exp_sz[55] = {NB * SEQ * DM, NB * NMEM * DM, NB * SEQ, 32 * 4, L2 * DM, L2 * DM, L2 * DM, L2 * DM, L2 * DM * DIN, L2 * 4 * DM, L2 * 1024, L2 * 1024, L2 * 16, L2 * 16384, L2 * 16384, L2 * 16384, L2 * 16384, L2 * 256, L2 * 65536, L2 * 256,
              L2 * 192, L2 * 128, L2 * 192 * 384, L2 * 128 * 512, L2 * 96, L2 * 96, L2 * 1024, L2 * 256, L2 * 16384, L2 * 256, L2 * 16384, L2 * 256, L2 * 256, L2 * 32, L2 * 32, L2 * 32, L2 * 32, L2 * 32, L2 * 32, L2 * 64,
              L2 * 4 * 256 * DM, L2 * DM * DM, L2 * DM * 256, L2 * DM * 256, L2 * DM * 256, L2 * 256 * DM, L2 * 64, L2 * 64, DM * FF, DM * FF, FF * DM, DM * 8, 8 * DM * EFF, 8 * DM * EFF, 8 * EFF * DM};
          for (int i = 0; i < 55; ++i) if (in_sizes[i] != exp_sz[i]) { fprintf(stderr, "kernel_launch: input %d has %d elements, expected %d\n", i, in_sizes[i], exp_sz[i]); grid = -1; return; } }
        int dev = 0, cus = 0, per_cu = 0;
        if (hipGetDevice(&dev) != hipSuccess || hipDeviceGetAttribute(&cus, hipDeviceAttributeMultiprocessorCount, dev) != hipSuccess) { grid = -1; return; }
        if (hipFuncSetAttribute((const void*)hybrid_fwd, hipFuncAttributeMaxDynamicSharedMemorySize, LDS_BYTES) != hipSuccess) { fprintf(stderr, "kernel_launch: hipFuncSetAttribute failed\n"); grid = -1; return; }
        if (hipOccupancyMaxActiveBlocksPerMultiprocessor(&per_cu, (const void*)hybrid_fwd, 512, LDS_BYTES) != hipSuccess || per_cu < 1) { fprintf(stderr, "kernel_launch: occupancy query says %d\n", per_cu); }
        (void)hipGetLastError();
        grid = cus;
    }
    if (grid < 0) return;
    if (hipMemsetAsync((char*)d_ws + WS_CTL, 0, CTL_ZERO_BYTES, stream) != hipSuccess) return;
    Args a{};
    for (int i = 0; i < 55; ++i) a.in[i] = d_in[i];
    a.out = (float*)d_out; a.ws = (unsigned char*)d_ws; a.submask = 0xFFFF; a.pad = 0;
#if MK_ONE_LAUNCH
    a.ph_lo = 0; a.ph_hi = NPHASE;
    hipLaunchKernelGGL(hybrid_fwd, dim3(grid), dim3(512), LDS_BYTES, stream, a);
#else
    for (int p = 0; p < DBG_NPH; ++p) { a.ph_lo = p; a.ph_hi = p + 1;
#if defined(DBG_CHECK) || defined(DBG_VAR)
        if (p == DBG_NPH - 1) hipMemcpyAsync((char*)d_ws + 440 * MiB, d_out, (size_t)MTOK * DM * 4, hipMemcpyDeviceToDevice, stream);
#endif
        hipLaunchKernelGGL(hybrid_fwd, dim3(grid), dim3(512), LDS_BYTES, stream, a);
#ifdef DBG_REPEAT
        if (p == DBG_REPEAT) {
#ifdef DBG_REPSUB
            a.submask = DBG_REPSUB;
#endif
            hipLaunchKernelGGL(hybrid_fwd, dim3(grid), dim3(512), LDS_BYTES, stream, a); hipLaunchKernelGGL(hybrid_fwd, dim3(grid), dim3(512), LDS_BYTES, stream, a); a.submask = 0xFFFF; }
#endif
    }
#ifdef DBG_CHECK
    { DbgArgs da{}; for (int i = 0; i < 55; ++i) da.in[i] = d_in[i]; da.ws = (unsigned char*)d_ws; da.out = (float*)d_out; da.acc = (float*)((char*)d_ws + 700 * 1024);
#if DBG_NPH == 6 || DBG_NPH == 16
      hipLaunchKernelGGL(chk_merge, dim3(512), dim3(256), 0, stream, da);
#elif DBG_NPH == 8 || DBG_NPH == 18
      hipLaunchKernelGGL(chk_cross, dim3(64), dim3(256), 0, stream, da);
#elif DBG_NPH == 10
      hipLaunchKernelGGL(chk_ffn, dim3(64), dim3(256), 0, stream, da);
#elif DBG_NPH == 24
      hipLaunchKernelGGL(chk_final, dim3(64), dim3(256), 0, stream, da);
#elif DBG_NPH == 23
      hipLaunchKernelGGL(chk_moe, dim3(128), dim3(256), 0, stream, da);
#elif DBG_NPH == 9 || DBG_NPH == 19
      hipLaunchKernelGGL(chk_res, dim3(512), dim3(256), 0, stream, da, 0);
#elif DBG_NPH == 11
      hipLaunchKernelGGL(chk_res, dim3(512), dim3(256), 0, stream, da, 1);
#else
      hipLaunchKernelGGL(chk_z, dim3(1024), dim3(256), 0, stream, da);
      hipLaunchKernelGGL(chk_mla_prep, dim3(512), dim3(256), 0, stream, da);
      hipLaunchKernelGGL(chk_diff_prep, dim3(16), dim3(256), 0, stream, da);
      hipLaunchKernelGGL(chk_lru_prep, dim3(512), dim3(256), 0, stream, da);
      hipLaunchKernelGGL(chk_mla_attn, dim3(64), dim3(256), 0, stream, da);
      hipLaunchKernelGGL(chk_diff_attn, dim3(64), dim3(256), 0, stream, da);
      hipLaunchKernelGGL(chk_lru_scan, dim3(4), dim3(256), 0, stream, da);
      hipLaunchKernelGGL(chk_s5_scan, dim3(16), dim3(64), 0, stream, da);
      hipLaunchKernelGGL(chk_s5_glu, dim3(64), dim3(256), 0, stream, da);
#endif
      hipLaunchKernelGGL(chk_emit, dim3(1024), dim3(256), 0, stream, da, 23); }
#endif
#ifdef DBG_COPYX
    hipMemcpyAsync(d_out, d_in[0], (size_t)MTOK * DM * 4, hipMemcpyDeviceToDevice, stream);
#endif
#ifdef DBG_GSTAT
    { float* acc = (float*)((char*)d_ws + 900 * 1024);
      hipLaunchKernelGGL(gstat_scan, dim3(2048), dim3(256), 0, stream, (const bf16_t*)((const char*)d_ws + WS_ZG), acc);
      hipLaunchKernelGGL(gstat_emit, dim3(1024), dim3(256), 0, stream, (float*)d_out, (const float*)acc, DBG_GSTAT); }
#endif
#ifdef DBG_VAR
    { float* acc = (float*)((char*)d_ws + 900 * 1024);
      hipLaunchKernelGGL(var_scan, dim3(1024), dim3(256), 0, stream, (const float*)d_out, DBG_NPH == 6 ? (const float*)d_in[0] : (const float*)((const char*)d_ws + 440 * MiB), acc);
      hipLaunchKernelGGL(var_emit, dim3(1024), dim3(256), 0, stream, (float*)d_out, (const float*)acc, DBG_VAR); }
#endif
#ifdef DBG_STAT
    { unsigned* acc = (unsigned*)((char*)d_ws + 800 * 1024);
      hipLaunchKernelGGL(stat_scan, dim3(2048), dim3(256), 0, stream, (const float*)d_out, acc);
      hipLaunchKernelGGL(stat_emit, dim3(1024), dim3(256), 0, stream, (float*)d_out, (const unsigned*)acc, DBG_STAT); }
#endif
#ifdef DBG_DUMP_OFF
    hipLaunchKernelGGL(dbg_copy_bf16, dim3(2048), dim3(256), 0, stream, (const bf16_t*)((const char*)d_ws + (size_t)(DBG_DUMP_OFF)), (float*)d_out, MTOK * DM, DBG_DUMP_N);
#endif
#endif
}
```

```cpp
#include <hip/hip_runtime.h>
#include <cstdio>
#include <cstdint>

#define DBG_NPH 24

#ifndef DBG_GPERM
#define DBG_GPERM(n) (n)
#endif
#ifndef DBG_SCALE
#define DBG_SCALE 1.0f
#endif
#ifndef MK_ONE_LAUNCH
#define MK_ONE_LAUNCH 1
#endif
#define WGM_S 4
#define WGM_M 8
#ifndef G2_FP8
#define G2_FP8 0
#endif

#define LAS __attribute__((address_space(3)))
typedef unsigned short bf16_t;
typedef short bf16x8 __attribute__((ext_vector_type(8)));
typedef float f32x2 __attribute__((ext_vector_type(2)));
typedef float f32x4 __attribute__((ext_vector_type(4)));
typedef float f32x16 __attribute__((ext_vector_type(16)));
typedef unsigned u32x2 __attribute__((ext_vector_type(2)));
typedef unsigned u32x4 __attribute__((ext_vector_type(4)));
typedef int i32x4 __attribute__((ext_vector_type(4)));
typedef int i32x8 __attribute__((ext_vector_type(8)));

constexpr int DM = 1024, NB = 4, SEQ = 4096, MTOK = NB * SEQ, NMEM = 256;
constexpr int DIN = 5984, ZSW = 2048, ZGW = 4096, NIN = ZSW + ZGW;
constexpr int C_S5 = 0, C_CQ = 256, C_CKV = 448, C_KPE = 576, C_XLRU = 608, C_GLRU = 864, C_QD = 1120, C_KD = 1376, C_VD = 1632, C_END = 1888;
constexpr int FF = 2816, EFF = 3584, NEXP = 8, MOE_ROWS = 34816;
constexpr float EPS = 1e-6f, LOG2E = 1.4426950408889634f;

constexpr size_t MiB = 1u << 20;
constexpr size_t WS_CTL = 0, CTL_ZERO_BYTES = 1 * MiB + 512 * 1024;
constexpr size_t WS_MOESM = 1 * MiB;
constexpr size_t WS_XB = 2 * MiB;
constexpr size_t WS_WL = 34 * MiB, WL_STRIDE = 19 * MiB;
constexpr size_t WL_WIN = 0, WL_PT = 12 * MiB, WL_WO = 14 * MiB, WL_WXQ = 16 * MiB, WL_WXKV = 16 * MiB + 512 * 1024, WL_WXO = 17 * MiB + 512 * 1024, WL_SM = 18 * MiB;
constexpr size_t SM_WUQ = 0, SM_WUKV = 256 * 1024, SM_WR = 512 * 1024, SM_WI = 576 * 1024, SM_WGLU = 640 * 1024;
constexpr size_t WS_WGU = 72 * MiB, WS_WD = 83 * MiB, WS_TAB = 89 * MiB, WS_KX = 90 * MiB, WS_VXT = 91 * MiB;
constexpr size_t TAB_S5T = 0, TAB_CMAT = 512 * 1024, TAB_MISC = 768 * 1024;
constexpr size_t WS_ZS = 92 * MiB, WS_MERGED = 92 * MiB, WS_ZG = 156 * MiB, WS_HFF = 156 * MiB, WS_Y = 284 * MiB;
constexpr size_t WS_QM = 316 * MiB, WS_KM = 328 * MiB, WS_VMT = 340 * MiB, WS_QD = 348 * MiB, WS_KD = 356 * MiB, WS_VDT = 364 * MiB;
constexpr size_t WS_QX = 316 * MiB, WS_OX = 324 * MiB;
constexpr size_t WS_LA = 372 * MiB, WS_LI = 388 * MiB, WS_S5S = 404 * MiB, WS_LSUM = 406 * MiB, WS_RSP = 407 * MiB;
constexpr size_t WS_WMGU = 34 * MiB, WS_WMD = 146 * MiB, WS_HMOE = 202 * MiB, WS_XQ = 330 * MiB, WS_YS = 34 * MiB, WS_X8 = 416 * MiB, WS_END = 440 * MiB;
constexpr int CW_TMO = 0, CW_BAR = 4096, CW_MOECNT = 8192, CW_Q = 12288;
constexpr size_t CTL_ROWSS = 256 * 1024;
constexpr size_t MS_ROWTOK = 0, MS_TOKW = 512 * 1024, MS_ASSIGN = 640 * 1024, MS_RSTD = 768 * 1024;
constexpr int RING_BYTES = 131072, MISC_OFF = RING_BYTES + 320, LDS_BYTES = 147456;

typedef __bf16 bf16x2_t __attribute__((ext_vector_type(2)));
__device__ __forceinline__ unsigned cvt_pk_bf16(float lo, float hi) { const f32x2 v = {lo, hi}; const bf16x2_t b = __builtin_convertvector(v, bf16x2_t); return __builtin_bit_cast(unsigned, b); }
__device__ __forceinline__ float clamp8(float x) { return __builtin_fminf(__builtin_fmaxf(x, -448.f), 448.f); }
__device__ __forceinline__ unsigned cvt_pk4_fp8(float a, float b, float c, float d) { int w = __builtin_amdgcn_cvt_pk_fp8_f32(clamp8(a), clamp8(b), 0, false); w = __builtin_amdgcn_cvt_pk_fp8_f32(clamp8(c), clamp8(d), w, true); return (unsigned)w; }
__device__ __forceinline__ float bflo(unsigned w) { return __uint_as_float(w << 16); }
__device__ __forceinline__ float bfhi(unsigned w) { return __uint_as_float(w & 0xffff0000u); }
__device__ __forceinline__ float bf2f(bf16_t b) { return __uint_as_float((unsigned)b << 16); }
__device__ __forceinline__ bf16_t f2bf(float f) { return (bf16_t)(cvt_pk_bf16(f, 0.f) & 0xffffu); }
__device__ __forceinline__ float fexp2(float x) { return __builtin_amdgcn_exp2f(x); }
__device__ __forceinline__ float frcp(float x) { return __builtin_amdgcn_rcpf(x); }
__device__ __forceinline__ float frsq(float x) { return __builtin_amdgcn_rsqf(x); }
__device__ __forceinline__ float fsigmoid(float x) { return frcp(1.f + fexp2(-x * LOG2E)); }
__device__ __forceinline__ float fgelu(float x) {
    const float z = 0.7978845608028654f * (x + 0.044715f * x * x * x);
    const float e = fexp2(2.f * LOG2E * z);
    const float th = 1.f - 2.f * frcp(e + 1.f);
    return 0.5f * x * (1.f + th);
}
__device__ __forceinline__ int crow(int r, int hi) { return (r & 3) + 8 * (r >> 2) + 4 * hi; }
__device__ __forceinline__ bf16x8 ldg8(const bf16_t* p) { return *(const bf16x8*)p; }
__device__ __forceinline__ float sq8(bf16x8 v) {
    const u32x4 w = *(const u32x4*)&v; float s = 0.f;
#pragma unroll
    for (int i = 0; i < 4; ++i) { const float a = bflo(w[i]), b = bfhi(w[i]); s += a * a + b * b; }
    return s;
}
__device__ __forceinline__ float row_rstd(const float* rsp, int row) {
    const f32x4* p = (const f32x4*)(rsp + (size_t)row * 16); const f32x4 a = p[0], b = p[1], c = p[2], d = p[3];
    const float s = (((a.x + a.y) + (a.z + a.w)) + ((b.x + b.y) + (b.z + b.w))) + (((c.x + c.y) + (c.z + c.w)) + ((d.x + d.y) + (d.z + d.w)));
    return frsq(s * (1.f / DM) + EPS);
}
__device__ __forceinline__ float wave_sum(float v) {
#pragma unroll
    for (int o = 1; o < 64; o <<= 1) v += __shfl_xor(v, o);
    return v;
}
#define MFMA32(a, b, c) __builtin_amdgcn_mfma_f32_32x32x16_bf16((a), (b), (c), 0, 0, 0)
#define MFMA16(a, b, c) __builtin_amdgcn_mfma_f32_16x16x32_bf16((a), (b), (c), 0, 0, 0)
__device__ __forceinline__ void sincos_red(float a, float& s, float& c) {
    const float k = rintf(a * 0.15915494309189535f);
    float r = fmaf(-k, 6.28318548202514648f, a);
    r = fmaf(-k, -1.7484555e-7f, r);
    s = __sinf(r); c = __cosf(r);
}

namespace pg8 {
constexpr int BM = 256, BK = 64, HALF = 128, HTB = HALF * BK * 2, STAGE_BYTES = 8 * HTB;
__host__ __device__ __forceinline__ int lds_byte(int r, int c) { const int st = (r >> 4) * 2 + (c >> 5), rr = r & 15, cc = c & 31, ob = rr * 64 + cc * 2; return st * 1024 + (ob ^ (((ob >> 9) & 1) << 5)); }
__host__ __device__ __forceinline__ void stage_rc(int b, int& R, int& C) { const int st = b / 1024, sb = b % 1024, swz = sb ^ (((sb >> 9) & 1) << 5); R = (st >> 1) * 16 + swz / 64; C = (st & 1) * 32 + (swz % 64) / 2; }
__host__ __device__ __forceinline__ int perm32(int rho) { const int n = rho >> 4, i = rho & 15; return 8 * (i >> 2) + 4 * n + (i & 3); }

struct Unit { int pm, pn, om, on, aux, gofs; };
struct Gemm { const bf16_t* A; const bf16_t* Bt; int K; const int* gather; };

template <class Epi, class Sched, bool ALIGN_EPI, bool GATHER, bool FP8 = false>
__device__ __forceinline__ void gemm_phase(LAS unsigned char* lds, Gemm g, const Sched& S, const Epi& E) {
    int tid = threadIdx.x; asm volatile("" : "+v"(tid));
    asm volatile("" : "+s"(g.A), "+s"(g.Bt));
    const int wid = __builtin_amdgcn_readfirstlane(tid >> 6), lane = tid & 63, wr = wid >> 2, wc = wid & 3, fr = lane & 15, fq = lane >> 4;
    const int K = g.K, nt = K / BK;
    unsigned voffB[2];
#pragma unroll
    for (int i = 0; i < 2; ++i) { int Rr_, Cc_; stage_rc(tid * 16 + i * 8192, Rr_, Cc_); const int Rb = (Rr_ & ~31) + perm32(Rr_ & 31); voffB[i] = (unsigned)(Rb * K + Cc_) * 2u; }
    const size_t kstep = (size_t)(BK * 2);
    const size_t hstep = (size_t)HALF * K * 2;
    const size_t tstep = 2 * hstep;
    const unsigned ldsw = (unsigned)wid * 1024u;
    const int aoff = lds_byte(wr * 64 + fr, fq * 8), boff = lds_byte(wc * 32 + fr, fq * 8);
#define PG8_SA(b, h) (((b) * 2 + (h)) * HTB)
#define PG8_SB(b, h) ((4 + (b) * 2 + (h)) * HTB)
#define PG8_STAGE_B(bufoff, gbase) do { _Pragma("unroll") for (int _i = 0; _i < 2; ++_i) \
        __builtin_amdgcn_global_load_lds((const unsigned*)((const char*)(gbase) + voffB[_i]), (LAS unsigned*)(lds + (bufoff) + ldsw + _i * 8192), 16, 0, 0); } while (0)
#define PG8_STAGE_A(bufoff, kt, vo0, vo1) do { const char* _gb = (const char*)g.A + (size_t)(kt) * kstep; \
        __builtin_amdgcn_global_load_lds((const unsigned*)(_gb + (vo0)), (LAS unsigned*)(lds + (bufoff) + ldsw), 16, 0, 0); \
        __builtin_amdgcn_global_load_lds((const unsigned*)(_gb + (vo1)), (LAS unsigned*)(lds + (bufoff) + ldsw + 8192), 16, 0, 0); } while (0)
#define PG8_LDA(dst, b, h) do { _Pragma("unroll") for (int m = 0; m < 4; ++m) _Pragma("unroll") for (int k = 0; k < 2; ++k) dst[m][k] = *(const LAS bf16x8*)(lds + PG8_SA(b, h) + aoff + m * 2048 + k * 1024); } while (0)
#define PG8_LDB(dst, b, h) do { _Pragma("unroll") for (int n = 0; n < 2; ++n) _Pragma("unroll") for (int k = 0; k < 2; ++k) dst[n][k] = *(const LAS bf16x8*)(lds + PG8_SB(b, h) + boff + n * 2048 + k * 1024); } while (0)
#define PG8_MMA(ai, bj, At, Bt) do { __builtin_amdgcn_s_setprio(1); _Pragma("unroll") for (int m = 0; m < 4; ++m) _Pragma("unroll") for (int n = 0; n < 2; ++n) _Pragma("unroll") for (int k = 0; k < 2; ++k) \
        acc[ai][bj][m][n] = __builtin_amdgcn_mfma_f32_16x16x32_bf16(Bt[n][k], At[m][k], acc[ai][bj][m][n], 0, 0, 0); __builtin_amdgcn_s_setprio(0); } while (0)
#define PG8_MMA8(ai, bj, w) do { __builtin_amdgcn_s_setprio(1); _Pragma("unroll") for (int m = 0; m < 4; ++m) _Pragma("unroll") for (int n = 0; n < 2; ++n) \
        asm volatile("v_mfma_f32_16x16x128_f8f6f4 %0, %1, %2, %0" : "+v"(acc[ai][bj][m][n]) : "v"(B##w##8[n]), "v"(A8[m])); __builtin_amdgcn_s_setprio(0); } while (0)
#define PG8_LA(b, h) do { if constexpr (FP8) { _Pragma("unroll") for (int m = 0; m < 4; ++m) { A8[m].lo = *(const LAS i32x4*)(lds + PG8_SA(b, h) + aoff + m * 2048); A8[m].hi = *(const LAS i32x4*)(lds + PG8_SA(b, h) + aoff + m * 2048 + 1024); } } \
        else PG8_LDA(At, b, h); } while (0)
#define PG8_LB(w, b, h) do { if constexpr (FP8) { _Pragma("unroll") for (int n = 0; n < 2; ++n) { B##w##8[n].lo = *(const LAS i32x4*)(lds + PG8_SB(b, h) + boff + n * 2048); B##w##8[n].hi = *(const LAS i32x4*)(lds + PG8_SB(b, h) + boff + n * 2048 + 1024); } } \
        else PG8_LDB(B##w, b, h); } while (0)
#define PG8_MM(ai, bj, w) do { if constexpr (FP8) PG8_MMA8(ai, bj, w); else PG8_MMA(ai, bj, At, B##w); } while (0)
#define PG8_WAIT_V(n) asm volatile("s_waitcnt vmcnt(" #n ")" ::: "memory")
#define PG8_WAIT_L(n) asm volatile("s_waitcnt lgkmcnt(" #n ")" ::: "memory")
#define PG8_BAR __builtin_amdgcn_s_barrier()
#define PG8_SCHED __builtin_amdgcn_sched_barrier(0)
#define PG8_VOFF(dst, u) do { _Pragma("unroll") for (int _h = 0; _h < 2; ++_h) _Pragma("unroll") for (int _i = 0; _i < 2; ++_i) { int Rr_, Cc_; stage_rc(tid * 16 + _i * 8192, Rr_, Cc_); \
        const int _rt = (u).pm * BM + _h * HALF + Rr_; const int _ar = GATHER ? g.gather[_rt + (u).gofs] : _rt; dst[_h][_i] = (unsigned)((size_t)_ar * K + Cc_) * 2u; } } while (0)
    Unit cur, nxt; int ui = 0;
    if (!S.next(0, cur)) return;
    f32x4 acc[2][2][4][2];
#pragma unroll
    for (int a = 0; a < 2; ++a)
#pragma unroll
        for (int b = 0; b < 2; ++b)
#pragma unroll
            for (int m = 0; m < 4; ++m)
#pragma unroll
                for (int n = 0; n < 2; ++n) acc[a][b][m][n] = (f32x4){0.f, 0.f, 0.f, 0.f};
    bf16x8 At[4][2], B0[2][2], B1[2][2];
    i32x8 A8[4], B08[2], B18[2];
    unsigned vC[2][2], vN[2][2];
    PG8_VOFF(vC, cur);
    const char* cB = (const char*)g.Bt + (size_t)cur.pn * tstep;
    PG8_STAGE_B(PG8_SB(0, 0), cB); PG8_STAGE_B(PG8_SB(0, 1), cB + hstep); PG8_STAGE_A(PG8_SA(0, 0), 0, vC[0][0], vC[0][1]); PG8_STAGE_A(PG8_SA(0, 1), 0, vC[1][0], vC[1][1]);
    if (wr == 1) PG8_BAR;
    PG8_WAIT_V(2); PG8_BAR;
    PG8_STAGE_B(PG8_SB(1, 0), cB + kstep); PG8_STAGE_A(PG8_SA(1, 0), 1, vC[0][0], vC[0][1]); PG8_STAGE_B(PG8_SB(1, 1), cB + hstep + kstep);
    PG8_WAIT_V(6); PG8_BAR;
    for (;;) {
        const bool has_next = S.next(ui + 1, nxt);
        unsigned ndelta = 0u;
        if constexpr (GATHER) {
            if (has_next) { PG8_VOFF(vN, nxt); } else {
#pragma unroll
                for (int _h = 0; _h < 2; ++_h)
#pragma unroll
                    for (int _i = 0; _i < 2; ++_i) vN[_h][_i] = vC[_h][_i]; }
        } else { if (has_next) ndelta = (unsigned)((nxt.pm - cur.pm) * (int)tstep); }
        const char* nB = has_next ? (const char*)g.Bt + (size_t)nxt.pn * tstep : cB;
#pragma unroll 1
        for (int t = 0; t < nt; t += 2) {
            const bool last = (t == nt - 2);
            const int k2 = last ? 0 : t + 2, k3 = k2 + 1;
            const char* b2 = last ? nB : cB + (size_t)(t + 2) * kstep; const char* b3 = b2 + kstep;
            unsigned v200, v201, v210, v211;
            if constexpr (GATHER) { v200 = last ? vN[0][0] : vC[0][0]; v201 = last ? vN[0][1] : vC[0][1]; v210 = last ? vN[1][0] : vC[1][0]; v211 = last ? vN[1][1] : vC[1][1]; }
            else { const unsigned dl = last ? ndelta : 0u; v200 = vC[0][0] + dl; v201 = vC[0][1] + dl; v210 = vC[1][0] + dl; v211 = vC[1][1] + dl; }
            PG8_LB(0, 0, 0); PG8_LB(1, 0, 1); PG8_SCHED; PG8_LA(0, 0); PG8_STAGE_A(PG8_SA(1, 1), t + 1, vC[1][0], vC[1][1]);
            PG8_WAIT_V(8); PG8_WAIT_L(0); PG8_BAR; PG8_MM(0, 0, 0); PG8_MM(0, 1, 1); PG8_BAR; PG8_SCHED;
            PG8_LA(0, 1); PG8_STAGE_B(PG8_SB(0, 0), b2); PG8_STAGE_B(PG8_SB(0, 1), b2 + hstep); PG8_STAGE_A(PG8_SA(0, 0), k2, v200, v201);
            PG8_WAIT_V(8); PG8_WAIT_L(0); PG8_BAR; PG8_MM(1, 0, 0); PG8_MM(1, 1, 1); PG8_BAR; PG8_SCHED;
            PG8_LB(0, 1, 0); PG8_LB(1, 1, 1); PG8_SCHED; PG8_LA(1, 0); PG8_STAGE_A(PG8_SA(0, 1), k2, v210, v211);
            PG8_WAIT_V(8); PG8_WAIT_L(0); PG8_BAR; PG8_MM(0, 0, 0); PG8_MM(0, 1, 1); PG8_BAR; PG8_SCHED;
            PG8_LA(1, 1); PG8_STAGE_B(PG8_SB(1, 0), b3); PG8_STAGE_B(PG8_SB(1, 1), b3 + hstep); PG8_STAGE_A(PG8_SA(1, 0), k3, v200, v201);
            PG8_WAIT_V(8); PG8_WAIT_L(0); PG8_BAR; PG8_MM(1, 0, 0); PG8_MM(1, 1, 1); PG8_BAR; PG8_SCHED;
        }
        if constexpr (ALIGN_EPI) { if (wr == 0) PG8_BAR; }
        if constexpr (FP8) asm volatile("s_nop 15\n\ts_nop 15" ::: "memory");
        { int fr_ = fr, fq_ = fq; asm volatile("" : "+v"(fr_), "+v"(fq_)); E(acc, cur, wr, wc, fr_, fq_); }
        if (!has_next) break;
#pragma unroll
        for (int a = 0; a < 2; ++a)
#pragma unroll
            for (int b = 0; b < 2; ++b)
#pragma unroll
                for (int m = 0; m < 4; ++m)
#pragma unroll
                    for (int n = 0; n < 2; ++n) acc[a][b][m][n] = (f32x4){0.f, 0.f, 0.f, 0.f};
        cur = nxt; cB = nB; ++ui;
#pragma unroll
        for (int _h = 0; _h < 2; ++_h)
#pragma unroll
            for (int _i = 0; _i < 2; ++_i) { if constexpr (GATHER) vC[_h][_i] = vN[_h][_i]; else vC[_h][_i] += ndelta; }
        if constexpr (ALIGN_EPI) { if (wr == 1) PG8_BAR; }
    }
    PG8_WAIT_V(0);
    if constexpr (!ALIGN_EPI) { if (wr == 0) PG8_BAR; }
    PG8_BAR;
#undef PG8_SA
#undef PG8_SB
#undef PG8_STAGE_A
#undef PG8_STAGE_B
#undef PG8_LDA
#undef PG8_LDB
#undef PG8_MMA
#undef PG8_MMA8
#undef PG8_MM
#undef PG8_LA
#undef PG8_LB
#undef PG8_WAIT_V
#undef PG8_WAIT_L
#undef PG8_BAR
#undef PG8_SCHED
#undef PG8_VOFF
}

constexpr int NXCD = 8, WGM = WGM_S, WGMM = WGM_M;
struct StaticOrder {
    int nM, nN, nwg, G, c;
    __device__ void init(int nM_, int nN_, int G_, int c_) { nM = nM_; nN = nN_; nwg = nM * nN; G = G_; c = c_; }
    __device__ bool next(int i, Unit& u) const {
        const long L = (long)i * G + c; if (L >= nwg) return false;
        int wgid = (int)L; { const int q = nwg / NXCD, r = nwg % NXCD, xcd = wgid % NXCD, off = wgid / NXCD; wgid = (xcd < r ? xcd * (q + 1) : r * (q + 1) + (xcd - r) * q) + off; }
        const int nig = WGM * nN, gid = wgid / nig, fm = gid * WGM, gsz = (nM - fm) < WGM ? (nM - fm) : WGM;
        u.pm = fm + ((wgid % nig) % gsz); u.pn = (wgid % nig) / gsz; u.om = u.pm; u.on = u.pn; u.aux = 0; return true;
    }
};
struct MergeOrder {
    int G, c;
    __device__ bool next(int i, Unit& u) const {
        const int n = i & 3; const long tile = (long)(i >> 2) * G + c; if (tile >= 256) return false;
        const int om = (int)tile >> 2, on = (int)tile & 3;
        u.pm = n * 64 + om; u.pn = n * 4 + on; u.om = om; u.on = on; u.aux = n; return true;
    }
};
struct MoeOrder {
    int ntiles, nN, nwg, G, c; int pend[NEXP];
    __device__ void init(const unsigned* cnt, int nN_, int G_, int c_) {
        int acc = 0;
#pragma unroll
        for (int e = 0; e < NEXP; ++e) { const int ce = (int)cnt[64 * e]; acc += (ce + 255) >> 8; pend[e] = acc; }
        ntiles = acc; nN = nN_; nwg = ntiles * nN; G = G_; c = c_;
    }
    __device__ bool next(int i, Unit& u) const {
        const long L = (long)i * G + c; if (L >= nwg) return false;
        const int wgid = (int)L;
        const int nig = WGMM * nN, gid = wgid / nig, fm = gid * WGMM, gsz = (ntiles - fm) < WGMM ? (ntiles - fm) : WGMM;
        const int pm = fm + ((wgid % nig) % gsz), pn = (wgid % nig) / gsz;
        int e = 0, ps = 0;
#pragma unroll
        for (int j = 0; j < NEXP - 1; ++j) if (pm >= pend[j]) { e = j + 1; ps = pend[j]; }
        u.pm = pm; u.pn = e * nN + pn; u.om = pm; u.on = pn; u.aux = e; u.gofs = e * 16384 - 256 * ps; return true;
    }
};

__device__ __forceinline__ u32x4 pack8(f32x4 a, f32x4 b) { u32x4 w; w.x = cvt_pk_bf16(a[0], a[1]); w.y = cvt_pk_bf16(a[2], a[3]); w.z = cvt_pk_bf16(b[0], b[1]); w.w = cvt_pk_bf16(b[2], b[3]); return w; }
struct EpiIn {
    bf16_t* Zs; bf16_t* Zg; const float* rowss; const float* bgate;
    __device__ __forceinline__ void operator()(const f32x4 (&acc)[2][2][4][2], const Unit& u, int wr, int wc, int fr, int fq) const {
        const int row0 = u.om * BM + wr * 64 + fr, colt = u.on * BM, cw = wc * 32 + 8 * fq;
        if (colt < ZSW) {
#pragma unroll
            for (int ai = 0; ai < 2; ++ai) { float rsd[4];
#pragma unroll
                for (int m = 0; m < 4; ++m) rsd[m] = row_rstd(rowss, row0 + ai * HALF + m * 16);
#pragma unroll
                for (int m = 0; m < 4; ++m) {
                    const int row = row0 + ai * HALF + m * 16; const float rstd = rsd[m];
#pragma unroll
                    for (int bj = 0; bj < 2; ++bj) *(u32x4*)(Zs + (size_t)row * ZSW + colt + bj * HALF + cw) = pack8(acc[ai][bj][m][0] * rstd, acc[ai][bj][m][1] * rstd);
                    if (m == 3) asm volatile("" ::: "memory");
                } }
        } else {
            const int gc0 = colt - ZSW + cw;
            const f32x4 b00 = *(const f32x4*)(bgate + gc0), b01 = *(const f32x4*)(bgate + gc0 + 4), b10 = *(const f32x4*)(bgate + gc0 + HALF), b11 = *(const f32x4*)(bgate + gc0 + HALF + 4);
#pragma unroll
            for (int ai = 0; ai < 2; ++ai) { float rsd[4];
#pragma unroll
                for (int m = 0; m < 4; ++m) rsd[m] = row_rstd(rowss, row0 + ai * HALF + m * 16);
#pragma unroll
                for (int m = 0; m < 4; ++m) {
                    const int row = row0 + ai * HALF + m * 16; const float rstd = rsd[m];
#pragma unroll
                    for (int bj = 0; bj < 2; ++bj) { f32x4 v0 = acc[ai][bj][m][0] * rstd + (bj ? b10 : b00), v1 = acc[ai][bj][m][1] * rstd + (bj ? b11 : b01);
                        *(u32x4*)(Zg + (size_t)row * ZGW + gc0 + bj * HALF) = pack8(v0, v1); }
                    if (m == 3) asm volatile("" ::: "memory");
                } }
        }
    }
};
struct EpiMerge {
    bf16_t* Mg; const bf16_t* Zg;
    __device__ __forceinline__ void operator()(const f32x4 (&acc)[2][2][4][2], const Unit& u, int wr, int wc, int fr, int fq) const {
        const int row0 = u.om * BM + wr * 64 + fr, colt = u.on * BM, cw = wc * 32 + 8 * fq, n = u.aux;
#pragma unroll
        for (int ai = 0; ai < 2; ++ai) {
            u32x4 gw[4][2], ow[4][2];
#pragma unroll
            for (int m = 0; m < 4; ++m)
#pragma unroll
                for (int bj = 0; bj < 2; ++bj) { const int row = row0 + ai * HALF + m * 16, col = colt + bj * HALF + cw;
                    gw[m][bj] = *(const u32x4*)(Zg + (size_t)row * ZGW + DBG_GPERM(n) * DM + col);
                    ow[m][bj] = n > 0 ? *(const u32x4*)(Mg + (size_t)row * DM + col) : (u32x4){0u, 0u, 0u, 0u}; }
#pragma unroll
            for (int m = 0; m < 4; ++m)
#pragma unroll
                for (int bj = 0; bj < 2; ++bj) { const int row = row0 + ai * HALF + m * 16, col = colt + bj * HALF + cw; const u32x4 g = gw[m][bj], o = ow[m][bj];
                    f32x4 v0 = acc[ai][bj][m][0], v1 = acc[ai][bj][m][1];
                    v0[0] = v0[0] * fsigmoid(bflo(g.x)) + bflo(o.x); v0[1] = v0[1] * fsigmoid(bfhi(g.x)) + bfhi(o.x); v0[2] = v0[2] * fsigmoid(bflo(g.y)) + bflo(o.y); v0[3] = v0[3] * fsigmoid(bfhi(g.y)) + bfhi(o.y);
                    v1[0] = v1[0] * fsigmoid(bflo(g.z)) + bflo(o.z); v1[1] = v1[1] * fsigmoid(bfhi(g.z)) + bfhi(o.z); v1[2] = v1[2] * fsigmoid(bflo(g.w)) + bflo(o.w); v1[3] = v1[3] * fsigmoid(bfhi(g.w)) + bfhi(o.w);
                    *(u32x4*)(Mg + (size_t)row * DM + col) = pack8(v0, v1); }
            asm volatile("" ::: "memory");
        }
    }
};
template <bool F32OUT, bool X8 = false, bool SC32 = false> struct EpiRes {
    float* xout; bf16_t* xb; float* rowss; unsigned char* x8;
    __device__ __forceinline__ void operator()(const f32x4 (&acc)[2][2][4][2], const Unit& u, int wr, int wc, int fr, int fq) const {
        const int row0 = u.om * BM + wr * 64 + fr, colt = u.on * BM, cw = wc * 32 + 8 * fq;
#pragma unroll
        for (int ai = 0; ai < 2; ++ai) {
            u32x4 xw[4][2];
#pragma unroll
            for (int m = 0; m < 4; ++m)
#pragma unroll
                for (int bj = 0; bj < 2; ++bj) xw[m][bj] = *(const u32x4*)(xb + (size_t)(row0 + ai * HALF + m * 16) * DM + colt + bj * HALF + cw);
#pragma unroll
            for (int m = 0; m < 4; ++m) {
                const int row = row0 + ai * HALF + m * 16; float ss = 0.f;
#pragma unroll
                for (int bj = 0; bj < 2; ++bj) { const size_t off = (size_t)row * DM + colt + bj * HALF + cw; const u32x4 w = xw[m][bj];
                    f32x4 v0 = acc[ai][bj][m][0], v1 = acc[ai][bj][m][1];
                    if constexpr (SC32) { v0 *= 0.03125f; v1 *= 0.03125f; }
                    v0[0] += bflo(w.x); v0[1] += bfhi(w.x); v0[2] += bflo(w.y); v0[3] += bfhi(w.y); v1[0] += bflo(w.z); v1[1] += bfhi(w.z); v1[2] += bflo(w.w); v1[3] += bfhi(w.w);
                    if constexpr (F32OUT) { *(f32x4*)(xout + off) = v0; *(f32x4*)(xout + off + 4) = v1; }
                    *(u32x4*)(xb + off) = pack8(v0, v1);
                    if constexpr (X8) { u32x2 q; q.x = cvt_pk4_fp8(v0[0], v0[1], v0[2], v0[3]); q.y = cvt_pk4_fp8(v1[0], v1[1], v1[2], v1[3]); *(u32x2*)(x8 + off) = q; }
                    ss += (v0[0] * v0[0] + v0[1] * v0[1]) + (v0[2] * v0[2] + v0[3] * v0[3]) + (v1[0] * v1[0] + v1[1] * v1[1]) + (v1[2] * v1[2] + v1[3] * v1[3]); }
                ss += __shfl_xor(ss, 16); ss += __shfl_xor(ss, 32);
                if (fq == 0) rowss[(size_t)row * 16 + u.on * 4 + wc] = ss;
            }
            asm volatile("" ::: "memory");
        }
    }
};
struct EpiRowScale {
    bf16_t* O; int ldc; const float* rowss;
    __device__ __forceinline__ void operator()(const f32x4 (&acc)[2][2][4][2], const Unit& u, int wr, int wc, int fr, int fq) const {
        const int row0 = u.om * BM + wr * 64 + fr, colt = u.on * BM, cw = wc * 32 + 8 * fq;
#pragma unroll
        for (int ai = 0; ai < 2; ++ai)
#pragma unroll
            for (int m = 0; m < 4; ++m) {
                const int row = row0 + ai * HALF + m * 16; const float rstd = row_rstd(rowss, row);
#pragma unroll
                for (int bj = 0; bj < 2; ++bj) *(u32x4*)(O + (size_t)row * ldc + colt + bj * HALF + cw) = pack8(acc[ai][bj][m][0] * rstd, acc[ai][bj][m][1] * rstd);
                if (m == 3) asm volatile("" ::: "memory");
            }
    }
};
template <bool MOE> struct EpiSwiGLU {
    bf16_t* H; int ldh; const float* rs; const int* row_tok;
    __device__ __forceinline__ void operator()(const f32x4 (&acc)[2][2][4][2], const Unit& u, int wr, int wc, int fr, int fq) const {
        const int row0 = u.om * BM + wr * 64 + fr, hc = u.on * HALF + wc * 32 + 8 * fq;
#pragma unroll
        for (int ai = 0; ai < 2; ++ai) { float rsd[4];
#pragma unroll
            for (int m = 0; m < 4; ++m) { const int row = row0 + ai * HALF + m * 16; rsd[m] = MOE ? rs[row_tok[row]] : row_rstd(rs, row); }
#pragma unroll
            for (int m = 0; m < 4; ++m) {
                const int row = row0 + ai * HALF + m * 16;
                const float rstd = rsd[m];
                f32x4 o[2];
#pragma unroll
                for (int n = 0; n < 2; ++n)
#pragma unroll
                    for (int j = 0; j < 4; ++j) { const float gv = acc[ai][0][m][n][j] * rstd, uv = acc[ai][1][m][n][j] * rstd; o[n][j] = gv * fsigmoid(gv) * uv; }
                *(u32x4*)(H + (size_t)row * ldh + hc) = pack8(o[0], o[1]);
                if (m == 3) asm volatile("" ::: "memory");
            } }
    }
};
template <bool RSTD, bool W32 = true> struct EpiSwiGLU8 {
    unsigned char* H; int ldh; const float* rs;
    __device__ __forceinline__ void operator()(const f32x4 (&acc)[2][2][4][2], const Unit& u, int wr, int wc, int fr, int fq) const {
        const int row0 = u.om * BM + wr * 64 + fr, hc = u.on * HALF + wc * 32 + 8 * fq;
#pragma unroll
        for (int ai = 0; ai < 2; ++ai)
#pragma unroll
            for (int m = 0; m < 4; ++m) {
                const int row = row0 + ai * HALF + m * 16;
                float sc = W32 ? 0.03125f : 1.f; if constexpr (RSTD) sc *= row_rstd(rs, row);
                f32x4 o[2];
#pragma unroll
                for (int n = 0; n < 2; ++n)
#pragma unroll
                    for (int j = 0; j < 4; ++j) { const float gv = acc[ai][0][m][n][j] * sc, uv = acc[ai][1][m][n][j] * sc; o[n][j] = gv * fsigmoid(gv) * uv; }
                u32x2 w; w.x = cvt_pk4_fp8(o[0][0], o[0][1], o[0][2], o[0][3]); w.y = cvt_pk4_fp8(o[1][0], o[1][1], o[1][2], o[1][3]);
                *(u32x2*)(H + (size_t)row * ldh + hc) = w;
                if (m == 3) asm volatile("" ::: "memory");
            }
    }
};
struct EpiPlain {
    bf16_t* O; int ldc; float sc;
    __device__ __forceinline__ void operator()(const f32x4 (&acc)[2][2][4][2], const Unit& u, int wr, int wc, int fr, int fq) const {
        const int row0 = u.om * BM + wr * 64 + fr, colt = u.on * BM, cw = wc * 32 + 8 * fq;
#pragma unroll
        for (int ai = 0; ai < 2; ++ai)
#pragma unroll
            for (int m = 0; m < 4; ++m) { const int row = row0 + ai * HALF + m * 16;
#pragma unroll
                for (int bj = 0; bj < 2; ++bj) *(u32x4*)(O + (size_t)row * ldc + colt + bj * HALF + cw) = pack8(acc[ai][bj][m][0] * sc, acc[ai][bj][m][1] * sc); }
    }
};
}

#define XB_TMO      128
#define XB_XCNT(j)  (256  + 64 * (j))
#define XB_XSUB(j)  (1280 + 64 * (j))
#define XB_XGEN(j)  (2304 + 64 * (j))
#define XB_TOP      3328
#define XB_TOPGEN   3392
#define XCD_BAR_WORDS 3456
#define XB_SPIN_CAP (1u << 18)
__device__ __forceinline__ unsigned xb_ld(unsigned* p)              { return __hip_atomic_load(p, __ATOMIC_RELAXED, __HIP_MEMORY_SCOPE_AGENT); }
__device__ __forceinline__ unsigned xb_add(unsigned* p, unsigned v) { return __hip_atomic_fetch_add(p, v, __ATOMIC_RELAXED, __HIP_MEMORY_SCOPE_AGENT); }
__device__ __forceinline__ unsigned xb_xcc_id() { return (unsigned)__builtin_amdgcn_s_getreg((3 << 11) | 20) & 0xFu; }
#define XB_SPIN(cond, bar) do { unsigned _sp = 0; while (cond) { __builtin_amdgcn_s_sleep(1); \
    if ((++_sp & 255u) == 0u) { if (xb_ld(&(bar)[XB_TMO])) break; if (_sp > XB_SPIN_CAP) { atomicAdd(&(bar)[XB_TMO], 1u); break; } } } } while (0)
struct XcdBarrier { unsigned* bar; unsigned x; volatile LAS unsigned* st; };
__device__ __forceinline__ XcdBarrier xcd_barrier_post(unsigned* bar, volatile LAS unsigned* st) {
    XcdBarrier b; b.bar = bar; b.x = xb_xcc_id(); b.st = st;
    if (threadIdx.x == 0) (void)xb_add(&bar[XB_XCNT(b.x)], 1u);
    return b;
}
__device__ __forceinline__ void xcd_barrier_complete(unsigned* bar, unsigned x, unsigned& nloc, unsigned& nx) {
    const unsigned G = gridDim.x * gridDim.y * gridDim.z;
    unsigned sum, cnt, mine, sp = 0u;
    for (;;) {
        sum = 0u; cnt = 0u; mine = 0u;
#pragma unroll
        for (unsigned j = 0; j < 16; ++j) { const unsigned c = xb_ld(&bar[XB_XCNT(j)]); sum += c; cnt += (c > 0u) ? 1u : 0u; mine = (j == x) ? c : mine; }
        if (sum == G) break;
        __builtin_amdgcn_s_sleep(1);
        if ((++sp & 255u) == 0u) { if (xb_ld(&bar[XB_TMO])) break; if (sp > XB_SPIN_CAP) { atomicAdd(&bar[XB_TMO], 1u); break; } }
    }
    nloc = mine > 0u ? mine : 1u; nx = cnt > 0u ? cnt : 1u;
}
__device__ __forceinline__ void xcd_barrier(const XcdBarrier& b) {
    asm volatile("s_waitcnt vmcnt(0)" ::: "memory");
    __syncthreads();
    if (threadIdx.x == 0) {
        unsigned* bar = b.bar;
        __builtin_amdgcn_s_waitcnt(0);
        unsigned nloc = b.st[0], nx = b.st[1];
        if (nloc == 0u) { xcd_barrier_complete(bar, b.x, nloc, nx); b.st[0] = nloc; b.st[1] = nx; }
        const unsigned old = xb_add(&bar[XB_XSUB(b.x)], 1u);
        const unsigned gen = old / nloc;
        if (old + 1u == (gen + 1u) * nloc) {
            __builtin_amdgcn_fence(__ATOMIC_RELEASE, "agent");
            asm volatile("s_waitcnt vmcnt(0)" ::: "memory");
            const unsigned og = xb_add(&bar[XB_TOP], 1u);
            const unsigned tg = og / nx;
            if (og + 1u == (tg + 1u) * nx) xb_add(&bar[XB_TOPGEN], 1u);
            else XB_SPIN(xb_ld(&bar[XB_TOPGEN]) == tg, bar);
            __builtin_amdgcn_fence(__ATOMIC_ACQUIRE, "agent");
            xb_add(&bar[XB_XGEN(b.x)], 1u);
            asm volatile("s_waitcnt vmcnt(0)" ::: "memory");
        } else {
            XB_SPIN(xb_ld(&bar[XB_XGEN(b.x)]) == gen, bar);
            __builtin_amdgcn_fence(__ATOMIC_ACQUIRE, "agent");
            asm volatile("s_waitcnt vmcnt(0)" ::: "memory");
        }
    }
    __syncthreads();
}

struct Args { const void* in[55]; float* out; unsigned char* ws; int ph_lo, ph_hi, submask, pad; };
struct Frame {
    LAS unsigned char* lds; unsigned char* ws; unsigned* ctl; float* out;
    int tid, lane, wave, G, bid, gw, ngw;
};
#define GAS __attribute__((address_space(1)))
#define CAS __attribute__((address_space(4)))
#define PHASE_BEGIN() const CAS char* kp_ = (const CAS char*)__builtin_amdgcn_kernarg_segment_ptr(); asm volatile("" : "+s"(kp_)); \
    unsigned char* ws = (unsigned char*)(GAS unsigned char*)(*(const CAS unsigned long long*)(kp_ + 448)); \
    Frame F; { int t_ = threadIdx.x; asm volatile("" : "+v"(t_)); int b_ = blockIdx.x; asm volatile("" : "+s"(b_)); \
      F.lds = (LAS unsigned char*)lds_raw; F.ws = ws; F.ctl = (unsigned*)(ws + WS_CTL); F.out = (float*)(GAS float*)(*(const CAS unsigned long long*)(kp_ + 440)); \
      F.tid = t_; F.lane = t_ & 63; F.wave = __builtin_amdgcn_readfirstlane(t_ >> 6); F.G = gridDim.x; F.bid = b_; F.gw = b_ * 8 + F.wave; F.ngw = F.G * 8; }
#define XB ((bf16_t*)(ws + WS_XB))
#define RS ((float*)(ws + WS_RSP))
#define ZS ((bf16_t*)(ws + WS_ZS))
#define ZG ((bf16_t*)(ws + WS_ZG))
#define YB ((bf16_t*)(ws + WS_Y))
#define MG ((bf16_t*)(ws + WS_MERGED))
#define S5T ((float*)(ws + WS_TAB + TAB_S5T))
#define CMAT ((bf16_t*)(ws + WS_TAB + TAB_CMAT))
#define MISCT ((float*)(ws + WS_TAB + TAB_MISC))
#define BBF ((bf16_t*)(ws + WS_TAB + 832 * 1024))
#define WLP(l) (ws + WS_WL + (size_t)(l) * WL_STRIDE)
#define INF(i) ((const float*)(const GAS float*)(*(const CAS unsigned long long*)(kp_ + 8 * (i))))

struct TJob { const float* W; bf16_t* WT; const float* ks; int K, N, ldw, ldk, nb, map; size_t sstride, dstride; int f8; };
__device__ __forceinline__ int tjob_items(const TJob& j) { return j.nb * (j.K / 64) * (j.N / 32); }
__device__ __forceinline__ void tjob_load(const TJob& j, int item, float (&v)[32], int lane) {
    const int per = (j.K / 64) * (j.N / 32), b = item / per, r = item % per, nblk = j.N / 32, kb = r / nblk, nbk = r % nblk, k0 = 64 * kb, n0 = 32 * nbk;
    const float* W = j.W + (size_t)b * j.sstride + (size_t)(k0 + (lane >> 5)) * j.ldw + n0 + (lane & 31);
#pragma unroll
    for (int i = 0; i < 32; ++i) v[i] = __builtin_nontemporal_load(W + (size_t)(2 * i) * j.ldw);
}
__device__ __forceinline__ void tjob_store(const TJob& j, int item, float (&v)[32], LAS float* scr, int lane) {
    const int per = (j.K / 64) * (j.N / 32), b = item / per, r = item % per, nblk = j.N / 32, kb = r / nblk, nbk = r % nblk, k0 = 64 * kb, n0 = 32 * nbk;
    int drow = n0;
    if (j.map == 1) drow = n0 < C_END ? n0 : n0 + (ZSW - C_END);
    else if (j.map == 2) drow = 256 * (n0 >> 7) + (n0 & 127);
    else if (j.map == 3) drow = 256 * (n0 >> 7) + 128 + (n0 & 127);
    if (j.ks) {
#pragma unroll
        for (int i = 0; i < 32; ++i) v[i] *= j.ks[k0 + 2 * i + (lane >> 5)]; }
#pragma unroll
    for (int i = 0; i < 32; ++i) scr[(2 * i + (lane >> 5)) * 33 + (lane & 31)] = v[i];
    asm volatile("s_waitcnt lgkmcnt(0)" ::: "memory");
    const int c = lane & 7; bf16_t* WT = j.WT + (size_t)b * j.dstride;
    if (j.f8) { unsigned char* W8 = (unsigned char*)j.WT + (size_t)b * j.dstride;
#pragma unroll
        for (int q = 0; q < 4; ++q) { const int n = (lane >> 3) + 8 * q; const LAS float* sp = scr + (8 * c) * 33 + n;
            u32x2 o; o.x = cvt_pk4_fp8(sp[0 * 33] * 32.f, sp[1 * 33] * 32.f, sp[2 * 33] * 32.f, sp[3 * 33] * 32.f); o.y = cvt_pk4_fp8(sp[4 * 33] * 32.f, sp[5 * 33] * 32.f, sp[6 * 33] * 32.f, sp[7 * 33] * 32.f);
            *(u32x2*)(W8 + (size_t)(drow + n) * j.ldk + k0 + 8 * c) = o; }
    } else
#pragma unroll
    for (int q = 0; q < 4; ++q) { const int n = (lane >> 3) + 8 * q; const LAS float* sp = scr + (8 * c) * 33 + n;
        u32x4 o; o.x = cvt_pk_bf16(sp[0 * 33], sp[1 * 33]); o.y = cvt_pk_bf16(sp[2 * 33], sp[3 * 33]); o.z = cvt_pk_bf16(sp[4 * 33], sp[5 * 33]); o.w = cvt_pk_bf16(sp[6 * 33], sp[7 * 33]);
        *(u32x4*)(WT + (size_t)(drow + n) * j.ldk + k0 + 8 * c) = o; }
    asm volatile("s_waitcnt lgkmcnt(0)" ::: "memory");
}
__device__ __forceinline__ void tjob_run_all(const TJob& j, int first, int stride, LAS float* scr, int lane) {
    const int ni = tjob_items(j); int it = first; if (it >= ni) return;
    float va[32], vb[32]; tjob_load(j, it, va, lane);
    for (;;) {
        const int n1 = it + stride; if (n1 < ni) tjob_load(j, n1, vb, lane);
        tjob_store(j, it, va, scr, lane); if (n1 >= ni) break;
        const int n2 = n1 + stride; if (n2 < ni) tjob_load(j, n2, va, lane);
        tjob_store(j, n1, vb, scr, lane); if (n2 >= ni) break;
        it = n2;
    }
}

template <int DQ> struct AttnLds { static constexpr int KROW = DQ * 2 + 16, VROW = 272, KBYTES = 128 * KROW, VBYTES = 64 * VROW, BUF = KBYTES + VBYTES; };
#define PK4(P, BASE, OUT) do { unsigned a0_ = cvt_pk_bf16(P[BASE + 0], P[BASE + 1]), a1_ = cvt_pk_bf16(P[BASE + 2], P[BASE + 3]); \
    unsigned b0_ = cvt_pk_bf16(P[BASE + 4], P[BASE + 5]), b1_ = cvt_pk_bf16(P[BASE + 6], P[BASE + 7]); \
    auto r0_ = __builtin_amdgcn_permlane32_swap(a0_, b0_, false, false); auto r1_ = __builtin_amdgcn_permlane32_swap(a1_, b1_, false, false); \
    u32x4 w_ = {r0_[0], r1_[0], r0_[1], r1_[1]}; OUT = *(bf16x8*)&w_; } while (0)

template <int DQ, int NMAP, bool CAUSAL, bool BIAS, bool QNORM>
__device__ __forceinline__ void attn_unit(LAS unsigned char* lds, const bf16_t* Qp, int ldq, const bf16_t* Kp, const bf16_t* Vtp, int vstride, int nkt, int q0,
                                          const LAS float* lut, const float* qg, float qscale, float mshift, f32x16 (&o)[NMAP][2], float (&l)[NMAP]) {
    typedef AttnLds<DQ> L; constexpr int KD = DQ / NMAP, KS = KD / 16, KCH = DQ / 8, NKC = 64 * KCH;
    int tid = threadIdx.x; asm volatile("" : "+v"(tid));
    const int wid = tid >> 6, lane = tid & 63, r32 = lane & 31, hi = lane >> 5;
    bf16x8 q[NMAP][KS];
    {
        const bf16_t* qrow = Qp + (size_t)(wid * 32 + r32) * ldq + hi * 8;
#pragma unroll
        for (int mp = 0; mp < NMAP; ++mp)
#pragma unroll
            for (int ks = 0; ks < KS; ++ks) q[mp][ks] = ldg8(qrow + mp * KD + ks * 16);
        if constexpr (QNORM) {
            float ss = 0.f;
#pragma unroll
            for (int ks = 0; ks < KS; ++ks) ss += sq8(q[0][ks]);
            ss += __shfl_xor(ss, 32);
            const float rs = frsq(ss * (1.f / DQ) + EPS) * qscale;
#pragma unroll
            for (int ks = 0; ks < KS; ++ks) { u32x4 w = *(u32x4*)&q[0][ks]; const float* gp = qg + ks * 16 + hi * 8;
                w.x = cvt_pk_bf16(bflo(w.x) * rs * gp[0], bfhi(w.x) * rs * gp[1]); w.y = cvt_pk_bf16(bflo(w.y) * rs * gp[2], bfhi(w.y) * rs * gp[3]);
                w.z = cvt_pk_bf16(bflo(w.z) * rs * gp[4], bfhi(w.z) * rs * gp[5]); w.w = cvt_pk_bf16(bflo(w.w) * rs * gp[6], bfhi(w.w) * rs * gp[7]);
                q[0][ks] = *(bf16x8*)&w; }
        }
    }
#pragma unroll
    for (int mp = 0; mp < NMAP; ++mp) { l[mp] = 0.f; o[mp][0] = f32x16{}; o[mp][1] = f32x16{}; }
    constexpr int NKI = (128 * KCH) / 512;
    bf16x8 skr[NKI], svr[2];
#define AT_LOAD(j) do { const int key0_ = (j) * 128; \
        _Pragma("unroll") for (int i_ = 0; i_ < NKI; ++i_) { const int c_ = tid + 512 * i_; skr[i_] = ldg8(Kp + (size_t)(key0_ + c_ / KCH) * DQ + (c_ % KCH) * 8); } \
        _Pragma("unroll") for (int i_ = 0; i_ < 2; ++i_) { const int c_ = tid + 512 * i_; svr[i_] = ldg8(Vtp + (size_t)(c_ >> 4) * vstride + key0_ + (c_ & 15) * 8); } } while (0)
#define AT_WRITE(b) do { LAS unsigned char* base_ = lds + (b) * L::BUF; \
        _Pragma("unroll") for (int i_ = 0; i_ < NKI; ++i_) { const int c_ = tid + 512 * i_; *(LAS bf16x8*)(base_ + (c_ / KCH) * L::KROW + (c_ % KCH) * 16) = skr[i_]; } \
        _Pragma("unroll") for (int i_ = 0; i_ < 2; ++i_) { const int c_ = tid + 512 * i_; *(LAS bf16x8*)(base_ + L::KBYTES + (c_ >> 4) * L::VROW + (c_ & 15) * 16) = svr[i_]; } } while (0)
    const int qi = q0 + wid * 32 + r32;
    const int qlo = q0 + wid * 32;
#define AT_COMPUTE(key0, bf, sb) do { const bool active = !CAUSAL || (key0) <= qlo + 31; \
        if (active) { const LAS unsigned char* kb = lds + (bf) * L::BUF + (sb) * 64 * L::KROW; const LAS unsigned char* vb = lds + (bf) * L::BUF + L::KBYTES + (sb) * 128; const bool need_mask = CAUSAL && ((key0) + 63 > qlo); \
            _Pragma("unroll") for (int mp = 0; mp < NMAP; ++mp) { f32x16 p0 = f32x16{}, p1 = f32x16{}; \
                _Pragma("unroll") for (int ks = 0; ks < KS; ++ks) { \
                    const bf16x8 a0 = *(const LAS bf16x8*)(kb + r32 * L::KROW + (mp * KD + ks * 16 + hi * 8) * 2); \
                    const bf16x8 a1 = *(const LAS bf16x8*)(kb + (32 + r32) * L::KROW + (mp * KD + ks * 16 + hi * 8) * 2); \
                    p0 = MFMA32(a0, q[mp][ks], p0); p1 = MFMA32(a1, q[mp][ks], p1); } \
                __builtin_amdgcn_sched_barrier(0); \
                float sh = mshift; \
                if constexpr (BIAS) { \
                    if (qlo - ((key0) + 63) >= 127) sh -= lut[255]; \
                    else { const LAS float* lp = lut + (qi - (key0) - 4 * hi + 69); \
                        _Pragma("unroll") for (int r = 0; r < 16; ++r) { const int cr = (r & 3) + 8 * (r >> 2); p0[r] += lp[59 - cr]; p1[r] += lp[27 - cr]; } } } \
                if (need_mask) { _Pragma("unroll") for (int r = 0; r < 16; ++r) { const int kk = (key0) + crow(r, hi); if (kk > qi) p0[r] = -1e30f; if (kk + 32 > qi) p1[r] = -1e30f; } } \
                float ps = 0.f; \
                _Pragma("unroll") for (int r = 0; r < 16; ++r) { p0[r] = fexp2(p0[r] - sh); p1[r] = fexp2(p1[r] - sh); ps += p0[r] + p1[r]; } \
                l[mp] += ps; \
                __builtin_amdgcn_sched_barrier(0); \
                bf16x8 pa0, pa1, pa2, pa3; \
                PK4(p0, 0, pa0); PK4(p0, 8, pa1); PK4(p1, 0, pa2); PK4(p1, 8, pa3); \
                _Pragma("unroll") for (int dt = 0; dt < 2; ++dt) { \
                    const LAS unsigned char* vrow = vb + (dt * 32 + r32) * L::VROW + hi * 16; \
                    const bf16x8 v0 = *(const LAS bf16x8*)(vrow), v1 = *(const LAS bf16x8*)(vrow + 32), v2 = *(const LAS bf16x8*)(vrow + 64), v3 = *(const LAS bf16x8*)(vrow + 96); \
                    o[mp][dt] = MFMA32(v0, pa0, o[mp][dt]); o[mp][dt] = MFMA32(v1, pa1, o[mp][dt]); o[mp][dt] = MFMA32(v2, pa2, o[mp][dt]); o[mp][dt] = MFMA32(v3, pa3, o[mp][dt]); } \
                __builtin_amdgcn_sched_barrier(0); } } } while (0)
    const int n128 = nkt >> 1;
    if (wid < 4) __builtin_amdgcn_s_setprio(2);
    AT_LOAD(0); AT_WRITE(0); __syncthreads();
    for (int j = 0; j < n128; ++j) {
        if (j + 1 < n128) AT_LOAD(j + 1);
        AT_COMPUTE(j * 128, j & 1, 0);
        AT_COMPUTE(j * 128 + 64, j & 1, 1);
        if (j + 1 < n128) AT_WRITE((j + 1) & 1);
        __syncthreads();
    }
    __builtin_amdgcn_s_setprio(0);
#undef AT_COMPUTE
#pragma unroll
    for (int mp = 0; mp < NMAP; ++mp) l[mp] += __shfl_xor(l[mp], 32);
#undef AT_LOAD
#undef AT_WRITE
}

__device__ __forceinline__ void attn_store(bf16_t* dst, const f32x16 (&o)[2], float scale, int hi) {
#pragma unroll
    for (int dt = 0; dt < 2; ++dt)
#pragma unroll
        for (int rg = 0; rg < 4; ++rg) { u32x2 w; w.x = cvt_pk_bf16(o[dt][4 * rg] * scale, o[dt][4 * rg + 1] * scale); w.y = cvt_pk_bf16(o[dt][4 * rg + 2] * scale, o[dt][4 * rg + 3] * scale);
            *(u32x2*)(dst + dt * 32 + 8 * rg + 4 * hi) = w; }
}

__device__ __forceinline__ bool in_phase(int k) { const __attribute__((address_space(4))) int* p_ = (const __attribute__((address_space(4))) int*)__builtin_amdgcn_kernarg_segment_ptr(); asm volatile("" : "+s"(p_)); return p_[114] <= k && k < p_[115]; }
__device__ __forceinline__ bool sub_on(int k) { const __attribute__((address_space(4))) int* p_ = (const __attribute__((address_space(4))) int*)__builtin_amdgcn_kernarg_segment_ptr(); asm volatile("" : "+s"(p_)); return (p_[116] >> k) & 1; }
__device__ __forceinline__ void s5_bu_tile(LAS unsigned char* tile, const bf16_t* bbf_g, const bf16_t* zs_tok0, int lane) {
    const int r32 = lane & 31, hi = lane >> 5;
    const bf16x8 uf = ldg8(zs_tok0 + (size_t)r32 * ZSW + 8 * hi);
#pragma unroll
    for (int pt = 0; pt < 4; ++pt) { f32x16 d = f32x16{}; d = MFMA32(ldg8(bbf_g + (size_t)(32 * pt + r32) * 16 + 8 * hi), uf, d);
#pragma unroll
        for (int rg = 0; rg < 4; ++rg) { u32x2 w; w.x = cvt_pk_bf16(d[4 * rg], d[4 * rg + 1]); w.y = cvt_pk_bf16(d[4 * rg + 2], d[4 * rg + 3]);
            *(LAS u32x2*)(tile + r32 * 272 + (32 * pt + 8 * rg + 4 * hi) * 2) = w; } }
    asm volatile("s_waitcnt lgkmcnt(0)" ::: "memory");
}
__device__ __forceinline__ int h0_pull(LAS unsigned* qc, int lane, int wg_items, int bid, int G, int total) {
    unsigned k = 0u; if (lane == 0) k = __hip_atomic_fetch_add(qc, 1u, __ATOMIC_RELAXED, __HIP_MEMORY_SCOPE_WORKGROUP);
    const int kk = __builtin_amdgcn_readfirstlane((int)k);
    return kk < wg_items ? bid + kk * G : total;
}
__device__ __forceinline__ int queue_pull(unsigned* ctr, volatile LAS unsigned* slot, int tid) {
    __syncthreads();
    if (tid == 0) *slot = __hip_atomic_fetch_add(ctr, 1u, __ATOMIC_RELAXED, __HIP_MEMORY_SCOPE_AGENT);
    __syncthreads();
    return (int)*slot;
}
constexpr int NPHASE = 24;
#ifndef DBG_NPH
#endif
__global__ void __launch_bounds__(512, 2) hybrid_fwd(Args args) {
    extern __shared__ __attribute__((aligned(16))) unsigned char lds_raw[];
    LAS unsigned char* lds0 = (LAS unsigned char*)lds_raw;
    volatile LAS unsigned* MISC = (volatile LAS unsigned*)(lds0 + MISC_OFF);
    for (int u = threadIdx.x; u < (LDS_BYTES - RING_BYTES) / 4; u += 512) ((LAS unsigned*)(lds0 + RING_BYTES))[u] = 0u;
    __syncthreads();
    const int lo = args.ph_lo, hi_ph = args.ph_hi;
    const bool one_launch = (hi_ph - lo) > 1;
    XcdBarrier bar; bar.bar = (unsigned*)(args.ws + WS_CTL) + CW_BAR; bar.x = 0; bar.st = nullptr;
    if (one_launch) bar = xcd_barrier_post((unsigned*)(args.ws + WS_CTL) + CW_BAR, MISC + 8);
#ifndef SUBMASK
#define SUBMASK 0xFFFFu
#endif
#define SUB(k) ((((SUBMASK) >> (k)) & 1u) && sub_on(k))
#ifndef PHMASK
#define PHMASK 0xFFFFFFu
#endif
#define IN(k) ((((PHMASK) >> (k)) & 1u) && in_phase(k))
#define SEAM(k) do { if (IN(k) && IN((k) + 1)) { XcdBarrier b2_ = bar; asm volatile("" : "+s"(b2_.bar), "+s"(b2_.x)); xcd_barrier(b2_); } } while (0)

    if (IN(0)) { PHASE_BEGIN();
        LAS float* scr = (LAS float*)(F.lds + F.wave * 16384);
        int joff = 0;
        for (int l = 0; l < 2; ++l) {
            unsigned char* wl = ws + WS_WL + l * WL_STRIDE;
#define RUNJOB(...) do { const TJob jb_ = TJob{__VA_ARGS__}; int fst_ = F.gw - joff; if (fst_ < 0) fst_ += F.ngw; tjob_run_all(jb_, fst_, F.ngw, scr, F.lane); joff = (joff + tjob_items(jb_)) % F.ngw; } while (0)
            RUNJOB(INF(8) + (size_t)l * DM * DIN, (bf16_t*)(wl + WL_WIN), INF(4) + l * DM, DM, DIN, DIN, DM, 1, 1, 0, 0);
            RUNJOB(INF(22) + (size_t)l * 192 * 384, (bf16_t*)(wl + WL_SM + SM_WUQ), INF(20) + l * 192, 192, 384, 384, 192, 1, 0, 0, 0);
            RUNJOB(INF(23) + (size_t)l * 128 * 512, (bf16_t*)(wl + WL_SM + SM_WUKV), INF(21) + l * 128, 128, 512, 512, 128, 1, 0, 0, 0);
            RUNJOB(INF(28) + (size_t)l * 4 * 4096, (bf16_t*)(wl + WL_SM + SM_WR), nullptr, 64, 64, 64, 64, 4, 0, 4096, 4096);
            RUNJOB(INF(30) + (size_t)l * 4 * 4096, (bf16_t*)(wl + WL_SM + SM_WI), nullptr, 64, 64, 64, 64, 4, 0, 4096, 4096);
            RUNJOB(INF(18) + (size_t)l * 65536, (bf16_t*)(wl + WL_SM + SM_WGLU), nullptr, 256, 256, 256, 256, 1, 0, 0, 0);
            RUNJOB(INF(40) + (size_t)l * 4 * 256 * DM, (bf16_t*)(wl + WL_PT), nullptr, 256, DM, DM, 256, 4, 0, (size_t)256 * DM, (size_t)DM * 256);
            RUNJOB(INF(41) + (size_t)l * DM * DM, (bf16_t*)(wl + WL_WO), nullptr, DM, DM, DM, DM, 1, 0, 0, 0);
            RUNJOB(INF(42) + (size_t)l * DM * 256, (bf16_t*)(wl + WL_WXQ), INF(5) + l * DM, DM, 256, 256, DM, 1, 0, 0, 0);
            RUNJOB(INF(43) + (size_t)l * DM * 256, (bf16_t*)(wl + WL_WXKV), INF(6) + l * DM, DM, 256, 256, DM, 1, 0, 0, 0);
            RUNJOB(INF(44) + (size_t)l * DM * 256, (bf16_t*)(wl + WL_WXKV) + (size_t)256 * DM, INF(6) + l * DM, DM, 256, 256, DM, 1, 0, 0, 0);
            RUNJOB(INF(45) + (size_t)l * 256 * DM, (bf16_t*)(wl + WL_WXO), nullptr, 256, DM, DM, 256, 1, 0, 0, 0);
            { u32x4* z = (u32x4*)((bf16_t*)(wl + WL_WIN) + (size_t)C_END * DM); const int n16 = (ZSW - C_END) * DM * 2 / 16;
              for (int i = F.bid * 512 + F.tid; i < n16; i += F.G * 512) z[i] = (u32x4){0u, 0u, 0u, 0u}; }
        }
        {
            RUNJOB(INF(48), (bf16_t*)(ws + WS_WGU), INF(7), DM, FF, FF, DM, 1, 2, 0, 0);
            RUNJOB(INF(49), (bf16_t*)(ws + WS_WGU), INF(7), DM, FF, FF, DM, 1, 3, 0, 0);
            RUNJOB(INF(50), (bf16_t*)(ws + WS_WD), nullptr, FF, DM, DM, FF, 1, 0, 0, 0, G2_FP8);
        }
        for (int i = F.bid * 512 + F.tid; i < 2 * 16 * 64; i += F.G * 512) {
            const int l = i >> 10, g = (i >> 6) & 15, p = i & 63;
            const float dt = __expf(INF(12)[l * 16 + g]);
            const float lr = INF(10)[(l * 16 + g) * 64 + p], li = INF(11)[(l * 16 + g) * 64 + p];
            const float mag = __expf(lr * dt); float sn, cs; sincos_red(li * dt, sn, cs);
            const float ar = mag * cs, ai = mag * sn, den = lr * lr + li * li;
            const float zr = ((ar - 1.f) * lr + ai * li) / den, zi = (ai * lr - (ar - 1.f) * li) / den;
            float* tb = S5T + (size_t)(l * 16 + g) * 36 * 64;
            for (int c = 0; c < 16; ++c) { const float br = INF(13)[((l * 16 + g) * 64 + p) * 16 + c], bi = INF(14)[((l * 16 + g) * 64 + p) * 16 + c];
                tb[c * 64 + p] = zr * br - zi * bi; tb[(16 + c) * 64 + p] = zr * bi + zi * br;
                BBF[((size_t)(l * 16 + g) * 128 + p) * 16 + c] = f2bf(zr * br - zi * bi); BBF[((size_t)(l * 16 + g) * 128 + 64 + p) * 16 + c] = f2bf(zr * bi + zi * br); }
            tb[32 * 64 + p] = ar; tb[33 * 64 + p] = ai;
            float pr = ar, pi = ai;
            for (int s = 0; s < 6; ++s) { const float nr = pr * pr - pi * pi, ni = 2.f * pr * pi; pr = nr; pi = ni; }
            tb[34 * 64 + p] = pr; tb[35 * 64 + p] = pi;
            bf16_t* cm = CMAT + (size_t)(l * 16 + g) * 16 * 128;
            for (int c = 0; c < 16; ++c) { cm[c * 128 + p] = f2bf(INF(15)[((l * 16 + g) * 16 + c) * 64 + p]); cm[c * 128 + 64 + p] = f2bf(-INF(16)[((l * 16 + g) * 16 + c) * 64 + p]); }
        }
        for (int i = F.bid * 512 + F.tid; i < 512; i += F.G * 512) { const float lam = INF(32)[i]; MISCT[i] = 8.f * log1pf(__expf(-lam)); }
        if (F.bid == 0 && F.tid < 2) { const int l = F.tid; float s1 = 0.f, s2 = 0.f;
            for (int d = 0; d < 32; ++d) { s1 += INF(35)[l * 32 + d] * INF(36)[l * 32 + d]; s2 += INF(37)[l * 32 + d] * INF(38)[l * 32 + d]; }
            const float lam_init = 0.8f - 0.6f * expf(-0.3f * (float)l);
            MISCT[512 + l] = expf(s1) - expf(s2) + lam_init; MISCT[514 + l] = lam_init;
            float gq = 0.f, gk = 0.f; for (int d = 0; d < 96; ++d) { gq = fmaxf(gq, fabsf(INF(24)[l * 96 + d])); gk = fmaxf(gk, fabsf(INF(25)[l * 96 + d])); }
            MISCT[516 + l * 4 + 0] = 1.02f * gq * gk * 9.797958971f * LOG2E;
            gq = 0.f; gk = 0.f; for (int d = 0; d < 32; ++d) { gq = fmaxf(gq, fabsf(INF(33)[l * 32 + d])); gk = fmaxf(gk, fabsf(INF(34)[l * 32 + d])); }
            float bm = 0.f; for (int i = 0; i < 128; ++i) bm = fmaxf(bm, fabsf(INF(3)[i]));
            MISCT[516 + l * 4 + 1] = 1.02f * gq * gk * 5.656854249f * LOG2E + bm * LOG2E;
            gq = 0.f; gk = 0.f; for (int d = 0; d < 64; ++d) { gq = fmaxf(gq, fabsf(INF(46)[l * 64 + d])); gk = fmaxf(gk, fabsf(INF(47)[l * 64 + d])); }
            MISCT[516 + l * 4 + 2] = 1.02f * gq * gk * 8.f * LOG2E; }
        for (int i = F.bid * 512 + F.tid; i < 4 * 384; i += F.G * 512) { const int h = i / 384, dd = i % 384 - 128, d = dd > 127 ? 127 : dd; int bk;
            if (d < 16) bk = d < 0 ? 0 : d; else { const float lr_ = logf((float)d / 16.f) / logf(8.f); bk = 16 + (int)(lr_ * 16.f); if (bk > 31) bk = 31; }
            MISCT[1024 + i] = dd < 0 ? 0.f : INF(3)[bk * 4 + h] * LOG2E; }
        for (int m = F.gw; m < MTOK; m += F.ngw) {
            const f32x4* xr = (const f32x4*)(INF(0) + (size_t)m * DM) + F.lane; float s = 0.f;
            u32x2* o8 = (u32x2*)(XB + (size_t)m * DM) + F.lane;
#pragma unroll
            for (int j = 0; j < 4; ++j) { const f32x4 v = __builtin_nontemporal_load(xr + 64 * j); s += (v.x * v.x + v.y * v.y) + (v.z * v.z + v.w * v.w); u32x2 w; w.x = cvt_pk_bf16(v.x, v.y); w.y = cvt_pk_bf16(v.z, v.w); o8[64 * j] = w; }
            s = wave_sum(s); if (F.lane < 16) RS[(size_t)m * 16 + F.lane] = F.lane == 0 ? s : 0.f;
        }
    }
    SEAM(0);

    for (int l = 0; l < 2; ++l) {
        const int pb = 1 + 10 * l;
        if (IN(pb + 0)) { PHASE_BEGIN();
            pg8::Gemm g{XB, (const bf16_t*)(WLP(l) + WL_WIN), DM, nullptr}; pg8::StaticOrder S; S.init(MTOK / 256, NIN / 256, F.G, F.bid);
            pg8::EpiIn E{ZS, ZG, RS + (size_t)(l == 0 ? 0 : 3) * MTOK * 16, INF(9) + (size_t)l * 4 * DM};
            pg8::gemm_phase<pg8::EpiIn, pg8::StaticOrder, true, false>(F.lds, g, S, E);
        }
        SEAM(pb + 0);
        if (IN(pb + 1)) { PHASE_BEGIN();
            const int lane = F.lane, r = lane & 31, hi = lane >> 5;
            bf16_t* QM = (bf16_t*)(ws + WS_QM); bf16_t* KM = (bf16_t*)(ws + WS_KM); bf16_t* VMT = (bf16_t*)(ws + WS_VMT);
            if (SUB(0) && F.wave < 2) for (int tt = F.bid * 2 + F.wave; tt < 512; tt += F.G * 2) {
                const int row = tt * 32 + r, b = row >> 12, s = row & 4095;
                bf16x8 xq[12]; float ss = 0.f;
#pragma unroll
                for (int ks = 0; ks < 12; ++ks) { xq[ks] = ldg8(ZS + (size_t)row * ZSW + C_CQ + 16 * ks + 8 * hi); ss += sq8(xq[ks]); }
                ss += __shfl_xor(ss, 32); const float rc = frsq(ss * (1.f / 192.f) + EPS);
                const float pos = (float)((const int*)INF(2))[row]; float cs[8], sn[8];
#pragma unroll
                for (int i = 0; i < 8; ++i) { const int fi = crow(i, hi); const float inv = exp2f(-(float)fi * (13.287712379549449f / 16.f)); sincos_red(pos * inv, sn[i], cs[i]); }
                const bf16_t* W = (const bf16_t*)(WLP(l) + WL_SM + SM_WUQ); const float* gq = INF(24) + l * 96;
#pragma unroll 1
                for (int hd = 0; hd < 4; ++hd) {
                    f32x16 acc[3] = {f32x16{}, f32x16{}, f32x16{}};
#pragma unroll
                    for (int ft = 0; ft < 3; ++ft) {
#pragma unroll
                        for (int ks = 0; ks < 12; ++ks) acc[ft] = MFMA32(ldg8(W + (size_t)(hd * 96 + 32 * ft + r) * 192 + 16 * ks + 8 * hi), xq[ks], acc[ft]); }
                    float s2 = 0.f;
#pragma unroll
                    for (int ft = 0; ft < 3; ++ft)
#pragma unroll
                        for (int q = 0; q < 16; ++q) { acc[ft][q] *= rc; s2 += acc[ft][q] * acc[ft][q]; }
                    s2 += __shfl_xor(s2, 32); const float rq = frsq(s2 * (1.f / 96.f) + EPS);
#pragma unroll
                    for (int ft = 0; ft < 3; ++ft)
#pragma unroll
                        for (int q = 0; q < 16; ++q) acc[ft][q] *= rq * gq[32 * ft + crow(q, hi)];
#pragma unroll
                    for (int q = 0; q < 8; ++q) { const float x1 = acc[2][q], x2 = acc[2][q + 8]; acc[2][q] = x1 * cs[q] - x2 * sn[q]; acc[2][q + 8] = x1 * sn[q] + x2 * cs[q]; }
                    const float qs = 0.10206207261596577f * LOG2E;
                    bf16_t* dst = QM + ((size_t)(b * 4 + hd) * SEQ + s) * 96;
#pragma unroll
                    for (int ft = 0; ft < 3; ++ft)
#pragma unroll
                        for (int rg = 0; rg < 4; ++rg) { u32x2 w; w.x = cvt_pk_bf16(acc[ft][4 * rg] * qs, acc[ft][4 * rg + 1] * qs); w.y = cvt_pk_bf16(acc[ft][4 * rg + 2] * qs, acc[ft][4 * rg + 3] * qs);
                            *(u32x2*)(dst + 32 * ft + 8 * rg + 4 * hi) = w; }
                }
            }
            if (SUB(1) && (F.wave == 2 || F.wave == 3)) for (int tt = F.bid * 2 + F.wave - 2; tt < 512; tt += F.G * 2) {
                const int row = tt * 32 + r, b = row >> 12, s = row & 4095;
                bf16x8 xk[8]; float ss = 0.f;
#pragma unroll
                for (int ks = 0; ks < 8; ++ks) { xk[ks] = ldg8(ZS + (size_t)row * ZSW + C_CKV + 16 * ks + 8 * hi); ss += sq8(xk[ks]); }
                ss += __shfl_xor(ss, 32); const float rc = frsq(ss * (1.f / 128.f) + EPS);
                float kp[16]; float sskp = 0.f;
#pragma unroll
                for (int rg = 0; rg < 4; ++rg) { const u32x2 w = *(const u32x2*)(ZS + (size_t)row * ZSW + C_KPE + 8 * rg + 4 * hi);
                    kp[4 * rg] = bflo(w.x); kp[4 * rg + 1] = bfhi(w.x); kp[4 * rg + 2] = bflo(w.y); kp[4 * rg + 3] = bfhi(w.y); }
#pragma unroll
                for (int q = 0; q < 16; ++q) sskp += kp[q] * kp[q];
                const float pos = (float)((const int*)INF(2))[row]; float cs[8], sn[8];
#pragma unroll
                for (int i = 0; i < 8; ++i) { const int fi = crow(i, hi); const float inv = exp2f(-(float)fi * (13.287712379549449f / 16.f)); sincos_red(pos * inv, sn[i], cs[i]); }
                const bf16_t* W = (const bf16_t*)(WLP(l) + WL_SM + SM_WUKV); const float* gk = INF(25) + l * 96;
#pragma unroll 1
                for (int hd = 0; hd < 4; ++hd) {
                    f32x16 acc[4] = {f32x16{}, f32x16{}, f32x16{}, f32x16{}};
#pragma unroll
                    for (int ft = 0; ft < 4; ++ft) {
#pragma unroll
                        for (int ks = 0; ks < 8; ++ks) acc[ft] = MFMA32(ldg8(W + (size_t)(hd * 128 + 32 * ft + r) * 128 + 16 * ks + 8 * hi), xk[ks], acc[ft]); }
                    float s2 = sskp;
#pragma unroll
                    for (int ft = 0; ft < 2; ++ft)
#pragma unroll
                        for (int q = 0; q < 16; ++q) { acc[ft][q] *= rc; s2 += acc[ft][q] * acc[ft][q]; }
                    s2 += __shfl_xor(s2, 32); const float rk = frsq(s2 * (1.f / 96.f) + EPS);
                    float kr[16];
#pragma unroll
                    for (int q = 0; q < 16; ++q) kr[q] = kp[q] * rk * gk[64 + crow(q, hi)];
#pragma unroll
                    for (int q = 0; q < 8; ++q) { const float x1 = kr[q], x2 = kr[q + 8]; kr[q] = x1 * cs[q] - x2 * sn[q]; kr[q + 8] = x1 * sn[q] + x2 * cs[q]; }
                    bf16_t* dst = KM + ((size_t)(b * 4 + hd) * SEQ + s) * 96;
#pragma unroll
                    for (int ft = 0; ft < 2; ++ft)
#pragma unroll
                        for (int rg = 0; rg < 4; ++rg) { const float* gp = gk + 32 * ft + 8 * rg + 4 * hi; u32x2 w;
                            w.x = cvt_pk_bf16(acc[ft][4 * rg] * rk * gp[0], acc[ft][4 * rg + 1] * rk * gp[1]); w.y = cvt_pk_bf16(acc[ft][4 * rg + 2] * rk * gp[2], acc[ft][4 * rg + 3] * rk * gp[3]);
                            *(u32x2*)(dst + 32 * ft + 8 * rg + 4 * hi) = w; }
#pragma unroll
                    for (int rg = 0; rg < 4; ++rg) { u32x2 w; w.x = cvt_pk_bf16(kr[4 * rg], kr[4 * rg + 1]); w.y = cvt_pk_bf16(kr[4 * rg + 2], kr[4 * rg + 3]); *(u32x2*)(dst + 64 + 8 * rg + 4 * hi) = w; }
                    bf16_t* vd = VMT + (size_t)(b * 4 + hd) * 64 * SEQ + s;
#pragma unroll
                    for (int ft = 2; ft < 4; ++ft)
#pragma unroll
                        for (int q = 0; q < 16; ++q) vd[(size_t)(32 * (ft - 2) + crow(q, hi)) * SEQ] = f2bf(acc[ft][q] * rc);
                }
            }
            if (SUB(2)) {
                bf16_t* QD = (bf16_t*)(ws + WS_QD); bf16_t* KD = (bf16_t*)(ws + WS_KD); bf16_t* VDT = (bf16_t*)(ws + WS_VDT);
                const float* gqn = INF(33) + l * 32; const float* gkn = INF(34) + l * 32;
                for (int i = F.bid * 512 + F.tid; i < MTOK * 16; i += F.G * 512) {
                    const int row = i & (MTOK - 1), j = i >> 14, half = j & 1, hd = (j >> 1) & 3, isk = j >> 3;
                    const bf16_t* src = ZS + (size_t)row * ZSW + (isk ? C_KD : C_QD) + hd * 64 + half * 32;
                    bf16x8 v[4]; float ss = 0.f;
#pragma unroll
                    for (int c = 0; c < 4; ++c) { v[c] = ldg8(src + 8 * c); ss += sq8(v[c]); }
                    const float rs = frsq(ss * (1.f / 32.f) + EPS) * (isk ? 1.f : 0.17677669529663687f * LOG2E);
                    const float* gg = isk ? gkn : gqn; const int b = row >> 12, s = row & 4095;
                    bf16_t* dst = (isk ? KD : QD) + ((size_t)(b * 4 + hd) * SEQ + s) * 64 + half * 32;
#pragma unroll
                    for (int c = 0; c < 4; ++c) { u32x4 w = *(u32x4*)&v[c]; const float* gp = gg + 8 * c;
                        w.x = cvt_pk_bf16(bflo(w.x) * rs * gp[0], bfhi(w.x) * rs * gp[1]); w.y = cvt_pk_bf16(bflo(w.y) * rs * gp[2], bfhi(w.y) * rs * gp[3]);
                        w.z = cvt_pk_bf16(bflo(w.z) * rs * gp[4], bfhi(w.z) * rs * gp[5]); w.w = cvt_pk_bf16(bflo(w.w) * rs * gp[6], bfhi(w.w) * rs * gp[7]);
                        *(u32x4*)(dst + 8 * c) = w; }
                }
                for (int i = F.bid * 512 + F.tid; i < MTOK * 32; i += F.G * 512) {
                    const int row = i & (MTOK - 1), j = i >> 14, oc = j & 7, hd = j >> 3, b = row >> 12, s = row & 4095;
                    const bf16x8 v = ldg8(ZS + (size_t)row * ZSW + C_VD + hd * 64 + oc * 8);
                    bf16_t* vd = VDT + ((size_t)(b * 4 + hd) * 64 + oc * 8) * SEQ + s;
#pragma unroll
                    for (int e = 0; e < 8; ++e) vd[(size_t)e * SEQ] = (bf16_t)v[e];
                }
            }
            if (SUB(3)) {
                float* LA = (float*)(ws + WS_LA); float* LI = (float*)(ws + WS_LI); float* LSA = (float*)(ws + WS_LSUM); float* LSH = LSA + NB * 128 * 256;
                const float* cw = INF(26) + l * 4 * 256; const float* cb = INF(27) + l * 256; const float* br = INF(29) + l * 256; const float* bi = INF(31) + l * 256;
                const float* c8 = MISCT + l * 256;
                LAS float* lsa = (LAS float*)(F.lds + F.wave * 16384); LAS float* lsh = lsa + 32 * 64;
                for (int tk = F.gw; tk < NB * 128 * 4; tk += F.ngw) {
                    const int n = tk & 3, tile = (tk >> 2) & 127, b = tk >> 9, s = tile * 32 + r, row = b * SEQ + s, cbase = 64 * n;
                    bf16x8 xcb[4]; float xcf[4][8];
#pragma unroll
                    for (int ks = 0; ks < 4; ++ks) {
                        const int c0 = cbase + 16 * ks + 8 * hi;
#pragma unroll
                        for (int e = 0; e < 8; ++e) xcf[ks][e] = cb[c0 + e];
#pragma unroll
                        for (int k = 0; k < 4; ++k) { const int sr = s - 3 + k;
                            if (sr >= 0) { const bf16x8 xv = ldg8(ZS + (size_t)(b * SEQ + sr) * ZSW + C_XLRU + c0); const u32x4 w = *(const u32x4*)&xv; const float* wk = cw + k * 256 + c0;
                                xcf[ks][0] += wk[0] * bflo(w.x); xcf[ks][1] += wk[1] * bfhi(w.x); xcf[ks][2] += wk[2] * bflo(w.y); xcf[ks][3] += wk[3] * bfhi(w.y);
                                xcf[ks][4] += wk[4] * bflo(w.z); xcf[ks][5] += wk[5] * bfhi(w.z); xcf[ks][6] += wk[6] * bflo(w.w); xcf[ks][7] += wk[7] * bfhi(w.w); } }
                        u32x4 pw; pw.x = cvt_pk_bf16(xcf[ks][0], xcf[ks][1]); pw.y = cvt_pk_bf16(xcf[ks][2], xcf[ks][3]); pw.z = cvt_pk_bf16(xcf[ks][4], xcf[ks][5]); pw.w = cvt_pk_bf16(xcf[ks][6], xcf[ks][7]); xcb[ks] = *(bf16x8*)&pw;
                    }
                    const bf16_t* Wr = (const bf16_t*)(WLP(l) + WL_SM + SM_WR) + n * 4096; const bf16_t* Wi = (const bf16_t*)(WLP(l) + WL_SM + SM_WI) + n * 4096;
                    f32x16 ar_[2] = {f32x16{}, f32x16{}}, ai_[2] = {f32x16{}, f32x16{}};
#pragma unroll
                    for (int ft = 0; ft < 2; ++ft)
#pragma unroll
                        for (int ks = 0; ks < 4; ++ks) { ar_[ft] = MFMA32(ldg8(Wr + (32 * ft + r) * 64 + 16 * ks + 8 * hi), xcb[ks], ar_[ft]); ai_[ft] = MFMA32(ldg8(Wi + (32 * ft + r) * 64 + 16 * ks + 8 * hi), xcb[ks], ai_[ft]); }
                    float xloc[4][4], xrcv[4][4];
#pragma unroll
                    for (int ks = 0; ks < 4; ++ks)
#pragma unroll
                        for (int j = 0; j < 4; ++j) { xloc[ks][j] = hi ? xcf[ks][4 + j] : xcf[ks][j]; const float snd = hi ? xcf[ks][j] : xcf[ks][4 + j]; xrcv[ks][j] = __shfl_xor(snd, 32); }
#pragma unroll
                    for (int ft = 0; ft < 2; ++ft)
#pragma unroll
                        for (int rg = 0; rg < 4; ++rg) {
                            const int c0 = cbase + 32 * ft + 8 * rg + 4 * hi, ks = 2 * ft + (rg >> 1);
                            f32x4 av, iv;
#pragma unroll
                            for (int e = 0; e < 4; ++e) { const float xce = ((rg & 1) == hi) ? xloc[ks][e] : xrcv[ks][e];
                                const float rr = fsigmoid(ar_[ft][4 * rg + e] + br[c0 + e]), ii = fsigmoid(ai_[ft][4 * rg + e] + bi[c0 + e]);
                                const float la = -rr * c8[c0 + e]; const float a = fexp2(la * LOG2E); av[e] = a; iv[e] = sqrtf(fmaxf(1.f - a * a, 0.f)) * ii * xce; }
                            *(f32x4*)(LA + (size_t)row * 256 + c0) = av; *(f32x4*)(LI + (size_t)row * 256 + c0) = iv;
                            { const int sc_ = (32 * ft + 8 * rg + 4 * hi) ^ ((r & 7) << 2); *(LAS f32x4*)(lsa + r * 64 + sc_) = av; *(LAS f32x4*)(lsh + r * 64 + sc_) = iv; }
                        }
                    asm volatile("s_waitcnt lgkmcnt(0)" ::: "memory");
                    {
                        float ta = 1.f, th = 0.f;
#pragma unroll
                        for (int t = 0; t < 32; ++t) { const float a_ = lsa[t * 64 + (lane ^ ((t & 7) << 2))], h_ = lsh[t * 64 + (lane ^ ((t & 7) << 2))]; th = a_ * th + h_; ta = ta * a_; }
                        LSA[(size_t)(b * 128 + tile) * 256 + cbase + lane] = ta; LSH[(size_t)(b * 128 + tile) * 256 + cbase + lane] = th;
                    }
                    asm volatile("s_waitcnt lgkmcnt(0)" ::: "memory");
                }
            }
            if (SUB(4)) {
                float* S5S = (float*)(ws + WS_S5S);
                const int t5cnt = F.wave < 4 ? 1 : (F.wave == 4 ? 0 : 4), t5off = F.wave < 4 ? F.wave : 4 + 4 * (F.wave - 5);
                for (int tbk = F.bid; tbk < NB * 64; tbk += F.G) for (int tj = 0; tj < t5cnt; ++tj) { const int tk = tbk * 16 + t5off + tj;
                    const int g = tk & 15, ch = (tk >> 4) & 63, b = tk >> 10;
                    const float* tb = S5T + (size_t)(l * 16 + g) * 36 * 64 + lane;
                    const float ar = tb[32 * 64], ai = tb[33 * 64];
                    LAS unsigned char* tile = F.lds + F.wave * 16384;
                    float hr = 0.f, hi2 = 0.f;
#pragma unroll 1
                    for (int hf = 0; hf < 2; ++hf) {
                        s5_bu_tile(tile, BBF + (size_t)(l * 16 + g) * 128 * 16, ZS + (size_t)(b * SEQ + ch * 64 + hf * 32) * ZSW + C_S5 + 16 * g, lane);
#pragma unroll 8
                        for (int t2 = 0; t2 < 32; ++t2) { const float bur = bf2f(*(const LAS bf16_t*)(tile + t2 * 272 + lane * 2)), bui = bf2f(*(const LAS bf16_t*)(tile + t2 * 272 + 128 + lane * 2));
                            const float nr = ar * hr - ai * hi2 + bur, ni = ar * hi2 + ai * hr + bui; hr = nr; hi2 = ni; }
                        asm volatile("s_waitcnt lgkmcnt(0)" ::: "memory");
                    }
                    float* dst = S5S + ((size_t)((b * 64 + ch) * 16 + g) * 2) * 64 + lane; dst[0] = hr; dst[64] = hi2;
                }
            }
            if (SUB(5) && l == 0) {
                bf16_t* KX = (bf16_t*)(ws + WS_KX); bf16_t* VXT = (bf16_t*)(ws + WS_VXT);
                if (F.wave == 4) for (int tk = F.bid; tk < 2 * 32 * 4; tk += F.G) {
                    const int hd = tk & 3, mt = (tk >> 2) & 31, ly = tk >> 7, row = mt * 32 + r, b = row >> 8, jm = row & 255;
                    const bf16_t* W = (const bf16_t*)(ws + WS_WL + ly * WL_STRIDE + WL_WXKV);
                    f32x16 acc[4] = {f32x16{}, f32x16{}, f32x16{}, f32x16{}}; float ss = 0.f;
                    const float* mp = INF(1) + (size_t)row * DM + 8 * hi;
#pragma unroll 2
                    for (int ks = 0; ks < 64; ++ks) {
                        const f32x4 m0 = *(const f32x4*)(mp + 16 * ks), m1 = *(const f32x4*)(mp + 16 * ks + 4);
                        ss += (m0.x * m0.x + m0.y * m0.y) + (m0.z * m0.z + m0.w * m0.w) + (m1.x * m1.x + m1.y * m1.y) + (m1.z * m1.z + m1.w * m1.w);
                        const u32x4 pw = pg8::pack8(m0, m1); const bf16x8 xb = *(const bf16x8*)&pw;
#pragma unroll
                        for (int f = 0; f < 4; ++f) { const int wrow = (f < 2 ? 64 * hd + 32 * f : 256 + 64 * hd + 32 * (f - 2)) + r; acc[f] = MFMA32(ldg8(W + (size_t)wrow * DM + 16 * ks + 8 * hi), xb, acc[f]); }
                    }
                    ss += __shfl_xor(ss, 32); const float rm = frsq(ss * (1.f / DM) + EPS);
                    float s2 = 0.f;
#pragma unroll
                    for (int f = 0; f < 2; ++f)
#pragma unroll
                        for (int q = 0; q < 16; ++q) { acc[f][q] *= rm; s2 += acc[f][q] * acc[f][q]; }
                    s2 += __shfl_xor(s2, 32); const float rk = frsq(s2 * (1.f / 64.f) + EPS);
                    const float* gk = INF(47) + ly * 64;
                    bf16_t* kd = KX + ((size_t)(ly * 16 + b * 4 + hd) * 256 + jm) * 64;
#pragma unroll
                    for (int f = 0; f < 2; ++f)
#pragma unroll
                        for (int rg = 0; rg < 4; ++rg) { const float* gp = gk + 32 * f + 8 * rg + 4 * hi; u32x2 w;
                            w.x = cvt_pk_bf16(acc[f][4 * rg] * rk * gp[0], acc[f][4 * rg + 1] * rk * gp[1]); w.y = cvt_pk_bf16(acc[f][4 * rg + 2] * rk * gp[2], acc[f][4 * rg + 3] * rk * gp[3]);
                            *(u32x2*)(kd + 32 * f + 8 * rg + 4 * hi) = w; }
                    bf16_t* vd = VXT + (size_t)(ly * 16 + b * 4 + hd) * 64 * 256 + jm;
#pragma unroll
                    for (int f = 2; f < 4; ++f)
#pragma unroll
                        for (int q = 0; q < 16; ++q) vd[(size_t)(32 * (f - 2) + crow(q, hi)) * 256] = f2bf(acc[f][q] * rm);
                }
            }
        }
        SEAM(pb + 1);
        if (IN(pb + 2)) {
            if (SUB(6)) { PHASE_BEGIN();
            const int lane = F.lane, r32 = lane & 31, hi = lane >> 5, wid = F.wave;
            volatile LAS unsigned* qslot = (volatile LAS unsigned*)(F.lds + MISC_OFF + 64);
            for (int it = queue_pull(F.ctl + CW_Q + 64 * (4 * l + 0), qslot, F.tid); it < 256; it = queue_pull(F.ctl + CW_Q + 64 * (4 * l + 0), qslot, F.tid)) {
                {
                    const int bh = it & 15, qt = 15 - (it >> 4), b = bh >> 2, hd = bh & 3;
                    const bf16_t* QM = (const bf16_t*)(ws + WS_QM) + (size_t)bh * SEQ * 96; const bf16_t* KM = (const bf16_t*)(ws + WS_KM) + (size_t)bh * SEQ * 96;
                    const bf16_t* VMT = (const bf16_t*)(ws + WS_VMT) + (size_t)bh * 64 * SEQ;
                    f32x16 o[1][2]; float lsum[1];
                    attn_unit<96, 1, true, false, false>(F.lds, QM + (size_t)qt * 256 * 96, 96, KM, VMT, SEQ, 4 * (qt + 1), 256 * qt, nullptr, nullptr, 1.f, MISCT[516 + l * 4 + 0], o, lsum);
                    const int row = b * SEQ + qt * 256 + wid * 32 + r32;
                    attn_store(YB + (size_t)1 * MTOK * 256 + (size_t)row * 256 + hd * 64, o[0], frcp(lsum[0]), hi);
                }
            } }
            if (SUB(7)) { PHASE_BEGIN();
            const int lane = F.lane, r32 = lane & 31, hi = lane >> 5, wid = F.wave;
            LAS float* lut = (LAS float*)(F.lds + 106496);
            for (int i = F.tid; i < 4 * 384; i += 512) lut[i] = MISCT[1024 + i];
            __syncthreads();
            volatile LAS unsigned* qslot = (volatile LAS unsigned*)(F.lds + MISC_OFF + 64);
            for (int it = queue_pull(F.ctl + CW_Q + 64 * (4 * l + 1), qslot, F.tid); it < 256; it = queue_pull(F.ctl + CW_Q + 64 * (4 * l + 1), qslot, F.tid)) {
                {
                    const int bh = it & 15, qt = 15 - (it >> 4), b = bh >> 2, hd = bh & 3;
                    const bf16_t* QD = (const bf16_t*)(ws + WS_QD) + (size_t)bh * SEQ * 64; const bf16_t* KD = (const bf16_t*)(ws + WS_KD) + (size_t)bh * SEQ * 64;
                    const bf16_t* VDT = (const bf16_t*)(ws + WS_VDT) + (size_t)bh * 64 * SEQ;
                    f32x16 o[2][2]; float lsum[2];
                    attn_unit<64, 2, true, true, false>(F.lds, QD + (size_t)qt * 256 * 64, 64, KD, VDT, SEQ, 4 * (qt + 1), 256 * qt, lut + hd * 384, nullptr, 1.f, MISCT[516 + l * 4 + 1], o, lsum);
                    const float lam = MISCT[512 + l], lam_init = MISCT[514 + l];
                    const float i1 = frcp(lsum[0]), i2 = lam * frcp(lsum[1]); float ss = 0.f;
#pragma unroll
                    for (int dt = 0; dt < 2; ++dt)
#pragma unroll
                        for (int q = 0; q < 16; ++q) { const float v = o[0][dt][q] * i1 - o[1][dt][q] * i2; o[0][dt][q] = v; ss += v * v; }
                    ss += __shfl_xor(ss, 32); const float rs = frsq(ss * (1.f / 64.f) + EPS) * (1.f - lam_init);
                    const float* gs = INF(39) + l * 64;
#pragma unroll
                    for (int dt = 0; dt < 2; ++dt)
#pragma unroll
                        for (int q = 0; q < 16; ++q) o[0][dt][q] *= gs[32 * dt + crow(q, hi)];
                    const int row = b * SEQ + qt * 256 + wid * 32 + r32;
                    attn_store(YB + (size_t)3 * MTOK * 256 + (size_t)row * 256 + hd * 64, o[0], rs, hi);
                }
            } }
            if (SUB(8)) { PHASE_BEGIN();
            const int lane = F.lane, r32 = lane & 31, hi = lane >> 5, wid = F.wave;
            volatile LAS unsigned* qslot = (volatile LAS unsigned*)(F.lds + MISC_OFF + 64);
            for (int it = queue_pull(F.ctl + CW_Q + 64 * (4 * l + 2), qslot, F.tid); it < 256; it = queue_pull(F.ctl + CW_Q + 64 * (4 * l + 2), qslot, F.tid)) {
                {
                    const int b = it >> 6, ch = it & 63, row0 = b * SEQ + ch * 64;
                    LAS unsigned char* hbuf = F.lds + wid * 8704;
                    LAS unsigned char* ypre = F.lds + 69632;
                    const float* S5S = (const float*)(ws + WS_S5S);
#pragma unroll 1
                    for (int gg = 0; gg < 2; ++gg) {
                        const int g = 2 * wid + gg;
                        const float* tb = S5T + (size_t)(l * 16 + g) * 36 * 64 + lane;
                        const float ar = tb[32 * 64], ai = tb[33 * 64], a64r = tb[34 * 64], a64i = tb[35 * 64];
                        float hr = 0.f, hi2 = 0.f;
                        for (int c0 = 0; c0 < ch; c0 += 8) {
                            float sr[8], si[8];
#pragma unroll
                            for (int u = 0; u < 8; ++u) { const int c = c0 + u; const bool ok = c < ch; const float* sp = S5S + ((size_t)((b * 64 + (ok ? c : 0)) * 16 + g) * 2) * 64 + lane; sr[u] = ok ? sp[0] : 0.f; si[u] = ok ? sp[64] : 0.f; }
#pragma unroll
                            for (int u = 0; u < 8; ++u) { if (c0 + u < ch) { const float nr = a64r * hr - a64i * hi2 + sr[u], ni = a64r * hi2 + a64i * hr + si[u]; hr = nr; hi2 = ni; } }
                        }
                        bf16x8 cf[4];
#pragma unroll
                        for (int ks = 0; ks < 4; ++ks) cf[ks] = ldg8(CMAT + (size_t)(l * 16 + g) * 16 * 128 + (lane & 15) * 128 + 32 * ks + 8 * (lane >> 4));
                        const float* dsk = INF(17) + l * 256 + 16 * g + 4 * (lane >> 4);
#pragma unroll 1
                        for (int hf = 0; hf < 2; ++hf) {
                            s5_bu_tile(hbuf, BBF + (size_t)(l * 16 + g) * 128 * 16, ZS + (size_t)(row0 + hf * 32) * ZSW + C_S5 + 16 * g, lane);
#pragma unroll 8
                            for (int t2 = 0; t2 < 32; ++t2) { const float bur = bf2f(*(const LAS bf16_t*)(hbuf + t2 * 272 + lane * 2)), bui = bf2f(*(const LAS bf16_t*)(hbuf + t2 * 272 + 128 + lane * 2));
                                const float nr = ar * hr - ai * hi2 + bur, ni = ar * hi2 + ai * hr + bui; hr = nr; hi2 = ni;
                                *(LAS bf16_t*)(hbuf + t2 * 272 + lane * 2) = f2bf(hr); *(LAS bf16_t*)(hbuf + t2 * 272 + 128 + lane * 2) = f2bf(hi2);
                            }
                            asm volatile("s_waitcnt lgkmcnt(0)" ::: "memory");
#pragma unroll
                            for (int tq = 0; tq < 2; ++tq) {
                                f32x4 yv = (f32x4){0.f, 0.f, 0.f, 0.f};
#pragma unroll
                                for (int ks = 0; ks < 4; ++ks) { const bf16x8 hb = *(const LAS bf16x8*)(hbuf + (16 * tq + (lane & 15)) * 272 + (32 * ks + 8 * (lane >> 4)) * 2); yv = MFMA16(cf[ks], hb, yv); }
                                const int tl = hf * 32 + 16 * tq + (lane & 15);
                                const u32x2 uw = *(const u32x2*)(ZS + (size_t)(row0 + tl) * ZSW + C_S5 + 16 * g + 4 * (lane >> 4));
                                yv[0] = fgelu(yv[0] + dsk[0] * bflo(uw.x)); yv[1] = fgelu(yv[1] + dsk[1] * bfhi(uw.x)); yv[2] = fgelu(yv[2] + dsk[2] * bflo(uw.y)); yv[3] = fgelu(yv[3] + dsk[3] * bfhi(uw.y));
                                u32x2 pw; pw.x = cvt_pk_bf16(yv[0], yv[1]); pw.y = cvt_pk_bf16(yv[2], yv[3]);
                                *(LAS u32x2*)(ypre + tl * 528 + (16 * g + 4 * (lane >> 4)) * 2) = pw;
                            }
                            asm volatile("s_waitcnt lgkmcnt(0)" ::: "memory");
                        }
                    }
                    __syncthreads();
                    {
                        const bf16_t* WG = (const bf16_t*)(WLP(l) + WL_SM + SM_WGLU);
                        f32x16 acc[2] = {f32x16{}, f32x16{}};
#pragma unroll 4
                        for (int ks = 0; ks < 16; ++ks) { const bf16x8 a = ldg8(WG + (size_t)(32 * wid + r32) * 256 + 16 * ks + 8 * hi);
#pragma unroll
                            for (int tt = 0; tt < 2; ++tt) acc[tt] = MFMA32(a, *(const LAS bf16x8*)(ypre + (32 * tt + r32) * 528 + (16 * ks + 8 * hi) * 2), acc[tt]); }
                        const float* bg = INF(19) + l * 256;
#pragma unroll
                        for (int tt = 0; tt < 2; ++tt)
#pragma unroll
                            for (int rg = 0; rg < 4; ++rg) { const int n0 = 32 * wid + 8 * rg + 4 * hi, t = 32 * tt + r32;
                                const u32x2 yw = *(const LAS u32x2*)(ypre + t * 528 + n0 * 2); u32x2 ow;
                                ow.x = cvt_pk_bf16(bflo(yw.x) * fsigmoid(acc[tt][4 * rg] + bg[n0]), bfhi(yw.x) * fsigmoid(acc[tt][4 * rg + 1] + bg[n0 + 1]));
                                ow.y = cvt_pk_bf16(bflo(yw.y) * fsigmoid(acc[tt][4 * rg + 2] + bg[n0 + 2]), bfhi(yw.y) * fsigmoid(acc[tt][4 * rg + 3] + bg[n0 + 3]));
                                *(u32x2*)(YB + (size_t)(row0 + t) * 256 + n0) = ow; }
                    }
                    __syncthreads();
                }
            }
            }
            if (SUB(9)) { PHASE_BEGIN(); const int lane = F.lane;
                const float* LA = (const float*)(ws + WS_LA); const float* LI = (const float*)(ws + WS_LI); const float* LSA = (const float*)(ws + WS_LSUM); const float* LSH = LSA + NB * 128 * 256;
                volatile LAS unsigned* qslot = (volatile LAS unsigned*)(F.lds + MISC_OFF + 64);
                for (int it = queue_pull(F.ctl + CW_Q + 64 * (4 * l + 3), qslot, F.tid); it < NB * 64 * 4 / 8; it = queue_pull(F.ctl + CW_Q + 64 * (4 * l + 3), qslot, F.tid)) {
                    const int tk = (NB * 64 * 4 / 8 - 1 - it) * 8 + F.wave;
                    const int n = tk & 3, ch = (tk >> 2) & 63, b = tk >> 8, c = 64 * n + lane;
                    float h = 0.f;
                    for (int tp0 = 0; tp0 < 2 * ch; tp0 += 16) {
                        float ca[16], chh[16];
#pragma unroll
                        for (int u = 0; u < 16; ++u) { const int tp = tp0 + u; const bool ok = tp < 2 * ch; const size_t o = (size_t)(b * 128 + (ok ? tp : 0)) * 256 + c; ca[u] = ok ? LSA[o] : 1.f; chh[u] = ok ? LSH[o] : 0.f; }
#pragma unroll
                        for (int u = 0; u < 16; ++u) h = ca[u] * h + chh[u];
                    }
                    const int row0 = b * SEQ + ch * 64;
#pragma unroll 1
                    for (int t0 = 0; t0 < 64; t0 += 16) {
                        float la[16], li[16], gt[16];
#pragma unroll
                        for (int u = 0; u < 16; ++u) { const size_t o = (size_t)(row0 + t0 + u) * 256 + c; la[u] = LA[o]; li[u] = LI[o]; gt[u] = bf2f(ZS[(size_t)(row0 + t0 + u) * ZSW + C_GLRU + c]); }
#pragma unroll
                        for (int u = 0; u < 16; ++u) { h = la[u] * h + li[u]; gt[u] = h * fgelu(gt[u]); }
#pragma unroll
                        for (int u = 0; u < 16; ++u) YB[(size_t)2 * MTOK * 256 + (size_t)(row0 + t0 + u) * 256 + c] = f2bf(gt[u]);
                    }
                }
            }
        }
        SEAM(pb + 2);
        if (IN(pb + 3)) { PHASE_BEGIN();
            pg8::Gemm g{YB, (const bf16_t*)(WLP(l) + WL_PT), 256, nullptr}; pg8::MergeOrder S{F.G, F.bid};
            pg8::EpiMerge E{MG, ZG};
            pg8::gemm_phase<pg8::EpiMerge, pg8::MergeOrder, true, false>(F.lds, g, S, E);
        }
        SEAM(pb + 3);
        if (IN(pb + 4)) { PHASE_BEGIN();
            pg8::Gemm g{MG, (const bf16_t*)(WLP(l) + WL_WO), DM, nullptr}; pg8::StaticOrder S; S.init(MTOK / 256, DM / 256, F.G, F.bid);
            pg8::EpiRes<false> E{nullptr, XB, RS + (size_t)(l == 0 ? 1 : 4) * MTOK * 16, nullptr};
            pg8::gemm_phase<pg8::EpiRes<false>, pg8::StaticOrder, false, false>(F.lds, g, S, E);
        }
        SEAM(pb + 4);
        if (IN(pb + 5)) { PHASE_BEGIN();
            pg8::Gemm g{XB, (const bf16_t*)(WLP(l) + WL_WXQ), DM, nullptr}; pg8::StaticOrder S; S.init(MTOK / 256, 1, F.G, F.bid);
            pg8::EpiRowScale E{(bf16_t*)(ws + WS_QX), 256, RS + (size_t)(l == 0 ? 1 : 4) * MTOK * 16};
            pg8::gemm_phase<pg8::EpiRowScale, pg8::StaticOrder, false, false>(F.lds, g, S, E);
        }
        SEAM(pb + 5);
        if (IN(pb + 6)) { PHASE_BEGIN();
            const int lane = F.lane, r32 = lane & 31, hi = lane >> 5, wid = F.wave;
            for (int it = F.bid; it < 256; it += F.G) {
                const int hd = it & 3, rt = it >> 2, b = rt >> 4;
                const bf16_t* QX = (const bf16_t*)(ws + WS_QX) + (size_t)rt * 256 * 256 + hd * 64;
                const bf16_t* KX = (const bf16_t*)(ws + WS_KX) + (size_t)(l * 16 + b * 4 + hd) * 256 * 64;
                const bf16_t* VXT = (const bf16_t*)(ws + WS_VXT) + (size_t)(l * 16 + b * 4 + hd) * 64 * 256;
                f32x16 o[1][2]; float lsum[1];
                attn_unit<64, 1, false, false, true>(F.lds, QX, 256, KX, VXT, 256, 4, 0, nullptr, INF(46) + l * 64, 0.125f * LOG2E, MISCT[516 + l * 4 + 2], o, lsum);
                const int row = rt * 256 + wid * 32 + r32;
                attn_store((bf16_t*)(ws + WS_OX) + (size_t)row * 256 + hd * 64, o[0], frcp(lsum[0]), hi);
            }
        }
        SEAM(pb + 6);
        if (IN(pb + 7)) { PHASE_BEGIN();
            pg8::Gemm g{(const bf16_t*)(ws + WS_OX), (const bf16_t*)(WLP(l) + WL_WXO), 256, nullptr}; pg8::StaticOrder S; S.init(MTOK / 256, DM / 256, F.G, F.bid);
            if (l == 0) { pg8::EpiRes<false> E{nullptr, XB, RS + (size_t)2 * MTOK * 16, nullptr}; pg8::gemm_phase<pg8::EpiRes<false>, pg8::StaticOrder, false, false>(F.lds, g, S, E); }
            else { pg8::EpiRes<false> E{nullptr, XB, RS + (size_t)5 * MTOK * 16, nullptr}; pg8::gemm_phase<pg8::EpiRes<false>, pg8::StaticOrder, false, false>(F.lds, g, S, E); }
        }
        SEAM(pb + 7);
        if (l == 0) {
            if (IN(9)) { PHASE_BEGIN();
                pg8::Gemm g{XB, (const bf16_t*)(ws + WS_WGU), DM, nullptr}; pg8::StaticOrder S; S.init(MTOK / 256, 2 * FF / 256, F.G, F.bid);
#if G2_FP8
                pg8::EpiSwiGLU8<true, false> E{ws + WS_HFF, FF, RS + (size_t)2 * MTOK * 16};
                pg8::gemm_phase<pg8::EpiSwiGLU8<true, false>, pg8::StaticOrder, true, false>(F.lds, g, S, E);
#else
                pg8::EpiSwiGLU<false> E{(bf16_t*)(ws + WS_HFF), FF, RS + (size_t)2 * MTOK * 16, nullptr};
                pg8::gemm_phase<pg8::EpiSwiGLU<false>, pg8::StaticOrder, true, false>(F.lds, g, S, E);
#endif
            }
            SEAM(9);
            if (IN(10)) { PHASE_BEGIN();
#if G2_FP8
                pg8::Gemm g{(const bf16_t*)(ws + WS_HFF), (const bf16_t*)(ws + WS_WD), FF / 2, nullptr}; pg8::StaticOrder S; S.init(MTOK / 256, DM / 256, F.G, F.bid);
                pg8::EpiRes<false, false, true> E{nullptr, XB, RS + (size_t)3 * MTOK * 16, nullptr};
                pg8::gemm_phase<pg8::EpiRes<false, false, true>, pg8::StaticOrder, false, false, true>(F.lds, g, S, E);
#else
                pg8::Gemm g{(const bf16_t*)(ws + WS_HFF), (const bf16_t*)(ws + WS_WD), FF, nullptr}; pg8::StaticOrder S; S.init(MTOK / 256, DM / 256, F.G, F.bid);
                pg8::EpiRes<false> E{nullptr, XB, RS + (size_t)3 * MTOK * 16, nullptr};
                pg8::gemm_phase<pg8::EpiRes<false>, pg8::StaticOrder, false, false>(F.lds, g, S, E);
#endif
            }
            SEAM(10);
        } else {
#define ROWTOK ((int*)(ws + WS_MOESM + MS_ROWTOK))
#define TOKW ((float*)(ws + WS_MOESM + MS_TOKW))
#define ASSIGN ((int*)(ws + WS_MOESM + MS_ASSIGN))
#define RSTD2 ((float*)(ws + WS_MOESM + MS_RSTD))
#define MCNT (F.ctl + CW_MOECNT)
            if (IN(19)) { PHASE_BEGIN();
                LAS float* wrs = (LAS float*)(F.lds);
                for (int i = F.tid; i < 8192; i += 512) wrs[i] = INF(51)[i] * INF(7)[DM + (i >> 3)];
                __syncthreads();
                if (SUB(10) && F.wave < 4) {
                    const int lane = F.lane;
                    for (int blk = F.bid; blk < 256; blk += F.G) {
                        unsigned cntv = 0u, mypack = 0u;
#pragma unroll 1
                        for (int j = 0; j < 16; ++j) {
                            const int tok = blk * 64 + F.wave * 16 + j;
                            const u32x2* xr = (const u32x2*)(XB + (size_t)tok * DM) + lane;
                            float lg[8] = {0.f, 0.f, 0.f, 0.f, 0.f, 0.f, 0.f, 0.f}; float ss = 0.f; f32x4 xv4[4];
#pragma unroll
                            for (int q = 0; q < 4; ++q) { const u32x2 xw = xr[64 * q]; const f32x4 v = {bflo(xw.x), bfhi(xw.x), bflo(xw.y), bfhi(xw.y)}; const int k0 = 256 * q + 4 * lane; xv4[q] = v;
                                ss += (v.x * v.x + v.y * v.y) + (v.z * v.z + v.w * v.w);
#pragma unroll
                                for (int e4 = 0; e4 < 4; ++e4) { const float xv = v[e4]; const LAS f32x4* wp = (const LAS f32x4*)(wrs + (k0 + e4) * 8); const f32x4 wa = wp[0], wb = wp[1];
                                    lg[0] += xv * wa.x; lg[1] += xv * wa.y; lg[2] += xv * wa.z; lg[3] += xv * wa.w; lg[4] += xv * wb.x; lg[5] += xv * wb.y; lg[6] += xv * wb.z; lg[7] += xv * wb.w; } }
                            ss = wave_sum(ss);
#pragma unroll
                            for (int e = 0; e < 8; ++e) lg[e] = wave_sum(lg[e]);
                            const float rstd = frsq(ss * (1.f / DM) + EPS);
                            { unsigned* xq = (unsigned*)(ws + WS_XQ + (size_t)tok * DM) + lane;
#pragma unroll
                              for (int q = 0; q < 4; ++q) xq[64 * q] = cvt_pk4_fp8(xv4[q].x * rstd, xv4[q].y * rstd, xv4[q].z * rstd, xv4[q].w * rstd); }
                            int e1 = 0; float v1 = lg[0];
#pragma unroll
                            for (int e = 1; e < 8; ++e) if (lg[e] > v1) { v1 = lg[e]; e1 = e; }
                            int e2 = -1; float v2 = -3.4e38f;
#pragma unroll
                            for (int e = 0; e < 8; ++e) if (e != e1 && lg[e] > v2) { v2 = lg[e]; e2 = e; }
                            if (e2 < 0) e2 = (e1 + 1) & 7;
                            const int se1 = __builtin_amdgcn_readfirstlane(e1), se2 = __builtin_amdgcn_readfirstlane(e2);
                            const unsigned r1 = __builtin_amdgcn_readlane(cntv, se1), r2 = __builtin_amdgcn_readlane(cntv, se2);
                            cntv += (lane == se1 ? 1u : 0u) + (lane == se2 ? 1u : 0u);
                            if (lane == j) mypack = (unsigned)se1 | (r1 << 4) | ((unsigned)se2 << 12) | (r2 << 16);
                            if (lane == 0) { const float w1 = frcp(1.f + __expf((v2 - v1) * rstd)); RSTD2[tok] = rstd; TOKW[tok * 2] = w1; TOKW[tok * 2 + 1] = 1.f - w1; }
                        }
                        unsigned basev = 0u;
                        if (lane < 8) basev = __hip_atomic_fetch_add(MCNT + 64 * lane, cntv, __ATOMIC_RELAXED, __HIP_MEMORY_SCOPE_AGENT);
                        const int pe1 = mypack & 15, pr1 = (mypack >> 4) & 255, pe2 = (mypack >> 12) & 15, pr2 = (mypack >> 16) & 255;
                        const unsigned b1 = __shfl(basev, pe1), b2 = __shfl(basev, pe2);
                        if (lane < 16) { const int tok = blk * 64 + F.wave * 16 + lane; ASSIGN[tok * 2] = pe1 | (int)((b1 + (unsigned)pr1) << 8); ASSIGN[tok * 2 + 1] = pe2 | (int)((b2 + (unsigned)pr2) << 8);
                            ROWTOK[pe1 * 16384 + (int)(b1 + (unsigned)pr1)] = tok; ROWTOK[pe2 * 16384 + (int)(b2 + (unsigned)pr2)] = tok; }
                    }
                }
                if (SUB(11)) {
                    LAS float* scr = (LAS float*)(F.lds + 40960 + F.wave * 8448);
                    const TJob j0{INF(52), (bf16_t*)(ws + WS_WMGU), INF(7) + DM, DM, EFF, EFF, DM, 8, 2, (size_t)DM * EFF, (size_t)2 * EFF * DM, 1};
                    const TJob j1{INF(53), (bf16_t*)(ws + WS_WMGU), INF(7) + DM, DM, EFF, EFF, DM, 8, 3, (size_t)DM * EFF, (size_t)2 * EFF * DM, 1};
                    const TJob j2{INF(54), (bf16_t*)(ws + WS_WMD), nullptr, EFF, DM, DM, EFF, 8, 0, (size_t)EFF * DM, (size_t)DM * EFF, 1};
                    constexpr int NI = 8 * (DM / 64) * (EFF / 32);
                    LAS unsigned* qc = (LAS unsigned*)(F.lds + MISC_OFF + 128);
                    const int wg_items = (3 * NI - F.bid + F.G - 1) / F.G;
#define H0_PULL() h0_pull(qc, F.lane, wg_items, F.bid, F.G, 3 * NI)
#define H0_JOB(idx) const int jn_ = (idx) / NI; TJob js_ = j0; if (jn_ == 1) { js_.W = j1.W; js_.map = 3; } if (jn_ == 2) js_ = j2;
#define H0_LOAD(idx, v) do { H0_JOB(idx) tjob_load(js_, (idx) - jn_ * NI, v, F.lane); } while (0)
#define H0_STORE(idx, v) do { H0_JOB(idx) tjob_store(js_, (idx) - jn_ * NI, v, scr, F.lane); } while (0)
                    float va[32] = {}, vb[32] = {}; int it = H0_PULL();
                    if (it < 3 * NI) { H0_LOAD(it, va);
                        for (;;) {
                            const int n1 = H0_PULL(); if (n1 < 3 * NI) H0_LOAD(n1, vb);
                            H0_STORE(it, va); if (n1 >= 3 * NI) break;
                            const int n2 = H0_PULL(); if (n2 < 3 * NI) H0_LOAD(n2, va);
                            H0_STORE(n1, vb); if (n2 >= 3 * NI) break;
                            it = n2;
                        } }
#undef H0_PULL
#undef H0_JOB
#undef H0_LOAD
#undef H0_STORE
                }
            }
            SEAM(19);
            if (IN(21)) { PHASE_BEGIN();
                pg8::Gemm g{(const bf16_t*)(ws + WS_XQ), (const bf16_t*)(ws + WS_WMGU), DM / 2, ROWTOK}; pg8::MoeOrder S; S.init(MCNT, 2 * EFF / 256, F.G, F.bid);
                pg8::EpiSwiGLU8<false> E{ws + WS_HMOE, EFF, nullptr};
                pg8::gemm_phase<pg8::EpiSwiGLU8<false>, pg8::MoeOrder, true, true, true>(F.lds, g, S, E);
            }
            SEAM(21);
            if (IN(22)) { PHASE_BEGIN();
                pg8::Gemm g{(const bf16_t*)(ws + WS_HMOE), (const bf16_t*)(ws + WS_WMD), EFF / 2, nullptr}; pg8::MoeOrder S; S.init(MCNT, DM / 256, F.G, F.bid);
                pg8::EpiPlain E{(bf16_t*)(ws + WS_YS), DM, 0.03125f};
                pg8::gemm_phase<pg8::EpiPlain, pg8::MoeOrder, true, false, true>(F.lds, g, S, E);
            }
            SEAM(22);
            if (IN(23)) { PHASE_BEGIN();
                const bf16_t* YS = (const bf16_t*)(ws + WS_YS);
                int pst[8]; { int acc = 0;
#pragma unroll
                    for (int e = 0; e < 8; ++e) { pst[e] = acc; acc += ((int)MCNT[64 * e] + 255) & ~255; } }
                for (int m = F.gw; m < MTOK; m += F.ngw) {
                    const int a1 = ASSIGN[2 * m], a2 = ASSIGN[2 * m + 1]; int p1 = 0, p2 = 0;
#pragma unroll
                    for (int q = 0; q < 8; ++q) { p1 = (q == (a1 & 255)) ? pst[q] : p1; p2 = (q == (a2 & 255)) ? pst[q] : p2; }
                    const int d1 = p1 + (a1 >> 8), d2 = p2 + (a2 >> 8); const float w1 = TOKW[2 * m], w2 = TOKW[2 * m + 1];
                    f32x4* xr = (f32x4*)(F.out + (size_t)m * DM) + F.lane; const u32x2* xbr = (const u32x2*)(XB + (size_t)m * DM) + F.lane;
                    const u32x2* y1 = (const u32x2*)(YS + (size_t)d1 * DM) + F.lane; const u32x2* y2 = (const u32x2*)(YS + (size_t)d2 * DM) + F.lane;
#pragma unroll
                    for (int j = 0; j < 4; ++j) { const u32x2 xw = xbr[64 * j]; f32x4 v = {bflo(xw.x), bfhi(xw.x), bflo(xw.y), bfhi(xw.y)}; const u32x2 a = __builtin_nontemporal_load(y1 + 64 * j), c = __builtin_nontemporal_load(y2 + 64 * j);
                        v.x += w1 * bflo(a.x) + w2 * bflo(c.x); v.y += w1 * bfhi(a.x) + w2 * bfhi(c.x); v.z += w1 * bflo(a.y) + w2 * bflo(c.y); v.w += w1 * bfhi(a.y) + w2 * bfhi(c.y);
                        __builtin_nontemporal_store(v, xr + 64 * j); }
                }
            }
        }
    }
#undef IN
#undef SEAM
}

#ifdef DBG_DUMP_OFF
__global__ void dbg_copy_bf16(const bf16_t* src, float* out, int n, int nv) { for (int i = blockIdx.x * 256 + threadIdx.x; i < n; i += gridDim.x * 256) out[i] = i < nv ? bf2f(src[i]) : 0.f; }
#endif

#ifdef DBG_CHECK
struct DbgArgs { const void* in[55]; unsigned char* ws; float* out; float* acc; };
#ifndef DBG_LAYER
#define DBG_LAYER 0
#endif
__device__ __forceinline__ size_t dstride(int i) {
    switch (i) { case 4: case 5: case 6: case 7: case 10: case 11: case 26: return 1024; case 8: return (size_t)DM * DIN; case 9: return 4096; case 12: return 16;
      case 13: case 14: case 15: case 16: case 28: case 30: return 16384; case 17: case 19: case 27: case 29: case 31: case 32: return 256; case 18: case 23: return 65536; case 20: return 192; case 21: return 128;
      case 22: return 73728; case 24: case 25: return 96; case 33: case 34: case 35: case 36: case 37: case 38: return 32; case 39: case 46: case 47: return 64; case 40: return (size_t)4 * 256 * DM; case 41: return (size_t)DM * DM;
      case 42: case 43: case 44: case 45: return (size_t)DM * 256; default: return 0; } }
#define DIN_(i) ((const float*)a.in[i] + (size_t)DBG_LAYER * dstride(i))
#define DXIN_ (DBG_LAYER == 0 ? (const float*)a.in[0] : (const float*)(a.ws + WS_DBG))
constexpr size_t WS_DBG = 440 * MiB;
__device__ float blk_sum(float v, float* sh) { sh[threadIdx.x] = v; __syncthreads(); for (int o = 128; o > 0; o >>= 1) { if ((int)threadIdx.x < o) sh[threadIdx.x] += sh[threadIdx.x + o]; __syncthreads(); } const float r = sh[0]; __syncthreads(); return r; }
__device__ float blk_max(float v, float* sh) { sh[threadIdx.x] = v; __syncthreads(); for (int o = 128; o > 0; o >>= 1) { if ((int)threadIdx.x < o) sh[threadIdx.x] = fmaxf(sh[threadIdx.x], sh[threadIdx.x + o]); __syncthreads(); } const float r = sh[0]; __syncthreads(); return r; }
__device__ void dbg_acc(float* acc, int k, float fast, float ref) { atomicMax((unsigned*)&acc[2 * k], __float_as_uint(fabsf(fast - ref))); atomicAdd(&acc[2 * k + 1], ref * ref); atomicAdd(&acc[64 + k], 1.f); }
__device__ float dsig(float x) { return 1.f / (1.f + expf(-x)); }
__device__ float dgelu(float x) { return 0.5f * x * (1.f + tanhf(0.7978845608028654f * (x + 0.044715f * x * x * x))); }
__device__ int dbucket(int d) { if (d < 16) return d < 0 ? 0 : d; int bk = 16 + (int)(logf((float)d / 16.f) / logf(8.f) * 16.f); return bk > 31 ? 31 : bk; }

__global__ void chk_z(DbgArgs a) {
    __shared__ float sh[256]; const int s = blockIdx.x, tid = threadIdx.x; const int row = (s * 7919 + 13) % MTOK; int col = (s * 104729 + 7 + (s >> 1)) % DIN; if (s & 1) col = col % C_END;
    const float* x = (DBG_LAYER == 0 ? (const float*)a.in[0] : (const float*)a.out) + (size_t)row * DM; const float* g = DIN_(4); const float* W = DIN_(8);
    float ss = 0.f, dot = 0.f; for (int k = tid; k < DM; k += 256) { const float xv = x[k]; ss += xv * xv; dot += xv * g[k] * W[(size_t)k * DIN + col]; }
    ss = blk_sum(ss, sh); dot = blk_sum(dot, sh);
    if (tid == 0) { const float z = dot * rsqrtf(ss / DM + EPS);
        if (col < C_END) dbg_acc(a.acc, 1, bf2f(((const bf16_t*)(a.ws + WS_ZS))[(size_t)row * ZSW + col]), z);
        else { const int gc = col - C_END; dbg_acc(a.acc, 2, bf2f(((const bf16_t*)(a.ws + WS_ZG))[(size_t)row * ZGW + gc]), dsig(z + DIN_(9)[gc])); } }
}
__global__ void chk_mla_prep(DbgArgs a) {
    __shared__ float sh[256]; __shared__ float vn[192]; __shared__ float qs[128];
    const int s = blockIdx.x, tid = threadIdx.x, row = (s * 7919 + 13) % MTOK, hd = s & 3, b = row >> 12, sq = row & 4095;
    const bf16_t* ZSp = (const bf16_t*)(a.ws + WS_ZS) + (size_t)row * ZSW; const float pos = (float)((const int*)a.in[2])[row];
    { const float v = tid < 192 ? bf2f(ZSp[C_CQ + tid]) : 0.f; const float ss = blk_sum(v * v, sh); if (tid < 192) vn[tid] = v * rsqrtf(ss / 192.f + EPS) * DIN_(20)[tid]; __syncthreads(); }
    float qf = 0.f; if (tid < 96) for (int k = 0; k < 192; ++k) qf += vn[k] * DIN_(22)[k * 384 + hd * 96 + tid];
    { const float ss = blk_sum(tid < 96 ? qf * qf : 0.f, sh); if (tid < 96) qs[tid] = qf * rsqrtf(ss / 96.f + EPS) * DIN_(24)[tid]; __syncthreads(); }
    if (tid < 96) { float val = qs[tid]; if (tid >= 64) { const int i = (tid - 64) & 15; float sn, cs; sincos_red(pos * exp2f(-(float)i * (13.287712379549449f / 16.f)), sn, cs); const float x1 = qs[64 + i], x2 = qs[80 + i]; val = tid < 80 ? x1 * cs - x2 * sn : x1 * sn + x2 * cs; }
        val *= 0.10206207261596577f * LOG2E; dbg_acc(a.acc, 3, bf2f(((const bf16_t*)(a.ws + WS_QM))[((size_t)(b * 4 + hd) * SEQ + sq) * 96 + tid]), val); }
    __syncthreads();
    { const float v = tid < 128 ? bf2f(ZSp[C_CKV + tid]) : 0.f; const float ss = blk_sum(v * v, sh); if (tid < 128) vn[tid] = v * rsqrtf(ss / 128.f + EPS) * DIN_(21)[tid]; __syncthreads(); }
    float kv = 0.f; if (tid < 128) for (int k = 0; k < 128; ++k) kv += vn[k] * DIN_(23)[k * 512 + hd * 128 + tid];
    float kfull = 0.f; if (tid < 64) kfull = kv; else if (tid < 96) kfull = bf2f(ZSp[C_KPE + tid - 64]);
    { const float ss = blk_sum(tid < 96 ? kfull * kfull : 0.f, sh); if (tid < 96) qs[tid] = kfull * rsqrtf(ss / 96.f + EPS) * DIN_(25)[tid]; __syncthreads(); }
    if (tid < 96) { float val = qs[tid]; if (tid >= 64) { const int i = (tid - 64) & 15; float sn, cs; sincos_red(pos * exp2f(-(float)i * (13.287712379549449f / 16.f)), sn, cs); const float x1 = qs[64 + i], x2 = qs[80 + i]; val = tid < 80 ? x1 * cs - x2 * sn : x1 * sn + x2 * cs; }
        dbg_acc(a.acc, 4, bf2f(((const bf16_t*)(a.ws + WS_KM))[((size_t)(b * 4 + hd) * SEQ + sq) * 96 + tid]), val); }
    if (tid >= 64 && tid < 128) dbg_acc(a.acc, 5, bf2f(((const bf16_t*)(a.ws + WS_VMT))[((size_t)(b * 4 + hd) * 64 + tid - 64) * SEQ + sq]), kv);
}
__global__ void chk_diff_prep(DbgArgs a) {
    const int i = blockIdx.x * 256 + threadIdx.x; const int row = (i * 37 + 5) % MTOK, hd = i & 3, half = (i >> 2) & 1, isk = (i >> 3) & 1, b = row >> 12, sq = row & 4095;
    const bf16_t* src = (const bf16_t*)(a.ws + WS_ZS) + (size_t)row * ZSW + (isk ? C_KD : C_QD) + hd * 64 + half * 32;
    float ss = 0.f; for (int d = 0; d < 32; ++d) { const float v = bf2f(src[d]); ss += v * v; }
    const float rs = rsqrtf(ss / 32.f + EPS) * (isk ? 1.f : 0.17677669529663687f * LOG2E); const float* gg = DIN_(isk ? 34 : 33);
    const bf16_t* dst = (const bf16_t*)(a.ws + (isk ? WS_KD : WS_QD)) + ((size_t)(b * 4 + hd) * SEQ + sq) * 64 + half * 32;
    for (int d = 0; d < 32; ++d) dbg_acc(a.acc, 6, bf2f(dst[d]), bf2f(src[d]) * rs * gg[d]);
    const bf16_t* vs = (const bf16_t*)(a.ws + WS_ZS) + (size_t)row * ZSW + C_VD + hd * 64;
    for (int d = half * 32; d < half * 32 + 32; ++d) dbg_acc(a.acc, 7, bf2f(((const bf16_t*)(a.ws + WS_VDT))[((size_t)(b * 4 + hd) * 64 + d) * SEQ + sq]), bf2f(vs[d]));
}
__global__ void __launch_bounds__(256) chk_lru_prep(DbgArgs a) {
    __shared__ float xcs[64]; const int s = blockIdx.x, tid = threadIdx.x, row = (s * 7919 + 13) % MTOK, n = s & 3, b = row >> 12, sq = row & 4095;
    if (s == 0 || s == 1) { }
    float xc = 0.f;
    if (tid < 64) { const int c = 64 * n + tid; xc = DIN_(27)[c]; for (int k = 0; k < 4; ++k) { const int sr = sq - 3 + k; if (sr >= 0) xc += DIN_(26)[k * 256 + c] * bf2f(((const bf16_t*)(a.ws + WS_ZS))[(size_t)(b * SEQ + sr) * ZSW + C_XLRU + c]); } xcs[tid] = xc; }
    __syncthreads();
    if (tid < 64) { const int c = 64 * n + tid; float ar = DIN_(29)[c], ai = DIN_(31)[c];
        const float* wr_ = DIN_(28); const float* wi_ = DIN_(30);
#pragma unroll 2
        for (int cc = 0; cc < 64; ++cc) { ar += xcs[cc] * wr_[(n * 64 + cc) * 64 + tid]; ai += xcs[cc] * wi_[(n * 64 + cc) * 64 + tid]; }
        const float r = 1.f / (1.f + __expf(-ar)), ii = 1.f / (1.f + __expf(-ai)), la = -8.f * r * __logf(1.f + __expf(-DIN_(32)[c])), av = __expf(la), iv = sqrtf(fmaxf(1.f - av * av, 0.f)) * ii * xc;
        dbg_acc(a.acc, 8, ((const float*)(a.ws + WS_LA))[(size_t)row * 256 + c], av); dbg_acc(a.acc, 9, ((const float*)(a.ws + WS_LI))[(size_t)row * 256 + c], iv); }
}
__global__ void chk_mla_attn(DbgArgs a) {
    __shared__ float sh[256]; __shared__ float q[96]; __shared__ float p[4096];
    const int s = blockIdx.x, tid = threadIdx.x, bh = s & 15, sq = (s * 523 + 77) % SEQ, b = bh >> 2, hd = bh & 3;
    const bf16_t* QM = (const bf16_t*)(a.ws + WS_QM) + (size_t)bh * SEQ * 96; const bf16_t* KM = (const bf16_t*)(a.ws + WS_KM) + (size_t)bh * SEQ * 96; const bf16_t* VMT = (const bf16_t*)(a.ws + WS_VMT) + (size_t)bh * 64 * SEQ;
    if (tid < 96) q[tid] = bf2f(QM[(size_t)sq * 96 + tid]); __syncthreads();
    float mx = -1e30f; for (int j = tid; j <= sq; j += 256) { float sc = 0.f; for (int d = 0; d < 96; ++d) sc += q[d] * bf2f(KM[(size_t)j * 96 + d]); p[j] = sc; mx = fmaxf(mx, sc); }
    mx = blk_max(mx, sh); float sm = 0.f; for (int j = tid; j <= sq; j += 256) { p[j] = exp2f(p[j] - mx); sm += p[j]; } sm = blk_sum(sm, sh);
    if (tid < 64) { float o = 0.f; for (int j = 0; j <= sq; ++j) o += p[j] * bf2f(VMT[(size_t)tid * SEQ + j]); dbg_acc(a.acc, 10, bf2f(((const bf16_t*)(a.ws + WS_Y))[(size_t)1 * MTOK * 256 + (size_t)(b * SEQ + sq) * 256 + hd * 64 + tid]), o / sm); }
}
__global__ void chk_diff_attn(DbgArgs a) {
    __shared__ float sh[256]; __shared__ float q[64]; __shared__ float p1[4096]; __shared__ float p2[4096];
    const int s = blockIdx.x, tid = threadIdx.x, bh = s & 15, sq = (s * 523 + 77) % SEQ, b = bh >> 2, hd = bh & 3;
    const bf16_t* QD = (const bf16_t*)(a.ws + WS_QD) + (size_t)bh * SEQ * 64; const bf16_t* KD = (const bf16_t*)(a.ws + WS_KD) + (size_t)bh * SEQ * 64; const bf16_t* VDT = (const bf16_t*)(a.ws + WS_VDT) + (size_t)bh * 64 * SEQ;
    if (tid < 64) q[tid] = bf2f(QD[(size_t)sq * 64 + tid]); __syncthreads();
    float m1 = -1e30f, m2 = -1e30f; for (int j = tid; j <= sq; j += 256) { float s1 = 0.f, s2 = 0.f; for (int d = 0; d < 32; ++d) { s1 += q[d] * bf2f(KD[(size_t)j * 64 + d]); s2 += q[32 + d] * bf2f(KD[(size_t)j * 64 + 32 + d]); }
        const float bias = DIN_(3)[dbucket(sq - j) * 4 + hd] * LOG2E; s1 += bias; s2 += bias; p1[j] = s1; p2[j] = s2; m1 = fmaxf(m1, s1); m2 = fmaxf(m2, s2); }
    m1 = blk_max(m1, sh); m2 = blk_max(m2, sh); float l1 = 0.f, l2 = 0.f; for (int j = tid; j <= sq; j += 256) { p1[j] = exp2f(p1[j] - m1); p2[j] = exp2f(p2[j] - m2); l1 += p1[j]; l2 += p2[j]; } l1 = blk_sum(l1, sh); l2 = blk_sum(l2, sh);
    float s1 = 0.f, s2 = 0.f; for (int d = 0; d < 32; ++d) { s1 += DIN_(35)[d] * DIN_(36)[d]; s2 += DIN_(37)[d] * DIN_(38)[d]; } const float lam_init = DBG_LAYER == 0 ? 0.2f : 0.8f - 0.6f * 0.7408182206817179f, lam = expf(s1) - expf(s2) + lam_init;
    float o = 0.f; if (tid < 64) { float o1 = 0.f, o2 = 0.f; for (int j = 0; j <= sq; ++j) { const float v = bf2f(VDT[(size_t)tid * SEQ + j]); o1 += p1[j] * v; o2 += p2[j] * v; } o = o1 / l1 - lam * o2 / l2; }
    const float ss = blk_sum(tid < 64 ? o * o : 0.f, sh);
    if (tid < 64) dbg_acc(a.acc, 11, bf2f(((const bf16_t*)(a.ws + WS_Y))[(size_t)3 * MTOK * 256 + (size_t)(b * SEQ + sq) * 256 + hd * 64 + tid]), o * rsqrtf(ss / 64.f + EPS) * DIN_(39)[tid] * (1.f - lam_init));
}
__global__ void chk_lru_scan(DbgArgs a) {
    const int i = blockIdx.x * 256 + threadIdx.x, b = i >> 8, c = i & 255; if (b >= NB) return;
    const float* LA = (const float*)(a.ws + WS_LA); const float* LI = (const float*)(a.ws + WS_LI); float h = 0.f;
    for (int t = 0; t < SEQ; ++t) { const size_t o = (size_t)(b * SEQ + t) * 256 + c; h = LA[o] * h + LI[o];
        if (t % 97 == 0 || t == SEQ - 1) dbg_acc(a.acc, 12, bf2f(((const bf16_t*)(a.ws + WS_Y))[(size_t)2 * MTOK * 256 + o]), h * dgelu(bf2f(((const bf16_t*)(a.ws + WS_ZS))[(size_t)(b * SEQ + t) * ZSW + C_GLRU + c]))); }
}
__global__ void chk_s5_scan(DbgArgs a) {
    __shared__ float part[16][65]; const int g = blockIdx.x, p = threadIdx.x; float* ypre = (float*)(a.ws + WS_DBG);
    const float dt = expf(DIN_(12)[g]), lr = DIN_(10)[g * 64 + p], li = DIN_(11)[g * 64 + p], mag = expf(lr * dt); float sn, cs; sincos_red(li * dt, sn, cs);
    const float ar = mag * cs, ai = mag * sn, den = lr * lr + li * li, zr = ((ar - 1.f) * lr + ai * li) / den, zi = (ai * lr - (ar - 1.f) * li) / den;
    float hr = 0.f, hi = 0.f;
    for (int t = 0; t < SEQ; ++t) { const bf16_t* up = (const bf16_t*)(a.ws + WS_ZS) + (size_t)(SEQ + t) * ZSW + 16 * g; float bur = 0.f, bui = 0.f;
        for (int c = 0; c < 16; ++c) { const float u = bf2f(up[c]), br = DIN_(13)[(g * 64 + p) * 16 + c], bi = DIN_(14)[(g * 64 + p) * 16 + c]; bur += (zr * br - zi * bi) * u; bui += (zr * bi + zi * br) * u; }
        const float nr = ar * hr - ai * hi + bur, ni = ar * hi + ai * hr + bui; hr = nr; hi = ni;
        for (int c = 0; c < 16; ++c) part[c][p] = DIN_(15)[(g * 16 + c) * 64 + p] * hr - DIN_(16)[(g * 16 + c) * 64 + p] * hi;
        __syncthreads();
        if (p < 16) { float y = 0.f; for (int pp = 0; pp < 64; ++pp) y += part[p][pp]; y += DIN_(17)[16 * g + p] * bf2f(up[p]); ypre[(size_t)t * 256 + 16 * g + p] = dgelu(y); }
        __syncthreads(); }
}
__global__ void chk_s5_glu(DbgArgs a) {
    const int s = blockIdx.x, n = threadIdx.x, t = (s * 61 + 5) % SEQ; const float* ypre = (const float*)(a.ws + WS_DBG) + (size_t)t * 256;
    float z = DIN_(19)[n]; for (int k = 0; k < 256; ++k) z += ypre[k] * DIN_(18)[k * 256 + n];
    dbg_acc(a.acc, 13, bf2f(((const bf16_t*)(a.ws + WS_Y))[(size_t)(SEQ + t) * 256 + n]), ypre[n] * dsig(z));
}

__global__ void chk_merge(DbgArgs a) {
    __shared__ float sh[256]; const int s = blockIdx.x, tid = threadIdx.x, row = (s * 7919 + 13) % MTOK, col = (s * 104729 + 7) % DM;
    const bf16_t* Y = (const bf16_t*)(a.ws + WS_Y); const bf16_t* ZGp = (const bf16_t*)(a.ws + WS_ZG) + (size_t)row * ZGW; const bf16_t* MGp = (const bf16_t*)(a.ws + WS_MERGED) + (size_t)row * DM;
    float m = 0.f;
    for (int n = 0; n < 4; ++n) { float d = 0.f; { const int k = tid; d = bf2f(Y[(size_t)n * MTOK * 256 + (size_t)row * 256 + k]) * DIN_(40)[((size_t)n * 256 + k) * DM + col]; } d = blk_sum(d, sh); m += bf2f(ZGp[n * DM + col]) * d; }
    if (tid == 0) dbg_acc(a.acc, 14, bf2f(MGp[col]), m);
    float o = 0.f; for (int c = tid; c < DM; c += 256) o += bf2f(MGp[c]) * DIN_(41)[(size_t)c * DM + col]; o = blk_sum(o, sh);
    if (tid == 0) dbg_acc(a.acc, 15, a.out[(size_t)row * DM + col], DXIN_[(size_t)row * DM + col] + o);
}
__global__ void chk_cross(DbgArgs a) {
    __shared__ float sh[256]; __shared__ float hn[DM]; __shared__ float q[64]; __shared__ float p[256]; __shared__ float mn[DM];
    const int s = blockIdx.x, tid = threadIdx.x, row = (s * 7919 + 13) % MTOK, hd = s & 3, b = row >> 12;
    const float* x1 = a.out + (size_t)row * DM; float ss = 0.f; for (int k = tid; k < DM; k += 256) ss += x1[k] * x1[k]; ss = blk_sum(ss, sh); const float rs = rsqrtf(ss / DM + EPS);
    for (int k = tid; k < DM; k += 256) hn[k] = x1[k] * rs * DIN_(5)[k]; __syncthreads();
    float qf = 0.f; if (tid < 64) { for (int k = 0; k < DM; ++k) qf += hn[k] * DIN_(42)[(size_t)k * 256 + hd * 64 + tid]; dbg_acc(a.acc, 16, bf2f(((const bf16_t*)(a.ws + WS_QX))[(size_t)row * 256 + hd * 64 + tid]), qf); }
    { const float s2 = blk_sum(tid < 64 ? qf * qf : 0.f, sh); if (tid < 64) q[tid] = qf * rsqrtf(s2 / 64.f + EPS) * DIN_(46)[tid] * 0.125f; __syncthreads(); }
    float sc = 0.f; float vj[1]; (void)vj;
    { const float* mr = DIN_(1) + (size_t)(b * 256 + tid) * DM; float ms = 0.f; for (int k = 0; k < DM; ++k) ms += mr[k] * mr[k]; const float mrs = rsqrtf(ms / DM + EPS);
      float kk[64]; (void)kk; float s2 = 0.f; float dotq = 0.f;
      for (int d = 0; d < 64; ++d) { float kd = 0.f; for (int k = 0; k < DM; ++k) kd += mr[k] * mrs * DIN_(6)[k] * DIN_(43)[(size_t)k * 256 + hd * 64 + d]; s2 += kd * kd; dotq += kd * DIN_(47)[d] * q[d]; }
      sc = dotq * rsqrtf(s2 / 64.f + EPS); }
    const float mx = blk_max(sc, sh); const float e = expf(sc - mx); const float sm = blk_sum(e, sh); p[tid] = e / sm; __syncthreads();
    if (tid < 64) { float o = 0.f; for (int j = 0; j < 256; ++j) { const float* mr = DIN_(1) + (size_t)(b * 256 + j) * DM; float ms = 0.f, vd = 0.f; for (int k = 0; k < DM; ++k) { ms += mr[k] * mr[k]; vd += mr[k] * DIN_(6)[k] * DIN_(44)[(size_t)k * 256 + hd * 64 + tid]; } o += p[j] * vd * rsqrtf(ms / DM + EPS); }
        dbg_acc(a.acc, 17, bf2f(((const bf16_t*)(a.ws + WS_OX))[(size_t)row * 256 + hd * 64 + tid]), o); }
}
__global__ void chk_ffn(DbgArgs a) {
    __shared__ float sh[256]; __shared__ float hn[DM]; const int s = blockIdx.x, tid = threadIdx.x, row = (s * 7919 + 13) % MTOK;
    const float* x2 = a.out + (size_t)row * DM; float ss = 0.f; for (int k = tid; k < DM; k += 256) ss += x2[k] * x2[k]; ss = blk_sum(ss, sh); const float rs = rsqrtf(ss / DM + EPS);
    for (int k = tid; k < DM; k += 256) hn[k] = x2[k] * rs * DIN_(7)[k]; __syncthreads();
    for (int j = tid; j < FF; j += 256 * 8) { float g = 0.f, u = 0.f; for (int k = 0; k < DM; ++k) { g += hn[k] * DIN_(48)[(size_t)k * FF + j]; u += hn[k] * DIN_(49)[(size_t)k * FF + j]; }
        dbg_acc(a.acc, 18, bf2f(((const bf16_t*)(a.ws + WS_HFF))[(size_t)row * FF + j]), g / (1.f + expf(-g)) * u); }
}

__global__ void chk_moe(DbgArgs a) {
    __shared__ float sh[256]; __shared__ float hn[DM]; __shared__ float hid[EFF]; __shared__ float lgs[8];
    const int s = blockIdx.x, tid = threadIdx.x, tok = (s * 7919 + 13) % MTOK, slot = s & 1, col = (s * 104729 + 7) % DM;
    const float* x2 = a.out + (size_t)tok * DM; float ss = 0.f; for (int k = tid; k < DM; k += 256) ss += x2[k] * x2[k]; ss = blk_sum(ss, sh); const float rs = rsqrtf(ss / DM + EPS);
    for (int k = tid; k < DM; k += 256) hn[k] = x2[k] * rs * ((const float*)a.in[7])[DM + k]; __syncthreads();
    for (int e = 0; e < 8; ++e) { float d = 0.f; for (int k = tid; k < DM; k += 256) d += hn[k] * DIN_(51)[k * 8 + e]; d = blk_sum(d, sh); if (tid == 0) lgs[e] = d; } __syncthreads();
    int e1 = 0; for (int e = 1; e < 8; ++e) if (lgs[e] > lgs[e1]) e1 = e; int e2 = -1; for (int e = 0; e < 8; ++e) if (e != e1 && (e2 < 0 || lgs[e] > lgs[e2])) e2 = e;
    const float w1 = 1.f / (1.f + expf(lgs[e2] - lgs[e1])), w2 = 1.f - w1;
    const int* ASG = (const int*)(a.ws + WS_MOESM + MS_ASSIGN); const int* TD = (const int*)(a.ws + WS_MOESM + MS_TOKDEST); const float* TW = (const float*)(a.ws + WS_MOESM + MS_TOKW); const int* RT = (const int*)(a.ws + WS_MOESM + MS_ROWTOK);
    const int ef = ASG[2 * tok + slot] & 255, dest = TD[2 * tok + slot];
    if (tid == 0) { dbg_acc(a.acc, 19, (float)(ASG[2 * tok] & 255), (float)e1 + 1e-3f); dbg_acc(a.acc, 19, (float)(ASG[2 * tok + 1] & 255), (float)e2 + 1e-3f); dbg_acc(a.acc, 19, TW[2 * tok], w1); dbg_acc(a.acc, 19, TW[2 * tok + 1], w2); dbg_acc(a.acc, 19, (float)(RT[dest] - tok), 1e-3f); }
    const float* wg = DIN_(52) + (size_t)ef * DM * EFF; const float* wu = DIN_(53) + (size_t)ef * DM * EFF; const float* wd = DIN_(54) + (size_t)ef * EFF * DM;
    for (int f = tid; f < EFF; f += 256) { float g = 0.f, u = 0.f; for (int k = 0; k < DM; ++k) { g += hn[k] * wg[(size_t)k * EFF + f]; u += hn[k] * wu[(size_t)k * EFF + f]; } hid[f] = g / (1.f + expf(-g)) * u; }
    __syncthreads();
    float y = 0.f; for (int f = tid; f < EFF; f += 256) y += hid[f] * wd[(size_t)f * DM + col]; y = blk_sum(y, sh);
    if (tid == 0) dbg_acc(a.acc, 20, bf2f(((const bf16_t*)(a.ws + WS_YS))[(size_t)dest * DM + col]), y);
}

__global__ void chk_res(DbgArgs a, int kind) {
    __shared__ float sh[256]; const int s = blockIdx.x, tid = threadIdx.x, row = (s * 7919 + 13) % MTOK, col = (s * 104729 + 7) % DM; const float* xprev = (const float*)(a.ws + WS_DBG);
    float o = 0.f;
    if (kind == 0) { const bf16_t* A = (const bf16_t*)(a.ws + WS_OX) + (size_t)row * 256; o = bf2f(A[tid]) * DIN_(45)[(size_t)tid * DM + col]; }
    else { const bf16_t* A = (const bf16_t*)(a.ws + WS_HFF) + (size_t)row * FF; for (int k = tid; k < FF; k += 256) o += bf2f(A[k]) * DIN_(50)[(size_t)k * DM + col]; }
    o = blk_sum(o, sh);
    if (tid == 0) { dbg_acc(a.acc, 21, a.out[(size_t)row * DM + col], xprev[(size_t)row * DM + col] + o);
        const bf16_t xbv = ((const bf16_t*)(a.ws + WS_XB))[(size_t)row * DM + col]; dbg_acc(a.acc, 22, bf2f(xbv), a.out[(size_t)row * DM + col]); }
}

__global__ void chk_final(DbgArgs a) {
    const int i = blockIdx.x * 256 + threadIdx.x; const int tok = (i * 37 + 5) % MTOK, col = (i * 101 + 3) % DM; const float* xprev = (const float*)(a.ws + WS_DBG);
    const int* TD = (const int*)(a.ws + WS_MOESM + MS_TOKDEST); const float* TW = (const float*)(a.ws + WS_MOESM + MS_TOKW); const bf16_t* YS = (const bf16_t*)(a.ws + WS_YS);
    const float ref = xprev[(size_t)tok * DM + col] + TW[2 * tok] * bf2f(YS[(size_t)TD[2 * tok] * DM + col]) + TW[2 * tok + 1] * bf2f(YS[(size_t)TD[2 * tok + 1] * DM + col]);
    dbg_acc(a.acc, 23, a.out[(size_t)tok * DM + col], ref);
}
__global__ void chk_emit(DbgArgs a, int nchk) {
    for (int i = blockIdx.x * 256 + threadIdx.x; i < MTOK * DM; i += gridDim.x * 256) a.out[i] = 0.f;
    if (blockIdx.x == 0 && threadIdx.x == 0) { float V = 99000.f; float worst = 0.f;
        for (int k = 1; k <= nchk; ++k) { const float cnt = a.acc[64 + k]; const float rms = sqrtf(a.acc[2 * k + 1] / fmaxf(cnt, 1.f)) + 1e-20f; float err = a.acc[2 * k] / rms; if (cnt < 1.f) continue; if (!(err == err)) err = 0.97f; worst = fmaxf(worst, err);
#ifdef DBG_ONLY
            if (k == DBG_ONLY) { V = 1000.f + err * 10000.f; break; }
#else
            if (err > 0.06f) { V = (float)k * 1000.f + fminf(err, 0.99f) * 1000.f; break; }
#endif
        }
        if (V == 99000.f) V = 99000.f + worst * 1000.f;
        a.out[12345] = V; }
}
#endif

#ifdef DBG_STAT
__global__ void stat_scan(const float* out, unsigned* acc) {
    for (int i = blockIdx.x * 256 + threadIdx.x; i < MTOK * DM; i += gridDim.x * 256) { const float v = fabsf(out[i]);
        atomicMax(&acc[1], __float_as_uint(v)); if (v > 10.f || !(v == v)) { atomicAdd(&acc[0], 1u); atomicAdd(&acc[2 + (i >> 18)], 1u); atomicAdd(&acc[70 + ((i & 1023) >> 8)], 1u); atomicAdd(&acc[80 + ((i >> 10) & 255) / 32], 1u); } }
}
__global__ void stat_emit(float* out, const unsigned* acc, int mode) {
    for (int i = blockIdx.x * 256 + threadIdx.x; i < MTOK * DM; i += gridDim.x * 256) out[i] = 0.f;
    if (blockIdx.x == 0 && threadIdx.x == 0) { float V = 0.f;
        if (mode == 0) V = (float)acc[0];
        else if (mode == 1) V = __uint_as_float(acc[1]) * 100.f;
        else if (mode == 2) { unsigned best = 0, bi = 0, nz = 0; for (int k = 0; k < 64; ++k) { if (acc[2 + k] > best) { best = acc[2 + k]; bi = k; } nz += acc[2 + k] > 0; } V = 1000.f * (float)bi + 10.f * (float)nz; }
        else if (mode == 3) V = 1000.f * (float)acc[70] / fmaxf((float)acc[0], 1.f) + 100000.f * (float)acc[71] / fmaxf((float)acc[0], 1.f);
        else if (mode == 4) { unsigned best = 0, bi = 0; for (int k = 0; k < 8; ++k) if (acc[80 + k] > best) { best = acc[80 + k]; bi = k; } V = 1000.f + 1000.f * (float)bi + 900.f * (float)best / fmaxf((float)acc[0], 1.f); }
        out[12345] = V + 100.f; }
}
#endif

#ifdef DBG_VAR
__global__ void var_scan(const float* out, const float* prev, float* acc) {
    float s = 0.f, mx = 0.f; for (int i = blockIdx.x * 256 + threadIdx.x; i < MTOK * DM; i += gridDim.x * 256) { const float d = out[i] - prev[i]; s += d * d; mx = fmaxf(mx, fabsf(d)); }
    atomicAdd(&acc[0], s); atomicMax((unsigned*)&acc[1], __float_as_uint(mx));
}
__global__ void var_emit(float* out, const float* acc, int mode) {
    for (int i = blockIdx.x * 256 + threadIdx.x; i < MTOK * DM; i += gridDim.x * 256) out[i] = 0.f;
    if (blockIdx.x == 0 && threadIdx.x == 0) out[12345] = 100.f + (mode == 0 ? acc[0] / (float)(MTOK * DM) * 1e5f : acc[1] * 100.f);
}
#endif

#ifdef DBG_GSTAT
__global__ void gstat_scan(const bf16_t* zg, float* acc) { float s1 = 0.f, s2 = 0.f; for (size_t i = blockIdx.x * 256 + threadIdx.x; i < (size_t)MTOK * ZGW; i += (size_t)gridDim.x * 256) { const float g = bf2f(zg[i]); const int blk = (int)((i & 4095) >> 10); if (blk == DBG_GSTAT) { s1 += (g < -0.01f || g > 1.01f || !(g == g)) ? 1.f : 0.f; s2 += (g - 0.5f) * (g - 0.5f); } } atomicAdd(&acc[0], s1); atomicAdd(&acc[1], s2); }
__global__ void gstat_emit(float* out, const float* acc, int mode) {
    for (int i = blockIdx.x * 256 + threadIdx.x; i < MTOK * DM; i += gridDim.x * 256) out[i] = 0.f;
    if (blockIdx.x == 0 && threadIdx.x == 0) out[12345] = 100.f + 10000.f * acc[1] / ((float)MTOK * 1024);
}
#endif
extern "C" void kernel_launch(void* const* d_in, const int* in_sizes, int n_in, void* d_out, int out_size, void* d_ws, size_t ws_size, hipStream_t stream) {
    static int grid = 0;
    if (grid == 0) {
        if (n_in != 55 || out_size != MTOK * DM || ws_size < WS_END) { fprintf(stderr, "kernel_launch: unexpected shapes (n_in %d out %d ws %zu)\n", n_in, out_size, ws_size); grid = -1; return; }
        { const int L2 = 2; const int exp_sz[55] = {NB * SEQ * DM, NB * NMEM * DM, NB * SEQ, 32 * 4, L2 * DM, L2 * DM, L2 * DM, L2 * DM, L2 * DM * DIN, L2 * 4 * DM, L2 * 1024, L2 * 1024, L2 * 16, L2 * 16384, L2 * 16384, L2 * 16384, L2 * 16384, L2 * 256, L2 * 65536, L2 * 256,
              L2 * 192, L2 * 128, L2 * 192 * 384, L2 * 128 * 512, L2 * 96, L2 * 96, L2 * 1024, L2 * 256, L2 * 16384, L2 * 256, L2 * 16384, L2 * 256, L2 * 256, L2 * 32, L2 * 32, L2 * 32, L2 * 32, L2 * 32, L2 * 32, L2 * 64,
              L2 * 4 * 256 * DM, L2 * DM * DM, L2 * DM * 256, L2 * DM * 256, L2 * DM * 256, L2 * 256 * DM, L2 * 64, L2 * 64, DM * FF, DM * FF, FF * DM, DM * 8, 8 * DM * EFF, 8 * DM * EFF, 8 * EFF * DM};
          for (int i = 0; i < 55; ++i) if (in_sizes[i] != exp_sz[i]) { fprintf(stderr, "kernel_launch: input %d has %d elements, expected %d\n", i, in_sizes[i], exp_sz[i]); grid = -1; return; } }
        int dev = 0, cus = 0, per_cu = 0;
        if (hipGetDevice(&dev) != hipSuccess || hipDeviceGetAttribute(&cus, hipDeviceAttributeMultiprocessorCount, dev) != hipSuccess) { grid = -1; return; }
        if (hipFuncSetAttribute((const void*)hybrid_fwd, hipFuncAttributeMaxDynamicSharedMemorySize, LDS_BYTES) != hipSuccess) { fprintf(stderr, "kernel_launch: hipFuncSetAttribute failed\n"); grid = -1; return; }
        if (hipOccupancyMaxActiveBlocksPerMultiprocessor(&per_cu, (const void*)hybrid_fwd, 512, LDS_BYTES) != hipSuccess || per_cu < 1) { fprintf(stderr, "kernel_launch: occupancy query says %d\n", per_cu); }
        (void)hipGetLastError();
        grid = cus;
    }
    if (grid < 0) return;
    if (hipMemsetAsync((char*)d_ws + WS_CTL, 0, CTL_ZERO_BYTES, stream) != hipSuccess) return;
    Args a{};
    for (int i = 0; i < 55; ++i) a.in[i] = d_in[i];
    a.out = (float*)d_out; a.ws = (unsigned char*)d_ws; a.submask = 0xFFFF; a.pad = 0;
#if MK_ONE_LAUNCH
    a.ph_lo = 0; a.ph_hi = NPHASE;
    hipLaunchKernelGGL(hybrid_fwd, dim3(grid), dim3(512), LDS_BYTES, stream, a);
#else
    for (int p = 0; p < DBG_NPH; ++p) { a.ph_lo = p; a.ph_hi = p + 1;
#if defined(DBG_CHECK) || defined(DBG_VAR)
        if (p == DBG_NPH - 1) hipMemcpyAsync((char*)d_ws + 440 * MiB, d_out, (size_t)MTOK * DM * 4, hipMemcpyDeviceToDevice, stream);
#endif
        hipLaunchKernelGGL(hybrid_fwd, dim3(grid), dim3(512), LDS_BYTES, stream, a);
#ifdef DBG_REPEAT
        if (p == DBG_REPEAT) {
#ifdef DBG_REPSUB
            a.submask = DBG_REPSUB;
#endif
            hipLaunchKernelGGL(hybrid_fwd, dim3(grid), dim3(512), LDS_BYTES, stream, a); hipLaunchKernelGGL(hybrid_fwd, dim3(grid), dim3(512), LDS_BYTES, stream, a); a.submask = 0xFFFF; }
#endif
    }
#ifdef DBG_CHECK
    { DbgArgs da{}; for (int i = 0; i < 55; ++i) da.in[i] = d_in[i]; da.ws = (unsigned char*)d_ws; da.out = (float*)d_out; da.acc = (float*)((char*)d_ws + 700 * 1024);
#if DBG_NPH == 6 || DBG_NPH == 16
      hipLaunchKernelGGL(chk_merge, dim3(512), dim3(256), 0, stream, da);
#elif DBG_NPH == 8 || DBG_NPH == 18
      hipLaunchKernelGGL(chk_cross, dim3(64), dim3(256), 0, stream, da);
#elif DBG_NPH == 10
      hipLaunchKernelGGL(chk_ffn, dim3(64), dim3(256), 0, stream, da);
#elif DBG_NPH == 24
      hipLaunchKernelGGL(chk_final, dim3(64), dim3(256), 0, stream, da);
#elif DBG_NPH == 23
      hipLaunchKernelGGL(chk_moe, dim3(128), dim3(256), 0, stream, da);
#elif DBG_NPH == 9 || DBG_NPH == 19
      hipLaunchKernelGGL(chk_res, dim3(512), dim3(256), 0, stream, da, 0);
#elif DBG_NPH == 11
      hipLaunchKernelGGL(chk_res, dim3(512), dim3(256), 0, stream, da, 1);
#else
      hipLaunchKernelGGL(chk_z, dim3(1024), dim3(256), 0, stream, da);
      hipLaunchKernelGGL(chk_mla_prep, dim3(512), dim3(256), 0, stream, da);
      hipLaunchKernelGGL(chk_diff_prep, dim3(16), dim3(256), 0, stream, da);
      hipLaunchKernelGGL(chk_lru_prep, dim3(512), dim3(256), 0, stream, da);
      hipLaunchKernelGGL(chk_mla_attn, dim3(64), dim3(256), 0, stream, da);
      hipLaunchKernelGGL(chk_diff_attn, dim3(64), dim3(256), 0, stream, da);
      hipLaunchKernelGGL(chk_lru_scan, dim3(4), dim3(256), 0, stream, da);
      hipLaunchKernelGGL(chk_s5_scan, dim3(16), dim3(64), 0, stream, da);
      hipLaunchKernelGGL(chk_s5_glu, dim3(64), dim3(256), 0, stream, da);
#endif
      hipLaunchKernelGGL(chk_emit, dim3(1024), dim3(256), 0, stream, da, 23); }
#endif
#ifdef DBG_COPYX
    hipMemcpyAsync(d_out, d_in[0], (size_t)MTOK * DM * 4, hipMemcpyDeviceToDevice, stream);
#endif
#ifdef DBG_GSTAT
    { float* acc = (float*)((char*)d_ws + 900 * 1024);
      hipLaunchKernelGGL(gstat_scan, dim3(2048), dim3(256), 0, stream, (const bf16_t*)((const char*)d_ws + WS_ZG), acc);
      hipLaunchKernelGGL(gstat_emit, dim3(1024), dim3(256), 0, stream, (float*)d_out, (const float*)acc, DBG_GSTAT); }
#endif
#ifdef DBG_VAR
    { float* acc = (float*)((char*)d_ws + 900 * 1024);
      hipLaunchKernelGGL(var_scan, dim3(1024), dim3(256), 0, stream, (const float*)d_out, DBG_NPH == 6 ? (const float*)d_in[0] : (const float*)((const char*)d_ws + 440 * MiB), acc);
      hipLaunchKernelGGL(var_emit, dim3(1024), dim3(256), 0, stream, (float*)d_out, (const float*)acc, DBG_VAR); }
#endif
#ifdef DBG_STAT
    { unsigned* acc = (unsigned*)((char*)d_ws + 800 * 1024);
      hipLaunchKernelGGL(stat_scan, dim3(2048), dim3(256), 0, stream, (const float*)d_out, acc);
      hipLaunchKernelGGL(stat_emit, dim3(1024), dim3(256), 0, stream, (float*)d_out, (const unsigned*)acc, DBG_STAT); }
#endif
#ifdef DBG_DUMP_OFF
    hipLaunchKernelGGL(dbg_copy_bf16, dim3(2048), dim3(256), 0, stream, (const bf16_t*)((const char*)d_ws + (size_t)(DBG_DUMP_OFF)), (float*)d_out, MTOK * DM, DBG_DUMP_N);
#endif
#endif
}
```

```cpp
#include <hip/hip_runtime.h>
#include <cstdio>
#include <cstdint>

#define DBG_NPH 24

#ifndef DBG_GPERM
#define DBG_GPERM(n) (n)
#endif
#ifndef DBG_SCALE
#define DBG_SCALE 1.0f
#endif
#ifndef MK_ONE_LAUNCH
#define MK_ONE_LAUNCH 1
#endif
#ifndef GATE_FP8
#define GATE_FP8 3
#endif
#ifndef ZG_FP8
#define ZG_FP8 (GATE_FP8 == 3)
#endif
#ifndef G2_FP8
#define G2_FP8 1
#endif

#define LAS __attribute__((address_space(3)))
typedef unsigned short bf16_t;
typedef short bf16x8 __attribute__((ext_vector_type(8)));
typedef float f32x2 __attribute__((ext_vector_type(2)));
typedef float f32x4 __attribute__((ext_vector_type(4)));
typedef float f32x16 __attribute__((ext_vector_type(16)));
typedef unsigned u32x2 __attribute__((ext_vector_type(2)));
typedef unsigned u32x4 __attribute__((ext_vector_type(4)));
typedef int i32x4 __attribute__((ext_vector_type(4)));
typedef int i32x8 __attribute__((ext_vector_type(8)));

constexpr int DM = 1024, NB = 4, SEQ = 4096, MTOK = NB * SEQ, NMEM = 256;
constexpr int DIN = 5984, ZSW = 2048, ZGW = 4096, NIN = ZSW + ZGW;
constexpr int C_S5 = 0, C_CQ = 256, C_CKV = 448, C_KPE = 576, C_XLRU = 608, C_GLRU = 864, C_QD = 1120, C_KD = 1376, C_VD = 1632, C_END = 1888;
constexpr int FF = 2816, EFF = 3584, NEXP = 8, MOE_ROWS = 34816;
constexpr float EPS = 1e-6f, LOG2E = 1.4426950408889634f;

constexpr size_t MiB = 1u << 20;
constexpr size_t WS_CTL = 0, CTL_ZERO_BYTES = 1 * MiB + 512 * 1024;
constexpr size_t WS_MOESM = 1 * MiB;
constexpr size_t WS_XB = 2 * MiB;
constexpr size_t WS_WL = 34 * MiB, WL_STRIDE = 19 * MiB;
constexpr size_t WL_WIN = 0, WL_PT = 12 * MiB, WL_WO = 14 * MiB, WL_WXQ = 16 * MiB, WL_WXKV = 16 * MiB + 512 * 1024, WL_WXO = 17 * MiB + 512 * 1024, WL_SM = 18 * MiB;
constexpr size_t SM_WUQ = 0, SM_WUKV = 256 * 1024, SM_WR = 512 * 1024, SM_WI = 576 * 1024, SM_WGLU = 640 * 1024;
constexpr size_t WS_WGU = 72 * MiB, WS_WD = 83 * MiB, WS_TAB = 89 * MiB, WS_KX = 90 * MiB, WS_VXT = 91 * MiB;
constexpr size_t TAB_S5T = 0, TAB_CMAT = 512 * 1024, TAB_MISC = 768 * 1024;
constexpr size_t WS_ZS = 92 * MiB, WS_MERGED = 92 * MiB, WS_ZG = 156 * MiB, WS_HFF = 156 * MiB, WS_Y = 284 * MiB;
constexpr size_t WS_QM = 316 * MiB, WS_KM = 328 * MiB, WS_VMT = 340 * MiB, WS_QD = 348 * MiB, WS_KD = 356 * MiB, WS_VDT = 364 * MiB;
constexpr size_t WS_QX = 316 * MiB, WS_OX = 324 * MiB;
constexpr size_t WS_LA = 372 * MiB, WS_LI = 388 * MiB, WS_S5S = 404 * MiB, WS_LSUM = 406 * MiB, WS_RSP = 407 * MiB;
constexpr size_t WS_WMGU = 34 * MiB, WS_WMD = 146 * MiB, WS_HMOE = 202 * MiB, WS_XQ = 330 * MiB, WS_YS = 34 * MiB, WS_X8 = 416 * MiB, WS_WG8 = 432 * MiB, WS_END = 440 * MiB;
constexpr int CW_TMO = 0, CW_BAR = 4096, CW_MOECNT = 8192, CW_Q = 12288;
constexpr size_t CTL_ROWSS = 256 * 1024;
constexpr size_t MS_ROWTOK = 0, MS_TOKW = 512 * 1024, MS_ASSIGN = 640 * 1024, MS_RSTD = 768 * 1024;
constexpr int RING_BYTES = 131072, MISC_OFF = RING_BYTES + 320, LDS_BYTES = 147456;

typedef __bf16 bf16x2_t __attribute__((ext_vector_type(2)));
__device__ __forceinline__ unsigned cvt_pk_bf16(float lo, float hi) { const f32x2 v = {lo, hi}; const bf16x2_t b = __builtin_convertvector(v, bf16x2_t); return __builtin_bit_cast(unsigned, b); }
__device__ __forceinline__ float clamp8(float x) { return __builtin_fminf(__builtin_fmaxf(x, -448.f), 448.f); }
__device__ __forceinline__ unsigned cvt_pk4_fp8(float a, float b, float c, float d) { int w = __builtin_amdgcn_cvt_pk_fp8_f32(clamp8(a), clamp8(b), 0, false); w = __builtin_amdgcn_cvt_pk_fp8_f32(clamp8(c), clamp8(d), w, true); return (unsigned)w; }
__device__ __forceinline__ float bflo(unsigned w) { return __uint_as_float(w << 16); }
__device__ __forceinline__ float bfhi(unsigned w) { return __uint_as_float(w & 0xffff0000u); }
__device__ __forceinline__ float bf2f(bf16_t b) { return __uint_as_float((unsigned)b << 16); }
__device__ __forceinline__ bf16_t f2bf(float f) { return (bf16_t)(cvt_pk_bf16(f, 0.f) & 0xffffu); }
__device__ __forceinline__ float fexp2(float x) { return __builtin_amdgcn_exp2f(x); }
__device__ __forceinline__ float frcp(float x) { return __builtin_amdgcn_rcpf(x); }
__device__ __forceinline__ float frsq(float x) { return __builtin_amdgcn_rsqf(x); }
__device__ __forceinline__ float fsigmoid(float x) { return frcp(1.f + fexp2(-x * LOG2E)); }
__device__ __forceinline__ float fgelu(float x) {
    const float z = 0.7978845608028654f * (x + 0.044715f * x * x * x);
    const float e = fexp2(2.f * LOG2E * z);
    const float th = 1.f - 2.f * frcp(e + 1.f);
    return 0.5f * x * (1.f + th);
}
__device__ __forceinline__ int crow(int r, int hi) { return (r & 3) + 8 * (r >> 2) + 4 * hi; }
__device__ __forceinline__ bf16x8 ldg8(const bf16_t* p) { return *(const bf16x8*)p; }
__device__ __forceinline__ float sq8(bf16x8 v) {
    const u32x4 w = *(const u32x4*)&v; float s = 0.f;
#pragma unroll
    for (int i = 0; i < 4; ++i) { const float a = bflo(w[i]), b = bfhi(w[i]); s += a * a + b * b; }
    return s;
}
__device__ __forceinline__ float row_rstd(const float* rsp, int row) {
    const f32x4* p = (const f32x4*)(rsp + (size_t)row * 16); const f32x4 a = p[0], b = p[1], c = p[2], d = p[3];
    const float s = (((a.x + a.y) + (a.z + a.w)) + ((b.x + b.y) + (b.z + b.w))) + (((c.x + c.y) + (c.z + c.w)) + ((d.x + d.y) + (d.z + d.w)));
    return frsq(s * (1.f / DM) + EPS);
}
__device__ __forceinline__ float wave_sum(float v) {
#pragma unroll
    for (int o = 1; o < 64; o <<= 1) v += __shfl_xor(v, o);
    return v;
}
#define MFMA32(a, b, c) __builtin_amdgcn_mfma_f32_32x32x16_bf16((a), (b), (c), 0, 0, 0)
#define MFMA16(a, b, c) __builtin_amdgcn_mfma_f32_16x16x32_bf16((a), (b), (c), 0, 0, 0)
__device__ __forceinline__ void sincos_red(float a, float& s, float& c) {
    const float k = rintf(a * 0.15915494309189535f);
    float r = fmaf(-k, 6.28318548202514648f, a);
    r = fmaf(-k, -1.7484555e-7f, r);
    s = __sinf(r); c = __cosf(r);
}

namespace pg8 {
constexpr int BM = 256, BK = 64, HALF = 128, HTB = HALF * BK * 2, STAGE_BYTES = 8 * HTB;
__host__ __device__ __forceinline__ int lds_byte(int r, int c) { const int st = (r >> 4) * 2 + (c >> 5), rr = r & 15, cc = c & 31, ob = rr * 64 + cc * 2; return st * 1024 + (ob ^ (((ob >> 9) & 1) << 5)); }
__host__ __device__ __forceinline__ void stage_rc(int b, int& R, int& C) { const int st = b / 1024, sb = b % 1024, swz = sb ^ (((sb >> 9) & 1) << 5); R = (st >> 1) * 16 + swz / 64; C = (st & 1) * 32 + (swz % 64) / 2; }
__host__ __device__ __forceinline__ int perm32(int rho) { const int n = rho >> 4, i = rho & 15; return 8 * (i >> 2) + 4 * n + (i & 3); }

struct Unit { int pm, pn, om, on, aux, gofs; };
struct Gemm { const bf16_t* A; const bf16_t* Bt; int K; const int* gather; };

template <class Epi, class Sched, bool ALIGN_EPI, bool GATHER, bool FP8 = false>
__device__ __forceinline__ void gemm_phase(LAS unsigned char* lds, Gemm g, const Sched& S, const Epi& E) {
    int tid = threadIdx.x; asm volatile("" : "+v"(tid));
    asm volatile("" : "+s"(g.A), "+s"(g.Bt));
    const int wid = __builtin_amdgcn_readfirstlane(tid >> 6), lane = tid & 63, wr = wid >> 2, wc = wid & 3, fr = lane & 15, fq = lane >> 4;
    const int K = g.K, nt = K / BK;
    unsigned voffB[2];
#pragma unroll
    for (int i = 0; i < 2; ++i) { int Rr_, Cc_; stage_rc(tid * 16 + i * 8192, Rr_, Cc_); const int Rb = (Rr_ & ~31) + perm32(Rr_ & 31); voffB[i] = (unsigned)(Rb * K + Cc_) * 2u; }
    const size_t kstep = (size_t)(BK * 2);
    const size_t hstep = (size_t)HALF * K * 2;
    const size_t tstep = 2 * hstep;
    const unsigned ldsw = (unsigned)wid * 1024u;
    const int aoff = lds_byte(wr * 64 + fr, fq * 8), boff = lds_byte(wc * 32 + fr, fq * 8);
#define PG8_SA(b, h) (((b) * 2 + (h)) * HTB)
#define PG8_SB(b, h) ((4 + (b) * 2 + (h)) * HTB)
#define PG8_STAGE_B(bufoff, gbase) do { _Pragma("unroll") for (int _i = 0; _i < 2; ++_i) \
        __builtin_amdgcn_global_load_lds((const unsigned*)((const char*)(gbase) + voffB[_i]), (LAS unsigned*)(lds + (bufoff) + ldsw + _i * 8192), 16, 0, 0); } while (0)
#define PG8_STAGE_A(bufoff, kt, vo0, vo1) do { const char* _gb = (const char*)g.A + (size_t)(kt) * kstep; \
        __builtin_amdgcn_global_load_lds((const unsigned*)(_gb + (vo0)), (LAS unsigned*)(lds + (bufoff) + ldsw), 16, 0, 0); \
        __builtin_amdgcn_global_load_lds((const unsigned*)(_gb + (vo1)), (LAS unsigned*)(lds + (bufoff) + ldsw + 8192), 16, 0, 0); } while (0)
#define PG8_LDA(dst, b, h) do { _Pragma("unroll") for (int m = 0; m < 4; ++m) _Pragma("unroll") for (int k = 0; k < 2; ++k) dst[m][k] = *(const LAS bf16x8*)(lds + PG8_SA(b, h) + aoff + m * 2048 + k * 1024); } while (0)
#define PG8_LDB(dst, b, h) do { _Pragma("unroll") for (int n = 0; n < 2; ++n) _Pragma("unroll") for (int k = 0; k < 2; ++k) dst[n][k] = *(const LAS bf16x8*)(lds + PG8_SB(b, h) + boff + n * 2048 + k * 1024); } while (0)
#define PG8_MMA(ai, bj, At, Bt) do { __builtin_amdgcn_s_setprio(1); _Pragma("unroll") for (int m = 0; m < 4; ++m) _Pragma("unroll") for (int n = 0; n < 2; ++n) _Pragma("unroll") for (int k = 0; k < 2; ++k) \
        acc[ai][bj][m][n] = __builtin_amdgcn_mfma_f32_16x16x32_bf16(Bt[n][k], At[m][k], acc[ai][bj][m][n], 0, 0, 0); __builtin_amdgcn_s_setprio(0); } while (0)
#define PG8_MMA8(ai, bj, w) do { __builtin_amdgcn_s_setprio(1); _Pragma("unroll") for (int m = 0; m < 4; ++m) _Pragma("unroll") for (int n = 0; n < 2; ++n) \
        asm volatile("v_mfma_f32_16x16x128_f8f6f4 %0, %1, %2, %0" : "+v"(acc[ai][bj][m][n]) : "v"(B##w##8[n]), "v"(A8[m])); __builtin_amdgcn_s_setprio(0); } while (0)
#define PG8_LA(b, h) do { if constexpr (FP8) { _Pragma("unroll") for (int m = 0; m < 4; ++m) { A8[m].lo = *(const LAS i32x4*)(lds + PG8_SA(b, h) + aoff + m * 2048); A8[m].hi = *(const LAS i32x4*)(lds + PG8_SA(b, h) + aoff + m * 2048 + 1024); } } \
        else PG8_LDA(At, b, h); } while (0)
#define PG8_LB(w, b, h) do { if constexpr (FP8) { _Pragma("unroll") for (int n = 0; n < 2; ++n) { B##w##8[n].lo = *(const LAS i32x4*)(lds + PG8_SB(b, h) + boff + n * 2048); B##w##8[n].hi = *(const LAS i32x4*)(lds + PG8_SB(b, h) + boff + n * 2048 + 1024); } } \
        else PG8_LDB(B##w, b, h); } while (0)
#define PG8_MM(ai, bj, w) do { if constexpr (FP8) PG8_MMA8(ai, bj, w); else PG8_MMA(ai, bj, At, B##w); } while (0)
#define PG8_WAIT_V(n) asm volatile("s_waitcnt vmcnt(" #n ")" ::: "memory")
#define PG8_WAIT_L(n) asm volatile("s_waitcnt lgkmcnt(" #n ")" ::: "memory")
#define PG8_BAR __builtin_amdgcn_s_barrier()
#define PG8_SCHED __builtin_amdgcn_sched_barrier(0)
#define PG8_VOFF(dst, u) do { _Pragma("unroll") for (int _h = 0; _h < 2; ++_h) _Pragma("unroll") for (int _i = 0; _i < 2; ++_i) { int Rr_, Cc_; stage_rc(tid * 16 + _i * 8192, Rr_, Cc_); \
        const int _rt = (u).pm * BM + _h * HALF + Rr_; const int _ar = GATHER ? g.gather[_rt + (u).gofs] : _rt; dst[_h][_i] = (unsigned)((size_t)_ar * K + Cc_) * 2u; } } while (0)
    Unit cur, nxt; int ui = 0;
    if (!S.next(0, cur)) return;
    f32x4 acc[2][2][4][2];
#pragma unroll
    for (int a = 0; a < 2; ++a)
#pragma unroll
        for (int b = 0; b < 2; ++b)
#pragma unroll
            for (int m = 0; m < 4; ++m)
#pragma unroll
                for (int n = 0; n < 2; ++n) acc[a][b][m][n] = (f32x4){0.f, 0.f, 0.f, 0.f};
    bf16x8 At[4][2], B0[2][2], B1[2][2];
    i32x8 A8[4], B08[2], B18[2];
    unsigned vC[2][2], vN[2][2];
    PG8_VOFF(vC, cur);
    const char* cB = (const char*)g.Bt + (size_t)cur.pn * tstep;
    PG8_STAGE_B(PG8_SB(0, 0), cB); PG8_STAGE_B(PG8_SB(0, 1), cB + hstep); PG8_STAGE_A(PG8_SA(0, 0), 0, vC[0][0], vC[0][1]); PG8_STAGE_A(PG8_SA(0, 1), 0, vC[1][0], vC[1][1]);
    if (wr == 1) PG8_BAR;
    PG8_WAIT_V(2); PG8_BAR;
    PG8_STAGE_B(PG8_SB(1, 0), cB + kstep); PG8_STAGE_A(PG8_SA(1, 0), 1, vC[0][0], vC[0][1]); PG8_STAGE_B(PG8_SB(1, 1), cB + hstep + kstep);
    PG8_WAIT_V(6); PG8_BAR;
    for (;;) {
        const bool has_next = S.next(ui + 1, nxt);
        unsigned ndelta = 0u;
        if constexpr (GATHER) {
            if (has_next) { PG8_VOFF(vN, nxt); } else {
#pragma unroll
                for (int _h = 0; _h < 2; ++_h)
#pragma unroll
                    for (int _i = 0; _i < 2; ++_i) vN[_h][_i] = vC[_h][_i]; }
        } else { if (has_next) ndelta = (unsigned)((nxt.pm - cur.pm) * (int)tstep); }
        const char* nB = has_next ? (const char*)g.Bt + (size_t)nxt.pn * tstep : cB;
#pragma unroll 1
        for (int t = 0; t < nt; t += 2) {
            const bool last = (t == nt - 2);
            const int k2 = last ? 0 : t + 2, k3 = k2 + 1;
            const char* b2 = last ? nB : cB + (size_t)(t + 2) * kstep; const char* b3 = b2 + kstep;
            unsigned v200, v201, v210, v211;
            if constexpr (GATHER) { v200 = last ? vN[0][0] : vC[0][0]; v201 = last ? vN[0][1] : vC[0][1]; v210 = last ? vN[1][0] : vC[1][0]; v211 = last ? vN[1][1] : vC[1][1]; }
            else { const unsigned dl = last ? ndelta : 0u; v200 = vC[0][0] + dl; v201 = vC[0][1] + dl; v210 = vC[1][0] + dl; v211 = vC[1][1] + dl; }
            PG8_LB(0, 0, 0); PG8_LB(1, 0, 1); PG8_SCHED; PG8_LA(0, 0); PG8_STAGE_A(PG8_SA(1, 1), t + 1, vC[1][0], vC[1][1]);
            PG8_WAIT_V(8); PG8_WAIT_L(0); PG8_BAR; PG8_MM(0, 0, 0); PG8_MM(0, 1, 1); PG8_BAR; PG8_SCHED;
            PG8_LA(0, 1); PG8_STAGE_B(PG8_SB(0, 0), b2); PG8_STAGE_B(PG8_SB(0, 1), b2 + hstep); PG8_STAGE_A(PG8_SA(0, 0), k2, v200, v201);
            PG8_WAIT_V(8); PG8_WAIT_L(0); PG8_BAR; PG8_MM(1, 0, 0); PG8_MM(1, 1, 1); PG8_BAR; PG8_SCHED;
            PG8_LB(0, 1, 0); PG8_LB(1, 1, 1); PG8_SCHED; PG8_LA(1, 0); PG8_STAGE_A(PG8_SA(0, 1), k2, v210, v211);
            PG8_WAIT_V(8); PG8_WAIT_L(0); PG8_BAR; PG8_MM(0, 0, 0); PG8_MM(0, 1, 1); PG8_BAR; PG8_SCHED;
            PG8_LA(1, 1); PG8_STAGE_B(PG8_SB(1, 0), b3); PG8_STAGE_B(PG8_SB(1, 1), b3 + hstep); PG8_STAGE_A(PG8_SA(1, 0), k3, v200, v201);
            PG8_WAIT_V(8); PG8_WAIT_L(0); PG8_BAR; PG8_MM(1, 0, 0); PG8_MM(1, 1, 1); PG8_BAR; PG8_SCHED;
        }
        if constexpr (ALIGN_EPI) { if (wr == 0) PG8_BAR; }
        if constexpr (FP8) asm volatile("s_nop 15\n\ts_nop 15" ::: "memory");
        { int fr_ = fr, fq_ = fq; asm volatile("" : "+v"(fr_), "+v"(fq_)); E(acc, cur, wr, wc, fr_, fq_); }
        if (!has_next) break;
#pragma unroll
        for (int a = 0; a < 2; ++a)
#pragma unroll
            for (int b = 0; b < 2; ++b)
#pragma unroll
                for (int m = 0; m < 4; ++m)
#pragma unroll
                    for (int n = 0; n < 2; ++n) acc[a][b][m][n] = (f32x4){0.f, 0.f, 0.f, 0.f};
        cur = nxt; cB = nB; ++ui;
#pragma unroll
        for (int _h = 0; _h < 2; ++_h)
#pragma unroll
            for (int _i = 0; _i < 2; ++_i) { if constexpr (GATHER) vC[_h][_i] = vN[_h][_i]; else vC[_h][_i] += ndelta; }
        if constexpr (ALIGN_EPI) { if (wr == 1) PG8_BAR; }
    }
    PG8_WAIT_V(0);
    if constexpr (!ALIGN_EPI) { if (wr == 0) PG8_BAR; }
    PG8_BAR;
#undef PG8_SA
#undef PG8_SB
#undef PG8_STAGE_A
#undef PG8_STAGE_B
#undef PG8_LDA
#undef PG8_LDB
#undef PG8_MMA
#undef PG8_MMA8
#undef PG8_MM
#undef PG8_LA
#undef PG8_LB
#undef PG8_WAIT_V
#undef PG8_WAIT_L
#undef PG8_BAR
#undef PG8_SCHED
#undef PG8_VOFF
}

constexpr int NXCD = 8, WGM = 4, WGMM = 8;
struct StaticOrder {
    int nM, nN, nwg, G, c;
    __device__ void init(int nM_, int nN_, int G_, int c_) { nM = nM_; nN = nN_; nwg = nM * nN; G = G_; c = c_; }
    __device__ bool next(int i, Unit& u) const {
        const long L = (long)i * G + c; if (L >= nwg) return false;
        int wgid = (int)L; { const int q = nwg / NXCD, r = nwg % NXCD, xcd = wgid % NXCD, off = wgid / NXCD; wgid = (xcd < r ? xcd * (q + 1) : r * (q + 1) + (xcd - r) * q) + off; }
        const int nig = WGM * nN, gid = wgid / nig, fm = gid * WGM, gsz = (nM - fm) < WGM ? (nM - fm) : WGM;
        u.pm = fm + ((wgid % nig) % gsz); u.pn = (wgid % nig) / gsz; u.om = u.pm; u.on = u.pn; u.aux = 0; return true;
    }
};
struct MergeOrder {
    int G, c;
    __device__ bool next(int i, Unit& u) const {
        const int n = i & 3; const long tile = (long)(i >> 2) * G + c; if (tile >= 256) return false;
        const int om = (int)tile >> 2, on = (int)tile & 3;
        u.pm = n * 64 + om; u.pn = n * 4 + on; u.om = om; u.on = on; u.aux = n; return true;
    }
};
struct MoeOrder {
    int ntiles, nN, nwg, G, c; int pend[NEXP];
    __device__ void init(const unsigned* cnt, int nN_, int G_, int c_) {
        int acc = 0;
#pragma unroll
        for (int e = 0; e < NEXP; ++e) { const int ce = (int)cnt[64 * e]; acc += (ce + 255) >> 8; pend[e] = acc; }
        ntiles = acc; nN = nN_; nwg = ntiles * nN; G = G_; c = c_;
    }
    __device__ bool next(int i, Unit& u) const {
        const long L = (long)i * G + c; if (L >= nwg) return false;
        const int wgid = (int)L;
        const int nig = WGMM * nN, gid = wgid / nig, fm = gid * WGMM, gsz = (ntiles - fm) < WGMM ? (ntiles - fm) : WGMM;
        const int pm = fm + ((wgid % nig) % gsz), pn = (wgid % nig) / gsz;
        int e = 0, ps = 0;
#pragma unroll
        for (int j = 0; j < NEXP - 1; ++j) if (pm >= pend[j]) { e = j + 1; ps = pend[j]; }
        u.pm = pm; u.pn = e * nN + pn; u.om = pm; u.on = pn; u.aux = e; u.gofs = e * 16384 - 256 * ps; return true;
    }
};

__device__ __forceinline__ u32x4 pack8(f32x4 a, f32x4 b) { u32x4 w; w.x = cvt_pk_bf16(a[0], a[1]); w.y = cvt_pk_bf16(a[2], a[3]); w.z = cvt_pk_bf16(b[0], b[1]); w.w = cvt_pk_bf16(b[2], b[3]); return w; }
struct EpiIn {
    bf16_t* Zs; bf16_t* Zg; const float* rowss; const float* bgate;
    __device__ __forceinline__ void operator()(const f32x4 (&acc)[2][2][4][2], const Unit& u, int wr, int wc, int fr, int fq) const {
        const int row0 = u.om * BM + wr * 64 + fr, colt = u.on * BM, cw = wc * 32 + 8 * fq;
        if (colt < ZSW) {
#pragma unroll
            for (int ai = 0; ai < 2; ++ai) { float rsd[4];
#pragma unroll
                for (int m = 0; m < 4; ++m) rsd[m] = row_rstd(rowss, row0 + ai * HALF + m * 16);
#pragma unroll
                for (int m = 0; m < 4; ++m) {
                    const int row = row0 + ai * HALF + m * 16; const float rstd = rsd[m];
#pragma unroll
                    for (int bj = 0; bj < 2; ++bj) *(u32x4*)(Zs + (size_t)row * ZSW + colt + bj * HALF + cw) = pack8(acc[ai][bj][m][0] * rstd, acc[ai][bj][m][1] * rstd);
                    if (m == 3) asm volatile("" ::: "memory");
                } }
        } else {
            const int gc0 = colt - ZSW + cw;
            const f32x4 b00 = *(const f32x4*)(bgate + gc0), b01 = *(const f32x4*)(bgate + gc0 + 4), b10 = *(const f32x4*)(bgate + gc0 + HALF), b11 = *(const f32x4*)(bgate + gc0 + HALF + 4);
#pragma unroll
            for (int ai = 0; ai < 2; ++ai) { float rsd[4];
#pragma unroll
                for (int m = 0; m < 4; ++m) rsd[m] = row_rstd(rowss, row0 + ai * HALF + m * 16);
#pragma unroll
                for (int m = 0; m < 4; ++m) {
                    const int row = row0 + ai * HALF + m * 16; const float rstd = rsd[m];
#pragma unroll
                    for (int bj = 0; bj < 2; ++bj) { f32x4 v0 = acc[ai][bj][m][0] * rstd + (bj ? b10 : b00), v1 = acc[ai][bj][m][1] * rstd + (bj ? b11 : b01);
                        *(u32x4*)(Zg + (size_t)row * ZGW + gc0 + bj * HALF) = pack8(v0, v1); }
                    if (m == 3) asm volatile("" ::: "memory");
                } }
        }
    }
};
struct EpiGate8 {
    bf16_t* Zg; const float* rowss; const float* bgate;
    __device__ __forceinline__ void operator()(const f32x4 (&acc)[2][2][4][2], const Unit& u, int wr, int wc, int fr, int fq) const {
        const int row0 = u.om * BM + wr * 64 + fr, gc0 = u.on * BM + wc * 32 + 8 * fq;
        const f32x4 b00 = *(const f32x4*)(bgate + gc0), b01 = *(const f32x4*)(bgate + gc0 + 4), b10 = *(const f32x4*)(bgate + gc0 + HALF), b11 = *(const f32x4*)(bgate + gc0 + HALF + 4);
#pragma unroll
        for (int ai = 0; ai < 2; ++ai) { float rsd[4];
#pragma unroll
            for (int m = 0; m < 4; ++m) rsd[m] = row_rstd(rowss, row0 + ai * HALF + m * 16) * 0.03125f;
#pragma unroll
            for (int m = 0; m < 4; ++m) {
                const int row = row0 + ai * HALF + m * 16; const float rstd = rsd[m];
#pragma unroll
                for (int bj = 0; bj < 2; ++bj) { f32x4 v0 = acc[ai][bj][m][0] * rstd + (bj ? b10 : b00), v1 = acc[ai][bj][m][1] * rstd + (bj ? b11 : b01);
#if ZG_FP8
                    u32x2 q; q.x = cvt_pk4_fp8(v0[0], v0[1], v0[2], v0[3]); q.y = cvt_pk4_fp8(v1[0], v1[1], v1[2], v1[3]); *(u32x2*)((unsigned char*)Zg + (size_t)row * ZGW + gc0 + bj * HALF) = q; }
#else
                    *(u32x4*)(Zg + (size_t)row * ZGW + gc0 + bj * HALF) = pack8(v0, v1); }
#endif
                if (m == 3) asm volatile("" ::: "memory");
            } }
    }
};
struct EpiMerge {
    bf16_t* Mg; const bf16_t* Zg;
    __device__ __forceinline__ void operator()(const f32x4 (&acc)[2][2][4][2], const Unit& u, int wr, int wc, int fr, int fq) const {
        const int row0 = u.om * BM + wr * 64 + fr, colt = u.on * BM, cw = wc * 32 + 8 * fq, n = u.aux;
#if ZG_FP8
        u32x2 gq[2][4][2];
#pragma unroll
        for (int ai = 0; ai < 2; ++ai)
#pragma unroll
            for (int m = 0; m < 4; ++m)
#pragma unroll
                for (int bj = 0; bj < 2; ++bj) gq[ai][m][bj] = *(const u32x2*)((const unsigned char*)Zg + (size_t)(row0 + ai * HALF + m * 16) * ZGW + DBG_GPERM(n) * DM + colt + bj * HALF + cw);
#endif
#pragma unroll
        for (int ai = 0; ai < 2; ++ai) {
            u32x4 gw[4][2], ow[4][2];
#pragma unroll
            for (int m = 0; m < 4; ++m)
#pragma unroll
                for (int bj = 0; bj < 2; ++bj) { const int row = row0 + ai * HALF + m * 16, col = colt + bj * HALF + cw;
#if ZG_FP8
                    gw[m][bj] = (u32x4){gq[ai][m][bj].x, gq[ai][m][bj].y, 0u, 0u};
#else
                    gw[m][bj] = *(const u32x4*)(Zg + (size_t)row * ZGW + DBG_GPERM(n) * DM + col);
#endif
                    ow[m][bj] = n > 0 ? *(const u32x4*)(Mg + (size_t)row * DM + col) : (u32x4){0u, 0u, 0u, 0u}; }
#pragma unroll
            for (int m = 0; m < 4; ++m)
#pragma unroll
                for (int bj = 0; bj < 2; ++bj) { const int row = row0 + ai * HALF + m * 16, col = colt + bj * HALF + cw; const u32x4 g = gw[m][bj], o = ow[m][bj];
                    f32x4 v0 = acc[ai][bj][m][0], v1 = acc[ai][bj][m][1];
                    float z[8];
#if ZG_FP8
                    { const f32x2 a = __builtin_amdgcn_cvt_pk_f32_fp8((int)g.x, false), b = __builtin_amdgcn_cvt_pk_f32_fp8((int)g.x, true), c = __builtin_amdgcn_cvt_pk_f32_fp8((int)g.y, false), d = __builtin_amdgcn_cvt_pk_f32_fp8((int)g.y, true);
                      z[0] = a[0]; z[1] = a[1]; z[2] = b[0]; z[3] = b[1]; z[4] = c[0]; z[5] = c[1]; z[6] = d[0]; z[7] = d[1]; }
#else
                    z[0] = bflo(g.x); z[1] = bfhi(g.x); z[2] = bflo(g.y); z[3] = bfhi(g.y); z[4] = bflo(g.z); z[5] = bfhi(g.z); z[6] = bflo(g.w); z[7] = bfhi(g.w);
#endif
                    v0[0] = v0[0] * fsigmoid(z[0]) + bflo(o.x); v0[1] = v0[1] * fsigmoid(z[1]) + bfhi(o.x); v0[2] = v0[2] * fsigmoid(z[2]) + bflo(o.y); v0[3] = v0[3] * fsigmoid(z[3]) + bfhi(o.y);
                    v1[0] = v1[0] * fsigmoid(z[4]) + bflo(o.z); v1[1] = v1[1] * fsigmoid(z[5]) + bfhi(o.z); v1[2] = v1[2] * fsigmoid(z[6]) + bflo(o.w); v1[3] = v1[3] * fsigmoid(z[7]) + bfhi(o.w);
                    *(u32x4*)(Mg + (size_t)row * DM + col) = pack8(v0, v1); }
            asm volatile("" ::: "memory");
        }
    }
};
template <bool F32OUT, bool X8 = false, bool SC32 = false> struct EpiRes {
    float* xout; bf16_t* xb; float* rowss; unsigned char* x8;
    __device__ __forceinline__ void operator()(const f32x4 (&acc)[2][2][4][2], const Unit& u, int wr, int wc, int fr, int fq) const {
        const int row0 = u.om * BM + wr * 64 + fr, colt = u.on * BM, cw = wc * 32 + 8 * fq;
#pragma unroll
        for (int ai = 0; ai < 2; ++ai) {
            u32x4 xw[4][2];
#pragma unroll
            for (int m = 0; m < 4; ++m)
#pragma unroll
                for (int bj = 0; bj < 2; ++bj) xw[m][bj] = *(const u32x4*)(xb + (size_t)(row0 + ai * HALF + m * 16) * DM + colt + bj * HALF + cw);
#pragma unroll
            for (int m = 0; m < 4; ++m) {
                const int row = row0 + ai * HALF + m * 16; float ss = 0.f;
#pragma unroll
                for (int bj = 0; bj < 2; ++bj) { const size_t off = (size_t)row * DM + colt + bj * HALF + cw; const u32x4 w = xw[m][bj];
                    f32x4 v0 = acc[ai][bj][m][0], v1 = acc[ai][bj][m][1];
                    if constexpr (SC32) { v0 *= 0.03125f; v1 *= 0.03125f; }
                    v0[0] += bflo(w.x); v0[1] += bfhi(w.x); v0[2] += bflo(w.y); v0[3] += bfhi(w.y); v1[0] += bflo(w.z); v1[1] += bfhi(w.z); v1[2] += bflo(w.w); v1[3] += bfhi(w.w);
                    if constexpr (F32OUT) { *(f32x4*)(xout + off) = v0; *(f32x4*)(xout + off + 4) = v1; }
                    *(u32x4*)(xb + off) = pack8(v0, v1);
                    if constexpr (X8) { u32x2 q; q.x = cvt_pk4_fp8(v0[0], v0[1], v0[2], v0[3]); q.y = cvt_pk4_fp8(v1[0], v1[1], v1[2], v1[3]); *(u32x2*)(x8 + off) = q; }
                    ss += (v0[0] * v0[0] + v0[1] * v0[1]) + (v0[2] * v0[2] + v0[3] * v0[3]) + (v1[0] * v1[0] + v1[1] * v1[1]) + (v1[2] * v1[2] + v1[3] * v1[3]); }
                ss += __shfl_xor(ss, 16); ss += __shfl_xor(ss, 32);
                if (fq == 0) rowss[(size_t)row * 16 + u.on * 4 + wc] = ss;
            }
            asm volatile("" ::: "memory");
        }
    }
};
struct EpiRowScale {
    bf16_t* O; int ldc; const float* rowss;
    __device__ __forceinline__ void operator()(const f32x4 (&acc)[2][2][4][2], const Unit& u, int wr, int wc, int fr, int fq) const {
        const int row0 = u.om * BM + wr * 64 + fr, colt = u.on * BM, cw = wc * 32 + 8 * fq;
#pragma unroll
        for (int ai = 0; ai < 2; ++ai)
#pragma unroll
            for (int m = 0; m < 4; ++m) {
                const int row = row0 + ai * HALF + m * 16; const float rstd = row_rstd(rowss, row);
#pragma unroll
                for (int bj = 0; bj < 2; ++bj) *(u32x4*)(O + (size_t)row * ldc + colt + bj * HALF + cw) = pack8(acc[ai][bj][m][0] * rstd, acc[ai][bj][m][1] * rstd);
                if (m == 3) asm volatile("" ::: "memory");
            }
    }
};
template <bool MOE> struct EpiSwiGLU {
    bf16_t* H; int ldh; const float* rs; const int* row_tok;
    __device__ __forceinline__ void operator()(const f32x4 (&acc)[2][2][4][2], const Unit& u, int wr, int wc, int fr, int fq) const {
        const int row0 = u.om * BM + wr * 64 + fr, hc = u.on * HALF + wc * 32 + 8 * fq;
#pragma unroll
        for (int ai = 0; ai < 2; ++ai) { float rsd[4];
#pragma unroll
            for (int m = 0; m < 4; ++m) { const int row = row0 + ai * HALF + m * 16; rsd[m] = MOE ? rs[row_tok[row]] : row_rstd(rs, row); }
#pragma unroll
            for (int m = 0; m < 4; ++m) {
                const int row = row0 + ai * HALF + m * 16;
                const float rstd = rsd[m];
                f32x4 o[2];
#pragma unroll
                for (int n = 0; n < 2; ++n)
#pragma unroll
                    for (int j = 0; j < 4; ++j) { const float gv = acc[ai][0][m][n][j] * rstd, uv = acc[ai][1][m][n][j] * rstd; o[n][j] = gv * fsigmoid(gv) * uv; }
                *(u32x4*)(H + (size_t)row * ldh + hc) = pack8(o[0], o[1]);
                if (m == 3) asm volatile("" ::: "memory");
            } }
    }
};
template <bool RSTD, bool W32 = true> struct EpiSwiGLU8 {
    unsigned char* H; int ldh; const float* rs;
    __device__ __forceinline__ void operator()(const f32x4 (&acc)[2][2][4][2], const Unit& u, int wr, int wc, int fr, int fq) const {
        const int row0 = u.om * BM + wr * 64 + fr, hc = u.on * HALF + wc * 32 + 8 * fq;
#pragma unroll
        for (int ai = 0; ai < 2; ++ai)
#pragma unroll
            for (int m = 0; m < 4; ++m) {
                const int row = row0 + ai * HALF + m * 16;
                float sc = W32 ? 0.03125f : 1.f; if constexpr (RSTD) sc *= row_rstd(rs, row);
                f32x4 o[2];
#pragma unroll
                for (int n = 0; n < 2; ++n)
#pragma unroll
                    for (int j = 0; j < 4; ++j) { const float gv = acc[ai][0][m][n][j] * sc, uv = acc[ai][1][m][n][j] * sc; o[n][j] = gv * fsigmoid(gv) * uv; }
                u32x2 w; w.x = cvt_pk4_fp8(o[0][0], o[0][1], o[0][2], o[0][3]); w.y = cvt_pk4_fp8(o[1][0], o[1][1], o[1][2], o[1][3]);
                *(u32x2*)(H + (size_t)row * ldh + hc) = w;
                if (m == 3) asm volatile("" ::: "memory");
            }
    }
};
struct EpiPlain {
    bf16_t* O; int ldc; float sc;
    __device__ __forceinline__ void operator()(const f32x4 (&acc)[2][2][4][2], const Unit& u, int wr, int wc, int fr, int fq) const {
        const int row0 = u.om * BM + wr * 64 + fr, colt = u.on * BM, cw = wc * 32 + 8 * fq;
#pragma unroll
        for (int ai = 0; ai < 2; ++ai)
#pragma unroll
            for (int m = 0; m < 4; ++m) { const int row = row0 + ai * HALF + m * 16;
#pragma unroll
                for (int bj = 0; bj < 2; ++bj) { const f32x4 a0 = acc[ai][bj][m][0] * sc, a1 = acc[ai][bj][m][1] * sc; u32x2 q; q.x = cvt_pk4_fp8(a0[0], a0[1], a0[2], a0[3]); q.y = cvt_pk4_fp8(a1[0], a1[1], a1[2], a1[3]);
                    *(u32x2*)((unsigned char*)O + (size_t)row * ldc + colt + bj * HALF + cw) = q; } }
    }
};
}

#define XB_TMO      128
#define XB_XCNT(j)  (256  + 64 * (j))
#define XB_XSUB(j)  (1280 + 64 * (j))
#define XB_XGEN(j)  (2304 + 64 * (j))
#define XB_TOP      3328
#define XB_TOPGEN   3392
#define XCD_BAR_WORDS 3456
#define XB_SPIN_CAP (1u << 18)
__device__ __forceinline__ unsigned xb_ld(unsigned* p)              { return __hip_atomic_load(p, __ATOMIC_RELAXED, __HIP_MEMORY_SCOPE_AGENT); }
__device__ __forceinline__ unsigned xb_add(unsigned* p, unsigned v) { return __hip_atomic_fetch_add(p, v, __ATOMIC_RELAXED, __HIP_MEMORY_SCOPE_AGENT); }
__device__ __forceinline__ unsigned xb_xcc_id() { return (unsigned)__builtin_amdgcn_s_getreg((3 << 11) | 20) & 0xFu; }
#define XB_SPIN(cond, bar) do { unsigned _sp = 0; while (cond) { __builtin_amdgcn_s_sleep(1); \
    if ((++_sp & 255u) == 0u) { if (xb_ld(&(bar)[XB_TMO])) break; if (_sp > XB_SPIN_CAP) { atomicAdd(&(bar)[XB_TMO], 1u); break; } } } } while (0)
struct XcdBarrier { unsigned* bar; unsigned x; volatile LAS unsigned* st; };
__device__ __forceinline__ XcdBarrier xcd_barrier_post(unsigned* bar, volatile LAS unsigned* st) {
    XcdBarrier b; b.bar = bar; b.x = xb_xcc_id(); b.st = st;
    if (threadIdx.x == 0) (void)xb_add(&bar[XB_XCNT(b.x)], 1u);
    return b;
}
__device__ __forceinline__ void xcd_barrier_complete(unsigned* bar, unsigned x, unsigned& nloc, unsigned& nx) {
    const unsigned G = gridDim.x * gridDim.y * gridDim.z;
    unsigned sum, cnt, mine, sp = 0u;
    for (;;) {
        sum = 0u; cnt = 0u; mine = 0u;
#pragma unroll
        for (unsigned j = 0; j < 16; ++j) { const unsigned c = xb_ld(&bar[XB_XCNT(j)]); sum += c; cnt += (c > 0u) ? 1u : 0u; mine = (j == x) ? c : mine; }
        if (sum == G) break;
        __builtin_amdgcn_s_sleep(1);
        if ((++sp & 255u) == 0u) { if (xb_ld(&bar[XB_TMO])) break; if (sp > XB_SPIN_CAP) { atomicAdd(&bar[XB_TMO], 1u); break; } }
    }
    nloc = mine > 0u ? mine : 1u; nx = cnt > 0u ? cnt : 1u;
}
__device__ __forceinline__ void xcd_barrier(const XcdBarrier& b) {
    asm volatile("s_waitcnt vmcnt(0)" ::: "memory");
    __syncthreads();
    if (threadIdx.x == 0) {
        unsigned* bar = b.bar;
        __builtin_amdgcn_s_waitcnt(0);
        unsigned nloc = b.st[0], nx = b.st[1];
        if (nloc == 0u) { xcd_barrier_complete(bar, b.x, nloc, nx); b.st[0] = nloc; b.st[1] = nx; }
        const unsigned old = xb_add(&bar[XB_XSUB(b.x)], 1u);
        const unsigned gen = old / nloc;
        if (old + 1u == (gen + 1u) * nloc) {
            __builtin_amdgcn_fence(__ATOMIC_RELEASE, "agent");
            asm volatile("s_waitcnt vmcnt(0)" ::: "memory");
            const unsigned og = xb_add(&bar[XB_TOP], 1u);
            const unsigned tg = og / nx;
            if (og + 1u == (tg + 1u) * nx) xb_add(&bar[XB_TOPGEN], 1u);
            else XB_SPIN(xb_ld(&bar[XB_TOPGEN]) == tg, bar);
            __builtin_amdgcn_fence(__ATOMIC_ACQUIRE, "agent");
            xb_add(&bar[XB_XGEN(b.x)], 1u);
            asm volatile("s_waitcnt vmcnt(0)" ::: "memory");
        } else {
            XB_SPIN(xb_ld(&bar[XB_XGEN(b.x)]) == gen, bar);
            __builtin_amdgcn_fence(__ATOMIC_ACQUIRE, "agent");
            asm volatile("s_waitcnt vmcnt(0)" ::: "memory");
        }
    }
    __syncthreads();
}

struct Args { const void* in[55]; float* out; unsigned char* ws; int ph_lo, ph_hi, submask, pad; };
struct Frame {
    LAS unsigned char* lds; unsigned char* ws; unsigned* ctl; float* out;
    int tid, lane, wave, G, bid, gw, ngw;
};
#define GAS __attribute__((address_space(1)))
#define CAS __attribute__((address_space(4)))
#define PHASE_BEGIN() const CAS char* kp_ = (const CAS char*)__builtin_amdgcn_kernarg_segment_ptr(); asm volatile("" : "+s"(kp_)); \
    unsigned char* ws = (unsigned char*)(GAS unsigned char*)(*(const CAS unsigned long long*)(kp_ + 448)); \
    Frame F; { int t_ = threadIdx.x; asm volatile("" : "+v"(t_)); int b_ = blockIdx.x; asm volatile("" : "+s"(b_)); \
      F.lds = (LAS unsigned char*)lds_raw; F.ws = ws; F.ctl = (unsigned*)(ws + WS_CTL); F.out = (float*)(GAS float*)(*(const CAS unsigned long long*)(kp_ + 440)); \
      F.tid = t_; F.lane = t_ & 63; F.wave = __builtin_amdgcn_readfirstlane(t_ >> 6); F.G = gridDim.x; F.bid = b_; F.gw = b_ * 8 + F.wave; F.ngw = F.G * 8; }
#define XB ((bf16_t*)(ws + WS_XB))
#define RS ((float*)(ws + WS_RSP))
#define ZS ((bf16_t*)(ws + WS_ZS))
#define ZG ((bf16_t*)(ws + WS_ZG))
#define YB ((bf16_t*)(ws + WS_Y))
#define MG ((bf16_t*)(ws + WS_MERGED))
#define S5T ((float*)(ws + WS_TAB + TAB_S5T))
#define CMAT ((bf16_t*)(ws + WS_TAB + TAB_CMAT))
#define MISCT ((float*)(ws + WS_TAB + TAB_MISC))
#define BBF ((bf16_t*)(ws + WS_TAB + 832 * 1024))
#define WLP(l) (ws + WS_WL + (size_t)(l) * WL_STRIDE)
#define INF(i) ((const float*)(const GAS float*)(*(const CAS unsigned long long*)(kp_ + 8 * (i))))

struct TJob { const float* W; bf16_t* WT; const float* ks; int K, N, ldw, ldk, nb, map; size_t sstride, dstride; int f8; };
__device__ __forceinline__ int tjob_items(const TJob& j) { return j.nb * (j.K / 64) * (j.N / 32); }
__device__ __forceinline__ void tjob_load(const TJob& j, int item, float (&v)[32], int lane) {
    const int per = (j.K / 64) * (j.N / 32), b = item / per, r = item % per, nblk = j.N / 32, kb = r / nblk, nbk = r % nblk, k0 = 64 * kb, n0 = 32 * nbk;
    const float* W = j.W + (size_t)b * j.sstride + (size_t)(k0 + (lane >> 5)) * j.ldw + n0 + (lane & 31);
#pragma unroll
    for (int i = 0; i < 32; ++i) v[i] = __builtin_nontemporal_load(W + (size_t)(2 * i) * j.ldw);
}
__device__ __forceinline__ void tjob_store(const TJob& j, int item, float (&v)[32], LAS float* scr, int lane) {
    const int per = (j.K / 64) * (j.N / 32), b = item / per, r = item % per, nblk = j.N / 32, kb = r / nblk, nbk = r % nblk, k0 = 64 * kb, n0 = 32 * nbk;
    int drow = n0;
    if (j.map == 1) drow = n0 < C_END ? n0 : n0 + (ZSW - C_END);
    else if (j.map == 2) drow = 256 * (n0 >> 7) + (n0 & 127);
    else if (j.map == 3) drow = 256 * (n0 >> 7) + 128 + (n0 & 127);
    if (j.ks) {
#pragma unroll
        for (int i = 0; i < 32; ++i) v[i] *= j.ks[k0 + 2 * i + (lane >> 5)]; }
#pragma unroll
    for (int i = 0; i < 32; ++i) scr[(2 * i + (lane >> 5)) * 33 + (lane & 31)] = v[i];
    asm volatile("s_waitcnt lgkmcnt(0)" ::: "memory");
    const int c = lane & 7; bf16_t* WT = j.WT + (size_t)b * j.dstride;
    if (j.f8) { unsigned char* W8 = (unsigned char*)j.WT + (size_t)b * j.dstride;
#pragma unroll
        for (int q = 0; q < 4; ++q) { const int n = (lane >> 3) + 8 * q; const LAS float* sp = scr + (8 * c) * 33 + n;
            u32x2 o; o.x = cvt_pk4_fp8(sp[0 * 33] * 32.f, sp[1 * 33] * 32.f, sp[2 * 33] * 32.f, sp[3 * 33] * 32.f); o.y = cvt_pk4_fp8(sp[4 * 33] * 32.f, sp[5 * 33] * 32.f, sp[6 * 33] * 32.f, sp[7 * 33] * 32.f);
            *(u32x2*)(W8 + (size_t)(drow + n) * j.ldk + k0 + 8 * c) = o; }
    } else
#pragma unroll
    for (int q = 0; q < 4; ++q) { const int n = (lane >> 3) + 8 * q; const LAS float* sp = scr + (8 * c) * 33 + n;
        u32x4 o; o.x = cvt_pk_bf16(sp[0 * 33], sp[1 * 33]); o.y = cvt_pk_bf16(sp[2 * 33], sp[3 * 33]); o.z = cvt_pk_bf16(sp[4 * 33], sp[5 * 33]); o.w = cvt_pk_bf16(sp[6 * 33], sp[7 * 33]);
        *(u32x4*)(WT + (size_t)(drow + n) * j.ldk + k0 + 8 * c) = o; }
    asm volatile("s_waitcnt lgkmcnt(0)" ::: "memory");
}
__device__ __forceinline__ void tjob_run_all(const TJob& j, int first, int stride, LAS float* scr, int lane) {
    const int ni = tjob_items(j); int it = first; if (it >= ni) return;
    float va[32], vb[32]; tjob_load(j, it, va, lane);
    for (;;) {
        const int n1 = it + stride; if (n1 < ni) tjob_load(j, n1, vb, lane);
        tjob_store(j, it, va, scr, lane); if (n1 >= ni) break;
        const int n2 = n1 + stride; if (n2 < ni) tjob_load(j, n2, va, lane);
        tjob_store(j, n1, vb, scr, lane); if (n2 >= ni) break;
        it = n2;
    }
}

template <int DQ> struct AttnLds { static constexpr int KROW = DQ * 2 + 16, VROW = 272, KBYTES = 128 * KROW, VBYTES = 64 * VROW, BUF = KBYTES + VBYTES; };
#define PK4(P, BASE, OUT) do { unsigned a0_ = cvt_pk_bf16(P[BASE + 0], P[BASE + 1]), a1_ = cvt_pk_bf16(P[BASE + 2], P[BASE + 3]); \
    unsigned b0_ = cvt_pk_bf16(P[BASE + 4], P[BASE + 5]), b1_ = cvt_pk_bf16(P[BASE + 6], P[BASE + 7]); \
    auto r0_ = __builtin_amdgcn_permlane32_swap(a0_, b0_, false, false); auto r1_ = __builtin_amdgcn_permlane32_swap(a1_, b1_, false, false); \
    u32x4 w_ = {r0_[0], r1_[0], r0_[1], r1_[1]}; OUT = *(bf16x8*)&w_; } while (0)

template <int DQ, int NMAP, bool CAUSAL, bool BIAS, bool QNORM>
__device__ __forceinline__ void attn_unit(LAS unsigned char* lds, const bf16_t* Qp, int ldq, const bf16_t* Kp, const bf16_t* Vtp, int vstride, int nkt, int q0,
                                          const LAS float* lut, const float* qg, float qscale, float mshift, f32x16 (&o)[NMAP][2], float (&l)[NMAP]) {
    typedef AttnLds<DQ> L; constexpr int KD = DQ / NMAP, KS = KD / 16, KCH = DQ / 8, NKC = 64 * KCH;
    int tid = threadIdx.x; asm volatile("" : "+v"(tid));
    const int wid = tid >> 6, lane = tid & 63, r32 = lane & 31, hi = lane >> 5;
    bf16x8 q[NMAP][KS];
    {
        const bf16_t* qrow = Qp + (size_t)(wid * 32 + r32) * ldq + hi * 8;
#pragma unroll
        for (int mp = 0; mp < NMAP; ++mp)
#pragma unroll
            for (int ks = 0; ks < KS; ++ks) q[mp][ks] = ldg8(qrow + mp * KD + ks * 16);
        if constexpr (QNORM) {
            float ss = 0.f;
#pragma unroll
            for (int ks = 0; ks < KS; ++ks) ss += sq8(q[0][ks]);
            ss += __shfl_xor(ss, 32);
            const float rs = frsq(ss * (1.f / DQ) + EPS) * qscale;
#pragma unroll
            for (int ks = 0; ks < KS; ++ks) { u32x4 w = *(u32x4*)&q[0][ks]; const float* gp = qg + ks * 16 + hi * 8;
                w.x = cvt_pk_bf16(bflo(w.x) * rs * gp[0], bfhi(w.x) * rs * gp[1]); w.y = cvt_pk_bf16(bflo(w.y) * rs * gp[2], bfhi(w.y) * rs * gp[3]);
                w.z = cvt_pk_bf16(bflo(w.z) * rs * gp[4], bfhi(w.z) * rs * gp[5]); w.w = cvt_pk_bf16(bflo(w.w) * rs * gp[6], bfhi(w.w) * rs * gp[7]);
                q[0][ks] = *(bf16x8*)&w; }
        }
    }
#pragma unroll
    for (int mp = 0; mp < NMAP; ++mp) { l[mp] = 0.f; o[mp][0] = f32x16{}; o[mp][1] = f32x16{}; }
    constexpr int NKI = (128 * KCH) / 512;
    bf16x8 skr[NKI], svr[2];
#define AT_LOAD(j) do { const int key0_ = (j) * 128; \
        _Pragma("unroll") for (int i_ = 0; i_ < NKI; ++i_) { const int c_ = tid + 512 * i_; skr[i_] = ldg8(Kp + (size_t)(key0_ + c_ / KCH) * DQ + (c_ % KCH) * 8); } \
        _Pragma("unroll") for (int i_ = 0; i_ < 2; ++i_) { const int c_ = tid + 512 * i_; svr[i_] = ldg8(Vtp + (size_t)(c_ >> 4) * vstride + key0_ + (c_ & 15) * 8); } } while (0)
#define AT_WRITE(b) do { LAS unsigned char* base_ = lds + (b) * L::BUF; \
        _Pragma("unroll") for (int i_ = 0; i_ < NKI; ++i_) { const int c_ = tid + 512 * i_; *(LAS bf16x8*)(base_ + (c_ / KCH) * L::KROW + (c_ % KCH) * 16) = skr[i_]; } \
        _Pragma("unroll") for (int i_ = 0; i_ < 2; ++i_) { const int c_ = tid + 512 * i_; *(LAS bf16x8*)(base_ + L::KBYTES + (c_ >> 4) * L::VROW + (c_ & 15) * 16) = svr[i_]; } } while (0)
    const int qi = q0 + wid * 32 + r32;
    const int qlo = q0 + wid * 32;
#define AT_COMPUTE(key0, bf, sb) do { const bool active = !CAUSAL || (key0) <= qlo + 31; \
        if (active) { const LAS unsigned char* kb = lds + (bf) * L::BUF + (sb) * 64 * L::KROW; const LAS unsigned char* vb = lds + (bf) * L::BUF + L::KBYTES + (sb) * 128; const bool need_mask = CAUSAL && ((key0) + 63 > qlo); \
            _Pragma("unroll") for (int mp = 0; mp < NMAP; ++mp) { f32x16 p0 = f32x16{}, p1 = f32x16{}; \
                _Pragma("unroll") for (int ks = 0; ks < KS; ++ks) { \
                    const bf16x8 a0 = *(const LAS bf16x8*)(kb + r32 * L::KROW + (mp * KD + ks * 16 + hi * 8) * 2); \
                    const bf16x8 a1 = *(const LAS bf16x8*)(kb + (32 + r32) * L::KROW + (mp * KD + ks * 16 + hi * 8) * 2); \
                    p0 = MFMA32(a0, q[mp][ks], p0); p1 = MFMA32(a1, q[mp][ks], p1); } \
                __builtin_amdgcn_sched_barrier(0); \
                float sh = mshift; \
                if constexpr (BIAS) { \
                    if (qlo - ((key0) + 63) >= 127) sh -= lut[255]; \
                    else { const LAS float* lp = lut + (qi - (key0) - 4 * hi + 69); \
                        _Pragma("unroll") for (int r = 0; r < 16; ++r) { const int cr = (r & 3) + 8 * (r >> 2); p0[r] += lp[59 - cr]; p1[r] += lp[27 - cr]; } } } \
                if (need_mask) { _Pragma("unroll") for (int r = 0; r < 16; ++r) { const int kk = (key0) + crow(r, hi); if (kk > qi) p0[r] = -1e30f; if (kk + 32 > qi) p1[r] = -1e30f; } } \
                float ps = 0.f; \
                _Pragma("unroll") for (int r = 0; r < 16; ++r) { p0[r] = fexp2(p0[r] - sh); p1[r] = fexp2(p1[r] - sh); ps += p0[r] + p1[r]; } \
                l[mp] += ps; \
                __builtin_amdgcn_sched_barrier(0); \
                bf16x8 pa0, pa1, pa2, pa3; \
                PK4(p0, 0, pa0); PK4(p0, 8, pa1); PK4(p1, 0, pa2); PK4(p1, 8, pa3); \
                _Pragma("unroll") for (int dt = 0; dt < 2; ++dt) { \
                    const LAS unsigned char* vrow = vb + (dt * 32 + r32) * L::VROW + hi * 16; \
                    const bf16x8 v0 = *(const LAS bf16x8*)(vrow), v1 = *(const LAS bf16x8*)(vrow + 32), v2 = *(const LAS bf16x8*)(vrow + 64), v3 = *(const LAS bf16x8*)(vrow + 96); \
                    o[mp][dt] = MFMA32(v0, pa0, o[mp][dt]); o[mp][dt] = MFMA32(v1, pa1, o[mp][dt]); o[mp][dt] = MFMA32(v2, pa2, o[mp][dt]); o[mp][dt] = MFMA32(v3, pa3, o[mp][dt]); } \
                __builtin_amdgcn_sched_barrier(0); } } } while (0)
    const int n128 = nkt >> 1;
    if (wid < 4) __builtin_amdgcn_s_setprio(2);
    AT_LOAD(0); AT_WRITE(0); __syncthreads();
    for (int j = 0; j < n128; ++j) {
        if (j + 1 < n128) AT_LOAD(j + 1);
        AT_COMPUTE(j * 128, j & 1, 0);
        AT_COMPUTE(j * 128 + 64, j & 1, 1);
        if (j + 1 < n128) AT_WRITE((j + 1) & 1);
        __syncthreads();
    }
    __builtin_amdgcn_s_setprio(0);
#undef AT_COMPUTE
#pragma unroll
    for (int mp = 0; mp < NMAP; ++mp) l[mp] += __shfl_xor(l[mp], 32);
#undef AT_LOAD
#undef AT_WRITE
}

__device__ __forceinline__ void attn_store(bf16_t* dst, const f32x16 (&o)[2], float scale, int hi) {
#pragma unroll
    for (int dt = 0; dt < 2; ++dt)
#pragma unroll
        for (int rg = 0; rg < 4; ++rg) { u32x2 w; w.x = cvt_pk_bf16(o[dt][4 * rg] * scale, o[dt][4 * rg + 1] * scale); w.y = cvt_pk_bf16(o[dt][4 * rg + 2] * scale, o[dt][4 * rg + 3] * scale);
            *(u32x2*)(dst + dt * 32 + 8 * rg + 4 * hi) = w; }
}

__device__ __forceinline__ bool in_phase(int k) { const __attribute__((address_space(4))) int* p_ = (const __attribute__((address_space(4))) int*)__builtin_amdgcn_kernarg_segment_ptr(); asm volatile("" : "+s"(p_)); return p_[114] <= k && k < p_[115]; }
__device__ __forceinline__ bool sub_on(int k) { const __attribute__((address_space(4))) int* p_ = (const __attribute__((address_space(4))) int*)__builtin_amdgcn_kernarg_segment_ptr(); asm volatile("" : "+s"(p_)); return (p_[116] >> k) & 1; }
__device__ __forceinline__ void s5_bu_tile(LAS unsigned char* tile, const bf16_t* bbf_g, const bf16_t* zs_tok0, int lane) {
    const int r32 = lane & 31, hi = lane >> 5;
    const bf16x8 uf = ldg8(zs_tok0 + (size_t)r32 * ZSW + 8 * hi);
#pragma unroll
    for (int pt = 0; pt < 4; ++pt) { f32x16 d = f32x16{}; d = MFMA32(ldg8(bbf_g + (size_t)(32 * pt + r32) * 16 + 8 * hi), uf, d);
#pragma unroll
        for (int rg = 0; rg < 4; ++rg) { u32x2 w; w.x = cvt_pk_bf16(d[4 * rg], d[4 * rg + 1]); w.y = cvt_pk_bf16(d[4 * rg + 2], d[4 * rg + 3]);
            *(LAS u32x2*)(tile + r32 * 272 + (32 * pt + 8 * rg + 4 * hi) * 2) = w; } }
    asm volatile("s_waitcnt lgkmcnt(0)" ::: "memory");
}
__device__ __forceinline__ int h0_pull(LAS unsigned* qc, int lane, int wg_items, int bid, int G, int total) {
    unsigned k = 0u; if (lane == 0) k = __hip_atomic_fetch_add(qc, 1u, __ATOMIC_RELAXED, __HIP_MEMORY_SCOPE_WORKGROUP);
    const int kk = __builtin_amdgcn_readfirstlane((int)k);
    return kk < wg_items ? bid + kk * G : total;
}
__device__ __forceinline__ int queue_pull(unsigned* ctr, volatile LAS unsigned* slot, int tid) {
    __syncthreads();
    if (tid == 0) *slot = __hip_atomic_fetch_add(ctr, 1u, __ATOMIC_RELAXED, __HIP_MEMORY_SCOPE_AGENT);
    __syncthreads();
    return (int)*slot;
}
constexpr int NPHASE = 24;
#ifndef DBG_NPH
#endif
__global__ void __launch_bounds__(512, 2) hybrid_fwd(Args args) {
    extern __shared__ __attribute__((aligned(16))) unsigned char lds_raw[];
    LAS unsigned char* lds0 = (LAS unsigned char*)lds_raw;
    volatile LAS unsigned* MISC = (volatile LAS unsigned*)(lds0 + MISC_OFF);
    for (int u = threadIdx.x; u < (LDS_BYTES - RING_BYTES) / 4; u += 512) ((LAS unsigned*)(lds0 + RING_BYTES))[u] = 0u;
    __syncthreads();
    const int lo = args.ph_lo, hi_ph = args.ph_hi;
    const bool one_launch = (hi_ph - lo) > 1;
    XcdBarrier bar; bar.bar = (unsigned*)(args.ws + WS_CTL) + CW_BAR; bar.x = 0; bar.st = nullptr;
    if (one_launch) bar = xcd_barrier_post((unsigned*)(args.ws + WS_CTL) + CW_BAR, MISC + 8);
#ifndef SUBMASK
#define SUBMASK 0xFFFFu
#endif
#define SUB(k) ((((SUBMASK) >> (k)) & 1u) && sub_on(k))
#ifndef PHMASK
#define PHMASK 0xFFFFFFu
#endif
#define IN(k) ((((PHMASK) >> (k)) & 1u) && in_phase(k))
#define SEAM(k) do { if (IN(k) && IN((k) + 1)) { XcdBarrier b2_ = bar; asm volatile("" : "+s"(b2_.bar), "+s"(b2_.x)); xcd_barrier(b2_); } } while (0)

    if (IN(0)) { PHASE_BEGIN();
        LAS float* scr = (LAS float*)(F.lds + F.wave * 16384);
        int joff = 0;
        for (int l = 0; l < 2; ++l) {
            unsigned char* wl = ws + WS_WL + l * WL_STRIDE;
#define RUNJOB(...) do { const TJob jb_ = TJob{__VA_ARGS__}; int fst_ = F.gw - joff; if (fst_ < 0) fst_ += F.ngw; tjob_run_all(jb_, fst_, F.ngw, scr, F.lane); joff = (joff + tjob_items(jb_)) % F.ngw; } while (0)
            RUNJOB(INF(8) + (size_t)l * DM * DIN, (bf16_t*)(wl + WL_WIN), INF(4) + l * DM, DM, ((GATE_FP8 >> l) & 1) ? C_END : DIN, DIN, DM, 1, 1, 0, 0);
            if ((GATE_FP8 >> l) & 1) RUNJOB(INF(8) + (size_t)l * DM * DIN + C_END, (bf16_t*)(ws + WS_WG8 + (size_t)l * 4 * MiB), INF(4) + l * DM, DM, ZGW, DIN, DM, 1, 0, 0, 0, 1);
            RUNJOB(INF(22) + (size_t)l * 192 * 384, (bf16_t*)(wl + WL_SM + SM_WUQ), INF(20) + l * 192, 192, 384, 384, 192, 1, 0, 0, 0);
            RUNJOB(INF(23) + (size_t)l * 128 * 512, (bf16_t*)(wl + WL_SM + SM_WUKV), INF(21) + l * 128, 128, 512, 512, 128, 1, 0, 0, 0);
            RUNJOB(INF(28) + (size_t)l * 4 * 4096, (bf16_t*)(wl + WL_SM + SM_WR), nullptr, 64, 64, 64, 64, 4, 0, 4096, 4096);
            RUNJOB(INF(30) + (size_t)l * 4 * 4096, (bf16_t*)(wl + WL_SM + SM_WI), nullptr, 64, 64, 64, 64, 4, 0, 4096, 4096);
            RUNJOB(INF(18) + (size_t)l * 65536, (bf16_t*)(wl + WL_SM + SM_WGLU), nullptr, 256, 256, 256, 256, 1, 0, 0, 0);
            RUNJOB(INF(40) + (size_t)l * 4 * 256 * DM, (bf16_t*)(wl + WL_PT), nullptr, 256, DM, DM, 256, 4, 0, (size_t)256 * DM, (size_t)DM * 256);
            RUNJOB(INF(41) + (size_t)l * DM * DM, (bf16_t*)(wl + WL_WO), nullptr, DM, DM, DM, DM, 1, 0, 0, 0);
            RUNJOB(INF(42) + (size_t)l * DM * 256, (bf16_t*)(wl + WL_WXQ), INF(5) + l * DM, DM, 256, 256, DM, 1, 0, 0, 0);
            RUNJOB(INF(43) + (size_t)l * DM * 256, (bf16_t*)(wl + WL_WXKV), INF(6) + l * DM, DM, 256, 256, DM, 1, 0, 0, 0);
            RUNJOB(INF(44) + (size_t)l * DM * 256, (bf16_t*)(wl + WL_WXKV) + (size_t)256 * DM, INF(6) + l * DM, DM, 256, 256, DM, 1, 0, 0, 0);
            RUNJOB(INF(45) + (size_t)l * 256 * DM, (bf16_t*)(wl + WL_WXO), nullptr, 256, DM, DM, 256, 1, 0, 0, 0);
            { u32x4* z = (u32x4*)((bf16_t*)(wl + WL_WIN) + (size_t)C_END * DM); const int n16 = (ZSW - C_END) * DM * 2 / 16;
              for (int i = F.bid * 512 + F.tid; i < n16; i += F.G * 512) z[i] = (u32x4){0u, 0u, 0u, 0u}; }
        }
        {
            RUNJOB(INF(48), (bf16_t*)(ws + WS_WGU), INF(7), DM, FF, FF, DM, 1, 2, 0, 0);
            RUNJOB(INF(49), (bf16_t*)(ws + WS_WGU), INF(7), DM, FF, FF, DM, 1, 3, 0, 0);
            RUNJOB(INF(50), (bf16_t*)(ws + WS_WD), nullptr, FF, DM, DM, FF, 1, 0, 0, 0, G2_FP8);
        }
        for (int i = F.bid * 512 + F.tid; i < 2 * 16 * 64; i += F.G * 512) {
            const int l = i >> 10, g = (i >> 6) & 15, p = i & 63;
            const float dt = __expf(INF(12)[l * 16 + g]);
            const float lr = INF(10)[(l * 16 + g) * 64 + p], li = INF(11)[(l * 16 + g) * 64 + p];
            const float mag = __expf(lr * dt); float sn, cs; sincos_red(li * dt, sn, cs);
            const float ar = mag * cs, ai = mag * sn, den = lr * lr + li * li;
            const float zr = ((ar - 1.f) * lr + ai * li) / den, zi = (ai * lr - (ar - 1.f) * li) / den;
            float* tb = S5T + (size_t)(l * 16 + g) * 36 * 64;
            for (int c = 0; c < 16; ++c) { const float br = INF(13)[((l * 16 + g) * 64 + p) * 16 + c], bi = INF(14)[((l * 16 + g) * 64 + p) * 16 + c];
                tb[c * 64 + p] = zr * br - zi * bi; tb[(16 + c) * 64 + p] = zr * bi + zi * br;
                BBF[((size_t)(l * 16 + g) * 128 + p) * 16 + c] = f2bf(zr * br - zi * bi); BBF[((size_t)(l * 16 + g) * 128 + 64 + p) * 16 + c] = f2bf(zr * bi + zi * br); }
            tb[32 * 64 + p] = ar; tb[33 * 64 + p] = ai;
            float pr = ar, pi = ai;
            for (int s = 0; s < 6; ++s) { const float nr = pr * pr - pi * pi, ni = 2.f * pr * pi; pr = nr; pi = ni; }
            tb[34 * 64 + p] = pr; tb[35 * 64 + p] = pi;
            bf16_t* cm = CMAT + (size_t)(l * 16 + g) * 16 * 128;
            for (int c = 0; c < 16; ++c) { cm[c * 128 + p] = f2bf(INF(15)[((l * 16 + g) * 16 + c) * 64 + p]); cm[c * 128 + 64 + p] = f2bf(-INF(16)[((l * 16 + g) * 16 + c) * 64 + p]); }
        }
        for (int i = F.bid * 512 + F.tid; i < 512; i += F.G * 512) { const float lam = INF(32)[i]; MISCT[i] = 8.f * log1pf(__expf(-lam)); }
        if (F.bid == 0 && F.tid < 2) { const int l = F.tid; float s1 = 0.f, s2 = 0.f;
            for (int d = 0; d < 32; ++d) { s1 += INF(35)[l * 32 + d] * INF(36)[l * 32 + d]; s2 += INF(37)[l * 32 + d] * INF(38)[l * 32 + d]; }
            const float lam_init = 0.8f - 0.6f * expf(-0.3f * (float)l);
            MISCT[512 + l] = expf(s1) - expf(s2) + lam_init; MISCT[514 + l] = lam_init;
            float gq = 0.f, gk = 0.f; for (int d = 0; d < 96; ++d) { gq = fmaxf(gq, fabsf(INF(24)[l * 96 + d])); gk = fmaxf(gk, fabsf(INF(25)[l * 96 + d])); }
            MISCT[516 + l * 4 + 0] = 1.02f * gq * gk * 9.797958971f * LOG2E;
            gq = 0.f; gk = 0.f; for (int d = 0; d < 32; ++d) { gq = fmaxf(gq, fabsf(INF(33)[l * 32 + d])); gk = fmaxf(gk, fabsf(INF(34)[l * 32 + d])); }
            float bm = 0.f; for (int i = 0; i < 128; ++i) bm = fmaxf(bm, fabsf(INF(3)[i]));
            MISCT[516 + l * 4 + 1] = 1.02f * gq * gk * 5.656854249f * LOG2E + bm * LOG2E;
            gq = 0.f; gk = 0.f; for (int d = 0; d < 64; ++d) { gq = fmaxf(gq, fabsf(INF(46)[l * 64 + d])); gk = fmaxf(gk, fabsf(INF(47)[l * 64 + d])); }
            MISCT[516 + l * 4 + 2] = 1.02f * gq * gk * 8.f * LOG2E; }
        for (int i = F.bid * 512 + F.tid; i < 4 * 384; i += F.G * 512) { const int h = i / 384, dd = i % 384 - 128, d = dd > 127 ? 127 : dd; int bk;
            if (d < 16) bk = d < 0 ? 0 : d; else { const float lr_ = logf((float)d / 16.f) / logf(8.f); bk = 16 + (int)(lr_ * 16.f); if (bk > 31) bk = 31; }
            MISCT[1024 + i] = dd < 0 ? 0.f : INF(3)[bk * 4 + h] * LOG2E; }
        for (int m = F.gw; m < MTOK; m += F.ngw) {
            const f32x4* xr = (const f32x4*)(INF(0) + (size_t)m * DM) + F.lane; float s = 0.f;
            u32x2* o8 = (u32x2*)(XB + (size_t)m * DM) + F.lane;
#pragma unroll
            for (int j = 0; j < 4; ++j) { const f32x4 v = __builtin_nontemporal_load(xr + 64 * j); s += (v.x * v.x + v.y * v.y) + (v.z * v.z + v.w * v.w); u32x2 w; w.x = cvt_pk_bf16(v.x, v.y); w.y = cvt_pk_bf16(v.z, v.w); o8[64 * j] = w;
                if (GATE_FP8 & 1) ((unsigned*)(ws + WS_X8 + (size_t)m * DM))[64 * j + F.lane] = cvt_pk4_fp8(v.x, v.y, v.z, v.w); }
            s = wave_sum(s); if (F.lane < 16) RS[(size_t)m * 16 + F.lane] = F.lane == 0 ? s : 0.f;
        }
    }
    SEAM(0);

    for (int l = 0; l < 2; ++l) {
        const int pb = 1 + 10 * l;
        if (IN(pb + 0)) { PHASE_BEGIN();
            const bool g8 = (GATE_FP8 >> l) & 1;
            pg8::Gemm g{XB, (const bf16_t*)(WLP(l) + WL_WIN), DM, nullptr}; pg8::StaticOrder S; S.init(MTOK / 256, g8 ? ZSW / 256 : NIN / 256, F.G, F.bid);
            pg8::EpiIn E{ZS, ZG, RS + (size_t)(l == 0 ? 0 : 3) * MTOK * 16, INF(9) + (size_t)l * 4 * DM};
            pg8::gemm_phase<pg8::EpiIn, pg8::StaticOrder, true, false>(F.lds, g, S, E);
            if (GATE_FP8 != 0 && g8) {
                pg8::Gemm g2{(const bf16_t*)(ws + WS_X8), (const bf16_t*)(ws + WS_WG8 + (size_t)l * 4 * MiB), DM / 2, nullptr}; pg8::StaticOrder S2; S2.init(MTOK / 256, ZGW / 256, F.G, F.bid);
                pg8::EpiGate8 E2{ZG, RS + (size_t)(l == 0 ? 0 : 3) * MTOK * 16, INF(9) + (size_t)l * 4 * DM};
                pg8::gemm_phase<pg8::EpiGate8, pg8::StaticOrder, true, false, true>(F.lds, g2, S2, E2);
            }
        }
        SEAM(pb + 0);
        if (IN(pb + 1)) { PHASE_BEGIN();
            const int lane = F.lane, r = lane & 31, hi = lane >> 5;
            bf16_t* QM = (bf16_t*)(ws + WS_QM); bf16_t* KM = (bf16_t*)(ws + WS_KM); bf16_t* VMT = (bf16_t*)(ws + WS_VMT);
            if (SUB(0) && F.wave < 2) for (int tt = F.bid * 2 + F.wave; tt < 512; tt += F.G * 2) {
                const int row = tt * 32 + r, b = row >> 12, s = row & 4095;
                bf16x8 xq[12]; float ss = 0.f;
#pragma unroll
                for (int ks = 0; ks < 12; ++ks) { xq[ks] = ldg8(ZS + (size_t)row * ZSW + C_CQ + 16 * ks + 8 * hi); ss += sq8(xq[ks]); }
                ss += __shfl_xor(ss, 32); const float rc = frsq(ss * (1.f / 192.f) + EPS);
                const float pos = (float)((const int*)INF(2))[row]; float cs[8], sn[8];
#pragma unroll
                for (int i = 0; i < 8; ++i) { const int fi = crow(i, hi); const float inv = exp2f(-(float)fi * (13.287712379549449f / 16.f)); sincos_red(pos * inv, sn[i], cs[i]); }
                const bf16_t* W = (const bf16_t*)(WLP(l) + WL_SM + SM_WUQ); const float* gq = INF(24) + l * 96;
#pragma unroll 1
                for (int hd = 0; hd < 4; ++hd) {
                    f32x16 acc[3] = {f32x16{}, f32x16{}, f32x16{}};
#pragma unroll
                    for (int ft = 0; ft < 3; ++ft) {
#pragma unroll
                        for (int ks = 0; ks < 12; ++ks) acc[ft] = MFMA32(ldg8(W + (size_t)(hd * 96 + 32 * ft + r) * 192 + 16 * ks + 8 * hi), xq[ks], acc[ft]); }
                    float s2 = 0.f;
#pragma unroll
                    for (int ft = 0; ft < 3; ++ft)
#pragma unroll
                        for (int q = 0; q < 16; ++q) { acc[ft][q] *= rc; s2 += acc[ft][q] * acc[ft][q]; }
                    s2 += __shfl_xor(s2, 32); const float rq = frsq(s2 * (1.f / 96.f) + EPS);
#pragma unroll
                    for (int ft = 0; ft < 3; ++ft)
#pragma unroll
                        for (int q = 0; q < 16; ++q) acc[ft][q] *= rq * gq[32 * ft + crow(q, hi)];
#pragma unroll
                    for (int q = 0; q < 8; ++q) { const float x1 = acc[2][q], x2 = acc[2][q + 8]; acc[2][q] = x1 * cs[q] - x2 * sn[q]; acc[2][q + 8] = x1 * sn[q] + x2 * cs[q]; }
                    const float qs = 0.10206207261596577f * LOG2E;
                    bf16_t* dst = QM + ((size_t)(b * 4 + hd) * SEQ + s) * 96;
#pragma unroll
                    for (int ft = 0; ft < 3; ++ft)
#pragma unroll
                        for (int rg = 0; rg < 4; ++rg) { u32x2 w; w.x = cvt_pk_bf16(acc[ft][4 * rg] * qs, acc[ft][4 * rg + 1] * qs); w.y = cvt_pk_bf16(acc[ft][4 * rg + 2] * qs, acc[ft][4 * rg + 3] * qs);
                            *(u32x2*)(dst + 32 * ft + 8 * rg + 4 * hi) = w; }
                }
            }
            if (SUB(1) && (F.wave == 2 || F.wave == 3)) for (int tt = F.bid * 2 + F.wave - 2; tt < 512; tt += F.G * 2) {
                const int row = tt * 32 + r, b = row >> 12, s = row & 4095;
                bf16x8 xk[8]; float ss = 0.f;
#pragma unroll
                for (int ks = 0; ks < 8; ++ks) { xk[ks] = ldg8(ZS + (size_t)row * ZSW + C_CKV + 16 * ks + 8 * hi); ss += sq8(xk[ks]); }
                ss += __shfl_xor(ss, 32); const float rc = frsq(ss * (1.f / 128.f) + EPS);
                float kp[16]; float sskp = 0.f;
#pragma unroll
                for (int rg = 0; rg < 4; ++rg) { const u32x2 w = *(const u32x2*)(ZS + (size_t)row * ZSW + C_KPE + 8 * rg + 4 * hi);
                    kp[4 * rg] = bflo(w.x); kp[4 * rg + 1] = bfhi(w.x); kp[4 * rg + 2] = bflo(w.y); kp[4 * rg + 3] = bfhi(w.y); }
#pragma unroll
                for (int q = 0; q < 16; ++q) sskp += kp[q] * kp[q];
                const float pos = (float)((const int*)INF(2))[row]; float cs[8], sn[8];
#pragma unroll
                for (int i = 0; i < 8; ++i) { const int fi = crow(i, hi); const float inv = exp2f(-(float)fi * (13.287712379549449f / 16.f)); sincos_red(pos * inv, sn[i], cs[i]); }
                const bf16_t* W = (const bf16_t*)(WLP(l) + WL_SM + SM_WUKV); const float* gk = INF(25) + l * 96;
#pragma unroll 1
                for (int hd = 0; hd < 4; ++hd) {
                    f32x16 acc[4] = {f32x16{}, f32x16{}, f32x16{}, f32x16{}};
#pragma unroll
                    for (int ft = 0; ft < 4; ++ft) {
#pragma unroll
                        for (int ks = 0; ks < 8; ++ks) acc[ft] = MFMA32(ldg8(W + (size_t)(hd * 128 + 32 * ft + r) * 128 + 16 * ks + 8 * hi), xk[ks], acc[ft]); }
                    float s2 = sskp;
#pragma unroll
                    for (int ft = 0; ft < 2; ++ft)
#pragma unroll
                        for (int q = 0; q < 16; ++q) { acc[ft][q] *= rc; s2 += acc[ft][q] * acc[ft][q]; }
                    s2 += __shfl_xor(s2, 32); const float rk = frsq(s2 * (1.f / 96.f) + EPS);
                    float kr[16];
#pragma unroll
                    for (int q = 0; q < 16; ++q) kr[q] = kp[q] * rk * gk[64 + crow(q, hi)];
#pragma unroll
                    for (int q = 0; q < 8; ++q) { const float x1 = kr[q], x2 = kr[q + 8]; kr[q] = x1 * cs[q] - x2 * sn[q]; kr[q + 8] = x1 * sn[q] + x2 * cs[q]; }
                    bf16_t* dst = KM + ((size_t)(b * 4 + hd) * SEQ + s) * 96;
#pragma unroll
                    for (int ft = 0; ft < 2; ++ft)
#pragma unroll
                        for (int rg = 0; rg < 4; ++rg) { const float* gp = gk + 32 * ft + 8 * rg + 4 * hi; u32x2 w;
                            w.x = cvt_pk_bf16(acc[ft][4 * rg] * rk * gp[0], acc[ft][4 * rg + 1] * rk * gp[1]); w.y = cvt_pk_bf16(acc[ft][4 * rg + 2] * rk * gp[2], acc[ft][4 * rg + 3] * rk * gp[3]);
                            *(u32x2*)(dst + 32 * ft + 8 * rg + 4 * hi) = w; }
#pragma unroll
                    for (int rg = 0; rg < 4; ++rg) { u32x2 w; w.x = cvt_pk_bf16(kr[4 * rg], kr[4 * rg + 1]); w.y = cvt_pk_bf16(kr[4 * rg + 2], kr[4 * rg + 3]); *(u32x2*)(dst + 64 + 8 * rg + 4 * hi) = w; }
                    bf16_t* vd = VMT + (size_t)(b * 4 + hd) * 64 * SEQ + s;
#pragma unroll
                    for (int ft = 2; ft < 4; ++ft)
#pragma unroll
                        for (int q = 0; q < 16; ++q) vd[(size_t)(32 * (ft - 2) + crow(q, hi)) * SEQ] = f2bf(acc[ft][q] * rc);
                }
            }
            if (SUB(2)) {
                bf16_t* QD = (bf16_t*)(ws + WS_QD); bf16_t* KD = (bf16_t*)(ws + WS_KD); bf16_t* VDT = (bf16_t*)(ws + WS_VDT);
                const float* gqn = INF(33) + l * 32; const float* gkn = INF(34) + l * 32;
                for (int i = F.bid * 512 + F.tid; i < MTOK * 16; i += F.G * 512) {
                    const int row = i & (MTOK - 1), j = i >> 14, half = j & 1, hd = (j >> 1) & 3, isk = j >> 3;
                    const bf16_t* src = ZS + (size_t)row * ZSW + (isk ? C_KD : C_QD) + hd * 64 + half * 32;
                    bf16x8 v[4]; float ss = 0.f;
#pragma unroll
                    for (int c = 0; c < 4; ++c) { v[c] = ldg8(src + 8 * c); ss += sq8(v[c]); }
                    const float rs = frsq(ss * (1.f / 32.f) + EPS) * (isk ? 1.f : 0.17677669529663687f * LOG2E);
                    const float* gg = isk ? gkn : gqn; const int b = row >> 12, s = row & 4095;
                    bf16_t* dst = (isk ? KD : QD) + ((size_t)(b * 4 + hd) * SEQ + s) * 64 + half * 32;
#pragma unroll
                    for (int c = 0; c < 4; ++c) { u32x4 w = *(u32x4*)&v[c]; const float* gp = gg + 8 * c;
                        w.x = cvt_pk_bf16(bflo(w.x) * rs * gp[0], bfhi(w.x) * rs * gp[1]); w.y = cvt_pk_bf16(bflo(w.y) * rs * gp[2], bfhi(w.y) * rs * gp[3]);
                        w.z = cvt_pk_bf16(bflo(w.z) * rs * gp[4], bfhi(w.z) * rs * gp[5]); w.w = cvt_pk_bf16(bflo(w.w) * rs * gp[6], bfhi(w.w) * rs * gp[7]);
                        *(u32x4*)(dst + 8 * c) = w; }
                }
                for (int i = F.bid * 512 + F.tid; i < MTOK * 32; i += F.G * 512) {
                    const int row = i & (MTOK - 1), j = i >> 14, oc = j & 7, hd = j >> 3, b = row >> 12, s = row & 4095;
                    const bf16x8 v = ldg8(ZS + (size_t)row * ZSW + C_VD + hd * 64 + oc * 8);
                    bf16_t* vd = VDT + ((size_t)(b * 4 + hd) * 64 + oc * 8) * SEQ + s;
#pragma unroll
                    for (int e = 0; e < 8; ++e) vd[(size_t)e * SEQ] = (bf16_t)v[e];
                }
            }
            if (SUB(3)) {
                float* LA = (float*)(ws + WS_LA); float* LI = (float*)(ws + WS_LI); float* LSA = (float*)(ws + WS_LSUM); float* LSH = LSA + NB * 128 * 256;
                const float* cw = INF(26) + l * 4 * 256; const float* cb = INF(27) + l * 256; const float* br = INF(29) + l * 256; const float* bi = INF(31) + l * 256;
                const float* c8 = MISCT + l * 256;
                LAS float* lsa = (LAS float*)(F.lds + F.wave * 16384); LAS float* lsh = lsa + 32 * 64;
                for (int tk = F.gw; tk < NB * 128 * 4; tk += F.ngw) {
                    const int n = tk & 3, tile = (tk >> 2) & 127, b = tk >> 9, s = tile * 32 + r, row = b * SEQ + s, cbase = 64 * n;
                    bf16x8 xcb[4]; float xcf[4][8];
#pragma unroll
                    for (int ks = 0; ks < 4; ++ks) {
                        const int c0 = cbase + 16 * ks + 8 * hi;
#pragma unroll
                        for (int e = 0; e < 8; ++e) xcf[ks][e] = cb[c0 + e];
#pragma unroll
                        for (int k = 0; k < 4; ++k) { const int sr = s - 3 + k;
                            if (sr >= 0) { const bf16x8 xv = ldg8(ZS + (size_t)(b * SEQ + sr) * ZSW + C_XLRU + c0); const u32x4 w = *(const u32x4*)&xv; const float* wk = cw + k * 256 + c0;
                                xcf[ks][0] += wk[0] * bflo(w.x); xcf[ks][1] += wk[1] * bfhi(w.x); xcf[ks][2] += wk[2] * bflo(w.y); xcf[ks][3] += wk[3] * bfhi(w.y);
                                xcf[ks][4] += wk[4] * bflo(w.z); xcf[ks][5] += wk[5] * bfhi(w.z); xcf[ks][6] += wk[6] * bflo(w.w); xcf[ks][7] += wk[7] * bfhi(w.w); } }
                        u32x4 pw; pw.x = cvt_pk_bf16(xcf[ks][0], xcf[ks][1]); pw.y = cvt_pk_bf16(xcf[ks][2], xcf[ks][3]); pw.z = cvt_pk_bf16(xcf[ks][4], xcf[ks][5]); pw.w = cvt_pk_bf16(xcf[ks][6], xcf[ks][7]); xcb[ks] = *(bf16x8*)&pw;
                    }
                    const bf16_t* Wr = (const bf16_t*)(WLP(l) + WL_SM + SM_WR) + n * 4096; const bf16_t* Wi = (const bf16_t*)(WLP(l) + WL_SM + SM_WI) + n * 4096;
                    f32x16 ar_[2] = {f32x16{}, f32x16{}}, ai_[2] = {f32x16{}, f32x16{}};
#pragma unroll
                    for (int ft = 0; ft < 2; ++ft)
#pragma unroll
                        for (int ks = 0; ks < 4; ++ks) { ar_[ft] = MFMA32(ldg8(Wr + (32 * ft + r) * 64 + 16 * ks + 8 * hi), xcb[ks], ar_[ft]); ai_[ft] = MFMA32(ldg8(Wi + (32 * ft + r) * 64 + 16 * ks + 8 * hi), xcb[ks], ai_[ft]); }
                    float xloc[4][4], xrcv[4][4];
#pragma unroll
                    for (int ks = 0; ks < 4; ++ks)
#pragma unroll
                        for (int j = 0; j < 4; ++j) { xloc[ks][j] = hi ? xcf[ks][4 + j] : xcf[ks][j]; const float snd = hi ? xcf[ks][j] : xcf[ks][4 + j]; xrcv[ks][j] = __shfl_xor(snd, 32); }
#pragma unroll
                    for (int ft = 0; ft < 2; ++ft)
#pragma unroll
                        for (int rg = 0; rg < 4; ++rg) {
                            const int c0 = cbase + 32 * ft + 8 * rg + 4 * hi, ks = 2 * ft + (rg >> 1);
                            f32x4 av, iv;
#pragma unroll
                            for (int e = 0; e < 4; ++e) { const float xce = ((rg & 1) == hi) ? xloc[ks][e] : xrcv[ks][e];
                                const float rr = fsigmoid(ar_[ft][4 * rg + e] + br[c0 + e]), ii = fsigmoid(ai_[ft][4 * rg + e] + bi[c0 + e]);
                                const float la = -rr * c8[c0 + e]; const float a = fexp2(la * LOG2E); av[e] = a; iv[e] = sqrtf(fmaxf(1.f - a * a, 0.f)) * ii * xce; }
                            *(f32x4*)(LA + (size_t)row * 256 + c0) = av; *(f32x4*)(LI + (size_t)row * 256 + c0) = iv;
                            { const int sc_ = (32 * ft + 8 * rg + 4 * hi) ^ ((r & 7) << 2); *(LAS f32x4*)(lsa + r * 64 + sc_) = av; *(LAS f32x4*)(lsh + r * 64 + sc_) = iv; }
                        }
                    asm volatile("s_waitcnt lgkmcnt(0)" ::: "memory");
                    {
                        float ta = 1.f, th = 0.f;
#pragma unroll
                        for (int t = 0; t < 32; ++t) { const float a_ = lsa[t * 64 + (lane ^ ((t & 7) << 2))], h_ = lsh[t * 64 + (lane ^ ((t & 7) << 2))]; th = a_ * th + h_; ta = ta * a_; }
                        LSA[(size_t)(b * 128 + tile) * 256 + cbase + lane] = ta; LSH[(size_t)(b * 128 + tile) * 256 + cbase + lane] = th;
                    }
                    asm volatile("s_waitcnt lgkmcnt(0)" ::: "memory");
                }
            }
            if (SUB(4)) {
                float* S5S = (float*)(ws + WS_S5S);
                const int t5cnt = F.wave < 4 ? 1 : (F.wave == 4 ? 0 : 4), t5off = F.wave < 4 ? F.wave : 4 + 4 * (F.wave - 5);
                for (int tbk = F.bid; tbk < NB * 64; tbk += F.G) for (int tj = 0; tj < t5cnt; ++tj) { const int tk = tbk * 16 + t5off + tj;
                    const int g = tk & 15, ch = (tk >> 4) & 63, b = tk >> 10;
                    const float* tb = S5T + (size_t)(l * 16 + g) * 36 * 64 + lane;
                    const float ar = tb[32 * 64], ai = tb[33 * 64];
                    LAS unsigned char* tile = F.lds + F.wave * 16384;
                    float hr = 0.f, hi2 = 0.f;
#pragma unroll 1
                    for (int hf = 0; hf < 2; ++hf) {
                        s5_bu_tile(tile, BBF + (size_t)(l * 16 + g) * 128 * 16, ZS + (size_t)(b * SEQ + ch * 64 + hf * 32) * ZSW + C_S5 + 16 * g, lane);
#pragma unroll 8
                        for (int t2 = 0; t2 < 32; ++t2) { const float bur = bf2f(*(const LAS bf16_t*)(tile + t2 * 272 + lane * 2)), bui = bf2f(*(const LAS bf16_t*)(tile + t2 * 272 + 128 + lane * 2));
                            const float nr = ar * hr - ai * hi2 + bur, ni = ar * hi2 + ai * hr + bui; hr = nr; hi2 = ni; }
                        asm volatile("s_waitcnt lgkmcnt(0)" ::: "memory");
                    }
                    float* dst = S5S + ((size_t)((b * 64 + ch) * 16 + g) * 2) * 64 + lane; dst[0] = hr; dst[64] = hi2;
                }
            }
            if (SUB(5) && l == 0) {
                bf16_t* KX = (bf16_t*)(ws + WS_KX); bf16_t* VXT = (bf16_t*)(ws + WS_VXT);
                if (F.wave == 4) for (int tk = F.bid; tk < 2 * 32 * 4; tk += F.G) {
                    const int hd = tk & 3, mt = (tk >> 2) & 31, ly = tk >> 7, row = mt * 32 + r, b = row >> 8, jm = row & 255;
                    const bf16_t* W = (const bf16_t*)(ws + WS_WL + ly * WL_STRIDE + WL_WXKV);
                    f32x16 acc[4] = {f32x16{}, f32x16{}, f32x16{}, f32x16{}}; float ss = 0.f;
                    const float* mp = INF(1) + (size_t)row * DM + 8 * hi;
#pragma unroll 2
                    for (int ks = 0; ks < 64; ++ks) {
                        const f32x4 m0 = *(const f32x4*)(mp + 16 * ks), m1 = *(const f32x4*)(mp + 16 * ks + 4);
                        ss += (m0.x * m0.x + m0.y * m0.y) + (m0.z * m0.z + m0.w * m0.w) + (m1.x * m1.x + m1.y * m1.y) + (m1.z * m1.z + m1.w * m1.w);
                        const u32x4 pw = pg8::pack8(m0, m1); const bf16x8 xb = *(const bf16x8*)&pw;
#pragma unroll
                        for (int f = 0; f < 4; ++f) { const int wrow = (f < 2 ? 64 * hd + 32 * f : 256 + 64 * hd + 32 * (f - 2)) + r; acc[f] = MFMA32(ldg8(W + (size_t)wrow * DM + 16 * ks + 8 * hi), xb, acc[f]); }
                    }
                    ss += __shfl_xor(ss, 32); const float rm = frsq(ss * (1.f / DM) + EPS);
                    float s2 = 0.f;
#pragma unroll
                    for (int f = 0; f < 2; ++f)
#pragma unroll
                        for (int q = 0; q < 16; ++q) { acc[f][q] *= rm; s2 += acc[f][q] * acc[f][q]; }
                    s2 += __shfl_xor(s2, 32); const float rk = frsq(s2 * (1.f / 64.f) + EPS);
                    const float* gk = INF(47) + ly * 64;
                    bf16_t* kd = KX + ((size_t)(ly * 16 + b * 4 + hd) * 256 + jm) * 64;
#pragma unroll
                    for (int f = 0; f < 2; ++f)
#pragma unroll
                        for (int rg = 0; rg < 4; ++rg) { const float* gp = gk + 32 * f + 8 * rg + 4 * hi; u32x2 w;
                            w.x = cvt_pk_bf16(acc[f][4 * rg] * rk * gp[0], acc[f][4 * rg + 1] * rk * gp[1]); w.y = cvt_pk_bf16(acc[f][4 * rg + 2] * rk * gp[2], acc[f][4 * rg + 3] * rk * gp[3]);
                            *(u32x2*)(kd + 32 * f + 8 * rg + 4 * hi) = w; }
                    bf16_t* vd = VXT + (size_t)(ly * 16 + b * 4 + hd) * 64 * 256 + jm;
#pragma unroll
                    for (int f = 2; f < 4; ++f)
#pragma unroll
                        for (int q = 0; q < 16; ++q) vd[(size_t)(32 * (f - 2) + crow(q, hi)) * 256] = f2bf(acc[f][q] * rm);
                }
            }
        }
        SEAM(pb + 1);
        if (IN(pb + 2)) {
            if (SUB(6)) { PHASE_BEGIN();
            const int lane = F.lane, r32 = lane & 31, hi = lane >> 5, wid = F.wave;
            volatile LAS unsigned* qslot = (volatile LAS unsigned*)(F.lds + MISC_OFF + 64);
            for (int it = queue_pull(F.ctl + CW_Q + 64 * (4 * l + 0), qslot, F.tid); it < 256; it = queue_pull(F.ctl + CW_Q + 64 * (4 * l + 0), qslot, F.tid)) {
                {
                    const int bh = it & 15, qt = 15 - (it >> 4), b = bh >> 2, hd = bh & 3;
                    const bf16_t* QM = (const bf16_t*)(ws + WS_QM) + (size_t)bh * SEQ * 96; const bf16_t* KM = (const bf16_t*)(ws + WS_KM) + (size_t)bh * SEQ * 96;
                    const bf16_t* VMT = (const bf16_t*)(ws + WS_VMT) + (size_t)bh * 64 * SEQ;
                    f32x16 o[1][2]; float lsum[1];
                    attn_unit<96, 1, true, false, false>(F.lds, QM + (size_t)qt * 256 * 96, 96, KM, VMT, SEQ, 4 * (qt + 1), 256 * qt, nullptr, nullptr, 1.f, MISCT[516 + l * 4 + 0], o, lsum);
                    const int row = b * SEQ + qt * 256 + wid * 32 + r32;
                    attn_store(YB + (size_t)1 * MTOK * 256 + (size_t)row * 256 + hd * 64, o[0], frcp(lsum[0]), hi);
                }
            } }
            if (SUB(7)) { PHASE_BEGIN();
            const int lane = F.lane, r32 = lane & 31, hi = lane >> 5, wid = F.wave;
            LAS float* lut = (LAS float*)(F.lds + 106496);
            for (int i = F.tid; i < 4 * 384; i += 512) lut[i] = MISCT[1024 + i];
            __syncthreads();
            volatile LAS unsigned* qslot = (volatile LAS unsigned*)(F.lds + MISC_OFF + 64);
            for (int it = queue_pull(F.ctl + CW_Q + 64 * (4 * l + 1), qslot, F.tid); it < 256; it = queue_pull(F.ctl + CW_Q + 64 * (4 * l + 1), qslot, F.tid)) {
                {
                    const int bh = it & 15, qt = 15 - (it >> 4), b = bh >> 2, hd = bh & 3;
                    const bf16_t* QD = (const bf16_t*)(ws + WS_QD) + (size_t)bh * SEQ * 64; const bf16_t* KD = (const bf16_t*)(ws + WS_KD) + (size_t)bh * SEQ * 64;
                    const bf16_t* VDT = (const bf16_t*)(ws + WS_VDT) + (size_t)bh * 64 * SEQ;
                    f32x16 o[2][2]; float lsum[2];
                    attn_unit<64, 2, true, true, false>(F.lds, QD + (size_t)qt * 256 * 64, 64, KD, VDT, SEQ, 4 * (qt + 1), 256 * qt, lut + hd * 384, nullptr, 1.f, MISCT[516 + l * 4 + 1], o, lsum);
                    const float lam = MISCT[512 + l], lam_init = MISCT[514 + l];
                    const float i1 = frcp(lsum[0]), i2 = lam * frcp(lsum[1]); float ss = 0.f;
#pragma unroll
                    for (int dt = 0; dt < 2; ++dt)
#pragma unroll
                        for (int q = 0; q < 16; ++q) { const float v = o[0][dt][q] * i1 - o[1][dt][q] * i2; o[0][dt][q] = v; ss += v * v; }
                    ss += __shfl_xor(ss, 32); const float rs = frsq(ss * (1.f / 64.f) + EPS) * (1.f - lam_init);
                    const float* gs = INF(39) + l * 64;
#pragma unroll
                    for (int dt = 0; dt < 2; ++dt)
#pragma unroll
                        for (int q = 0; q < 16; ++q) o[0][dt][q] *= gs[32 * dt + crow(q, hi)];
                    const int row = b * SEQ + qt * 256 + wid * 32 + r32;
                    attn_store(YB + (size_t)3 * MTOK * 256 + (size_t)row * 256 + hd * 64, o[0], rs, hi);
                }
            } }
            if (SUB(8)) { PHASE_BEGIN();
            const int lane = F.lane, r32 = lane & 31, hi = lane >> 5, wid = F.wave;
            volatile LAS unsigned* qslot = (volatile LAS unsigned*)(F.lds + MISC_OFF + 64);
            for (int it = queue_pull(F.ctl + CW_Q + 64 * (4 * l + 2), qslot, F.tid); it < 256; it = queue_pull(F.ctl + CW_Q + 64 * (4 * l + 2), qslot, F.tid)) {
                {
                    const int b = it >> 6, ch = it & 63, row0 = b * SEQ + ch * 64;
                    LAS unsigned char* hbuf = F.lds + wid * 8704;
                    LAS unsigned char* ypre = F.lds + 69632;
                    const float* S5S = (const float*)(ws + WS_S5S);
#pragma unroll 1
                    for (int gg = 0; gg < 2; ++gg) {
                        const int g = 2 * wid + gg;
                        const float* tb = S5T + (size_t)(l * 16 + g) * 36 * 64 + lane;
                        const float ar = tb[32 * 64], ai = tb[33 * 64], a64r = tb[34 * 64], a64i = tb[35 * 64];
                        float hr = 0.f, hi2 = 0.f;
                        for (int c0 = 0; c0 < ch; c0 += 8) {
                            float sr[8], si[8];
#pragma unroll
                            for (int u = 0; u < 8; ++u) { const int c = c0 + u; const bool ok = c < ch; const float* sp = S5S + ((size_t)((b * 64 + (ok ? c : 0)) * 16 + g) * 2) * 64 + lane; sr[u] = ok ? sp[0] : 0.f; si[u] = ok ? sp[64] : 0.f; }
#pragma unroll
                            for (int u = 0; u < 8; ++u) { if (c0 + u < ch) { const float nr = a64r * hr - a64i * hi2 + sr[u], ni = a64r * hi2 + a64i * hr + si[u]; hr = nr; hi2 = ni; } }
                        }
                        bf16x8 cf[4];
#pragma unroll
                        for (int ks = 0; ks < 4; ++ks) cf[ks] = ldg8(CMAT + (size_t)(l * 16 + g) * 16 * 128 + (lane & 15) * 128 + 32 * ks + 8 * (lane >> 4));
                        const float* dsk = INF(17) + l * 256 + 16 * g + 4 * (lane >> 4);
#pragma unroll 1
                        for (int hf = 0; hf < 2; ++hf) {
                            s5_bu_tile(hbuf, BBF + (size_t)(l * 16 + g) * 128 * 16, ZS + (size_t)(row0 + hf * 32) * ZSW + C_S5 + 16 * g, lane);
#pragma unroll 8
                            for (int t2 = 0; t2 < 32; ++t2) { const float bur = bf2f(*(const LAS bf16_t*)(hbuf + t2 * 272 + lane * 2)), bui = bf2f(*(const LAS bf16_t*)(hbuf + t2 * 272 + 128 + lane * 2));
                                const float nr = ar * hr - ai * hi2 + bur, ni = ar * hi2 + ai * hr + bui; hr = nr; hi2 = ni;
                                *(LAS bf16_t*)(hbuf + t2 * 272 + lane * 2) = f2bf(hr); *(LAS bf16_t*)(hbuf + t2 * 272 + 128 + lane * 2) = f2bf(hi2);
                            }
                            asm volatile("s_waitcnt lgkmcnt(0)" ::: "memory");
#pragma unroll
                            for (int tq = 0; tq < 2; ++tq) {
                                f32x4 yv = (f32x4){0.f, 0.f, 0.f, 0.f};
#pragma unroll
                                for (int ks = 0; ks < 4; ++ks) { const bf16x8 hb = *(const LAS bf16x8*)(hbuf + (16 * tq + (lane & 15)) * 272 + (32 * ks + 8 * (lane >> 4)) * 2); yv = MFMA16(cf[ks], hb, yv); }
                                const int tl = hf * 32 + 16 * tq + (lane & 15);
                                const u32x2 uw = *(const u32x2*)(ZS + (size_t)(row0 + tl) * ZSW + C_S5 + 16 * g + 4 * (lane >> 4));
                                yv[0] = fgelu(yv[0] + dsk[0] * bflo(uw.x)); yv[1] = fgelu(yv[1] + dsk[1] * bfhi(uw.x)); yv[2] = fgelu(yv[2] + dsk[2] * bflo(uw.y)); yv[3] = fgelu(yv[3] + dsk[3] * bfhi(uw.y));
                                u32x2 pw; pw.x = cvt_pk_bf16(yv[0], yv[1]); pw.y = cvt_pk_bf16(yv[2], yv[3]);
                                *(LAS u32x2*)(ypre + tl * 528 + (16 * g + 4 * (lane >> 4)) * 2) = pw;
                            }
                            asm volatile("s_waitcnt lgkmcnt(0)" ::: "memory");
                        }
                    }
                    __syncthreads();
                    {
                        const bf16_t* WG = (const bf16_t*)(WLP(l) + WL_SM + SM_WGLU);
                        f32x16 acc[2] = {f32x16{}, f32x16{}};
#pragma unroll 4
                        for (int ks = 0; ks < 16; ++ks) { const bf16x8 a = ldg8(WG + (size_t)(32 * wid + r32) * 256 + 16 * ks + 8 * hi);
#pragma unroll
                            for (int tt = 0; tt < 2; ++tt) acc[tt] = MFMA32(a, *(const LAS bf16x8*)(ypre + (32 * tt + r32) * 528 + (16 * ks + 8 * hi) * 2), acc[tt]); }
                        const float* bg = INF(19) + l * 256;
#pragma unroll
                        for (int tt = 0; tt < 2; ++tt)
#pragma unroll
                            for (int rg = 0; rg < 4; ++rg) { const int n0 = 32 * wid + 8 * rg + 4 * hi, t = 32 * tt + r32;
                                const u32x2 yw = *(const LAS u32x2*)(ypre + t * 528 + n0 * 2); u32x2 ow;
                                ow.x = cvt_pk_bf16(bflo(yw.x) * fsigmoid(acc[tt][4 * rg] + bg[n0]), bfhi(yw.x) * fsigmoid(acc[tt][4 * rg + 1] + bg[n0 + 1]));
                                ow.y = cvt_pk_bf16(bflo(yw.y) * fsigmoid(acc[tt][4 * rg + 2] + bg[n0 + 2]), bfhi(yw.y) * fsigmoid(acc[tt][4 * rg + 3] + bg[n0 + 3]));
                                *(u32x2*)(YB + (size_t)(row0 + t) * 256 + n0) = ow; }
                    }
                    __syncthreads();
                }
            }
            }
            if (SUB(9)) { PHASE_BEGIN(); const int lane = F.lane;
                const float* LA = (const float*)(ws + WS_LA); const float* LI = (const float*)(ws + WS_LI); const float* LSA = (const float*)(ws + WS_LSUM); const float* LSH = LSA + NB * 128 * 256;
                volatile LAS unsigned* qslot = (volatile LAS unsigned*)(F.lds + MISC_OFF + 64);
                for (int it = queue_pull(F.ctl + CW_Q + 64 * (4 * l + 3), qslot, F.tid); it < NB * 64 * 4 / 8; it = queue_pull(F.ctl + CW_Q + 64 * (4 * l + 3), qslot, F.tid)) {
                    const int tk = (NB * 64 * 4 / 8 - 1 - it) * 8 + F.wave;
                    const int n = tk & 3, ch = (tk >> 2) & 63, b = tk >> 8, c = 64 * n + lane;
                    float h = 0.f;
                    for (int tp0 = 0; tp0 < 2 * ch; tp0 += 16) {
                        float ca[16], chh[16];
#pragma unroll
                        for (int u = 0; u < 16; ++u) { const int tp = tp0 + u; const bool ok = tp < 2 * ch; const size_t o = (size_t)(b * 128 + (ok ? tp : 0)) * 256 + c; ca[u] = ok ? LSA[o] : 1.f; chh[u] = ok ? LSH[o] : 0.f; }
#pragma unroll
                        for (int u = 0; u < 16; ++u) h = ca[u] * h + chh[u];
                    }
                    const int row0 = b * SEQ + ch * 64;
#pragma unroll 1
                    for (int t0 = 0; t0 < 64; t0 += 16) {
                        float la[16], li[16], gt[16];
#pragma unroll
                        for (int u = 0; u < 16; ++u) { const size_t o = (size_t)(row0 + t0 + u) * 256 + c; la[u] = LA[o]; li[u] = LI[o]; gt[u] = bf2f(ZS[(size_t)(row0 + t0 + u) * ZSW + C_GLRU + c]); }
#pragma unroll
                        for (int u = 0; u < 16; ++u) { h = la[u] * h + li[u]; gt[u] = h * fgelu(gt[u]); }
#pragma unroll
                        for (int u = 0; u < 16; ++u) YB[(size_t)2 * MTOK * 256 + (size_t)(row0 + t0 + u) * 256 + c] = f2bf(gt[u]);
                    }
                }
            }
        }
        SEAM(pb + 2);
        if (IN(pb + 3)) { PHASE_BEGIN();
            pg8::Gemm g{YB, (const bf16_t*)(WLP(l) + WL_PT), 256, nullptr}; pg8::MergeOrder S{F.G, F.bid};
            pg8::EpiMerge E{MG, ZG};
            pg8::gemm_phase<pg8::EpiMerge, pg8::MergeOrder, true, false>(F.lds, g, S, E);
        }
        SEAM(pb + 3);
        if (IN(pb + 4)) { PHASE_BEGIN();
            pg8::Gemm g{MG, (const bf16_t*)(WLP(l) + WL_WO), DM, nullptr}; pg8::StaticOrder S; S.init(MTOK / 256, DM / 256, F.G, F.bid);
            pg8::EpiRes<false> E{nullptr, XB, RS + (size_t)(l == 0 ? 1 : 4) * MTOK * 16, nullptr};
            pg8::gemm_phase<pg8::EpiRes<false>, pg8::StaticOrder, false, false>(F.lds, g, S, E);
        }
        SEAM(pb + 4);
        if (IN(pb + 5)) { PHASE_BEGIN();
            pg8::Gemm g{XB, (const bf16_t*)(WLP(l) + WL_WXQ), DM, nullptr}; pg8::StaticOrder S; S.init(MTOK / 256, 1, F.G, F.bid);
            pg8::EpiRowScale E{(bf16_t*)(ws + WS_QX), 256, RS + (size_t)(l == 0 ? 1 : 4) * MTOK * 16};
            pg8::gemm_phase<pg8::EpiRowScale, pg8::StaticOrder, false, false>(F.lds, g, S, E);
        }
        SEAM(pb + 5);
        if (IN(pb + 6)) { PHASE_BEGIN();
            const int lane = F.lane, r32 = lane & 31, hi = lane >> 5, wid = F.wave;
            for (int it = F.bid; it < 256; it += F.G) {
                const int hd = it & 3, rt = it >> 2, b = rt >> 4;
                const bf16_t* QX = (const bf16_t*)(ws + WS_QX) + (size_t)rt * 256 * 256 + hd * 64;
                const bf16_t* KX = (const bf16_t*)(ws + WS_KX) + (size_t)(l * 16 + b * 4 + hd) * 256 * 64;
                const bf16_t* VXT = (const bf16_t*)(ws + WS_VXT) + (size_t)(l * 16 + b * 4 + hd) * 64 * 256;
                f32x16 o[1][2]; float lsum[1];
                attn_unit<64, 1, false, false, true>(F.lds, QX, 256, KX, VXT, 256, 4, 0, nullptr, INF(46) + l * 64, 0.125f * LOG2E, MISCT[516 + l * 4 + 2], o, lsum);
                const int row = rt * 256 + wid * 32 + r32;
                attn_store((bf16_t*)(ws + WS_OX) + (size_t)row * 256 + hd * 64, o[0], frcp(lsum[0]), hi);
            }
        }
        SEAM(pb + 6);
        if (IN(pb + 7)) { PHASE_BEGIN();
            pg8::Gemm g{(const bf16_t*)(ws + WS_OX), (const bf16_t*)(WLP(l) + WL_WXO), 256, nullptr}; pg8::StaticOrder S; S.init(MTOK / 256, DM / 256, F.G, F.bid);
            if (l == 0) { pg8::EpiRes<false> E{nullptr, XB, RS + (size_t)2 * MTOK * 16, nullptr}; pg8::gemm_phase<pg8::EpiRes<false>, pg8::StaticOrder, false, false>(F.lds, g, S, E); }
            else { pg8::EpiRes<false> E{nullptr, XB, RS + (size_t)5 * MTOK * 16, nullptr}; pg8::gemm_phase<pg8::EpiRes<false>, pg8::StaticOrder, false, false>(F.lds, g, S, E); }
        }
        SEAM(pb + 7);
        if (l == 0) {
            if (IN(9)) { PHASE_BEGIN();
                pg8::Gemm g{XB, (const bf16_t*)(ws + WS_WGU), DM, nullptr}; pg8::StaticOrder S; S.init(MTOK / 256, 2 * FF / 256, F.G, F.bid);
#if G2_FP8
                pg8::EpiSwiGLU8<true, false> E{ws + WS_HFF, FF, RS + (size_t)2 * MTOK * 16};
                pg8::gemm_phase<pg8::EpiSwiGLU8<true, false>, pg8::StaticOrder, true, false>(F.lds, g, S, E);
#else
                pg8::EpiSwiGLU<false> E{(bf16_t*)(ws + WS_HFF), FF, RS + (size_t)2 * MTOK * 16, nullptr};
                pg8::gemm_phase<pg8::EpiSwiGLU<false>, pg8::StaticOrder, true, false>(F.lds, g, S, E);
#endif
            }
            SEAM(9);
            if (IN(10)) { PHASE_BEGIN();
#if G2_FP8
                pg8::Gemm g{(const bf16_t*)(ws + WS_HFF), (const bf16_t*)(ws + WS_WD), FF / 2, nullptr}; pg8::StaticOrder S; S.init(MTOK / 256, DM / 256, F.G, F.bid);
                pg8::EpiRes<false, (GATE_FP8 & 2) != 0, true> E{nullptr, XB, RS + (size_t)3 * MTOK * 16, ws + WS_X8};
                pg8::gemm_phase<pg8::EpiRes<false, (GATE_FP8 & 2) != 0, true>, pg8::StaticOrder, false, false, true>(F.lds, g, S, E);
#else
                pg8::Gemm g{(const bf16_t*)(ws + WS_HFF), (const bf16_t*)(ws + WS_WD), FF, nullptr}; pg8::StaticOrder S; S.init(MTOK / 256, DM / 256, F.G, F.bid);
                pg8::EpiRes<false, (GATE_FP8 & 2) != 0> E{nullptr, XB, RS + (size_t)3 * MTOK * 16, ws + WS_X8};
                pg8::gemm_phase<pg8::EpiRes<false, (GATE_FP8 & 2) != 0>, pg8::StaticOrder, false, false>(F.lds, g, S, E);
#endif
            }
            SEAM(10);
        } else {
#define ROWTOK ((int*)(ws + WS_MOESM + MS_ROWTOK))
#define TOKW ((float*)(ws + WS_MOESM + MS_TOKW))
#define ASSIGN ((int*)(ws + WS_MOESM + MS_ASSIGN))
#define RSTD2 ((float*)(ws + WS_MOESM + MS_RSTD))
#define MCNT (F.ctl + CW_MOECNT)
            if (IN(19)) { PHASE_BEGIN();
                LAS float* wrs = (LAS float*)(F.lds);
                for (int i = F.tid; i < 8192; i += 512) wrs[i] = INF(51)[i] * INF(7)[DM + (i >> 3)];
                __syncthreads();
                if (SUB(10) && F.wave < 4) {
                    const int lane = F.lane;
                    for (int blk = F.bid; blk < 256; blk += F.G) {
                        unsigned cntv = 0u, mypack = 0u;
#pragma unroll 1
                        for (int j = 0; j < 16; ++j) {
                            const int tok = blk * 64 + F.wave * 16 + j;
                            const u32x2* xr = (const u32x2*)(XB + (size_t)tok * DM) + lane;
                            float lg[8] = {0.f, 0.f, 0.f, 0.f, 0.f, 0.f, 0.f, 0.f}; float ss = 0.f; f32x4 xv4[4];
#pragma unroll
                            for (int q = 0; q < 4; ++q) { const u32x2 xw = xr[64 * q]; const f32x4 v = {bflo(xw.x), bfhi(xw.x), bflo(xw.y), bfhi(xw.y)}; const int k0 = 256 * q + 4 * lane; xv4[q] = v;
                                ss += (v.x * v.x + v.y * v.y) + (v.z * v.z + v.w * v.w);
#pragma unroll
                                for (int e4 = 0; e4 < 4; ++e4) { const float xv = v[e4]; const LAS f32x4* wp = (const LAS f32x4*)(wrs + (k0 + e4) * 8); const f32x4 wa = wp[0], wb = wp[1];
                                    lg[0] += xv * wa.x; lg[1] += xv * wa.y; lg[2] += xv * wa.z; lg[3] += xv * wa.w; lg[4] += xv * wb.x; lg[5] += xv * wb.y; lg[6] += xv * wb.z; lg[7] += xv * wb.w; } }
                            ss = wave_sum(ss);
#pragma unroll
                            for (int e = 0; e < 8; ++e) lg[e] = wave_sum(lg[e]);
                            const float rstd = frsq(ss * (1.f / DM) + EPS);
                            { unsigned* xq = (unsigned*)(ws + WS_XQ + (size_t)tok * DM) + lane;
#pragma unroll
                              for (int q = 0; q < 4; ++q) xq[64 * q] = cvt_pk4_fp8(xv4[q].x * rstd, xv4[q].y * rstd, xv4[q].z * rstd, xv4[q].w * rstd); }
                            int e1 = 0; float v1 = lg[0];
#pragma unroll
                            for (int e = 1; e < 8; ++e) if (lg[e] > v1) { v1 = lg[e]; e1 = e; }
                            int e2 = -1; float v2 = -3.4e38f;
#pragma unroll
                            for (int e = 0; e < 8; ++e) if (e != e1 && lg[e] > v2) { v2 = lg[e]; e2 = e; }
                            if (e2 < 0) e2 = (e1 + 1) & 7;
                            const int se1 = __builtin_amdgcn_readfirstlane(e1), se2 = __builtin_amdgcn_readfirstlane(e2);
                            const unsigned r1 = __builtin_amdgcn_readlane(cntv, se1), r2 = __builtin_amdgcn_readlane(cntv, se2);
                            cntv += (lane == se1 ? 1u : 0u) + (lane == se2 ? 1u : 0u);
                            if (lane == j) mypack = (unsigned)se1 | (r1 << 4) | ((unsigned)se2 << 12) | (r2 << 16);
                            if (lane == 0) { const float w1 = frcp(1.f + __expf((v2 - v1) * rstd)); RSTD2[tok] = rstd; TOKW[tok * 2] = w1; TOKW[tok * 2 + 1] = 1.f - w1; }
                        }
                        unsigned basev = 0u;
                        if (lane < 8) basev = __hip_atomic_fetch_add(MCNT + 64 * lane, cntv, __ATOMIC_RELAXED, __HIP_MEMORY_SCOPE_AGENT);
                        const int pe1 = mypack & 15, pr1 = (mypack >> 4) & 255, pe2 = (mypack >> 12) & 15, pr2 = (mypack >> 16) & 255;
                        const unsigned b1 = __shfl(basev, pe1), b2 = __shfl(basev, pe2);
                        if (lane < 16) { const int tok = blk * 64 + F.wave * 16 + lane; ASSIGN[tok * 2] = pe1 | (int)((b1 + (unsigned)pr1) << 8); ASSIGN[tok * 2 + 1] = pe2 | (int)((b2 + (unsigned)pr2) << 8);
                            ROWTOK[pe1 * 16384 + (int)(b1 + (unsigned)pr1)] = tok; ROWTOK[pe2 * 16384 + (int)(b2 + (unsigned)pr2)] = tok; }
                    }
                }
                if (SUB(11)) {
                    LAS float* scr = (LAS float*)(F.lds + 40960 + F.wave * 8448);
                    const TJob j0{INF(52), (bf16_t*)(ws + WS_WMGU), INF(7) + DM, DM, EFF, EFF, DM, 8, 2, (size_t)DM * EFF, (size_t)2 * EFF * DM, 1};
                    const TJob j1{INF(53), (bf16_t*)(ws + WS_WMGU), INF(7) + DM, DM, EFF, EFF, DM, 8, 3, (size_t)DM * EFF, (size_t)2 * EFF * DM, 1};
                    const TJob j2{INF(54), (bf16_t*)(ws + WS_WMD), nullptr, EFF, DM, DM, EFF, 8, 0, (size_t)EFF * DM, (size_t)DM * EFF, 1};
                    constexpr int NI = 8 * (DM / 64) * (EFF / 32);
                    LAS unsigned* qc = (LAS unsigned*)(F.lds + MISC_OFF + 128);
                    const int wg_items = (3 * NI - F.bid + F.G - 1) / F.G;
#define H0_PULL() h0_pull(qc, F.lane, wg_items, F.bid, F.G, 3 * NI)
#define H0_JOB(idx) const int jn_ = (idx) / NI; TJob js_ = j0; if (jn_ == 1) { js_.W = j1.W; js_.map = 3; } if (jn_ == 2) js_ = j2;
#define H0_LOAD(idx, v) do { H0_JOB(idx) tjob_load(js_, (idx) - jn_ * NI, v, F.lane); } while (0)
#define H0_STORE(idx, v) do { H0_JOB(idx) tjob_store(js_, (idx) - jn_ * NI, v, scr, F.lane); } while (0)
                    float va[32] = {}, vb[32] = {}; int it = H0_PULL();
                    if (it < 3 * NI) { H0_LOAD(it, va);
                        for (;;) {
                            const int n1 = H0_PULL(); if (n1 < 3 * NI) H0_LOAD(n1, vb);
                            H0_STORE(it, va); if (n1 >= 3 * NI) break;
                            const int n2 = H0_PULL(); if (n2 < 3 * NI) H0_LOAD(n2, va);
                            H0_STORE(n1, vb); if (n2 >= 3 * NI) break;
                            it = n2;
                        } }
#undef H0_PULL
#undef H0_JOB
#undef H0_LOAD
#undef H0_STORE
                }
            }
            SEAM(19);
            if (IN(21)) { PHASE_BEGIN();
                pg8::Gemm g{(const bf16_t*)(ws + WS_XQ), (const bf16_t*)(ws + WS_WMGU), DM / 2, ROWTOK}; pg8::MoeOrder S; S.init(MCNT, 2 * EFF / 256, F.G, F.bid);
                pg8::EpiSwiGLU8<false> E{ws + WS_HMOE, EFF, nullptr};
                pg8::gemm_phase<pg8::EpiSwiGLU8<false>, pg8::MoeOrder, true, true, true>(F.lds, g, S, E);
            }
            SEAM(21);
            if (IN(22)) { PHASE_BEGIN();
                pg8::Gemm g{(const bf16_t*)(ws + WS_HMOE), (const bf16_t*)(ws + WS_WMD), EFF / 2, nullptr}; pg8::MoeOrder S; S.init(MCNT, DM / 256, F.G, F.bid);
                pg8::EpiPlain E{(bf16_t*)(ws + WS_YS), DM, 0.03125f};
                pg8::gemm_phase<pg8::EpiPlain, pg8::MoeOrder, true, false, true>(F.lds, g, S, E);
            }
            SEAM(22);
            if (IN(23)) { PHASE_BEGIN();
                const bf16_t* YS = (const bf16_t*)(ws + WS_YS);
                int pst[8]; { int acc = 0;
#pragma unroll
                    for (int e = 0; e < 8; ++e) { pst[e] = acc; acc += ((int)MCNT[64 * e] + 255) & ~255; } }
                for (int m = F.gw; m < MTOK; m += F.ngw) {
                    const int a1 = ASSIGN[2 * m], a2 = ASSIGN[2 * m + 1]; int p1 = 0, p2 = 0;
#pragma unroll
                    for (int q = 0; q < 8; ++q) { p1 = (q == (a1 & 255)) ? pst[q] : p1; p2 = (q == (a2 & 255)) ? pst[q] : p2; }
                    const int d1 = p1 + (a1 >> 8), d2 = p2 + (a2 >> 8); const float w1 = TOKW[2 * m], w2 = TOKW[2 * m + 1];
                    f32x4* xr = (f32x4*)(F.out + (size_t)m * DM) + F.lane; const u32x2* xbr = (const u32x2*)(XB + (size_t)m * DM) + F.lane;
                    const unsigned* y1 = (const unsigned*)((const unsigned char*)YS + (size_t)d1 * DM) + F.lane; const unsigned* y2 = (const unsigned*)((const unsigned char*)YS + (size_t)d2 * DM) + F.lane;
#pragma unroll
                    for (int j = 0; j < 4; ++j) { const u32x2 xw = xbr[64 * j]; f32x4 v = {bflo(xw.x), bfhi(xw.x), bflo(xw.y), bfhi(xw.y)}; const unsigned a = __builtin_nontemporal_load(y1 + 64 * j), c = __builtin_nontemporal_load(y2 + 64 * j);
                        const f32x2 a01 = __builtin_amdgcn_cvt_pk_f32_fp8((int)a, false), a23 = __builtin_amdgcn_cvt_pk_f32_fp8((int)a, true), c01 = __builtin_amdgcn_cvt_pk_f32_fp8((int)c, false), c23 = __builtin_amdgcn_cvt_pk_f32_fp8((int)c, true);
                        v.x += w1 * a01[0] + w2 * c01[0]; v.y += w1 * a01[1] + w2 * c01[1]; v.z += w1 * a23[0] + w2 * c23[0]; v.w += w1 * a23[1] + w2 * c23[1];
                        __builtin_nontemporal_store(v, xr + 64 * j); }
                }
            }
        }
    }
#undef IN
#undef SEAM
}

#ifdef DBG_DUMP_OFF
__global__ void dbg_copy_bf16(const bf16_t* src, float* out, int n, int nv) { for (int i = blockIdx.x * 256 + threadIdx.x; i < n; i += gridDim.x * 256) out[i] = i < nv ? bf2f(src[i]) : 0.f; }
#endif

#ifdef DBG_CHECK
struct DbgArgs { const void* in[55]; unsigned char* ws; float* out; float* acc; };
#ifndef DBG_LAYER
#define DBG_LAYER 0
#endif
__device__ __forceinline__ size_t dstride(int i) {
    switch (i) { case 4: case 5: case 6: case 7: case 10: case 11: case 26: return 1024; case 8: return (size_t)DM * DIN; case 9: return 4096; case 12: return 16;
      case 13: case 14: case 15: case 16: case 28: case 30: return 16384; case 17: case 19: case 27: case 29: case 31: case 32: return 256; case 18: case 23: return 65536; case 20: return 192; case 21: return 128;
      case 22: return 73728; case 24: case 25: return 96; case 33: case 34: case 35: case 36: case 37: case 38: return 32; case 39: case 46: case 47: return 64; case 40: return (size_t)4 * 256 * DM; case 41: return (size_t)DM * DM;
      case 42: case 43: case 44: case 45: return (size_t)DM * 256; default: return 0; } }
#define DIN_(i) ((const float*)a.in[i] + (size_t)DBG_LAYER * dstride(i))
#define DXIN_ (DBG_LAYER == 0 ? (const float*)a.in[0] : (const float*)(a.ws + WS_DBG))
constexpr size_t WS_DBG = 440 * MiB;
__device__ float blk_sum(float v, float* sh) { sh[threadIdx.x] = v; __syncthreads(); for (int o = 128; o > 0; o >>= 1) { if ((int)threadIdx.x < o) sh[threadIdx.x] += sh[threadIdx.x + o]; __syncthreads(); } const float r = sh[0]; __syncthreads(); return r; }
__device__ float blk_max(float v, float* sh) { sh[threadIdx.x] = v; __syncthreads(); for (int o = 128; o > 0; o >>= 1) { if ((int)threadIdx.x < o) sh[threadIdx.x] = fmaxf(sh[threadIdx.x], sh[threadIdx.x + o]); __syncthreads(); } const float r = sh[0]; __syncthreads(); return r; }
__device__ void dbg_acc(float* acc, int k, float fast, float ref) { atomicMax((unsigned*)&acc[2 * k], __float_as_uint(fabsf(fast - ref))); atomicAdd(&acc[2 * k + 1], ref * ref); atomicAdd(&acc[64 + k], 1.f); }
__device__ float dsig(float x) { return 1.f / (1.f + expf(-x)); }
__device__ float dgelu(float x) { return 0.5f * x * (1.f + tanhf(0.7978845608028654f * (x + 0.044715f * x * x * x))); }
__device__ int dbucket(int d) { if (d < 16) return d < 0 ? 0 : d; int bk = 16 + (int)(logf((float)d / 16.f) / logf(8.f) * 16.f); return bk > 31 ? 31 : bk; }

__global__ void chk_z(DbgArgs a) {
    __shared__ float sh[256]; const int s = blockIdx.x, tid = threadIdx.x; const int row = (s * 7919 + 13) % MTOK; int col = (s * 104729 + 7 + (s >> 1)) % DIN; if (s & 1) col = col % C_END;
    const float* x = (DBG_LAYER == 0 ? (const float*)a.in[0] : (const float*)a.out) + (size_t)row * DM; const float* g = DIN_(4); const float* W = DIN_(8);
    float ss = 0.f, dot = 0.f; for (int k = tid; k < DM; k += 256) { const float xv = x[k]; ss += xv * xv; dot += xv * g[k] * W[(size_t)k * DIN + col]; }
    ss = blk_sum(ss, sh); dot = blk_sum(dot, sh);
    if (tid == 0) { const float z = dot * rsqrtf(ss / DM + EPS);
        if (col < C_END) dbg_acc(a.acc, 1, bf2f(((const bf16_t*)(a.ws + WS_ZS))[(size_t)row * ZSW + col]), z);
        else { const int gc = col - C_END; dbg_acc(a.acc, 2, bf2f(((const bf16_t*)(a.ws + WS_ZG))[(size_t)row * ZGW + gc]), dsig(z + DIN_(9)[gc])); } }
}
__global__ void chk_mla_prep(DbgArgs a) {
    __shared__ float sh[256]; __shared__ float vn[192]; __shared__ float qs[128];
    const int s = blockIdx.x, tid = threadIdx.x, row = (s * 7919 + 13) % MTOK, hd = s & 3, b = row >> 12, sq = row & 4095;
    const bf16_t* ZSp = (const bf16_t*)(a.ws + WS_ZS) + (size_t)row * ZSW; const float pos = (float)((const int*)a.in[2])[row];
    { const float v = tid < 192 ? bf2f(ZSp[C_CQ + tid]) : 0.f; const float ss = blk_sum(v * v, sh); if (tid < 192) vn[tid] = v * rsqrtf(ss / 192.f + EPS) * DIN_(20)[tid]; __syncthreads(); }
    float qf = 0.f; if (tid < 96) for (int k = 0; k < 192; ++k) qf += vn[k] * DIN_(22)[k * 384 + hd * 96 + tid];
    { const float ss = blk_sum(tid < 96 ? qf * qf : 0.f, sh); if (tid < 96) qs[tid] = qf * rsqrtf(ss / 96.f + EPS) * DIN_(24)[tid]; __syncthreads(); }
    if (tid < 96) { float val = qs[tid]; if (tid >= 64) { const int i = (tid - 64) & 15; float sn, cs; sincos_red(pos * exp2f(-(float)i * (13.287712379549449f / 16.f)), sn, cs); const float x1 = qs[64 + i], x2 = qs[80 + i]; val = tid < 80 ? x1 * cs - x2 * sn : x1 * sn + x2 * cs; }
        val *= 0.10206207261596577f * LOG2E; dbg_acc(a.acc, 3, bf2f(((const bf16_t*)(a.ws + WS_QM))[((size_t)(b * 4 + hd) * SEQ + sq) * 96 + tid]), val); }
    __syncthreads();
    { const float v = tid < 128 ? bf2f(ZSp[C_CKV + tid]) : 0.f; const float ss = blk_sum(v * v, sh); if (tid < 128) vn[tid] = v * rsqrtf(ss / 128.f + EPS) * DIN_(21)[tid]; __syncthreads(); }
    float kv = 0.f; if (tid < 128) for (int k = 0; k < 128; ++k) kv += vn[k] * DIN_(23)[k * 512 + hd * 128 + tid];
    float kfull = 0.f; if (tid < 64) kfull = kv; else if (tid < 96) kfull = bf2f(ZSp[C_KPE + tid - 64]);
    { const float ss = blk_sum(tid < 96 ? kfull * kfull : 0.f, sh); if (tid < 96) qs[tid] = kfull * rsqrtf(ss / 96.f + EPS) * DIN_(25)[tid]; __syncthreads(); }
    if (tid < 96) { float val = qs[tid]; if (tid >= 64) { const int i = (tid - 64) & 15; float sn, cs; sincos_red(pos * exp2f(-(float)i * (13.287712379549449f / 16.f)), sn, cs); const float x1 = qs[64 + i], x2 = qs[80 + i]; val = tid < 80 ? x1 * cs - x2 * sn : x1 * sn + x2 * cs; }
        dbg_acc(a.acc, 4, bf2f(((const bf16_t*)(a.ws + WS_KM))[((size_t)(b * 4 + hd) * SEQ + sq) * 96 + tid]), val); }
    if (tid >= 64 && tid < 128) dbg_acc(a.acc, 5, bf2f(((const bf16_t*)(a.ws + WS_VMT))[((size_t)(b * 4 + hd) * 64 + tid - 64) * SEQ + sq]), kv);
}
__global__ void chk_diff_prep(DbgArgs a) {
    const int i = blockIdx.x * 256 + threadIdx.x; const int row = (i * 37 + 5) % MTOK, hd = i & 3, half = (i >> 2) & 1, isk = (i >> 3) & 1, b = row >> 12, sq = row & 4095;
    const bf16_t* src = (const bf16_t*)(a.ws + WS_ZS) + (size_t)row * ZSW + (isk ? C_KD : C_QD) + hd * 64 + half * 32;
    float ss = 0.f; for (int d = 0; d < 32; ++d) { const float v = bf2f(src[d]); ss += v * v; }
    const float rs = rsqrtf(ss / 32.f + EPS) * (isk ? 1.f : 0.17677669529663687f * LOG2E); const float* gg = DIN_(isk ? 34 : 33);
    const bf16_t* dst = (const bf16_t*)(a.ws + (isk ? WS_KD : WS_QD)) + ((size_t)(b * 4 + hd) * SEQ + sq) * 64 + half * 32;
    for (int d = 0; d < 32; ++d) dbg_acc(a.acc, 6, bf2f(dst[d]), bf2f(src[d]) * rs * gg[d]);
    const bf16_t* vs = (const bf16_t*)(a.ws + WS_ZS) + (size_t)row * ZSW + C_VD + hd * 64;
    for (int d = half * 32; d < half * 32 + 32; ++d) dbg_acc(a.acc, 7, bf2f(((const bf16_t*)(a.ws + WS_VDT))[((size_t)(b * 4 + hd) * 64 + d) * SEQ + sq]), bf2f(vs[d]));
}
__global__ void __launch_bounds__(256) chk_lru_prep(DbgArgs a) {
    __shared__ float xcs[64]; const int s = blockIdx.x, tid = threadIdx.x, row = (s * 7919 + 13) % MTOK, n = s & 3, b = row >> 12, sq = row & 4095;
    if (s == 0 || s == 1) { }
    float xc = 0.f;
    if (tid < 64) { const int c = 64 * n + tid; xc = DIN_(27)[c]; for (int k = 0; k < 4; ++k) { const int sr = sq - 3 + k; if (sr >= 0) xc += DIN_(26)[k * 256 + c] * bf2f(((const bf16_t*)(a.ws + WS_ZS))[(size_t)(b * SEQ + sr) * ZSW + C_XLRU + c]); } xcs[tid] = xc; }
    __syncthreads();
    if (tid < 64) { const int c = 64 * n + tid; float ar = DIN_(29)[c], ai = DIN_(31)[c];
        const float* wr_ = DIN_(28); const float* wi_ = DIN_(30);
#pragma unroll 2
        for (int cc = 0; cc < 64; ++cc) { ar += xcs[cc] * wr_[(n * 64 + cc) * 64 + tid]; ai += xcs[cc] * wi_[(n * 64 + cc) * 64 + tid]; }
        const float r = 1.f / (1.f + __expf(-ar)), ii = 1.f / (1.f + __expf(-ai)), la = -8.f * r * __logf(1.f + __expf(-DIN_(32)[c])), av = __expf(la), iv = sqrtf(fmaxf(1.f - av * av, 0.f)) * ii * xc;
        dbg_acc(a.acc, 8, ((const float*)(a.ws + WS_LA))[(size_t)row * 256 + c], av); dbg_acc(a.acc, 9, ((const float*)(a.ws + WS_LI))[(size_t)row * 256 + c], iv); }
}
__global__ void chk_mla_attn(DbgArgs a) {
    __shared__ float sh[256]; __shared__ float q[96]; __shared__ float p[4096];
    const int s = blockIdx.x, tid = threadIdx.x, bh = s & 15, sq = (s * 523 + 77) % SEQ, b = bh >> 2, hd = bh & 3;
    const bf16_t* QM = (const bf16_t*)(a.ws + WS_QM) + (size_t)bh * SEQ * 96; const bf16_t* KM = (const bf16_t*)(a.ws + WS_KM) + (size_t)bh * SEQ * 96; const bf16_t* VMT = (const bf16_t*)(a.ws + WS_VMT) + (size_t)bh * 64 * SEQ;
    if (tid < 96) q[tid] = bf2f(QM[(size_t)sq * 96 + tid]); __syncthreads();
    float mx = -1e30f; for (int j = tid; j <= sq; j += 256) { float sc = 0.f; for (int d = 0; d < 96; ++d) sc += q[d] * bf2f(KM[(size_t)j * 96 + d]); p[j] = sc; mx = fmaxf(mx, sc); }
    mx = blk_max(mx, sh); float sm = 0.f; for (int j = tid; j <= sq; j += 256) { p[j] = exp2f(p[j] - mx); sm += p[j]; } sm = blk_sum(sm, sh);
    if (tid < 64) { float o = 0.f; for (int j = 0; j <= sq; ++j) o += p[j] * bf2f(VMT[(size_t)tid * SEQ + j]); dbg_acc(a.acc, 10, bf2f(((const bf16_t*)(a.ws + WS_Y))[(size_t)1 * MTOK * 256 + (size_t)(b * SEQ + sq) * 256 + hd * 64 + tid]), o / sm); }
}
__global__ void chk_diff_attn(DbgArgs a) {
    __shared__ float sh[256]; __shared__ float q[64]; __shared__ float p1[4096]; __shared__ float p2[4096];
    const int s = blockIdx.x, tid = threadIdx.x, bh = s & 15, sq = (s * 523 + 77) % SEQ, b = bh >> 2, hd = bh & 3;
    const bf16_t* QD = (const bf16_t*)(a.ws + WS_QD) + (size_t)bh * SEQ * 64; const bf16_t* KD = (const bf16_t*)(a.ws + WS_KD) + (size_t)bh * SEQ * 64; const bf16_t* VDT = (const bf16_t*)(a.ws + WS_VDT) + (size_t)bh * 64 * SEQ;
    if (tid < 64) q[tid] = bf2f(QD[(size_t)sq * 64 + tid]); __syncthreads();
    float m1 = -1e30f, m2 = -1e30f; for (int j = tid; j <= sq; j += 256) { float s1 = 0.f, s2 = 0.f; for (int d = 0; d < 32; ++d) { s1 += q[d] * bf2f(KD[(size_t)j * 64 + d]); s2 += q[32 + d] * bf2f(KD[(size_t)j * 64 + 32 + d]); }
        const float bias = DIN_(3)[dbucket(sq - j) * 4 + hd] * LOG2E; s1 += bias; s2 += bias; p1[j] = s1; p2[j] = s2; m1 = fmaxf(m1, s1); m2 = fmaxf(m2, s2); }
    m1 = blk_max(m1, sh); m2 = blk_max(m2, sh); float l1 = 0.f, l2 = 0.f; for (int j = tid; j <= sq; j += 256) { p1[j] = exp2f(p1[j] - m1); p2[j] = exp2f(p2[j] - m2); l1 += p1[j]; l2 += p2[j]; } l1 = blk_sum(l1, sh); l2 = blk_sum(l2, sh);
    float s1 = 0.f, s2 = 0.f; for (int d = 0; d < 32; ++d) { s1 += DIN_(35)[d] * DIN_(36)[d]; s2 += DIN_(37)[d] * DIN_(38)[d]; } const float lam_init = DBG_LAYER == 0 ? 0.2f : 0.8f - 0.6f * 0.7408182206817179f, lam = expf(s1) - expf(s2) + lam_init;
    float o = 0.f; if (tid < 64) { float o1 = 0.f, o2 = 0.f; for (int j = 0; j <= sq; ++j) { const float v = bf2f(VDT[(size_t)tid * SEQ + j]); o1 += p1[j] * v; o2 += p2[j] * v; } o = o1 / l1 - lam * o2 / l2; }
    const float ss = blk_sum(tid < 64 ? o * o : 0.f, sh);
    if (tid < 64) dbg_acc(a.acc, 11, bf2f(((const bf16_t*)(a.ws + WS_Y))[(size_t)3 * MTOK * 256 + (size_t)(b * SEQ + sq) * 256 + hd * 64 + tid]), o * rsqrtf(ss / 64.f + EPS) * DIN_(39)[tid] * (1.f - lam_init));
}
__global__ void chk_lru_scan(DbgArgs a) {
    const int i = blockIdx.x * 256 + threadIdx.x, b = i >> 8, c = i & 255; if (b >= NB) return;
    const float* LA = (const float*)(a.ws + WS_LA); const float* LI = (const float*)(a.ws + WS_LI); float h = 0.f;
    for (int t = 0; t < SEQ; ++t) { const size_t o = (size_t)(b * SEQ + t) * 256 + c; h = LA[o] * h + LI[o];
        if (t % 97 == 0 || t == SEQ - 1) dbg_acc(a.acc, 12, bf2f(((const bf16_t*)(a.ws + WS_Y))[(size_t)2 * MTOK * 256 + o]), h * dgelu(bf2f(((const bf16_t*)(a.ws + WS_ZS))[(size_t)(b * SEQ + t) * ZSW + C_GLRU + c]))); }
}
__global__ void chk_s5_scan(DbgArgs a) {
    __shared__ float part[16][65]; const int g = blockIdx.x, p = threadIdx.x; float* ypre = (float*)(a.ws + WS_DBG);
    const float dt = expf(DIN_(12)[g]), lr = DIN_(10)[g * 64 + p], li = DIN_(11)[g * 64 + p], mag = expf(lr * dt); float sn, cs; sincos_red(li * dt, sn, cs);
    const float ar = mag * cs, ai = mag * sn, den = lr * lr + li * li, zr = ((ar - 1.f) * lr + ai * li) / den, zi = (ai * lr - (ar - 1.f) * li) / den;
    float hr = 0.f, hi = 0.f;
    for (int t = 0; t < SEQ; ++t) { const bf16_t* up = (const bf16_t*)(a.ws + WS_ZS) + (size_t)(SEQ + t) * ZSW + 16 * g; float bur = 0.f, bui = 0.f;
        for (int c = 0; c < 16; ++c) { const float u = bf2f(up[c]), br = DIN_(13)[(g * 64 + p) * 16 + c], bi = DIN_(14)[(g * 64 + p) * 16 + c]; bur += (zr * br - zi * bi) * u; bui += (zr * bi + zi * br) * u; }
        const float nr = ar * hr - ai * hi + bur, ni = ar * hi + ai * hr + bui; hr = nr; hi = ni;
        for (int c = 0; c < 16; ++c) part[c][p] = DIN_(15)[(g * 16 + c) * 64 + p] * hr - DIN_(16)[(g * 16 + c) * 64 + p] * hi;
        __syncthreads();
        if (p < 16) { float y = 0.f; for (int pp = 0; pp < 64; ++pp) y += part[p][pp]; y += DIN_(17)[16 * g + p] * bf2f(up[p]); ypre[(size_t)t * 256 + 16 * g + p] = dgelu(y); }
        __syncthreads(); }
}
__global__ void chk_s5_glu(DbgArgs a) {
    const int s = blockIdx.x, n = threadIdx.x, t = (s * 61 + 5) % SEQ; const float* ypre = (const float*)(a.ws + WS_DBG) + (size_t)t * 256;
    float z = DIN_(19)[n]; for (int k = 0; k < 256; ++k) z += ypre[k] * DIN_(18)[k * 256 + n];
    dbg_acc(a.acc, 13, bf2f(((const bf16_t*)(a.ws + WS_Y))[(size_t)(SEQ + t) * 256 + n]), ypre[n] * dsig(z));
}

__global__ void chk_merge(DbgArgs a) {
    __shared__ float sh[256]; const int s = blockIdx.x, tid = threadIdx.x, row = (s * 7919 + 13) % MTOK, col = (s * 104729 + 7) % DM;
    const bf16_t* Y = (const bf16_t*)(a.ws + WS_Y); const bf16_t* ZGp = (const bf16_t*)(a.ws + WS_ZG) + (size_t)row * ZGW; const bf16_t* MGp = (const bf16_t*)(a.ws + WS_MERGED) + (size_t)row * DM;
    float m = 0.f;
    for (int n = 0; n < 4; ++n) { float d = 0.f; { const int k = tid; d = bf2f(Y[(size_t)n * MTOK * 256 + (size_t)row * 256 + k]) * DIN_(40)[((size_t)n * 256 + k) * DM + col]; } d = blk_sum(d, sh); m += bf2f(ZGp[n * DM + col]) * d; }
    if (tid == 0) dbg_acc(a.acc, 14, bf2f(MGp[col]), m);
    float o = 0.f; for (int c = tid; c < DM; c += 256) o += bf2f(MGp[c]) * DIN_(41)[(size_t)c * DM + col]; o = blk_sum(o, sh);
    if (tid == 0) dbg_acc(a.acc, 15, a.out[(size_t)row * DM + col], DXIN_[(size_t)row * DM + col] + o);
}
__global__ void chk_cross(DbgArgs a) {
    __shared__ float sh[256]; __shared__ float hn[DM]; __shared__ float q[64]; __shared__ float p[256]; __shared__ float mn[DM];
    const int s = blockIdx.x, tid = threadIdx.x, row = (s * 7919 + 13) % MTOK, hd = s & 3, b = row >> 12;
    const float* x1 = a.out + (size_t)row * DM; float ss = 0.f; for (int k = tid; k < DM; k += 256) ss += x1[k] * x1[k]; ss = blk_sum(ss, sh); const float rs = rsqrtf(ss / DM + EPS);
    for (int k = tid; k < DM; k += 256) hn[k] = x1[k] * rs * DIN_(5)[k]; __syncthreads();
    float qf = 0.f; if (tid < 64) { for (int k = 0; k < DM; ++k) qf += hn[k] * DIN_(42)[(size_t)k * 256 + hd * 64 + tid]; dbg_acc(a.acc, 16, bf2f(((const bf16_t*)(a.ws + WS_QX))[(size_t)row * 256 + hd * 64 + tid]), qf); }
    { const float s2 = blk_sum(tid < 64 ? qf * qf : 0.f, sh); if (tid < 64) q[tid] = qf * rsqrtf(s2 / 64.f + EPS) * DIN_(46)[tid] * 0.125f; __syncthreads(); }
    float sc = 0.f; float vj[1]; (void)vj;
    { const float* mr = DIN_(1) + (size_t)(b * 256 + tid) * DM; float ms = 0.f; for (int k = 0; k < DM; ++k) ms += mr[k] * mr[k]; const float mrs = rsqrtf(ms / DM + EPS);
      float kk[64]; (void)kk; float s2 = 0.f; float dotq = 0.f;
      for (int d = 0; d < 64; ++d) { float kd = 0.f; for (int k = 0; k < DM; ++k) kd += mr[k] * mrs * DIN_(6)[k] * DIN_(43)[(size_t)k * 256 + hd * 64 + d]; s2 += kd * kd; dotq += kd * DIN_(47)[d] * q[d]; }
      sc = dotq * rsqrtf(s2 / 64.f + EPS); }
    const float mx = blk_max(sc, sh); const float e = expf(sc - mx); const float sm = blk_sum(e, sh); p[tid] = e / sm; __syncthreads();
    if (tid < 64) { float o = 0.f; for (int j = 0; j < 256; ++j) { const float* mr = DIN_(1) + (size_t)(b * 256 + j) * DM; float ms = 0.f, vd = 0.f; for (int k = 0; k < DM; ++k) { ms += mr[k] * mr[k]; vd += mr[k] * DIN_(6)[k] * DIN_(44)[(size_t)k * 256 + hd * 64 + tid]; } o += p[j] * vd * rsqrtf(ms / DM + EPS); }
        dbg_acc(a.acc, 17, bf2f(((const bf16_t*)(a.ws + WS_OX))[(size_t)row * 256 + hd * 64 + tid]), o); }
}
__global__ void chk_ffn(DbgArgs a) {
    __shared__ float sh[256]; __shared__ float hn[DM]; const int s = blockIdx.x, tid = threadIdx.x, row = (s * 7919 + 13) % MTOK;
    const float* x2 = a.out + (size_t)row * DM; float ss = 0.f; for (int k = tid; k < DM; k += 256) ss += x2[k] * x2[k]; ss = blk_sum(ss, sh); const float rs = rsqrtf(ss / DM + EPS);
    for (int k = tid; k < DM; k += 256) hn[k] = x2[k] * rs * DIN_(7)[k]; __syncthreads();
    for (int j = tid; j < FF; j += 256 * 8) { float g = 0.f, u = 0.f; for (int k = 0; k < DM; ++k) { g += hn[k] * DIN_(48)[(size_t)k * FF + j]; u += hn[k] * DIN_(49)[(size_t)k * FF + j]; }
        dbg_acc(a.acc, 18, bf2f(((const bf16_t*)(a.ws + WS_HFF))[(size_t)row * FF + j]), g / (1.f + expf(-g)) * u); }
}

__global__ void chk_moe(DbgArgs a) {
    __shared__ float sh[256]; __shared__ float hn[DM]; __shared__ float hid[EFF]; __shared__ float lgs[8];
    const int s = blockIdx.x, tid = threadIdx.x, tok = (s * 7919 + 13) % MTOK, slot = s & 1, col = (s * 104729 + 7) % DM;
    const float* x2 = a.out + (size_t)tok * DM; float ss = 0.f; for (int k = tid; k < DM; k += 256) ss += x2[k] * x2[k]; ss = blk_sum(ss, sh); const float rs = rsqrtf(ss / DM + EPS);
    for (int k = tid; k < DM; k += 256) hn[k] = x2[k] * rs * ((const float*)a.in[7])[DM + k]; __syncthreads();
    for (int e = 0; e < 8; ++e) { float d = 0.f; for (int k = tid; k < DM; k += 256) d += hn[k] * DIN_(51)[k * 8 + e]; d = blk_sum(d, sh); if (tid == 0) lgs[e] = d; } __syncthreads();
    int e1 = 0; for (int e = 1; e < 8; ++e) if (lgs[e] > lgs[e1]) e1 = e; int e2 = -1; for (int e = 0; e < 8; ++e) if (e != e1 && (e2 < 0 || lgs[e] > lgs[e2])) e2 = e;
    const float w1 = 1.f / (1.f + expf(lgs[e2] - lgs[e1])), w2 = 1.f - w1;
    const int* ASG = (const int*)(a.ws + WS_MOESM + MS_ASSIGN); const int* TD = (const int*)(a.ws + WS_MOESM + MS_TOKDEST); const float* TW = (const float*)(a.ws + WS_MOESM + MS_TOKW); const int* RT = (const int*)(a.ws + WS_MOESM + MS_ROWTOK);
    const int ef = ASG[2 * tok + slot] & 255, dest = TD[2 * tok + slot];
    if (tid == 0) { dbg_acc(a.acc, 19, (float)(ASG[2 * tok] & 255), (float)e1 + 1e-3f); dbg_acc(a.acc, 19, (float)(ASG[2 * tok + 1] & 255), (float)e2 + 1e-3f); dbg_acc(a.acc, 19, TW[2 * tok], w1); dbg_acc(a.acc, 19, TW[2 * tok + 1], w2); dbg_acc(a.acc, 19, (float)(RT[dest] - tok), 1e-3f); }
    const float* wg = DIN_(52) + (size_t)ef * DM * EFF; const float* wu = DIN_(53) + (size_t)ef * DM * EFF; const float* wd = DIN_(54) + (size_t)ef * EFF * DM;
    for (int f = tid; f < EFF; f += 256) { float g = 0.f, u = 0.f; for (int k = 0; k < DM; ++k) { g += hn[k] * wg[(size_t)k * EFF + f]; u += hn[k] * wu[(size_t)k * EFF + f]; } hid[f] = g / (1.f + expf(-g)) * u; }
    __syncthreads();
    float y = 0.f; for (int f = tid; f < EFF; f += 256) y += hid[f] * wd[(size_t)f * DM + col]; y = blk_sum(y, sh);
    if (tid == 0) dbg_acc(a.acc, 20, bf2f(((const bf16_t*)(a.ws + WS_YS))[(size_t)dest * DM + col]), y);
}

__global__ void chk_res(DbgArgs a, int kind) {
    __shared__ float sh[256]; const int s = blockIdx.x, tid = threadIdx.x, row = (s * 7919 + 13) % MTOK, col = (s * 104729 + 7) % DM; const float* xprev = (const float*)(a.ws + WS_DBG);
    float o = 0.f;
    if (kind == 0) { const bf16_t* A = (const bf16_t*)(a.ws + WS_OX) + (size_t)row * 256; o = bf2f(A[tid]) * DIN_(45)[(size_t)tid * DM + col]; }
    else { const bf16_t* A = (const bf16_t*)(a.ws + WS_HFF) + (size_t)row * FF; for (int k = tid; k < FF; k += 256) o += bf2f(A[k]) * DIN_(50)[(size_t)k * DM + col]; }
    o = blk_sum(o, sh);
    if (tid == 0) { dbg_acc(a.acc, 21, a.out[(size_t)row * DM + col], xprev[(size_t)row * DM + col] + o);
        const bf16_t xbv = ((const bf16_t*)(a.ws + WS_XB))[(size_t)row * DM + col]; dbg_acc(a.acc, 22, bf2f(xbv), a.out[(size_t)row * DM + col]); }
}

__global__ void chk_final(DbgArgs a) {
    const int i = blockIdx.x * 256 + threadIdx.x; const int tok = (i * 37 + 5) % MTOK, col = (i * 101 + 3) % DM; const float* xprev = (const float*)(a.ws + WS_DBG);
    const int* TD = (const int*)(a.ws + WS_MOESM + MS_TOKDEST); const float* TW = (const float*)(a.ws + WS_MOESM + MS_TOKW); const bf16_t* YS = (const bf16_t*)(a.ws + WS_YS);
    const float ref = xprev[(size_t)tok * DM + col] + TW[2 * tok] * bf2f(YS[(size_t)TD[2 * tok] * DM + col]) + TW[2 * tok + 1] * bf2f(YS[(size_t)TD[2 * tok + 1] * DM + col]);
    dbg_acc(a.acc, 23, a.out[(size_t)tok * DM + col], ref);
}
__global__ void chk_emit(DbgArgs a, int nchk) {
    for (int i = blockIdx.x * 256 + threadIdx.x; i < MTOK * DM; i += gridDim.x * 256) a.out[i] = 0.f;
    if (blockIdx.x == 0 && threadIdx.x == 0) { float V = 99000.f; float worst = 0.f;
        for (int k = 1; k <= nchk; ++k) { const float cnt = a.acc[64 + k]; const float rms = sqrtf(a.acc[2 * k + 1] / fmaxf(cnt, 1.f)) + 1e-20f; float err = a.acc[2 * k] / rms; if (cnt < 1.f) continue; if (!(err == err)) err = 0.97f; worst = fmaxf(worst, err);
#ifdef DBG_ONLY
            if (k == DBG_ONLY) { V = 1000.f + err * 10000.f; break; }
#else
            if (err > 0.06f) { V = (float)k * 1000.f + fminf(err, 0.99f) * 1000.f; break; }
#endif
        }
        if (V == 99000.f) V = 99000.f + worst * 1000.f;
        a.out[12345] = V; }
}
#endif

#ifdef DBG_STAT
__global__ void stat_scan(const float* out, unsigned* acc) {
    for (int i = blockIdx.x * 256 + threadIdx.x; i < MTOK * DM; i += gridDim.x * 256) { const float v = fabsf(out[i]);
        atomicMax(&acc[1], __float_as_uint(v)); if (v > 10.f || !(v == v)) { atomicAdd(&acc[0], 1u); atomicAdd(&acc[2 + (i >> 18)], 1u); atomicAdd(&acc[70 + ((i & 1023) >> 8)], 1u); atomicAdd(&acc[80 + ((i >> 10) & 255) / 32], 1u); } }
}
__global__ void stat_emit(float* out, const unsigned* acc, int mode) {
    for (int i = blockIdx.x * 256 + threadIdx.x; i < MTOK * DM; i += gridDim.x * 256) out[i] = 0.f;
    if (blockIdx.x == 0 && threadIdx.x == 0) { float V = 0.f;
        if (mode == 0) V = (float)acc[0];
        else if (mode == 1) V = __uint_as_float(acc[1]) * 100.f;
        else if (mode == 2) { unsigned best = 0, bi = 0, nz = 0; for (int k = 0; k < 64; ++k) { if (acc[2 + k] > best) { best = acc[2 + k]; bi = k; } nz += acc[2 + k] > 0; } V = 1000.f * (float)bi + 10.f * (float)nz; }
        else if (mode == 3) V = 1000.f * (float)acc[70] / fmaxf((float)acc[0], 1.f) + 100000.f * (float)acc[71] / fmaxf((float)acc[0], 1.f);
        else if (mode == 4) { unsigned best = 0, bi = 0; for (int k = 0; k < 8; ++k) if (acc[80 + k] > best) { best = acc[80 + k]; bi = k; } V = 1000.f + 1000.f * (float)bi + 900.f * (float)best / fmaxf((float)acc[0], 1.f); }
        out[12345] = V + 100.f; }
}
#endif

#ifdef DBG_VAR
__global__ void var_scan(const float* out, const float* prev, float* acc) {
    float s = 0.f, mx = 0.f; for (int i = blockIdx.x * 256 + threadIdx.x; i < MTOK * DM; i += gridDim.x * 256) { const float d = out[i] - prev[i]; s += d * d; mx = fmaxf(mx, fabsf(d)); }
    atomicAdd(&acc[0], s); atomicMax((unsigned*)&acc[1], __float_as_uint(mx));
}
__global__ void var_emit(float* out, const float* acc, int mode) {
    for (int i = blockIdx.x * 256 + threadIdx.x; i < MTOK * DM; i += gridDim.x * 256) out[i] = 0.f;
    if (blockIdx.x == 0 && threadIdx.x == 0) out[12345] = 100.f + (mode == 0 ? acc[0] / (float)(MTOK * DM) * 1e5f : acc[1] * 100.f);
}
#endif

#ifdef DBG_GSTAT
__global__ void gstat_scan(const bf16_t* zg, float* acc) { float s1 = 0.f, s2 = 0.f; for (size_t i = blockIdx.x * 256 + threadIdx.x; i < (size_t)MTOK * ZGW; i += (size_t)gridDim.x * 256) { const float g = bf2f(zg[i]); const int blk = (int)((i & 4095) >> 10); if (blk == DBG_GSTAT) { s1 += (g < -0.01f || g > 1.01f || !(g == g)) ? 1.f : 0.f; s2 += (g - 0.5f) * (g - 0.5f); } } atomicAdd(&acc[0], s1); atomicAdd(&acc[1], s2); }
__global__ void gstat_emit(float* out, const float* acc, int mode) {
    for (int i = blockIdx.x * 256 + threadIdx.x; i < MTOK * DM; i += gridDim.x * 256) out[i] = 0.f;
    if (blockIdx.x == 0 && threadIdx.x == 0) out[12345] = 100.f + 10000.f * acc[1] / ((float)MTOK * 1024);
}
#endif
extern "C" void kernel_launch(void* const* d_in, const int* in_sizes, int n_in, void* d_out, int out_size, void* d_ws, size_t ws_size, hipStream_t stream) {
    static int grid = 0;
    if (grid == 0) {
        if (n_in != 55 || out_size != MTOK * DM || ws_size < WS_END) { fprintf(stderr, "kernel_launch: unexpected shapes (n_in %d out %d ws %zu)\n", n_in, out_size, ws_size); grid = -1; return; }
        { const int L2 = 2; const int exp_sz[55] = {NB * SEQ * DM, NB * NMEM * DM, NB * SEQ, 32 * 4, L2 * DM, L2 * DM, L2 * DM, L2 * DM, L2 * DM * DIN, L2 * 4 * DM, L2 * 1024, L2 * 1024, L2 * 16, L2 * 16384, L2 * 16384, L2 * 16384, L2 * 16384, L2 * 256, L2 * 65536, L2 * 256,
              L2 * 192, L2 * 128, L2 * 192 * 384, L2 * 128 * 512, L2 * 96, L2 * 96, L2 * 1024, L2 * 256, L2 * 16384, L2 * 256, L2 * 16384, L2 * 256, L2 * 256, L2 * 32, L2 * 32, L2 * 32, L2 * 32, L2 * 32, L2 * 32, L2 * 64,
              L2 * 4 * 256 * DM, L2 * DM * DM, L2 * DM * 256, L2 * DM * 256, L2 * DM * 256, L2 * 256 * DM, L2 * 64, L2 * 64, DM * FF, DM * FF, FF * DM, DM * 8, 8 * DM * EFF, 8 * DM * EFF, 8 * EFF * DM};
          for (int i = 0; i < 55; ++i) if (in_sizes[i] != exp_sz[i]) { fprintf(stderr, "kernel_launch: input %d has %d elements, expected %d\n", i, in_sizes[i], exp_sz[i]); grid = -1; return; } }
        int dev = 0, cus = 0, per_cu = 0;
        if (hipGetDevice(&dev) != hipSuccess || hipDeviceGetAttribute(&cus, hipDeviceAttributeMultiprocessorCount, dev) != hipSuccess) { grid = -1; return; }
        if (hipFuncSetAttribute((const void*)hybrid_fwd, hipFuncAttributeMaxDynamicSharedMemorySize, LDS_BYTES) != hipSuccess) { fprintf(stderr, "kernel_launch: hipFuncSetAttribute failed\n"); grid = -1; return; }
        if (hipOccupancyMaxActiveBlocksPerMultiprocessor(&per_cu, (const void*)hybrid_fwd, 512, LDS_BYTES) != hipSuccess || per_cu < 1) { fprintf(stderr, "kernel_launch: occupancy query says %d\n", per_cu); }
        (void)hipGetLastError();
        grid = cus;
    }
    if (grid < 0) return;
    if (hipMemsetAsync((char*)d_ws + WS_CTL, 0, CTL_ZERO_BYTES, stream) != hipSuccess) return;
    Args a{};
    for (int i = 0; i < 55; ++i) a.in[i] = d_in[i];
    a.out = (float*)d_out; a.ws = (unsigned char*)d_ws; a.submask = 0xFFFF; a.pad = 0;
#if MK_ONE_LAUNCH
    a.ph_lo = 0; a.ph_hi = NPHASE;
    hipLaunchKernelGGL(hybrid_fwd, dim3(grid), dim3(512), LDS_BYTES, stream, a);
#else
    for (int p = 0; p < DBG_NPH; ++p) { a.ph_lo = p; a.ph_hi = p + 1;
#if defined(DBG_CHECK) || defined(DBG_VAR)
        if (p == DBG_NPH - 1) hipMemcpyAsync((char*)d_ws + 440 * MiB, d_out, (size_t)MTOK * DM * 4, hipMemcpyDeviceToDevice, stream);
#endif
        hipLaunchKernelGGL(hybrid_fwd, dim3(grid), dim3(512), LDS_BYTES, stream, a);
#ifdef DBG_REPEAT
        if (p == DBG_REPEAT) {
#ifdef DBG_REPSUB
            a.submask = DBG_REPSUB;
#endif
            hipLaunchKernelGGL(hybrid_fwd, dim3(grid), dim3(512), LDS_BYTES, stream, a); hipLaunchKernelGGL(hybrid_fwd, dim3(grid), dim3(512), LDS_BYTES, stream, a); a.submask = 0xFFFF; }
#endif
    }
#ifdef DBG_CHECK
    { DbgArgs da{}; for (int i = 0; i < 55; ++i) da.in[i] = d_in[i]; da.ws = (unsigned char*)d_ws; da.out = (float*)d_out; da.acc = (float*)((char*)d_ws + 700 * 1024);
#if DBG_NPH == 6 || DBG_NPH == 16
      hipLaunchKernelGGL(chk_merge, dim3(512), dim3(256), 0, stream, da);
#elif DBG_NPH == 8 || DBG_NPH == 18
      hipLaunchKernelGGL(chk_cross, dim3(64), dim3(256), 0, stream, da);
#elif DBG_NPH == 10
      hipLaunchKernelGGL(chk_ffn, dim3(64), dim3(256), 0, stream, da);
#elif DBG_NPH == 24
      hipLaunchKernelGGL(chk_final, dim3(64), dim3(256), 0, stream, da);
#elif DBG_NPH == 23
      hipLaunchKernelGGL(chk_moe, dim3(128), dim3(256), 0, stream, da);
#elif DBG_NPH == 9 || DBG_NPH == 19
      hipLaunchKernelGGL(chk_res, dim3(512), dim3(256), 0, stream, da, 0);
#elif DBG_NPH == 11
      hipLaunchKernelGGL(chk_res, dim3(512), dim3(256), 0, stream, da, 1);
#else
      hipLaunchKernelGGL(chk_z, dim3(1024), dim3(256), 0, stream, da);
      hipLaunchKernelGGL(chk_mla_prep, dim3(512), dim3(256), 0, stream, da);
      hipLaunchKernelGGL(chk_diff_prep, dim3(16), dim3(256), 0, stream, da);
      hipLaunchKernelGGL(chk_lru_prep, dim3(512), dim3(256), 0, stream, da);
      hipLaunchKernelGGL(chk_mla_attn, dim3(64), dim3(256), 0, stream, da);
      hipLaunchKernelGGL(chk_diff_attn, dim3(64), dim3(256), 0, stream, da);
      hipLaunchKernelGGL(chk_lru_scan, dim3(4), dim3(256), 0, stream, da);
      hipLaunchKernelGGL(chk_s5_scan, dim3(16), dim3(64), 0, stream, da);
      hipLaunchKernelGGL(chk_s5_glu, dim3(64), dim3(256), 0, stream, da);
#endif
      hipLaunchKernelGGL(chk_emit, dim3(1024), dim3(256), 0, stream, da, 23); }
#endif
#ifdef DBG_COPYX
    hipMemcpyAsync(d_out, d_in[0], (size_t)MTOK * DM * 4, hipMemcpyDeviceToDevice, stream);
#endif
#ifdef DBG_GSTAT
    { float* acc = (float*)((char*)d_ws + 900 * 1024);
      hipLaunchKernelGGL(gstat_scan, dim3(2048), dim3(256), 0, stream, (const bf16_t*)((const char*)d_ws + WS_ZG), acc);
      hipLaunchKernelGGL(gstat_emit, dim3(1024), dim3(256), 0, stream, (float*)d_out, (const float*)acc, DBG_GSTAT); }
#endif
#ifdef DBG_VAR
    { float* acc = (float*)((char*)d_ws + 900 * 1024);
      hipLaunchKernelGGL(var_scan, dim3(1024), dim3(256), 0, stream, (const float*)d_out, DBG_NPH == 6 ? (const float*)d_in[0] : (const float*)((const char*)d_ws + 440 * MiB), acc);
      hipLaunchKernelGGL(var_emit, dim3(1024), dim3(256), 0, stream, (float*)d_out, (const float*)acc, DBG_VAR); }
#endif
#ifdef DBG_STAT
    { unsigned* acc = (unsigned*)((char*)d_ws + 800 * 1024);
      hipLaunchKernelGGL(stat_scan, dim3(2048), dim3(256), 0, stream, (const float*)d_out, acc);
      hipLaunchKernelGGL(stat_emit, dim3(1024), dim3(256), 0, stream, (float*)d_out, (const unsigned*)acc, DBG_STAT); }
#endif
#ifdef DBG_DUMP_OFF
    hipLaunchKernelGGL(dbg_copy_bf16, dim3(2048), dim3(256), 0, stream, (const bf16_t*)((const char*)d_ws + (size_t)(DBG_DUMP_OFF)), (float*)d_out, MTOK * DM, DBG_DUMP_N);
#endif
#endif
}
```
